# Optimizing an MI355X kernel written in HIP

```python
import jax
import jax.numpy as jnp
from jax import lax
import numpy as np

D_MODEL = 1024
BATCH = 2
SEQ = 8192
DEPTH = 2

HEAD_DIM = 64
BRANCH_HEADS = 6
BRANCH_WIDTH = BRANCH_HEADS * HEAD_DIM
N_BRANCH = 5
MOBA_BLOCK = 256
MOBA_TOPK = 3
MOBA_QCHUNK = 64
DILATED_GROUPS = ((128, 1), (512, 4), (2048, 16))
N_DIL_GROUPS = 3
BAND = 128
FOX_BLOCK = 128
GDN_CHUNK = 64
CONV_K = 4
MEM_LEN = 256
MEM_HEADS = 4
MEM_HEAD_DIM = BRANCH_WIDTH // MEM_HEADS

A_QKV = 3 * BRANCH_WIDTH
B_QK = 2 * N_DIL_GROUPS * BRANCH_WIDTH
B_V = BRANCH_WIDTH
C_QKV = 3 * BRANCH_WIDTH
C_F = BRANCH_HEADS
D_QKV = 3 * BRANCH_WIDTH
D_BETA = BRANCH_HEADS
D_DECAY = BRANCH_HEADS
E_Q = BRANCH_WIDTH
Z_W = N_BRANCH * BRANCH_WIDTH
MERGE_W = N_BRANCH * D_MODEL
IN_SPLIT_SIZES = (A_QKV, B_QK, B_V, C_QKV, C_F, D_QKV, D_BETA, D_DECAY, E_Q, Z_W, MERGE_W)
D_IN = A_QKV + B_QK + B_V + C_QKV + C_F + D_QKV + D_BETA + D_DECAY + E_Q + Z_W + MERGE_W

DEEPNORM_ALPHA = (2 * DEPTH) ** 0.25
DEEPNORM_BETA = (8 * DEPTH) ** -0.25
NEG = -1e30
LN_EPS = 1e-5
RMS_EPS = 1e-6

kernel_name = 'hybrid_gated_parallel_moba_dilated_fox_gdn'


def _layer_norm(x, g, b):
    xf = x.astype(jnp.float32)
    mu = xf.mean(-1, keepdims=True)
    var = jnp.square(xf - mu).mean(-1, keepdims=True)
    y = (xf - mu) * lax.rsqrt(var + LN_EPS) * g.astype(jnp.float32) + b.astype(jnp.float32)
    return y.astype(x.dtype)


def _split_heads(t, n):
    B, S, _ = t.shape
    return t.reshape(B, S, n, -1).transpose(0, 2, 1, 3)


def _merge_heads(o):
    B, H, S, dh = o.shape
    return o.transpose(0, 2, 1, 3).reshape(B, S, H * dh)


def _l2norm(t):
    return t * lax.rsqrt(jnp.sum(jnp.square(t), -1, keepdims=True) + RMS_EPS)


def _moba_attention(q, k, v):
    B, H, S, dh = q.shape
    nblk = -(-S // MOBA_BLOCK)
    Sp = nblk * MOBA_BLOCK
    pad = ((0, 0), (0, 0), (0, Sp - S), (0, 0))
    q = jnp.pad(q.astype(jnp.float32) * dh ** -0.5, pad)
    k = jnp.pad(k.astype(jnp.float32), pad)
    v = jnp.pad(v.astype(jnp.float32), pad)
    kb = k.reshape(B, H, nblk, MOBA_BLOCK, dh)
    vb = v.reshape(B, H, nblk, MOBA_BLOCK, dh)
    qblk = jnp.arange(Sp) // MOBA_BLOCK
    gate = jnp.einsum('bhsd,bhnd->bhsn', q, kb.mean(axis=3))
    gate = jnp.where(jnp.arange(nblk)[None, :] < qblk[:, None], gate, NEG)
    ksel = min(MOBA_TOPK, nblk)
    _, sel = lax.top_k(gate, ksel)
    sel_ok = sel < qblk[:, None]
    bi = jnp.arange(B)[:, None, None, None]
    hi = jnp.arange(H)[None, :, None, None]
    qoff = jnp.arange(MOBA_QCHUNK)
    koff = jnp.arange(MOBA_BLOCK)

    def chunk(c):
        start = c * MOBA_QCHUNK
        own = (start // MOBA_BLOCK) * MOBA_BLOCK
        qc = lax.dynamic_slice_in_dim(q, start, MOBA_QCHUNK, axis=2)
        sc = lax.dynamic_slice_in_dim(sel, start, MOBA_QCHUNK, axis=2)
        okc = lax.dynamic_slice_in_dim(sel_ok, start, MOBA_QCHUNK, axis=2)
        kg = kb[bi, hi, sc]
        vg = vb[bi, hi, sc]
        l_sel = jnp.einsum('bhqd,bhqnkd->bhqnk', qc, kg)
        l_sel = jnp.where(okc[..., None], l_sel, NEG).reshape(B, H, MOBA_QCHUNK, ksel * MOBA_BLOCK)
        ko = lax.dynamic_slice_in_dim(k, own, MOBA_BLOCK, axis=2)
        vo = lax.dynamic_slice_in_dim(v, own, MOBA_BLOCK, axis=2)
        l_own = jnp.einsum('bhqd,bhkd->bhqk', qc, ko)
        l_own = jnp.where((start + qoff)[:, None] >= (own + koff)[None, :], l_own, NEG)
        p = jax.nn.softmax(jnp.concatenate([l_sel, l_own], axis=-1), axis=-1)
        p_sel = p[..., :ksel * MOBA_BLOCK].reshape(B, H, MOBA_QCHUNK, ksel, MOBA_BLOCK)
        p_own = p[..., ksel * MOBA_BLOCK:]
        return jnp.einsum('bhqnk,bhqnkd->bhqd', p_sel, vg) + jnp.einsum('bhqk,bhkd->bhqd', p_own, vo)

    out = lax.map(chunk, jnp.arange(Sp // MOBA_QCHUNK))
    return jnp.moveaxis(out, 0, 2).reshape(B, H, Sp, dh)[:, :, :S]


def _dilated_band(q, k, v, window, dilation):
    B, H, S, dh = q.shape
    L = S // dilation
    nb = -(-L // BAND)
    Lp = nb * BAND
    reach = window // dilation

    def streams(t):
        t = t.reshape(B, H, L, dilation, dh).transpose(0, 1, 3, 2, 4)
        t = jnp.pad(t, ((0, 0), (0, 0), (0, 0), (0, Lp - L), (0, 0)))
        return t.reshape(B, H, dilation, nb, BAND, dh)

    def with_prev(t):
        prev = jnp.pad(t, ((0, 0), (0, 0), (0, 0), (1, 0), (0, 0), (0, 0)))[:, :, :, :nb]
        return jnp.concatenate([prev, t], axis=4)

    qs = streams(q)
    kk = with_prev(streams(k))
    vv = with_prev(streams(v))
    logits = jnp.einsum('bhrnqd,bhrnkd->bhrnqk', qs, kk)
    qi = jnp.arange(BAND)[:, None]
    kj = jnp.arange(2 * BAND)[None, :]
    dist = BAND + qi - kj
    blk = jnp.arange(nb)[:, None, None]
    valid = (dist >= 0) & (dist <= reach) & ((blk - 1) * BAND + kj >= 0)
    logits = jnp.where(valid, logits, NEG)
    m = logits.max(-1)
    p = jnp.exp(logits - m[..., None])
    s = p.sum(-1)
    num = jnp.einsum('bhrnqk,bhrnkd->bhrnqd', p, vv)

    def unstream(t):
        t = t.reshape(B, H, dilation, Lp, *t.shape[5:])[:, :, :, :L]
        return jnp.swapaxes(t, 2, 3).reshape(B, H, S, *t.shape[4:])

    return unstream(num), unstream(s), unstream(m)


def _dilated_mixture(qg, kg, v):
    dh = v.shape[-1]
    qg = qg.astype(jnp.float32) * dh ** -0.5
    kg = kg.astype(jnp.float32)
    v = v.astype(jnp.float32)
    parts = [_dilated_band(qg[i], kg[i], v, w, d) for i, (w, d) in enumerate(DILATED_GROUPS)]
    m_max = jnp.max(jnp.stack([pt[2] for pt in parts]), axis=0)
    num, den = None, None
    for pn, ps, pm in parts:
        wgt = jnp.exp(pm - m_max)
        num = pn * wgt[..., None] if num is None else num + pn * wgt[..., None]
        den = ps * wgt if den is None else den + ps * wgt
    return num / den[..., None]


def _forgetting_attention(q, k, v, log_f):
    B, H, S, dh = q.shape
    q = q.astype(jnp.float32) * dh ** -0.5
    k = k.astype(jnp.float32)
    v = v.astype(jnp.float32)
    F = lax.cumsum(log_f, axis=2)
    kpos = jnp.arange(S)
    qoff = jnp.arange(FOX_BLOCK)

    def block(c):
        start = c * FOX_BLOCK
        qc = lax.dynamic_slice_in_dim(q, start, FOX_BLOCK, axis=2)
        Fc = lax.dynamic_slice_in_dim(F, start, FOX_BLOCK, axis=2)
        l = jnp.einsum('bhqd,bhkd->bhqk', qc, k) + Fc[..., :, None] - F[..., None, :]
        l = jnp.where((start + qoff)[:, None] >= kpos[None, :], l, NEG)
        p = jax.nn.softmax(l, axis=-1)
        return jnp.einsum('bhqk,bhkd->bhqd', p, v)

    out = lax.map(block, jnp.arange(S // FOX_BLOCK))
    return jnp.moveaxis(out, 0, 2).reshape(B, H, S, dh)


def _causal_depthwise_conv(x, w):
    C = x.shape[-1]
    return lax.conv_general_dilated(x, w[:, None, :], window_strides=(1,), padding=[(CONV_K - 1, 0)], dimension_numbers=('NWC', 'WIO', 'NWC'), feature_group_count=C)


def _gated_delta_rule(q, k, v, beta, g):
    B, H, S, dk = q.shape
    dv = v.shape[-1]
    C = GDN_CHUNK
    n = S // C
    ch = lambda t: t.reshape(B, H, n, C, *t.shape[3:])
    q, k, v, beta, g = ch(q), ch(k), ch(v), ch(beta), ch(g)
    gc = lax.cumsum(g, axis=3)
    incl = jnp.tril(jnp.ones((C, C), dtype=bool))
    strict = jnp.tril(jnp.ones((C, C), dtype=bool), -1)
    diff = gc[..., :, None] - gc[..., None, :]
    decay = jnp.where(incl, jnp.exp(jnp.where(incl, diff, 0.0)), 0.0)
    kb = k * beta[..., None]
    M = jnp.where(strict, jnp.einsum('bhnid,bhnjd->bhnij', kb, k) * decay, 0.0)
    eye = jnp.eye(C, dtype=q.dtype)
    T = lax.linalg.triangular_solve(M + eye, jnp.broadcast_to(eye, M.shape), left_side=True, lower=True)
    u = T @ (v * beta[..., None])
    w = T @ (kb * jnp.exp(gc)[..., None])
    qk = jnp.einsum('bhnid,bhnjd->bhnij', q, k) * decay
    q_dec = q * jnp.exp(gc)[..., None]
    k_dec = k * jnp.exp(gc[..., -1:] - gc)[..., None]
    g_last = jnp.exp(gc[..., -1])
    xs = (jnp.moveaxis(u, 2, 0), jnp.moveaxis(w, 2, 0), jnp.moveaxis(qk, 2, 0), jnp.moveaxis(q_dec, 2, 0), jnp.moveaxis(k_dec, 2, 0), jnp.moveaxis(g_last, 2, 0))

    def step(state, inp):
        u_i, w_i, qk_i, qd_i, kd_i, gl_i = inp
        v_new = u_i - w_i @ state
        o = qd_i @ state + qk_i @ v_new
        state = state * gl_i[..., None, None] + jnp.swapaxes(kd_i, -1, -2) @ v_new
        return state, o

    state0 = jnp.zeros((B, H, dk, dv), dtype=q.dtype)
    _, o = lax.scan(step, state0, xs)
    return jnp.moveaxis(o, 0, 2).reshape(B, H, S, dv)


def _memory_cross_attention(q, mem_n, w_kv):
    B, S, _ = q.shape
    Mn = mem_n.shape[1]
    k, v = jnp.split(mem_n @ w_kv, 2, axis=-1)
    q = q.reshape(B, S, MEM_HEADS, MEM_HEAD_DIM).astype(jnp.float32) * MEM_HEAD_DIM ** -0.5
    k = k.reshape(B, Mn, MEM_HEADS, MEM_HEAD_DIM).astype(jnp.float32)
    v = v.reshape(B, Mn, MEM_HEADS, MEM_HEAD_DIM).astype(jnp.float32)
    p = jax.nn.softmax(jnp.einsum('bshd,bmhd->bhsm', q, k), axis=-1)
    return jnp.einsum('bhsm,bmhd->bshd', p, v).reshape(B, S, BRANCH_WIDTH)


def _hybrid_layer(x, mem_n, w_in, b_in, conv_w, a_log, dt_bias, gdn_norm_w, w_mem_kv, w_branch, w_out, ln_g, ln_b):
    B, S, _ = x.shape
    f32 = jnp.float32
    h = x @ w_in + b_in
    offs = [int(o) for o in np.cumsum(IN_SPLIT_SIZES)[:-1]]
    (a_qkv, b_qk, b_v, c_qkv, c_f, d_qkv, d_beta, d_decay, e_q, z, merge_logits) = jnp.split(h, offs, axis=-1)

    aq, ak, av = [_split_heads(t, BRANCH_HEADS) for t in jnp.split(a_qkv, 3, axis=-1)]
    o_a = _moba_attention(aq, ak, av)

    bqk = b_qk.reshape(B, S, 2, N_DIL_GROUPS, BRANCH_HEADS, HEAD_DIM).transpose(2, 3, 0, 4, 1, 5)
    o_b = _dilated_mixture(bqk[0], bqk[1], _split_heads(b_v, BRANCH_HEADS))

    cq, ck, cv = [_split_heads(t, BRANCH_HEADS) for t in jnp.split(c_qkv, 3, axis=-1)]
    log_f = jax.nn.log_sigmoid(c_f.astype(f32)).transpose(0, 2, 1)
    o_c = _forgetting_attention(cq, ck, cv, log_f)

    dqkv = jax.nn.silu(_causal_depthwise_conv(d_qkv.astype(f32), conv_w.astype(f32)))
    dq, dk, dv = [_split_heads(t, BRANCH_HEADS) for t in jnp.split(dqkv, 3, axis=-1)]
    dq = _l2norm(dq) * HEAD_DIM ** -0.5
    dk = _l2norm(dk)
    beta = jax.nn.sigmoid(d_beta.astype(f32)).transpose(0, 2, 1)
    g = (-jnp.exp(a_log.astype(f32)) * jax.nn.softplus(d_decay.astype(f32) + dt_bias.astype(f32))).transpose(0, 2, 1)
    o_d = _gated_delta_rule(dq, dk, dv, beta, g)
    o_d = o_d * lax.rsqrt(jnp.square(o_d).mean(-1, keepdims=True) + RMS_EPS) * gdn_norm_w.astype(f32)

    o_e = _memory_cross_attention(e_q, mem_n, w_mem_kv)

    o = jnp.stack([_merge_heads(o_a), _merge_heads(o_b), _merge_heads(o_c), _merge_heads(o_d), o_e], axis=2).astype(x.dtype)
    o = o * jax.nn.silu(z.reshape(B, S, N_BRANCH, BRANCH_WIDTH))
    y = jnp.einsum('bsnc,ncd->bsnd', o, w_branch)
    y = jnp.sum(jax.nn.sigmoid(merge_logits.reshape(B, S, N_BRANCH, D_MODEL)) * y, axis=2)
    y = y @ w_out
    return _layer_norm(DEEPNORM_ALPHA * x + y, ln_g, ln_b)


def setup_inputs(seed: int = 0) -> dict:
    key = jax.random.key(seed)
    ks = jax.random.split(key, 16)
    nrm = jax.random.normal
    x = nrm(ks[0], (BATCH, SEQ, D_MODEL), jnp.float32)
    mem = nrm(ks[1], (BATCH, MEM_LEN, D_MODEL), jnp.float32)
    mem_ln_g = 1.0 + 0.02 * nrm(ks[2], (D_MODEL,), jnp.float32)
    mem_ln_b = 0.02 * nrm(ks[3], (D_MODEL,), jnp.float32)
    w_in = nrm(ks[4], (DEPTH, D_MODEL, D_IN), jnp.float32) * D_MODEL ** -0.5
    b_in = 0.02 * nrm(ks[5], (DEPTH, D_IN), jnp.float32)
    conv_w = nrm(ks[6], (DEPTH, CONV_K, D_QKV), jnp.float32) * CONV_K ** -0.5
    a_log = jnp.log(jax.random.uniform(ks[7], (DEPTH, BRANCH_HEADS), jnp.float32, 1.0, 16.0))
    dt = jnp.exp(jax.random.uniform(ks[8], (DEPTH, BRANCH_HEADS), jnp.float32, np.log(1e-3), np.log(1e-1)))
    dt_bias = dt + jnp.log(-jnp.expm1(-dt))
    gdn_norm_w = 1.0 + 0.02 * nrm(ks[9], (DEPTH, HEAD_DIM), jnp.float32)
    w_mem_kv = nrm(ks[10], (DEPTH, D_MODEL, 2 * BRANCH_WIDTH), jnp.float32) * D_MODEL ** -0.5
    w_branch = nrm(ks[11], (DEPTH, N_BRANCH, BRANCH_WIDTH, D_MODEL), jnp.float32) * (BRANCH_WIDTH ** -0.5 * DEEPNORM_BETA)
    w_out = nrm(ks[12], (DEPTH, D_MODEL, D_MODEL), jnp.float32) * (D_MODEL ** -0.5 * DEEPNORM_BETA)
    ln_g = 1.0 + 0.02 * nrm(ks[13], (DEPTH, D_MODEL), jnp.float32)
    ln_b = 0.02 * nrm(ks[14], (DEPTH, D_MODEL), jnp.float32)
    return {'x': x, 'mem': mem, 'mem_ln_g': mem_ln_g, 'mem_ln_b': mem_ln_b, 'w_in': w_in, 'b_in': b_in, 'conv_w': conv_w, 'a_log': a_log, 'dt_bias': dt_bias, 'gdn_norm_w': gdn_norm_w, 'w_mem_kv': w_mem_kv, 'w_branch': w_branch, 'w_out': w_out, 'ln_g': ln_g, 'ln_b': ln_b}


def reference(x, mem, mem_ln_g, mem_ln_b, w_in, b_in, conv_w, a_log, dt_bias, gdn_norm_w, w_mem_kv, w_branch, w_out, ln_g, ln_b):
    mem_n = _layer_norm(mem, mem_ln_g, mem_ln_b)
    for l in range(DEPTH):
        x = _hybrid_layer(x, mem_n, w_in[l], b_in[l], conv_w[l], a_log[l], dt_bias[l], gdn_norm_w[l], w_mem_kv[l], w_branch[l], w_out[l], ln_g[l], ln_b[l])
    return x
```

```cpp
#include <hip/hip_runtime.h>
#include <hip/hip_cooperative_groups.h>
#include <cstdio>
#include <cstdint>
namespace cg = cooperative_groups;

#define DI __device__ __forceinline__
typedef unsigned short bf16_t;
typedef short bf16x8 __attribute__((ext_vector_type(8)));
typedef short s16x4 __attribute__((ext_vector_type(4)));
typedef float f32x4 __attribute__((ext_vector_type(4)));
typedef float f32x2 __attribute__((ext_vector_type(2)));
typedef float f32x16 __attribute__((ext_vector_type(16)));
typedef unsigned u32x2 __attribute__((ext_vector_type(2)));
typedef unsigned u32x4 __attribute__((ext_vector_type(4)));
typedef __bf16 bfv2 __attribute__((ext_vector_type(2)));

#define MFMA32(a, b, c) __builtin_amdgcn_mfma_f32_32x32x16_bf16((a), (b), (c), 0, 0, 0)
#define MFMA16(a, b, c) __builtin_amdgcn_mfma_f32_16x16x32_bf16((a), (b), (c), 0, 0, 0)

DI unsigned pk2(float a, float b) { f32x2 v = {a, b}; return __builtin_bit_cast(unsigned, __builtin_convertvector(v, bfv2)); }
DI bf16_t f2bf(float a) { return (bf16_t)(pk2(a, 0.f) & 0xffffu); }
DI float bf2f(bf16_t v) { return __uint_as_float(((unsigned)v) << 16); }
DI float bflo(unsigned u) { return __uint_as_float(u << 16); }
DI float bfhi(unsigned u) { return __uint_as_float(u & 0xffff0000u); }
DI int otid() { int t = __builtin_amdgcn_workitem_id_x(); asm volatile("" : "+v"(t)); return t; }
DI int crow(int i, int h) { return (i & 3) + 8 * (i >> 2) + 4 * h; }
DI float fsigmoid(float v) { return __builtin_amdgcn_rcpf(1.f + __expf(-v)); }
DI float fsilu(float v) { return v * fsigmoid(v); }
DI u32x2 pk4(float a, float b, float c, float d) { u32x2 r; r.x = pk2(a, b); r.y = pk2(c, d); return r; }
DI bf16x8 pk8(const float* v) { u32x4 r; r.x = pk2(v[0], v[1]); r.y = pk2(v[2], v[3]); r.z = pk2(v[4], v[5]); r.w = pk2(v[6], v[7]); return __builtin_bit_cast(bf16x8, r); }
DI void unpk8(bf16x8 x, float* v) { u32x4 u = __builtin_bit_cast(u32x4, x); v[0] = bflo(u.x); v[1] = bfhi(u.x); v[2] = bflo(u.y); v[3] = bfhi(u.y); v[4] = bflo(u.z); v[5] = bfhi(u.z); v[6] = bflo(u.w); v[7] = bfhi(u.w); }

constexpr int NB = 2, SQ = 8192, NT = NB * SQ, DM = 1024, NH = 6, BW = 384;
constexpr int TH = 8192;
constexpr int NP = 13696;
constexpr int DIN = 13586;
constexpr float LOG2E = 1.4426950408889634f;
#define NEG_INF (-__builtin_inff())

constexpr int C_AQK = 0, C_AV = 768, C_BQK = 1152, C_BV = 3456, C_CQK = 3840, C_CV = 4608, C_D = 4992, C_E = 6144, C_SM = 6528, C_SMEND = 6546, C_Z = 6656, C_MG = 8576;

__host__ __device__ constexpr int inmap(int n) {
  return n < 4992 ? n : n < 6144 ? n + 6 : n < 6528 ? n + 18 : n < 6534 ? n - 1536 : n < 6546 ? n - 384 : n < 6656 ? -1 : n - 110;
}

constexpr size_t O_CTL = 0;
constexpr size_t O_WTIN = 4096;
constexpr size_t SZ_WTIN1 = (size_t)NP * 1024 * 2;
constexpr size_t O_WTBR = O_WTIN + 2 * SZ_WTIN1;
constexpr size_t SZ_WTBR1 = (size_t)5 * 1024 * 384 * 2;
constexpr size_t O_WTOUT = O_WTBR + 2 * SZ_WTBR1;
constexpr size_t SZ_WTOUT1 = (size_t)1024 * 1024 * 2;
constexpr size_t O_WTKV = O_WTOUT + 2 * SZ_WTOUT1;
constexpr size_t SZ_WTKV1 = (size_t)768 * 1024 * 2;
constexpr size_t O_BIASP = O_WTKV + 2 * SZ_WTKV1;
constexpr size_t O_XB = O_BIASP + (size_t)2 * NP * 4;
constexpr size_t O_MEMN = O_XB + (size_t)NT * 1024 * 2;
constexpr size_t O_MEMK = O_MEMN + (size_t)512 * 1024 * 2;
constexpr size_t O_MEMVT = O_MEMK + (size_t)512 * 384 * 2;
constexpr size_t O_QKA = O_MEMVT + (size_t)512 * 384 * 2;
constexpr size_t O_VTA = O_QKA + (size_t)TH * 768 * 2;
constexpr size_t O_QKB = O_VTA + (size_t)384 * TH * 2;
constexpr size_t O_VTB = O_QKB + (size_t)TH * 2304 * 2;
constexpr size_t SZ_VT = (size_t)384 * TH * 2;
constexpr size_t O_QKC = O_VTB + 3 * SZ_VT;
constexpr size_t O_VTC = O_QKC + (size_t)TH * 768 * 2;
constexpr size_t O_QKVD = O_VTC + SZ_VT;
constexpr size_t O_QE = O_QKVD + (size_t)TH * 1152 * 2;
constexpr size_t O_SM = O_QE + (size_t)TH * 384 * 2;
constexpr size_t O_FF = O_SM + (size_t)TH * 32 * 4;
constexpr size_t O_KM = O_FF + (size_t)6 * TH * 4;
constexpr size_t O_KMAX = O_KM + (size_t)2 * 6 * 32 * 64 * 2;
constexpr size_t O_GL = O_KMAX + 256;
constexpr size_t O_DPREP = O_GL + 6 * 128 * 4;
constexpr size_t O_SZ = O_DPREP + (size_t)768 * 32768;
constexpr size_t O_SIG = O_SZ + (size_t)TH * 1920 * 2;
constexpr size_t O_OA = O_SIG + (size_t)TH * 5120 * 2;
constexpr size_t SZ_O = (size_t)TH * 384 * 2;
constexpr size_t O_OB = O_OA + SZ_O;
constexpr size_t O_STB = O_OB + 3 * SZ_O;
constexpr size_t O_OC = O_STB + (size_t)3 * TH * 6 * 2 * 4;
constexpr size_t O_OD = O_OC + SZ_O;
constexpr size_t O_SSQ = O_OD + SZ_O;
constexpr size_t O_OE = O_SSQ + (size_t)TH * 6 * 4 * 4;
constexpr size_t WS_END = O_OE + SZ_O;
constexpr size_t O_YM = O_QKB;
static_assert(WS_END < (size_t)440 * 1000 * 1000, "workspace too large");

struct Params {
  const float *x, *mem, *mem_g, *mem_b, *w_in, *b_in, *conv_w, *a_log, *dt_bias, *gdn_w, *w_kv, *w_br, *w_out, *ln_g, *ln_b;
  float* out;
  unsigned char* ws;
};

constexpr int LDS_BYTES = 75776;
#ifndef PH_MASK
#define PH_MASK 0xFFFF
#endif
#define PH(x) ((PH_MASK >> (x)) & 1)

DI void transpose_tile(const float* __restrict__ src, int ld, int k0, int n0, bool usemap, bf16_t* __restrict__ dst, int dstld, float* tile) {
  const int tid = otid();
#pragma unroll 4
  for (int it = 0; it < 16; ++it) {
    const int kk = (tid >> 6) + 4 * it, nn = tid & 63;
    const int sc = usemap ? inmap(n0 + nn) : (n0 + nn);
    tile[kk * 65 + nn] = sc >= 0 ? src[(size_t)(k0 + kk) * ld + sc] : 0.f;
  }
  __syncthreads();
#pragma unroll 4
  for (int it = 0; it < 16; ++it) {
    const int nn = (tid >> 6) + 4 * it, kk = tid & 63;
    dst[(size_t)(n0 + nn) * dstld + k0 + kk] = f2bf(tile[kk * 65 + nn]);
  }
  __syncthreads();
}

DI void phase0(const Params& p, unsigned char* smem) {
  float* tile = (float*)smem;
  const int tid = otid(), lane = tid & 63, wave = tid >> 6;
  constexpr int N_TIN = 2 * 214 * 16, N_TBR = 2 * 5 * 16 * 6, N_TOUT = 2 * 16 * 16, N_TKV = 2 * 12 * 16, N_XB = 1024, N_MEMN = 128, N_BIAS = 107;
  constexpr int TOT = N_TIN + N_TBR + N_TOUT + N_TKV + N_XB + N_MEMN + N_BIAS;
  for (int it = blockIdx.x; it < TOT; it += gridDim.x) {
    int i = it;
    if (i < N_TIN) {
      const int l = i / (214 * 16), rr = i % (214 * 16), nt = rr / 16, kt = rr % 16;
      transpose_tile(p.w_in + (size_t)l * 1024 * DIN, DIN, kt * 64, nt * 64, true, (bf16_t*)(p.ws + O_WTIN + l * SZ_WTIN1), 1024, tile);
      continue;
    }
    i -= N_TIN;
    if (i < N_TBR) {
      const int ln = i / 96, rr = i % 96, nt = rr / 6, kt = rr % 6;
      transpose_tile(p.w_br + (size_t)ln * 384 * 1024, 1024, kt * 64, nt * 64, false, (bf16_t*)(p.ws + O_WTBR) + (size_t)ln * 1024 * 384, 384, tile);
      continue;
    }
    i -= N_TBR;
    if (i < N_TOUT) {
      const int l = i / 256, rr = i % 256, nt = rr / 16, kt = rr % 16;
      transpose_tile(p.w_out + (size_t)l * 1024 * 1024, 1024, kt * 64, nt * 64, false, (bf16_t*)(p.ws + O_WTOUT + l * SZ_WTOUT1), 1024, tile);
      continue;
    }
    i -= N_TOUT;
    if (i < N_TKV) {
      const int l = i / 192, rr = i % 192, nt = rr / 16, kt = rr % 16;
      transpose_tile(p.w_kv + (size_t)l * 1024 * 768, 768, kt * 64, nt * 64, false, (bf16_t*)(p.ws + O_WTKV + l * SZ_WTKV1), 1024, tile);
      continue;
    }
    i -= N_TKV;
    if (i < N_XB) {
      const float* src = p.x + (size_t)i * 16 * 1024;
      bf16_t* dst = (bf16_t*)(p.ws + O_XB) + (size_t)i * 16 * 1024;
#pragma unroll 4
      for (int j = 0; j < 16; ++j) {
        const int e = (j * 256 + tid) * 4;
        const f32x4 v = *(const f32x4*)(src + e);
        *(u32x2*)(dst + e) = pk4(v[0], v[1], v[2], v[3]);
      }
      continue;
    }
    i -= N_XB;
    if (i < N_MEMN) {
      const int row = i * 4 + wave;
      const float* src = p.mem + (size_t)row * 1024;
      f32x4 v[4]; float s = 0.f;
#pragma unroll
      for (int j = 0; j < 4; ++j) { v[j] = *(const f32x4*)(src + 4 * lane + 256 * j); s += v[j][0] + v[j][1] + v[j][2] + v[j][3]; }
#pragma unroll
      for (int o = 32; o >= 1; o >>= 1) s += __shfl_xor(s, o);
      const float mu = s * (1.f / 1024.f); float q = 0.f;
#pragma unroll
      for (int j = 0; j < 4; ++j) { v[j] -= mu; q += v[j][0] * v[j][0] + v[j][1] * v[j][1] + v[j][2] * v[j][2] + v[j][3] * v[j][3]; }
#pragma unroll
      for (int o = 32; o >= 1; o >>= 1) q += __shfl_xor(q, o);
      const float rs = rsqrtf(q * (1.f / 1024.f) + 1e-5f);
      bf16_t* dst = (bf16_t*)(p.ws + O_MEMN) + (size_t)row * 1024;
#pragma unroll
      for (int j = 0; j < 4; ++j) {
        const int c = 4 * lane + 256 * j;
        const f32x4 g = *(const f32x4*)(p.mem_g + c), b = *(const f32x4*)(p.mem_b + c);
        *(u32x2*)(dst + c) = pk4(v[j][0] * rs * g[0] + b[0], v[j][1] * rs * g[1] + b[1], v[j][2] * rs * g[2] + b[2], v[j][3] * rs * g[3] + b[3]);
      }
      continue;
    }
    i -= N_MEMN;
    {
      float* bp = (float*)(p.ws + O_BIASP);
      if (tid < 128) {
        const int n = i * 128 + tid;
        const int sc = inmap(n);
        for (int l = 0; l < 2; ++l) bp[l * NP + n] = sc >= 0 ? p.b_in[l * DIN + sc] : 0.f;
      }
    }
  }
}

template <class AL>
DI void gemm_kloop(const AL& al, const bf16_t* __restrict__ Bt, int ldb, int nkt, int m0, int n0, f32x16 (&acc)[2][2], bf16_t* As, bf16_t* Bs) {
  const int tid = otid(), lane = tid & 63, wave = tid >> 6, wr = wave >> 1, wc = wave & 1, r = lane & 31, h = lane >> 5;
  bf16x8 ra[4], rb[4];
  auto gload = [&](int kt) {
#pragma unroll
    for (int i = 0; i < 4; ++i) {
      const int cid = tid + 256 * i, row = cid >> 3, kc = (cid & 7) * 8;
      ra[i] = al(m0 + row, kt * 64 + kc);
      rb[i] = *(const bf16x8*)(Bt + (size_t)(n0 + row) * ldb + kt * 64 + kc);
    }
  };
  auto lstore = [&](int buf) {
#pragma unroll
    for (int i = 0; i < 4; ++i) {
      const int cid = tid + 256 * i, row = cid >> 3, kc = (cid & 7) * 8;
      *(bf16x8*)(As + buf * 9216 + row * 72 + kc) = ra[i];
      *(bf16x8*)(Bs + buf * 9216 + row * 72 + kc) = rb[i];
    }
  };
  gload(0); lstore(0); __syncthreads();
  for (int kt = 0; kt < nkt; ++kt) {
    const int buf = kt & 1;
    if (kt + 1 < nkt) gload(kt + 1);
    const bf16_t* a_ = As + buf * 9216 + (wr * 64 + r) * 72 + 8 * h;
    const bf16_t* b_ = Bs + buf * 9216 + (wc * 64 + r) * 72 + 8 * h;
#pragma unroll
    for (int s = 0; s < 4; ++s) {
      bf16x8 af[2], bfr[2];
      af[0] = *(const bf16x8*)(a_ + 16 * s); af[1] = *(const bf16x8*)(a_ + 32 * 72 + 16 * s);
      bfr[0] = *(const bf16x8*)(b_ + 16 * s); bfr[1] = *(const bf16x8*)(b_ + 32 * 72 + 16 * s);
#pragma unroll
      for (int mi = 0; mi < 2; ++mi)
#pragma unroll
        for (int ni = 0; ni < 2; ++ni) acc[mi][ni] = MFMA32(bfr[ni], af[mi], acc[mi][ni]);
    }
    if (kt + 1 < nkt) lstore(buf ^ 1);
    __syncthreads();
  }
}

DI void zero_acc(f32x16 (&acc)[2][2]) {
#pragma unroll
  for (int a = 0; a < 2; ++a)
#pragma unroll
    for (int b = 0; b < 2; ++b)
#pragma unroll
      for (int i = 0; i < 16; ++i) acc[a][b][i] = 0.f;
}

struct PlainA {
  const bf16_t* A; int lda;
  DI bf16x8 operator()(int row, int k) const { return *(const bf16x8*)(A + (size_t)row * lda + k); }
};

DI void p1_tile(const Params& p, int layer, int half, int mt, int nt, unsigned char* smem) {
  bf16_t* As = (bf16_t*)smem; bf16_t* Bs = As + 2 * 9216;
  f32x16 acc[2][2]; zero_acc(acc);
  PlainA al{(const bf16_t*)(p.ws + O_XB) + (size_t)half * TH * 1024, 1024};
  const int m0 = mt * 128, n0 = nt * 128;
  gemm_kloop(al, (const bf16_t*)(p.ws + O_WTIN + layer * SZ_WTIN1), 1024, 16, m0, n0, acc, As, Bs);
  const int tid = otid(), lane = tid & 63, wave = tid >> 6, wr = wave >> 1, wc = wave & 1, r = lane & 31, h = lane >> 5;
  const float* bias = (const float*)(p.ws + O_BIASP) + layer * NP;
  unsigned char* ws = p.ws;
#pragma unroll
  for (int ni = 0; ni < 2; ++ni) {
    const int nb = n0 + wc * 64 + ni * 32;
    int kind;
    int xf = 0;
    bf16_t* dst = nullptr; int pitch = 0, coff = 0;
    if (nb < C_AV) { kind = 0; dst = (bf16_t*)(ws + O_QKA); pitch = 768; coff = nb; }
    else if (nb < C_BQK) { kind = 1; dst = (bf16_t*)(ws + O_VTA); coff = nb - C_AV; }
    else if (nb < C_BV) { kind = 0; dst = (bf16_t*)(ws + O_QKB); pitch = 2304; coff = nb - C_BQK; }
    else if (nb < C_CQK) { kind = 2; dst = (bf16_t*)(ws + O_VTB); coff = nb - C_BV; }
    else if (nb < C_CV) { kind = 0; dst = (bf16_t*)(ws + O_QKC); pitch = 768; coff = nb - C_CQK; }
    else if (nb < C_D) { kind = 1; dst = (bf16_t*)(ws + O_VTC); coff = nb - C_CV; }
    else if (nb < C_E) { kind = 0; dst = (bf16_t*)(ws + O_QKVD); pitch = 1152; coff = nb - C_D; }
    else if (nb < C_SM) { kind = 0; dst = (bf16_t*)(ws + O_QE); pitch = 384; coff = nb - C_E; }
    else if (nb < C_Z) { kind = (nb == C_SM) ? 3 : 4; }
    else if (nb < C_MG) { kind = 0; xf = 1; dst = (bf16_t*)(ws + O_SZ); pitch = 1920; coff = nb - C_Z; }
    else { kind = 0; xf = 2; dst = (bf16_t*)(ws + O_SIG); pitch = 5120; coff = nb - C_MG; }
    if (kind == 4) continue;
#pragma unroll
    for (int mi = 0; mi < 2; ++mi) {
      const int tok = m0 + wr * 64 + mi * 32 + r;
#pragma unroll
      for (int g = 0; g < 4; ++g) {
        const int cq = 8 * g + 4 * h;
        const f32x4 bv = *(const f32x4*)(bias + nb + cq);
        float v[4];
#pragma unroll
        for (int e = 0; e < 4; ++e) v[e] = acc[mi][ni][4 * g + e] + bv[e];
        if (kind == 0) {
          if (xf == 1) {
#pragma unroll
            for (int e = 0; e < 4; ++e) v[e] = fsilu(v[e]);
          } else if (xf == 2) {
#pragma unroll
            for (int e = 0; e < 4; ++e) v[e] = fsigmoid(v[e]);
          }
          *(u32x2*)(dst + (size_t)tok * pitch + coff + cq) = pk4(v[0], v[1], v[2], v[3]);
        } else if (kind == 1) {
#pragma unroll
          for (int e = 0; e < 4; ++e) dst[(size_t)(coff + cq + e) * TH + tok] = f2bf(v[e]);
        } else if (kind == 2) {
          const int p4 = (tok & 3) * 2048 + (tok >> 2), p16 = (tok & 15) * 512 + (tok >> 4);
#pragma unroll
          for (int e = 0; e < 4; ++e) {
            const bf16_t b = f2bf(v[e]); const size_t ro = (size_t)(coff + cq + e) * TH;
            dst[ro + tok] = b; dst[SZ_VT / 2 + ro + p4] = b; dst[SZ_VT + ro + p16] = b;
          }
        } else {
          float* sm = (float*)(ws + O_SM);
#pragma unroll
          for (int e = 0; e < 4; ++e) if (cq + e < 18) sm[tok * 32 + cq + e] = v[e];
        }
      }
    }
  }
}

DI void fox_prep(const Params& p, int hh, unsigned char* smem) {
  float* red = (float*)smem;
  const int tid = otid();
  const float* sm = (const float*)(p.ws + O_SM);
  float* FF = (float*)(p.ws + O_FF) + hh * TH;
  const bf16_t* qkc = (const bf16_t*)(p.ws + O_QKC);
  float s = 0.f, kmx = 0.f;
  for (int j = 0; j < 32; ++j) {
    const int t = tid * 32 + j;
    const float xv = sm[t * 32 + hh];
    const float ls = fminf(xv, 0.f) - log1pf(expf(-fabsf(xv)));
    s += ls; FF[t] = s;
    float kk = 0.f;
#pragma unroll
    for (int c = 0; c < 8; ++c) { float v[8]; unpk8(*(const bf16x8*)(qkc + (size_t)t * 768 + 384 + hh * 64 + c * 8), v);
#pragma unroll
      for (int e = 0; e < 8; ++e) kk += v[e] * v[e]; }
    kmx = fmaxf(kmx, kk);
  }
  red[tid] = s; red[256 + tid] = kmx;
  __syncthreads();
  if (tid == 0) {
    float run = 0.f, mx = 0.f;
    for (int i = 0; i < 256; ++i) { const float t = red[i]; red[i] = run; run += t; mx = fmaxf(mx, red[256 + i]); }
    ((float*)(p.ws + O_KMAX))[hh] = mx;
  }
  __syncthreads();
  const float off = red[tid];
  for (int j = 0; j < 32; ++j) FF[tid * 32 + j] += off;
  __syncthreads();
}

DI void kmean_prep(const Params& p, int idx) {
  const int lane = otid() & 63;
  const int hh = idx / 32, blk = idx % 32;
  const bf16_t* k = (const bf16_t*)(p.ws + O_QKA) + (size_t)(blk * 256) * 768 + 384 + hh * 64 + lane;
  float s = 0.f;
#pragma unroll 8
  for (int i = 0; i < 256; ++i) s += bf2f(k[(size_t)i * 768]);
  s *= (1.f / 256.f);
  const bf16_t hi = f2bf(s);
  bf16_t* km = (bf16_t*)(p.ws + O_KM);
  km[(hh * 32 + blk) * 64 + lane] = hi;
  km[6 * 32 * 64 + (hh * 32 + blk) * 64 + lane] = f2bf(s - bf2f(hi));
}

DI void memkv_tile(const Params& p, int layer, int half, int mt, int nt, unsigned char* smem) {
  bf16_t* As = (bf16_t*)smem; bf16_t* Bs = As + 2 * 9216;
  f32x16 acc[2][2]; zero_acc(acc);
  PlainA al{(const bf16_t*)(p.ws + O_MEMN) + (size_t)half * 256 * 1024, 1024};
  const int m0 = mt * 128, n0 = nt * 128;
  gemm_kloop(al, (const bf16_t*)(p.ws + O_WTKV + layer * SZ_WTKV1), 1024, 16, m0, n0, acc, As, Bs);
  const int tid = otid(), lane = tid & 63, wave = tid >> 6, wr = wave >> 1, wc = wave & 1, r = lane & 31, h = lane >> 5;
  bf16_t* mk = (bf16_t*)(p.ws + O_MEMK); bf16_t* mv = (bf16_t*)(p.ws + O_MEMVT);
#pragma unroll
  for (int ni = 0; ni < 2; ++ni)
#pragma unroll
    for (int mi = 0; mi < 2; ++mi) {
      const int m = m0 + wr * 64 + mi * 32 + r;
#pragma unroll
      for (int i = 0; i < 16; ++i) {
        const int col = n0 + wc * 64 + ni * 32 + crow(i, h);
        const bf16_t b = f2bf(acc[mi][ni][i]);
        if (col < 384) mk[(size_t)(half * 256 + m) * 384 + col] = b;
        else { const int cc = col - 384, hd = cc / 96, d = cc % 96; mv[(size_t)((half * 4 + hd) * 96 + d) * 256 + m] = b; }
      }
    }
}

DI f32x16 mm_quad(const bf16_t* A, const bf16_t* B, int wr, int wc, int r, int h) {
  f32x16 acc;
#pragma unroll
  for (int i = 0; i < 16; ++i) acc[i] = 0.f;
  const bf16_t* a_ = A + (wr * 32 + r) * 72 + 8 * h;
  const bf16_t* b_ = B + (wc * 32 + r) * 72 + 8 * h;
#pragma unroll
  for (int s = 0; s < 4; ++s) acc = MFMA32(*(const bf16x8*)(a_ + 16 * s), *(const bf16x8*)(b_ + 16 * s), acc);
  return acc;
}

DI void gdn_prep(const Params& p, int layer, int half, int hh, int c, unsigned char* smem) {
  bf16_t* QN = (bf16_t*)smem; bf16_t* KN = QN + 4608; bf16_t* KB = KN + 4608; bf16_t* KDT = KB + 4608; bf16_t* VBT = KDT + 4608;
  bf16_t* KBET = VBT + 4608; bf16_t* QKm = KBET + 4608; bf16_t* Tm = QKm + 4608;
  float* gcv = (float*)(smem + 73728); float* betav = gcv + 64; float* egc = gcv + 128;
  float* Mf = (float*)(smem + 9216);
  bf16_t* UT = KN; bf16_t* WT = KB;
  int tid = otid();
  int lane = tid & 63, wave = tid >> 6, wr = wave >> 1, wc = wave & 1, r = lane & 31, h = lane >> 5;
#define REOPAQUE() do { asm volatile("" : "+v"(tid)); lane = tid & 63; wave = tid >> 6; wr = wave >> 1; wc = wave & 1; r = lane & 31; h = lane >> 5; } while (0)
  const float* sm = (const float*)(p.ws + O_SM);
  if (wave == 0) {
    const int tok = c * 64 + lane;
    const float bt = fsigmoid(sm[tok * 32 + 6 + hh]);
    const float xv = sm[tok * 32 + 12 + hh] + p.dt_bias[layer * 6 + hh];
    const float sp = fmaxf(xv, 0.f) + log1pf(expf(-fabsf(xv)));
    float g = -expf(p.a_log[layer * 6 + hh]) * sp;
#pragma unroll
    for (int o = 1; o < 64; o <<= 1) { const float t = __shfl_up(g, o); if (lane >= o) g += t; }
    gcv[lane] = g; betav[lane] = bt; egc[lane] = expf(g);
    if (lane == 63) ((float*)(p.ws + O_GL))[hh * 128 + c] = expf(g);
  }
  __syncthreads();
  REOPAQUE();
  {
    const int t = tid >> 2, cg4 = tid & 3, ch0 = cg4 * 16;
    const bf16_t* src = (const bf16_t*)(p.ws + O_QKVD);
    const float* cw = p.conv_w + (size_t)layer * 4 * 1152;
    const float bt = betav[t], gct = gcv[t], eg = egc[t], ed = expf(gcv[63] - gct);
    auto convpart = [&](int pt, float (&val)[16]) {
      const int col = pt * 384 + hh * 64 + ch0;
#pragma unroll
      for (int e = 0; e < 16; ++e) val[e] = 0.f;
#pragma unroll
      for (int j = 0; j < 4; ++j) {
        const int row = c * 64 + t - 3 + j;
        if (row >= 0) {
          float xv[16];
          unpk8(*(const bf16x8*)(src + (size_t)row * 1152 + col), xv);
          unpk8(*(const bf16x8*)(src + (size_t)row * 1152 + col + 8), xv + 8);
#pragma unroll
          for (int e4 = 0; e4 < 4; ++e4) {
            const f32x4 w4 = *(const f32x4*)(cw + j * 1152 + col + 4 * e4);
#pragma unroll
            for (int e = 0; e < 4; ++e) val[4 * e4 + e] += w4[e] * xv[4 * e4 + e];
          }
        }
      }
#pragma unroll
      for (int e = 0; e < 16; ++e) val[e] = fsilu(val[e]);
    };
    {
      float val[16]; convpart(0, val);
      float sq = 0.f;
#pragma unroll
      for (int e = 0; e < 16; ++e) sq += val[e] * val[e];
      sq += __shfl_xor(sq, 1); sq += __shfl_xor(sq, 2);
      const float rq = rsqrtf(sq + 1e-6f) * 0.125f;
#pragma unroll
      for (int e = 0; e < 16; ++e) val[e] *= rq;
      *(bf16x8*)(QN + t * 72 + ch0) = pk8(val); *(bf16x8*)(QN + t * 72 + ch0 + 8) = pk8(val + 8);
    }
    asm volatile("" ::: "memory");
    {
      float val[16]; convpart(1, val);
      float sk = 0.f;
#pragma unroll
      for (int e = 0; e < 16; ++e) sk += val[e] * val[e];
      sk += __shfl_xor(sk, 1); sk += __shfl_xor(sk, 2);
      const float rk = rsqrtf(sk + 1e-6f);
      float kb[16];
#pragma unroll
      for (int e = 0; e < 16; ++e) { val[e] *= rk; kb[e] = val[e] * bt; }
      *(bf16x8*)(KN + t * 72 + ch0) = pk8(val); *(bf16x8*)(KN + t * 72 + ch0 + 8) = pk8(val + 8);
      *(bf16x8*)(KB + t * 72 + ch0) = pk8(kb); *(bf16x8*)(KB + t * 72 + ch0 + 8) = pk8(kb + 8);
#pragma unroll
      for (int e = 0; e < 16; ++e) {
        KDT[(ch0 + e) * 72 + t] = f2bf(val[e] * ed);
        KBET[(ch0 + e) * 72 + t] = f2bf(kb[e] * eg);
      }
    }
    asm volatile("" ::: "memory");
    {
      float val[16]; convpart(2, val);
#pragma unroll
      for (int e = 0; e < 16; ++e) VBT[(ch0 + e) * 72 + t] = f2bf(val[e] * bt);
    }
  }
  __syncthreads();
  REOPAQUE();
  {
    const f32x16 kk = mm_quad(KB, KN, wr, wc, r, h);
    const f32x16 qk = mm_quad(QN, KN, wr, wc, r, h);
    __syncthreads();
    const int j = wc * 32 + r; const float gj = gcv[j];
#pragma unroll
    for (int i = 0; i < 16; ++i) {
      const int row = wr * 32 + crow(i, h);
      const float dec = (row >= j) ? expf(gcv[row] - gj) : 0.f;
      Mf[row * 68 + j] = (row > j) ? kk[i] * dec : 0.f;
      QKm[row * 72 + j] = f2bf(qk[i] * dec);
    }
  }
  __syncthreads();
  REOPAQUE();
  if (wave == 0) {
    float t[64];
#pragma unroll
    for (int i = 0; i < 64; ++i) {
      float a = (i == lane) ? 1.f : 0.f;
#pragma unroll
      for (int j4 = 0; j4 < (i + 3) / 4; ++j4) {
        const f32x4 mrow = *(const f32x4*)(Mf + i * 68 + 4 * j4);
#pragma unroll
        for (int e = 0; e < 4; ++e) if (4 * j4 + e < i) a -= mrow[e] * t[4 * j4 + e];
      }
      t[i] = a;
      Tm[i * 72 + lane] = f2bf(a);
      asm volatile("" ::: "memory");
    }
  }
  __syncthreads();
  REOPAQUE();
  {
    const f32x16 u = mm_quad(Tm, VBT, wr, wc, r, h);
    const f32x16 w = mm_quad(Tm, KBET, wr, wc, r, h);
    const int col = wc * 32 + r;
#pragma unroll
    for (int g = 0; g < 4; ++g) {
      const int i0 = wr * 32 + 8 * g + 4 * h;
      *(u32x2*)(UT + col * 72 + i0) = pk4(u[4 * g], u[4 * g + 1], u[4 * g + 2], u[4 * g + 3]);
      *(u32x2*)(WT + col * 72 + i0) = pk4(w[4 * g], w[4 * g + 1], w[4 * g + 2], w[4 * g + 3]);
    }
  }
  __syncthreads();
  REOPAQUE();
  {
    bf16_t* base = (bf16_t*)(p.ws + O_DPREP + (size_t)(hh * 128 + c) * 32768);
    const int n = wc * 32 + r;
    {
      const int ks = n >> 5, jh = (n >> 4) & 1, q = (n >> 2) & 3, jl = n & 3, jj = 4 * jh + jl;
      const int cbase = (ks * 64 + 16 * q) * 8 + jj;
      {
        const f32x16 P = mm_quad(KDT, WT, wr, wc, r, h);
#pragma unroll
        for (int i = 0; i < 16; ++i) {
          const int m = wr * 32 + crow(i, h);
          base[((m >> 4) * 128 + (m & 15)) * 8 + cbase] = f2bf(P[i]);
        }
      }
      asm volatile("" ::: "memory");
      {
        const f32x16 QW = mm_quad(QKm, WT, wr, wc, r, h);
#pragma unroll
        for (int i = 0; i < 16; ++i) {
          const int m = wr * 32 + crow(i, h);
          const float qd = bf2f(QN[m * 72 + n]) * egc[m];
          base[4096 + ((m >> 4) * 128 + (m & 15)) * 8 + cbase] = f2bf(qd - QW[i]);
        }
      }
      asm volatile("" ::: "memory");
    }
    const int jsl = n >> 4;
    {
      const f32x16 Bc = mm_quad(KDT, UT, wr, wc, r, h);
#pragma unroll
      for (int g = 0; g < 4; ++g) {
        const int row0 = wr * 32 + 8 * g + 4 * h;
        const int rt = row0 >> 4, lp = 16 * ((row0 >> 2) & 3) + (n & 15);
        *(u32x2*)(base + 8192 + ((jsl * 4 + rt) * 64 + lp) * 4) = pk4(Bc[4 * g], Bc[4 * g + 1], Bc[4 * g + 2], Bc[4 * g + 3]);
      }
    }
    asm volatile("" ::: "memory");
    {
      const f32x16 O0 = mm_quad(QKm, UT, wr, wc, r, h);
#pragma unroll
      for (int g = 0; g < 4; ++g) {
        const int row0 = wr * 32 + 8 * g + 4 * h;
        const int rt = row0 >> 4, lp = 16 * ((row0 >> 2) & 3) + (n & 15);
        *(u32x2*)(base + 12288 + ((jsl * 4 + rt) * 64 + lp) * 4) = pk4(O0[4 * g], O0[4 * g + 1], O0[4 * g + 2], O0[4 * g + 3]);
      }
    }
  }
  __syncthreads();
#undef REOPAQUE
}

struct TileDesc { const bf16_t* k; const bf16_t* v; const float* aux; int tag; };

template <int DHT, bool AUX>
struct TileRegs { bf16x8 k[DHT / 16]; s16x4 v[DHT / 32][2][2]; f32x4 a[4]; };

template <int DHT, bool AUX>
DI void load_tile(const bf16_t* kp, const bf16_t* vp, const float* ap, long ldv, TileRegs<DHT, AUX>& t) {
#pragma unroll
  for (int s = 0; s < DHT / 16; ++s) t.k[s] = *(const bf16x8*)(kp + 16 * s);
#pragma unroll
  for (int dt = 0; dt < DHT / 32; ++dt)
#pragma unroll
    for (int s = 0; s < 2; ++s)
#pragma unroll
      for (int q = 0; q < 2; ++q) t.v[dt][s][q] = *(const s16x4*)(vp + (long)dt * 32 * ldv + 16 * s + 8 * q);
  if (AUX) {
#pragma unroll
    for (int g = 0; g < 4; ++g) t.a[g] = *(const f32x4*)(ap + 8 * g);
  }
}

template <int DHT, bool AUX, class TF, class MF, class SF>
DI void attn_loop(int maxtiles, TF&& tf, MF&& mf, SF&& stopf, const bf16x8 (&qf)[DHT / 16], long ldv, float scale2,
                  f32x16 (&o)[DHT / 32], float& m, float& l) {
  TileRegs<DHT, AUX> cur, nxt;
  int tagc, tagn;
  { const bf16_t* kp; const bf16_t* vp; const float* ap = nullptr; tagc = tf(0, kp, vp, ap); load_tile<DHT, AUX>(kp, vp, ap, ldv, cur); }
  for (int t = 0; t < maxtiles; ++t) {
    { const bf16_t* kp; const bf16_t* vp; const float* ap = nullptr; tagn = tf(t + 1, kp, vp, ap); load_tile<DHT, AUX>(kp, vp, ap, ldv, nxt); }
    f32x16 sacc;
#pragma unroll
    for (int i = 0; i < 16; ++i) sacc[i] = 0.f;
#pragma unroll
    for (int s = 0; s < DHT / 16; ++s) sacc = MFMA32(cur.k[s], qf[s], sacc);
    float sv[16]; float mx = NEG_INF;
#pragma unroll
    for (int i = 0; i < 16; ++i) { sv[i] = sacc[i] * scale2 + mf(tagc, i, AUX ? cur.a[i >> 2][i & 3] : 0.f); mx = fmaxf(mx, sv[i]); }
    mx = fmaxf(mx, __shfl_xor(mx, 32));
    const float mnew = fmaxf(m, mx);
    const float alpha = exp2f(m - mnew);
    m = mnew;
    float pv[16]; float ps = 0.f;
#pragma unroll
    for (int i = 0; i < 16; ++i) { pv[i] = exp2f(sv[i] - mnew); ps += pv[i]; }
    l = l * alpha + ps;
#pragma unroll
    for (int dt = 0; dt < DHT / 32; ++dt)
#pragma unroll
      for (int i = 0; i < 16; ++i) o[dt][i] *= alpha;
    bf16x8 pf[2]; pf[0] = pk8(pv); pf[1] = pk8(pv + 8);
#pragma unroll
    for (int dt = 0; dt < DHT / 32; ++dt)
#pragma unroll
      for (int s = 0; s < 2; ++s) {
        const bf16x8 vf = __builtin_shufflevector(cur.v[dt][s][0], cur.v[dt][s][1], 0, 1, 2, 3, 4, 5, 6, 7);
        o[dt] = MFMA32(vf, pf[s], o[dt]);
      }
    if (stopf(t, m, AUX ? cur.a[0][0] : 0.f)) break;
    cur = nxt; tagc = tagn;
  }
}

template <int DHT>
DI void attn_store(const f32x16 (&o)[DHT / 32], float l, bf16_t* dstrow, int h, float& ltot_out) {
  const float ltot = l + __shfl_xor(l, 32);
  ltot_out = ltot;
  const float inv = 1.f / ltot;
#pragma unroll
  for (int dt = 0; dt < DHT / 32; ++dt)
#pragma unroll
    for (int g = 0; g < 4; ++g)
      *(u32x2*)(dstrow + dt * 32 + 8 * g + 4 * h) = pk4(o[dt][4 * g] * inv, o[dt][4 * g + 1] * inv, o[dt][4 * g + 2] * inv, o[dt][4 * g + 3] * inv);
}

template <int N>
DI void zero_o(f32x16 (&o)[N]) {
#pragma unroll
  for (int a = 0; a < N; ++a)
#pragma unroll
    for (int i = 0; i < 16; ++i) o[a][i] = 0.f;
}

DI void top3_insert(float v, int n, float& v0, float& v1, float& v2, int& i0, int& i1, int& i2) {
  const bool g0 = v > v0, g1 = v > v1, g2 = v > v2;
  v2 = g1 ? v1 : (g2 ? v : v2); i2 = g1 ? i1 : (g2 ? n : i2);
  v1 = g0 ? v0 : (g1 ? v : v1); i1 = g0 ? i0 : (g1 ? n : i1);
  v0 = g0 ? v : v0;             i0 = g0 ? n : i0;
}

DI void moba_item(const Params& p, int a) {
  const int lane = otid() & 63, r = lane & 31, h = lane >> 5;
  const int qtile = 255 - a / 6, hh = a % 6, qb = qtile >> 3, own = qtile & 7;
  const bf16_t* QK = (const bf16_t*)(p.ws + O_QKA);
  const bf16_t* VT = (const bf16_t*)(p.ws + O_VTA);
  bf16x8 qf[4];
  { const bf16_t* qrow = QK + (size_t)(qtile * 32 + r) * 768 + hh * 64 + 8 * h;
#pragma unroll
    for (int s = 0; s < 4; ++s) qf[s] = *(const bf16x8*)(qrow + 16 * s); }
  unsigned mask = 0;
  if (qb > 0) {
    const bf16_t* kmh = (const bf16_t*)(p.ws + O_KM) + (hh * 32 + r) * 64 + 8 * h;
    const bf16_t* kml = kmh + 6 * 32 * 64;
    f32x16 g;
#pragma unroll
    for (int i = 0; i < 16; ++i) g[i] = 0.f;
#pragma unroll
    for (int s = 0; s < 4; ++s) { g = MFMA32(*(const bf16x8*)(kmh + 16 * s), qf[s], g); g = MFMA32(*(const bf16x8*)(kml + 16 * s), qf[s], g); }
    float v0 = NEG_INF, v1 = NEG_INF, v2 = NEG_INF; int i0 = -1, i1 = -1, i2 = -1;
#pragma unroll
    for (int i = 0; i < 16; ++i) { const int n = crow(i, h); if (n < qb) top3_insert(g[i], n, v0, v1, v2, i0, i1, i2); }
    const float pv0 = __shfl_xor(v0, 32), pv1 = __shfl_xor(v1, 32), pv2 = __shfl_xor(v2, 32);
    const int pi0 = __shfl_xor(i0, 32), pi1 = __shfl_xor(i1, 32), pi2 = __shfl_xor(i2, 32);
    if (pi0 >= 0) top3_insert(pv0, pi0, v0, v1, v2, i0, i1, i2);
    if (pi1 >= 0) top3_insert(pv1, pi1, v0, v1, v2, i0, i1, i2);
    if (pi2 >= 0) top3_insert(pv2, pi2, v0, v1, v2, i0, i1, i2);
    if (i0 >= 0) mask |= 1u << i0;
    if (i1 >= 0) mask |= 1u << i1;
    if (i2 >= 0) mask |= 1u << i2;
  }
  unsigned um = mask;
#pragma unroll
  for (int o = 16; o >= 1; o >>= 1) um |= (unsigned)__shfl_xor((int)um, o);
  um = (unsigned)__builtin_amdgcn_readfirstlane((int)um);
  const int ntiles = 8 * __builtin_popcount(um) + own + 1;
  unsigned rem = um; int cn = rem ? __builtin_ctz(rem) : -1; int kt = 0;
  auto tf = [&](int, const bf16_t*& kp, const bf16_t*& vp, const float*&) -> int {
    int keybase, tag;
    if (cn >= 0) { keybase = cn * 256 + kt * 32; tag = cn; if (++kt == 8) { kt = 0; rem &= rem - 1; cn = rem ? __builtin_ctz(rem) : -1; } }
    else { const int kk = kt < own ? kt : own; keybase = qb * 256 + kk * 32; tag = (kk == own) ? 101 : 100; ++kt; }
    kp = QK + (size_t)(keybase + r) * 768 + 384 + hh * 64 + 8 * h;
    vp = VT + (size_t)(hh * 64 + r) * TH + keybase + 4 * h;
    return tag;
  };
  auto mf = [&](int tag, int i, float) -> float {
    if (tag < 100) return ((mask >> tag) & 1u) ? 0.f : NEG_INF;
    if (tag == 100) return 0.f;
    return (crow(i, h) <= r) ? 0.f : NEG_INF;
  };
  auto sf = [&](int, float, float) { return false; };
  f32x16 o[2]; zero_o(o); float m = -1e30f, l = 0.f;
  attn_loop<64, false>(ntiles, tf, mf, sf, qf, (long)TH, 0.125f * LOG2E, o, m, l);
  float lt;
  attn_store<64>(o, l, (bf16_t*)(p.ws + O_OA) + (size_t)(qtile * 32 + r) * 384 + hh * 64, h, lt);
}

DI void fox_item(const Params& p, int c) {
  const int lane = otid() & 63, r = lane & 31, h = lane >> 5;
  const int qtile = 255 - c / 6, hh = c % 6;
  const bf16_t* QK = (const bf16_t*)(p.ws + O_QKC);
  const bf16_t* VT = (const bf16_t*)(p.ws + O_VTC);
  const float* FF = (const float*)(p.ws + O_FF) + hh * TH;
  bf16x8 qf[4]; float qn2 = 0.f;
  { const bf16_t* qrow = QK + (size_t)(qtile * 32 + r) * 768 + hh * 64 + 8 * h;
#pragma unroll
    for (int s = 0; s < 4; ++s) { qf[s] = *(const bf16x8*)(qrow + 16 * s); float v[8]; unpk8(qf[s], v);
#pragma unroll
      for (int e = 0; e < 8; ++e) qn2 += v[e] * v[e]; } }
  qn2 += __shfl_xor(qn2, 32);
#pragma unroll
  for (int o = 16; o >= 1; o >>= 1) qn2 = fmaxf(qn2, __shfl_xor(qn2, o));
  const float Fq = FF[qtile * 32 + r];
  const float Ffirst = FF[qtile * 32];
  const float kmaxn = sqrtf(((const float*)(p.ws + O_KMAX))[hh]);
  const float bound = sqrtf(qn2) * kmaxn * 0.125f + Ffirst;
  auto tf = [&](int t, const bf16_t*& kp, const bf16_t*& vp, const float*& ap) -> int {
    const int keybase = (qtile - t > 0 ? qtile - t : 0) * 32;
    kp = QK + (size_t)(keybase + r) * 768 + 384 + hh * 64 + 8 * h;
    vp = VT + (size_t)(hh * 64 + r) * TH + keybase + 4 * h;
    ap = FF + keybase + 4 * h;
    return (t == 0) ? 1 : 0;
  };
  auto mf = [&](int tag, int i, float fk) -> float {
    const float b = (Fq - fk) * LOG2E;
    return (tag == 1 && crow(i, h) > r) ? NEG_INF : b;
  };
  auto sf = [&](int, float m, float a0) {
    const float fkb = __builtin_bit_cast(float, __builtin_amdgcn_readfirstlane(__builtin_bit_cast(int, a0)));
    float mm = m;
#pragma unroll
    for (int o = 16; o >= 1; o >>= 1) mm = fminf(mm, __shfl_xor(mm, o));
    return (bound - fkb) * LOG2E < mm - 45.f;
  };
  f32x16 o[2]; zero_o(o); float m = -1e30f, l = 0.f;
  attn_loop<64, true>(qtile + 1, tf, mf, sf, qf, (long)TH, 0.125f * LOG2E, o, m, l);
  float lt;
  attn_store<64>(o, l, (bf16_t*)(p.ws + O_OC) + (size_t)(qtile * 32 + r) * 384 + hh * 64, h, lt);
}

DI void dil_item(const Params& p, int idx) {
  const int lane = otid() & 63, r = lane & 31, h = lane >> 5;
  const int g = idx / 1536, rem = idx % 1536, hh = rem / 256, w = rem % 256;
  const int dsh = 2 * g;
  const int dil = 1 << dsh, L = TH >> dsh, tps = L / 32;
  const int rs = w / tps, lt_ = w % tps, l0 = lt_ * 32;
  const bf16_t* QK = (const bf16_t*)(p.ws + O_QKB);
  const bf16_t* VT = (const bf16_t*)(p.ws + O_VTB + g * SZ_VT);
  const int tq = (l0 + r) * dil + rs;
  bf16x8 qf[4];
  { const bf16_t* qrow = QK + (size_t)tq * 2304 + g * 384 + hh * 64 + 8 * h;
#pragma unroll
    for (int s = 0; s < 4; ++s) qf[s] = *(const bf16x8*)(qrow + 16 * s); }
  const int t0 = (l0 >= 128) ? 0 : (128 - l0) / 32;
  auto tf = [&](int tt, const bf16_t*& kp, const bf16_t*& vp, const float*&) -> int {
    const int t = (t0 + tt < 4) ? t0 + tt : 4; const int keybase = l0 - 128 + 32 * t;
    kp = QK + (size_t)((keybase + r) * dil + rs) * 2304 + 1152 + g * 384 + hh * 64 + 8 * h;
    vp = VT + (size_t)(hh * 64 + r) * TH + rs * L + keybase + 4 * h;
    return t;
  };
  auto mf = [&](int tag, int i, float) -> float {
    const int kj = crow(i, h);
    if (tag == 0) return (kj >= r) ? 0.f : NEG_INF;
    if (tag == 4) return (kj <= r) ? 0.f : NEG_INF;
    return 0.f;
  };
  auto sf = [&](int, float, float) { return false; };
  f32x16 o[2]; zero_o(o); float m = -1e30f, l = 0.f;
  attn_loop<64, false>(5 - t0, tf, mf, sf, qf, (long)TH, 0.125f * LOG2E, o, m, l);
  float lt;
  attn_store<64>(o, l, (bf16_t*)(p.ws + O_OB + g * SZ_O) + (size_t)tq * 384 + hh * 64, h, lt);
  if (h == 0) { float* st = (float*)(p.ws + O_STB) + ((size_t)(g * TH + tq) * 6 + hh) * 2; st[0] = m; st[1] = lt; }
}

DI void mem_item(const Params& p, int half, int e) {
  const int lane = otid() & 63, r = lane & 31, h = lane >> 5;
  const int hd = e & 3, qtile = e >> 2;
  const bf16_t* QE = (const bf16_t*)(p.ws + O_QE);
  const bf16_t* MK = (const bf16_t*)(p.ws + O_MEMK);
  const bf16_t* MV = (const bf16_t*)(p.ws + O_MEMVT);
  bf16x8 qf[6];
  { const bf16_t* qrow = QE + (size_t)(qtile * 32 + r) * 384 + hd * 96 + 8 * h;
#pragma unroll
    for (int s = 0; s < 6; ++s) qf[s] = *(const bf16x8*)(qrow + 16 * s); }
  auto tf = [&](int t, const bf16_t*& kp, const bf16_t*& vp, const float*&) -> int {
    const int keybase = 32 * (t < 7 ? t : 7);
    kp = MK + (size_t)(half * 256 + keybase + r) * 384 + hd * 96 + 8 * h;
    vp = MV + (size_t)((half * 4 + hd) * 96 + r) * 256 + keybase + 4 * h;
    return 0;
  };
  auto mf = [&](int, int, float) -> float { return 0.f; };
  auto sf = [&](int, float, float) { return false; };
  f32x16 o[3]; zero_o(o); float m = -1e30f, l = 0.f;
  attn_loop<96, false>(8, tf, mf, sf, qf, 256L, 0.10206207261596577f * LOG2E, o, m, l);
  float lt;
  attn_store<96>(o, l, (bf16_t*)(p.ws + O_OE) + (size_t)(qtile * 32 + r) * 384 + hd * 96, h, lt);
}

DI float dpp_ror(float v, int ctrl);
DI float row16_sum(float v) {
  v += __builtin_bit_cast(float, __builtin_amdgcn_update_dpp(0, __builtin_bit_cast(int, v), 0x128, 0xf, 0xf, false));
  v += __builtin_bit_cast(float, __builtin_amdgcn_update_dpp(0, __builtin_bit_cast(int, v), 0x124, 0xf, 0xf, false));
  v += __builtin_bit_cast(float, __builtin_amdgcn_update_dpp(0, __builtin_bit_cast(int, v), 0x122, 0xf, 0xf, false));
  v += __builtin_bit_cast(float, __builtin_amdgcn_update_dpp(0, __builtin_bit_cast(int, v), 0x121, 0xf, 0xf, false));
  return v;
}

struct ScanRegs { bf16x8 pf[4][2]; bf16x8 qe[4][2]; s16x4 bc[4]; s16x4 o0[4]; float gl; };
DI void scan_load(const Params& p, int hh, int j, int c, int lane, ScanRegs& s) {
  const unsigned char* base = p.ws + O_DPREP + (size_t)(hh * 128 + c) * 32768;
#pragma unroll
  for (int mt = 0; mt < 4; ++mt)
#pragma unroll
    for (int ks = 0; ks < 2; ++ks) {
      s.pf[mt][ks] = *(const bf16x8*)(base + ((mt * 2 + ks) * 64 + lane) * 16);
      s.qe[mt][ks] = *(const bf16x8*)(base + 8192 + ((mt * 2 + ks) * 64 + lane) * 16);
    }
#pragma unroll
  for (int rt = 0; rt < 4; ++rt) {
    s.bc[rt] = *(const s16x4*)(base + 16384 + ((j * 4 + rt) * 64 + lane) * 8);
    s.o0[rt] = *(const s16x4*)(base + 24576 + ((j * 4 + rt) * 64 + lane) * 8);
  }
  s.gl = ((const float*)(p.ws + O_GL))[hh * 128 + c];
}
DI f32x4 s4f(s16x4 v) { u32x2 u = __builtin_bit_cast(u32x2, v); f32x4 r; r[0] = bflo(u.x); r[1] = bfhi(u.x); r[2] = bflo(u.y); r[3] = bfhi(u.y); return r; }

DI void scan_item(const Params& p, int it) {
  const int lane = otid() & 63, q = lane >> 4, cl = lane & 15;
  const int hh = it >> 2, j = it & 3;
  f32x4 S[4];
#pragma unroll
  for (int rt = 0; rt < 4; ++rt) S[rt] = (f32x4){0.f, 0.f, 0.f, 0.f};
  bf16_t* OD = (bf16_t*)(p.ws + O_OD);
  float* SSQ = (float*)(p.ws + O_SSQ);
  ScanRegs cur, nxt;
  scan_load(p, hh, j, 0, lane, cur);
  for (int c = 0; c < 128; ++c) {
    scan_load(p, hh, j, (c + 1 < 128) ? c + 1 : c, lane, nxt);
    bf16x8 bfr[2];
#pragma unroll
    for (int ks = 0; ks < 2; ++ks) {
      u32x4 u; u.x = pk2(S[2 * ks][0], S[2 * ks][1]); u.y = pk2(S[2 * ks][2], S[2 * ks][3]); u.z = pk2(S[2 * ks + 1][0], S[2 * ks + 1][1]); u.w = pk2(S[2 * ks + 1][2], S[2 * ks + 1][3]);
      bfr[ks] = __builtin_bit_cast(bf16x8, u);
    }
    f32x4 aP[4], aO[4];
#pragma unroll
    for (int rt = 0; rt < 4; ++rt) {
      aP[rt] = (f32x4){0.f, 0.f, 0.f, 0.f};
      aO[rt] = s4f(cur.o0[rt]);
#pragma unroll
      for (int ks = 0; ks < 2; ++ks) { aP[rt] = MFMA16(cur.pf[rt][ks], bfr[ks], aP[rt]); aO[rt] = MFMA16(cur.qe[rt][ks], bfr[ks], aO[rt]); }
    }
#pragma unroll
    for (int rt = 0; rt < 4; ++rt) S[rt] = S[rt] * cur.gl - aP[rt] + s4f(cur.bc[rt]);
#pragma unroll
    for (int rt = 0; rt < 4; ++rt)
#pragma unroll
      for (int e = 0; e < 4; ++e) {
        const int tok = c * 64 + 16 * rt + 4 * q + e;
        const float v = aO[rt][e];
        OD[(size_t)tok * 384 + hh * 64 + 16 * j + cl] = f2bf(v);
        const float ss = row16_sum(v * v);
        if (cl == 0) SSQ[(tok * 6 + hh) * 4 + j] = ss;
      }
    cur = nxt;
  }
}

DI void phase3(const Params& p, int half, unsigned* ctr) {
  const int lane = otid() & 63;
  constexpr int N_SCAN = 24, N_A = 1536, N_E = 1024, N_B = 4608, N_C = 1536, TOT = N_SCAN + N_A + N_E + N_B + N_C;
  for (;;) {
    int it = 0;
    if (lane == 0) it = (int)atomicAdd(ctr, 1u);
    it = __builtin_amdgcn_readfirstlane(it);
    if (it >= TOT) break;
    if (it < N_SCAN) { if (PH(5)) scan_item(p, it); continue; }
    it -= N_SCAN;
    if (it < N_A) { if (PH(6)) moba_item(p, it); continue; }
    it -= N_A;
    if (it < N_E) { if (PH(7)) mem_item(p, half, it); continue; }
    it -= N_E;
    if (it < N_B) { if (PH(8)) dil_item(p, it); continue; }
    it -= N_B;
    if (PH(9)) fox_item(p, it);
  }
}

DI void gbuild_chunk(const Params& p, int layer, int tok, int c8) {
  const unsigned char* ws = p.ws;
  const int n = c8 / 48, c = (c8 % 48) * 8;
  bf16_t* szp = (bf16_t*)(p.ws + O_SZ) + (size_t)tok * 1920 + n * 384 + c;
  float o[8], z[8];
  unpk8(*(const bf16x8*)szp, z);
  if (n == 1) {
    const int hh = c >> 6;
    const float* st = (const float*)(ws + O_STB);
    float mg[3], lg[3];
#pragma unroll
    for (int g = 0; g < 3; ++g) { const f32x2 s2 = *(const f32x2*)(st + ((size_t)(g * TH + tok) * 6 + hh) * 2); mg[g] = s2[0]; lg[g] = s2[1]; }
    const float mm = fmaxf(mg[0], fmaxf(mg[1], mg[2]));
    float wg[3], ws_ = 0.f;
#pragma unroll
    for (int g = 0; g < 3; ++g) { wg[g] = exp2f(mg[g] - mm) * lg[g]; ws_ += wg[g]; }
    const float inv = 1.f / ws_;
#pragma unroll
    for (int e = 0; e < 8; ++e) o[e] = 0.f;
#pragma unroll
    for (int g = 0; g < 3; ++g) {
      float t[8]; unpk8(*(const bf16x8*)((const bf16_t*)(ws + O_OB + g * SZ_O) + (size_t)tok * 384 + c), t);
      const float wgi = wg[g] * inv;
#pragma unroll
      for (int e = 0; e < 8; ++e) o[e] += wgi * t[e];
    }
  } else if (n == 3) {
    const int hh = c >> 6;
    const f32x4 sq = *(const f32x4*)((const float*)(ws + O_SSQ) + ((size_t)tok * 6 + hh) * 4);
    const float rs = rsqrtf((sq[0] + sq[1] + sq[2] + sq[3]) * (1.f / 64.f) + 1e-6f);
    unpk8(*(const bf16x8*)((const bf16_t*)(ws + O_OD) + (size_t)tok * 384 + c), o);
    const float* gw = p.gdn_w + layer * 64 + (c & 63);
#pragma unroll
    for (int e = 0; e < 8; ++e) o[e] *= rs * gw[e];
  } else {
    const size_t off = (n == 0) ? O_OA : (n == 2) ? O_OC : O_OE;
    unpk8(*(const bf16x8*)((const bf16_t*)(ws + off) + (size_t)tok * 384 + c), o);
  }
#pragma unroll
  for (int e = 0; e < 8; ++e) o[e] *= z[e];
  *(bf16x8*)szp = pk8(o);
}

DI void p4a_tile(const Params& p, int layer, int mt, int nt, unsigned char* smem) {
  bf16_t* As = (bf16_t*)smem; bf16_t* Bs = As + 2 * 9216;
  const int tid = otid(), lane = tid & 63, wave = tid >> 6, wr = wave >> 1, wc = wave & 1, r = lane & 31, h = lane >> 5;
  const int m0 = mt * 128, n0 = nt * 128;
  f32x16 tot[2][2]; zero_acc(tot);
  const bf16_t* SIG = (const bf16_t*)(p.ws + O_SIG);
  for (int n = 0; n < 5; ++n) {
    f32x16 acc[2][2]; zero_acc(acc);
    PlainA al{(const bf16_t*)(p.ws + O_SZ) + n * 384, 1920};
    gemm_kloop(al, (const bf16_t*)(p.ws + O_WTBR) + (size_t)(layer * 5 + n) * 1024 * 384, 384, 6, m0, n0, acc, As, Bs);
#pragma unroll
    for (int mi = 0; mi < 2; ++mi) {
      const int tok = m0 + wr * 64 + mi * 32 + r;
#pragma unroll
      for (int ni = 0; ni < 2; ++ni)
#pragma unroll
        for (int g = 0; g < 4; ++g) {
          const int col = n0 + wc * 64 + ni * 32 + 8 * g + 4 * h;
          const u32x2 sg = *(const u32x2*)(SIG + (size_t)tok * 5120 + n * 1024 + col);
          tot[mi][ni][4 * g] += bflo(sg.x) * acc[mi][ni][4 * g];
          tot[mi][ni][4 * g + 1] += bfhi(sg.x) * acc[mi][ni][4 * g + 1];
          tot[mi][ni][4 * g + 2] += bflo(sg.y) * acc[mi][ni][4 * g + 2];
          tot[mi][ni][4 * g + 3] += bfhi(sg.y) * acc[mi][ni][4 * g + 3];
        }
    }
  }
  bf16_t* YM = (bf16_t*)(p.ws + O_YM);
#pragma unroll
  for (int mi = 0; mi < 2; ++mi) {
    const int tok = m0 + wr * 64 + mi * 32 + r;
#pragma unroll
    for (int ni = 0; ni < 2; ++ni)
#pragma unroll
      for (int g = 0; g < 4; ++g) {
        const int col = n0 + wc * 64 + ni * 32 + 8 * g + 4 * h;
        *(u32x2*)(YM + (size_t)tok * 1024 + col) = pk4(tot[mi][ni][4 * g], tot[mi][ni][4 * g + 1], tot[mi][ni][4 * g + 2], tot[mi][ni][4 * g + 3]);
      }
  }
}

DI void p4b_tile(const Params& p, int layer, int half, int mt, int nt, unsigned char* smem) {
  bf16_t* As = (bf16_t*)smem; bf16_t* Bs = As + 2 * 9216;
  const int tid = otid(), lane = tid & 63, wave = tid >> 6, wr = wave >> 1, wc = wave & 1, r = lane & 31, h = lane >> 5;
  const int m0 = mt * 128, n0 = nt * 128;
  f32x16 acc[2][2]; zero_acc(acc);
  PlainA al{(const bf16_t*)(p.ws + O_YM), 1024};
  gemm_kloop(al, (const bf16_t*)(p.ws + O_WTOUT + layer * SZ_WTOUT1), 1024, 16, m0, n0, acc, As, Bs);
  const float* xin = layer == 0 ? p.x : p.out;
  const float alpha = 1.4142135623730951f;
#pragma unroll
  for (int mi = 0; mi < 2; ++mi) {
    const size_t gt = (size_t)half * TH + m0 + wr * 64 + mi * 32 + r;
#pragma unroll
    for (int ni = 0; ni < 2; ++ni)
#pragma unroll
      for (int g = 0; g < 4; ++g) {
        const int col = n0 + wc * 64 + ni * 32 + 8 * g + 4 * h;
        const f32x4 xv = *(const f32x4*)(xin + gt * 1024 + col);
        f32x4 o;
#pragma unroll
        for (int e = 0; e < 4; ++e) o[e] = alpha * xv[e] + acc[mi][ni][4 * g + e];
        *(f32x4*)(p.out + gt * 1024 + col) = o;
      }
  }
}

DI void p4c_row(const Params& p, int layer, size_t gt) {
  const int lane = otid() & 63;
  float* row = p.out + gt * 1024;
  f32x4 v[4]; float s = 0.f;
#pragma unroll
  for (int j = 0; j < 4; ++j) { v[j] = *(const f32x4*)(row + 4 * lane + 256 * j); s += v[j][0] + v[j][1] + v[j][2] + v[j][3]; }
#pragma unroll
  for (int o = 32; o >= 1; o >>= 1) s += __shfl_xor(s, o);
  const float mu = s * (1.f / 1024.f); float q = 0.f;
#pragma unroll
  for (int j = 0; j < 4; ++j) { v[j] -= mu; q += v[j][0] * v[j][0] + v[j][1] * v[j][1] + v[j][2] * v[j][2] + v[j][3] * v[j][3]; }
#pragma unroll
  for (int o = 32; o >= 1; o >>= 1) q += __shfl_xor(q, o);
  const float rs = rsqrtf(q * (1.f / 1024.f) + 1e-5f);
  bf16_t* xb = (bf16_t*)(p.ws + O_XB) + gt * 1024;
#pragma unroll
  for (int j = 0; j < 4; ++j) {
    const int c = 4 * lane + 256 * j;
    const f32x4 g = *(const f32x4*)(p.ln_g + layer * 1024 + c), b = *(const f32x4*)(p.ln_b + layer * 1024 + c);
    f32x4 y;
#pragma unroll
    for (int e = 0; e < 4; ++e) y[e] = v[j][e] * rs * g[e] + b[e];
    *(f32x4*)(row + c) = y;
    *(u32x2*)(xb + c) = pk4(y[0], y[1], y[2], y[3]);
  }
}

__global__ void __launch_bounds__(256, 2) mega(Params p) {
  extern __shared__ __attribute__((aligned(16))) unsigned char smem[];
  cg::grid_group grid = cg::this_grid();
  const int wave = otid() >> 6;
  const int gw = blockIdx.x * 4 + wave, ngw = gridDim.x * 4;
  if (PH(0)) phase0(p, smem);
  grid.sync();
  for (int layer = 0; layer < 2; ++layer)
    for (int half = 0; half < 2; ++half) {
      for (int t = blockIdx.x; t < 64 * 107; t += gridDim.x) { if (PH(1)) p1_tile(p, layer, half, t % 64, t / 64, smem); }
      grid.sync();
      {
        constexpr int N_FOX = 6, N_GDN = 768, N_MKV = 12, N_KM = 48, TOT = N_FOX + N_GDN + N_MKV + N_KM;
        for (int t = blockIdx.x; t < TOT; t += gridDim.x) {
          int i = t;
          if (i < N_FOX) { if (PH(2)) fox_prep(p, i, smem); continue; }
          i -= N_FOX;
          if (i < N_GDN) { if (PH(3)) gdn_prep(p, layer, half, i / 128, i % 128, smem); continue; }
          i -= N_GDN;
          if (i < N_MKV) { if (PH(4)) memkv_tile(p, layer, half, i / 6, i % 6, smem); continue; }
          i -= N_MKV;
          if (PH(4)) kmean_prep(p, i * 4 + wave);
        }
      }
      grid.sync();
      phase3(p, half, (unsigned*)(p.ws + O_CTL) + layer * 2 + half);
      grid.sync();
      if (PH(13)) for (int ci = blockIdx.x * 256 + otid(); ci < TH * 240; ci += gridDim.x * 256) gbuild_chunk(p, layer, ci / 240, ci % 240);
      grid.sync();
      for (int t = blockIdx.x; t < 512; t += gridDim.x) { if (PH(10)) p4a_tile(p, layer, t % 64, t / 64, smem); }
      grid.sync();
      for (int t = blockIdx.x; t < 512; t += gridDim.x) { if (PH(11)) p4b_tile(p, layer, half, t % 64, t / 64, smem); }
      grid.sync();
      for (int rw = gw; rw < TH; rw += ngw) { if (PH(12)) p4c_row(p, layer, (size_t)half * TH + rw); }
      grid.sync();
    }
}

extern "C" void kernel_launch(void* const* d_in, const int* in_sizes, int n_in, void* d_out, int out_size, void* d_ws, size_t ws_size,
                              hipStream_t stream) {
  static int grid_blocks = 0;
  if (grid_blocks == 0) {
    if (ws_size < WS_END) { fprintf(stderr, "workspace too small: %zu < %zu\n", ws_size, (size_t)WS_END); grid_blocks = -1; return; }
    int dev = 0, cus = 0, per_cu = 0;
    (void)hipGetDevice(&dev);
    (void)hipDeviceGetAttribute(&cus, hipDeviceAttributeMultiprocessorCount, dev);
    (void)hipFuncSetAttribute((const void*)mega, hipFuncAttributeMaxDynamicSharedMemorySize, LDS_BYTES);
    (void)hipOccupancyMaxActiveBlocksPerMultiprocessor(&per_cu, (const void*)mega, 256, LDS_BYTES);
    if (per_cu < 1) per_cu = 1;
    if (per_cu > 2) per_cu = 2;
    grid_blocks = cus * per_cu;
  }
  if (grid_blocks < 0) return;
  (void)hipMemsetAsync((char*)d_ws + O_CTL, 0, 4096, stream);
  Params p{};
  p.x = (const float*)d_in[0]; p.mem = (const float*)d_in[1]; p.mem_g = (const float*)d_in[2]; p.mem_b = (const float*)d_in[3];
  p.w_in = (const float*)d_in[4]; p.b_in = (const float*)d_in[5]; p.conv_w = (const float*)d_in[6]; p.a_log = (const float*)d_in[7];
  p.dt_bias = (const float*)d_in[8]; p.gdn_w = (const float*)d_in[9]; p.w_kv = (const float*)d_in[10]; p.w_br = (const float*)d_in[11];
  p.w_out = (const float*)d_in[12]; p.ln_g = (const float*)d_in[13]; p.ln_b = (const float*)d_in[14];
  p.out = (float*)d_out; p.ws = (unsigned char*)d_ws;
  void* args[] = {&p};
  hipError_t e = hipLaunchCooperativeKernel((const void*)mega, dim3(grid_blocks), dim3(256), args, LDS_BYTES, stream);
  if (e != hipSuccess) fprintf(stderr, "cooperative launch failed: %s (grid %d)\n", hipGetErrorString(e), grid_blocks);
}
```

```cpp
#include <hip/hip_runtime.h>
#include <hip/hip_cooperative_groups.h>
#include <cstdio>
#include <cstdint>
namespace cg = cooperative_groups;

#define DI __device__ __forceinline__
typedef unsigned short bf16_t;
typedef short bf16x8 __attribute__((ext_vector_type(8)));
typedef short s16x4 __attribute__((ext_vector_type(4)));
typedef float f32x4 __attribute__((ext_vector_type(4)));
typedef float f32x2 __attribute__((ext_vector_type(2)));
typedef float f32x16 __attribute__((ext_vector_type(16)));
typedef unsigned u32x2 __attribute__((ext_vector_type(2)));
typedef unsigned u32x4 __attribute__((ext_vector_type(4)));
typedef __bf16 bfv2 __attribute__((ext_vector_type(2)));

#define MFMA32(a, b, c) __builtin_amdgcn_mfma_f32_32x32x16_bf16((a), (b), (c), 0, 0, 0)
#define MFMA16(a, b, c) __builtin_amdgcn_mfma_f32_16x16x32_bf16((a), (b), (c), 0, 0, 0)

DI unsigned pk2(float a, float b) { f32x2 v = {a, b}; return __builtin_bit_cast(unsigned, __builtin_convertvector(v, bfv2)); }
DI bf16_t f2bf(float a) { return (bf16_t)(pk2(a, 0.f) & 0xffffu); }
DI float bf2f(bf16_t v) { return __uint_as_float(((unsigned)v) << 16); }
DI float bflo(unsigned u) { return __uint_as_float(u << 16); }
DI float bfhi(unsigned u) { return __uint_as_float(u & 0xffff0000u); }
DI int otid() { int t = __builtin_amdgcn_workitem_id_x(); asm volatile("" : "+v"(t)); return t; }
DI int crow(int i, int h) { return (i & 3) + 8 * (i >> 2) + 4 * h; }
DI float fsigmoid(float v) { return __builtin_amdgcn_rcpf(1.f + __expf(-v)); }
DI float fsilu(float v) { return v * fsigmoid(v); }
DI u32x2 pk4(float a, float b, float c, float d) { u32x2 r; r.x = pk2(a, b); r.y = pk2(c, d); return r; }
DI bf16x8 pk8(const float* v) { u32x4 r; r.x = pk2(v[0], v[1]); r.y = pk2(v[2], v[3]); r.z = pk2(v[4], v[5]); r.w = pk2(v[6], v[7]); return __builtin_bit_cast(bf16x8, r); }
DI void unpk8(bf16x8 x, float* v) { u32x4 u = __builtin_bit_cast(u32x4, x); v[0] = bflo(u.x); v[1] = bfhi(u.x); v[2] = bflo(u.y); v[3] = bfhi(u.y); v[4] = bflo(u.z); v[5] = bfhi(u.z); v[6] = bflo(u.w); v[7] = bfhi(u.w); }

constexpr int NB = 2, SQ = 8192, NT = NB * SQ, DM = 1024, NH = 6, BW = 384;
constexpr int TH = 8192;
constexpr int NP = 13696;
constexpr int DIN = 13586;
constexpr float LOG2E = 1.4426950408889634f;
#define NEG_INF (-__builtin_inff())

constexpr int C_AQK = 0, C_AV = 768, C_BQK = 1152, C_BV = 3456, C_CQK = 3840, C_CV = 4608, C_D = 4992, C_E = 6144, C_SM = 6528, C_SMEND = 6546, C_Z = 6656, C_MG = 8576;

__host__ __device__ constexpr int inmap(int n) {
  return n < 4992 ? n : n < 6144 ? n + 6 : n < 6528 ? n + 18 : n < 6534 ? n - 1536 : n < 6546 ? n - 384 : n < 6656 ? -1 : n - 110;
}

constexpr size_t O_CTL = 0;
constexpr size_t O_BAR = 4096;
constexpr size_t O_WTIN = 32768;
constexpr size_t SZ_WTIN1 = (size_t)NP * 1024 * 2;
constexpr size_t O_WTBR = O_WTIN + 2 * SZ_WTIN1;
constexpr size_t SZ_WTBR1 = (size_t)5 * 1024 * 384 * 2;
constexpr size_t O_WTOUT = O_WTBR + 2 * SZ_WTBR1;
constexpr size_t SZ_WTOUT1 = (size_t)1024 * 1024 * 2;
constexpr size_t O_WTKV = O_WTOUT + 2 * SZ_WTOUT1;
constexpr size_t SZ_WTKV1 = (size_t)768 * 1024 * 2;
constexpr size_t O_BIASP = O_WTKV + 2 * SZ_WTKV1;
constexpr size_t O_XB = O_BIASP + (size_t)2 * NP * 4;
constexpr size_t O_MEMN = O_XB + (size_t)NT * 1024 * 2;
constexpr size_t O_MEMK = O_MEMN + (size_t)512 * 1024 * 2;
constexpr size_t O_MEMVT = O_MEMK + (size_t)512 * 384 * 2;
constexpr size_t O_QKA = O_MEMVT + (size_t)512 * 384 * 2;
constexpr size_t SZ_VT = (size_t)384 * TH * 2;
constexpr size_t O_KFA = O_QKA + SZ_VT;
constexpr size_t O_VTA = O_KFA + SZ_VT;
constexpr size_t O_QKB = O_VTA + SZ_VT;
constexpr size_t O_KFB = O_QKB + 3 * SZ_VT;
constexpr size_t O_VTB = O_KFB + 3 * SZ_VT;
constexpr size_t O_QKC = O_VTB + 3 * SZ_VT;
constexpr size_t O_KFC = O_QKC + SZ_VT;
constexpr size_t O_VTC = O_KFC + SZ_VT;
constexpr size_t O_QKVD = O_VTC + SZ_VT;
constexpr size_t O_QE = O_QKVD + (size_t)TH * 1152 * 2;
constexpr size_t O_SM = O_QE + (size_t)TH * 384 * 2;
constexpr size_t O_FF = O_SM + (size_t)TH * 32 * 4;
constexpr size_t O_KM = O_FF + (size_t)6 * TH * 4;
constexpr size_t O_KMAX = O_KM + (size_t)2 * 6 * 32 * 64 * 2;
constexpr size_t O_GL = O_KMAX + 256;
constexpr size_t O_MASK = O_GL + 6 * 128 * 4;
constexpr size_t O_DPREP = O_MASK + (size_t)TH * 8 * 4;
constexpr size_t O_SZ = O_DPREP + (size_t)768 * 32768;
constexpr size_t O_SIG = O_SZ + (size_t)TH * 1920 * 2;
constexpr size_t O_OA = O_SIG + (size_t)TH * 5120 * 2;
constexpr size_t SZ_O = (size_t)TH * 384 * 2;
constexpr size_t O_STA = O_OA + 4 * SZ_O;
constexpr size_t O_OB = O_STA + (size_t)4 * TH * 6 * 2 * 4;
constexpr size_t O_STB = O_OB + 3 * SZ_O;
constexpr size_t O_OC = O_STB + (size_t)3 * TH * 6 * 2 * 4;
constexpr size_t O_OD = O_OC + SZ_O;
constexpr size_t O_SSQ = O_OD + SZ_O;
constexpr size_t O_OE = O_SSQ + (size_t)TH * 6 * 4 * 4;
constexpr size_t WS_END = O_OE + SZ_O;
constexpr size_t O_YM = O_QKB;
static_assert(WS_END < (size_t)443 * 1000 * 1000, "workspace too large");

struct Params {
  const float *x, *mem, *mem_g, *mem_b, *w_in, *b_in, *conv_w, *a_log, *dt_bias, *gdn_w, *w_kv, *w_br, *w_out, *ln_g, *ln_b;
  float* out;
  unsigned char* ws;
};

constexpr int LDS_BYTES = 75776 + 16;
#ifndef PH_MASK
#define PH_MASK 0xFFFF
#endif
#define PH(x) ((PH_MASK >> (x)) & 1)
#ifndef REP_MASK
#define REP_MASK 0
#endif
#define REP(x) (1 + ((REP_MASK >> (x)) & 1))

DI void transpose_tile(const float* __restrict__ src, int ld, int k0, int n0, bool usemap, bf16_t* __restrict__ dst, int dstld, float* tile) {
  const int tid = otid();
#pragma unroll
  for (int it = 0; it < 16; ++it) {
    const int kk = (tid >> 6) + 4 * it, n2 = (tid & 63) * 2;
    const int sc = usemap ? inmap(n0 + n2) : (n0 + n2);
    f32x2 v = {0.f, 0.f};
    if (sc >= 0) v = *(const f32x2*)(src + (size_t)(k0 + kk) * ld + sc);
    *(f32x2*)(tile + kk * 130 + n2) = v;
  }
  __syncthreads();
#pragma unroll
  for (int it = 0; it < 4; ++it) {
    const int nn = (tid >> 3) + 32 * it, kc = (tid & 7) * 8;
    float v[8];
#pragma unroll
    for (int e = 0; e < 8; ++e) v[e] = tile[(kc + e) * 130 + nn];
    *(bf16x8*)(dst + (size_t)(n0 + nn) * dstld + k0 + kc) = pk8(v);
  }
  __syncthreads();
}

DI void phase0(const Params& p, unsigned char* smem) {
  float* tile = (float*)smem;
  const int tid = otid(), lane = tid & 63, wave = tid >> 6;
  constexpr int N_TIN = 2 * 107 * 16, N_TBR = 2 * 5 * 8 * 6, N_TOUT = 2 * 8 * 16, N_TKV = 2 * 6 * 16, N_XB = 1024, N_MEMN = 128, N_BIAS = 107;
  constexpr int TOT = N_TIN + N_TBR + N_TOUT + N_TKV + N_XB + N_MEMN + N_BIAS;
  for (int it = blockIdx.x; it < TOT; it += gridDim.x) {
    int i = it;
    if (i < N_TIN) {
      const int l = i / (107 * 16), rr = i % (107 * 16), nt = rr / 16, kt = rr % 16;
      transpose_tile(p.w_in + (size_t)l * 1024 * DIN, DIN, kt * 64, nt * 128, true, (bf16_t*)(p.ws + O_WTIN + l * SZ_WTIN1), 1024, tile);
      continue;
    }
    i -= N_TIN;
    if (i < N_TBR) {
      const int ln = i / 48, rr = i % 48, nt = rr / 6, kt = rr % 6;
      transpose_tile(p.w_br + (size_t)ln * 384 * 1024, 1024, kt * 64, nt * 128, false, (bf16_t*)(p.ws + O_WTBR) + (size_t)ln * 1024 * 384, 384, tile);
      continue;
    }
    i -= N_TBR;
    if (i < N_TOUT) {
      const int l = i / 128, rr = i % 128, nt = rr / 16, kt = rr % 16;
      transpose_tile(p.w_out + (size_t)l * 1024 * 1024, 1024, kt * 64, nt * 128, false, (bf16_t*)(p.ws + O_WTOUT + l * SZ_WTOUT1), 1024, tile);
      continue;
    }
    i -= N_TOUT;
    if (i < N_TKV) {
      const int l = i / 96, rr = i % 96, nt = rr / 16, kt = rr % 16;
      transpose_tile(p.w_kv + (size_t)l * 1024 * 768, 768, kt * 64, nt * 128, false, (bf16_t*)(p.ws + O_WTKV + l * SZ_WTKV1), 1024, tile);
      continue;
    }
    i -= N_TKV;
    if (i < N_XB) {
      const float* src = p.x + (size_t)i * 16 * 1024;
      bf16_t* dst = (bf16_t*)(p.ws + O_XB) + (size_t)i * 16 * 1024;
#pragma unroll
      for (int j = 0; j < 16; ++j) {
        const int e = (j * 256 + tid) * 4;
        const f32x4 v = *(const f32x4*)(src + e);
        *(u32x2*)(dst + e) = pk4(v[0], v[1], v[2], v[3]);
      }
      continue;
    }
    i -= N_XB;
    if (i < N_MEMN) {
      const int row = i * 4 + wave;
      const float* src = p.mem + (size_t)row * 1024;
      f32x4 v[4]; float s = 0.f;
#pragma unroll
      for (int j = 0; j < 4; ++j) { v[j] = *(const f32x4*)(src + 4 * lane + 256 * j); s += v[j][0] + v[j][1] + v[j][2] + v[j][3]; }
#pragma unroll
      for (int o = 32; o >= 1; o >>= 1) s += __shfl_xor(s, o);
      const float mu = s * (1.f / 1024.f); float q = 0.f;
#pragma unroll
      for (int j = 0; j < 4; ++j) { v[j] -= mu; q += v[j][0] * v[j][0] + v[j][1] * v[j][1] + v[j][2] * v[j][2] + v[j][3] * v[j][3]; }
#pragma unroll
      for (int o = 32; o >= 1; o >>= 1) q += __shfl_xor(q, o);
      const float rs = rsqrtf(q * (1.f / 1024.f) + 1e-5f);
      bf16_t* dst = (bf16_t*)(p.ws + O_MEMN) + (size_t)row * 1024;
#pragma unroll
      for (int j = 0; j < 4; ++j) {
        const int c = 4 * lane + 256 * j;
        const f32x4 g = *(const f32x4*)(p.mem_g + c), b = *(const f32x4*)(p.mem_b + c);
        *(u32x2*)(dst + c) = pk4(v[j][0] * rs * g[0] + b[0], v[j][1] * rs * g[1] + b[1], v[j][2] * rs * g[2] + b[2], v[j][3] * rs * g[3] + b[3]);
      }
      continue;
    }
    i -= N_MEMN;
    {
      float* bp = (float*)(p.ws + O_BIASP);
      if (tid < 128) {
        const int n = i * 128 + tid;
        const int sc = inmap(n);
        for (int l = 0; l < 2; ++l) bp[l * NP + n] = sc >= 0 ? p.b_in[l * DIN + sc] : 0.f;
      }
    }
  }
}

template <int BK, class AL>
DI void gemm_kloop_t(const AL& al, const bf16_t* __restrict__ Bt, int ldb, int nkt, int m0, int n0, f32x16 (&acc)[2][2], bf16_t* As, bf16_t* Bs) {
  constexpr int CPR = BK / 8, NCH = BK / 16, PITCH = BK + 8, BUF = 128 * PITCH;
  const int tid = otid(), lane = tid & 63, wave = tid >> 6, wr = wave >> 1, wc = wave & 1, r = lane & 31, h = lane >> 5;
  bf16x8 ra[NCH], rb[NCH];
  auto gload = [&](int kt) {
#pragma unroll
    for (int i = 0; i < NCH; ++i) {
      const int cid = tid + 256 * i, row = cid / CPR, kc = (cid % CPR) * 8;
      ra[i] = al(m0 + row, kt * BK + kc);
      rb[i] = *(const bf16x8*)(Bt + (size_t)(n0 + row) * ldb + kt * BK + kc);
    }
  };
  auto lstore = [&](int buf) {
#pragma unroll
    for (int i = 0; i < NCH; ++i) {
      const int cid = tid + 256 * i, row = cid / CPR, kc = (cid % CPR) * 8;
      *(bf16x8*)(As + buf * BUF + row * PITCH + kc) = ra[i];
      *(bf16x8*)(Bs + buf * BUF + row * PITCH + kc) = rb[i];
    }
  };
  gload(0); lstore(0); __syncthreads();
  for (int kt = 0; kt < nkt; ++kt) {
    const int buf = kt & 1;
    if (kt + 1 < nkt) gload(kt + 1);
    asm volatile("" ::: "memory");
    const bf16_t* a_ = As + buf * BUF + (wr * 64 + r) * PITCH + 8 * h;
    const bf16_t* b_ = Bs + buf * BUF + (wc * 64 + r) * PITCH + 8 * h;
#pragma unroll
    for (int s = 0; s < BK / 16; ++s) {
      bf16x8 af[2], bfr[2];
      af[0] = *(const bf16x8*)(a_ + 16 * s); af[1] = *(const bf16x8*)(a_ + 32 * PITCH + 16 * s);
      bfr[0] = *(const bf16x8*)(b_ + 16 * s); bfr[1] = *(const bf16x8*)(b_ + 32 * PITCH + 16 * s);
#pragma unroll
      for (int mi = 0; mi < 2; ++mi)
#pragma unroll
        for (int ni = 0; ni < 2; ++ni) acc[mi][ni] = MFMA32(bfr[ni], af[mi], acc[mi][ni]);
    }
    if (kt + 1 < nkt) lstore(buf ^ 1);
    __syncthreads();
  }
}
template <class AL>
DI void gemm_kloop(const AL& al, const bf16_t* __restrict__ Bt, int ldb, int nkt, int m0, int n0, f32x16 (&acc)[2][2], bf16_t* As, bf16_t* Bs) {
  gemm_kloop_t<64>(al, Bt, ldb, nkt, m0, n0, acc, As, Bs);
}

DI void zero_acc(f32x16 (&acc)[2][2]) {
#pragma unroll
  for (int a = 0; a < 2; ++a)
#pragma unroll
    for (int b = 0; b < 2; ++b)
#pragma unroll
      for (int i = 0; i < 16; ++i) acc[a][b][i] = 0.f;
}

DI int vfrag_key(int key) { const int kk = key & 31; return (key >> 5) * 2048 + (kk >> 4) * 512 + ((kk >> 3) & 1) * 256 + ((kk >> 2) & 1) * 128 + (kk & 3); }
DI int vfrag_col(int cw) { const int d = cw & 63; return (cw >> 6) * 524288 + (d >> 5) * 1024 + (d & 31) * 4; }

DI int kfrag_key(int key) { return (key >> 5) * 2048 + (key & 31) * 8; }
DI int kfrag_col(int cw) { const int d = cw & 63; return (cw >> 6) * 524288 + (d >> 4) * 512 + ((d >> 3) & 1) * 256 + (d & 7); }

struct PlainA {
  const bf16_t* A; int lda;
  DI bf16x8 operator()(int row, int k) const { return *(const bf16x8*)(A + (size_t)row * lda + k); }
};

DI void p1_tile(const Params& p, int layer, int half, int mt, int nt, unsigned char* smem) {
  __syncthreads();
  bf16_t* As = (bf16_t*)smem; bf16_t* Bs = As + 2 * 9216;
  f32x16 acc[2][2]; zero_acc(acc);
  PlainA al{(const bf16_t*)(p.ws + O_XB) + (size_t)half * TH * 1024, 1024};
  const int m0 = mt * 128, n0 = nt * 128;
  gemm_kloop(al, (const bf16_t*)(p.ws + O_WTIN + layer * SZ_WTIN1), 1024, 16, m0, n0, acc, As, Bs);
  const int tid = otid(), lane = tid & 63, wave = tid >> 6, wr = wave >> 1, wc = wave & 1, r = lane & 31, h = lane >> 5;
  const float* bias = (const float*)(p.ws + O_BIASP) + layer * NP;
  unsigned char* ws = p.ws;
  {
    const int nb0 = n0 + wc * 64;
    bf16_t* dst0 = nullptr; int pitch0 = 0, coff0 = 0, xf0 = 0;
    if (nb0 < 384) { dst0 = (bf16_t*)(ws + O_QKA); pitch0 = 384; coff0 = nb0; }
    else if (nb0 >= C_BQK && nb0 < 2304) { dst0 = (bf16_t*)(ws + O_QKB); pitch0 = 1152; coff0 = nb0 - C_BQK; }
    else if (nb0 >= C_CQK && nb0 < 4224) { dst0 = (bf16_t*)(ws + O_QKC); pitch0 = 384; coff0 = nb0 - C_CQK; }
    else if (nb0 >= C_D && nb0 < C_E) { dst0 = (bf16_t*)(ws + O_QKVD); pitch0 = 1152; coff0 = nb0 - C_D; }
    else if (nb0 >= C_E && nb0 < C_SM) { dst0 = (bf16_t*)(ws + O_QE); pitch0 = 384; coff0 = nb0 - C_E; }
    else if (nb0 >= C_Z && nb0 < C_MG) { dst0 = (bf16_t*)(ws + O_SZ); pitch0 = 1920; coff0 = nb0 - C_Z; xf0 = 1; }
    else if (nb0 >= C_MG) { dst0 = (bf16_t*)(ws + O_SIG); pitch0 = 5120; coff0 = nb0 - C_MG; xf0 = 2; }
    if (dst0 != nullptr) {
      bf16_t* stg = (bf16_t*)smem + wave * (64 * 72);
#pragma unroll
      for (int ni = 0; ni < 2; ++ni)
#pragma unroll
        for (int mi = 0; mi < 2; ++mi)
#pragma unroll
          for (int g = 0; g < 4; ++g) {
            const int cq = ni * 32 + 8 * g + 4 * h;
            const f32x4 bv = *(const f32x4*)(bias + nb0 + cq);
            float v[4];
#pragma unroll
            for (int e = 0; e < 4; ++e) v[e] = acc[mi][ni][4 * g + e] + bv[e];
            if (xf0 == 1) {
#pragma unroll
              for (int e = 0; e < 4; ++e) v[e] = fsilu(v[e]);
            } else if (xf0 == 2) {
#pragma unroll
              for (int e = 0; e < 4; ++e) v[e] = fsigmoid(v[e]);
            }
            *(u32x2*)(stg + (mi * 32 + r) * 72 + cq) = pk4(v[0], v[1], v[2], v[3]);
          }
      asm volatile("s_waitcnt lgkmcnt(0)" ::: "memory");
      __builtin_amdgcn_wave_barrier();
      const int tok0 = m0 + wr * 64;
#pragma unroll
      for (int it = 0; it < 8; ++it) {
        const int row = it * 8 + (lane >> 3), ch = (lane & 7) * 8;
        const bf16x8 val = *(const bf16x8*)(stg + row * 72 + ch);
        *(bf16x8*)(dst0 + (size_t)(tok0 + row) * pitch0 + coff0 + ch) = val;
      }
      return;
    }
  }
  {
    const int nb0 = n0 + wc * 64;
    bf16_t* dstv = nullptr; int cv = 0; bool isB = false;
    if (nb0 >= C_AV && nb0 < C_BQK) { dstv = (bf16_t*)(ws + O_VTA); cv = nb0 - C_AV; }
    else if (nb0 >= C_BV && nb0 < C_CQK) { dstv = (bf16_t*)(ws + O_VTB); cv = nb0 - C_BV; isB = true; }
    else if (nb0 >= C_CV && nb0 < C_D) { dstv = (bf16_t*)(ws + O_VTC); cv = nb0 - C_CV; }
    if (dstv != nullptr) {
      bf16_t* stg = (bf16_t*)smem + wave * (64 * 72);
#pragma unroll
      for (int ni = 0; ni < 2; ++ni)
#pragma unroll
        for (int mi = 0; mi < 2; ++mi)
#pragma unroll
          for (int g = 0; g < 4; ++g) {
            const int cq = ni * 32 + 8 * g + 4 * h;
            const f32x4 bv = *(const f32x4*)(bias + nb0 + cq);
#pragma unroll
            for (int e = 0; e < 4; ++e) stg[(cq + e) * 72 + mi * 32 + r] = f2bf(acc[mi][ni][4 * g + e] + bv[e]);
          }
      asm volatile("s_waitcnt lgkmcnt(0)" ::: "memory");
      __builtin_amdgcn_wave_barrier();
      bf16_t* base = dstv + (size_t)(cv >> 6) * 524288 + (size_t)((m0 + wr * 64) >> 5) * 2048 + lane * 4;
#pragma unroll
      for (int i = 0; i < 16; ++i) {
        const int T = i >> 3, dt = (i >> 2) & 1, sq = i & 3;
        const u32x2 val = *(const u32x2*)(stg + (dt * 32 + r) * 72 + T * 32 + 8 * sq + 4 * h);
        *(u32x2*)(base + T * 2048 + dt * 1024 + sq * 256) = val;
      }
      if (!isB) return;
    }
  }
#pragma unroll
  for (int ni = 0; ni < 2; ++ni) {
    const int nb = n0 + wc * 64 + ni * 32;
    int kind;
    int xf = 0;
    bf16_t* dst = nullptr; int pitch = 0, coff = 0;
    int kgrp = 0;
    if (nb < 384) { kind = 0; dst = (bf16_t*)(ws + O_QKA); pitch = 384; coff = nb; }
    else if (nb < C_AV) { kind = 5; dst = (bf16_t*)(ws + O_KFA); coff = nb - 384; }
    else if (nb < C_BQK) { kind = 1; dst = (bf16_t*)(ws + O_VTA); coff = nb - C_AV; }
    else if (nb < 2304) { kind = 0; dst = (bf16_t*)(ws + O_QKB); pitch = 1152; coff = nb - C_BQK; }
    else if (nb < C_BV) { kind = 5; kgrp = (nb - 2304) / 384; dst = (bf16_t*)(ws + O_KFB + kgrp * SZ_VT); coff = (nb - 2304) - kgrp * 384; }
    else if (nb < C_CQK) { kind = 2; dst = (bf16_t*)(ws + O_VTB); coff = nb - C_BV; }
    else if (nb < 4224) { kind = 0; dst = (bf16_t*)(ws + O_QKC); pitch = 384; coff = nb - C_CQK; }
    else if (nb < C_CV) { kind = 5; dst = (bf16_t*)(ws + O_KFC); coff = nb - 4224; }
    else if (nb < C_D) { kind = 1; dst = (bf16_t*)(ws + O_VTC); coff = nb - C_CV; }
    else if (nb < C_E) { kind = 0; dst = (bf16_t*)(ws + O_QKVD); pitch = 1152; coff = nb - C_D; }
    else if (nb < C_SM) { kind = 0; dst = (bf16_t*)(ws + O_QE); pitch = 384; coff = nb - C_E; }
    else if (nb < C_Z) { kind = (nb == C_SM) ? 3 : 4; }
    else if (nb < C_MG) { kind = 0; xf = 1; dst = (bf16_t*)(ws + O_SZ); pitch = 1920; coff = nb - C_Z; }
    else { kind = 0; xf = 2; dst = (bf16_t*)(ws + O_SIG); pitch = 5120; coff = nb - C_MG; }
    if (kind == 4) continue;
#pragma unroll
    for (int mi = 0; mi < 2; ++mi) {
      const int tok = m0 + wr * 64 + mi * 32 + r;
#pragma unroll
      for (int g = 0; g < 4; ++g) {
        const int cq = 8 * g + 4 * h;
        const f32x4 bv = *(const f32x4*)(bias + nb + cq);
        float v[4];
#pragma unroll
        for (int e = 0; e < 4; ++e) v[e] = acc[mi][ni][4 * g + e] + bv[e];
        if (kind == 0) {
          if (xf == 1) {
#pragma unroll
            for (int e = 0; e < 4; ++e) v[e] = fsilu(v[e]);
          } else if (xf == 2) {
#pragma unroll
            for (int e = 0; e < 4; ++e) v[e] = fsigmoid(v[e]);
          }
          *(u32x2*)(dst + (size_t)tok * pitch + coff + cq) = pk4(v[0], v[1], v[2], v[3]);
        } else if (kind == 5) {
          const int key = kgrp == 0 ? tok : kgrp == 1 ? (tok & 3) * 2048 + (tok >> 2) : (tok & 15) * 512 + (tok >> 4);
          *(u32x2*)(dst + kfrag_col(coff + cq) + kfrag_key(key)) = pk4(v[0], v[1], v[2], v[3]);
        } else if (kind == 1) {
          const int ko = vfrag_key(tok);
#pragma unroll
          for (int e = 0; e < 4; ++e) dst[vfrag_col(coff + cq + e) + ko] = f2bf(v[e]);
        } else if (kind == 2) {
          const int k1 = vfrag_key(tok), k4 = vfrag_key((tok & 3) * 2048 + (tok >> 2)), k16 = vfrag_key((tok & 15) * 512 + (tok >> 4));
#pragma unroll
          for (int e = 0; e < 4; ++e) {
            const bf16_t b = f2bf(v[e]); const int co = vfrag_col(coff + cq + e);
            dst[SZ_VT / 2 + co + k4] = b; dst[SZ_VT + co + k16] = b;
          }
        } else {
          float* sm = (float*)(ws + O_SM);
#pragma unroll
          for (int e = 0; e < 4; ++e) if (cq + e < 18) sm[tok * 32 + cq + e] = v[e];
        }
      }
    }
  }
}

DI void fox_prep(const Params& p, int hh, unsigned char* smem) {
  float* red = (float*)smem;
  const int tid = otid(), lane = tid & 63, wave = tid >> 6;
  const float* sm = (const float*)(p.ws + O_SM);
  float* FF = (float*)(p.ws + O_FF) + hh * TH;
  float loc[32];
#pragma unroll
  for (int j = 0; j < 32; ++j) loc[j] = sm[(tid * 32 + j) * 32 + hh];
  float s = 0.f;
#pragma unroll
  for (int j = 0; j < 32; ++j) { const float xv = loc[j]; s += fminf(xv, 0.f) - log1pf(expf(-fabsf(xv))); loc[j] = s; }
  float inc = s;
#pragma unroll
  for (int o = 1; o < 64; o <<= 1) { const float t = __shfl_up(inc, o); if (lane >= o) inc += t; }
  if (lane == 63) red[wave] = inc;
  __syncthreads();
  float off = inc - s;
  for (int w = 0; w < wave; ++w) off += red[w];
#pragma unroll
  for (int j4 = 0; j4 < 8; ++j4) {
    f32x4 o4 = {off + loc[4 * j4], off + loc[4 * j4 + 1], off + loc[4 * j4 + 2], off + loc[4 * j4 + 3]};
    *(f32x4*)(FF + tid * 32 + 4 * j4) = o4;
  }
  __syncthreads();
}

DI void kmean_prep(const Params& p, int idx, unsigned* kmaxu) {
  const int lane = otid() & 63;
  const int hh = idx / 32, blk = idx % 32;
  const bf16_t* k = (const bf16_t*)(p.ws + O_KFA) + kfrag_col(hh * 64 + lane) + blk * 8 * 2048;
  float s = 0.f;
#pragma unroll 8
  for (int i = 0; i < 256; ++i) s += bf2f(k[(i >> 5) * 2048 + (i & 31) * 8]);
  s *= (1.f / 256.f);
  const bf16_t hi = f2bf(s);
  bf16_t* km = (bf16_t*)(p.ws + O_KM);
  km[(hh * 32 + blk) * 64 + lane] = hi;
  km[6 * 32 * 64 + (hh * 32 + blk) * 64 + lane] = f2bf(s - bf2f(hi));
  const bf16_t* kc = (const bf16_t*)(p.ws + O_KFC) + (size_t)hh * 524288;
  float mx = 0.f;
#pragma unroll
  for (int t = 0; t < 4; ++t) {
    const int key = blk * 256 + lane * 4 + t;
    float kk = 0.f;
#pragma unroll
    for (int c = 0; c < 8; ++c) { float v[8]; unpk8(*(const bf16x8*)(kc + kfrag_key(key) + c * 256), v);
#pragma unroll
      for (int e = 0; e < 8; ++e) kk += v[e] * v[e]; }
    mx = fmaxf(mx, kk);
  }
#pragma unroll
  for (int o = 32; o >= 1; o >>= 1) mx = fmaxf(mx, __shfl_xor(mx, o));
  if (lane == 0) atomicMax(kmaxu + hh, __float_as_uint(mx));
}

DI void memkv_tile(const Params& p, int layer, int half, int mt, int nt, unsigned char* smem) {
  bf16_t* As = (bf16_t*)smem; bf16_t* Bs = As + 2 * 9216;
  f32x16 acc[2][2]; zero_acc(acc);
  PlainA al{(const bf16_t*)(p.ws + O_MEMN) + (size_t)half * 256 * 1024, 1024};
  const int m0 = mt * 128, n0 = nt * 128;
  gemm_kloop(al, (const bf16_t*)(p.ws + O_WTKV + layer * SZ_WTKV1), 1024, 16, m0, n0, acc, As, Bs);
  const int tid = otid(), lane = tid & 63, wave = tid >> 6, wr = wave >> 1, wc = wave & 1, r = lane & 31, h = lane >> 5;
  bf16_t* mk = (bf16_t*)(p.ws + O_MEMK); bf16_t* mv = (bf16_t*)(p.ws + O_MEMVT);
#pragma unroll
  for (int ni = 0; ni < 2; ++ni)
#pragma unroll
    for (int mi = 0; mi < 2; ++mi) {
      const int m = m0 + wr * 64 + mi * 32 + r;
#pragma unroll
      for (int i = 0; i < 16; ++i) {
        const int col = n0 + wc * 64 + ni * 32 + crow(i, h);
        const bf16_t b = f2bf(acc[mi][ni][i]);
        if (col < 384) { const int hd = col / 96, d = col % 96; mk[(size_t)((half * 4 + hd) * 8 + (m >> 5)) * 3072 + (d >> 4) * 512 + ((d >> 3) & 1) * 256 + (m & 31) * 8 + (d & 7)] = b; }
        else { const int cc = col - 384, hd = cc / 96, d = cc % 96, kk = m & 31;
          mv[(size_t)((half * 4 + hd) * 8 + (m >> 5)) * 3072 + (d >> 5) * 1024 + (kk >> 4) * 512 + ((kk >> 3) & 1) * 256 + ((kk >> 2) & 1) * 128 + (d & 31) * 4 + (kk & 3)] = b; }
      }
    }
}

DI f32x16 mm_quad(const bf16_t* A, const bf16_t* B, int wr, int wc, int r, int h) {
  f32x16 acc;
#pragma unroll
  for (int i = 0; i < 16; ++i) acc[i] = 0.f;
  const bf16_t* a_ = A + (wr * 32 + r) * 72 + 8 * h;
  const bf16_t* b_ = B + (wc * 32 + r) * 72 + 8 * h;
#pragma unroll
  for (int s = 0; s < 4; ++s) acc = MFMA32(*(const bf16x8*)(a_ + 16 * s), *(const bf16x8*)(b_ + 16 * s), acc);
  return acc;
}

DI void gdn_prep(const Params& p, int layer, int half, int hh, int c, unsigned char* smem) {
  bf16_t* QN = (bf16_t*)smem; bf16_t* KN = QN + 4608; bf16_t* KB = KN + 4608; bf16_t* KDT = KB + 4608; bf16_t* VBT = KDT + 4608;
  bf16_t* KBET = VBT + 4608; bf16_t* QKm = KBET + 4608; bf16_t* Tm = QKm + 4608;
  float* gcv = (float*)(smem + 73728); float* betav = gcv + 64; float* egc = gcv + 128;
  float* Mf = (float*)(smem + 9216);
  bf16_t* UT = KN; bf16_t* WT = KB;
  int tid = otid();
  int lane = tid & 63, wave = tid >> 6, wr = wave >> 1, wc = wave & 1, r = lane & 31, h = lane >> 5;
#define REOPAQUE() do { asm volatile("" : "+v"(tid)); lane = tid & 63; wave = tid >> 6; wr = wave >> 1; wc = wave & 1; r = lane & 31; h = lane >> 5; } while (0)
  const float* sm = (const float*)(p.ws + O_SM);
  if (wave == 0) {
    const int tok = c * 64 + lane;
    const float bt = fsigmoid(sm[tok * 32 + 6 + hh]);
    const float xv = sm[tok * 32 + 12 + hh] + p.dt_bias[layer * 6 + hh];
    const float sp = fmaxf(xv, 0.f) + log1pf(expf(-fabsf(xv)));
    float g = -expf(p.a_log[layer * 6 + hh]) * sp;
#pragma unroll
    for (int o = 1; o < 64; o <<= 1) { const float t = __shfl_up(g, o); if (lane >= o) g += t; }
    gcv[lane] = g; betav[lane] = bt; egc[lane] = expf(g);
    if (lane == 63) ((float*)(p.ws + O_GL))[hh * 128 + c] = expf(g);
  }
  __syncthreads();
  REOPAQUE();
  {
    const int t = tid >> 2, cg4 = tid & 3, ch0 = cg4 * 16;
    const bf16_t* src = (const bf16_t*)(p.ws + O_QKVD);
    const float* cw = p.conv_w + (size_t)layer * 4 * 1152;
    const float bt = betav[t], gct = gcv[t], eg = egc[t], ed = expf(gcv[63] - gct);
    auto convpart = [&](int pt, float (&val)[16]) {
      const int col = pt * 384 + hh * 64 + ch0;
#pragma unroll
      for (int e = 0; e < 16; ++e) val[e] = 0.f;
#pragma unroll
      for (int j = 0; j < 4; ++j) {
        const int row = c * 64 + t - 3 + j;
        if (row >= 0) {
          float xv[16];
          unpk8(*(const bf16x8*)(src + (size_t)row * 1152 + col), xv);
          unpk8(*(const bf16x8*)(src + (size_t)row * 1152 + col + 8), xv + 8);
#pragma unroll
          for (int e4 = 0; e4 < 4; ++e4) {
            const f32x4 w4 = *(const f32x4*)(cw + j * 1152 + col + 4 * e4);
#pragma unroll
            for (int e = 0; e < 4; ++e) val[4 * e4 + e] += w4[e] * xv[4 * e4 + e];
          }
        }
      }
#pragma unroll
      for (int e = 0; e < 16; ++e) val[e] = fsilu(val[e]);
    };
    {
      float val[16]; convpart(0, val);
      float sq = 0.f;
#pragma unroll
      for (int e = 0; e < 16; ++e) sq += val[e] * val[e];
      sq += __shfl_xor(sq, 1); sq += __shfl_xor(sq, 2);
      const float rq = rsqrtf(sq + 1e-6f) * 0.125f;
#pragma unroll
      for (int e = 0; e < 16; ++e) val[e] *= rq;
      *(bf16x8*)(QN + t * 72 + ch0) = pk8(val); *(bf16x8*)(QN + t * 72 + ch0 + 8) = pk8(val + 8);
    }
    asm volatile("" ::: "memory");
    {
      float val[16]; convpart(1, val);
      float sk = 0.f;
#pragma unroll
      for (int e = 0; e < 16; ++e) sk += val[e] * val[e];
      sk += __shfl_xor(sk, 1); sk += __shfl_xor(sk, 2);
      const float rk = rsqrtf(sk + 1e-6f);
      float kb[16];
#pragma unroll
      for (int e = 0; e < 16; ++e) { val[e] *= rk; kb[e] = val[e] * bt; }
      *(bf16x8*)(KN + t * 72 + ch0) = pk8(val); *(bf16x8*)(KN + t * 72 + ch0 + 8) = pk8(val + 8);
      *(bf16x8*)(KB + t * 72 + ch0) = pk8(kb); *(bf16x8*)(KB + t * 72 + ch0 + 8) = pk8(kb + 8);
#pragma unroll
      for (int e = 0; e < 16; ++e) {
        KDT[(ch0 + e) * 72 + t] = f2bf(val[e] * ed);
        KBET[(ch0 + e) * 72 + t] = f2bf(kb[e] * eg);
      }
    }
    asm volatile("" ::: "memory");
    {
      float val[16]; convpart(2, val);
#pragma unroll
      for (int e = 0; e < 16; ++e) VBT[(ch0 + e) * 72 + t] = f2bf(val[e] * bt);
    }
  }
  __syncthreads();
  REOPAQUE();
  {
    const f32x16 kk = mm_quad(KB, KN, wr, wc, r, h);
    const f32x16 qk = mm_quad(QN, KN, wr, wc, r, h);
    __syncthreads();
    const int j = wc * 32 + r; const float gj = gcv[j];
#pragma unroll
    for (int i = 0; i < 16; ++i) {
      const int row = wr * 32 + crow(i, h);
      const float dec = (row >= j) ? expf(gcv[row] - gj) : 0.f;
      Mf[row * 68 + j] = (row > j) ? kk[i] * dec : 0.f;
      QKm[row * 72 + j] = f2bf(qk[i] * dec);
    }
  }
  __syncthreads();
  REOPAQUE();
  if (wave == 0) {
    float t[64];
#pragma unroll
    for (int i = 0; i < 64; ++i) {
      float a4[4] = {(i == lane) ? 1.f : 0.f, 0.f, 0.f, 0.f};
#pragma unroll
      for (int j4 = 0; j4 < (i + 3) / 4; ++j4) {
        const f32x4 mrow = *(const f32x4*)(Mf + i * 68 + 4 * j4);
#pragma unroll
        for (int e = 0; e < 4; ++e) if (4 * j4 + e < i) a4[e] -= mrow[e] * t[4 * j4 + e];
      }
      const float a = (a4[0] + a4[1]) + (a4[2] + a4[3]);
      t[i] = a;
      Tm[i * 72 + lane] = f2bf(a);
      asm volatile("" ::: "memory");
    }
  }
  __syncthreads();
  REOPAQUE();
  {
    const f32x16 u = mm_quad(Tm, VBT, wr, wc, r, h);
    const f32x16 w = mm_quad(Tm, KBET, wr, wc, r, h);
    const int col = wc * 32 + r;
#pragma unroll
    for (int g = 0; g < 4; ++g) {
      const int i0 = wr * 32 + 8 * g + 4 * h;
      *(u32x2*)(UT + col * 72 + i0) = pk4(u[4 * g], u[4 * g + 1], u[4 * g + 2], u[4 * g + 3]);
      *(u32x2*)(WT + col * 72 + i0) = pk4(w[4 * g], w[4 * g + 1], w[4 * g + 2], w[4 * g + 3]);
    }
  }
  __syncthreads();
  REOPAQUE();
  {
    bf16_t* base = (bf16_t*)(p.ws + O_DPREP + (size_t)(hh * 128 + c) * 32768);
    const int n = wc * 32 + r;
    {
      const int ks = n >> 5, jh = (n >> 4) & 1, q = (n >> 2) & 3, jl = n & 3, jj = 4 * jh + jl;
      const int cbase = (ks * 64 + 16 * q) * 8 + jj;
      {
        const f32x16 P = mm_quad(KDT, WT, wr, wc, r, h);
#pragma unroll
        for (int i = 0; i < 16; ++i) {
          const int m = wr * 32 + crow(i, h);
          base[((m >> 4) * 128 + (m & 15)) * 8 + cbase] = f2bf(P[i]);
        }
      }
      asm volatile("" ::: "memory");
      {
        const f32x16 QW = mm_quad(QKm, WT, wr, wc, r, h);
#pragma unroll
        for (int i = 0; i < 16; ++i) {
          const int m = wr * 32 + crow(i, h);
          const float qd = bf2f(QN[m * 72 + n]) * egc[m];
          base[4096 + ((m >> 4) * 128 + (m & 15)) * 8 + cbase] = f2bf(qd - QW[i]);
        }
      }
      asm volatile("" ::: "memory");
    }
    const int jsl = n >> 4;
    {
      const f32x16 Bc = mm_quad(KDT, UT, wr, wc, r, h);
#pragma unroll
      for (int g = 0; g < 4; ++g) {
        const int row0 = wr * 32 + 8 * g + 4 * h;
        const int rt = row0 >> 4, lp = 16 * ((row0 >> 2) & 3) + (n & 15);
        *(u32x2*)(base + 8192 + ((jsl * 4 + rt) * 64 + lp) * 4) = pk4(Bc[4 * g], Bc[4 * g + 1], Bc[4 * g + 2], Bc[4 * g + 3]);
      }
    }
    asm volatile("" ::: "memory");
    {
      const f32x16 O0 = mm_quad(QKm, UT, wr, wc, r, h);
#pragma unroll
      for (int g = 0; g < 4; ++g) {
        const int row0 = wr * 32 + 8 * g + 4 * h;
        const int rt = row0 >> 4, lp = 16 * ((row0 >> 2) & 3) + (n & 15);
        *(u32x2*)(base + 12288 + ((jsl * 4 + rt) * 64 + lp) * 4) = pk4(O0[4 * g], O0[4 * g + 1], O0[4 * g + 2], O0[4 * g + 3]);
      }
    }
  }
  __syncthreads();
#undef REOPAQUE
}

struct TileDesc { const bf16_t* k; const bf16_t* v; const float* aux; int tag; };

template <int DHT, bool AUX>
struct TileRegs { bf16x8 k[DHT / 16]; s16x4 v[DHT / 32][2][2]; f32x4 a[4]; };

template <int DHT, bool AUX>
DI void load_tile(const bf16_t* kp, const bf16_t* vp, const float* ap, long ldv, TileRegs<DHT, AUX>& t) {
#pragma unroll
  for (int s = 0; s < DHT / 16; ++s) t.k[s] = *(const bf16x8*)(kp + 512 * s);
#pragma unroll
  for (int dt = 0; dt < DHT / 32; ++dt)
#pragma unroll
    for (int s = 0; s < 2; ++s)
#pragma unroll
      for (int q = 0; q < 2; ++q) t.v[dt][s][q] = *(const s16x4*)(vp + ((dt * 2 + s) * 2 + q) * 256);
  if (AUX) {
#pragma unroll
    for (int g = 0; g < 4; ++g) t.a[g] = *(const f32x4*)(ap + 8 * g);
  }
}

template <int DHT, bool AUX, class TF, class MF, class SF>
DI void attn_loop(int maxtiles, TF&& tf, MF&& mf, SF&& stopf, const bf16x8 (&qf)[DHT / 16], long ldv, float scale2,
                  f32x16 (&o)[DHT / 32], float& m, float& l) {
  TileRegs<DHT, AUX> cur, nxt;
  int tagc, tagn;
  bf16x8 qf0 = qf[0];
  { const bf16_t* kp; const bf16_t* vp; const float* ap = nullptr; tagc = tf(0, kp, vp, ap); load_tile<DHT, AUX>(kp, vp, ap, ldv, cur); }
#pragma unroll 1
  for (int t = 0; t < maxtiles; ++t) {
    { const bf16_t* kp; const bf16_t* vp; const float* ap = nullptr; tagn = tf(t + 1, kp, vp, ap); load_tile<DHT, AUX>(kp, vp, ap, ldv, nxt); }
    { bf16x8 q0 = qf[0]; asm volatile("" : "+v"(q0) :: "memory"); qf0 = q0; }
    f32x16 sacc;
#pragma unroll
    for (int i = 0; i < 16; ++i) sacc[i] = 0.f;
#pragma unroll
    for (int s = 0; s < DHT / 16; ++s) sacc = MFMA32(cur.k[s], s == 0 ? qf0 : qf[s], sacc);
    float sv[16]; float mx = NEG_INF;
#pragma unroll
    for (int i = 0; i < 16; ++i) { sv[i] = sacc[i] * scale2 + mf(tagc, i, AUX ? cur.a[i >> 2][i & 3] : 0.f); mx = fmaxf(mx, sv[i]); }
    mx = fmaxf(mx, __shfl_xor(mx, 32));
    const float mnew = fmaxf(m, mx);
    const float alpha = __builtin_amdgcn_exp2f(m - mnew);
    m = mnew;
    float pv[16]; float ps = 0.f;
#pragma unroll
    for (int i = 0; i < 16; ++i) { pv[i] = __builtin_amdgcn_exp2f(sv[i] - mnew); ps += pv[i]; }
    l = l * alpha + ps;
#pragma unroll
    for (int dt = 0; dt < DHT / 32; ++dt)
#pragma unroll
      for (int i = 0; i < 16; ++i) o[dt][i] *= alpha;
    bf16x8 pf[2]; pf[0] = pk8(pv); pf[1] = pk8(pv + 8);
#pragma unroll
    for (int dt = 0; dt < DHT / 32; ++dt)
#pragma unroll
      for (int s = 0; s < 2; ++s) {
        const bf16x8 vf = __builtin_shufflevector(cur.v[dt][s][0], cur.v[dt][s][1], 0, 1, 2, 3, 4, 5, 6, 7);
        o[dt] = MFMA32(vf, pf[s], o[dt]);
      }
    if (stopf(t, m, AUX ? cur.a[0][0] : 0.f)) break;
    cur = nxt; tagc = tagn;
  }
}

template <int DHT>
DI void attn_store(const f32x16 (&o)[DHT / 32], float l, bf16_t* dstrow, int h, float& ltot_out, bool valid = true) {
  const float ltot = l + __shfl_xor(l, 32);
  ltot_out = ltot;
  const float inv = ltot > 0.f ? 1.f / ltot : 0.f;
  if (valid)
#pragma unroll
  for (int dt = 0; dt < DHT / 32; ++dt)
#pragma unroll
    for (int g = 0; g < 4; ++g)
      *(u32x2*)(dstrow + dt * 32 + 8 * g + 4 * h) = pk4(o[dt][4 * g] * inv, o[dt][4 * g + 1] * inv, o[dt][4 * g + 2] * inv, o[dt][4 * g + 3] * inv);
}

template <int N>
DI void zero_o(f32x16 (&o)[N]) {
#pragma unroll
  for (int a = 0; a < N; ++a)
#pragma unroll
    for (int i = 0; i < 16; ++i) o[a][i] = 0.f;
}

DI void top3_insert(float v, int n, float& v0, float& v1, float& v2, int& i0, int& i1, int& i2) {
  const bool g0 = v > v0, g1 = v > v1, g2 = v > v2;
  v2 = g1 ? v1 : (g2 ? v : v2); i2 = g1 ? i1 : (g2 ? n : i2);
  v1 = g0 ? v0 : (g1 ? v : v1); i1 = g0 ? i0 : (g1 ? n : i1);
  v0 = g0 ? v : v0;             i0 = g0 ? n : i0;
}

DI void moba_select(const Params& p, int a) {
  const int lane = otid() & 63, r = lane & 31, h = lane >> 5;
  const int qtile = a / 6, hh = a % 6, qb = qtile >> 3;
  unsigned mask = 0;
  if (qb > 0) {
    const bf16_t* qrow = (const bf16_t*)(p.ws + O_QKA) + (size_t)(qtile * 32 + r) * 384 + hh * 64 + 8 * h;
    bf16x8 qf[4];
#pragma unroll
    for (int s = 0; s < 4; ++s) qf[s] = *(const bf16x8*)(qrow + 16 * s);
    const bf16_t* kmh = (const bf16_t*)(p.ws + O_KM) + (hh * 32 + r) * 64 + 8 * h;
    const bf16_t* kml = kmh + 6 * 32 * 64;
    f32x16 g;
#pragma unroll
    for (int i = 0; i < 16; ++i) g[i] = 0.f;
#pragma unroll
    for (int s = 0; s < 4; ++s) { g = MFMA32(*(const bf16x8*)(kmh + 16 * s), qf[s], g); g = MFMA32(*(const bf16x8*)(kml + 16 * s), qf[s], g); }
    float v0 = NEG_INF, v1 = NEG_INF, v2 = NEG_INF; int i0 = -1, i1 = -1, i2 = -1;
#pragma unroll
    for (int i = 0; i < 16; ++i) { const int n = crow(i, h); if (n < qb) top3_insert(g[i], n, v0, v1, v2, i0, i1, i2); }
    const float pv0 = __shfl_xor(v0, 32), pv1 = __shfl_xor(v1, 32), pv2 = __shfl_xor(v2, 32);
    const int pi0 = __shfl_xor(i0, 32), pi1 = __shfl_xor(i1, 32), pi2 = __shfl_xor(i2, 32);
    if (pi0 >= 0) top3_insert(pv0, pi0, v0, v1, v2, i0, i1, i2);
    if (pi1 >= 0) top3_insert(pv1, pi1, v0, v1, v2, i0, i1, i2);
    if (pi2 >= 0) top3_insert(pv2, pi2, v0, v1, v2, i0, i1, i2);
    if (i0 >= 0) mask |= 1u << i0;
    if (i1 >= 0) mask |= 1u << i1;
    if (i2 >= 0) mask |= 1u << i2;
  }
  if (h == 0) ((unsigned*)(p.ws + O_MASK))[(qtile * 32 + r) * 8 + hh] = mask;
}

DI void moba_gather(const Params& p, int a, unsigned char* smem) {
  const int tid = otid(), lane = tid & 63, wave = tid >> 6, r = lane & 31, h = lane >> 5;
  const int part = a & 1, a2 = a >> 1;
  const int hh = a2 % 6, idx = a2 / 6;
  int qb = 1;
  while ((qb + 1) * qb / 2 <= idx) ++qb;
  const int n = idx - qb * (qb - 1) / 2;
  const unsigned* MASK = (const unsigned*)(p.ws + O_MASK);
  unsigned* list = (unsigned*)(smem + wave * 1024);
  int cnt = 0;
#pragma unroll
  for (int j = 0; j < 4; ++j) {
    const int qi = j * 64 + lane;
    const unsigned mk = MASK[(qb * 256 + qi) * 8 + hh];
    const bool pred = (mk >> n) & 1u;
    const unsigned long long ball = __ballot(pred);
    const int pos = cnt + __builtin_popcountll(ball & ((1ull << lane) - 1ull));
    if (pred) list[pos] = (unsigned)qi | ((unsigned)__builtin_popcount(mk & ((1u << n) - 1u)) << 8);
    cnt += __builtin_popcountll(ball);
  }
  cnt = __builtin_amdgcn_readfirstlane(cnt);
  if (cnt == 0) return;
  asm volatile("s_waitcnt lgkmcnt(0)" ::: "memory");
  __builtin_amdgcn_wave_barrier();
  const bf16_t* QK = (const bf16_t*)(p.ws + O_QKA);
  const bf16_t* KF = (const bf16_t*)(p.ws + O_KFA) + (size_t)hh * 524288 + (size_t)n * 8 * 2048 + lane * 8;
  const bf16_t* VT = (const bf16_t*)(p.ws + O_VTA) + (size_t)hh * 524288 + (size_t)n * 8 * 2048 + lane * 4;
  const int nch = (cnt + 31) >> 5;
#pragma unroll 1
  for (int c = part; c < nch; c += 2) {
    const int e = c * 32 + r;
    const bool valid = e < cnt;
    const unsigned ent = list[valid ? e : 0];
    const int tok = qb * 256 + (int)(ent & 255u), slot = (int)(ent >> 8);
    bf16x8 qf[4];
    { const bf16_t* qrow = QK + (size_t)tok * 384 + hh * 64 + 8 * h;
#pragma unroll
      for (int s = 0; s < 4; ++s) qf[s] = *(const bf16x8*)(qrow + 16 * s); }
    auto tf = [&](int t, const bf16_t*& kp, const bf16_t*& vp, const float*&) -> int {
      const int tt = t < 7 ? t : 7;
      kp = KF + tt * 2048; vp = VT + tt * 2048;
      return 0;
    };
    auto mf = [&](int, int, float) -> float { return 0.f; };
    auto sf = [&](int, float, float) { return false; };
    f32x16 o[2]; zero_o(o); float m = -1e30f, l = 0.f;
    int nt8 = 8; asm volatile("" : "+s"(nt8));
    attn_loop<64, false>(nt8, tf, mf, sf, qf, (long)TH, 0.125f * LOG2E, o, m, l);
    float lt;
    attn_store<64>(o, l, (bf16_t*)(p.ws + O_OA + slot * SZ_O) + (size_t)tok * 384 + hh * 64, h, lt, valid);
    if (valid && h == 0) { float* st = (float*)(p.ws + O_STA) + ((size_t)(slot * TH + tok) * 6 + hh) * 2; st[0] = m; st[1] = lt; }
  }
}

DI void moba_own(const Params& p, int a) {
  const int lane = otid() & 63, r = lane & 31, h = lane >> 5;
  const int qtile = 255 - a / 6, hh = a % 6, qb = qtile >> 3, own = qtile & 7;
  const bf16_t* QK = (const bf16_t*)(p.ws + O_QKA);
  const bf16_t* KF = (const bf16_t*)(p.ws + O_KFA) + (size_t)hh * 524288 + (size_t)qb * 8 * 2048 + lane * 8;
  const bf16_t* VT = (const bf16_t*)(p.ws + O_VTA) + (size_t)hh * 524288 + (size_t)qb * 8 * 2048 + lane * 4;
  const int tok = qtile * 32 + r;
  bf16x8 qf[4];
  { const bf16_t* qrow = QK + (size_t)tok * 384 + hh * 64 + 8 * h;
#pragma unroll
    for (int s = 0; s < 4; ++s) qf[s] = *(const bf16x8*)(qrow + 16 * s); }
  auto tf = [&](int t, const bf16_t*& kp, const bf16_t*& vp, const float*&) -> int {
    const int kk = t < own ? t : own;
    kp = KF + kk * 2048; vp = VT + kk * 2048;
    return (kk == own) ? 101 : 100;
  };
  auto mf = [&](int tag, int i, float) -> float {
    if (tag == 100) return 0.f;
    return (crow(i, h) <= r) ? 0.f : NEG_INF;
  };
  auto sf = [&](int, float, float) { return false; };
  f32x16 o[2]; zero_o(o); float m = -1e30f, l = 0.f;
  attn_loop<64, false>(own + 1, tf, mf, sf, qf, (long)TH, 0.125f * LOG2E, o, m, l);
  float lt;
  attn_store<64>(o, l, (bf16_t*)(p.ws + O_OA + 3 * SZ_O) + (size_t)tok * 384 + hh * 64, h, lt);
  if (h == 0) {
    float* st = (float*)(p.ws + O_STA);
    st[((size_t)(3 * TH + tok) * 6 + hh) * 2] = m; st[((size_t)(3 * TH + tok) * 6 + hh) * 2 + 1] = lt;
    const int np = __builtin_popcount(((const unsigned*)(p.ws + O_MASK))[tok * 8 + hh]);
    for (int sl = np; sl < 3; ++sl) { st[((size_t)(sl * TH + tok) * 6 + hh) * 2] = -1e30f; st[((size_t)(sl * TH + tok) * 6 + hh) * 2 + 1] = 0.f; }
  }
}

DI void fox_item(const Params& p, int c, const unsigned* kmaxu) {
  const int lane = otid() & 63, r = lane & 31, h = lane >> 5;
  const int qtile = 255 - c / 6, hh = c % 6;
  const bf16_t* QK = (const bf16_t*)(p.ws + O_QKC);
  const bf16_t* KF = (const bf16_t*)(p.ws + O_KFC);
  const bf16_t* VT = (const bf16_t*)(p.ws + O_VTC);
  const float* FF = (const float*)(p.ws + O_FF) + hh * TH;
  bf16x8 qf[4]; float qn2 = 0.f;
  { const bf16_t* qrow = QK + (size_t)(qtile * 32 + r) * 384 + hh * 64 + 8 * h;
#pragma unroll
    for (int s = 0; s < 4; ++s) { qf[s] = *(const bf16x8*)(qrow + 16 * s); float v[8]; unpk8(qf[s], v);
#pragma unroll
      for (int e = 0; e < 8; ++e) qn2 += v[e] * v[e]; } }
  qn2 += __shfl_xor(qn2, 32);
#pragma unroll
  for (int o = 16; o >= 1; o >>= 1) qn2 = fmaxf(qn2, __shfl_xor(qn2, o));
  const float Fq = FF[qtile * 32 + r];
  const float Ffirst = FF[qtile * 32];
  const float kmaxn = sqrtf(__uint_as_float(kmaxu[hh]));
  const float bound = sqrtf(qn2) * kmaxn * 0.125f + Ffirst;
  auto tf = [&](int t, const bf16_t*& kp, const bf16_t*& vp, const float*& ap) -> int {
    const int keybase = (qtile - t > 0 ? qtile - t : 0) * 32;
    kp = KF + (size_t)hh * 524288 + (keybase >> 5) * 2048 + lane * 8;
    vp = VT + (size_t)hh * 524288 + (keybase >> 5) * 2048 + lane * 4;
    ap = FF + keybase + 4 * h;
    return (t == 0) ? 1 : 0;
  };
  auto mf = [&](int tag, int i, float fk) -> float {
    const float b = (Fq - fk) * LOG2E;
    return (tag == 1 && crow(i, h) > r) ? NEG_INF : b;
  };
  auto sf = [&](int, float m, float a0) {
    const float fkb = __builtin_bit_cast(float, __builtin_amdgcn_readfirstlane(__builtin_bit_cast(int, a0)));
    float mm = m;
#pragma unroll
    for (int o = 16; o >= 1; o >>= 1) mm = fminf(mm, __shfl_xor(mm, o));
    return (bound - fkb) * LOG2E < mm - 45.f;
  };
  f32x16 o[2]; zero_o(o); float m = -1e30f, l = 0.f;
  attn_loop<64, true>(qtile + 1, tf, mf, sf, qf, (long)TH, 0.125f * LOG2E, o, m, l);
  float lt;
  attn_store<64>(o, l, (bf16_t*)(p.ws + O_OC) + (size_t)(qtile * 32 + r) * 384 + hh * 64, h, lt);
}

DI void dil_item(const Params& p, int idx) {
  const int lane = otid() & 63, r = lane & 31, h = lane >> 5;
  const int g = idx / 1536, rem = idx % 1536, hh = rem / 256, w = rem % 256;
  const int dsh = 2 * g;
  const int dil = 1 << dsh, L = TH >> dsh, tps = L / 32;
  const int rs = w / tps, lt_ = w % tps, l0 = lt_ * 32;
  const bf16_t* QK = (const bf16_t*)(p.ws + O_QKB);
  const bf16_t* KF = (const bf16_t*)(p.ws + O_KFB + g * SZ_VT);
  const bf16_t* VT = (const bf16_t*)(p.ws + O_VTB + g * SZ_VT);
  const int tq = (l0 + r) * dil + rs;
  bf16x8 qf[4];
  { const bf16_t* qrow = QK + (size_t)tq * 1152 + g * 384 + hh * 64 + 8 * h;
#pragma unroll
    for (int s = 0; s < 4; ++s) qf[s] = *(const bf16x8*)(qrow + 16 * s); }
  const int t0 = (l0 >= 128) ? 0 : (128 - l0) / 32;
  auto tf = [&](int tt, const bf16_t*& kp, const bf16_t*& vp, const float*&) -> int {
    const int t = (t0 + tt < 4) ? t0 + tt : 4; const int keybase = l0 - 128 + 32 * t;
    kp = KF + (size_t)hh * 524288 + ((rs * L + keybase) >> 5) * 2048 + lane * 8;
    vp = VT + (size_t)hh * 524288 + ((rs * L + keybase) >> 5) * 2048 + lane * 4;
    return t;
  };
  auto mf = [&](int tag, int i, float) -> float {
    const int kj = crow(i, h);
    if (tag == 0) return (kj >= r) ? 0.f : NEG_INF;
    if (tag == 4) return (kj <= r) ? 0.f : NEG_INF;
    return 0.f;
  };
  auto sf = [&](int, float, float) { return false; };
  f32x16 o[2]; zero_o(o); float m = -1e30f, l = 0.f;
  attn_loop<64, false>(5 - t0, tf, mf, sf, qf, (long)TH, 0.125f * LOG2E, o, m, l);
  float lt;
  attn_store<64>(o, l, (bf16_t*)(p.ws + O_OB + g * SZ_O) + (size_t)tq * 384 + hh * 64, h, lt);
  if (h == 0) { float* st = (float*)(p.ws + O_STB) + ((size_t)(g * TH + tq) * 6 + hh) * 2; st[0] = m; st[1] = lt; }
}

DI void mem_item(const Params& p, int half, int e) {
  const int lane = otid() & 63, r = lane & 31, h = lane >> 5;
  const int hd = e & 3, qtile = e >> 2;
  const bf16_t* QE = (const bf16_t*)(p.ws + O_QE);
  const bf16_t* MK = (const bf16_t*)(p.ws + O_MEMK);
  const bf16_t* MV = (const bf16_t*)(p.ws + O_MEMVT);
  bf16x8 qf[6];
  { const bf16_t* qrow = QE + (size_t)(qtile * 32 + r) * 384 + hd * 96 + 8 * h;
#pragma unroll
    for (int s = 0; s < 6; ++s) qf[s] = *(const bf16x8*)(qrow + 16 * s); }
  auto tf = [&](int t, const bf16_t*& kp, const bf16_t*& vp, const float*&) -> int {
    const int keybase = 32 * (t < 7 ? t : 7);
    kp = MK + (size_t)((half * 4 + hd) * 8 + (keybase >> 5)) * 3072 + lane * 8;
    vp = MV + (size_t)((half * 4 + hd) * 8 + (keybase >> 5)) * 3072 + lane * 4;
    return 0;
  };
  auto mf = [&](int, int, float) -> float { return 0.f; };
  auto sf = [&](int, float, float) { return false; };
  f32x16 o[3]; zero_o(o); float m = -1e30f, l = 0.f;
  attn_loop<96, false>(8, tf, mf, sf, qf, 256L, 0.10206207261596577f * LOG2E, o, m, l);
  float lt;
  attn_store<96>(o, l, (bf16_t*)(p.ws + O_OE) + (size_t)(qtile * 32 + r) * 384 + hd * 96, h, lt);
}

DI float dpp_ror(float v, int ctrl);
DI float row16_sum(float v) {
  v += __builtin_bit_cast(float, __builtin_amdgcn_update_dpp(0, __builtin_bit_cast(int, v), 0x128, 0xf, 0xf, false));
  v += __builtin_bit_cast(float, __builtin_amdgcn_update_dpp(0, __builtin_bit_cast(int, v), 0x124, 0xf, 0xf, false));
  v += __builtin_bit_cast(float, __builtin_amdgcn_update_dpp(0, __builtin_bit_cast(int, v), 0x122, 0xf, 0xf, false));
  v += __builtin_bit_cast(float, __builtin_amdgcn_update_dpp(0, __builtin_bit_cast(int, v), 0x121, 0xf, 0xf, false));
  return v;
}

struct ScanRegs { bf16x8 pf[4][2]; bf16x8 qe[4][2]; s16x4 bc[4]; s16x4 o0[4]; float gl; };
DI void scan_load(const Params& p, int hh, int j, int c, int lane, ScanRegs& s) {
  const unsigned char* base = p.ws + O_DPREP + (size_t)(hh * 128 + c) * 32768;
#pragma unroll
  for (int mt = 0; mt < 4; ++mt)
#pragma unroll
    for (int ks = 0; ks < 2; ++ks) {
      s.pf[mt][ks] = *(const bf16x8*)(base + ((mt * 2 + ks) * 64 + lane) * 16);
      s.qe[mt][ks] = *(const bf16x8*)(base + 8192 + ((mt * 2 + ks) * 64 + lane) * 16);
    }
#pragma unroll
  for (int rt = 0; rt < 4; ++rt) {
    s.bc[rt] = *(const s16x4*)(base + 16384 + ((j * 4 + rt) * 64 + lane) * 8);
    s.o0[rt] = *(const s16x4*)(base + 24576 + ((j * 4 + rt) * 64 + lane) * 8);
  }
  s.gl = ((const float*)(p.ws + O_GL))[hh * 128 + c];
}
DI f32x4 s4f(s16x4 v) { u32x2 u = __builtin_bit_cast(u32x2, v); f32x4 r; r[0] = bflo(u.x); r[1] = bfhi(u.x); r[2] = bflo(u.y); r[3] = bfhi(u.y); return r; }

DI void scan_item(const Params& p, int it) {
  const int lane = otid() & 63, q = lane >> 4, cl = lane & 15;
  const int hh = it >> 2, j = it & 3;
  f32x4 S[4];
#pragma unroll
  for (int rt = 0; rt < 4; ++rt) S[rt] = (f32x4){0.f, 0.f, 0.f, 0.f};
  bf16_t* OD = (bf16_t*)(p.ws + O_OD);
  float* SSQ = (float*)(p.ws + O_SSQ);
#ifndef SCAN_PREFETCH
#define SCAN_PREFETCH 1
#endif
  ScanRegs cur, nxt;
  if (SCAN_PREFETCH) scan_load(p, hh, j, 0, lane, cur);
  for (int c = 0; c < 128; ++c) {
    if (SCAN_PREFETCH) {
      scan_load(p, hh, j, (c + 1 < 128) ? c + 1 : c, lane, nxt);
      asm volatile("" : "+v"(S[0][0]) :: "memory");
    } else {
      scan_load(p, hh, j, c, lane, cur);
    }
    bf16x8 bfr[2];
#pragma unroll
    for (int ks = 0; ks < 2; ++ks) {
      u32x4 u; u.x = pk2(S[2 * ks][0], S[2 * ks][1]); u.y = pk2(S[2 * ks][2], S[2 * ks][3]); u.z = pk2(S[2 * ks + 1][0], S[2 * ks + 1][1]); u.w = pk2(S[2 * ks + 1][2], S[2 * ks + 1][3]);
      bfr[ks] = __builtin_bit_cast(bf16x8, u);
    }
    f32x4 aP[4], aO[4];
#pragma unroll
    for (int rt = 0; rt < 4; ++rt) {
      aP[rt] = (f32x4){0.f, 0.f, 0.f, 0.f};
      aO[rt] = s4f(cur.o0[rt]);
#pragma unroll
      for (int ks = 0; ks < 2; ++ks) { aP[rt] = MFMA16(cur.pf[rt][ks], bfr[ks], aP[rt]); aO[rt] = MFMA16(cur.qe[rt][ks], bfr[ks], aO[rt]); }
    }
#pragma unroll
    for (int rt = 0; rt < 4; ++rt) S[rt] = S[rt] * cur.gl - aP[rt] + s4f(cur.bc[rt]);
#pragma unroll
    for (int rt = 0; rt < 4; ++rt)
#pragma unroll
      for (int e = 0; e < 4; ++e) {
        const int tok = c * 64 + 16 * rt + 4 * q + e;
        const float v = aO[rt][e];
        OD[(size_t)tok * 384 + hh * 64 + 16 * j + cl] = f2bf(v);
        const float ss = row16_sum(v * v);
        if (cl == 0) SSQ[(tok * 6 + hh) * 4 + j] = ss;
      }
    if (SCAN_PREFETCH) cur = nxt;
  }
}

DI void scan_block(const Params& p, int hh, unsigned char* smem) {
  const int tid = otid(), lane = tid & 63, j = tid >> 6, q = lane >> 4, cl = lane & 15;
  const unsigned char* src = p.ws + O_DPREP + (size_t)hh * 128 * 32768;
  bf16_t* ostg = (bf16_t*)(smem + 65536);
  bf16x8 R0[8], R1[8];
  auto gld = [&](int c, bf16x8 (&R)[8]) {
    c = c < 128 ? c : 127;
    const unsigned char* b = src + (size_t)c * 32768 + tid * 16;
#pragma unroll
    for (int i = 0; i < 8; ++i) R[i] = *(const bf16x8*)(b + i * 4096);
  };
  auto lst = [&](int buf, const bf16x8 (&R)[8]) {
    unsigned char* d = smem + buf * 32768 + tid * 16;
#pragma unroll
    for (int i = 0; i < 8; ++i) *(bf16x8*)(d + i * 4096) = R[i];
  };
  const float* GL = (const float*)(p.ws + O_GL) + hh * 128;
  const float gl_lo = GL[lane], gl_hi = GL[64 + lane];
  f32x4 S[4];
#pragma unroll
  for (int rt = 0; rt < 4; ++rt) S[rt] = (f32x4){0.f, 0.f, 0.f, 0.f};
  bf16_t* OD = (bf16_t*)(p.ws + O_OD);
  float* SSQ = (float*)(p.ws + O_SSQ);
  f32x4 aO[4];
  auto flush = [&](int cp) {
    const int row = tid >> 2, part = tid & 3;
    const bf16x8 v0 = *(const bf16x8*)(ostg + row * 72 + 16 * part), v1 = *(const bf16x8*)(ostg + row * 72 + 16 * part + 8);
    float f[16]; unpk8(v0, f); unpk8(v1, f + 8);
    float ss = 0.f;
#pragma unroll
    for (int e = 0; e < 16; ++e) ss += f[e] * f[e];
    const int tok = cp * 64 + row;
    bf16_t* dst = OD + (size_t)tok * 384 + hh * 64 + 16 * part;
    *(bf16x8*)dst = v0; *(bf16x8*)(dst + 8) = v1;
    SSQ[(tok * 6 + hh) * 4 + part] = ss;
  };
  auto compute = [&](int buf, int c) {
    const unsigned char* base = smem + buf * 32768;
    const float gl = __builtin_bit_cast(float, __builtin_amdgcn_readlane(__builtin_bit_cast(int, c < 64 ? gl_lo : gl_hi), c & 63));
    bf16x8 bfr[2];
#pragma unroll
    for (int ks = 0; ks < 2; ++ks) {
      u32x4 u; u.x = pk2(S[2 * ks][0], S[2 * ks][1]); u.y = pk2(S[2 * ks][2], S[2 * ks][3]); u.z = pk2(S[2 * ks + 1][0], S[2 * ks + 1][1]); u.w = pk2(S[2 * ks + 1][2], S[2 * ks + 1][3]);
      bfr[ks] = __builtin_bit_cast(bf16x8, u);
    }
    f32x4 aP[4];
#pragma unroll
    for (int rt = 0; rt < 4; ++rt) {
      aP[rt] = (f32x4){0.f, 0.f, 0.f, 0.f};
      aO[rt] = s4f(*(const s16x4*)(base + 24576 + ((j * 4 + rt) * 64 + lane) * 8));
#pragma unroll
      for (int ks = 0; ks < 2; ++ks) {
        aP[rt] = MFMA16(*(const bf16x8*)(base + ((rt * 2 + ks) * 64 + lane) * 16), bfr[ks], aP[rt]);
        aO[rt] = MFMA16(*(const bf16x8*)(base + 8192 + ((rt * 2 + ks) * 64 + lane) * 16), bfr[ks], aO[rt]);
      }
    }
#pragma unroll
    for (int rt = 0; rt < 4; ++rt) S[rt] = S[rt] * gl - aP[rt] + s4f(*(const s16x4*)(base + 16384 + ((j * 4 + rt) * 64 + lane) * 8));
  };
  auto stage_out = [&]() {
#pragma unroll
    for (int rt = 0; rt < 4; ++rt)
#pragma unroll
      for (int e = 0; e < 4; ++e) ostg[(16 * rt + 4 * q + e) * 72 + 16 * j + cl] = f2bf(aO[rt][e]);
  };
  __builtin_amdgcn_s_setprio(3);
  gld(0, R0); gld(1, R1);
  lst(0, R0); gld(2, R0);
  __syncthreads();
#pragma unroll 1
  for (int c = 0; c < 128; c += 2) {
    lst(1, R1);
    gld(c + 3, R1);
    if (c > 0) flush(c - 1);
    compute(0, c);
    __syncthreads();
    stage_out();
    __syncthreads();
    lst(0, R0);
    gld(c + 4, R0);
    flush(c);
    compute(1, c + 1);
    __syncthreads();
    stage_out();
    __syncthreads();
  }
  flush(127);
  __syncthreads();
  __builtin_amdgcn_s_setprio(0);
}

DI void phase3(const Params& p, int half, unsigned* ctr, const unsigned* kmaxu, unsigned char* smem, int limit = 1 << 30) {
  const int tid = otid(), wave = tid >> 6;
  const int b = (int)blockIdx.x, x = b & 7, bi = b >> 3;
  if (b < 6 && limit >= 0) { if (PH(5)) scan_block(p, b, smem); }
  if (bi >= 1 && limit != 0) {
    const int nlw = ((int)(gridDim.x >> 3) - 1) * 4, lw = (bi - 1) * 4 + wave;
    if (x < 6) {
      const int hh = x;
      constexpr int NG = 992, NOWN = 256, NB_ = 640, NTOT = NG + NOWN + NB_;
      for (int pos0 = lw; pos0 < NTOT; pos0 += nlw) {
        int pos = __builtin_amdgcn_readfirstlane(pos0);
        if (pos < NG) { if (PH(6)) moba_gather(p, (((pos >> 1) * 6 + hh) << 1) | (pos & 1), smem); continue; }
        pos -= NG;
        if (pos < NOWN) { if (PH(6)) moba_own(p, pos * 6 + hh); continue; }
        pos -= NOWN;
        const int g = pos < 512 ? (pos >> 8) : 2, w = pos < 512 ? (pos & 255) : 2 * (pos - 512);
        if (PH(8)) dil_item(p, g * 1536 + hh * 256 + w);
      }
    } else {
      const int h0 = (x - 6) * 3;
      constexpr int NE = 512, NC = 768, NB2 = 384, NTOT = NE + NC + NB2;
      for (int pos0 = lw; pos0 < NTOT; pos0 += nlw) {
        int pos = __builtin_amdgcn_readfirstlane(pos0);
        if (pos < NE) { if (PH(7)) mem_item(p, half, (x - 6) * 512 + pos); continue; }
        pos -= NE;
        if (pos < NC) { if (PH(9)) fox_item(p, (pos & 255) * 6 + h0 + (pos >> 8), kmaxu); continue; }
        pos -= NC;
        if (PH(8)) dil_item(p, 2 * 1536 + (h0 + (pos >> 7)) * 256 + 2 * (pos & 127) + 1);
      }
    }
  }
}

DI void gbuild_chunk(const Params& p, int layer, int tok, int c8) {
  const unsigned char* ws = p.ws;
  const int n = c8 / 48, c = (c8 % 48) * 8;
  bf16_t* szp = (bf16_t*)(p.ws + O_SZ) + (size_t)tok * 1920 + n * 384 + c;
  float o[8], z[8];
  unpk8(*(const bf16x8*)szp, z);
  if (n == 1) {
    const int hh = c >> 6;
    const float* st = (const float*)(ws + O_STB);
    float mg[3], lg[3];
#pragma unroll
    for (int g = 0; g < 3; ++g) { const f32x2 s2 = *(const f32x2*)(st + ((size_t)(g * TH + tok) * 6 + hh) * 2); mg[g] = s2[0]; lg[g] = s2[1]; }
    const float mm = fmaxf(mg[0], fmaxf(mg[1], mg[2]));
    float wg[3], ws_ = 0.f;
#pragma unroll
    for (int g = 0; g < 3; ++g) { wg[g] = exp2f(mg[g] - mm) * lg[g]; ws_ += wg[g]; }
    const float inv = 1.f / ws_;
#pragma unroll
    for (int e = 0; e < 8; ++e) o[e] = 0.f;
#pragma unroll
    for (int g = 0; g < 3; ++g) {
      float t[8]; unpk8(*(const bf16x8*)((const bf16_t*)(ws + O_OB + g * SZ_O) + (size_t)tok * 384 + c), t);
      const float wgi = wg[g] * inv;
#pragma unroll
      for (int e = 0; e < 8; ++e) o[e] += wgi * t[e];
    }
  } else if (n == 3) {
    const int hh = c >> 6;
    const f32x4 sq = *(const f32x4*)((const float*)(ws + O_SSQ) + ((size_t)tok * 6 + hh) * 4);
    const float rs = rsqrtf((sq[0] + sq[1] + sq[2] + sq[3]) * (1.f / 64.f) + 1e-6f);
    unpk8(*(const bf16x8*)((const bf16_t*)(ws + O_OD) + (size_t)tok * 384 + c), o);
    const float* gw = p.gdn_w + layer * 64 + (c & 63);
#pragma unroll
    for (int e = 0; e < 8; ++e) o[e] *= rs * gw[e];
  } else if (n == 0) {
    const int hh = c >> 6;
    const float* st = (const float*)(ws + O_STA);
    float mg[4], lg[4], mm = -1e30f;
#pragma unroll
    for (int g = 0; g < 4; ++g) { const f32x2 s2 = *(const f32x2*)(st + ((size_t)(g * TH + tok) * 6 + hh) * 2); mg[g] = s2[0]; lg[g] = s2[1]; mm = fmaxf(mm, mg[g]); }
    float wg[4], ws_ = 0.f;
#pragma unroll
    for (int g = 0; g < 4; ++g) { wg[g] = exp2f(mg[g] - mm) * lg[g]; ws_ += wg[g]; }
    const float inv = 1.f / ws_;
#pragma unroll
    for (int e = 0; e < 8; ++e) o[e] = 0.f;
#pragma unroll
    for (int g = 0; g < 4; ++g) {
      if (lg[g] > 0.f) {
        float t[8]; unpk8(*(const bf16x8*)((const bf16_t*)(ws + O_OA + g * SZ_O) + (size_t)tok * 384 + c), t);
        const float wgi = wg[g] * inv;
#pragma unroll
        for (int e = 0; e < 8; ++e) o[e] += wgi * t[e];
      }
    }
  } else {
    const size_t off = (n == 2) ? O_OC : O_OE;
    unpk8(*(const bf16x8*)((const bf16_t*)(ws + off) + (size_t)tok * 384 + c), o);
  }
#pragma unroll
  for (int e = 0; e < 8; ++e) o[e] *= z[e];
  *(bf16x8*)szp = pk8(o);
}

DI void p4a_tile(const Params& p, int layer, int mt, int nt, unsigned char* smem) {
  __syncthreads();
  bf16_t* As = (bf16_t*)smem; bf16_t* Bs = As + 2 * 9216;
  const int tid = otid(), lane = tid & 63, wave = tid >> 6, wr = wave >> 1, wc = wave & 1, r = lane & 31, h = lane >> 5;
  const int m0 = mt * 128, n0 = nt * 128;
  f32x16 tot[2][2]; zero_acc(tot);
  const bf16_t* SIG = (const bf16_t*)(p.ws + O_SIG);
  for (int n = 0; n < 5; ++n) {
    f32x16 acc[2][2]; zero_acc(acc);
    PlainA al{(const bf16_t*)(p.ws + O_SZ) + n * 384, 1920};
    gemm_kloop_t<32>(al, (const bf16_t*)(p.ws + O_WTBR) + (size_t)(layer * 5 + n) * 1024 * 384, 384, 12, m0, n0, acc, As, Bs);
#pragma unroll
    for (int mi = 0; mi < 2; ++mi) {
      const int tok = m0 + wr * 64 + mi * 32 + r;
#pragma unroll
      for (int ni = 0; ni < 2; ++ni)
#pragma unroll
        for (int g = 0; g < 4; ++g) {
          const int col = n0 + wc * 64 + ni * 32 + 8 * g + 4 * h;
          const u32x2 sg = *(const u32x2*)(SIG + (size_t)tok * 5120 + n * 1024 + col);
          tot[mi][ni][4 * g] += bflo(sg.x) * acc[mi][ni][4 * g];
          tot[mi][ni][4 * g + 1] += bfhi(sg.x) * acc[mi][ni][4 * g + 1];
          tot[mi][ni][4 * g + 2] += bflo(sg.y) * acc[mi][ni][4 * g + 2];
          tot[mi][ni][4 * g + 3] += bfhi(sg.y) * acc[mi][ni][4 * g + 3];
          asm volatile("" ::: "memory");
        }
    }
  }
  bf16_t* YM = (bf16_t*)(p.ws + O_YM);
  {
    bf16_t* stg = (bf16_t*)smem + wave * (64 * 72);
#pragma unroll
    for (int ni = 0; ni < 2; ++ni)
#pragma unroll
      for (int mi = 0; mi < 2; ++mi)
#pragma unroll
        for (int g = 0; g < 4; ++g)
          *(u32x2*)(stg + (mi * 32 + r) * 72 + ni * 32 + 8 * g + 4 * h) = pk4(tot[mi][ni][4 * g], tot[mi][ni][4 * g + 1], tot[mi][ni][4 * g + 2], tot[mi][ni][4 * g + 3]);
    asm volatile("s_waitcnt lgkmcnt(0)" ::: "memory");
    __builtin_amdgcn_wave_barrier();
    const int tok0 = m0 + wr * 64, col0 = n0 + wc * 64;
#pragma unroll
    for (int it = 0; it < 8; ++it) {
      const int row = it * 8 + (lane >> 3), ch = (lane & 7) * 8;
      const bf16x8 val = *(const bf16x8*)(stg + row * 72 + ch);
      *(bf16x8*)(YM + (size_t)(tok0 + row) * 1024 + col0 + ch) = val;
    }
  }
}

DI void p4b_tile(const Params& p, int layer, int half, int mt, int nt, unsigned char* smem) {
  bf16_t* As = (bf16_t*)smem; bf16_t* Bs = As + 2 * 9216;
  const int tid = otid(), lane = tid & 63, wave = tid >> 6, wr = wave >> 1, wc = wave & 1, r = lane & 31, h = lane >> 5;
  const int m0 = mt * 128, n0 = nt * 128;
  f32x16 acc[2][2]; zero_acc(acc);
  PlainA al{(const bf16_t*)(p.ws + O_YM), 1024};
  gemm_kloop(al, (const bf16_t*)(p.ws + O_WTOUT + layer * SZ_WTOUT1), 1024, 16, m0, n0, acc, As, Bs);
  const float* xin = layer == 0 ? p.x : p.out;
  const float alpha = 1.4142135623730951f;
#pragma unroll
  for (int mi = 0; mi < 2; ++mi) {
    const size_t gt = (size_t)half * TH + m0 + wr * 64 + mi * 32 + r;
#pragma unroll
    for (int ni = 0; ni < 2; ++ni)
#pragma unroll
      for (int g = 0; g < 4; ++g) {
        const int col = n0 + wc * 64 + ni * 32 + 8 * g + 4 * h;
        const f32x4 xv = *(const f32x4*)(xin + gt * 1024 + col);
        f32x4 o;
#pragma unroll
        for (int e = 0; e < 4; ++e) o[e] = alpha * xv[e] + acc[mi][ni][4 * g + e];
        *(f32x4*)(p.out + gt * 1024 + col) = o;
      }
  }
}

DI void p4c_row(const Params& p, int layer, size_t gt, bool wxb = true) {
  const int lane = otid() & 63;
  float* row = p.out + gt * 1024;
  f32x4 v[4]; float s = 0.f;
#pragma unroll
  for (int j = 0; j < 4; ++j) { v[j] = *(const f32x4*)(row + 4 * lane + 256 * j); s += v[j][0] + v[j][1] + v[j][2] + v[j][3]; }
#pragma unroll
  for (int o = 32; o >= 1; o >>= 1) s += __shfl_xor(s, o);
  const float mu = s * (1.f / 1024.f); float q = 0.f;
#pragma unroll
  for (int j = 0; j < 4; ++j) { v[j] -= mu; q += v[j][0] * v[j][0] + v[j][1] * v[j][1] + v[j][2] * v[j][2] + v[j][3] * v[j][3]; }
#pragma unroll
  for (int o = 32; o >= 1; o >>= 1) q += __shfl_xor(q, o);
  const float rs = rsqrtf(q * (1.f / 1024.f) + 1e-5f);
  bf16_t* xb = (bf16_t*)(p.ws + O_XB) + gt * 1024;
#pragma unroll
  for (int j = 0; j < 4; ++j) {
    const int c = 4 * lane + 256 * j;
    const f32x4 g = *(const f32x4*)(p.ln_g + layer * 1024 + c), b = *(const f32x4*)(p.ln_b + layer * 1024 + c);
    f32x4 y;
#pragma unroll
    for (int e = 0; e < 4; ++e) y[e] = v[j][e] * rs * g[e] + b[e];
    *(f32x4*)(row + c) = y;
    if (wxb) *(u32x2*)(xb + c) = pk4(y[0], y[1], y[2], y[3]);
  }
}


#define XB_TMO      128
#define XB_XCNT(j)  (256  + 64 * (j))
#define XB_XSUB(j)  (1280 + 64 * (j))
#define XB_XGEN(j)  (2304 + 64 * (j))
#define XB_TOP      3328
#define XB_TOPGEN   3392
#define XB_SPIN_CAP (1u << 22)
#define LAS __attribute__((address_space(3)))
DI unsigned xb_ld(unsigned* p) { return __hip_atomic_load(p, __ATOMIC_RELAXED, __HIP_MEMORY_SCOPE_AGENT); }
DI unsigned xb_add(unsigned* p, unsigned v) { return __hip_atomic_fetch_add(p, v, __ATOMIC_RELAXED, __HIP_MEMORY_SCOPE_AGENT); }
DI unsigned xb_xcc_id() { return (unsigned)__builtin_amdgcn_s_getreg((3 << 11) | 20) & 0xFu; }
#define XB_SPIN(cond, bar) do { unsigned _sp = 0; while (cond) { __builtin_amdgcn_s_sleep(1); \
    if ((++_sp & 255u) == 0u) { if (xb_ld(&(bar)[XB_TMO])) break; if (_sp > XB_SPIN_CAP) { atomicAdd(&(bar)[XB_TMO], 1u); break; } } } } while (0)
struct XcdBarrier { unsigned* bar; unsigned x; volatile LAS unsigned* st; };
DI XcdBarrier xcd_barrier_post(unsigned* bar, volatile LAS unsigned* st) {
  XcdBarrier b; b.bar = bar; b.x = xb_xcc_id(); b.st = st;
  if (threadIdx.x == 0) (void)xb_add(&bar[XB_XCNT(b.x)], 1u);
  return b;
}
DI void xcd_barrier_complete(unsigned* bar, unsigned x, unsigned& nloc, unsigned& nx) {
  const unsigned G = gridDim.x;
  unsigned sum, cnt, mine, sp = 0u;
  for (;;) {
    sum = 0u; cnt = 0u; mine = 0u;
#pragma unroll
    for (unsigned j = 0; j < 16; ++j) { const unsigned c = xb_ld(&bar[XB_XCNT(j)]); sum += c; cnt += (c > 0u) ? 1u : 0u; mine = (j == x) ? c : mine; }
    if (sum == G) break;
    __builtin_amdgcn_s_sleep(1);
    if ((++sp & 255u) == 0u) { if (xb_ld(&bar[XB_TMO])) break; if (sp > XB_SPIN_CAP) { atomicAdd(&bar[XB_TMO], 1u); break; } }
  }
  nloc = mine > 0u ? mine : 1u; nx = cnt > 0u ? cnt : 1u;
}
DI void xcd_barrier(const XcdBarrier& b) {
  asm volatile("s_waitcnt vmcnt(0)" ::: "memory");
  __syncthreads();
  if (threadIdx.x == 0) {
    unsigned* bar = b.bar;
    __builtin_amdgcn_s_waitcnt(0);
    unsigned nloc = b.st[0], nx = b.st[1];
    if (nloc == 0u) { xcd_barrier_complete(bar, b.x, nloc, nx); b.st[0] = nloc; b.st[1] = nx; }
    const unsigned old = xb_add(&bar[XB_XSUB(b.x)], 1u);
    const unsigned gen = old / nloc;
    if (old + 1u == (gen + 1u) * nloc) {
      __builtin_amdgcn_fence(__ATOMIC_RELEASE, "agent");
      asm volatile("s_waitcnt vmcnt(0)" ::: "memory");
      const unsigned og = xb_add(&bar[XB_TOP], 1u);
      const unsigned tg = og / nx;
      if (og + 1u == (tg + 1u) * nx) xb_add(&bar[XB_TOPGEN], 1u);
      else XB_SPIN(xb_ld(&bar[XB_TOPGEN]) == tg, bar);
      __builtin_amdgcn_fence(__ATOMIC_ACQUIRE, "agent");
      xb_add(&bar[XB_XGEN(b.x)], 1u);
      asm volatile("s_waitcnt vmcnt(0)" ::: "memory");
    } else {
      XB_SPIN(xb_ld(&bar[XB_XGEN(b.x)]) == gen, bar);
      __builtin_amdgcn_fence(__ATOMIC_ACQUIRE, "agent");
      asm volatile("s_waitcnt vmcnt(0)" ::: "memory");
    }
  }
  __syncthreads();
}

#ifdef PROBE_A
#define STAMP(k) do { if (blockIdx.x == 0 && otid() == 0) { unsigned long long now_ = __builtin_amdgcn_s_memrealtime(); tsacc[k] += (float)(now_ - tlast) * 0.01f; tlast = now_; } } while (0)
#else
#define STAMP(k) do {} while (0)
#endif
__global__ void __launch_bounds__(256, 2) mega(Params p) {
#ifdef PROBE_A
  float tsacc[8] = {0.f, 0.f, 0.f, 0.f, 0.f, 0.f, 0.f, 0.f};
  unsigned long long tlast = __builtin_amdgcn_s_memrealtime();
#endif
  extern __shared__ __attribute__((aligned(16))) unsigned char smem[];
  cg::grid_group grid = cg::this_grid();
  if (p.ws == nullptr) grid.sync();
  volatile LAS unsigned* xbst = (volatile LAS unsigned*)(smem + 75776);
  if (threadIdx.x < 4) xbst[threadIdx.x] = 0u;
  __syncthreads();
  const XcdBarrier xb = xcd_barrier_post((unsigned*)(p.ws + O_BAR), xbst);
#define GSYNC() xcd_barrier(xb)
  const int wave = otid() >> 6;
  const int gw = blockIdx.x * 4 + wave, ngw = gridDim.x * 4;
  for (int rep = 0; rep < REP(0); ++rep) phase0(p, smem);
  GSYNC(); STAMP(0);
#ifndef REPEAT_ITER
#define REPEAT_ITER 0
#endif
#ifndef EXTRA_UPTO
#define EXTRA_UPTO 7
#endif
#ifndef EXTRA_P3_LIMIT
#define EXTRA_P3_LIMIT (1 << 30)
#endif
  int pend_layer = -1, pend_half = 0; bool pend_wxb = true;
  for (int itn = -REPEAT_ITER; itn < 4; ++itn) {
    const int layer = itn < 0 ? 0 : (itn >> 1), half = itn < 0 ? 0 : (itn & 1);
    {
      if (pend_layer >= 0) { for (int rw = gw; rw < TH; rw += ngw) { if (PH(12)) p4c_row(p, pend_layer, (size_t)pend_half * TH + rw, pend_wxb); } pend_layer = -1; }
      for (int rep = 0; rep < REP(1); ++rep) for (int t = blockIdx.x; t < 64 * 107; t += gridDim.x) { if (PH(1)) p1_tile(p, layer, half, t % 64, t / 64, smem); }
      GSYNC(); STAMP(1);
      if (itn < 0 && EXTRA_UPTO <= 1) continue;
      {
        constexpr int N_FOX = 6, N_GDN = 768, N_MKV = 12, N_KM = 48, TOT = N_FOX + N_GDN + N_MKV + N_KM;
        for (int rep = 0; rep < REP(2); ++rep) for (int t = blockIdx.x; t < TOT; t += gridDim.x) {
          int i = t;
          if (i < N_FOX) { if (PH(2)) fox_prep(p, i, smem); continue; }
          i -= N_FOX;
          if (i < N_GDN) { if (PH(3)) gdn_prep(p, layer, half, i / 128, i % 128, smem); continue; }
          i -= N_GDN;
          if (i < N_MKV) { if (PH(4)) memkv_tile(p, layer, half, i / 6, i % 6, smem); continue; }
          i -= N_MKV;
          if (PH(4)) kmean_prep(p, i * 4 + wave, (unsigned*)(p.ws + O_CTL) + 64 + (layer * 2 + half) * 8);
        }
      }
      GSYNC(); STAMP(2);
      if (itn < 0 && EXTRA_UPTO <= 2) continue;
#ifndef NO_SELECT
      for (int a = gw; a < 1536; a += ngw) moba_select(p, a);
#endif
      GSYNC();
      for (int rep = 0; rep < REP(3); ++rep) phase3(p, half, (unsigned*)(p.ws + O_CTL) + rep * 8 + (itn < 0 ? 16 - itn : layer * 2 + half), (const unsigned*)(p.ws + O_CTL) + 64 + (layer * 2 + half) * 8, smem, itn < 0 ? EXTRA_P3_LIMIT : (1 << 30));
      GSYNC(); STAMP(3);
      if (itn < 0 && EXTRA_UPTO <= 3) continue;
      if (PH(13)) for (int ci = blockIdx.x * 256 + otid(); ci < TH * 240; ci += gridDim.x * 256) gbuild_chunk(p, layer, ci / 240, ci % 240);
      GSYNC(); STAMP(4);
      for (int rep = 0; rep < REP(5); ++rep) for (int t = blockIdx.x; t < 512; t += gridDim.x) { if (PH(10)) p4a_tile(p, layer, t % 64, t / 64, smem); }
      GSYNC(); STAMP(5);
      for (int t = blockIdx.x; t < 512; t += gridDim.x) { if (PH(11)) p4b_tile(p, layer, half, t % 64, t / 64, smem); }
      GSYNC(); STAMP(6);
      pend_layer = layer; pend_half = half; pend_wxb = (itn >= 0);
    }
  }
  if (pend_layer >= 0) { for (int rw = gw; rw < TH; rw += ngw) { if (PH(12)) p4c_row(p, pend_layer, (size_t)pend_half * TH + rw, pend_wxb); } }
#ifdef EXTRA_SYNCS
  for (int i = 0; i < EXTRA_SYNCS; ++i) GSYNC();
#endif
#ifdef PROBE_A
  if (blockIdx.x == 0) {
    const float va = tsacc[PROBE_A] * 100.f, vb = tsacc[PROBE_B];
    for (int i = otid(); i < (1 << 20); i += 256) p.out[(size_t)4096 * 1024 + i] = vb;
    if (otid() == 0) p.out[0] = va;
  }
#endif
}

extern "C" void kernel_launch(void* const* d_in, const int* in_sizes, int n_in, void* d_out, int out_size, void* d_ws, size_t ws_size,
                              hipStream_t stream) {
  static int grid_blocks = 0;
  if (grid_blocks == 0) {
    if (ws_size < WS_END) { fprintf(stderr, "workspace too small: %zu < %zu\n", ws_size, (size_t)WS_END); grid_blocks = -1; return; }
    int dev = 0, cus = 0, per_cu = 0;
    (void)hipGetDevice(&dev);
    (void)hipDeviceGetAttribute(&cus, hipDeviceAttributeMultiprocessorCount, dev);
    (void)hipFuncSetAttribute((const void*)mega, hipFuncAttributeMaxDynamicSharedMemorySize, LDS_BYTES);
    (void)hipOccupancyMaxActiveBlocksPerMultiprocessor(&per_cu, (const void*)mega, 256, LDS_BYTES);
    if (per_cu < 1) per_cu = 1;
    if (per_cu > 2) per_cu = 2;
    grid_blocks = cus * per_cu;
  }
  if (grid_blocks < 0) return;
  (void)hipMemsetAsync((char*)d_ws + O_CTL, 0, 32768, stream);
  Params p{};
  p.x = (const float*)d_in[0]; p.mem = (const float*)d_in[1]; p.mem_g = (const float*)d_in[2]; p.mem_b = (const float*)d_in[3];
  p.w_in = (const float*)d_in[4]; p.b_in = (const float*)d_in[5]; p.conv_w = (const float*)d_in[6]; p.a_log = (const float*)d_in[7];
  p.dt_bias = (const float*)d_in[8]; p.gdn_w = (const float*)d_in[9]; p.w_kv = (const float*)d_in[10]; p.w_br = (const float*)d_in[11];
  p.w_out = (const float*)d_in[12]; p.ln_g = (const float*)d_in[13]; p.ln_b = (const float*)d_in[14];
  p.out = (float*)d_out; p.ws = (unsigned char*)d_ws;
  void* args[] = {&p};
  hipError_t e = hipLaunchCooperativeKernel((const void*)mega, dim3(grid_blocks), dim3(256), args, LDS_BYTES, stream);
  if (e != hipSuccess) fprintf(stderr, "cooperative launch failed: %s (grid %d)\n", hipGetErrorString(e), grid_blocks);
}
```

```cpp
#include <hip/hip_runtime.h>
#include <hip/hip_cooperative_groups.h>
#include <cstdio>
#include <cstdint>
namespace cg = cooperative_groups;

#define DI __device__ __forceinline__
typedef unsigned short bf16_t;
typedef short bf16x8 __attribute__((ext_vector_type(8)));
typedef short s16x4 __attribute__((ext_vector_type(4)));
typedef float f32x4 __attribute__((ext_vector_type(4)));
typedef float f32x2 __attribute__((ext_vector_type(2)));
typedef float f32x16 __attribute__((ext_vector_type(16)));
typedef unsigned u32x2 __attribute__((ext_vector_type(2)));
typedef unsigned u32x4 __attribute__((ext_vector_type(4)));
typedef __bf16 bfv2 __attribute__((ext_vector_type(2)));

#define MFMA32(a, b, c) __builtin_amdgcn_mfma_f32_32x32x16_bf16((a), (b), (c), 0, 0, 0)
#define MFMA16(a, b, c) __builtin_amdgcn_mfma_f32_16x16x32_bf16((a), (b), (c), 0, 0, 0)

DI unsigned pk2(float a, float b) { f32x2 v = {a, b}; return __builtin_bit_cast(unsigned, __builtin_convertvector(v, bfv2)); }
DI bf16_t f2bf(float a) { return (bf16_t)(pk2(a, 0.f) & 0xffffu); }
DI float bf2f(bf16_t v) { return __uint_as_float(((unsigned)v) << 16); }
DI float bflo(unsigned u) { return __uint_as_float(u << 16); }
DI float bfhi(unsigned u) { return __uint_as_float(u & 0xffff0000u); }
DI int otid() { int t = __builtin_amdgcn_workitem_id_x(); asm volatile("" : "+v"(t)); return t; }
DI int crow(int i, int h) { return (i & 3) + 8 * (i >> 2) + 4 * h; }
DI float fsigmoid(float v) { return __builtin_amdgcn_rcpf(1.f + __expf(-v)); }
DI float fsilu(float v) { return v * fsigmoid(v); }
DI u32x2 pk4(float a, float b, float c, float d) { u32x2 r; r.x = pk2(a, b); r.y = pk2(c, d); return r; }
DI bf16x8 pk8(const float* v) { u32x4 r; r.x = pk2(v[0], v[1]); r.y = pk2(v[2], v[3]); r.z = pk2(v[4], v[5]); r.w = pk2(v[6], v[7]); return __builtin_bit_cast(bf16x8, r); }
DI void unpk8(bf16x8 x, float* v) { u32x4 u = __builtin_bit_cast(u32x4, x); v[0] = bflo(u.x); v[1] = bfhi(u.x); v[2] = bflo(u.y); v[3] = bfhi(u.y); v[4] = bflo(u.z); v[5] = bfhi(u.z); v[6] = bflo(u.w); v[7] = bfhi(u.w); }

constexpr int NB = 2, SQ = 8192, NT = NB * SQ, DM = 1024, NH = 6, BW = 384;
constexpr int TH = 8192;
constexpr int NP = 13696;
constexpr int DIN = 13586;
constexpr float LOG2E = 1.4426950408889634f;
#define NEG_INF (-__builtin_inff())

constexpr int C_AQK = 0, C_AV = 768, C_BQK = 1152, C_BV = 3456, C_CQK = 3840, C_CV = 4608, C_D = 4992, C_E = 6144, C_SM = 6528, C_SMEND = 6546, C_Z = 6656, C_MG = 8576;

__host__ __device__ constexpr int inmap(int n) {
  return n < 4992 ? n : n < 6144 ? n + 6 : n < 6528 ? n + 18 : n < 6534 ? n - 1536 : n < 6546 ? n - 384 : n < 6656 ? -1 : n - 110;
}

constexpr size_t O_CTL = 0;
constexpr size_t O_BAR = 4096;
constexpr size_t O_WTIN = 32768;
constexpr size_t SZ_WTIN1 = (size_t)NP * 1024 * 2;
constexpr size_t O_WTBR = O_WTIN + 2 * SZ_WTIN1;
constexpr size_t SZ_WTBR1 = (size_t)5 * 1024 * 384 * 2;
constexpr size_t O_WTOUT = O_WTBR + 2 * SZ_WTBR1;
constexpr size_t SZ_WTOUT1 = (size_t)1024 * 1024 * 2;
constexpr size_t O_WTKV = O_WTOUT + 2 * SZ_WTOUT1;
constexpr size_t SZ_WTKV1 = (size_t)768 * 1024 * 2;
constexpr size_t O_BIASP = O_WTKV + 2 * SZ_WTKV1;
constexpr size_t O_XB = O_BIASP + (size_t)2 * NP * 4;
constexpr size_t O_MEMN = O_XB + (size_t)NT * 1024 * 2;
constexpr size_t O_MEMK = O_MEMN + (size_t)512 * 1024 * 2;
constexpr size_t O_MEMVT = O_MEMK + (size_t)512 * 384 * 2;
constexpr size_t O_QKA = O_MEMVT + (size_t)512 * 384 * 2;
constexpr size_t SZ_VT = (size_t)384 * TH * 2;
constexpr size_t O_KFA = O_QKA + SZ_VT;
constexpr size_t O_VTA = O_KFA + SZ_VT;
constexpr size_t O_QKB = O_VTA + SZ_VT;
constexpr size_t O_KFB = O_QKB + 3 * SZ_VT;
constexpr size_t O_VTB = O_KFB + 3 * SZ_VT;
constexpr size_t O_QKC = O_VTB + 3 * SZ_VT;
constexpr size_t O_KFC = O_QKC + SZ_VT;
constexpr size_t O_VTC = O_KFC + SZ_VT;
constexpr size_t O_QKVD = O_VTC + SZ_VT;
constexpr size_t O_QE = O_QKVD + (size_t)TH * 1152 * 2;
constexpr size_t O_SM = O_QE + (size_t)TH * 384 * 2;
constexpr size_t O_FF = O_SM + (size_t)TH * 32 * 4;
constexpr size_t O_KM = O_FF + (size_t)6 * TH * 4;
constexpr size_t O_KMAX = O_KM + (size_t)2 * 6 * 32 * 64 * 2;
constexpr size_t O_GL = O_KMAX + 256;
constexpr size_t O_MASK = O_GL + 6 * 128 * 4;
constexpr size_t O_DPREP = O_MASK + (size_t)TH * 8 * 4;
constexpr size_t O_SZ = O_DPREP + (size_t)768 * 32768;
constexpr size_t O_SIG = O_SZ + (size_t)TH * 1920 * 2;
constexpr size_t O_OA = O_SIG + (size_t)TH * 5120 * 2;
constexpr size_t SZ_O = (size_t)TH * 384 * 2;
constexpr size_t O_STA = O_OA + 4 * SZ_O;
constexpr size_t O_OB = O_STA + (size_t)4 * TH * 6 * 2 * 4;
constexpr size_t O_STB = O_OB + 3 * SZ_O;
constexpr size_t O_OC = O_STB + (size_t)3 * TH * 6 * 2 * 4;
constexpr size_t O_OD = O_OC + SZ_O;
constexpr size_t O_SSQ = O_OD + SZ_O;
constexpr size_t O_OE = O_SSQ + (size_t)TH * 6 * 4 * 4;
constexpr size_t WS_END = O_OE + SZ_O;
constexpr size_t O_YM = O_QKB;
static_assert(WS_END < (size_t)443 * 1000 * 1000, "workspace too large");

struct Params {
  const float *x, *mem, *mem_g, *mem_b, *w_in, *b_in, *conv_w, *a_log, *dt_bias, *gdn_w, *w_kv, *w_br, *w_out, *ln_g, *ln_b;
  float* out;
  unsigned char* ws;
};

constexpr int LDS_BYTES = 75776 + 16;
#ifndef PH_MASK
#define PH_MASK 0xFFFF
#endif
#define PH(x) ((PH_MASK >> (x)) & 1)
#ifndef REP_MASK
#define REP_MASK 0
#endif
#define REP(x) (1 + ((REP_MASK >> (x)) & 1))

DI void transpose_tile(const float* __restrict__ src, int ld, int k0, int n0, bool usemap, bf16_t* __restrict__ dst, int dstld, float* tile) {
  const int tid = otid();
#pragma unroll
  for (int it = 0; it < 16; ++it) {
    const int kk = (tid >> 6) + 4 * it, n2 = (tid & 63) * 2;
    const int sc = usemap ? inmap(n0 + n2) : (n0 + n2);
    f32x2 v = {0.f, 0.f};
    if (sc >= 0) v = *(const f32x2*)(src + (size_t)(k0 + kk) * ld + sc);
    *(f32x2*)(tile + kk * 130 + n2) = v;
  }
  __syncthreads();
#pragma unroll
  for (int it = 0; it < 4; ++it) {
    const int nn = (tid >> 3) + 32 * it, kc = (tid & 7) * 8;
    float v[8];
#pragma unroll
    for (int e = 0; e < 8; ++e) v[e] = tile[(kc + e) * 130 + nn];
    *(bf16x8*)(dst + (size_t)(n0 + nn) * dstld + k0 + kc) = pk8(v);
  }
  __syncthreads();
}

DI void phase0(const Params& p, unsigned char* smem) {
  float* tile = (float*)smem;
  const int tid = otid(), lane = tid & 63, wave = tid >> 6;
  constexpr int N_TIN = 2 * 107 * 16, N_TBR = 2 * 5 * 8 * 6, N_TOUT = 2 * 8 * 16, N_TKV = 2 * 6 * 16, N_XB = 1024, N_MEMN = 128, N_BIAS = 107;
  constexpr int TOT = N_TIN + N_TBR + N_TOUT + N_TKV + N_XB + N_MEMN + N_BIAS;
  for (int it = blockIdx.x; it < TOT; it += gridDim.x) {
    int i = it;
    if (i < N_TIN) {
      const int l = i / (107 * 16), rr = i % (107 * 16), nt = rr / 16, kt = rr % 16;
      transpose_tile(p.w_in + (size_t)l * 1024 * DIN, DIN, kt * 64, nt * 128, true, (bf16_t*)(p.ws + O_WTIN + l * SZ_WTIN1), 1024, tile);
      continue;
    }
    i -= N_TIN;
    if (i < N_TBR) {
      const int ln = i / 48, rr = i % 48, nt = rr / 6, kt = rr % 6;
      transpose_tile(p.w_br + (size_t)ln * 384 * 1024, 1024, kt * 64, nt * 128, false, (bf16_t*)(p.ws + O_WTBR) + (size_t)ln * 1024 * 384, 384, tile);
      continue;
    }
    i -= N_TBR;
    if (i < N_TOUT) {
      const int l = i / 128, rr = i % 128, nt = rr / 16, kt = rr % 16;
      transpose_tile(p.w_out + (size_t)l * 1024 * 1024, 1024, kt * 64, nt * 128, false, (bf16_t*)(p.ws + O_WTOUT + l * SZ_WTOUT1), 1024, tile);
      continue;
    }
    i -= N_TOUT;
    if (i < N_TKV) {
      const int l = i / 96, rr = i % 96, nt = rr / 16, kt = rr % 16;
      transpose_tile(p.w_kv + (size_t)l * 1024 * 768, 768, kt * 64, nt * 128, false, (bf16_t*)(p.ws + O_WTKV + l * SZ_WTKV1), 1024, tile);
      continue;
    }
    i -= N_TKV;
    if (i < N_XB) {
      const float* src = p.x + (size_t)i * 16 * 1024;
      bf16_t* dst = (bf16_t*)(p.ws + O_XB) + (size_t)i * 16 * 1024;
#pragma unroll
      for (int j = 0; j < 16; ++j) {
        const int e = (j * 256 + tid) * 4;
        const f32x4 v = *(const f32x4*)(src + e);
        *(u32x2*)(dst + e) = pk4(v[0], v[1], v[2], v[3]);
      }
      continue;
    }
    i -= N_XB;
    if (i < N_MEMN) {
      const int row = i * 4 + wave;
      const float* src = p.mem + (size_t)row * 1024;
      f32x4 v[4]; float s = 0.f;
#pragma unroll
      for (int j = 0; j < 4; ++j) { v[j] = *(const f32x4*)(src + 4 * lane + 256 * j); s += v[j][0] + v[j][1] + v[j][2] + v[j][3]; }
#pragma unroll
      for (int o = 32; o >= 1; o >>= 1) s += __shfl_xor(s, o);
      const float mu = s * (1.f / 1024.f); float q = 0.f;
#pragma unroll
      for (int j = 0; j < 4; ++j) { v[j] -= mu; q += v[j][0] * v[j][0] + v[j][1] * v[j][1] + v[j][2] * v[j][2] + v[j][3] * v[j][3]; }
#pragma unroll
      for (int o = 32; o >= 1; o >>= 1) q += __shfl_xor(q, o);
      const float rs = rsqrtf(q * (1.f / 1024.f) + 1e-5f);
      bf16_t* dst = (bf16_t*)(p.ws + O_MEMN) + (size_t)row * 1024;
#pragma unroll
      for (int j = 0; j < 4; ++j) {
        const int c = 4 * lane + 256 * j;
        const f32x4 g = *(const f32x4*)(p.mem_g + c), b = *(const f32x4*)(p.mem_b + c);
        *(u32x2*)(dst + c) = pk4(v[j][0] * rs * g[0] + b[0], v[j][1] * rs * g[1] + b[1], v[j][2] * rs * g[2] + b[2], v[j][3] * rs * g[3] + b[3]);
      }
      continue;
    }
    i -= N_MEMN;
    {
      float* bp = (float*)(p.ws + O_BIASP);
      if (tid < 128) {
        const int n = i * 128 + tid;
        const int sc = inmap(n);
        for (int l = 0; l < 2; ++l) bp[l * NP + n] = sc >= 0 ? p.b_in[l * DIN + sc] : 0.f;
      }
    }
  }
}

template <int BK, class AL>
DI void gemm_kloop_t(const AL& al, const bf16_t* __restrict__ Bt, int ldb, int nkt, int m0, int n0, f32x16 (&acc)[2][2], bf16_t* As, bf16_t* Bs) {
  constexpr int CPR = BK / 8, NCH = BK / 16, PITCH = BK + 8, BUF = 128 * PITCH;
  const int tid = otid(), lane = tid & 63, wave = tid >> 6, wr = wave >> 1, wc = wave & 1, r = lane & 31, h = lane >> 5;
  bf16x8 ra[NCH], rb[NCH];
  auto gload = [&](int kt) {
#pragma unroll
    for (int i = 0; i < NCH; ++i) {
      const int cid = tid + 256 * i, row = cid / CPR, kc = (cid % CPR) * 8;
      ra[i] = al(m0 + row, kt * BK + kc);
      rb[i] = *(const bf16x8*)(Bt + (size_t)(n0 + row) * ldb + kt * BK + kc);
    }
  };
  auto lstore = [&](int buf) {
#pragma unroll
    for (int i = 0; i < NCH; ++i) {
      const int cid = tid + 256 * i, row = cid / CPR, kc = (cid % CPR) * 8;
      *(bf16x8*)(As + buf * BUF + row * PITCH + kc) = ra[i];
      *(bf16x8*)(Bs + buf * BUF + row * PITCH + kc) = rb[i];
    }
  };
  gload(0); lstore(0); __syncthreads();
  for (int kt = 0; kt < nkt; ++kt) {
    const int buf = kt & 1;
    if (kt + 1 < nkt) gload(kt + 1);
    asm volatile("" ::: "memory");
    const bf16_t* a_ = As + buf * BUF + (wr * 64 + r) * PITCH + 8 * h;
    const bf16_t* b_ = Bs + buf * BUF + (wc * 64 + r) * PITCH + 8 * h;
#pragma unroll
    for (int s = 0; s < BK / 16; ++s) {
      bf16x8 af[2], bfr[2];
      af[0] = *(const bf16x8*)(a_ + 16 * s); af[1] = *(const bf16x8*)(a_ + 32 * PITCH + 16 * s);
      bfr[0] = *(const bf16x8*)(b_ + 16 * s); bfr[1] = *(const bf16x8*)(b_ + 32 * PITCH + 16 * s);
#pragma unroll
      for (int mi = 0; mi < 2; ++mi)
#pragma unroll
        for (int ni = 0; ni < 2; ++ni) acc[mi][ni] = MFMA32(bfr[ni], af[mi], acc[mi][ni]);
    }
    if (kt + 1 < nkt) lstore(buf ^ 1);
    __syncthreads();
  }
}
template <class AL>
DI void gemm_kloop(const AL& al, const bf16_t* __restrict__ Bt, int ldb, int nkt, int m0, int n0, f32x16 (&acc)[2][2], bf16_t* As, bf16_t* Bs) {
  gemm_kloop_t<64>(al, Bt, ldb, nkt, m0, n0, acc, As, Bs);
}

DI void zero_acc(f32x16 (&acc)[2][2]) {
#pragma unroll
  for (int a = 0; a < 2; ++a)
#pragma unroll
    for (int b = 0; b < 2; ++b)
#pragma unroll
      for (int i = 0; i < 16; ++i) acc[a][b][i] = 0.f;
}

DI int vfrag_key(int key) { const int kk = key & 31; return (key >> 5) * 2048 + (kk >> 4) * 512 + ((kk >> 2) & 1) * 256 + ((kk >> 3) & 1) * 4 + (kk & 3); }
DI int vfrag_col(int cw) { const int d = cw & 63; return (cw >> 6) * 524288 + (d >> 5) * 1024 + (d & 31) * 8; }

DI int kfrag_key(int key) { return (key >> 5) * 2048 + (key & 31) * 8; }
DI int kfrag_col(int cw) { const int d = cw & 63; return (cw >> 6) * 524288 + (d >> 4) * 512 + ((d >> 3) & 1) * 256 + (d & 7); }

struct PlainA {
  const bf16_t* A; int lda;
  DI bf16x8 operator()(int row, int k) const { return *(const bf16x8*)(A + (size_t)row * lda + k); }
};

DI void p1_tile(const Params& p, int layer, int half, int mt, int nt, unsigned char* smem) {
  __syncthreads();
  bf16_t* As = (bf16_t*)smem; bf16_t* Bs = As + 2 * 9216;
  f32x16 acc[2][2]; zero_acc(acc);
  PlainA al{(const bf16_t*)(p.ws + O_XB) + (size_t)half * TH * 1024, 1024};
  const int m0 = mt * 128, n0 = nt * 128;
  gemm_kloop(al, (const bf16_t*)(p.ws + O_WTIN + layer * SZ_WTIN1), 1024, 16, m0, n0, acc, As, Bs);
  const int tid = otid(), lane = tid & 63, wave = tid >> 6, wr = wave >> 1, wc = wave & 1, r = lane & 31, h = lane >> 5;
  const float* bias = (const float*)(p.ws + O_BIASP) + layer * NP;
  unsigned char* ws = p.ws;
  {
    const int nb0 = n0 + wc * 64;
    bf16_t* dst0 = nullptr; int pitch0 = 0, coff0 = 0, xf0 = 0;
    if (nb0 < 384) { dst0 = (bf16_t*)(ws + O_QKA); pitch0 = 384; coff0 = nb0; }
    else if (nb0 >= C_BQK && nb0 < 2304) { dst0 = (bf16_t*)(ws + O_QKB); pitch0 = 1152; coff0 = nb0 - C_BQK; }
    else if (nb0 >= C_CQK && nb0 < 4224) { dst0 = (bf16_t*)(ws + O_QKC); pitch0 = 384; coff0 = nb0 - C_CQK; }
    else if (nb0 >= C_D && nb0 < C_E) { dst0 = (bf16_t*)(ws + O_QKVD); pitch0 = 1152; coff0 = nb0 - C_D; }
    else if (nb0 >= C_E && nb0 < C_SM) { dst0 = (bf16_t*)(ws + O_QE); pitch0 = 384; coff0 = nb0 - C_E; }
    else if (nb0 >= C_Z && nb0 < C_MG) { dst0 = (bf16_t*)(ws + O_SZ); pitch0 = 1920; coff0 = nb0 - C_Z; xf0 = 1; }
    else if (nb0 >= C_MG) { dst0 = (bf16_t*)(ws + O_SIG); pitch0 = 5120; coff0 = nb0 - C_MG; xf0 = 2; }
    if (dst0 != nullptr) {
      bf16_t* stg = (bf16_t*)smem + wave * (64 * 72);
#pragma unroll
      for (int ni = 0; ni < 2; ++ni)
#pragma unroll
        for (int mi = 0; mi < 2; ++mi)
#pragma unroll
          for (int g = 0; g < 4; ++g) {
            const int cq = ni * 32 + 8 * g + 4 * h;
            const f32x4 bv = *(const f32x4*)(bias + nb0 + cq);
            float v[4];
#pragma unroll
            for (int e = 0; e < 4; ++e) v[e] = acc[mi][ni][4 * g + e] + bv[e];
            if (xf0 == 1) {
#pragma unroll
              for (int e = 0; e < 4; ++e) v[e] = fsilu(v[e]);
            } else if (xf0 == 2) {
#pragma unroll
              for (int e = 0; e < 4; ++e) v[e] = fsigmoid(v[e]);
            }
            *(u32x2*)(stg + (mi * 32 + r) * 72 + cq) = pk4(v[0], v[1], v[2], v[3]);
          }
      asm volatile("s_waitcnt lgkmcnt(0)" ::: "memory");
      __builtin_amdgcn_wave_barrier();
      const int tok0 = m0 + wr * 64;
#pragma unroll
      for (int it = 0; it < 8; ++it) {
        const int row = it * 8 + (lane >> 3), ch = (lane & 7) * 8;
        const bf16x8 val = *(const bf16x8*)(stg + row * 72 + ch);
        *(bf16x8*)(dst0 + (size_t)(tok0 + row) * pitch0 + coff0 + ch) = val;
      }
      return;
    }
  }
#pragma unroll
  for (int ni = 0; ni < 2; ++ni) {
    const int nb = n0 + wc * 64 + ni * 32;
    int kind;
    int xf = 0;
    bf16_t* dst = nullptr; int pitch = 0, coff = 0;
    int kgrp = 0;
    if (nb < 384) { kind = 0; dst = (bf16_t*)(ws + O_QKA); pitch = 384; coff = nb; }
    else if (nb < C_AV) { kind = 5; dst = (bf16_t*)(ws + O_KFA); coff = nb - 384; }
    else if (nb < C_BQK) { kind = 1; dst = (bf16_t*)(ws + O_VTA); coff = nb - C_AV; }
    else if (nb < 2304) { kind = 0; dst = (bf16_t*)(ws + O_QKB); pitch = 1152; coff = nb - C_BQK; }
    else if (nb < C_BV) { kind = 5; kgrp = (nb - 2304) / 384; dst = (bf16_t*)(ws + O_KFB + kgrp * SZ_VT); coff = (nb - 2304) - kgrp * 384; }
    else if (nb < C_CQK) { kind = 2; dst = (bf16_t*)(ws + O_VTB); coff = nb - C_BV; }
    else if (nb < 4224) { kind = 0; dst = (bf16_t*)(ws + O_QKC); pitch = 384; coff = nb - C_CQK; }
    else if (nb < C_CV) { kind = 5; dst = (bf16_t*)(ws + O_KFC); coff = nb - 4224; }
    else if (nb < C_D) { kind = 1; dst = (bf16_t*)(ws + O_VTC); coff = nb - C_CV; }
    else if (nb < C_E) { kind = 0; dst = (bf16_t*)(ws + O_QKVD); pitch = 1152; coff = nb - C_D; }
    else if (nb < C_SM) { kind = 0; dst = (bf16_t*)(ws + O_QE); pitch = 384; coff = nb - C_E; }
    else if (nb < C_Z) { kind = (nb == C_SM) ? 3 : 4; }
    else if (nb < C_MG) { kind = 0; xf = 1; dst = (bf16_t*)(ws + O_SZ); pitch = 1920; coff = nb - C_Z; }
    else { kind = 0; xf = 2; dst = (bf16_t*)(ws + O_SIG); pitch = 5120; coff = nb - C_MG; }
    if (kind == 4) continue;
#pragma unroll
    for (int mi = 0; mi < 2; ++mi) {
      const int tok = m0 + wr * 64 + mi * 32 + r;
#pragma unroll
      for (int g = 0; g < 4; ++g) {
        const int cq = 8 * g + 4 * h;
        const f32x4 bv = *(const f32x4*)(bias + nb + cq);
        float v[4];
#pragma unroll
        for (int e = 0; e < 4; ++e) v[e] = acc[mi][ni][4 * g + e] + bv[e];
        if (kind == 0) {
          if (xf == 1) {
#pragma unroll
            for (int e = 0; e < 4; ++e) v[e] = fsilu(v[e]);
          } else if (xf == 2) {
#pragma unroll
            for (int e = 0; e < 4; ++e) v[e] = fsigmoid(v[e]);
          }
          *(u32x2*)(dst + (size_t)tok * pitch + coff + cq) = pk4(v[0], v[1], v[2], v[3]);
        } else if (kind == 5) {
          const int key = kgrp == 0 ? tok : kgrp == 1 ? (tok & 3) * 2048 + (tok >> 2) : (tok & 15) * 512 + (tok >> 4);
          *(u32x2*)(dst + kfrag_col(coff + cq) + kfrag_key(key)) = pk4(v[0], v[1], v[2], v[3]);
        } else if (kind == 1) {
          const int ko = vfrag_key(tok);
#pragma unroll
          for (int e = 0; e < 4; ++e) dst[vfrag_col(coff + cq + e) + ko] = f2bf(v[e]);
        } else if (kind == 2) {
          const int k1 = vfrag_key(tok), k4 = vfrag_key((tok & 3) * 2048 + (tok >> 2)), k16 = vfrag_key((tok & 15) * 512 + (tok >> 4));
#pragma unroll
          for (int e = 0; e < 4; ++e) {
            const bf16_t b = f2bf(v[e]); const int co = vfrag_col(coff + cq + e);
            dst[co + k1] = b; dst[SZ_VT / 2 + co + k4] = b; dst[SZ_VT + co + k16] = b;
          }
        } else {
          float* sm = (float*)(ws + O_SM);
#pragma unroll
          for (int e = 0; e < 4; ++e) if (cq + e < 18) sm[tok * 32 + cq + e] = v[e];
        }
      }
    }
  }
}

DI void fox_prep(const Params& p, int hh, unsigned char* smem) {
  float* red = (float*)smem;
  const int tid = otid(), lane = tid & 63, wave = tid >> 6;
  const float* sm = (const float*)(p.ws + O_SM);
  float* FF = (float*)(p.ws + O_FF) + hh * TH;
  float loc[32];
#pragma unroll
  for (int j = 0; j < 32; ++j) loc[j] = sm[(tid * 32 + j) * 32 + hh];
  float s = 0.f;
#pragma unroll
  for (int j = 0; j < 32; ++j) { const float xv = loc[j]; s += fminf(xv, 0.f) - log1pf(expf(-fabsf(xv))); loc[j] = s; }
  float inc = s;
#pragma unroll
  for (int o = 1; o < 64; o <<= 1) { const float t = __shfl_up(inc, o); if (lane >= o) inc += t; }
  if (lane == 63) red[wave] = inc;
  __syncthreads();
  float off = inc - s;
  for (int w = 0; w < wave; ++w) off += red[w];
#pragma unroll
  for (int j4 = 0; j4 < 8; ++j4) {
    f32x4 o4 = {off + loc[4 * j4], off + loc[4 * j4 + 1], off + loc[4 * j4 + 2], off + loc[4 * j4 + 3]};
    *(f32x4*)(FF + tid * 32 + 4 * j4) = o4;
  }
  __syncthreads();
}

DI void kmean_prep(const Params& p, int idx, unsigned* kmaxu) {
  const int lane = otid() & 63;
  const int hh = idx / 32, blk = idx % 32;
  const bf16_t* k = (const bf16_t*)(p.ws + O_KFA) + kfrag_col(hh * 64 + lane) + blk * 8 * 2048;
  float s = 0.f;
#pragma unroll 8
  for (int i = 0; i < 256; ++i) s += bf2f(k[(i >> 5) * 2048 + (i & 31) * 8]);
  s *= (1.f / 256.f);
  const bf16_t hi = f2bf(s);
  bf16_t* km = (bf16_t*)(p.ws + O_KM);
  km[(hh * 32 + blk) * 64 + lane] = hi;
  km[6 * 32 * 64 + (hh * 32 + blk) * 64 + lane] = f2bf(s - bf2f(hi));
  const bf16_t* kc = (const bf16_t*)(p.ws + O_KFC) + (size_t)hh * 524288;
  float mx = 0.f;
#pragma unroll
  for (int t = 0; t < 4; ++t) {
    const int key = blk * 256 + lane * 4 + t;
    float kk = 0.f;
#pragma unroll
    for (int c = 0; c < 8; ++c) { float v[8]; unpk8(*(const bf16x8*)(kc + kfrag_key(key) + c * 256), v);
#pragma unroll
      for (int e = 0; e < 8; ++e) kk += v[e] * v[e]; }
    mx = fmaxf(mx, kk);
  }
#pragma unroll
  for (int o = 32; o >= 1; o >>= 1) mx = fmaxf(mx, __shfl_xor(mx, o));
  if (lane == 0) atomicMax(kmaxu + hh, __float_as_uint(mx));
}

DI void memkv_tile(const Params& p, int layer, int half, int mt, int nt, unsigned char* smem) {
  bf16_t* As = (bf16_t*)smem; bf16_t* Bs = As + 2 * 9216;
  f32x16 acc[2][2]; zero_acc(acc);
  PlainA al{(const bf16_t*)(p.ws + O_MEMN) + (size_t)half * 256 * 1024, 1024};
  const int m0 = mt * 128, n0 = nt * 128;
  gemm_kloop(al, (const bf16_t*)(p.ws + O_WTKV + layer * SZ_WTKV1), 1024, 16, m0, n0, acc, As, Bs);
  const int tid = otid(), lane = tid & 63, wave = tid >> 6, wr = wave >> 1, wc = wave & 1, r = lane & 31, h = lane >> 5;
  bf16_t* mk = (bf16_t*)(p.ws + O_MEMK); bf16_t* mv = (bf16_t*)(p.ws + O_MEMVT);
#pragma unroll
  for (int ni = 0; ni < 2; ++ni)
#pragma unroll
    for (int mi = 0; mi < 2; ++mi) {
      const int m = m0 + wr * 64 + mi * 32 + r;
#pragma unroll
      for (int i = 0; i < 16; ++i) {
        const int col = n0 + wc * 64 + ni * 32 + crow(i, h);
        const bf16_t b = f2bf(acc[mi][ni][i]);
        if (col < 384) { const int hd = col / 96, d = col % 96; mk[(size_t)((half * 4 + hd) * 8 + (m >> 5)) * 3072 + (d >> 4) * 512 + ((d >> 3) & 1) * 256 + (m & 31) * 8 + (d & 7)] = b; }
        else { const int cc = col - 384, hd = cc / 96, d = cc % 96, kk = m & 31;
          mv[(size_t)((half * 4 + hd) * 8 + (m >> 5)) * 3072 + (d >> 5) * 1024 + (kk >> 4) * 512 + ((kk >> 2) & 1) * 256 + (d & 31) * 8 + ((kk >> 3) & 1) * 4 + (kk & 3)] = b; }
      }
    }
}

DI f32x16 mm_quad(const bf16_t* A, const bf16_t* B, int wr, int wc, int r, int h) {
  f32x16 acc;
#pragma unroll
  for (int i = 0; i < 16; ++i) acc[i] = 0.f;
  const bf16_t* a_ = A + (wr * 32 + r) * 72 + 8 * h;
  const bf16_t* b_ = B + (wc * 32 + r) * 72 + 8 * h;
#pragma unroll
  for (int s = 0; s < 4; ++s) acc = MFMA32(*(const bf16x8*)(a_ + 16 * s), *(const bf16x8*)(b_ + 16 * s), acc);
  return acc;
}

DI void gdn_prep(const Params& p, int layer, int half, int hh, int c, unsigned char* smem) {
  bf16_t* QN = (bf16_t*)smem; bf16_t* KN = QN + 4608; bf16_t* KB = KN + 4608; bf16_t* KDT = KB + 4608; bf16_t* VBT = KDT + 4608;
  bf16_t* KBET = VBT + 4608; bf16_t* QKm = KBET + 4608; bf16_t* Tm = QKm + 4608;
  float* gcv = (float*)(smem + 73728); float* betav = gcv + 64; float* egc = gcv + 128;
  float* Mf = (float*)(smem + 9216);
  bf16_t* UT = KN; bf16_t* WT = KB;
  int tid = otid();
  int lane = tid & 63, wave = tid >> 6, wr = wave >> 1, wc = wave & 1, r = lane & 31, h = lane >> 5;
#define REOPAQUE() do { asm volatile("" : "+v"(tid)); lane = tid & 63; wave = tid >> 6; wr = wave >> 1; wc = wave & 1; r = lane & 31; h = lane >> 5; } while (0)
  const float* sm = (const float*)(p.ws + O_SM);
  if (wave == 0) {
    const int tok = c * 64 + lane;
    const float bt = fsigmoid(sm[tok * 32 + 6 + hh]);
    const float xv = sm[tok * 32 + 12 + hh] + p.dt_bias[layer * 6 + hh];
    const float sp = fmaxf(xv, 0.f) + log1pf(expf(-fabsf(xv)));
    float g = -expf(p.a_log[layer * 6 + hh]) * sp;
#pragma unroll
    for (int o = 1; o < 64; o <<= 1) { const float t = __shfl_up(g, o); if (lane >= o) g += t; }
    gcv[lane] = g; betav[lane] = bt; egc[lane] = expf(g);
    if (lane == 63) ((float*)(p.ws + O_GL))[hh * 128 + c] = expf(g);
  }
  __syncthreads();
  REOPAQUE();
  {
    const int t = tid >> 2, cg4 = tid & 3, ch0 = cg4 * 16;
    const bf16_t* src = (const bf16_t*)(p.ws + O_QKVD);
    const float* cw = p.conv_w + (size_t)layer * 4 * 1152;
    const float bt = betav[t], gct = gcv[t], eg = egc[t], ed = expf(gcv[63] - gct);
    auto convpart = [&](int pt, float (&val)[16]) {
      const int col = pt * 384 + hh * 64 + ch0;
#pragma unroll
      for (int e = 0; e < 16; ++e) val[e] = 0.f;
#pragma unroll
      for (int j = 0; j < 4; ++j) {
        const int row = c * 64 + t - 3 + j;
        if (row >= 0) {
          float xv[16];
          unpk8(*(const bf16x8*)(src + (size_t)row * 1152 + col), xv);
          unpk8(*(const bf16x8*)(src + (size_t)row * 1152 + col + 8), xv + 8);
#pragma unroll
          for (int e4 = 0; e4 < 4; ++e4) {
            const f32x4 w4 = *(const f32x4*)(cw + j * 1152 + col + 4 * e4);
#pragma unroll
            for (int e = 0; e < 4; ++e) val[4 * e4 + e] += w4[e] * xv[4 * e4 + e];
          }
        }
      }
#pragma unroll
      for (int e = 0; e < 16; ++e) val[e] = fsilu(val[e]);
    };
    {
      float val[16]; convpart(0, val);
      float sq = 0.f;
#pragma unroll
      for (int e = 0; e < 16; ++e) sq += val[e] * val[e];
      sq += __shfl_xor(sq, 1); sq += __shfl_xor(sq, 2);
      const float rq = rsqrtf(sq + 1e-6f) * 0.125f;
#pragma unroll
      for (int e = 0; e < 16; ++e) val[e] *= rq;
      *(bf16x8*)(QN + t * 72 + ch0) = pk8(val); *(bf16x8*)(QN + t * 72 + ch0 + 8) = pk8(val + 8);
    }
    asm volatile("" ::: "memory");
    {
      float val[16]; convpart(1, val);
      float sk = 0.f;
#pragma unroll
      for (int e = 0; e < 16; ++e) sk += val[e] * val[e];
      sk += __shfl_xor(sk, 1); sk += __shfl_xor(sk, 2);
      const float rk = rsqrtf(sk + 1e-6f);
      float kb[16];
#pragma unroll
      for (int e = 0; e < 16; ++e) { val[e] *= rk; kb[e] = val[e] * bt; }
      *(bf16x8*)(KN + t * 72 + ch0) = pk8(val); *(bf16x8*)(KN + t * 72 + ch0 + 8) = pk8(val + 8);
      *(bf16x8*)(KB + t * 72 + ch0) = pk8(kb); *(bf16x8*)(KB + t * 72 + ch0 + 8) = pk8(kb + 8);
#pragma unroll
      for (int e = 0; e < 16; ++e) {
        KDT[(ch0 + e) * 72 + t] = f2bf(val[e] * ed);
        KBET[(ch0 + e) * 72 + t] = f2bf(kb[e] * eg);
      }
    }
    asm volatile("" ::: "memory");
    {
      float val[16]; convpart(2, val);
#pragma unroll
      for (int e = 0; e < 16; ++e) VBT[(ch0 + e) * 72 + t] = f2bf(val[e] * bt);
    }
  }
  __syncthreads();
  REOPAQUE();
  {
    const f32x16 kk = mm_quad(KB, KN, wr, wc, r, h);
    const f32x16 qk = mm_quad(QN, KN, wr, wc, r, h);
    __syncthreads();
    const int j = wc * 32 + r; const float gj = gcv[j];
#pragma unroll
    for (int i = 0; i < 16; ++i) {
      const int row = wr * 32 + crow(i, h);
      const float dec = (row >= j) ? expf(gcv[row] - gj) : 0.f;
      Mf[row * 68 + j] = (row > j) ? kk[i] * dec : 0.f;
      QKm[row * 72 + j] = f2bf(qk[i] * dec);
    }
  }
  __syncthreads();
  REOPAQUE();
  if (wave == 0) {
    float t[64];
#pragma unroll
    for (int i = 0; i < 64; ++i) {
      float a4[4] = {(i == lane) ? 1.f : 0.f, 0.f, 0.f, 0.f};
#pragma unroll
      for (int j4 = 0; j4 < (i + 3) / 4; ++j4) {
        const f32x4 mrow = *(const f32x4*)(Mf + i * 68 + 4 * j4);
#pragma unroll
        for (int e = 0; e < 4; ++e) if (4 * j4 + e < i) a4[e] -= mrow[e] * t[4 * j4 + e];
      }
      const float a = (a4[0] + a4[1]) + (a4[2] + a4[3]);
      t[i] = a;
      Tm[i * 72 + lane] = f2bf(a);
      asm volatile("" ::: "memory");
    }
  }
  __syncthreads();
  REOPAQUE();
  {
    const f32x16 u = mm_quad(Tm, VBT, wr, wc, r, h);
    const f32x16 w = mm_quad(Tm, KBET, wr, wc, r, h);
    const int col = wc * 32 + r;
#pragma unroll
    for (int g = 0; g < 4; ++g) {
      const int i0 = wr * 32 + 8 * g + 4 * h;
      *(u32x2*)(UT + col * 72 + i0) = pk4(u[4 * g], u[4 * g + 1], u[4 * g + 2], u[4 * g + 3]);
      *(u32x2*)(WT + col * 72 + i0) = pk4(w[4 * g], w[4 * g + 1], w[4 * g + 2], w[4 * g + 3]);
    }
  }
  __syncthreads();
  REOPAQUE();
  {
    bf16_t* base = (bf16_t*)(p.ws + O_DPREP + (size_t)(hh * 128 + c) * 32768);
    const int n = wc * 32 + r;
    {
      const int ks = n >> 5, jh = (n >> 4) & 1, q = (n >> 2) & 3, jl = n & 3, jj = 4 * jh + jl;
      const int cbase = (ks * 64 + 16 * q) * 8 + jj;
      {
        const f32x16 P = mm_quad(KDT, WT, wr, wc, r, h);
#pragma unroll
        for (int i = 0; i < 16; ++i) {
          const int m = wr * 32 + crow(i, h);
          base[((m >> 4) * 128 + (m & 15)) * 8 + cbase] = f2bf(P[i]);
        }
      }
      asm volatile("" ::: "memory");
      {
        const f32x16 QW = mm_quad(QKm, WT, wr, wc, r, h);
#pragma unroll
        for (int i = 0; i < 16; ++i) {
          const int m = wr * 32 + crow(i, h);
          const float qd = bf2f(QN[m * 72 + n]) * egc[m];
          base[4096 + ((m >> 4) * 128 + (m & 15)) * 8 + cbase] = f2bf(qd - QW[i]);
        }
      }
      asm volatile("" ::: "memory");
    }
    const int jsl = n >> 4;
    {
      const f32x16 Bc = mm_quad(KDT, UT, wr, wc, r, h);
#pragma unroll
      for (int g = 0; g < 4; ++g) {
        const int row0 = wr * 32 + 8 * g + 4 * h;
        const int rt = row0 >> 4, lp = 16 * ((row0 >> 2) & 3) + (n & 15);
        *(u32x2*)(base + 8192 + ((jsl * 4 + rt) * 64 + lp) * 4) = pk4(Bc[4 * g], Bc[4 * g + 1], Bc[4 * g + 2], Bc[4 * g + 3]);
      }
    }
    asm volatile("" ::: "memory");
    {
      const f32x16 O0 = mm_quad(QKm, UT, wr, wc, r, h);
#pragma unroll
      for (int g = 0; g < 4; ++g) {
        const int row0 = wr * 32 + 8 * g + 4 * h;
        const int rt = row0 >> 4, lp = 16 * ((row0 >> 2) & 3) + (n & 15);
        *(u32x2*)(base + 12288 + ((jsl * 4 + rt) * 64 + lp) * 4) = pk4(O0[4 * g], O0[4 * g + 1], O0[4 * g + 2], O0[4 * g + 3]);
      }
    }
  }
  __syncthreads();
#undef REOPAQUE
}

struct TileDesc { const bf16_t* k; const bf16_t* v; const float* aux; int tag; };

template <int DHT, bool AUX>
struct TileRegs { bf16x8 k[DHT / 16]; bf16x8 v[DHT / 32][2]; f32x4 a[4]; };

template <int DHT, bool AUX>
DI void load_tile(const bf16_t* kp, const bf16_t* vp, const float* ap, long ldv, TileRegs<DHT, AUX>& t) {
#pragma unroll
  for (int s = 0; s < DHT / 16; ++s) t.k[s] = *(const bf16x8*)(kp + 512 * s);
#pragma unroll
  for (int dt = 0; dt < DHT / 32; ++dt)
#pragma unroll
    for (int s = 0; s < 2; ++s) t.v[dt][s] = *(const bf16x8*)(vp + (dt * 2 + s) * 512);
  if (AUX) {
#pragma unroll
    for (int g = 0; g < 4; ++g) t.a[g] = *(const f32x4*)(ap + 8 * g);
  }
}

template <int DHT, bool AUX, class TF, class MF, class SF>
DI void attn_loop(int maxtiles, TF&& tf, MF&& mf, SF&& stopf, const bf16x8 (&qf)[DHT / 16], long ldv, float scale2,
                  f32x16 (&o)[DHT / 32], float& m, float& l) {
  TileRegs<DHT, AUX> cur, nxt;
  int tagc, tagn;
  bf16x8 qf0 = qf[0];
  { const bf16_t* kp; const bf16_t* vp; const float* ap = nullptr; tagc = tf(0, kp, vp, ap); load_tile<DHT, AUX>(kp, vp, ap, ldv, cur); }
#pragma unroll 1
  for (int t = 0; t < maxtiles; ++t) {
    { const bf16_t* kp; const bf16_t* vp; const float* ap = nullptr; tagn = tf(t + 1, kp, vp, ap); load_tile<DHT, AUX>(kp, vp, ap, ldv, nxt); }
    { bf16x8 q0 = qf[0]; asm volatile("" : "+v"(q0) :: "memory"); qf0 = q0; }
    f32x16 sacc;
#pragma unroll
    for (int i = 0; i < 16; ++i) sacc[i] = 0.f;
#pragma unroll
    for (int s = 0; s < DHT / 16; ++s) sacc = MFMA32(cur.k[s], s == 0 ? qf0 : qf[s], sacc);
    float sv[16]; float mx = NEG_INF;
#pragma unroll
    for (int i = 0; i < 16; ++i) { sv[i] = sacc[i] * scale2 + mf(tagc, i, AUX ? cur.a[i >> 2][i & 3] : 0.f); mx = fmaxf(mx, sv[i]); }
    mx = fmaxf(mx, __shfl_xor(mx, 32));
    const float mnew = fmaxf(m, mx);
    const float alpha = __builtin_amdgcn_exp2f(m - mnew);
    m = mnew;
    float pv[16]; float ps = 0.f;
#pragma unroll
    for (int i = 0; i < 16; ++i) { pv[i] = __builtin_amdgcn_exp2f(sv[i] - mnew); ps += pv[i]; }
    l = l * alpha + ps;
#pragma unroll
    for (int dt = 0; dt < DHT / 32; ++dt)
#pragma unroll
      for (int i = 0; i < 16; ++i) o[dt][i] *= alpha;
    bf16x8 pf[2]; pf[0] = pk8(pv); pf[1] = pk8(pv + 8);
#pragma unroll
    for (int dt = 0; dt < DHT / 32; ++dt)
#pragma unroll
      for (int s = 0; s < 2; ++s) {
        o[dt] = MFMA32(cur.v[dt][s], pf[s], o[dt]);
      }
    if (stopf(t, m, AUX ? cur.a[0][0] : 0.f)) break;
    cur = nxt; tagc = tagn;
  }
}

template <int DHT>
DI void attn_store(const f32x16 (&o)[DHT / 32], float l, bf16_t* dstrow, int h, float& ltot_out, bool valid = true) {
  const float ltot = l + __shfl_xor(l, 32);
  ltot_out = ltot;
  const float inv = ltot > 0.f ? 1.f / ltot : 0.f;
  if (valid)
#pragma unroll
  for (int dt = 0; dt < DHT / 32; ++dt)
#pragma unroll
    for (int g = 0; g < 4; ++g)
      *(u32x2*)(dstrow + dt * 32 + 8 * g + 4 * h) = pk4(o[dt][4 * g] * inv, o[dt][4 * g + 1] * inv, o[dt][4 * g + 2] * inv, o[dt][4 * g + 3] * inv);
}

template <int N>
DI void zero_o(f32x16 (&o)[N]) {
#pragma unroll
  for (int a = 0; a < N; ++a)
#pragma unroll
    for (int i = 0; i < 16; ++i) o[a][i] = 0.f;
}

DI void top3_insert(float v, int n, float& v0, float& v1, float& v2, int& i0, int& i1, int& i2) {
  const bool g0 = v > v0, g1 = v > v1, g2 = v > v2;
  v2 = g1 ? v1 : (g2 ? v : v2); i2 = g1 ? i1 : (g2 ? n : i2);
  v1 = g0 ? v0 : (g1 ? v : v1); i1 = g0 ? i0 : (g1 ? n : i1);
  v0 = g0 ? v : v0;             i0 = g0 ? n : i0;
}

DI void moba_select(const Params& p, int a) {
  const int lane = otid() & 63, r = lane & 31, h = lane >> 5;
  const int qtile = a / 6, hh = a % 6, qb = qtile >> 3;
  unsigned mask = 0;
  if (qb > 0) {
    const bf16_t* qrow = (const bf16_t*)(p.ws + O_QKA) + (size_t)(qtile * 32 + r) * 384 + hh * 64 + 8 * h;
    bf16x8 qf[4];
#pragma unroll
    for (int s = 0; s < 4; ++s) qf[s] = *(const bf16x8*)(qrow + 16 * s);
    const bf16_t* kmh = (const bf16_t*)(p.ws + O_KM) + (hh * 32 + r) * 64 + 8 * h;
    const bf16_t* kml = kmh + 6 * 32 * 64;
    f32x16 g;
#pragma unroll
    for (int i = 0; i < 16; ++i) g[i] = 0.f;
#pragma unroll
    for (int s = 0; s < 4; ++s) { g = MFMA32(*(const bf16x8*)(kmh + 16 * s), qf[s], g); g = MFMA32(*(const bf16x8*)(kml + 16 * s), qf[s], g); }
    float v0 = NEG_INF, v1 = NEG_INF, v2 = NEG_INF; int i0 = -1, i1 = -1, i2 = -1;
#pragma unroll
    for (int i = 0; i < 16; ++i) { const int n = crow(i, h); if (n < qb) top3_insert(g[i], n, v0, v1, v2, i0, i1, i2); }
    const float pv0 = __shfl_xor(v0, 32), pv1 = __shfl_xor(v1, 32), pv2 = __shfl_xor(v2, 32);
    const int pi0 = __shfl_xor(i0, 32), pi1 = __shfl_xor(i1, 32), pi2 = __shfl_xor(i2, 32);
    if (pi0 >= 0) top3_insert(pv0, pi0, v0, v1, v2, i0, i1, i2);
    if (pi1 >= 0) top3_insert(pv1, pi1, v0, v1, v2, i0, i1, i2);
    if (pi2 >= 0) top3_insert(pv2, pi2, v0, v1, v2, i0, i1, i2);
    if (i0 >= 0) mask |= 1u << i0;
    if (i1 >= 0) mask |= 1u << i1;
    if (i2 >= 0) mask |= 1u << i2;
  }
  if (h == 0) ((unsigned*)(p.ws + O_MASK))[(qtile * 32 + r) * 8 + hh] = mask;
}

DI void moba_gather(const Params& p, int a, unsigned char* smem) {
  const int tid = otid(), lane = tid & 63, wave = tid >> 6, r = lane & 31, h = lane >> 5;
  const int part = a & 1, a2 = a >> 1;
  const int hh = a2 % 6, idx = a2 / 6;
  int qb = 1;
  while ((qb + 1) * qb / 2 <= idx) ++qb;
  const int n = idx - qb * (qb - 1) / 2;
  const unsigned* MASK = (const unsigned*)(p.ws + O_MASK);
  unsigned* list = (unsigned*)(smem + wave * 1024);
  int cnt = 0;
#pragma unroll
  for (int j = 0; j < 4; ++j) {
    const int qi = j * 64 + lane;
    const unsigned mk = MASK[(qb * 256 + qi) * 8 + hh];
    const bool pred = (mk >> n) & 1u;
    const unsigned long long ball = __ballot(pred);
    const int pos = cnt + __builtin_popcountll(ball & ((1ull << lane) - 1ull));
    if (pred) list[pos] = (unsigned)qi | ((unsigned)__builtin_popcount(mk & ((1u << n) - 1u)) << 8);
    cnt += __builtin_popcountll(ball);
  }
  cnt = __builtin_amdgcn_readfirstlane(cnt);
  if (cnt == 0) return;
  asm volatile("s_waitcnt lgkmcnt(0)" ::: "memory");
  __builtin_amdgcn_wave_barrier();
  const bf16_t* QK = (const bf16_t*)(p.ws + O_QKA);
  const bf16_t* KF = (const bf16_t*)(p.ws + O_KFA) + (size_t)hh * 524288 + (size_t)n * 8 * 2048 + lane * 8;
  const bf16_t* VT = (const bf16_t*)(p.ws + O_VTA) + (size_t)hh * 524288 + (size_t)n * 8 * 2048 + lane * 8;
  const int nch = (cnt + 31) >> 5;
#pragma unroll 1
  for (int c = part; c < nch; c += 2) {
    const int e = c * 32 + r;
    const bool valid = e < cnt;
    const unsigned ent = list[valid ? e : 0];
    const int tok = qb * 256 + (int)(ent & 255u), slot = (int)(ent >> 8);
    bf16x8 qf[4];
    { const bf16_t* qrow = QK + (size_t)tok * 384 + hh * 64 + 8 * h;
#pragma unroll
      for (int s = 0; s < 4; ++s) qf[s] = *(const bf16x8*)(qrow + 16 * s); }
    auto tf = [&](int t, const bf16_t*& kp, const bf16_t*& vp, const float*&) -> int {
      const int tt = t < 7 ? t : 7;
      kp = KF + tt * 2048; vp = VT + tt * 2048;
      return 0;
    };
    auto mf = [&](int, int, float) -> float { return 0.f; };
    auto sf = [&](int, float, float) { return false; };
    f32x16 o[2]; zero_o(o); float m = -1e30f, l = 0.f;
    int nt8 = 8; asm volatile("" : "+s"(nt8));
    attn_loop<64, false>(nt8, tf, mf, sf, qf, (long)TH, 0.125f * LOG2E, o, m, l);
    float lt;
    attn_store<64>(o, l, (bf16_t*)(p.ws + O_OA + slot * SZ_O) + (size_t)tok * 384 + hh * 64, h, lt, valid);
    if (valid && h == 0) { float* st = (float*)(p.ws + O_STA) + ((size_t)(slot * TH + tok) * 6 + hh) * 2; st[0] = m; st[1] = lt; }
  }
}

DI void moba_own(const Params& p, int a) {
  const int lane = otid() & 63, r = lane & 31, h = lane >> 5;
  const int qtile = 255 - a / 6, hh = a % 6, qb = qtile >> 3, own = qtile & 7;
  const bf16_t* QK = (const bf16_t*)(p.ws + O_QKA);
  const bf16_t* KF = (const bf16_t*)(p.ws + O_KFA) + (size_t)hh * 524288 + (size_t)qb * 8 * 2048 + lane * 8;
  const bf16_t* VT = (const bf16_t*)(p.ws + O_VTA) + (size_t)hh * 524288 + (size_t)qb * 8 * 2048 + lane * 8;
  const int tok = qtile * 32 + r;
  bf16x8 qf[4];
  { const bf16_t* qrow = QK + (size_t)tok * 384 + hh * 64 + 8 * h;
#pragma unroll
    for (int s = 0; s < 4; ++s) qf[s] = *(const bf16x8*)(qrow + 16 * s); }
  auto tf = [&](int t, const bf16_t*& kp, const bf16_t*& vp, const float*&) -> int {
    const int kk = t < own ? t : own;
    kp = KF + kk * 2048; vp = VT + kk * 2048;
    return (kk == own) ? 101 : 100;
  };
  auto mf = [&](int tag, int i, float) -> float {
    if (tag == 100) return 0.f;
    return (crow(i, h) <= r) ? 0.f : NEG_INF;
  };
  auto sf = [&](int, float, float) { return false; };
  f32x16 o[2]; zero_o(o); float m = -1e30f, l = 0.f;
  attn_loop<64, false>(own + 1, tf, mf, sf, qf, (long)TH, 0.125f * LOG2E, o, m, l);
  float lt;
  attn_store<64>(o, l, (bf16_t*)(p.ws + O_OA + 3 * SZ_O) + (size_t)tok * 384 + hh * 64, h, lt);
  if (h == 0) {
    float* st = (float*)(p.ws + O_STA);
    st[((size_t)(3 * TH + tok) * 6 + hh) * 2] = m; st[((size_t)(3 * TH + tok) * 6 + hh) * 2 + 1] = lt;
    const int np = __builtin_popcount(((const unsigned*)(p.ws + O_MASK))[tok * 8 + hh]);
    for (int sl = np; sl < 3; ++sl) { st[((size_t)(sl * TH + tok) * 6 + hh) * 2] = -1e30f; st[((size_t)(sl * TH + tok) * 6 + hh) * 2 + 1] = 0.f; }
  }
}

DI void fox_item(const Params& p, int c, const unsigned* kmaxu) {
  const int lane = otid() & 63, r = lane & 31, h = lane >> 5;
  const int qtile = 255 - c / 6, hh = c % 6;
  const bf16_t* QK = (const bf16_t*)(p.ws + O_QKC);
  const bf16_t* KF = (const bf16_t*)(p.ws + O_KFC);
  const bf16_t* VT = (const bf16_t*)(p.ws + O_VTC);
  const float* FF = (const float*)(p.ws + O_FF) + hh * TH;
  bf16x8 qf[4]; float qn2 = 0.f;
  { const bf16_t* qrow = QK + (size_t)(qtile * 32 + r) * 384 + hh * 64 + 8 * h;
#pragma unroll
    for (int s = 0; s < 4; ++s) { qf[s] = *(const bf16x8*)(qrow + 16 * s); float v[8]; unpk8(qf[s], v);
#pragma unroll
      for (int e = 0; e < 8; ++e) qn2 += v[e] * v[e]; } }
  qn2 += __shfl_xor(qn2, 32);
#pragma unroll
  for (int o = 16; o >= 1; o >>= 1) qn2 = fmaxf(qn2, __shfl_xor(qn2, o));
  const float Fq = FF[qtile * 32 + r];
  const float Ffirst = FF[qtile * 32];
  const float kmaxn = sqrtf(__uint_as_float(kmaxu[hh]));
  const float bound = sqrtf(qn2) * kmaxn * 0.125f + Ffirst;
  auto tf = [&](int t, const bf16_t*& kp, const bf16_t*& vp, const float*& ap) -> int {
    const int keybase = (qtile - t > 0 ? qtile - t : 0) * 32;
    kp = KF + (size_t)hh * 524288 + (keybase >> 5) * 2048 + lane * 8;
    vp = VT + (size_t)hh * 524288 + (keybase >> 5) * 2048 + lane * 8;
    ap = FF + keybase + 4 * h;
    return (t == 0) ? 1 : 0;
  };
  auto mf = [&](int tag, int i, float fk) -> float {
    const float b = (Fq - fk) * LOG2E;
    return (tag == 1 && crow(i, h) > r) ? NEG_INF : b;
  };
  auto sf = [&](int, float m, float a0) {
    const float fkb = __builtin_bit_cast(float, __builtin_amdgcn_readfirstlane(__builtin_bit_cast(int, a0)));
    float mm = m;
#pragma unroll
    for (int o = 16; o >= 1; o >>= 1) mm = fminf(mm, __shfl_xor(mm, o));
    return (bound - fkb) * LOG2E < mm - 45.f;
  };
  f32x16 o[2]; zero_o(o); float m = -1e30f, l = 0.f;
  attn_loop<64, true>(qtile + 1, tf, mf, sf, qf, (long)TH, 0.125f * LOG2E, o, m, l);
  float lt;
  attn_store<64>(o, l, (bf16_t*)(p.ws + O_OC) + (size_t)(qtile * 32 + r) * 384 + hh * 64, h, lt);
}

DI void dil_item(const Params& p, int idx) {
  const int lane = otid() & 63, r = lane & 31, h = lane >> 5;
  const int g = idx / 1536, rem = idx % 1536, hh = rem / 256, w = rem % 256;
  const int dsh = 2 * g;
  const int dil = 1 << dsh, L = TH >> dsh, tps = L / 32;
  const int rs = w / tps, lt_ = w % tps, l0 = lt_ * 32;
  const bf16_t* QK = (const bf16_t*)(p.ws + O_QKB);
  const bf16_t* KF = (const bf16_t*)(p.ws + O_KFB + g * SZ_VT);
  const bf16_t* VT = (const bf16_t*)(p.ws + O_VTB + g * SZ_VT);
  const int tq = (l0 + r) * dil + rs;
  bf16x8 qf[4];
  { const bf16_t* qrow = QK + (size_t)tq * 1152 + g * 384 + hh * 64 + 8 * h;
#pragma unroll
    for (int s = 0; s < 4; ++s) qf[s] = *(const bf16x8*)(qrow + 16 * s); }
  const int t0 = (l0 >= 128) ? 0 : (128 - l0) / 32;
  auto tf = [&](int tt, const bf16_t*& kp, const bf16_t*& vp, const float*&) -> int {
    const int t = (t0 + tt < 4) ? t0 + tt : 4; const int keybase = l0 - 128 + 32 * t;
    kp = KF + (size_t)hh * 524288 + ((rs * L + keybase) >> 5) * 2048 + lane * 8;
    vp = VT + (size_t)hh * 524288 + ((rs * L + keybase) >> 5) * 2048 + lane * 8;
    return t;
  };
  auto mf = [&](int tag, int i, float) -> float {
    const int kj = crow(i, h);
    if (tag == 0) return (kj >= r) ? 0.f : NEG_INF;
    if (tag == 4) return (kj <= r) ? 0.f : NEG_INF;
    return 0.f;
  };
  auto sf = [&](int, float, float) { return false; };
  f32x16 o[2]; zero_o(o); float m = -1e30f, l = 0.f;
  attn_loop<64, false>(5 - t0, tf, mf, sf, qf, (long)TH, 0.125f * LOG2E, o, m, l);
  float lt;
  attn_store<64>(o, l, (bf16_t*)(p.ws + O_OB + g * SZ_O) + (size_t)tq * 384 + hh * 64, h, lt);
  if (h == 0) { float* st = (float*)(p.ws + O_STB) + ((size_t)(g * TH + tq) * 6 + hh) * 2; st[0] = m; st[1] = lt; }
}

DI void mem_item(const Params& p, int half, int e) {
  const int lane = otid() & 63, r = lane & 31, h = lane >> 5;
  const int hd = e & 3, qtile = e >> 2;
  const bf16_t* QE = (const bf16_t*)(p.ws + O_QE);
  const bf16_t* MK = (const bf16_t*)(p.ws + O_MEMK);
  const bf16_t* MV = (const bf16_t*)(p.ws + O_MEMVT);
  bf16x8 qf[6];
  { const bf16_t* qrow = QE + (size_t)(qtile * 32 + r) * 384 + hd * 96 + 8 * h;
#pragma unroll
    for (int s = 0; s < 6; ++s) qf[s] = *(const bf16x8*)(qrow + 16 * s); }
  auto tf = [&](int t, const bf16_t*& kp, const bf16_t*& vp, const float*&) -> int {
    const int keybase = 32 * (t < 7 ? t : 7);
    kp = MK + (size_t)((half * 4 + hd) * 8 + (keybase >> 5)) * 3072 + lane * 8;
    vp = MV + (size_t)((half * 4 + hd) * 8 + (keybase >> 5)) * 3072 + lane * 8;
    return 0;
  };
  auto mf = [&](int, int, float) -> float { return 0.f; };
  auto sf = [&](int, float, float) { return false; };
  f32x16 o[3]; zero_o(o); float m = -1e30f, l = 0.f;
  attn_loop<96, false>(8, tf, mf, sf, qf, 256L, 0.10206207261596577f * LOG2E, o, m, l);
  float lt;
  attn_store<96>(o, l, (bf16_t*)(p.ws + O_OE) + (size_t)(qtile * 32 + r) * 384 + hd * 96, h, lt);
}

DI float dpp_ror(float v, int ctrl);
DI float row16_sum(float v) {
  v += __builtin_bit_cast(float, __builtin_amdgcn_update_dpp(0, __builtin_bit_cast(int, v), 0x128, 0xf, 0xf, false));
  v += __builtin_bit_cast(float, __builtin_amdgcn_update_dpp(0, __builtin_bit_cast(int, v), 0x124, 0xf, 0xf, false));
  v += __builtin_bit_cast(float, __builtin_amdgcn_update_dpp(0, __builtin_bit_cast(int, v), 0x122, 0xf, 0xf, false));
  v += __builtin_bit_cast(float, __builtin_amdgcn_update_dpp(0, __builtin_bit_cast(int, v), 0x121, 0xf, 0xf, false));
  return v;
}

struct ScanRegs { bf16x8 pf[4][2]; bf16x8 qe[4][2]; s16x4 bc[4]; s16x4 o0[4]; float gl; };
DI void scan_load(const Params& p, int hh, int j, int c, int lane, ScanRegs& s) {
  const unsigned char* base = p.ws + O_DPREP + (size_t)(hh * 128 + c) * 32768;
#pragma unroll
  for (int mt = 0; mt < 4; ++mt)
#pragma unroll
    for (int ks = 0; ks < 2; ++ks) {
      s.pf[mt][ks] = *(const bf16x8*)(base + ((mt * 2 + ks) * 64 + lane) * 16);
      s.qe[mt][ks] = *(const bf16x8*)(base + 8192 + ((mt * 2 + ks) * 64 + lane) * 16);
    }
#pragma unroll
  for (int rt = 0; rt < 4; ++rt) {
    s.bc[rt] = *(const s16x4*)(base + 16384 + ((j * 4 + rt) * 64 + lane) * 8);
    s.o0[rt] = *(const s16x4*)(base + 24576 + ((j * 4 + rt) * 64 + lane) * 8);
  }
  s.gl = ((const float*)(p.ws + O_GL))[hh * 128 + c];
}
DI f32x4 s4f(s16x4 v) { u32x2 u = __builtin_bit_cast(u32x2, v); f32x4 r; r[0] = bflo(u.x); r[1] = bfhi(u.x); r[2] = bflo(u.y); r[3] = bfhi(u.y); return r; }

DI void scan_item(const Params& p, int it) {
  const int lane = otid() & 63, q = lane >> 4, cl = lane & 15;
  const int hh = it >> 2, j = it & 3;
  f32x4 S[4];
#pragma unroll
  for (int rt = 0; rt < 4; ++rt) S[rt] = (f32x4){0.f, 0.f, 0.f, 0.f};
  bf16_t* OD = (bf16_t*)(p.ws + O_OD);
  float* SSQ = (float*)(p.ws + O_SSQ);
#ifndef SCAN_PREFETCH
#define SCAN_PREFETCH 1
#endif
  ScanRegs cur, nxt;
  if (SCAN_PREFETCH) scan_load(p, hh, j, 0, lane, cur);
  for (int c = 0; c < 128; ++c) {
    if (SCAN_PREFETCH) {
      scan_load(p, hh, j, (c + 1 < 128) ? c + 1 : c, lane, nxt);
      asm volatile("" : "+v"(S[0][0]) :: "memory");
    } else {
      scan_load(p, hh, j, c, lane, cur);
    }
    bf16x8 bfr[2];
#pragma unroll
    for (int ks = 0; ks < 2; ++ks) {
      u32x4 u; u.x = pk2(S[2 * ks][0], S[2 * ks][1]); u.y = pk2(S[2 * ks][2], S[2 * ks][3]); u.z = pk2(S[2 * ks + 1][0], S[2 * ks + 1][1]); u.w = pk2(S[2 * ks + 1][2], S[2 * ks + 1][3]);
      bfr[ks] = __builtin_bit_cast(bf16x8, u);
    }
    f32x4 aP[4], aO[4];
#pragma unroll
    for (int rt = 0; rt < 4; ++rt) {
      aP[rt] = (f32x4){0.f, 0.f, 0.f, 0.f};
      aO[rt] = s4f(cur.o0[rt]);
#pragma unroll
      for (int ks = 0; ks < 2; ++ks) { aP[rt] = MFMA16(cur.pf[rt][ks], bfr[ks], aP[rt]); aO[rt] = MFMA16(cur.qe[rt][ks], bfr[ks], aO[rt]); }
    }
#pragma unroll
    for (int rt = 0; rt < 4; ++rt) S[rt] = S[rt] * cur.gl - aP[rt] + s4f(cur.bc[rt]);
#pragma unroll
    for (int rt = 0; rt < 4; ++rt)
#pragma unroll
      for (int e = 0; e < 4; ++e) {
        const int tok = c * 64 + 16 * rt + 4 * q + e;
        const float v = aO[rt][e];
        OD[(size_t)tok * 384 + hh * 64 + 16 * j + cl] = f2bf(v);
        const float ss = row16_sum(v * v);
        if (cl == 0) SSQ[(tok * 6 + hh) * 4 + j] = ss;
      }
    if (SCAN_PREFETCH) cur = nxt;
  }
}

DI void scan_block(const Params& p, int hh, unsigned char* smem) {
  const int tid = otid(), lane = tid & 63, j = tid >> 6, q = lane >> 4, cl = lane & 15;
  const unsigned char* src = p.ws + O_DPREP + (size_t)hh * 128 * 32768;
  bf16_t* ostg = (bf16_t*)(smem + 65536);
  bf16x8 R0[8], R1[8];
  auto gld = [&](int c, bf16x8 (&R)[8]) {
    c = c < 128 ? c : 127;
    const unsigned char* b = src + (size_t)c * 32768 + tid * 16;
#pragma unroll
    for (int i = 0; i < 8; ++i) R[i] = *(const bf16x8*)(b + i * 4096);
  };
  auto lst = [&](int buf, const bf16x8 (&R)[8]) {
    unsigned char* d = smem + buf * 32768 + tid * 16;
#pragma unroll
    for (int i = 0; i < 8; ++i) *(bf16x8*)(d + i * 4096) = R[i];
  };
  const float* GL = (const float*)(p.ws + O_GL) + hh * 128;
  const float gl_lo = GL[lane], gl_hi = GL[64 + lane];
  f32x4 S[4];
#pragma unroll
  for (int rt = 0; rt < 4; ++rt) S[rt] = (f32x4){0.f, 0.f, 0.f, 0.f};
  bf16_t* OD = (bf16_t*)(p.ws + O_OD);
  float* SSQ = (float*)(p.ws + O_SSQ);
  f32x4 aO[4];
  auto flush = [&](int cp) {
    const int row = tid >> 2, part = tid & 3;
    const bf16x8 v0 = *(const bf16x8*)(ostg + row * 72 + 16 * part), v1 = *(const bf16x8*)(ostg + row * 72 + 16 * part + 8);
    float f[16]; unpk8(v0, f); unpk8(v1, f + 8);
    float ss = 0.f;
#pragma unroll
    for (int e = 0; e < 16; ++e) ss += f[e] * f[e];
    const int tok = cp * 64 + row;
    bf16_t* dst = OD + (size_t)tok * 384 + hh * 64 + 16 * part;
    *(bf16x8*)dst = v0; *(bf16x8*)(dst + 8) = v1;
    SSQ[(tok * 6 + hh) * 4 + part] = ss;
  };
  auto compute = [&](int buf, int c) {
    const unsigned char* base = smem + buf * 32768;
    const float gl = __builtin_bit_cast(float, __builtin_amdgcn_readlane(__builtin_bit_cast(int, c < 64 ? gl_lo : gl_hi), c & 63));
    bf16x8 bfr[2];
#pragma unroll
    for (int ks = 0; ks < 2; ++ks) {
      u32x4 u; u.x = pk2(S[2 * ks][0], S[2 * ks][1]); u.y = pk2(S[2 * ks][2], S[2 * ks][3]); u.z = pk2(S[2 * ks + 1][0], S[2 * ks + 1][1]); u.w = pk2(S[2 * ks + 1][2], S[2 * ks + 1][3]);
      bfr[ks] = __builtin_bit_cast(bf16x8, u);
    }
    f32x4 aP[4];
#pragma unroll
    for (int rt = 0; rt < 4; ++rt) {
      aP[rt] = (f32x4){0.f, 0.f, 0.f, 0.f};
      aO[rt] = s4f(*(const s16x4*)(base + 24576 + ((j * 4 + rt) * 64 + lane) * 8));
#pragma unroll
      for (int ks = 0; ks < 2; ++ks) {
        aP[rt] = MFMA16(*(const bf16x8*)(base + ((rt * 2 + ks) * 64 + lane) * 16), bfr[ks], aP[rt]);
        aO[rt] = MFMA16(*(const bf16x8*)(base + 8192 + ((rt * 2 + ks) * 64 + lane) * 16), bfr[ks], aO[rt]);
      }
    }
#pragma unroll
    for (int rt = 0; rt < 4; ++rt) S[rt] = S[rt] * gl - aP[rt] + s4f(*(const s16x4*)(base + 16384 + ((j * 4 + rt) * 64 + lane) * 8));
  };
  auto stage_out = [&]() {
#pragma unroll
    for (int rt = 0; rt < 4; ++rt)
#pragma unroll
      for (int e = 0; e < 4; ++e) ostg[(16 * rt + 4 * q + e) * 72 + 16 * j + cl] = f2bf(aO[rt][e]);
  };
  __builtin_amdgcn_s_setprio(3);
  gld(0, R0); gld(1, R1);
  lst(0, R0); gld(2, R0);
  __syncthreads();
#pragma unroll 1
  for (int c = 0; c < 128; c += 2) {
    lst(1, R1);
    gld(c + 3, R1);
    if (c > 0) flush(c - 1);
    compute(0, c);
    __syncthreads();
    stage_out();
    __syncthreads();
    lst(0, R0);
    gld(c + 4, R0);
    flush(c);
    compute(1, c + 1);
    __syncthreads();
    stage_out();
    __syncthreads();
  }
  flush(127);
  __syncthreads();
  __builtin_amdgcn_s_setprio(0);
}

DI void phase3(const Params& p, int half, unsigned* ctr, const unsigned* kmaxu, unsigned char* smem, int limit = 1 << 30) {
  const int tid = otid(), wave = tid >> 6;
  const int b = (int)blockIdx.x, x = b & 7, bi = b >> 3;
  if (b < 6 && limit >= 0) { if (PH(5)) scan_block(p, b, smem); }
  if (bi >= 1 && limit != 0) {
    const int nlw = ((int)(gridDim.x >> 3) - 1) * 4, lw = (bi - 1) * 4 + wave;
    if (x < 6) {
      const int hh = x;
      constexpr int NG = 992, NOWN = 256, NB_ = 640, NTOT = NG + NOWN + NB_;
      for (int pos0 = lw; pos0 < NTOT; pos0 += nlw) {
        int pos = __builtin_amdgcn_readfirstlane(pos0);
        if (pos < NG) { if (PH(6)) moba_gather(p, (((pos >> 1) * 6 + hh) << 1) | (pos & 1), smem); continue; }
        pos -= NG;
        if (pos < NOWN) { if (PH(6)) moba_own(p, pos * 6 + hh); continue; }
        pos -= NOWN;
        const int g = pos < 512 ? (pos >> 8) : 2, w = pos < 512 ? (pos & 255) : 2 * (pos - 512);
        if (PH(8)) dil_item(p, g * 1536 + hh * 256 + w);
      }
    } else {
      const int h0 = (x - 6) * 3;
      constexpr int NE = 512, NC = 768, NB2 = 384, NTOT = NE + NC + NB2;
      for (int pos0 = lw; pos0 < NTOT; pos0 += nlw) {
        int pos = __builtin_amdgcn_readfirstlane(pos0);
        if (pos < NE) { if (PH(7)) mem_item(p, half, (x - 6) * 512 + pos); continue; }
        pos -= NE;
        if (pos < NC) { if (PH(9)) fox_item(p, (pos & 255) * 6 + h0 + (pos >> 8), kmaxu); continue; }
        pos -= NC;
        if (PH(8)) dil_item(p, 2 * 1536 + (h0 + (pos >> 7)) * 256 + 2 * (pos & 127) + 1);
      }
    }
  }
}

DI void gbuild_chunk(const Params& p, int layer, int tok, int c8) {
  const unsigned char* ws = p.ws;
  const int n = c8 / 48, c = (c8 % 48) * 8;
  bf16_t* szp = (bf16_t*)(p.ws + O_SZ) + (size_t)tok * 1920 + n * 384 + c;
  float o[8], z[8];
  unpk8(*(const bf16x8*)szp, z);
  if (n == 1) {
    const int hh = c >> 6;
    const float* st = (const float*)(ws + O_STB);
    float mg[3], lg[3];
#pragma unroll
    for (int g = 0; g < 3; ++g) { const f32x2 s2 = *(const f32x2*)(st + ((size_t)(g * TH + tok) * 6 + hh) * 2); mg[g] = s2[0]; lg[g] = s2[1]; }
    const float mm = fmaxf(mg[0], fmaxf(mg[1], mg[2]));
    float wg[3], ws_ = 0.f;
#pragma unroll
    for (int g = 0; g < 3; ++g) { wg[g] = exp2f(mg[g] - mm) * lg[g]; ws_ += wg[g]; }
    const float inv = 1.f / ws_;
#pragma unroll
    for (int e = 0; e < 8; ++e) o[e] = 0.f;
#pragma unroll
    for (int g = 0; g < 3; ++g) {
      float t[8]; unpk8(*(const bf16x8*)((const bf16_t*)(ws + O_OB + g * SZ_O) + (size_t)tok * 384 + c), t);
      const float wgi = wg[g] * inv;
#pragma unroll
      for (int e = 0; e < 8; ++e) o[e] += wgi * t[e];
    }
  } else if (n == 3) {
    const int hh = c >> 6;
    const f32x4 sq = *(const f32x4*)((const float*)(ws + O_SSQ) + ((size_t)tok * 6 + hh) * 4);
    const float rs = rsqrtf((sq[0] + sq[1] + sq[2] + sq[3]) * (1.f / 64.f) + 1e-6f);
    unpk8(*(const bf16x8*)((const bf16_t*)(ws + O_OD) + (size_t)tok * 384 + c), o);
    const float* gw = p.gdn_w + layer * 64 + (c & 63);
#pragma unroll
    for (int e = 0; e < 8; ++e) o[e] *= rs * gw[e];
  } else if (n == 0) {
    const int hh = c >> 6;
    const float* st = (const float*)(ws + O_STA);
    float mg[4], lg[4], mm = -1e30f;
#pragma unroll
    for (int g = 0; g < 4; ++g) { const f32x2 s2 = *(const f32x2*)(st + ((size_t)(g * TH + tok) * 6 + hh) * 2); mg[g] = s2[0]; lg[g] = s2[1]; mm = fmaxf(mm, mg[g]); }
    float wg[4], ws_ = 0.f;
#pragma unroll
    for (int g = 0; g < 4; ++g) { wg[g] = exp2f(mg[g] - mm) * lg[g]; ws_ += wg[g]; }
    const float inv = 1.f / ws_;
#pragma unroll
    for (int e = 0; e < 8; ++e) o[e] = 0.f;
#pragma unroll
    for (int g = 0; g < 4; ++g) {
      if (lg[g] > 0.f) {
        float t[8]; unpk8(*(const bf16x8*)((const bf16_t*)(ws + O_OA + g * SZ_O) + (size_t)tok * 384 + c), t);
        const float wgi = wg[g] * inv;
#pragma unroll
        for (int e = 0; e < 8; ++e) o[e] += wgi * t[e];
      }
    }
  } else {
    const size_t off = (n == 2) ? O_OC : O_OE;
    unpk8(*(const bf16x8*)((const bf16_t*)(ws + off) + (size_t)tok * 384 + c), o);
  }
#pragma unroll
  for (int e = 0; e < 8; ++e) o[e] *= z[e];
  *(bf16x8*)szp = pk8(o);
}

DI void p4a_tile(const Params& p, int layer, int mt, int nt, unsigned char* smem) {
  __syncthreads();
  bf16_t* As = (bf16_t*)smem; bf16_t* Bs = As + 2 * 9216;
  const int tid = otid(), lane = tid & 63, wave = tid >> 6, wr = wave >> 1, wc = wave & 1, r = lane & 31, h = lane >> 5;
  const int m0 = mt * 128, n0 = nt * 128;
  f32x16 tot[2][2]; zero_acc(tot);
  const bf16_t* SIG = (const bf16_t*)(p.ws + O_SIG);
  for (int n = 0; n < 5; ++n) {
    f32x16 acc[2][2]; zero_acc(acc);
    PlainA al{(const bf16_t*)(p.ws + O_SZ) + n * 384, 1920};
    gemm_kloop_t<32>(al, (const bf16_t*)(p.ws + O_WTBR) + (size_t)(layer * 5 + n) * 1024 * 384, 384, 12, m0, n0, acc, As, Bs);
#pragma unroll
    for (int mi = 0; mi < 2; ++mi) {
      const int tok = m0 + wr * 64 + mi * 32 + r;
#pragma unroll
      for (int ni = 0; ni < 2; ++ni)
#pragma unroll
        for (int g = 0; g < 4; ++g) {
          const int col = n0 + wc * 64 + ni * 32 + 8 * g + 4 * h;
          const u32x2 sg = *(const u32x2*)(SIG + (size_t)tok * 5120 + n * 1024 + col);
          tot[mi][ni][4 * g] += bflo(sg.x) * acc[mi][ni][4 * g];
          tot[mi][ni][4 * g + 1] += bfhi(sg.x) * acc[mi][ni][4 * g + 1];
          tot[mi][ni][4 * g + 2] += bflo(sg.y) * acc[mi][ni][4 * g + 2];
          tot[mi][ni][4 * g + 3] += bfhi(sg.y) * acc[mi][ni][4 * g + 3];
          asm volatile("" ::: "memory");
        }
    }
  }
  bf16_t* YM = (bf16_t*)(p.ws + O_YM);
  {
    bf16_t* stg = (bf16_t*)smem + wave * (64 * 72);
#pragma unroll
    for (int ni = 0; ni < 2; ++ni)
#pragma unroll
      for (int mi = 0; mi < 2; ++mi)
#pragma unroll
        for (int g = 0; g < 4; ++g)
          *(u32x2*)(stg + (mi * 32 + r) * 72 + ni * 32 + 8 * g + 4 * h) = pk4(tot[mi][ni][4 * g], tot[mi][ni][4 * g + 1], tot[mi][ni][4 * g + 2], tot[mi][ni][4 * g + 3]);
    asm volatile("s_waitcnt lgkmcnt(0)" ::: "memory");
    __builtin_amdgcn_wave_barrier();
    const int tok0 = m0 + wr * 64, col0 = n0 + wc * 64;
#pragma unroll
    for (int it = 0; it < 8; ++it) {
      const int row = it * 8 + (lane >> 3), ch = (lane & 7) * 8;
      const bf16x8 val = *(const bf16x8*)(stg + row * 72 + ch);
      *(bf16x8*)(YM + (size_t)(tok0 + row) * 1024 + col0 + ch) = val;
    }
  }
}

DI void p4b_tile(const Params& p, int layer, int half, int mt, int nt, unsigned char* smem) {
  bf16_t* As = (bf16_t*)smem; bf16_t* Bs = As + 2 * 9216;
  const int tid = otid(), lane = tid & 63, wave = tid >> 6, wr = wave >> 1, wc = wave & 1, r = lane & 31, h = lane >> 5;
  const int m0 = mt * 128, n0 = nt * 128;
  f32x16 acc[2][2]; zero_acc(acc);
  PlainA al{(const bf16_t*)(p.ws + O_YM), 1024};
  gemm_kloop(al, (const bf16_t*)(p.ws + O_WTOUT + layer * SZ_WTOUT1), 1024, 16, m0, n0, acc, As, Bs);
  const float* xin = layer == 0 ? p.x : p.out;
  const float alpha = 1.4142135623730951f;
#pragma unroll
  for (int mi = 0; mi < 2; ++mi) {
    const size_t gt = (size_t)half * TH + m0 + wr * 64 + mi * 32 + r;
#pragma unroll
    for (int ni = 0; ni < 2; ++ni)
#pragma unroll
      for (int g = 0; g < 4; ++g) {
        const int col = n0 + wc * 64 + ni * 32 + 8 * g + 4 * h;
        const f32x4 xv = *(const f32x4*)(xin + gt * 1024 + col);
        f32x4 o;
#pragma unroll
        for (int e = 0; e < 4; ++e) o[e] = alpha * xv[e] + acc[mi][ni][4 * g + e];
        *(f32x4*)(p.out + gt * 1024 + col) = o;
      }
  }
}

DI void p4c_row(const Params& p, int layer, size_t gt, bool wxb = true) {
  const int lane = otid() & 63;
  float* row = p.out + gt * 1024;
  f32x4 v[4]; float s = 0.f;
#pragma unroll
  for (int j = 0; j < 4; ++j) { v[j] = *(const f32x4*)(row + 4 * lane + 256 * j); s += v[j][0] + v[j][1] + v[j][2] + v[j][3]; }
#pragma unroll
  for (int o = 32; o >= 1; o >>= 1) s += __shfl_xor(s, o);
  const float mu = s * (1.f / 1024.f); float q = 0.f;
#pragma unroll
  for (int j = 0; j < 4; ++j) { v[j] -= mu; q += v[j][0] * v[j][0] + v[j][1] * v[j][1] + v[j][2] * v[j][2] + v[j][3] * v[j][3]; }
#pragma unroll
  for (int o = 32; o >= 1; o >>= 1) q += __shfl_xor(q, o);
  const float rs = rsqrtf(q * (1.f / 1024.f) + 1e-5f);
  bf16_t* xb = (bf16_t*)(p.ws + O_XB) + gt * 1024;
#pragma unroll
  for (int j = 0; j < 4; ++j) {
    const int c = 4 * lane + 256 * j;
    const f32x4 g = *(const f32x4*)(p.ln_g + layer * 1024 + c), b = *(const f32x4*)(p.ln_b + layer * 1024 + c);
    f32x4 y;
#pragma unroll
    for (int e = 0; e < 4; ++e) y[e] = v[j][e] * rs * g[e] + b[e];
    *(f32x4*)(row + c) = y;
    if (wxb) *(u32x2*)(xb + c) = pk4(y[0], y[1], y[2], y[3]);
  }
}


#define XB_TMO      128
#define XB_XCNT(j)  (256  + 64 * (j))
#define XB_XSUB(j)  (1280 + 64 * (j))
#define XB_XGEN(j)  (2304 + 64 * (j))
#define XB_TOP      3328
#define XB_TOPGEN   3392
#define XB_SPIN_CAP (1u << 22)
#define LAS __attribute__((address_space(3)))
DI unsigned xb_ld(unsigned* p) { return __hip_atomic_load(p, __ATOMIC_RELAXED, __HIP_MEMORY_SCOPE_AGENT); }
DI unsigned xb_add(unsigned* p, unsigned v) { return __hip_atomic_fetch_add(p, v, __ATOMIC_RELAXED, __HIP_MEMORY_SCOPE_AGENT); }
DI unsigned xb_xcc_id() { return (unsigned)__builtin_amdgcn_s_getreg((3 << 11) | 20) & 0xFu; }
#define XB_SPIN(cond, bar) do { unsigned _sp = 0; while (cond) { __builtin_amdgcn_s_sleep(1); \
    if ((++_sp & 255u) == 0u) { if (xb_ld(&(bar)[XB_TMO])) break; if (_sp > XB_SPIN_CAP) { atomicAdd(&(bar)[XB_TMO], 1u); break; } } } } while (0)
struct XcdBarrier { unsigned* bar; unsigned x; volatile LAS unsigned* st; };
DI XcdBarrier xcd_barrier_post(unsigned* bar, volatile LAS unsigned* st) {
  XcdBarrier b; b.bar = bar; b.x = xb_xcc_id(); b.st = st;
  if (threadIdx.x == 0) (void)xb_add(&bar[XB_XCNT(b.x)], 1u);
  return b;
}
DI void xcd_barrier_complete(unsigned* bar, unsigned x, unsigned& nloc, unsigned& nx) {
  const unsigned G = gridDim.x;
  unsigned sum, cnt, mine, sp = 0u;
  for (;;) {
    sum = 0u; cnt = 0u; mine = 0u;
#pragma unroll
    for (unsigned j = 0; j < 16; ++j) { const unsigned c = xb_ld(&bar[XB_XCNT(j)]); sum += c; cnt += (c > 0u) ? 1u : 0u; mine = (j == x) ? c : mine; }
    if (sum == G) break;
    __builtin_amdgcn_s_sleep(1);
    if ((++sp & 255u) == 0u) { if (xb_ld(&bar[XB_TMO])) break; if (sp > XB_SPIN_CAP) { atomicAdd(&bar[XB_TMO], 1u); break; } }
  }
  nloc = mine > 0u ? mine : 1u; nx = cnt > 0u ? cnt : 1u;
}
DI void xcd_barrier(const XcdBarrier& b) {
  asm volatile("s_waitcnt vmcnt(0)" ::: "memory");
  __syncthreads();
  if (threadIdx.x == 0) {
    unsigned* bar = b.bar;
    __builtin_amdgcn_s_waitcnt(0);
    unsigned nloc = b.st[0], nx = b.st[1];
    if (nloc == 0u) { xcd_barrier_complete(bar, b.x, nloc, nx); b.st[0] = nloc; b.st[1] = nx; }
    const unsigned old = xb_add(&bar[XB_XSUB(b.x)], 1u);
    const unsigned gen = old / nloc;
    if (old + 1u == (gen + 1u) * nloc) {
      __builtin_amdgcn_fence(__ATOMIC_RELEASE, "agent");
      asm volatile("s_waitcnt vmcnt(0)" ::: "memory");
      const unsigned og = xb_add(&bar[XB_TOP], 1u);
      const unsigned tg = og / nx;
      if (og + 1u == (tg + 1u) * nx) xb_add(&bar[XB_TOPGEN], 1u);
      else XB_SPIN(xb_ld(&bar[XB_TOPGEN]) == tg, bar);
      __builtin_amdgcn_fence(__ATOMIC_ACQUIRE, "agent");
      xb_add(&bar[XB_XGEN(b.x)], 1u);
      asm volatile("s_waitcnt vmcnt(0)" ::: "memory");
    } else {
      XB_SPIN(xb_ld(&bar[XB_XGEN(b.x)]) == gen, bar);
      __builtin_amdgcn_fence(__ATOMIC_ACQUIRE, "agent");
      asm volatile("s_waitcnt vmcnt(0)" ::: "memory");
    }
  }
  __syncthreads();
}

#ifdef PROBE_A
#define STAMP(k) do { if (blockIdx.x == 0 && otid() == 0) { unsigned long long now_ = __builtin_amdgcn_s_memrealtime(); tsacc[k] += (float)(now_ - tlast) * 0.01f; tlast = now_; } } while (0)
#else
#define STAMP(k) do {} while (0)
#endif
__global__ void __launch_bounds__(256, 2) mega(Params p) {
#ifdef PROBE_A
  float tsacc[8] = {0.f, 0.f, 0.f, 0.f, 0.f, 0.f, 0.f, 0.f};
  unsigned long long tlast = __builtin_amdgcn_s_memrealtime();
#endif
  extern __shared__ __attribute__((aligned(16))) unsigned char smem[];
  cg::grid_group grid = cg::this_grid();
  if (p.ws == nullptr) grid.sync();
  volatile LAS unsigned* xbst = (volatile LAS unsigned*)(smem + 75776);
  if (threadIdx.x < 4) xbst[threadIdx.x] = 0u;
  __syncthreads();
  const XcdBarrier xb = xcd_barrier_post((unsigned*)(p.ws + O_BAR), xbst);
#define GSYNC() xcd_barrier(xb)
  const int wave = otid() >> 6;
  const int gw = blockIdx.x * 4 + wave, ngw = gridDim.x * 4;
  for (int rep = 0; rep < REP(0); ++rep) phase0(p, smem);
  GSYNC(); STAMP(0);
#ifndef REPEAT_ITER
#define REPEAT_ITER 0
#endif
#ifndef EXTRA_UPTO
#define EXTRA_UPTO 7
#endif
#ifndef EXTRA_P3_LIMIT
#define EXTRA_P3_LIMIT (1 << 30)
#endif
  int pend_layer = -1, pend_half = 0; bool pend_wxb = true;
  for (int itn = -REPEAT_ITER; itn < 4; ++itn) {
    const int layer = itn < 0 ? 0 : (itn >> 1), half = itn < 0 ? 0 : (itn & 1);
    {
      if (pend_layer >= 0) { for (int rw = gw; rw < TH; rw += ngw) { if (PH(12)) p4c_row(p, pend_layer, (size_t)pend_half * TH + rw, pend_wxb); } pend_layer = -1; }
      for (int rep = 0; rep < REP(1); ++rep) for (int t = blockIdx.x; t < 64 * 107; t += gridDim.x) { if (PH(1)) p1_tile(p, layer, half, t % 64, t / 64, smem); }
      GSYNC(); STAMP(1);
      if (itn < 0 && EXTRA_UPTO <= 1) continue;
      {
        constexpr int N_FOX = 6, N_GDN = 768, N_MKV = 12, N_KM = 48, TOT = N_FOX + N_GDN + N_MKV + N_KM;
        for (int rep = 0; rep < REP(2); ++rep) for (int t = blockIdx.x; t < TOT; t += gridDim.x) {
          int i = t;
          if (i < N_FOX) { if (PH(2)) fox_prep(p, i, smem); continue; }
          i -= N_FOX;
          if (i < N_GDN) { if (PH(3)) gdn_prep(p, layer, half, i / 128, i % 128, smem); continue; }
          i -= N_GDN;
          if (i < N_MKV) { if (PH(4)) memkv_tile(p, layer, half, i / 6, i % 6, smem); continue; }
          i -= N_MKV;
          if (PH(4)) kmean_prep(p, i * 4 + wave, (unsigned*)(p.ws + O_CTL) + 64 + (layer * 2 + half) * 8);
        }
      }
      GSYNC(); STAMP(2);
      if (itn < 0 && EXTRA_UPTO <= 2) continue;
#ifndef NO_SELECT
      for (int a = gw; a < 1536; a += ngw) moba_select(p, a);
#endif
      GSYNC();
      for (int rep = 0; rep < REP(3); ++rep) phase3(p, half, (unsigned*)(p.ws + O_CTL) + rep * 8 + (itn < 0 ? 16 - itn : layer * 2 + half), (const unsigned*)(p.ws + O_CTL) + 64 + (layer * 2 + half) * 8, smem, itn < 0 ? EXTRA_P3_LIMIT : (1 << 30));
      GSYNC(); STAMP(3);
      if (itn < 0 && EXTRA_UPTO <= 3) continue;
      if (PH(13)) for (int ci = blockIdx.x * 256 + otid(); ci < TH * 240; ci += gridDim.x * 256) gbuild_chunk(p, layer, ci / 240, ci % 240);
      GSYNC(); STAMP(4);
      for (int rep = 0; rep < REP(5); ++rep) for (int t = blockIdx.x; t < 512; t += gridDim.x) { if (PH(10)) p4a_tile(p, layer, t % 64, t / 64, smem); }
      GSYNC(); STAMP(5);
      for (int t = blockIdx.x; t < 512; t += gridDim.x) { if (PH(11)) p4b_tile(p, layer, half, t % 64, t / 64, smem); }
      GSYNC(); STAMP(6);
      pend_layer = layer; pend_half = half; pend_wxb = (itn >= 0);
    }
  }
  if (pend_layer >= 0) { for (int rw = gw; rw < TH; rw += ngw) { if (PH(12)) p4c_row(p, pend_layer, (size_t)pend_half * TH + rw, pend_wxb); } }
#ifdef EXTRA_SYNCS
  for (int i = 0; i < EXTRA_SYNCS; ++i) GSYNC();
#endif
#ifdef PROBE_A
  if (blockIdx.x == 0) {
    const float va = tsacc[PROBE_A] * 100.f, vb = tsacc[PROBE_B];
    for (int i = otid(); i < (1 << 20); i += 256) p.out[(size_t)4096 * 1024 + i] = vb;
    if (otid() == 0) p.out[0] = va;
  }
#endif
}

extern "C" void kernel_launch(void* const* d_in, const int* in_sizes, int n_in, void* d_out, int out_size, void* d_ws, size_t ws_size,
                              hipStream_t stream) {
  static int grid_blocks = 0;
  if (grid_blocks == 0) {
    if (ws_size < WS_END) { fprintf(stderr, "workspace too small: %zu < %zu\n", ws_size, (size_t)WS_END); grid_blocks = -1; return; }
    int dev = 0, cus = 0, per_cu = 0;
    (void)hipGetDevice(&dev);
    (void)hipDeviceGetAttribute(&cus, hipDeviceAttributeMultiprocessorCount, dev);
    (void)hipFuncSetAttribute((const void*)mega, hipFuncAttributeMaxDynamicSharedMemorySize, LDS_BYTES);
    (void)hipOccupancyMaxActiveBlocksPerMultiprocessor(&per_cu, (const void*)mega, 256, LDS_BYTES);
    if (per_cu < 1) per_cu = 1;
    if (per_cu > 2) per_cu = 2;
    grid_blocks = cus * per_cu;
  }
  if (grid_blocks < 0) return;
  (void)hipMemsetAsync((char*)d_ws + O_CTL, 0, 32768, stream);
  Params p{};
  p.x = (const float*)d_in[0]; p.mem = (const float*)d_in[1]; p.mem_g = (const float*)d_in[2]; p.mem_b = (const float*)d_in[3];
  p.w_in = (const float*)d_in[4]; p.b_in = (const float*)d_in[5]; p.conv_w = (const float*)d_in[6]; p.a_log = (const float*)d_in[7];
  p.dt_bias = (const float*)d_in[8]; p.gdn_w = (const float*)d_in[9]; p.w_kv = (const float*)d_in[10]; p.w_br = (const float*)d_in[11];
  p.w_out = (const float*)d_in[12]; p.ln_g = (const float*)d_in[13]; p.ln_b = (const float*)d_in[14];
  p.out = (float*)d_out; p.ws = (unsigned char*)d_ws;
  void* args[] = {&p};
  hipError_t e = hipLaunchCooperativeKernel((const void*)mega, dim3(grid_blocks), dim3(256), args, LDS_BYTES, stream);
  if (e != hipSuccess) fprintf(stderr, "cooperative launch failed: %s (grid %d)\n", hipGetErrorString(e), grid_blocks);
}
```

```cpp
#include <hip/hip_runtime.h>
#include <hip/hip_cooperative_groups.h>
#include <cstdio>
#include <cstdint>
namespace cg = cooperative_groups;

#define DI __device__ __forceinline__
typedef unsigned short bf16_t;
typedef short bf16x8 __attribute__((ext_vector_type(8)));
typedef short s16x4 __attribute__((ext_vector_type(4)));
typedef float f32x4 __attribute__((ext_vector_type(4)));
typedef float f32x2 __attribute__((ext_vector_type(2)));
typedef float f32x16 __attribute__((ext_vector_type(16)));
typedef unsigned u32x2 __attribute__((ext_vector_type(2)));
typedef unsigned u32x4 __attribute__((ext_vector_type(4)));
typedef __bf16 bfv2 __attribute__((ext_vector_type(2)));

#define MFMA32(a, b, c) __builtin_amdgcn_mfma_f32_32x32x16_bf16((a), (b), (c), 0, 0, 0)
#define MFMA16(a, b, c) __builtin_amdgcn_mfma_f32_16x16x32_bf16((a), (b), (c), 0, 0, 0)

DI unsigned pk2(float a, float b) { f32x2 v = {a, b}; return __builtin_bit_cast(unsigned, __builtin_convertvector(v, bfv2)); }
DI bf16_t f2bf(float a) { return (bf16_t)(pk2(a, 0.f) & 0xffffu); }
DI float bf2f(bf16_t v) { return __uint_as_float(((unsigned)v) << 16); }
DI float bflo(unsigned u) { return __uint_as_float(u << 16); }
DI float bfhi(unsigned u) { return __uint_as_float(u & 0xffff0000u); }
DI int rtid() { int t = __builtin_amdgcn_workitem_id_x(); asm volatile("" : "+v"(t)); return t; }
DI int otid() { return rtid() & 255; }
extern __shared__ __attribute__((aligned(16))) unsigned char g_lds_all[];
#define LAS3 __attribute__((address_space(3)))
DI void sub_sync() {
  asm volatile("s_waitcnt lgkmcnt(0)" ::: "memory");
  const int t = __builtin_amdgcn_workitem_id_x();
  LAS3 unsigned* c = (LAS3 unsigned*)(g_lds_all + 2 * 75776 + 8) + (t >> 8);
  if ((t & 63) == 0) {
    const unsigned old = __hip_atomic_fetch_add(c, 1u, __ATOMIC_RELAXED, __HIP_MEMORY_SCOPE_WORKGROUP);
    const unsigned target = (old / 4u + 1u) * 4u;
    while (__hip_atomic_load(c, __ATOMIC_RELAXED, __HIP_MEMORY_SCOPE_WORKGROUP) < target) __builtin_amdgcn_s_sleep(1);
  }
  asm volatile("s_waitcnt lgkmcnt(0)" ::: "memory");
}
DI int crow(int i, int h) { return (i & 3) + 8 * (i >> 2) + 4 * h; }
DI float fsigmoid(float v) { return __builtin_amdgcn_rcpf(1.f + __expf(-v)); }
DI float fsilu(float v) { return v * fsigmoid(v); }
DI u32x2 pk4(float a, float b, float c, float d) { u32x2 r; r.x = pk2(a, b); r.y = pk2(c, d); return r; }
DI bf16x8 pk8(const float* v) { u32x4 r; r.x = pk2(v[0], v[1]); r.y = pk2(v[2], v[3]); r.z = pk2(v[4], v[5]); r.w = pk2(v[6], v[7]); return __builtin_bit_cast(bf16x8, r); }
DI void unpk8(bf16x8 x, float* v) { u32x4 u = __builtin_bit_cast(u32x4, x); v[0] = bflo(u.x); v[1] = bfhi(u.x); v[2] = bflo(u.y); v[3] = bfhi(u.y); v[4] = bflo(u.z); v[5] = bfhi(u.z); v[6] = bflo(u.w); v[7] = bfhi(u.w); }

constexpr int NB = 2, SQ = 8192, NT = NB * SQ, DM = 1024, NH = 6, BW = 384;
constexpr int TH = 8192;
constexpr int NP = 13824;
constexpr int DIN = 13586;
constexpr float LOG2E = 1.4426950408889634f;
#define NEG_INF (-__builtin_inff())

constexpr int C_AQK = 0, C_AV = 768, C_BQK = 1152, C_BV = 3456, C_CQK = 3840, C_CV = 4608, C_D = 4992, C_E = 6144, C_SM = 6528, C_SMEND = 6546, C_Z = 6656, C_MG = 8576;

__host__ __device__ constexpr int inmap(int n) {
  return n < 4992 ? n : n < 6144 ? n + 6 : n < 6528 ? n + 18 : n < 6534 ? n - 1536 : n < 6546 ? n - 384 : n < 6656 ? -1 : n < 13696 ? n - 110 : -1;
}

constexpr size_t O_CTL = 0;
constexpr size_t O_BAR = 4096;
constexpr size_t O_WTIN = 32768;
constexpr size_t SZ_WTIN1 = (size_t)NP * 1024 * 2;
constexpr size_t O_WTBR = O_WTIN + 2 * SZ_WTIN1;
constexpr size_t SZ_WTBR1 = (size_t)5 * 1024 * 384 * 2;
constexpr size_t O_WTOUT = O_WTBR + 2 * SZ_WTBR1;
constexpr size_t SZ_WTOUT1 = (size_t)1024 * 1024 * 2;
constexpr size_t O_WTKV = O_WTOUT + 2 * SZ_WTOUT1;
constexpr size_t SZ_WTKV1 = (size_t)768 * 1024 * 2;
constexpr size_t O_BIASP = O_WTKV + 2 * SZ_WTKV1;
constexpr size_t O_XB = O_BIASP + (size_t)2 * NP * 4;
constexpr size_t O_MEMN = O_XB + (size_t)NT * 1024 * 2;
constexpr size_t O_MEMK = O_MEMN + (size_t)512 * 1024 * 2;
constexpr size_t O_MEMVT = O_MEMK + (size_t)512 * 384 * 2;
constexpr size_t O_QKA = O_MEMVT + (size_t)512 * 384 * 2;
constexpr size_t SZ_VT = (size_t)384 * TH * 2;
constexpr size_t O_KFA = O_QKA + SZ_VT;
constexpr size_t O_VTA = O_KFA + SZ_VT;
constexpr size_t O_QKB = O_VTA + SZ_VT;
constexpr size_t O_KFB = O_QKB + 3 * SZ_VT;
constexpr size_t O_VTB = O_KFB + 3 * SZ_VT;
constexpr size_t O_QKC = O_VTB + 3 * SZ_VT;
constexpr size_t O_KFC = O_QKC + SZ_VT;
constexpr size_t O_VTC = O_KFC + SZ_VT;
constexpr size_t O_QKVD = O_VTC + SZ_VT;
constexpr size_t O_QE = O_QKVD + (size_t)TH * 1152 * 2;
constexpr size_t O_SM = O_QE + (size_t)TH * 384 * 2;
constexpr size_t O_FF = O_SM + (size_t)TH * 32 * 4;
constexpr size_t O_KM = O_FF + (size_t)6 * TH * 4;
constexpr size_t O_KMAX = O_KM + (size_t)2 * 6 * 32 * 64 * 2;
constexpr size_t O_GL = O_KMAX + 256;
constexpr size_t O_MASK = O_GL + 6 * 128 * 4;
constexpr size_t O_DPREP = O_MASK + (size_t)TH * 8 * 4;
constexpr size_t O_SZ = O_DPREP + (size_t)768 * 32768;
constexpr size_t O_SIG = O_SZ + (size_t)TH * 1920 * 2;
constexpr size_t O_OA = O_SIG + (size_t)TH * 5120 * 2;
constexpr size_t SZ_O = (size_t)TH * 384 * 2;
constexpr size_t O_STA = O_OA + 4 * SZ_O;
constexpr size_t O_OB = O_STA + (size_t)4 * TH * 6 * 2 * 4;
constexpr size_t O_STB = O_OB + 3 * SZ_O;
constexpr size_t O_OC = O_STB + (size_t)3 * TH * 6 * 2 * 4;
constexpr size_t O_OD = O_OC + SZ_O;
constexpr size_t O_SSQ = O_OD + SZ_O;
constexpr size_t O_OE = O_SSQ + (size_t)TH * 6 * 4 * 4;
constexpr size_t WS_END = O_OE + SZ_O;
constexpr size_t O_YM = O_QKB;
static_assert(WS_END < (size_t)443 * 1000 * 1000, "workspace too large");

struct Params {
  const float *x, *mem, *mem_g, *mem_b, *w_in, *b_in, *conv_w, *a_log, *dt_bias, *gdn_w, *w_kv, *w_br, *w_out, *ln_g, *ln_b;
  float* out;
  unsigned char* ws;
};

constexpr int SUB_LDS = 75776;
constexpr int LDS_BYTES = 2 * SUB_LDS + 16;
#ifndef PH_MASK
#define PH_MASK 0xFFFF
#endif
#define PH(x) ((PH_MASK >> (x)) & 1)
#ifndef REP_MASK
#define REP_MASK 0
#endif
#define REP(x) (1 + ((REP_MASK >> (x)) & 1))

DI void transpose_tile(const float* __restrict__ src, int ld, int k0, int n0, bool usemap, bf16_t* __restrict__ dst, int dstld, float* tile) {
  const int tid = otid();
#pragma unroll
  for (int it = 0; it < 16; ++it) {
    const int kk = (tid >> 6) + 4 * it, n2 = (tid & 63) * 2;
    const int sc = usemap ? inmap(n0 + n2) : (n0 + n2);
    f32x2 v = {0.f, 0.f};
    if (sc >= 0) v = *(const f32x2*)(src + (size_t)(k0 + kk) * ld + sc);
    *(f32x2*)(tile + kk * 130 + n2) = v;
  }
  sub_sync();
#pragma unroll
  for (int it = 0; it < 4; ++it) {
    const int nn = (tid >> 3) + 32 * it, kc = (tid & 7) * 8;
    float v[8];
#pragma unroll
    for (int e = 0; e < 8; ++e) v[e] = tile[(kc + e) * 130 + nn];
    *(bf16x8*)(dst + (size_t)(n0 + nn) * dstld + k0 + kc) = pk8(v);
  }
  sub_sync();
}

DI void phase0(const Params& p, unsigned char* smem, int vb, int vgrid) {
  float* tile = (float*)smem;
  const int tid = otid(), lane = tid & 63, wave = tid >> 6;
  constexpr int N_TIN = 2 * 108 * 16, N_TBR = 2 * 5 * 8 * 6, N_TOUT = 2 * 8 * 16, N_TKV = 2 * 6 * 16, N_XB = 1024, N_MEMN = 128, N_BIAS = 108;
  constexpr int TOT = N_TIN + N_TBR + N_TOUT + N_TKV + N_XB + N_MEMN + N_BIAS;
  for (int it = vb; it < TOT; it += vgrid) {
    int i = it;
    if (i < N_TIN) {
      const int l = i / (108 * 16), rr = i % (108 * 16), nt = rr / 16, kt = rr % 16;
      transpose_tile(p.w_in + (size_t)l * 1024 * DIN, DIN, kt * 64, nt * 128, true, (bf16_t*)(p.ws + O_WTIN + l * SZ_WTIN1), 1024, tile);
      continue;
    }
    i -= N_TIN;
    if (i < N_TBR) {
      const int ln = i / 48, rr = i % 48, nt = rr / 6, kt = rr % 6;
      transpose_tile(p.w_br + (size_t)ln * 384 * 1024, 1024, kt * 64, nt * 128, false, (bf16_t*)(p.ws + O_WTBR) + (size_t)ln * 1024 * 384, 384, tile);
      continue;
    }
    i -= N_TBR;
    if (i < N_TOUT) {
      const int l = i / 128, rr = i % 128, nt = rr / 16, kt = rr % 16;
      transpose_tile(p.w_out + (size_t)l * 1024 * 1024, 1024, kt * 64, nt * 128, false, (bf16_t*)(p.ws + O_WTOUT + l * SZ_WTOUT1), 1024, tile);
      continue;
    }
    i -= N_TOUT;
    if (i < N_TKV) {
      const int l = i / 96, rr = i % 96, nt = rr / 16, kt = rr % 16;
      transpose_tile(p.w_kv + (size_t)l * 1024 * 768, 768, kt * 64, nt * 128, false, (bf16_t*)(p.ws + O_WTKV + l * SZ_WTKV1), 1024, tile);
      continue;
    }
    i -= N_TKV;
    if (i < N_XB) {
      const float* src = p.x + (size_t)i * 16 * 1024;
      bf16_t* dst = (bf16_t*)(p.ws + O_XB) + (size_t)i * 16 * 1024;
#pragma unroll
      for (int j = 0; j < 16; ++j) {
        const int e = (j * 256 + tid) * 4;
        const f32x4 v = *(const f32x4*)(src + e);
        *(u32x2*)(dst + e) = pk4(v[0], v[1], v[2], v[3]);
      }
      continue;
    }
    i -= N_XB;
    if (i < N_MEMN) {
      const int row = i * 4 + wave;
      const float* src = p.mem + (size_t)row * 1024;
      f32x4 v[4]; float s = 0.f;
#pragma unroll
      for (int j = 0; j < 4; ++j) { v[j] = *(const f32x4*)(src + 4 * lane + 256 * j); s += v[j][0] + v[j][1] + v[j][2] + v[j][3]; }
#pragma unroll
      for (int o = 32; o >= 1; o >>= 1) s += __shfl_xor(s, o);
      const float mu = s * (1.f / 1024.f); float q = 0.f;
#pragma unroll
      for (int j = 0; j < 4; ++j) { v[j] -= mu; q += v[j][0] * v[j][0] + v[j][1] * v[j][1] + v[j][2] * v[j][2] + v[j][3] * v[j][3]; }
#pragma unroll
      for (int o = 32; o >= 1; o >>= 1) q += __shfl_xor(q, o);
      const float rs = rsqrtf(q * (1.f / 1024.f) + 1e-5f);
      bf16_t* dst = (bf16_t*)(p.ws + O_MEMN) + (size_t)row * 1024;
#pragma unroll
      for (int j = 0; j < 4; ++j) {
        const int c = 4 * lane + 256 * j;
        const f32x4 g = *(const f32x4*)(p.mem_g + c), b = *(const f32x4*)(p.mem_b + c);
        *(u32x2*)(dst + c) = pk4(v[j][0] * rs * g[0] + b[0], v[j][1] * rs * g[1] + b[1], v[j][2] * rs * g[2] + b[2], v[j][3] * rs * g[3] + b[3]);
      }
      continue;
    }
    i -= N_MEMN;
    {
      float* bp = (float*)(p.ws + O_BIASP);
      if (tid < 128) {
        const int n = i * 128 + tid;
        const int sc = inmap(n);
        for (int l = 0; l < 2; ++l) bp[l * NP + n] = sc >= 0 ? p.b_in[l * DIN + sc] : 0.f;
      }
    }
  }
}

template <int BK, class AL>
DI void gemm_kloop_t(const AL& al, const bf16_t* __restrict__ Bt, int ldb, int nkt, int m0, int n0, f32x16 (&acc)[2][2], bf16_t* As, bf16_t* Bs) {
  constexpr int CPR = BK / 8, NCH = BK / 16, PITCH = BK + 8, BUF = 128 * PITCH;
  const int tid = otid(), lane = tid & 63, wave = tid >> 6, wr = wave >> 1, wc = wave & 1, r = lane & 31, h = lane >> 5;
  bf16x8 ra[NCH], rb[NCH];
  auto gload = [&](int kt) {
#pragma unroll
    for (int i = 0; i < NCH; ++i) {
      const int cid = tid + 256 * i, row = cid / CPR, kc = (cid % CPR) * 8;
      ra[i] = al(m0 + row, kt * BK + kc);
      rb[i] = *(const bf16x8*)(Bt + (size_t)(n0 + row) * ldb + kt * BK + kc);
    }
  };
  auto lstore = [&](int buf) {
#pragma unroll
    for (int i = 0; i < NCH; ++i) {
      const int cid = tid + 256 * i, row = cid / CPR, kc = (cid % CPR) * 8;
      *(bf16x8*)(As + buf * BUF + row * PITCH + kc) = ra[i];
      *(bf16x8*)(Bs + buf * BUF + row * PITCH + kc) = rb[i];
    }
  };
  gload(0); lstore(0); sub_sync();
  for (int kt = 0; kt < nkt; ++kt) {
    const int buf = kt & 1;
    if (kt + 1 < nkt) gload(kt + 1);
    asm volatile("" ::: "memory");
    const bf16_t* a_ = As + buf * BUF + (wr * 64 + r) * PITCH + 8 * h;
    const bf16_t* b_ = Bs + buf * BUF + (wc * 64 + r) * PITCH + 8 * h;
#pragma unroll
    for (int s = 0; s < BK / 16; ++s) {
      bf16x8 af[2], bfr[2];
      af[0] = *(const bf16x8*)(a_ + 16 * s); af[1] = *(const bf16x8*)(a_ + 32 * PITCH + 16 * s);
      bfr[0] = *(const bf16x8*)(b_ + 16 * s); bfr[1] = *(const bf16x8*)(b_ + 32 * PITCH + 16 * s);
#pragma unroll
      for (int mi = 0; mi < 2; ++mi)
#pragma unroll
        for (int ni = 0; ni < 2; ++ni) acc[mi][ni] = MFMA32(bfr[ni], af[mi], acc[mi][ni]);
    }
    if (kt + 1 < nkt) lstore(buf ^ 1);
    sub_sync();
  }
}
template <class AL>
DI void gemm_kloop(const AL& al, const bf16_t* __restrict__ Bt, int ldb, int nkt, int m0, int n0, f32x16 (&acc)[2][2], bf16_t* As, bf16_t* Bs) {
  gemm_kloop_t<64>(al, Bt, ldb, nkt, m0, n0, acc, As, Bs);
}

DI void zero_acc(f32x16 (&acc)[2][2]) {
#pragma unroll
  for (int a = 0; a < 2; ++a)
#pragma unroll
    for (int b = 0; b < 2; ++b)
#pragma unroll
      for (int i = 0; i < 16; ++i) acc[a][b][i] = 0.f;
}

DI int vfrag_key(int key) { const int kk = key & 31; return (key >> 5) * 2048 + (kk >> 4) * 512 + ((kk >> 2) & 1) * 256 + ((kk >> 3) & 1) * 4 + (kk & 3); }
DI int vfrag_col(int cw) { const int d = cw & 63; return (cw >> 6) * 524288 + (d >> 5) * 1024 + (d & 31) * 8; }

DI int kfrag_key(int key) { return (key >> 5) * 2048 + (key & 31) * 8; }
DI int kfrag_col(int cw) { const int d = cw & 63; return (cw >> 6) * 524288 + (d >> 4) * 512 + ((d >> 3) & 1) * 256 + (d & 7); }

struct PlainA {
  const bf16_t* A; int lda;
  DI bf16x8 operator()(int row, int k) const { return *(const bf16x8*)(A + (size_t)row * lda + k); }
};

DI void p1_tile(const Params& p, int layer, int half, int mt, int nt, unsigned char* smem) {
  sub_sync();
  bf16_t* As = (bf16_t*)smem; bf16_t* Bs = As + 2 * 9216;
  f32x16 acc[2][2]; zero_acc(acc);
  PlainA al{(const bf16_t*)(p.ws + O_XB) + (size_t)half * TH * 1024, 1024};
  const int m0 = mt * 128, n0 = nt * 128;
  gemm_kloop(al, (const bf16_t*)(p.ws + O_WTIN + layer * SZ_WTIN1), 1024, 16, m0, n0, acc, As, Bs);
  const int tid = otid(), lane = tid & 63, wave = tid >> 6, wr = wave >> 1, wc = wave & 1, r = lane & 31, h = lane >> 5;
  const float* bias = (const float*)(p.ws + O_BIASP) + layer * NP;
  unsigned char* ws = p.ws;
  {
    const int nb0 = n0 + wc * 64;
    bf16_t* dst0 = nullptr; int pitch0 = 0, coff0 = 0, xf0 = 0;
    if (nb0 < 384) { dst0 = (bf16_t*)(ws + O_QKA); pitch0 = 384; coff0 = nb0; }
    else if (nb0 >= C_BQK && nb0 < 2304) { dst0 = (bf16_t*)(ws + O_QKB); pitch0 = 1152; coff0 = nb0 - C_BQK; }
    else if (nb0 >= C_CQK && nb0 < 4224) { dst0 = (bf16_t*)(ws + O_QKC); pitch0 = 384; coff0 = nb0 - C_CQK; }
    else if (nb0 >= C_D && nb0 < C_E) { dst0 = (bf16_t*)(ws + O_QKVD); pitch0 = 1152; coff0 = nb0 - C_D; }
    else if (nb0 >= C_E && nb0 < C_SM) { dst0 = (bf16_t*)(ws + O_QE); pitch0 = 384; coff0 = nb0 - C_E; }
    else if (nb0 >= C_Z && nb0 < C_MG) { dst0 = (bf16_t*)(ws + O_SZ); pitch0 = 1920; coff0 = nb0 - C_Z; xf0 = 1; }
    else if (nb0 >= C_MG) { dst0 = (bf16_t*)(ws + O_SIG); pitch0 = 5120; coff0 = nb0 - C_MG; xf0 = 2; }
    if (dst0 != nullptr) {
      bf16_t* stg = (bf16_t*)smem + wave * (64 * 72);
#pragma unroll
      for (int ni = 0; ni < 2; ++ni)
#pragma unroll
        for (int mi = 0; mi < 2; ++mi)
#pragma unroll
          for (int g = 0; g < 4; ++g) {
            const int cq = ni * 32 + 8 * g + 4 * h;
            const f32x4 bv = *(const f32x4*)(bias + nb0 + cq);
            float v[4];
#pragma unroll
            for (int e = 0; e < 4; ++e) v[e] = acc[mi][ni][4 * g + e] + bv[e];
            if (xf0 == 1) {
#pragma unroll
              for (int e = 0; e < 4; ++e) v[e] = fsilu(v[e]);
            } else if (xf0 == 2) {
#pragma unroll
              for (int e = 0; e < 4; ++e) v[e] = fsigmoid(v[e]);
            }
            *(u32x2*)(stg + (mi * 32 + r) * 72 + cq) = pk4(v[0], v[1], v[2], v[3]);
          }
      asm volatile("s_waitcnt lgkmcnt(0)" ::: "memory");
      __builtin_amdgcn_wave_barrier();
      const int tok0 = m0 + wr * 64;
#pragma unroll
      for (int it = 0; it < 8; ++it) {
        const int row = it * 8 + (lane >> 3), ch = (lane & 7) * 8;
        const bf16x8 val = *(const bf16x8*)(stg + row * 72 + ch);
        *(bf16x8*)(dst0 + (size_t)(tok0 + row) * pitch0 + coff0 + ch) = val;
      }
      return;
    }
  }
#pragma unroll
  for (int ni = 0; ni < 2; ++ni) {
    const int nb = n0 + wc * 64 + ni * 32;
    int kind;
    int xf = 0;
    bf16_t* dst = nullptr; int pitch = 0, coff = 0;
    int kgrp = 0;
    if (nb < 384) { kind = 0; dst = (bf16_t*)(ws + O_QKA); pitch = 384; coff = nb; }
    else if (nb < C_AV) { kind = 5; dst = (bf16_t*)(ws + O_KFA); coff = nb - 384; }
    else if (nb < C_BQK) { kind = 1; dst = (bf16_t*)(ws + O_VTA); coff = nb - C_AV; }
    else if (nb < 2304) { kind = 0; dst = (bf16_t*)(ws + O_QKB); pitch = 1152; coff = nb - C_BQK; }
    else if (nb < C_BV) { kind = 5; kgrp = (nb - 2304) / 384; dst = (bf16_t*)(ws + O_KFB + kgrp * SZ_VT); coff = (nb - 2304) - kgrp * 384; }
    else if (nb < C_CQK) { kind = 2; dst = (bf16_t*)(ws + O_VTB); coff = nb - C_BV; }
    else if (nb < 4224) { kind = 0; dst = (bf16_t*)(ws + O_QKC); pitch = 384; coff = nb - C_CQK; }
    else if (nb < C_CV) { kind = 5; dst = (bf16_t*)(ws + O_KFC); coff = nb - 4224; }
    else if (nb < C_D) { kind = 1; dst = (bf16_t*)(ws + O_VTC); coff = nb - C_CV; }
    else if (nb < C_E) { kind = 0; dst = (bf16_t*)(ws + O_QKVD); pitch = 1152; coff = nb - C_D; }
    else if (nb < C_SM) { kind = 0; dst = (bf16_t*)(ws + O_QE); pitch = 384; coff = nb - C_E; }
    else if (nb < C_Z) { kind = (nb == C_SM) ? 3 : 4; }
    else if (nb < C_MG) { kind = 0; xf = 1; dst = (bf16_t*)(ws + O_SZ); pitch = 1920; coff = nb - C_Z; }
    else { kind = 0; xf = 2; dst = (bf16_t*)(ws + O_SIG); pitch = 5120; coff = nb - C_MG; }
    if (kind == 4) continue;
#pragma unroll
    for (int mi = 0; mi < 2; ++mi) {
      const int tok = m0 + wr * 64 + mi * 32 + r;
#pragma unroll
      for (int g = 0; g < 4; ++g) {
        const int cq = 8 * g + 4 * h;
        const f32x4 bv = *(const f32x4*)(bias + nb + cq);
        float v[4];
#pragma unroll
        for (int e = 0; e < 4; ++e) v[e] = acc[mi][ni][4 * g + e] + bv[e];
        if (kind == 0) {
          if (xf == 1) {
#pragma unroll
            for (int e = 0; e < 4; ++e) v[e] = fsilu(v[e]);
          } else if (xf == 2) {
#pragma unroll
            for (int e = 0; e < 4; ++e) v[e] = fsigmoid(v[e]);
          }
          *(u32x2*)(dst + (size_t)tok * pitch + coff + cq) = pk4(v[0], v[1], v[2], v[3]);
        } else if (kind == 5) {
          const int key = kgrp == 0 ? tok : kgrp == 1 ? (tok & 3) * 2048 + (tok >> 2) : (tok & 15) * 512 + (tok >> 4);
          *(u32x2*)(dst + kfrag_col(coff + cq) + kfrag_key(key)) = pk4(v[0], v[1], v[2], v[3]);
        } else if (kind == 1) {
          const int ko = vfrag_key(tok);
#pragma unroll
          for (int e = 0; e < 4; ++e) dst[vfrag_col(coff + cq + e) + ko] = f2bf(v[e]);
        } else if (kind == 2) {
          const int k1 = vfrag_key(tok), k4 = vfrag_key((tok & 3) * 2048 + (tok >> 2)), k16 = vfrag_key((tok & 15) * 512 + (tok >> 4));
#pragma unroll
          for (int e = 0; e < 4; ++e) {
            const bf16_t b = f2bf(v[e]); const int co = vfrag_col(coff + cq + e);
            dst[co + k1] = b; dst[SZ_VT / 2 + co + k4] = b; dst[SZ_VT + co + k16] = b;
          }
        } else {
          float* sm = (float*)(ws + O_SM);
#pragma unroll
          for (int e = 0; e < 4; ++e) if (cq + e < 18) sm[tok * 32 + cq + e] = v[e];
        }
      }
    }
  }
}


DI int g_lds_byte(int r, int c) { const int st = (r >> 4) * 2 + (c >> 5), ob = (r & 15) * 64 + (c & 31) * 2; return st * 1024 + (ob ^ (((ob >> 9) & 1) << 5)); }
DI void g_stage_rc(int b, int& R, int& C) { const int st = b >> 10, sb = b & 1023, swz = sb ^ (((sb >> 9) & 1) << 5); R = (st >> 1) * 16 + (swz >> 6); C = (st & 1) * 32 + ((swz & 63) >> 1); }

DI void p1_unit(const Params& p, int layer, int half, int pm, int pn, unsigned char* lds) {
  const int tid = rtid(), wid = tid >> 6, lane = tid & 63, wr = wid >> 2, wc = wid & 3, fr = lane & 15, fq = lane >> 4;
  const bf16_t* Ab = (const bf16_t*)(p.ws + O_XB) + ((size_t)half * TH + (size_t)pm * 256) * 1024;
  const bf16_t* Bb = (const bf16_t*)(p.ws + O_WTIN + layer * SZ_WTIN1) + (size_t)pn * 256 * 1024;
  int sOff[4];
#pragma unroll
  for (int i = 0; i < 4; ++i) { int R, C; g_stage_rc(wid * 1024 + i * 8192 + lane * 16, R, C); sOff[i] = R * 1024 + C; }
  auto stage = [&](int buf, int kt) {
#pragma unroll
    for (int i = 0; i < 4; ++i) {
      __builtin_amdgcn_global_load_lds((const unsigned*)(Ab + sOff[i] + kt * 64), (unsigned*)(lds + buf * 65536 + wid * 1024 + i * 8192), 16, 0, 0);
      __builtin_amdgcn_global_load_lds((const unsigned*)(Bb + sOff[i] + kt * 64), (unsigned*)(lds + buf * 65536 + 32768 + wid * 1024 + i * 8192), 16, 0, 0);
    }
  };
  f32x4 acc[8][4];
#pragma unroll
  for (int m = 0; m < 8; ++m)
#pragma unroll
    for (int n = 0; n < 4; ++n) acc[m][n] = (f32x4){0.f, 0.f, 0.f, 0.f};
  const int lane_off = (fr * 64 + fq * 16) ^ ((fr >> 3) << 5);
  __syncthreads();
  stage(0, 0);
  asm volatile("s_waitcnt vmcnt(0)" ::: "memory");
  __syncthreads();
#pragma unroll 1
  for (int t = 0; t < 16; ++t) {
    const int cur = t & 1;
    if (t + 1 < 16) stage(cur ^ 1, t + 1);
    const unsigned char* SA = lds + cur * 65536 + wr * 16384 + lane_off;
    const unsigned char* SB = lds + cur * 65536 + 32768 + wc * 8192 + lane_off;
    bf16x8 Bf[2][4], At[2][2];
#pragma unroll
    for (int n = 0; n < 4; ++n) Bf[0][n] = *(const bf16x8*)(SB + n * 2048);
#pragma unroll
    for (int m = 0; m < 2; ++m) At[0][m] = *(const bf16x8*)(SA + m * 2048);
#pragma unroll
    for (int g = 0; g < 8; ++g) {
      const int ks = g >> 2, pr = g & 3;
      if (g == 1) {
#pragma unroll
        for (int n = 0; n < 4; ++n) Bf[1][n] = *(const bf16x8*)(SB + n * 2048 + 1024);
      }
      if (g < 7) {
        const int g1 = g + 1;
#pragma unroll
        for (int m = 0; m < 2; ++m) At[g1 & 1][m] = *(const bf16x8*)(SA + ((g1 & 3) * 2 + m) * 2048 + (g1 >> 2) * 1024);
      }
      asm volatile("" : "+v"(acc[pr * 2][0][0]) :: "memory");
#pragma unroll
      for (int m = 0; m < 2; ++m)
#pragma unroll
        for (int n = 0; n < 4; ++n) acc[pr * 2 + m][n] = MFMA16(Bf[ks][n], At[g & 1][m], acc[pr * 2 + m][n]);
    }
    asm volatile("s_waitcnt vmcnt(0)" ::: "memory");
    __syncthreads();
  }
  const int nb0 = pn * 256 + wc * 64, tok0 = pm * 256 + wr * 128;
  const float* bias = (const float*)(p.ws + O_BIASP) + layer * NP;
  unsigned char* ws = p.ws;
  int kind, xf = 0, kgrp = 0, pitch = 0, coff = 0; bf16_t* dst = nullptr;
  if (nb0 < 384) { kind = 0; dst = (bf16_t*)(ws + O_QKA); pitch = 384; coff = nb0; }
  else if (nb0 < C_AV) { kind = 5; dst = (bf16_t*)(ws + O_KFA); coff = nb0 - 384; }
  else if (nb0 < C_BQK) { kind = 1; dst = (bf16_t*)(ws + O_VTA); coff = nb0 - C_AV; }
  else if (nb0 < 2304) { kind = 0; dst = (bf16_t*)(ws + O_QKB); pitch = 1152; coff = nb0 - C_BQK; }
  else if (nb0 < C_BV) { kind = 5; kgrp = (nb0 - 2304) / 384; dst = (bf16_t*)(ws + O_KFB + kgrp * SZ_VT); coff = (nb0 - 2304) - kgrp * 384; }
  else if (nb0 < C_CQK) { kind = 2; dst = (bf16_t*)(ws + O_VTB); coff = nb0 - C_BV; }
  else if (nb0 < 4224) { kind = 0; dst = (bf16_t*)(ws + O_QKC); pitch = 384; coff = nb0 - C_CQK; }
  else if (nb0 < C_CV) { kind = 5; dst = (bf16_t*)(ws + O_KFC); coff = nb0 - 4224; }
  else if (nb0 < C_D) { kind = 1; dst = (bf16_t*)(ws + O_VTC); coff = nb0 - C_CV; }
  else if (nb0 < C_E) { kind = 0; dst = (bf16_t*)(ws + O_QKVD); pitch = 1152; coff = nb0 - C_D; }
  else if (nb0 < C_SM) { kind = 0; dst = (bf16_t*)(ws + O_QE); pitch = 384; coff = nb0 - C_E; }
  else if (nb0 < C_Z) { kind = (nb0 == C_SM) ? 3 : 4; }
  else if (nb0 < C_MG) { kind = 0; xf = 1; dst = (bf16_t*)(ws + O_SZ); pitch = 1920; coff = nb0 - C_Z; }
  else if (nb0 < 13696) { kind = 0; xf = 2; dst = (bf16_t*)(ws + O_SIG); pitch = 5120; coff = nb0 - C_MG; }
  else { kind = 4; }
  if (kind == 4) return;
  if (kind == 0) {
    bf16_t* stg = (bf16_t*)(lds + wid * 18432);
#pragma unroll
    for (int m = 0; m < 8; ++m)
#pragma unroll
      for (int n = 0; n < 4; ++n) {
        const int c4 = n * 16 + fq * 4;
        const f32x4 bv = *(const f32x4*)(bias + nb0 + c4);
        float v[4];
#pragma unroll
        for (int e = 0; e < 4; ++e) v[e] = acc[m][n][e] + bv[e];
        if (xf == 1) {
#pragma unroll
          for (int e = 0; e < 4; ++e) v[e] = fsilu(v[e]);
        } else if (xf == 2) {
#pragma unroll
          for (int e = 0; e < 4; ++e) v[e] = fsigmoid(v[e]);
        }
        *(u32x2*)(stg + (m * 16 + fr) * 72 + c4) = pk4(v[0], v[1], v[2], v[3]);
      }
    asm volatile("s_waitcnt lgkmcnt(0)" ::: "memory");
    __builtin_amdgcn_wave_barrier();
#pragma unroll
    for (int it = 0; it < 16; ++it) {
      const int row = it * 8 + (lane >> 3), ch = (lane & 7) * 8;
      const bf16x8 val = *(const bf16x8*)(stg + row * 72 + ch);
      *(bf16x8*)(dst + (size_t)(tok0 + row) * pitch + coff + ch) = val;
    }
    return;
  }
#pragma unroll
  for (int m = 0; m < 8; ++m) {
    const int tok = tok0 + m * 16 + fr;
#pragma unroll
    for (int n = 0; n < 4; ++n) {
      const int c4 = n * 16 + fq * 4;
      const f32x4 bv = *(const f32x4*)(bias + nb0 + c4);
      float v[4];
#pragma unroll
      for (int e = 0; e < 4; ++e) v[e] = acc[m][n][e] + bv[e];
      if (kind == 5) {
        const int key = kgrp == 0 ? tok : kgrp == 1 ? (tok & 3) * 2048 + (tok >> 2) : (tok & 15) * 512 + (tok >> 4);
        *(u32x2*)(dst + kfrag_col(coff + c4) + kfrag_key(key)) = pk4(v[0], v[1], v[2], v[3]);
      } else if (kind == 1) {
        const int ko = vfrag_key(tok);
#pragma unroll
        for (int e = 0; e < 4; ++e) dst[vfrag_col(coff + c4 + e) + ko] = f2bf(v[e]);
      } else if (kind == 2) {
        const int k1 = vfrag_key(tok), k4 = vfrag_key((tok & 3) * 2048 + (tok >> 2)), k16 = vfrag_key((tok & 15) * 512 + (tok >> 4));
#pragma unroll
        for (int e = 0; e < 4; ++e) {
          const bf16_t b = f2bf(v[e]); const int co = vfrag_col(coff + c4 + e);
          dst[co + k1] = b; dst[SZ_VT / 2 + co + k4] = b; dst[SZ_VT + co + k16] = b;
        }
      } else {
        float* sm = (float*)(ws + O_SM);
#pragma unroll
        for (int e = 0; e < 4; ++e) if (c4 + e < 18) sm[tok * 32 + c4 + e] = v[e];
      }
    }
  }
}

DI void fox_prep(const Params& p, int hh, unsigned char* smem) {
  float* red = (float*)smem;
  const int tid = otid(), lane = tid & 63, wave = tid >> 6;
  const float* sm = (const float*)(p.ws + O_SM);
  float* FF = (float*)(p.ws + O_FF) + hh * TH;
  float loc[32];
#pragma unroll
  for (int j = 0; j < 32; ++j) loc[j] = sm[(tid * 32 + j) * 32 + hh];
  float s = 0.f;
#pragma unroll
  for (int j = 0; j < 32; ++j) { const float xv = loc[j]; s += fminf(xv, 0.f) - log1pf(expf(-fabsf(xv))); loc[j] = s; }
  float inc = s;
#pragma unroll
  for (int o = 1; o < 64; o <<= 1) { const float t = __shfl_up(inc, o); if (lane >= o) inc += t; }
  if (lane == 63) red[wave] = inc;
  sub_sync();
  float off = inc - s;
  for (int w = 0; w < wave; ++w) off += red[w];
#pragma unroll
  for (int j4 = 0; j4 < 8; ++j4) {
    f32x4 o4 = {off + loc[4 * j4], off + loc[4 * j4 + 1], off + loc[4 * j4 + 2], off + loc[4 * j4 + 3]};
    *(f32x4*)(FF + tid * 32 + 4 * j4) = o4;
  }
  sub_sync();
}

DI void kmean_prep(const Params& p, int idx, unsigned* kmaxu) {
  const int lane = otid() & 63;
  const int hh = idx / 32, blk = idx % 32;
  const bf16_t* k = (const bf16_t*)(p.ws + O_KFA) + kfrag_col(hh * 64 + lane) + blk * 8 * 2048;
  float s = 0.f;
#pragma unroll 8
  for (int i = 0; i < 256; ++i) s += bf2f(k[(i >> 5) * 2048 + (i & 31) * 8]);
  s *= (1.f / 256.f);
  const bf16_t hi = f2bf(s);
  bf16_t* km = (bf16_t*)(p.ws + O_KM);
  km[(hh * 32 + blk) * 64 + lane] = hi;
  km[6 * 32 * 64 + (hh * 32 + blk) * 64 + lane] = f2bf(s - bf2f(hi));
  const bf16_t* kc = (const bf16_t*)(p.ws + O_KFC) + (size_t)hh * 524288;
  float mx = 0.f;
#pragma unroll
  for (int t = 0; t < 4; ++t) {
    const int key = blk * 256 + lane * 4 + t;
    float kk = 0.f;
#pragma unroll
    for (int c = 0; c < 8; ++c) { float v[8]; unpk8(*(const bf16x8*)(kc + kfrag_key(key) + c * 256), v);
#pragma unroll
      for (int e = 0; e < 8; ++e) kk += v[e] * v[e]; }
    mx = fmaxf(mx, kk);
  }
#pragma unroll
  for (int o = 32; o >= 1; o >>= 1) mx = fmaxf(mx, __shfl_xor(mx, o));
  if (lane == 0) atomicMax(kmaxu + hh, __float_as_uint(mx));
}

DI void memkv_tile(const Params& p, int layer, int half, int mt, int nt, unsigned char* smem) {
  bf16_t* As = (bf16_t*)smem; bf16_t* Bs = As + 2 * 9216;
  f32x16 acc[2][2]; zero_acc(acc);
  PlainA al{(const bf16_t*)(p.ws + O_MEMN) + (size_t)half * 256 * 1024, 1024};
  const int m0 = mt * 128, n0 = nt * 128;
  gemm_kloop(al, (const bf16_t*)(p.ws + O_WTKV + layer * SZ_WTKV1), 1024, 16, m0, n0, acc, As, Bs);
  const int tid = otid(), lane = tid & 63, wave = tid >> 6, wr = wave >> 1, wc = wave & 1, r = lane & 31, h = lane >> 5;
  bf16_t* mk = (bf16_t*)(p.ws + O_MEMK); bf16_t* mv = (bf16_t*)(p.ws + O_MEMVT);
#pragma unroll
  for (int ni = 0; ni < 2; ++ni)
#pragma unroll
    for (int mi = 0; mi < 2; ++mi) {
      const int m = m0 + wr * 64 + mi * 32 + r;
#pragma unroll
      for (int i = 0; i < 16; ++i) {
        const int col = n0 + wc * 64 + ni * 32 + crow(i, h);
        const bf16_t b = f2bf(acc[mi][ni][i]);
        if (col < 384) { const int hd = col / 96, d = col % 96; mk[(size_t)((half * 4 + hd) * 8 + (m >> 5)) * 3072 + (d >> 4) * 512 + ((d >> 3) & 1) * 256 + (m & 31) * 8 + (d & 7)] = b; }
        else { const int cc = col - 384, hd = cc / 96, d = cc % 96, kk = m & 31;
          mv[(size_t)((half * 4 + hd) * 8 + (m >> 5)) * 3072 + (d >> 5) * 1024 + (kk >> 4) * 512 + ((kk >> 2) & 1) * 256 + (d & 31) * 8 + ((kk >> 3) & 1) * 4 + (kk & 3)] = b; }
      }
    }
}

DI f32x16 mm_quad(const bf16_t* A, const bf16_t* B, int wr, int wc, int r, int h) {
  f32x16 acc;
#pragma unroll
  for (int i = 0; i < 16; ++i) acc[i] = 0.f;
  const bf16_t* a_ = A + (wr * 32 + r) * 72 + 8 * h;
  const bf16_t* b_ = B + (wc * 32 + r) * 72 + 8 * h;
#pragma unroll
  for (int s = 0; s < 4; ++s) acc = MFMA32(*(const bf16x8*)(a_ + 16 * s), *(const bf16x8*)(b_ + 16 * s), acc);
  return acc;
}

DI void gdn_prep(const Params& p, int layer, int half, int hh, int c, unsigned char* smem) {
  bf16_t* QN = (bf16_t*)smem; bf16_t* KN = QN + 4608; bf16_t* KB = KN + 4608; bf16_t* KDT = KB + 4608; bf16_t* VBT = KDT + 4608;
  bf16_t* KBET = VBT + 4608; bf16_t* QKm = KBET + 4608; bf16_t* Tm = QKm + 4608;
  float* gcv = (float*)(smem + 73728); float* betav = gcv + 64; float* egc = gcv + 128;
  float* Mf = (float*)(smem + 9216);
  bf16_t* UT = KN; bf16_t* WT = KB;
  int tid = otid();
  int lane = tid & 63, wave = tid >> 6, wr = wave >> 1, wc = wave & 1, r = lane & 31, h = lane >> 5;
#define REOPAQUE() do { asm volatile("" : "+v"(tid)); lane = tid & 63; wave = tid >> 6; wr = wave >> 1; wc = wave & 1; r = lane & 31; h = lane >> 5; } while (0)
  const float* sm = (const float*)(p.ws + O_SM);
  if (wave == 0) {
    const int tok = c * 64 + lane;
    const float bt = fsigmoid(sm[tok * 32 + 6 + hh]);
    const float xv = sm[tok * 32 + 12 + hh] + p.dt_bias[layer * 6 + hh];
    const float sp = fmaxf(xv, 0.f) + log1pf(expf(-fabsf(xv)));
    float g = -expf(p.a_log[layer * 6 + hh]) * sp;
#pragma unroll
    for (int o = 1; o < 64; o <<= 1) { const float t = __shfl_up(g, o); if (lane >= o) g += t; }
    gcv[lane] = g; betav[lane] = bt; egc[lane] = expf(g);
    if (lane == 63) ((float*)(p.ws + O_GL))[hh * 128 + c] = expf(g);
  }
  sub_sync();
  REOPAQUE();
  {
    const int t = tid >> 2, cg4 = tid & 3, ch0 = cg4 * 16;
    const bf16_t* src = (const bf16_t*)(p.ws + O_QKVD);
    const float* cw = p.conv_w + (size_t)layer * 4 * 1152;
    const float bt = betav[t], gct = gcv[t], eg = egc[t], ed = expf(gcv[63] - gct);
    auto convpart = [&](int pt, float (&val)[16]) {
      const int col = pt * 384 + hh * 64 + ch0;
#pragma unroll
      for (int e = 0; e < 16; ++e) val[e] = 0.f;
#pragma unroll
      for (int j = 0; j < 4; ++j) {
        const int row = c * 64 + t - 3 + j;
        if (row >= 0) {
          float xv[16];
          unpk8(*(const bf16x8*)(src + (size_t)row * 1152 + col), xv);
          unpk8(*(const bf16x8*)(src + (size_t)row * 1152 + col + 8), xv + 8);
#pragma unroll
          for (int e4 = 0; e4 < 4; ++e4) {
            const f32x4 w4 = *(const f32x4*)(cw + j * 1152 + col + 4 * e4);
#pragma unroll
            for (int e = 0; e < 4; ++e) val[4 * e4 + e] += w4[e] * xv[4 * e4 + e];
          }
        }
      }
#pragma unroll
      for (int e = 0; e < 16; ++e) val[e] = fsilu(val[e]);
    };
    {
      float val[16]; convpart(0, val);
      float sq = 0.f;
#pragma unroll
      for (int e = 0; e < 16; ++e) sq += val[e] * val[e];
      sq += __shfl_xor(sq, 1); sq += __shfl_xor(sq, 2);
      const float rq = rsqrtf(sq + 1e-6f) * 0.125f;
#pragma unroll
      for (int e = 0; e < 16; ++e) val[e] *= rq;
      *(bf16x8*)(QN + t * 72 + ch0) = pk8(val); *(bf16x8*)(QN + t * 72 + ch0 + 8) = pk8(val + 8);
    }
    asm volatile("" ::: "memory");
    {
      float val[16]; convpart(1, val);
      float sk = 0.f;
#pragma unroll
      for (int e = 0; e < 16; ++e) sk += val[e] * val[e];
      sk += __shfl_xor(sk, 1); sk += __shfl_xor(sk, 2);
      const float rk = rsqrtf(sk + 1e-6f);
      float kb[16];
#pragma unroll
      for (int e = 0; e < 16; ++e) { val[e] *= rk; kb[e] = val[e] * bt; }
      *(bf16x8*)(KN + t * 72 + ch0) = pk8(val); *(bf16x8*)(KN + t * 72 + ch0 + 8) = pk8(val + 8);
      *(bf16x8*)(KB + t * 72 + ch0) = pk8(kb); *(bf16x8*)(KB + t * 72 + ch0 + 8) = pk8(kb + 8);
#pragma unroll
      for (int e = 0; e < 16; ++e) {
        KDT[(ch0 + e) * 72 + t] = f2bf(val[e] * ed);
        KBET[(ch0 + e) * 72 + t] = f2bf(kb[e] * eg);
      }
    }
    asm volatile("" ::: "memory");
    {
      float val[16]; convpart(2, val);
#pragma unroll
      for (int e = 0; e < 16; ++e) VBT[(ch0 + e) * 72 + t] = f2bf(val[e] * bt);
    }
  }
  sub_sync();
  REOPAQUE();
  {
    const f32x16 kk = mm_quad(KB, KN, wr, wc, r, h);
    const f32x16 qk = mm_quad(QN, KN, wr, wc, r, h);
    sub_sync();
    const int j = wc * 32 + r; const float gj = gcv[j];
#pragma unroll
    for (int i = 0; i < 16; ++i) {
      const int row = wr * 32 + crow(i, h);
      const float dec = (row >= j) ? expf(gcv[row] - gj) : 0.f;
      Mf[row * 68 + j] = (row > j) ? kk[i] * dec : 0.f;
      QKm[row * 72 + j] = f2bf(qk[i] * dec);
    }
  }
  sub_sync();
  REOPAQUE();
  if (wave == 0) {
    float t[64];
#pragma unroll
    for (int i = 0; i < 64; ++i) {
      float a4[4] = {(i == lane) ? 1.f : 0.f, 0.f, 0.f, 0.f};
#pragma unroll
      for (int j4 = 0; j4 < (i + 3) / 4; ++j4) {
        const f32x4 mrow = *(const f32x4*)(Mf + i * 68 + 4 * j4);
#pragma unroll
        for (int e = 0; e < 4; ++e) if (4 * j4 + e < i) a4[e] -= mrow[e] * t[4 * j4 + e];
      }
      const float a = (a4[0] + a4[1]) + (a4[2] + a4[3]);
      t[i] = a;
      Tm[i * 72 + lane] = f2bf(a);
      asm volatile("" ::: "memory");
    }
  }
  sub_sync();
  REOPAQUE();
  {
    const f32x16 u = mm_quad(Tm, VBT, wr, wc, r, h);
    const f32x16 w = mm_quad(Tm, KBET, wr, wc, r, h);
    const int col = wc * 32 + r;
#pragma unroll
    for (int g = 0; g < 4; ++g) {
      const int i0 = wr * 32 + 8 * g + 4 * h;
      *(u32x2*)(UT + col * 72 + i0) = pk4(u[4 * g], u[4 * g + 1], u[4 * g + 2], u[4 * g + 3]);
      *(u32x2*)(WT + col * 72 + i0) = pk4(w[4 * g], w[4 * g + 1], w[4 * g + 2], w[4 * g + 3]);
    }
  }
  sub_sync();
  REOPAQUE();
  {
    bf16_t* base = (bf16_t*)(p.ws + O_DPREP + (size_t)(hh * 128 + c) * 32768);
    const int n = wc * 32 + r;
    {
      const int ks = n >> 5, jh = (n >> 4) & 1, q = (n >> 2) & 3, jl = n & 3, jj = 4 * jh + jl;
      const int cbase = (ks * 64 + 16 * q) * 8 + jj;
      {
        const f32x16 P = mm_quad(KDT, WT, wr, wc, r, h);
#pragma unroll
        for (int i = 0; i < 16; ++i) {
          const int m = wr * 32 + crow(i, h);
          base[((m >> 4) * 128 + (m & 15)) * 8 + cbase] = f2bf(P[i]);
        }
      }
      asm volatile("" ::: "memory");
      {
        const f32x16 QW = mm_quad(QKm, WT, wr, wc, r, h);
#pragma unroll
        for (int i = 0; i < 16; ++i) {
          const int m = wr * 32 + crow(i, h);
          const float qd = bf2f(QN[m * 72 + n]) * egc[m];
          base[4096 + ((m >> 4) * 128 + (m & 15)) * 8 + cbase] = f2bf(qd - QW[i]);
        }
      }
      asm volatile("" ::: "memory");
    }
    const int jsl = n >> 4;
    {
      const f32x16 Bc = mm_quad(KDT, UT, wr, wc, r, h);
#pragma unroll
      for (int g = 0; g < 4; ++g) {
        const int row0 = wr * 32 + 8 * g + 4 * h;
        const int rt = row0 >> 4, lp = 16 * ((row0 >> 2) & 3) + (n & 15);
        *(u32x2*)(base + 8192 + ((jsl * 4 + rt) * 64 + lp) * 4) = pk4(Bc[4 * g], Bc[4 * g + 1], Bc[4 * g + 2], Bc[4 * g + 3]);
      }
    }
    asm volatile("" ::: "memory");
    {
      const f32x16 O0 = mm_quad(QKm, UT, wr, wc, r, h);
#pragma unroll
      for (int g = 0; g < 4; ++g) {
        const int row0 = wr * 32 + 8 * g + 4 * h;
        const int rt = row0 >> 4, lp = 16 * ((row0 >> 2) & 3) + (n & 15);
        *(u32x2*)(base + 12288 + ((jsl * 4 + rt) * 64 + lp) * 4) = pk4(O0[4 * g], O0[4 * g + 1], O0[4 * g + 2], O0[4 * g + 3]);
      }
    }
  }
  sub_sync();
#undef REOPAQUE
}

struct TileDesc { const bf16_t* k; const bf16_t* v; const float* aux; int tag; };

template <int DHT, bool AUX>
struct TileRegs { bf16x8 k[DHT / 16]; bf16x8 v[DHT / 32][2]; f32x4 a[4]; };

template <int DHT, bool AUX>
DI void load_tile(const bf16_t* kp, const bf16_t* vp, const float* ap, long ldv, TileRegs<DHT, AUX>& t) {
#pragma unroll
  for (int s = 0; s < DHT / 16; ++s) t.k[s] = *(const bf16x8*)(kp + 512 * s);
#pragma unroll
  for (int dt = 0; dt < DHT / 32; ++dt)
#pragma unroll
    for (int s = 0; s < 2; ++s) t.v[dt][s] = *(const bf16x8*)(vp + (dt * 2 + s) * 512);
  if (AUX) {
#pragma unroll
    for (int g = 0; g < 4; ++g) t.a[g] = *(const f32x4*)(ap + 8 * g);
  }
}

template <int DHT, bool AUX, class TF, class MF, class SF>
DI void attn_loop(int maxtiles, TF&& tf, MF&& mf, SF&& stopf, const bf16x8 (&qf)[DHT / 16], long ldv, float scale2,
                  f32x16 (&o)[DHT / 32], float& m, float& l) {
  TileRegs<DHT, AUX> cur, nxt;
  int tagc, tagn;
  bf16x8 qf0 = qf[0];
  { const bf16_t* kp; const bf16_t* vp; const float* ap = nullptr; tagc = tf(0, kp, vp, ap); load_tile<DHT, AUX>(kp, vp, ap, ldv, cur); }
#pragma unroll 1
  for (int t = 0; t < maxtiles; ++t) {
    { const bf16_t* kp; const bf16_t* vp; const float* ap = nullptr; tagn = tf(t + 1, kp, vp, ap); load_tile<DHT, AUX>(kp, vp, ap, ldv, nxt); }
    { bf16x8 q0 = qf[0]; asm volatile("" : "+v"(q0) :: "memory"); qf0 = q0; }
    f32x16 sacc;
#pragma unroll
    for (int i = 0; i < 16; ++i) sacc[i] = 0.f;
#pragma unroll
    for (int s = 0; s < DHT / 16; ++s) sacc = MFMA32(cur.k[s], s == 0 ? qf0 : qf[s], sacc);
    float sv[16]; float mx = NEG_INF;
#pragma unroll
    for (int i = 0; i < 16; ++i) { sv[i] = sacc[i] * scale2 + mf(tagc, i, AUX ? cur.a[i >> 2][i & 3] : 0.f); mx = fmaxf(mx, sv[i]); }
    mx = fmaxf(mx, __shfl_xor(mx, 32));
    const float mnew = fmaxf(m, mx);
    const float alpha = __builtin_amdgcn_exp2f(m - mnew);
    m = mnew;
    float pv[16]; float ps = 0.f;
#pragma unroll
    for (int i = 0; i < 16; ++i) { pv[i] = __builtin_amdgcn_exp2f(sv[i] - mnew); ps += pv[i]; }
    l = l * alpha + ps;
#pragma unroll
    for (int dt = 0; dt < DHT / 32; ++dt)
#pragma unroll
      for (int i = 0; i < 16; ++i) o[dt][i] *= alpha;
    bf16x8 pf[2]; pf[0] = pk8(pv); pf[1] = pk8(pv + 8);
#pragma unroll
    for (int dt = 0; dt < DHT / 32; ++dt)
#pragma unroll
      for (int s = 0; s < 2; ++s) {
        o[dt] = MFMA32(cur.v[dt][s], pf[s], o[dt]);
      }
    if (stopf(t, m, AUX ? cur.a[0][0] : 0.f)) break;
    cur = nxt; tagc = tagn;
  }
}

template <int DHT>
DI void attn_store(const f32x16 (&o)[DHT / 32], float l, bf16_t* dstrow, int h, float& ltot_out, bool valid = true) {
  const float ltot = l + __shfl_xor(l, 32);
  ltot_out = ltot;
  const float inv = ltot > 0.f ? 1.f / ltot : 0.f;
  if (valid)
#pragma unroll
  for (int dt = 0; dt < DHT / 32; ++dt)
#pragma unroll
    for (int g = 0; g < 4; ++g)
      *(u32x2*)(dstrow + dt * 32 + 8 * g + 4 * h) = pk4(o[dt][4 * g] * inv, o[dt][4 * g + 1] * inv, o[dt][4 * g + 2] * inv, o[dt][4 * g + 3] * inv);
}

template <int N>
DI void zero_o(f32x16 (&o)[N]) {
#pragma unroll
  for (int a = 0; a < N; ++a)
#pragma unroll
    for (int i = 0; i < 16; ++i) o[a][i] = 0.f;
}

DI void top3_insert(float v, int n, float& v0, float& v1, float& v2, int& i0, int& i1, int& i2) {
  const bool g0 = v > v0, g1 = v > v1, g2 = v > v2;
  v2 = g1 ? v1 : (g2 ? v : v2); i2 = g1 ? i1 : (g2 ? n : i2);
  v1 = g0 ? v0 : (g1 ? v : v1); i1 = g0 ? i0 : (g1 ? n : i1);
  v0 = g0 ? v : v0;             i0 = g0 ? n : i0;
}

DI void moba_select(const Params& p, int a) {
  const int lane = otid() & 63, r = lane & 31, h = lane >> 5;
  const int qtile = a / 6, hh = a % 6, qb = qtile >> 3;
  unsigned mask = 0;
  if (qb > 0) {
    const bf16_t* qrow = (const bf16_t*)(p.ws + O_QKA) + (size_t)(qtile * 32 + r) * 384 + hh * 64 + 8 * h;
    bf16x8 qf[4];
#pragma unroll
    for (int s = 0; s < 4; ++s) qf[s] = *(const bf16x8*)(qrow + 16 * s);
    const bf16_t* kmh = (const bf16_t*)(p.ws + O_KM) + (hh * 32 + r) * 64 + 8 * h;
    const bf16_t* kml = kmh + 6 * 32 * 64;
    f32x16 g;
#pragma unroll
    for (int i = 0; i < 16; ++i) g[i] = 0.f;
#pragma unroll
    for (int s = 0; s < 4; ++s) { g = MFMA32(*(const bf16x8*)(kmh + 16 * s), qf[s], g); g = MFMA32(*(const bf16x8*)(kml + 16 * s), qf[s], g); }
    float v0 = NEG_INF, v1 = NEG_INF, v2 = NEG_INF; int i0 = -1, i1 = -1, i2 = -1;
#pragma unroll
    for (int i = 0; i < 16; ++i) { const int n = crow(i, h); if (n < qb) top3_insert(g[i], n, v0, v1, v2, i0, i1, i2); }
    const float pv0 = __shfl_xor(v0, 32), pv1 = __shfl_xor(v1, 32), pv2 = __shfl_xor(v2, 32);
    const int pi0 = __shfl_xor(i0, 32), pi1 = __shfl_xor(i1, 32), pi2 = __shfl_xor(i2, 32);
    if (pi0 >= 0) top3_insert(pv0, pi0, v0, v1, v2, i0, i1, i2);
    if (pi1 >= 0) top3_insert(pv1, pi1, v0, v1, v2, i0, i1, i2);
    if (pi2 >= 0) top3_insert(pv2, pi2, v0, v1, v2, i0, i1, i2);
    if (i0 >= 0) mask |= 1u << i0;
    if (i1 >= 0) mask |= 1u << i1;
    if (i2 >= 0) mask |= 1u << i2;
  }
  if (h == 0) ((unsigned*)(p.ws + O_MASK))[(qtile * 32 + r) * 8 + hh] = mask;
}

DI void moba_gather(const Params& p, int a, unsigned char* smem) {
  const int tid = otid(), lane = tid & 63, wave = tid >> 6, r = lane & 31, h = lane >> 5;
  const int part = a & 1, a2 = a >> 1;
  const int hh = a2 % 6, idx = a2 / 6;
  int qb = 1;
  while ((qb + 1) * qb / 2 <= idx) ++qb;
  const int n = idx - qb * (qb - 1) / 2;
  const unsigned* MASK = (const unsigned*)(p.ws + O_MASK);
  unsigned* list = (unsigned*)(smem + wave * 1024);
  int cnt = 0;
#pragma unroll
  for (int j = 0; j < 4; ++j) {
    const int qi = j * 64 + lane;
    const unsigned mk = MASK[(qb * 256 + qi) * 8 + hh];
    const bool pred = (mk >> n) & 1u;
    const unsigned long long ball = __ballot(pred);
    const int pos = cnt + __builtin_popcountll(ball & ((1ull << lane) - 1ull));
    if (pred) list[pos] = (unsigned)qi | ((unsigned)__builtin_popcount(mk & ((1u << n) - 1u)) << 8);
    cnt += __builtin_popcountll(ball);
  }
  cnt = __builtin_amdgcn_readfirstlane(cnt);
  if (cnt == 0) return;
  asm volatile("s_waitcnt lgkmcnt(0)" ::: "memory");
  __builtin_amdgcn_wave_barrier();
  const bf16_t* QK = (const bf16_t*)(p.ws + O_QKA);
  const bf16_t* KF = (const bf16_t*)(p.ws + O_KFA) + (size_t)hh * 524288 + (size_t)n * 8 * 2048 + lane * 8;
  const bf16_t* VT = (const bf16_t*)(p.ws + O_VTA) + (size_t)hh * 524288 + (size_t)n * 8 * 2048 + lane * 8;
  const int nch = (cnt + 31) >> 5;
#pragma unroll 1
  for (int c = part; c < nch; c += 2) {
    const int e = c * 32 + r;
    const bool valid = e < cnt;
    const unsigned ent = list[valid ? e : 0];
    const int tok = qb * 256 + (int)(ent & 255u), slot = (int)(ent >> 8);
    bf16x8 qf[4];
    { const bf16_t* qrow = QK + (size_t)tok * 384 + hh * 64 + 8 * h;
#pragma unroll
      for (int s = 0; s < 4; ++s) qf[s] = *(const bf16x8*)(qrow + 16 * s); }
    auto tf = [&](int t, const bf16_t*& kp, const bf16_t*& vp, const float*&) -> int {
      const int tt = t < 7 ? t : 7;
      kp = KF + tt * 2048; vp = VT + tt * 2048;
      return 0;
    };
    auto mf = [&](int, int, float) -> float { return 0.f; };
    auto sf = [&](int, float, float) { return false; };
    f32x16 o[2]; zero_o(o); float m = -1e30f, l = 0.f;
    int nt8 = 8; asm volatile("" : "+s"(nt8));
    attn_loop<64, false>(nt8, tf, mf, sf, qf, (long)TH, 0.125f * LOG2E, o, m, l);
    float lt;
    attn_store<64>(o, l, (bf16_t*)(p.ws + O_OA + slot * SZ_O) + (size_t)tok * 384 + hh * 64, h, lt, valid);
    if (valid && h == 0) { float* st = (float*)(p.ws + O_STA) + ((size_t)(slot * TH + tok) * 6 + hh) * 2; st[0] = m; st[1] = lt; }
  }
}

DI void moba_own(const Params& p, int a) {
  const int lane = otid() & 63, r = lane & 31, h = lane >> 5;
  const int qtile = 255 - a / 6, hh = a % 6, qb = qtile >> 3, own = qtile & 7;
  const bf16_t* QK = (const bf16_t*)(p.ws + O_QKA);
  const bf16_t* KF = (const bf16_t*)(p.ws + O_KFA) + (size_t)hh * 524288 + (size_t)qb * 8 * 2048 + lane * 8;
  const bf16_t* VT = (const bf16_t*)(p.ws + O_VTA) + (size_t)hh * 524288 + (size_t)qb * 8 * 2048 + lane * 8;
  const int tok = qtile * 32 + r;
  bf16x8 qf[4];
  { const bf16_t* qrow = QK + (size_t)tok * 384 + hh * 64 + 8 * h;
#pragma unroll
    for (int s = 0; s < 4; ++s) qf[s] = *(const bf16x8*)(qrow + 16 * s); }
  auto tf = [&](int t, const bf16_t*& kp, const bf16_t*& vp, const float*&) -> int {
    const int kk = t < own ? t : own;
    kp = KF + kk * 2048; vp = VT + kk * 2048;
    return (kk == own) ? 101 : 100;
  };
  auto mf = [&](int tag, int i, float) -> float {
    if (tag == 100) return 0.f;
    return (crow(i, h) <= r) ? 0.f : NEG_INF;
  };
  auto sf = [&](int, float, float) { return false; };
  f32x16 o[2]; zero_o(o); float m = -1e30f, l = 0.f;
  attn_loop<64, false>(own + 1, tf, mf, sf, qf, (long)TH, 0.125f * LOG2E, o, m, l);
  float lt;
  attn_store<64>(o, l, (bf16_t*)(p.ws + O_OA + 3 * SZ_O) + (size_t)tok * 384 + hh * 64, h, lt);
  if (h == 0) {
    float* st = (float*)(p.ws + O_STA);
    st[((size_t)(3 * TH + tok) * 6 + hh) * 2] = m; st[((size_t)(3 * TH + tok) * 6 + hh) * 2 + 1] = lt;
    const int np = __builtin_popcount(((const unsigned*)(p.ws + O_MASK))[tok * 8 + hh]);
    for (int sl = np; sl < 3; ++sl) { st[((size_t)(sl * TH + tok) * 6 + hh) * 2] = -1e30f; st[((size_t)(sl * TH + tok) * 6 + hh) * 2 + 1] = 0.f; }
  }
}

DI void fox_item(const Params& p, int c, const unsigned* kmaxu) {
  const int lane = otid() & 63, r = lane & 31, h = lane >> 5;
  const int qtile = 255 - c / 6, hh = c % 6;
  const bf16_t* QK = (const bf16_t*)(p.ws + O_QKC);
  const bf16_t* KF = (const bf16_t*)(p.ws + O_KFC);
  const bf16_t* VT = (const bf16_t*)(p.ws + O_VTC);
  const float* FF = (const float*)(p.ws + O_FF) + hh * TH;
  bf16x8 qf[4]; float qn2 = 0.f;
  { const bf16_t* qrow = QK + (size_t)(qtile * 32 + r) * 384 + hh * 64 + 8 * h;
#pragma unroll
    for (int s = 0; s < 4; ++s) { qf[s] = *(const bf16x8*)(qrow + 16 * s); float v[8]; unpk8(qf[s], v);
#pragma unroll
      for (int e = 0; e < 8; ++e) qn2 += v[e] * v[e]; } }
  qn2 += __shfl_xor(qn2, 32);
#pragma unroll
  for (int o = 16; o >= 1; o >>= 1) qn2 = fmaxf(qn2, __shfl_xor(qn2, o));
  const float Fq = FF[qtile * 32 + r];
  const float Ffirst = FF[qtile * 32];
  const float kmaxn = sqrtf(__uint_as_float(kmaxu[hh]));
  const float bound = sqrtf(qn2) * kmaxn * 0.125f + Ffirst;
  auto tf = [&](int t, const bf16_t*& kp, const bf16_t*& vp, const float*& ap) -> int {
    const int keybase = (qtile - t > 0 ? qtile - t : 0) * 32;
    kp = KF + (size_t)hh * 524288 + (keybase >> 5) * 2048 + lane * 8;
    vp = VT + (size_t)hh * 524288 + (keybase >> 5) * 2048 + lane * 8;
    ap = FF + keybase + 4 * h;
    return (t == 0) ? 1 : 0;
  };
  auto mf = [&](int tag, int i, float fk) -> float {
    const float b = (Fq - fk) * LOG2E;
    return (tag == 1 && crow(i, h) > r) ? NEG_INF : b;
  };
  auto sf = [&](int, float m, float a0) {
    const float fkb = __builtin_bit_cast(float, __builtin_amdgcn_readfirstlane(__builtin_bit_cast(int, a0)));
    float mm = m;
#pragma unroll
    for (int o = 16; o >= 1; o >>= 1) mm = fminf(mm, __shfl_xor(mm, o));
    return (bound - fkb) * LOG2E < mm - 45.f;
  };
  f32x16 o[2]; zero_o(o); float m = -1e30f, l = 0.f;
  attn_loop<64, true>(qtile + 1, tf, mf, sf, qf, (long)TH, 0.125f * LOG2E, o, m, l);
  float lt;
  attn_store<64>(o, l, (bf16_t*)(p.ws + O_OC) + (size_t)(qtile * 32 + r) * 384 + hh * 64, h, lt);
}

DI void dil_item(const Params& p, int idx) {
  const int lane = otid() & 63, r = lane & 31, h = lane >> 5;
  const int g = idx / 1536, rem = idx % 1536, hh = rem / 256, w = rem % 256;
  const int dsh = 2 * g;
  const int dil = 1 << dsh, L = TH >> dsh, tps = L / 32;
  const int rs = w / tps, lt_ = w % tps, l0 = lt_ * 32;
  const bf16_t* QK = (const bf16_t*)(p.ws + O_QKB);
  const bf16_t* KF = (const bf16_t*)(p.ws + O_KFB + g * SZ_VT);
  const bf16_t* VT = (const bf16_t*)(p.ws + O_VTB + g * SZ_VT);
  const int tq = (l0 + r) * dil + rs;
  bf16x8 qf[4];
  { const bf16_t* qrow = QK + (size_t)tq * 1152 + g * 384 + hh * 64 + 8 * h;
#pragma unroll
    for (int s = 0; s < 4; ++s) qf[s] = *(const bf16x8*)(qrow + 16 * s); }
  const int t0 = (l0 >= 128) ? 0 : (128 - l0) / 32;
  auto tf = [&](int tt, const bf16_t*& kp, const bf16_t*& vp, const float*&) -> int {
    const int t = (t0 + tt < 4) ? t0 + tt : 4; const int keybase = l0 - 128 + 32 * t;
    kp = KF + (size_t)hh * 524288 + ((rs * L + keybase) >> 5) * 2048 + lane * 8;
    vp = VT + (size_t)hh * 524288 + ((rs * L + keybase) >> 5) * 2048 + lane * 8;
    return t;
  };
  auto mf = [&](int tag, int i, float) -> float {
    const int kj = crow(i, h);
    if (tag == 0) return (kj >= r) ? 0.f : NEG_INF;
    if (tag == 4) return (kj <= r) ? 0.f : NEG_INF;
    return 0.f;
  };
  auto sf = [&](int, float, float) { return false; };
  f32x16 o[2]; zero_o(o); float m = -1e30f, l = 0.f;
  attn_loop<64, false>(5 - t0, tf, mf, sf, qf, (long)TH, 0.125f * LOG2E, o, m, l);
  float lt;
  attn_store<64>(o, l, (bf16_t*)(p.ws + O_OB + g * SZ_O) + (size_t)tq * 384 + hh * 64, h, lt);
  if (h == 0) { float* st = (float*)(p.ws + O_STB) + ((size_t)(g * TH + tq) * 6 + hh) * 2; st[0] = m; st[1] = lt; }
}

DI void mem_item(const Params& p, int half, int e) {
  const int lane = otid() & 63, r = lane & 31, h = lane >> 5;
  const int hd = e & 3, qtile = e >> 2;
  const bf16_t* QE = (const bf16_t*)(p.ws + O_QE);
  const bf16_t* MK = (const bf16_t*)(p.ws + O_MEMK);
  const bf16_t* MV = (const bf16_t*)(p.ws + O_MEMVT);
  bf16x8 qf[6];
  { const bf16_t* qrow = QE + (size_t)(qtile * 32 + r) * 384 + hd * 96 + 8 * h;
#pragma unroll
    for (int s = 0; s < 6; ++s) qf[s] = *(const bf16x8*)(qrow + 16 * s); }
  auto tf = [&](int t, const bf16_t*& kp, const bf16_t*& vp, const float*&) -> int {
    const int keybase = 32 * (t < 7 ? t : 7);
    kp = MK + (size_t)((half * 4 + hd) * 8 + (keybase >> 5)) * 3072 + lane * 8;
    vp = MV + (size_t)((half * 4 + hd) * 8 + (keybase >> 5)) * 3072 + lane * 8;
    return 0;
  };
  auto mf = [&](int, int, float) -> float { return 0.f; };
  auto sf = [&](int, float, float) { return false; };
  f32x16 o[3]; zero_o(o); float m = -1e30f, l = 0.f;
  attn_loop<96, false>(8, tf, mf, sf, qf, 256L, 0.10206207261596577f * LOG2E, o, m, l);
  float lt;
  attn_store<96>(o, l, (bf16_t*)(p.ws + O_OE) + (size_t)(qtile * 32 + r) * 384 + hd * 96, h, lt);
}

DI float dpp_ror(float v, int ctrl);
DI float row16_sum(float v) {
  v += __builtin_bit_cast(float, __builtin_amdgcn_update_dpp(0, __builtin_bit_cast(int, v), 0x128, 0xf, 0xf, false));
  v += __builtin_bit_cast(float, __builtin_amdgcn_update_dpp(0, __builtin_bit_cast(int, v), 0x124, 0xf, 0xf, false));
  v += __builtin_bit_cast(float, __builtin_amdgcn_update_dpp(0, __builtin_bit_cast(int, v), 0x122, 0xf, 0xf, false));
  v += __builtin_bit_cast(float, __builtin_amdgcn_update_dpp(0, __builtin_bit_cast(int, v), 0x121, 0xf, 0xf, false));
  return v;
}

struct ScanRegs { bf16x8 pf[4][2]; bf16x8 qe[4][2]; s16x4 bc[4]; s16x4 o0[4]; float gl; };
DI void scan_load(const Params& p, int hh, int j, int c, int lane, ScanRegs& s) {
  const unsigned char* base = p.ws + O_DPREP + (size_t)(hh * 128 + c) * 32768;
#pragma unroll
  for (int mt = 0; mt < 4; ++mt)
#pragma unroll
    for (int ks = 0; ks < 2; ++ks) {
      s.pf[mt][ks] = *(const bf16x8*)(base + ((mt * 2 + ks) * 64 + lane) * 16);
      s.qe[mt][ks] = *(const bf16x8*)(base + 8192 + ((mt * 2 + ks) * 64 + lane) * 16);
    }
#pragma unroll
  for (int rt = 0; rt < 4; ++rt) {
    s.bc[rt] = *(const s16x4*)(base + 16384 + ((j * 4 + rt) * 64 + lane) * 8);
    s.o0[rt] = *(const s16x4*)(base + 24576 + ((j * 4 + rt) * 64 + lane) * 8);
  }
  s.gl = ((const float*)(p.ws + O_GL))[hh * 128 + c];
}
DI f32x4 s4f(s16x4 v) { u32x2 u = __builtin_bit_cast(u32x2, v); f32x4 r; r[0] = bflo(u.x); r[1] = bfhi(u.x); r[2] = bflo(u.y); r[3] = bfhi(u.y); return r; }

DI void scan_item(const Params& p, int it) {
  const int lane = otid() & 63, q = lane >> 4, cl = lane & 15;
  const int hh = it >> 2, j = it & 3;
  f32x4 S[4];
#pragma unroll
  for (int rt = 0; rt < 4; ++rt) S[rt] = (f32x4){0.f, 0.f, 0.f, 0.f};
  bf16_t* OD = (bf16_t*)(p.ws + O_OD);
  float* SSQ = (float*)(p.ws + O_SSQ);
#ifndef SCAN_PREFETCH
#define SCAN_PREFETCH 1
#endif
  ScanRegs cur, nxt;
  if (SCAN_PREFETCH) scan_load(p, hh, j, 0, lane, cur);
  for (int c = 0; c < 128; ++c) {
    if (SCAN_PREFETCH) {
      scan_load(p, hh, j, (c + 1 < 128) ? c + 1 : c, lane, nxt);
      asm volatile("" : "+v"(S[0][0]) :: "memory");
    } else {
      scan_load(p, hh, j, c, lane, cur);
    }
    bf16x8 bfr[2];
#pragma unroll
    for (int ks = 0; ks < 2; ++ks) {
      u32x4 u; u.x = pk2(S[2 * ks][0], S[2 * ks][1]); u.y = pk2(S[2 * ks][2], S[2 * ks][3]); u.z = pk2(S[2 * ks + 1][0], S[2 * ks + 1][1]); u.w = pk2(S[2 * ks + 1][2], S[2 * ks + 1][3]);
      bfr[ks] = __builtin_bit_cast(bf16x8, u);
    }
    f32x4 aP[4], aO[4];
#pragma unroll
    for (int rt = 0; rt < 4; ++rt) {
      aP[rt] = (f32x4){0.f, 0.f, 0.f, 0.f};
      aO[rt] = s4f(cur.o0[rt]);
#pragma unroll
      for (int ks = 0; ks < 2; ++ks) { aP[rt] = MFMA16(cur.pf[rt][ks], bfr[ks], aP[rt]); aO[rt] = MFMA16(cur.qe[rt][ks], bfr[ks], aO[rt]); }
    }
#pragma unroll
    for (int rt = 0; rt < 4; ++rt) S[rt] = S[rt] * cur.gl - aP[rt] + s4f(cur.bc[rt]);
#pragma unroll
    for (int rt = 0; rt < 4; ++rt)
#pragma unroll
      for (int e = 0; e < 4; ++e) {
        const int tok = c * 64 + 16 * rt + 4 * q + e;
        const float v = aO[rt][e];
        OD[(size_t)tok * 384 + hh * 64 + 16 * j + cl] = f2bf(v);
        const float ss = row16_sum(v * v);
        if (cl == 0) SSQ[(tok * 6 + hh) * 4 + j] = ss;
      }
    if (SCAN_PREFETCH) cur = nxt;
  }
}

DI void scan_block(const Params& p, int hh, unsigned char* smem) {
  const int tid = otid(), lane = tid & 63, j = tid >> 6, q = lane >> 4, cl = lane & 15;
  const unsigned char* src = p.ws + O_DPREP + (size_t)hh * 128 * 32768;
  bf16_t* ostg = (bf16_t*)(smem + 65536);
  bf16x8 R0[8], R1[8];
  auto gld = [&](int c, bf16x8 (&R)[8]) {
    c = c < 128 ? c : 127;
    const unsigned char* b = src + (size_t)c * 32768 + tid * 16;
#pragma unroll
    for (int i = 0; i < 8; ++i) R[i] = *(const bf16x8*)(b + i * 4096);
  };
  auto lst = [&](int buf, const bf16x8 (&R)[8]) {
    unsigned char* d = smem + buf * 32768 + tid * 16;
#pragma unroll
    for (int i = 0; i < 8; ++i) *(bf16x8*)(d + i * 4096) = R[i];
  };
  const float* GL = (const float*)(p.ws + O_GL) + hh * 128;
  const float gl_lo = GL[lane], gl_hi = GL[64 + lane];
  f32x4 S[4];
#pragma unroll
  for (int rt = 0; rt < 4; ++rt) S[rt] = (f32x4){0.f, 0.f, 0.f, 0.f};
  bf16_t* OD = (bf16_t*)(p.ws + O_OD);
  float* SSQ = (float*)(p.ws + O_SSQ);
  f32x4 aO[4];
  auto flush = [&](int cp) {
    const int row = tid >> 2, part = tid & 3;
    const bf16x8 v0 = *(const bf16x8*)(ostg + row * 72 + 16 * part), v1 = *(const bf16x8*)(ostg + row * 72 + 16 * part + 8);
    float f[16]; unpk8(v0, f); unpk8(v1, f + 8);
    float ss = 0.f;
#pragma unroll
    for (int e = 0; e < 16; ++e) ss += f[e] * f[e];
    const int tok = cp * 64 + row;
    bf16_t* dst = OD + (size_t)tok * 384 + hh * 64 + 16 * part;
    *(bf16x8*)dst = v0; *(bf16x8*)(dst + 8) = v1;
    SSQ[(tok * 6 + hh) * 4 + part] = ss;
  };
  auto compute = [&](int buf, int c) {
    const unsigned char* base = smem + buf * 32768;
    const float gl = __builtin_bit_cast(float, __builtin_amdgcn_readlane(__builtin_bit_cast(int, c < 64 ? gl_lo : gl_hi), c & 63));
    bf16x8 bfr[2];
#pragma unroll
    for (int ks = 0; ks < 2; ++ks) {
      u32x4 u; u.x = pk2(S[2 * ks][0], S[2 * ks][1]); u.y = pk2(S[2 * ks][2], S[2 * ks][3]); u.z = pk2(S[2 * ks + 1][0], S[2 * ks + 1][1]); u.w = pk2(S[2 * ks + 1][2], S[2 * ks + 1][3]);
      bfr[ks] = __builtin_bit_cast(bf16x8, u);
    }
    f32x4 aP[4];
#pragma unroll
    for (int rt = 0; rt < 4; ++rt) {
      aP[rt] = (f32x4){0.f, 0.f, 0.f, 0.f};
      aO[rt] = s4f(*(const s16x4*)(base + 24576 + ((j * 4 + rt) * 64 + lane) * 8));
#pragma unroll
      for (int ks = 0; ks < 2; ++ks) {
        aP[rt] = MFMA16(*(const bf16x8*)(base + ((rt * 2 + ks) * 64 + lane) * 16), bfr[ks], aP[rt]);
        aO[rt] = MFMA16(*(const bf16x8*)(base + 8192 + ((rt * 2 + ks) * 64 + lane) * 16), bfr[ks], aO[rt]);
      }
    }
#pragma unroll
    for (int rt = 0; rt < 4; ++rt) S[rt] = S[rt] * gl - aP[rt] + s4f(*(const s16x4*)(base + 16384 + ((j * 4 + rt) * 64 + lane) * 8));
  };
  auto stage_out = [&]() {
#pragma unroll
    for (int rt = 0; rt < 4; ++rt)
#pragma unroll
      for (int e = 0; e < 4; ++e) ostg[(16 * rt + 4 * q + e) * 72 + 16 * j + cl] = f2bf(aO[rt][e]);
  };
  __builtin_amdgcn_s_setprio(3);
  gld(0, R0); gld(1, R1);
  lst(0, R0); gld(2, R0);
  sub_sync();
#pragma unroll 1
  for (int c = 0; c < 128; c += 2) {
    lst(1, R1);
    gld(c + 3, R1);
    if (c > 0) flush(c - 1);
    compute(0, c);
    sub_sync();
    stage_out();
    sub_sync();
    lst(0, R0);
    gld(c + 4, R0);
    flush(c);
    compute(1, c + 1);
    sub_sync();
    stage_out();
    sub_sync();
  }
  flush(127);
  sub_sync();
  __builtin_amdgcn_s_setprio(0);
}

DI void phase3(const Params& p, int half, unsigned* ctr, const unsigned* kmaxu, unsigned char* smem, int sub, int limit = 1 << 30) {
  const int tid = otid(), wave = tid >> 6;
  const int hb = (int)blockIdx.x, x = hb & 7, bi = hb >> 3;
  if (hb < 3 && limit >= 0) { if (PH(5)) scan_block(p, hb * 2 + sub, smem); }
  if (bi >= 1 && limit != 0) {
    const int nlw = ((int)(gridDim.x >> 3) - 1) * 8, lw = ((bi - 1) * 2 + sub) * 4 + wave;
    if (x < 6) {
      const int hh = x;
      constexpr int NG = 992, NOWN = 256, NB_ = 640, NTOT = NG + NOWN + NB_;
      for (int pos0 = lw; pos0 < NTOT; pos0 += nlw) {
        int pos = __builtin_amdgcn_readfirstlane(pos0);
        if (pos < NG) { if (PH(6)) moba_gather(p, (((pos >> 1) * 6 + hh) << 1) | (pos & 1), smem); continue; }
        pos -= NG;
        if (pos < NOWN) { if (PH(6)) moba_own(p, pos * 6 + hh); continue; }
        pos -= NOWN;
        const int g = pos < 512 ? (pos >> 8) : 2, w = pos < 512 ? (pos & 255) : 2 * (pos - 512);
        if (PH(8)) dil_item(p, g * 1536 + hh * 256 + w);
      }
    } else {
      const int h0 = (x - 6) * 3;
      constexpr int NE = 512, NC = 768, NB2 = 384, NTOT = NE + NC + NB2;
      for (int pos0 = lw; pos0 < NTOT; pos0 += nlw) {
        int pos = __builtin_amdgcn_readfirstlane(pos0);
        if (pos < NE) { if (PH(7)) mem_item(p, half, (x - 6) * 512 + pos); continue; }
        pos -= NE;
        if (pos < NC) { if (PH(9)) fox_item(p, (pos & 255) * 6 + h0 + (pos >> 8), kmaxu); continue; }
        pos -= NC;
        if (PH(8)) dil_item(p, 2 * 1536 + (h0 + (pos >> 7)) * 256 + 2 * (pos & 127) + 1);
      }
    }
  }
}

DI void gbuild_chunk(const Params& p, int layer, int tok, int c8) {
  const unsigned char* ws = p.ws;
  const int n = c8 / 48, c = (c8 % 48) * 8;
  bf16_t* szp = (bf16_t*)(p.ws + O_SZ) + (size_t)tok * 1920 + n * 384 + c;
  float o[8], z[8];
  unpk8(*(const bf16x8*)szp, z);
  if (n == 1) {
    const int hh = c >> 6;
    const float* st = (const float*)(ws + O_STB);
    float mg[3], lg[3];
#pragma unroll
    for (int g = 0; g < 3; ++g) { const f32x2 s2 = *(const f32x2*)(st + ((size_t)(g * TH + tok) * 6 + hh) * 2); mg[g] = s2[0]; lg[g] = s2[1]; }
    const float mm = fmaxf(mg[0], fmaxf(mg[1], mg[2]));
    float wg[3], ws_ = 0.f;
#pragma unroll
    for (int g = 0; g < 3; ++g) { wg[g] = exp2f(mg[g] - mm) * lg[g]; ws_ += wg[g]; }
    const float inv = 1.f / ws_;
#pragma unroll
    for (int e = 0; e < 8; ++e) o[e] = 0.f;
#pragma unroll
    for (int g = 0; g < 3; ++g) {
      float t[8]; unpk8(*(const bf16x8*)((const bf16_t*)(ws + O_OB + g * SZ_O) + (size_t)tok * 384 + c), t);
      const float wgi = wg[g] * inv;
#pragma unroll
      for (int e = 0; e < 8; ++e) o[e] += wgi * t[e];
    }
  } else if (n == 3) {
    const int hh = c >> 6;
    const f32x4 sq = *(const f32x4*)((const float*)(ws + O_SSQ) + ((size_t)tok * 6 + hh) * 4);
    const float rs = rsqrtf((sq[0] + sq[1] + sq[2] + sq[3]) * (1.f / 64.f) + 1e-6f);
    unpk8(*(const bf16x8*)((const bf16_t*)(ws + O_OD) + (size_t)tok * 384 + c), o);
    const float* gw = p.gdn_w + layer * 64 + (c & 63);
#pragma unroll
    for (int e = 0; e < 8; ++e) o[e] *= rs * gw[e];
  } else if (n == 0) {
    const int hh = c >> 6;
    const float* st = (const float*)(ws + O_STA);
    float mg[4], lg[4], mm = -1e30f;
#pragma unroll
    for (int g = 0; g < 4; ++g) { const f32x2 s2 = *(const f32x2*)(st + ((size_t)(g * TH + tok) * 6 + hh) * 2); mg[g] = s2[0]; lg[g] = s2[1]; mm = fmaxf(mm, mg[g]); }
    float wg[4], ws_ = 0.f;
#pragma unroll
    for (int g = 0; g < 4; ++g) { wg[g] = exp2f(mg[g] - mm) * lg[g]; ws_ += wg[g]; }
    const float inv = 1.f / ws_;
#pragma unroll
    for (int e = 0; e < 8; ++e) o[e] = 0.f;
#pragma unroll
    for (int g = 0; g < 4; ++g) {
      if (lg[g] > 0.f) {
        float t[8]; unpk8(*(const bf16x8*)((const bf16_t*)(ws + O_OA + g * SZ_O) + (size_t)tok * 384 + c), t);
        const float wgi = wg[g] * inv;
#pragma unroll
        for (int e = 0; e < 8; ++e) o[e] += wgi * t[e];
      }
    }
  } else {
    const size_t off = (n == 2) ? O_OC : O_OE;
    unpk8(*(const bf16x8*)((const bf16_t*)(ws + off) + (size_t)tok * 384 + c), o);
  }
#pragma unroll
  for (int e = 0; e < 8; ++e) o[e] *= z[e];
  *(bf16x8*)szp = pk8(o);
}

DI void p4a_tile(const Params& p, int layer, int mt, int nt, unsigned char* smem) {
  sub_sync();
  bf16_t* As = (bf16_t*)smem; bf16_t* Bs = As + 2 * 9216;
  const int tid = otid(), lane = tid & 63, wave = tid >> 6, wr = wave >> 1, wc = wave & 1, r = lane & 31, h = lane >> 5;
  const int m0 = mt * 128, n0 = nt * 128;
  f32x16 tot[2][2]; zero_acc(tot);
  const bf16_t* SIG = (const bf16_t*)(p.ws + O_SIG);
  for (int n = 0; n < 5; ++n) {
    f32x16 acc[2][2]; zero_acc(acc);
    PlainA al{(const bf16_t*)(p.ws + O_SZ) + n * 384, 1920};
    gemm_kloop_t<32>(al, (const bf16_t*)(p.ws + O_WTBR) + (size_t)(layer * 5 + n) * 1024 * 384, 384, 12, m0, n0, acc, As, Bs);
#pragma unroll
    for (int mi = 0; mi < 2; ++mi) {
      const int tok = m0 + wr * 64 + mi * 32 + r;
#pragma unroll
      for (int ni = 0; ni < 2; ++ni)
#pragma unroll
        for (int g = 0; g < 4; ++g) {
          const int col = n0 + wc * 64 + ni * 32 + 8 * g + 4 * h;
          const u32x2 sg = *(const u32x2*)(SIG + (size_t)tok * 5120 + n * 1024 + col);
          tot[mi][ni][4 * g] += bflo(sg.x) * acc[mi][ni][4 * g];
          tot[mi][ni][4 * g + 1] += bfhi(sg.x) * acc[mi][ni][4 * g + 1];
          tot[mi][ni][4 * g + 2] += bflo(sg.y) * acc[mi][ni][4 * g + 2];
          tot[mi][ni][4 * g + 3] += bfhi(sg.y) * acc[mi][ni][4 * g + 3];
          asm volatile("" ::: "memory");
        }
    }
  }
  bf16_t* YM = (bf16_t*)(p.ws + O_YM);
  {
    bf16_t* stg = (bf16_t*)smem + wave * (64 * 72);
#pragma unroll
    for (int ni = 0; ni < 2; ++ni)
#pragma unroll
      for (int mi = 0; mi < 2; ++mi)
#pragma unroll
        for (int g = 0; g < 4; ++g)
          *(u32x2*)(stg + (mi * 32 + r) * 72 + ni * 32 + 8 * g + 4 * h) = pk4(tot[mi][ni][4 * g], tot[mi][ni][4 * g + 1], tot[mi][ni][4 * g + 2], tot[mi][ni][4 * g + 3]);
    asm volatile("s_waitcnt lgkmcnt(0)" ::: "memory");
    __builtin_amdgcn_wave_barrier();
    const int tok0 = m0 + wr * 64, col0 = n0 + wc * 64;
#pragma unroll
    for (int it = 0; it < 8; ++it) {
      const int row = it * 8 + (lane >> 3), ch = (lane & 7) * 8;
      const bf16x8 val = *(const bf16x8*)(stg + row * 72 + ch);
      *(bf16x8*)(YM + (size_t)(tok0 + row) * 1024 + col0 + ch) = val;
    }
  }
}

DI void p4b_tile(const Params& p, int layer, int half, int mt, int nt, unsigned char* smem) {
  bf16_t* As = (bf16_t*)smem; bf16_t* Bs = As + 2 * 9216;
  const int tid = otid(), lane = tid & 63, wave = tid >> 6, wr = wave >> 1, wc = wave & 1, r = lane & 31, h = lane >> 5;
  const int m0 = mt * 128, n0 = nt * 128;
  f32x16 acc[2][2]; zero_acc(acc);
  PlainA al{(const bf16_t*)(p.ws + O_YM), 1024};
  gemm_kloop(al, (const bf16_t*)(p.ws + O_WTOUT + layer * SZ_WTOUT1), 1024, 16, m0, n0, acc, As, Bs);
  const float* xin = layer == 0 ? p.x : p.out;
  const float alpha = 1.4142135623730951f;
#pragma unroll
  for (int mi = 0; mi < 2; ++mi) {
    const size_t gt = (size_t)half * TH + m0 + wr * 64 + mi * 32 + r;
#pragma unroll
    for (int ni = 0; ni < 2; ++ni)
#pragma unroll
      for (int g = 0; g < 4; ++g) {
        const int col = n0 + wc * 64 + ni * 32 + 8 * g + 4 * h;
        const f32x4 xv = *(const f32x4*)(xin + gt * 1024 + col);
        f32x4 o;
#pragma unroll
        for (int e = 0; e < 4; ++e) o[e] = alpha * xv[e] + acc[mi][ni][4 * g + e];
        *(f32x4*)(p.out + gt * 1024 + col) = o;
      }
  }
}

DI void p4c_row(const Params& p, int layer, size_t gt, bool wxb = true) {
  const int lane = otid() & 63;
  float* row = p.out + gt * 1024;
  f32x4 v[4]; float s = 0.f;
#pragma unroll
  for (int j = 0; j < 4; ++j) { v[j] = *(const f32x4*)(row + 4 * lane + 256 * j); s += v[j][0] + v[j][1] + v[j][2] + v[j][3]; }
#pragma unroll
  for (int o = 32; o >= 1; o >>= 1) s += __shfl_xor(s, o);
  const float mu = s * (1.f / 1024.f); float q = 0.f;
#pragma unroll
  for (int j = 0; j < 4; ++j) { v[j] -= mu; q += v[j][0] * v[j][0] + v[j][1] * v[j][1] + v[j][2] * v[j][2] + v[j][3] * v[j][3]; }
#pragma unroll
  for (int o = 32; o >= 1; o >>= 1) q += __shfl_xor(q, o);
  const float rs = rsqrtf(q * (1.f / 1024.f) + 1e-5f);
  bf16_t* xb = (bf16_t*)(p.ws + O_XB) + gt * 1024;
#pragma unroll
  for (int j = 0; j < 4; ++j) {
    const int c = 4 * lane + 256 * j;
    const f32x4 g = *(const f32x4*)(p.ln_g + layer * 1024 + c), b = *(const f32x4*)(p.ln_b + layer * 1024 + c);
    f32x4 y;
#pragma unroll
    for (int e = 0; e < 4; ++e) y[e] = v[j][e] * rs * g[e] + b[e];
    *(f32x4*)(row + c) = y;
    if (wxb) *(u32x2*)(xb + c) = pk4(y[0], y[1], y[2], y[3]);
  }
}


#define XB_TMO      128
#define XB_XCNT(j)  (256  + 64 * (j))
#define XB_XSUB(j)  (1280 + 64 * (j))
#define XB_XGEN(j)  (2304 + 64 * (j))
#define XB_TOP      3328
#define XB_TOPGEN   3392
#define XB_SPIN_CAP (1u << 22)
#define LAS __attribute__((address_space(3)))
DI unsigned xb_ld(unsigned* p) { return __hip_atomic_load(p, __ATOMIC_RELAXED, __HIP_MEMORY_SCOPE_AGENT); }
DI unsigned xb_add(unsigned* p, unsigned v) { return __hip_atomic_fetch_add(p, v, __ATOMIC_RELAXED, __HIP_MEMORY_SCOPE_AGENT); }
DI unsigned xb_xcc_id() { return (unsigned)__builtin_amdgcn_s_getreg((3 << 11) | 20) & 0xFu; }
#define XB_SPIN(cond, bar) do { unsigned _sp = 0; while (cond) { __builtin_amdgcn_s_sleep(1); \
    if ((++_sp & 255u) == 0u) { if (xb_ld(&(bar)[XB_TMO])) break; if (_sp > XB_SPIN_CAP) { atomicAdd(&(bar)[XB_TMO], 1u); break; } } } } while (0)
struct XcdBarrier { unsigned* bar; unsigned x; volatile LAS unsigned* st; };
DI XcdBarrier xcd_barrier_post(unsigned* bar, volatile LAS unsigned* st) {
  XcdBarrier b; b.bar = bar; b.x = xb_xcc_id(); b.st = st;
  if (threadIdx.x == 0) (void)xb_add(&bar[XB_XCNT(b.x)], 1u);
  return b;
}
DI void xcd_barrier_complete(unsigned* bar, unsigned x, unsigned& nloc, unsigned& nx) {
  const unsigned G = gridDim.x;
  unsigned sum, cnt, mine, sp = 0u;
  for (;;) {
    sum = 0u; cnt = 0u; mine = 0u;
#pragma unroll
    for (unsigned j = 0; j < 16; ++j) { const unsigned c = xb_ld(&bar[XB_XCNT(j)]); sum += c; cnt += (c > 0u) ? 1u : 0u; mine = (j == x) ? c : mine; }
    if (sum == G) break;
    __builtin_amdgcn_s_sleep(1);
    if ((++sp & 255u) == 0u) { if (xb_ld(&bar[XB_TMO])) break; if (sp > XB_SPIN_CAP) { atomicAdd(&bar[XB_TMO], 1u); break; } }
  }
  nloc = mine > 0u ? mine : 1u; nx = cnt > 0u ? cnt : 1u;
}
DI void xcd_barrier(const XcdBarrier& b) {
  asm volatile("s_waitcnt vmcnt(0)" ::: "memory");
  __syncthreads();
  if (threadIdx.x == 0) {
    unsigned* bar = b.bar;
    __builtin_amdgcn_s_waitcnt(0);
    unsigned nloc = b.st[0], nx = b.st[1];
    if (nloc == 0u) { xcd_barrier_complete(bar, b.x, nloc, nx); b.st[0] = nloc; b.st[1] = nx; }
    const unsigned old = xb_add(&bar[XB_XSUB(b.x)], 1u);
    const unsigned gen = old / nloc;
    if (old + 1u == (gen + 1u) * nloc) {
      __builtin_amdgcn_fence(__ATOMIC_RELEASE, "agent");
      asm volatile("s_waitcnt vmcnt(0)" ::: "memory");
      const unsigned og = xb_add(&bar[XB_TOP], 1u);
      const unsigned tg = og / nx;
      if (og + 1u == (tg + 1u) * nx) xb_add(&bar[XB_TOPGEN], 1u);
      else XB_SPIN(xb_ld(&bar[XB_TOPGEN]) == tg, bar);
      __builtin_amdgcn_fence(__ATOMIC_ACQUIRE, "agent");
      xb_add(&bar[XB_XGEN(b.x)], 1u);
      asm volatile("s_waitcnt vmcnt(0)" ::: "memory");
    } else {
      XB_SPIN(xb_ld(&bar[XB_XGEN(b.x)]) == gen, bar);
      __builtin_amdgcn_fence(__ATOMIC_ACQUIRE, "agent");
      asm volatile("s_waitcnt vmcnt(0)" ::: "memory");
    }
  }
  __syncthreads();
}

#ifdef PROBE_A
#define STAMP(k) do { if (blockIdx.x == 0 && otid() == 0) { unsigned long long now_ = __builtin_amdgcn_s_memrealtime(); tsacc[k] += (float)(now_ - tlast) * 0.01f; tlast = now_; } } while (0)
#else
#define STAMP(k) do {} while (0)
#endif
__global__ void __launch_bounds__(512, 2) mega(Params p) {
  extern __shared__ __attribute__((aligned(16))) unsigned char smem_all[];
  cg::grid_group grid = cg::this_grid();
  if (p.ws == nullptr) grid.sync();
  volatile LAS unsigned* xbst = (volatile LAS unsigned*)(smem_all + 2 * SUB_LDS);
  if (threadIdx.x < 4) xbst[threadIdx.x] = 0u;
  __syncthreads();
  const XcdBarrier xb = xcd_barrier_post((unsigned*)(p.ws + O_BAR), xbst);
#define GSYNC() xcd_barrier(xb)
  const int sub = __builtin_amdgcn_readfirstlane(__builtin_amdgcn_workitem_id_x() >> 8);
  unsigned char* smem = smem_all + sub * SUB_LDS;
  const int vb = (int)blockIdx.x * 2 + sub, vgrid = (int)gridDim.x * 2;
  const int wave = otid() >> 6;
  const int gw = vb * 4 + wave, ngw = vgrid * 4;
  phase0(p, smem, vb, vgrid);
  GSYNC();
  int pend_layer = -1, pend_half = 0;
  for (int itn = 0; itn < 4; ++itn) {
    const int layer = itn >> 1, half = itn & 1;
    if (pend_layer >= 0) { for (int rw = gw; rw < TH; rw += ngw) p4c_row(p, pend_layer, (size_t)pend_half * TH + rw, true); pend_layer = -1; }
    for (int t = (int)blockIdx.x; t < 32 * 54; t += (int)gridDim.x) p1_unit(p, layer, half, t & 31, t >> 5, smem_all);
    GSYNC();
    {
      constexpr int N_FOX = 6, N_GDN = 768, N_MKV = 12, N_KM = 48, TOT = N_FOX + N_GDN + N_MKV + N_KM;
      for (int t = vb; t < TOT; t += vgrid) {
        int i = t;
        if (i < N_FOX) { fox_prep(p, i, smem); continue; }
        i -= N_FOX;
        if (i < N_GDN) { gdn_prep(p, layer, half, i / 128, i % 128, smem); continue; }
        i -= N_GDN;
        if (i < N_MKV) { memkv_tile(p, layer, half, i / 6, i % 6, smem); continue; }
        i -= N_MKV;
        kmean_prep(p, i * 4 + wave, (unsigned*)(p.ws + O_CTL) + 64 + (layer * 2 + half) * 8);
      }
    }
    GSYNC();
    for (int a = gw; a < 1536; a += ngw) moba_select(p, a);
    GSYNC();
    phase3(p, half, (unsigned*)(p.ws + O_CTL) + layer * 2 + half, (const unsigned*)(p.ws + O_CTL) + 64 + (layer * 2 + half) * 8, smem, sub);
    GSYNC();
    for (int ci = vb * 256 + otid(); ci < TH * 240; ci += vgrid * 256) gbuild_chunk(p, layer, ci / 240, ci % 240);
    GSYNC();
    for (int t = vb; t < 512; t += vgrid) p4a_tile(p, layer, t % 64, t / 64, smem);
    GSYNC();
    for (int t = vb; t < 512; t += vgrid) p4b_tile(p, layer, half, t % 64, t / 64, smem);
    GSYNC();
    pend_layer = layer; pend_half = half;
  }
  if (pend_layer >= 0) { for (int rw = gw; rw < TH; rw += ngw) p4c_row(p, pend_layer, (size_t)pend_half * TH + rw, true); }
}

extern "C" void kernel_launch(void* const* d_in, const int* in_sizes, int n_in, void* d_out, int out_size, void* d_ws, size_t ws_size,
                              hipStream_t stream) {
  static int grid_blocks = 0;
  if (grid_blocks == 0) {
    if (ws_size < WS_END) { fprintf(stderr, "workspace too small: %zu < %zu\n", ws_size, (size_t)WS_END); grid_blocks = -1; return; }
    int dev = 0, cus = 0, per_cu = 0;
    (void)hipGetDevice(&dev);
    (void)hipDeviceGetAttribute(&cus, hipDeviceAttributeMultiprocessorCount, dev);
    (void)hipFuncSetAttribute((const void*)mega, hipFuncAttributeMaxDynamicSharedMemorySize, LDS_BYTES);
    (void)hipOccupancyMaxActiveBlocksPerMultiprocessor(&per_cu, (const void*)mega, 512, LDS_BYTES);
    if (per_cu < 1) per_cu = 1;
    if (per_cu > 1) per_cu = 1;
    grid_blocks = cus * per_cu;
  }
  if (grid_blocks < 0) return;
  (void)hipMemsetAsync((char*)d_ws + O_CTL, 0, 32768, stream);
  Params p{};
  p.x = (const float*)d_in[0]; p.mem = (const float*)d_in[1]; p.mem_g = (const float*)d_in[2]; p.mem_b = (const float*)d_in[3];
  p.w_in = (const float*)d_in[4]; p.b_in = (const float*)d_in[5]; p.conv_w = (const float*)d_in[6]; p.a_log = (const float*)d_in[7];
  p.dt_bias = (const float*)d_in[8]; p.gdn_w = (const float*)d_in[9]; p.w_kv = (const float*)d_in[10]; p.w_br = (const float*)d_in[11];
  p.w_out = (const float*)d_in[12]; p.ln_g = (const float*)d_in[13]; p.ln_b = (const float*)d_in[14];
  p.out = (float*)d_out; p.ws = (unsigned char*)d_ws;
  void* args[] = {&p};
  hipError_t e = hipLaunchCooperativeKernel((const void*)mega, dim3(grid_blocks), dim3(512), args, LDS_BYTES, stream);
  if (e != hipSuccess) fprintf(stderr, "cooperative launch failed: %s (grid %d)\n", hipGetErrorString(e), grid_blocks);
}
```

```cpp
#include <hip/hip_runtime.h>
#include <hip/hip_cooperative_groups.h>
#include <cstdio>
#include <cstdint>
namespace cg = cooperative_groups;

#define DI __device__ __forceinline__
typedef unsigned short bf16_t;
typedef short bf16x8 __attribute__((ext_vector_type(8)));
typedef short s16x4 __attribute__((ext_vector_type(4)));
typedef float f32x4 __attribute__((ext_vector_type(4)));
typedef float f32x2 __attribute__((ext_vector_type(2)));
typedef float f32x16 __attribute__((ext_vector_type(16)));
typedef unsigned u32x2 __attribute__((ext_vector_type(2)));
typedef unsigned u32x4 __attribute__((ext_vector_type(4)));
typedef __bf16 bfv2 __attribute__((ext_vector_type(2)));

#define MFMA32(a, b, c) __builtin_amdgcn_mfma_f32_32x32x16_bf16((a), (b), (c), 0, 0, 0)
#define MFMA16(a, b, c) __builtin_amdgcn_mfma_f32_16x16x32_bf16((a), (b), (c), 0, 0, 0)

DI unsigned pk2(float a, float b) { f32x2 v = {a, b}; return __builtin_bit_cast(unsigned, __builtin_convertvector(v, bfv2)); }
DI bf16_t f2bf(float a) { return (bf16_t)(pk2(a, 0.f) & 0xffffu); }
DI float bf2f(bf16_t v) { return __uint_as_float(((unsigned)v) << 16); }
DI float bflo(unsigned u) { return __uint_as_float(u << 16); }
DI float bfhi(unsigned u) { return __uint_as_float(u & 0xffff0000u); }
DI int rtid() { int t = __builtin_amdgcn_workitem_id_x(); asm volatile("" : "+v"(t)); return t; }
DI int otid() { return rtid() & 255; }
extern __shared__ __attribute__((aligned(16))) unsigned char g_lds_all[];
#define LAS3 __attribute__((address_space(3)))
DI void sub_sync() {
  asm volatile("s_waitcnt lgkmcnt(0)" ::: "memory");
  const int t = __builtin_amdgcn_workitem_id_x();
  LAS3 unsigned* c = (LAS3 unsigned*)(g_lds_all + 2 * 75776 + 8) + (t >> 8);
  if ((t & 63) == 0) {
    const unsigned old = __hip_atomic_fetch_add(c, 1u, __ATOMIC_RELAXED, __HIP_MEMORY_SCOPE_WORKGROUP);
    const unsigned target = (old / 4u + 1u) * 4u;
    while (__hip_atomic_load(c, __ATOMIC_RELAXED, __HIP_MEMORY_SCOPE_WORKGROUP) < target) __builtin_amdgcn_s_sleep(1);
  }
  asm volatile("s_waitcnt lgkmcnt(0)" ::: "memory");
}
DI int crow(int i, int h) { return (i & 3) + 8 * (i >> 2) + 4 * h; }
DI float fsigmoid(float v) { return __builtin_amdgcn_rcpf(1.f + __expf(-v)); }
DI float fsilu(float v) { return v * fsigmoid(v); }
DI u32x2 pk4(float a, float b, float c, float d) { u32x2 r; r.x = pk2(a, b); r.y = pk2(c, d); return r; }
DI bf16x8 pk8(const float* v) { u32x4 r; r.x = pk2(v[0], v[1]); r.y = pk2(v[2], v[3]); r.z = pk2(v[4], v[5]); r.w = pk2(v[6], v[7]); return __builtin_bit_cast(bf16x8, r); }
DI void unpk8(bf16x8 x, float* v) { u32x4 u = __builtin_bit_cast(u32x4, x); v[0] = bflo(u.x); v[1] = bfhi(u.x); v[2] = bflo(u.y); v[3] = bfhi(u.y); v[4] = bflo(u.z); v[5] = bfhi(u.z); v[6] = bflo(u.w); v[7] = bfhi(u.w); }

constexpr int NB = 2, SQ = 8192, NT = NB * SQ, DM = 1024, NH = 6, BW = 384;
constexpr int TH = 8192;
constexpr int NP = 13824;
constexpr int DIN = 13586;
constexpr float LOG2E = 1.4426950408889634f;
#define NEG_INF (-__builtin_inff())

constexpr int C_AQK = 0, C_AV = 768, C_BQK = 1152, C_BV = 3456, C_CQK = 3840, C_CV = 4608, C_D = 4992, C_E = 6144, C_SM = 6528, C_SMEND = 6546, C_Z = 6656, C_MG = 8576;

__host__ __device__ constexpr int inmap(int n) {
  return n < 4992 ? n : n < 6144 ? n + 6 : n < 6528 ? n + 18 : n < 6534 ? n - 1536 : n < 6546 ? n - 384 : n < 6656 ? -1 : n < 13696 ? n - 110 : -1;
}

constexpr size_t O_CTL = 0;
constexpr size_t O_BAR = 4096;
constexpr size_t O_WTIN = 32768;
constexpr size_t SZ_WTIN1 = (size_t)NP * 1024 * 2;
constexpr size_t O_WTBR = O_WTIN + 2 * SZ_WTIN1;
constexpr size_t SZ_WTBR1 = (size_t)5 * 1024 * 384 * 2;
constexpr size_t O_WTOUT = O_WTBR + 2 * SZ_WTBR1;
constexpr size_t SZ_WTOUT1 = (size_t)1024 * 1024 * 2;
constexpr size_t O_WTKV = O_WTOUT + 2 * SZ_WTOUT1;
constexpr size_t SZ_WTKV1 = (size_t)768 * 1024 * 2;
constexpr size_t O_BIASP = O_WTKV + 2 * SZ_WTKV1;
constexpr size_t O_XB = O_BIASP + (size_t)2 * NP * 4;
constexpr size_t O_MEMN = O_XB + (size_t)NT * 1024 * 2;
constexpr size_t O_MEMK = O_MEMN + (size_t)512 * 1024 * 2;
constexpr size_t O_MEMVT = O_MEMK + (size_t)512 * 384 * 2;
constexpr size_t O_QKA = O_MEMVT + (size_t)512 * 384 * 2;
constexpr size_t SZ_VT = (size_t)384 * TH * 2;
constexpr size_t O_KFA = O_QKA + SZ_VT;
constexpr size_t O_VTA = O_KFA + SZ_VT;
constexpr size_t O_QKB = O_VTA + SZ_VT;
constexpr size_t O_KFB = O_QKB + 3 * SZ_VT;
constexpr size_t O_VTB = O_KFB + 3 * SZ_VT;
constexpr size_t O_QKC = O_VTB + 3 * SZ_VT;
constexpr size_t O_KFC = O_QKC + SZ_VT;
constexpr size_t O_VTC = O_KFC + SZ_VT;
constexpr size_t O_QKVD = O_VTC + SZ_VT;
constexpr size_t O_QE = O_QKVD + (size_t)TH * 1152 * 2;
constexpr size_t O_SM = O_QE + (size_t)TH * 384 * 2;
constexpr size_t O_FF = O_SM + (size_t)TH * 32 * 4;
constexpr size_t O_KM = O_FF + (size_t)6 * TH * 4;
constexpr size_t O_KMAX = O_KM + (size_t)2 * 6 * 32 * 64 * 2;
constexpr size_t O_GL = O_KMAX + 256;
constexpr size_t O_MASK = O_GL + 6 * 128 * 4;
constexpr size_t O_DPREP = O_MASK + (size_t)TH * 8 * 4;
constexpr size_t O_SZ = O_DPREP + (size_t)768 * 32768;
constexpr size_t O_SIG = O_SZ + (size_t)TH * 1920 * 2;
constexpr size_t O_OA = O_SIG + (size_t)TH * 5120 * 2;
constexpr size_t SZ_O = (size_t)TH * 384 * 2;
constexpr size_t O_STA = O_OA + 4 * SZ_O;
constexpr size_t O_OB = O_STA + (size_t)4 * TH * 6 * 2 * 4;
constexpr size_t O_STB = O_OB + 3 * SZ_O;
constexpr size_t O_OC = O_STB + (size_t)3 * TH * 6 * 2 * 4;
constexpr size_t O_OD = O_OC + SZ_O;
constexpr size_t O_SSQ = O_OD + SZ_O;
constexpr size_t O_OE = O_SSQ + (size_t)TH * 6 * 4 * 4;
constexpr size_t WS_END = O_OE + SZ_O;
constexpr size_t O_YM = O_QKB;
static_assert(WS_END < (size_t)443 * 1000 * 1000, "workspace too large");

struct Params {
  const float *x, *mem, *mem_g, *mem_b, *w_in, *b_in, *conv_w, *a_log, *dt_bias, *gdn_w, *w_kv, *w_br, *w_out, *ln_g, *ln_b;
  float* out;
  unsigned char* ws;
};

constexpr int SUB_LDS = 75776;
constexpr int LDS_BYTES = 2 * SUB_LDS + 16;
#ifndef PH_MASK
#define PH_MASK 0xFFFF
#endif
#define PH(x) ((PH_MASK >> (x)) & 1)
#ifndef REP_MASK
#define REP_MASK 0
#endif
#define REP(x) (1 + ((REP_MASK >> (x)) & 1))

DI void transpose_tile(const float* __restrict__ src, int ld, int k0, int n0, bool usemap, bf16_t* __restrict__ dst, int dstld, float* tile) {
  const int tid = otid();
#pragma unroll
  for (int it = 0; it < 16; ++it) {
    const int kk = (tid >> 6) + 4 * it, n2 = (tid & 63) * 2;
    const int sc = usemap ? inmap(n0 + n2) : (n0 + n2);
    f32x2 v = {0.f, 0.f};
    if (sc >= 0) v = *(const f32x2*)(src + (size_t)(k0 + kk) * ld + sc);
    *(f32x2*)(tile + kk * 130 + n2) = v;
  }
  sub_sync();
#pragma unroll
  for (int it = 0; it < 4; ++it) {
    const int nn = (tid >> 3) + 32 * it, kc = (tid & 7) * 8;
    float v[8];
#pragma unroll
    for (int e = 0; e < 8; ++e) v[e] = tile[(kc + e) * 130 + nn];
    *(bf16x8*)(dst + (size_t)(n0 + nn) * dstld + k0 + kc) = pk8(v);
  }
  sub_sync();
}

DI void phase0(const Params& p, unsigned char* smem, int vb, int vgrid) {
  float* tile = (float*)smem;
  const int tid = otid(), lane = tid & 63, wave = tid >> 6;
  constexpr int N_TIN = 2 * 108 * 16, N_TBR = 2 * 5 * 8 * 6, N_TOUT = 2 * 8 * 16, N_TKV = 2 * 6 * 16, N_XB = 1024, N_MEMN = 128, N_BIAS = 108;
  constexpr int TOT = N_TIN + N_TBR + N_TOUT + N_TKV + N_XB + N_MEMN + N_BIAS;
  for (int it = vb; it < TOT; it += vgrid) {
    int i = it;
    if (i < N_TIN) {
      const int l = i / (108 * 16), rr = i % (108 * 16), nt = rr / 16, kt = rr % 16;
      transpose_tile(p.w_in + (size_t)l * 1024 * DIN, DIN, kt * 64, nt * 128, true, (bf16_t*)(p.ws + O_WTIN + l * SZ_WTIN1), 1024, tile);
      continue;
    }
    i -= N_TIN;
    if (i < N_TBR) {
      const int ln = i / 48, rr = i % 48, nt = rr / 6, kt = rr % 6;
      transpose_tile(p.w_br + (size_t)ln * 384 * 1024, 1024, kt * 64, nt * 128, false, (bf16_t*)(p.ws + O_WTBR) + (size_t)ln * 1024 * 384, 384, tile);
      continue;
    }
    i -= N_TBR;
    if (i < N_TOUT) {
      const int l = i / 128, rr = i % 128, nt = rr / 16, kt = rr % 16;
      transpose_tile(p.w_out + (size_t)l * 1024 * 1024, 1024, kt * 64, nt * 128, false, (bf16_t*)(p.ws + O_WTOUT + l * SZ_WTOUT1), 1024, tile);
      continue;
    }
    i -= N_TOUT;
    if (i < N_TKV) {
      const int l = i / 96, rr = i % 96, nt = rr / 16, kt = rr % 16;
      transpose_tile(p.w_kv + (size_t)l * 1024 * 768, 768, kt * 64, nt * 128, false, (bf16_t*)(p.ws + O_WTKV + l * SZ_WTKV1), 1024, tile);
      continue;
    }
    i -= N_TKV;
    if (i < N_XB) {
      const float* src = p.x + (size_t)i * 16 * 1024;
      bf16_t* dst = (bf16_t*)(p.ws + O_XB) + (size_t)i * 16 * 1024;
#pragma unroll
      for (int j = 0; j < 16; ++j) {
        const int e = (j * 256 + tid) * 4;
        const f32x4 v = *(const f32x4*)(src + e);
        *(u32x2*)(dst + e) = pk4(v[0], v[1], v[2], v[3]);
      }
      continue;
    }
    i -= N_XB;
    if (i < N_MEMN) {
      const int row = i * 4 + wave;
      const float* src = p.mem + (size_t)row * 1024;
      f32x4 v[4]; float s = 0.f;
#pragma unroll
      for (int j = 0; j < 4; ++j) { v[j] = *(const f32x4*)(src + 4 * lane + 256 * j); s += v[j][0] + v[j][1] + v[j][2] + v[j][3]; }
#pragma unroll
      for (int o = 32; o >= 1; o >>= 1) s += __shfl_xor(s, o);
      const float mu = s * (1.f / 1024.f); float q = 0.f;
#pragma unroll
      for (int j = 0; j < 4; ++j) { v[j] -= mu; q += v[j][0] * v[j][0] + v[j][1] * v[j][1] + v[j][2] * v[j][2] + v[j][3] * v[j][3]; }
#pragma unroll
      for (int o = 32; o >= 1; o >>= 1) q += __shfl_xor(q, o);
      const float rs = rsqrtf(q * (1.f / 1024.f) + 1e-5f);
      bf16_t* dst = (bf16_t*)(p.ws + O_MEMN) + (size_t)row * 1024;
#pragma unroll
      for (int j = 0; j < 4; ++j) {
        const int c = 4 * lane + 256 * j;
        const f32x4 g = *(const f32x4*)(p.mem_g + c), b = *(const f32x4*)(p.mem_b + c);
        *(u32x2*)(dst + c) = pk4(v[j][0] * rs * g[0] + b[0], v[j][1] * rs * g[1] + b[1], v[j][2] * rs * g[2] + b[2], v[j][3] * rs * g[3] + b[3]);
      }
      continue;
    }
    i -= N_MEMN;
    {
      float* bp = (float*)(p.ws + O_BIASP);
      if (tid < 128) {
        const int n = i * 128 + tid;
        const int sc = inmap(n);
        for (int l = 0; l < 2; ++l) bp[l * NP + n] = sc >= 0 ? p.b_in[l * DIN + sc] : 0.f;
      }
    }
  }
}

template <int BK, class AL>
DI void gemm_kloop_t(const AL& al, const bf16_t* __restrict__ Bt, int ldb, int nkt, int m0, int n0, f32x16 (&acc)[2][2], bf16_t* As, bf16_t* Bs) {
  constexpr int CPR = BK / 8, NCH = BK / 16, PITCH = BK + 8, BUF = 128 * PITCH;
  const int tid = otid(), lane = tid & 63, wave = tid >> 6, wr = wave >> 1, wc = wave & 1, r = lane & 31, h = lane >> 5;
  bf16x8 ra[NCH], rb[NCH];
  auto gload = [&](int kt) {
#pragma unroll
    for (int i = 0; i < NCH; ++i) {
      const int cid = tid + 256 * i, row = cid / CPR, kc = (cid % CPR) * 8;
      ra[i] = al(m0 + row, kt * BK + kc);
      rb[i] = *(const bf16x8*)(Bt + (size_t)(n0 + row) * ldb + kt * BK + kc);
    }
  };
  auto lstore = [&](int buf) {
#pragma unroll
    for (int i = 0; i < NCH; ++i) {
      const int cid = tid + 256 * i, row = cid / CPR, kc = (cid % CPR) * 8;
      *(bf16x8*)(As + buf * BUF + row * PITCH + kc) = ra[i];
      *(bf16x8*)(Bs + buf * BUF + row * PITCH + kc) = rb[i];
    }
  };
  gload(0); lstore(0); sub_sync();
  for (int kt = 0; kt < nkt; ++kt) {
    const int buf = kt & 1;
    if (kt + 1 < nkt) gload(kt + 1);
    asm volatile("" ::: "memory");
    const bf16_t* a_ = As + buf * BUF + (wr * 64 + r) * PITCH + 8 * h;
    const bf16_t* b_ = Bs + buf * BUF + (wc * 64 + r) * PITCH + 8 * h;
#pragma unroll
    for (int s = 0; s < BK / 16; ++s) {
      bf16x8 af[2], bfr[2];
      af[0] = *(const bf16x8*)(a_ + 16 * s); af[1] = *(const bf16x8*)(a_ + 32 * PITCH + 16 * s);
      bfr[0] = *(const bf16x8*)(b_ + 16 * s); bfr[1] = *(const bf16x8*)(b_ + 32 * PITCH + 16 * s);
#pragma unroll
      for (int mi = 0; mi < 2; ++mi)
#pragma unroll
        for (int ni = 0; ni < 2; ++ni) acc[mi][ni] = MFMA32(bfr[ni], af[mi], acc[mi][ni]);
    }
    if (kt + 1 < nkt) lstore(buf ^ 1);
    sub_sync();
  }
}
template <class AL>
DI void gemm_kloop(const AL& al, const bf16_t* __restrict__ Bt, int ldb, int nkt, int m0, int n0, f32x16 (&acc)[2][2], bf16_t* As, bf16_t* Bs) {
  gemm_kloop_t<64>(al, Bt, ldb, nkt, m0, n0, acc, As, Bs);
}

DI void zero_acc(f32x16 (&acc)[2][2]) {
#pragma unroll
  for (int a = 0; a < 2; ++a)
#pragma unroll
    for (int b = 0; b < 2; ++b)
#pragma unroll
      for (int i = 0; i < 16; ++i) acc[a][b][i] = 0.f;
}

DI int vfrag_key(int key) { const int kk = key & 31; return (key >> 5) * 2048 + (kk >> 4) * 512 + ((kk >> 2) & 1) * 256 + ((kk >> 3) & 1) * 4 + (kk & 3); }
DI int vfrag_col(int cw) { const int d = cw & 63; return (cw >> 6) * 524288 + (d >> 5) * 1024 + (d & 31) * 8; }

DI int kfrag_key(int key) { return (key >> 5) * 2048 + (key & 31) * 8; }
DI int kfrag_col(int cw) { const int d = cw & 63; return (cw >> 6) * 524288 + (d >> 4) * 512 + ((d >> 3) & 1) * 256 + (d & 7); }

struct PlainA {
  const bf16_t* A; int lda;
  DI bf16x8 operator()(int row, int k) const { return *(const bf16x8*)(A + (size_t)row * lda + k); }
};

DI void p1_tile(const Params& p, int layer, int half, int mt, int nt, unsigned char* smem) {
  sub_sync();
  bf16_t* As = (bf16_t*)smem; bf16_t* Bs = As + 2 * 9216;
  f32x16 acc[2][2]; zero_acc(acc);
  PlainA al{(const bf16_t*)(p.ws + O_XB) + (size_t)half * TH * 1024, 1024};
  const int m0 = mt * 128, n0 = nt * 128;
  gemm_kloop(al, (const bf16_t*)(p.ws + O_WTIN + layer * SZ_WTIN1), 1024, 16, m0, n0, acc, As, Bs);
  const int tid = otid(), lane = tid & 63, wave = tid >> 6, wr = wave >> 1, wc = wave & 1, r = lane & 31, h = lane >> 5;
  const float* bias = (const float*)(p.ws + O_BIASP) + layer * NP;
  unsigned char* ws = p.ws;
  {
    const int nb0 = n0 + wc * 64;
    bf16_t* dst0 = nullptr; int pitch0 = 0, coff0 = 0, xf0 = 0;
    if (nb0 < 384) { dst0 = (bf16_t*)(ws + O_QKA); pitch0 = 384; coff0 = nb0; }
    else if (nb0 >= C_BQK && nb0 < 2304) { dst0 = (bf16_t*)(ws + O_QKB); pitch0 = 1152; coff0 = nb0 - C_BQK; }
    else if (nb0 >= C_CQK && nb0 < 4224) { dst0 = (bf16_t*)(ws + O_QKC); pitch0 = 384; coff0 = nb0 - C_CQK; }
    else if (nb0 >= C_D && nb0 < C_E) { dst0 = (bf16_t*)(ws + O_QKVD); pitch0 = 1152; coff0 = nb0 - C_D; }
    else if (nb0 >= C_E && nb0 < C_SM) { dst0 = (bf16_t*)(ws + O_QE); pitch0 = 384; coff0 = nb0 - C_E; }
    else if (nb0 >= C_Z && nb0 < C_MG) { dst0 = (bf16_t*)(ws + O_SZ); pitch0 = 1920; coff0 = nb0 - C_Z; xf0 = 1; }
    else if (nb0 >= C_MG) { dst0 = (bf16_t*)(ws + O_SIG); pitch0 = 5120; coff0 = nb0 - C_MG; xf0 = 2; }
    if (dst0 != nullptr) {
      bf16_t* stg = (bf16_t*)smem + wave * (64 * 72);
#pragma unroll
      for (int ni = 0; ni < 2; ++ni)
#pragma unroll
        for (int mi = 0; mi < 2; ++mi)
#pragma unroll
          for (int g = 0; g < 4; ++g) {
            const int cq = ni * 32 + 8 * g + 4 * h;
            const f32x4 bv = *(const f32x4*)(bias + nb0 + cq);
            float v[4];
#pragma unroll
            for (int e = 0; e < 4; ++e) v[e] = acc[mi][ni][4 * g + e] + bv[e];
            if (xf0 == 1) {
#pragma unroll
              for (int e = 0; e < 4; ++e) v[e] = fsilu(v[e]);
            } else if (xf0 == 2) {
#pragma unroll
              for (int e = 0; e < 4; ++e) v[e] = fsigmoid(v[e]);
            }
            *(u32x2*)(stg + (mi * 32 + r) * 72 + cq) = pk4(v[0], v[1], v[2], v[3]);
          }
      asm volatile("s_waitcnt lgkmcnt(0)" ::: "memory");
      __builtin_amdgcn_wave_barrier();
      const int tok0 = m0 + wr * 64;
#pragma unroll
      for (int it = 0; it < 8; ++it) {
        const int row = it * 8 + (lane >> 3), ch = (lane & 7) * 8;
        const bf16x8 val = *(const bf16x8*)(stg + row * 72 + ch);
        *(bf16x8*)(dst0 + (size_t)(tok0 + row) * pitch0 + coff0 + ch) = val;
      }
      return;
    }
  }
#pragma unroll
  for (int ni = 0; ni < 2; ++ni) {
    const int nb = n0 + wc * 64 + ni * 32;
    int kind;
    int xf = 0;
    bf16_t* dst = nullptr; int pitch = 0, coff = 0;
    int kgrp = 0;
    if (nb < 384) { kind = 0; dst = (bf16_t*)(ws + O_QKA); pitch = 384; coff = nb; }
    else if (nb < C_AV) { kind = 5; dst = (bf16_t*)(ws + O_KFA); coff = nb - 384; }
    else if (nb < C_BQK) { kind = 1; dst = (bf16_t*)(ws + O_VTA); coff = nb - C_AV; }
    else if (nb < 2304) { kind = 0; dst = (bf16_t*)(ws + O_QKB); pitch = 1152; coff = nb - C_BQK; }
    else if (nb < C_BV) { kind = 5; kgrp = (nb - 2304) / 384; dst = (bf16_t*)(ws + O_KFB + kgrp * SZ_VT); coff = (nb - 2304) - kgrp * 384; }
    else if (nb < C_CQK) { kind = 2; dst = (bf16_t*)(ws + O_VTB); coff = nb - C_BV; }
    else if (nb < 4224) { kind = 0; dst = (bf16_t*)(ws + O_QKC); pitch = 384; coff = nb - C_CQK; }
    else if (nb < C_CV) { kind = 5; dst = (bf16_t*)(ws + O_KFC); coff = nb - 4224; }
    else if (nb < C_D) { kind = 1; dst = (bf16_t*)(ws + O_VTC); coff = nb - C_CV; }
    else if (nb < C_E) { kind = 0; dst = (bf16_t*)(ws + O_QKVD); pitch = 1152; coff = nb - C_D; }
    else if (nb < C_SM) { kind = 0; dst = (bf16_t*)(ws + O_QE); pitch = 384; coff = nb - C_E; }
    else if (nb < C_Z) { kind = (nb == C_SM) ? 3 : 4; }
    else if (nb < C_MG) { kind = 0; xf = 1; dst = (bf16_t*)(ws + O_SZ); pitch = 1920; coff = nb - C_Z; }
    else { kind = 0; xf = 2; dst = (bf16_t*)(ws + O_SIG); pitch = 5120; coff = nb - C_MG; }
    if (kind == 4) continue;
#pragma unroll
    for (int mi = 0; mi < 2; ++mi) {
      const int tok = m0 + wr * 64 + mi * 32 + r;
#pragma unroll
      for (int g = 0; g < 4; ++g) {
        const int cq = 8 * g + 4 * h;
        const f32x4 bv = *(const f32x4*)(bias + nb + cq);
        float v[4];
#pragma unroll
        for (int e = 0; e < 4; ++e) v[e] = acc[mi][ni][4 * g + e] + bv[e];
        if (kind == 0) {
          if (xf == 1) {
#pragma unroll
            for (int e = 0; e < 4; ++e) v[e] = fsilu(v[e]);
          } else if (xf == 2) {
#pragma unroll
            for (int e = 0; e < 4; ++e) v[e] = fsigmoid(v[e]);
          }
          *(u32x2*)(dst + (size_t)tok * pitch + coff + cq) = pk4(v[0], v[1], v[2], v[3]);
        } else if (kind == 5) {
          const int key = kgrp == 0 ? tok : kgrp == 1 ? (tok & 3) * 2048 + (tok >> 2) : (tok & 15) * 512 + (tok >> 4);
          *(u32x2*)(dst + kfrag_col(coff + cq) + kfrag_key(key)) = pk4(v[0], v[1], v[2], v[3]);
        } else if (kind == 1) {
          const int ko = vfrag_key(tok);
#pragma unroll
          for (int e = 0; e < 4; ++e) dst[vfrag_col(coff + cq + e) + ko] = f2bf(v[e]);
        } else if (kind == 2) {
          const int k1 = vfrag_key(tok), k4 = vfrag_key((tok & 3) * 2048 + (tok >> 2)), k16 = vfrag_key((tok & 15) * 512 + (tok >> 4));
#pragma unroll
          for (int e = 0; e < 4; ++e) {
            const bf16_t b = f2bf(v[e]); const int co = vfrag_col(coff + cq + e);
            dst[co + k1] = b; dst[SZ_VT / 2 + co + k4] = b; dst[SZ_VT + co + k16] = b;
          }
        } else {
          float* sm = (float*)(ws + O_SM);
#pragma unroll
          for (int e = 0; e < 4; ++e) if (cq + e < 18) sm[tok * 32 + cq + e] = v[e];
        }
      }
    }
  }
}


DI int g_lds_byte(int r, int c) { const int st = (r >> 4) * 2 + (c >> 5), ob = (r & 15) * 64 + (c & 31) * 2; return st * 1024 + (ob ^ (((ob >> 9) & 1) << 5)); }
DI void g_stage_rc(int b, int& R, int& C) { const int st = b >> 10, sb = b & 1023, swz = sb ^ (((sb >> 9) & 1) << 5); R = (st >> 1) * 16 + (swz >> 6); C = (st & 1) * 32 + ((swz & 63) >> 1); }

DI void p1_unit(const Params& p, int layer, int half, int pm, int pn, int pm_next, int pn_next  , bool first, unsigned char* lds) {
  const int tid = rtid(), wid = tid >> 6, lane = tid & 63, wr = wid >> 2, wc = wid & 3, fr = lane & 15, fq = lane >> 4;
  const bf16_t* Ab = (const bf16_t*)(p.ws + O_XB) + ((size_t)half * TH + (size_t)pm * 256) * 1024;
  const bf16_t* Bb = (const bf16_t*)(p.ws + O_WTIN + layer * SZ_WTIN1) + (size_t)pn * 256 * 1024;
  int sOff[4];
#pragma unroll
  for (int i = 0; i < 4; ++i) { int R, C; g_stage_rc(wid * 1024 + i * 8192 + lane * 16, R, C); sOff[i] = R * 1024 + C; }
  auto stage2 = [&](const bf16_t* A_, const bf16_t* B_, int buf, int kt) {
#pragma unroll
    for (int i = 0; i < 4; ++i) {
      __builtin_amdgcn_global_load_lds((const unsigned*)(A_ + sOff[i] + kt * 64), (unsigned*)(lds + buf * 65536 + wid * 1024 + i * 8192), 16, 0, 0);
      __builtin_amdgcn_global_load_lds((const unsigned*)(B_ + sOff[i] + kt * 64), (unsigned*)(lds + buf * 65536 + 32768 + wid * 1024 + i * 8192), 16, 0, 0);
    }
  };
  auto stage = [&](int buf, int kt) { stage2(Ab, Bb, buf, kt); };
  f32x4 acc[8][4];
#pragma unroll
  for (int m = 0; m < 8; ++m)
#pragma unroll
    for (int n = 0; n < 4; ++n) acc[m][n] = (f32x4){0.f, 0.f, 0.f, 0.f};
  const int lane_off = (fr * 64 + fq * 16) ^ ((fr >> 3) << 5);
  if (first) { __syncthreads(); stage(0, 0); }
  asm volatile("s_waitcnt vmcnt(0)" ::: "memory");
  __syncthreads();
#pragma unroll 1
  for (int t = 0; t < 16; ++t) {
    const int cur = t & 1;
    {
      const bool last = (t + 1 == 16);
      if (!last || pn_next >= 0) {
        const long dA = last ? (long)(pm_next - pm) * 256 * 1024 - 0 : (long)(t + 1) * 64;
        const long dB = last ? (long)(pn_next - pn) * 256 * 1024 - 0 : (long)(t + 1) * 64;
#pragma unroll
        for (int i = 0; i < 4; ++i) {
          __builtin_amdgcn_global_load_lds((const unsigned*)(Ab + sOff[i] + dA), (unsigned*)(lds + (cur ^ 1) * 65536 + wid * 1024 + i * 8192), 16, 0, 0);
          __builtin_amdgcn_global_load_lds((const unsigned*)(Bb + sOff[i] + dB), (unsigned*)(lds + (cur ^ 1) * 65536 + 32768 + wid * 1024 + i * 8192), 16, 0, 0);
        }
      }
    }
    const unsigned char* SA = lds + cur * 65536 + wr * 16384 + lane_off;
    const unsigned char* SB = lds + cur * 65536 + 32768 + wc * 8192 + lane_off;
    bf16x8 Bf[2][4], At[2][2];
#pragma unroll
    for (int n = 0; n < 4; ++n) Bf[0][n] = *(const bf16x8*)(SB + n * 2048);
#pragma unroll
    for (int m = 0; m < 2; ++m) At[0][m] = *(const bf16x8*)(SA + m * 2048);
#pragma unroll
    for (int g = 0; g < 8; ++g) {
      const int ks = g >> 2, pr = g & 3;
      if (g == 1) {
#pragma unroll
        for (int n = 0; n < 4; ++n) Bf[1][n] = *(const bf16x8*)(SB + n * 2048 + 1024);
      }
      if (g < 7) {
        const int g1 = g + 1;
#pragma unroll
        for (int m = 0; m < 2; ++m) At[g1 & 1][m] = *(const bf16x8*)(SA + ((g1 & 3) * 2 + m) * 2048 + (g1 >> 2) * 1024);
      }
      asm volatile("" : "+v"(acc[pr * 2][0][0]) :: "memory");
#pragma unroll
      for (int m = 0; m < 2; ++m)
#pragma unroll
        for (int n = 0; n < 4; ++n) acc[pr * 2 + m][n] = MFMA16(Bf[ks][n], At[g & 1][m], acc[pr * 2 + m][n]);
    }
    asm volatile("s_waitcnt vmcnt(0)" ::: "memory");
    __syncthreads();
  }
  const int nb0 = pn * 256 + wc * 64, tok0 = pm * 256 + wr * 128;
  const float* bias = (const float*)(p.ws + O_BIASP) + layer * NP;
  unsigned char* ws = p.ws;
  int kind, xf = 0, kgrp = 0, pitch = 0, coff = 0; bf16_t* dst = nullptr;
  if (nb0 < 384) { kind = 0; dst = (bf16_t*)(ws + O_QKA); pitch = 384; coff = nb0; }
  else if (nb0 < C_AV) { kind = 5; dst = (bf16_t*)(ws + O_KFA); coff = nb0 - 384; }
  else if (nb0 < C_BQK) { kind = 1; dst = (bf16_t*)(ws + O_VTA); coff = nb0 - C_AV; }
  else if (nb0 < 2304) { kind = 0; dst = (bf16_t*)(ws + O_QKB); pitch = 1152; coff = nb0 - C_BQK; }
  else if (nb0 < C_BV) { kind = 5; kgrp = (nb0 - 2304) / 384; dst = (bf16_t*)(ws + O_KFB + kgrp * SZ_VT); coff = (nb0 - 2304) - kgrp * 384; }
  else if (nb0 < C_CQK) { kind = 2; dst = (bf16_t*)(ws + O_VTB); coff = nb0 - C_BV; }
  else if (nb0 < 4224) { kind = 0; dst = (bf16_t*)(ws + O_QKC); pitch = 384; coff = nb0 - C_CQK; }
  else if (nb0 < C_CV) { kind = 5; dst = (bf16_t*)(ws + O_KFC); coff = nb0 - 4224; }
  else if (nb0 < C_D) { kind = 1; dst = (bf16_t*)(ws + O_VTC); coff = nb0 - C_CV; }
  else if (nb0 < C_E) { kind = 0; dst = (bf16_t*)(ws + O_QKVD); pitch = 1152; coff = nb0 - C_D; }
  else if (nb0 < C_SM) { kind = 0; dst = (bf16_t*)(ws + O_QE); pitch = 384; coff = nb0 - C_E; }
  else if (nb0 < C_Z) { kind = (nb0 == C_SM) ? 3 : 4; }
  else if (nb0 < C_MG) { kind = 0; xf = 1; dst = (bf16_t*)(ws + O_SZ); pitch = 1920; coff = nb0 - C_Z; }
  else if (nb0 < 13696) { kind = 0; xf = 2; dst = (bf16_t*)(ws + O_SIG); pitch = 5120; coff = nb0 - C_MG; }
  else { kind = 4; }
  if (kind == 4) return;
  if (kind == 0) {
    bf16_t* stg = (bf16_t*)(lds + 65536 + wid * 9216);
#pragma unroll
    for (int mh = 0; mh < 2; ++mh) {
#pragma unroll
      for (int m = 0; m < 4; ++m)
#pragma unroll
        for (int n = 0; n < 4; ++n) {
          const int c4 = n * 16 + fq * 4;
          const f32x4 bv = *(const f32x4*)(bias + nb0 + c4);
          float v[4];
#pragma unroll
          for (int e = 0; e < 4; ++e) v[e] = acc[mh * 4 + m][n][e] + bv[e];
          if (xf == 1) {
#pragma unroll
            for (int e = 0; e < 4; ++e) v[e] = fsilu(v[e]);
          } else if (xf == 2) {
#pragma unroll
            for (int e = 0; e < 4; ++e) v[e] = fsigmoid(v[e]);
          }
          *(u32x2*)(stg + (m * 16 + fr) * 72 + c4) = pk4(v[0], v[1], v[2], v[3]);
        }
      asm volatile("s_waitcnt lgkmcnt(0)" ::: "memory");
      __builtin_amdgcn_wave_barrier();
#pragma unroll
      for (int it = 0; it < 8; ++it) {
        const int row = it * 8 + (lane >> 3), ch = (lane & 7) * 8;
        const bf16x8 val = *(const bf16x8*)(stg + row * 72 + ch);
        *(bf16x8*)(dst + (size_t)(tok0 + mh * 64 + row) * pitch + coff + ch) = val;
      }
      asm volatile("s_waitcnt lgkmcnt(0)" ::: "memory");
      __builtin_amdgcn_wave_barrier();
    }
    return;
  }
#pragma unroll
  for (int m = 0; m < 8; ++m) {
    const int tok = tok0 + m * 16 + fr;
#pragma unroll
    for (int n = 0; n < 4; ++n) {
      const int c4 = n * 16 + fq * 4;
      const f32x4 bv = *(const f32x4*)(bias + nb0 + c4);
      float v[4];
#pragma unroll
      for (int e = 0; e < 4; ++e) v[e] = acc[m][n][e] + bv[e];
      if (kind == 5) {
        const int key = kgrp == 0 ? tok : kgrp == 1 ? (tok & 3) * 2048 + (tok >> 2) : (tok & 15) * 512 + (tok >> 4);
        *(u32x2*)(dst + kfrag_col(coff + c4) + kfrag_key(key)) = pk4(v[0], v[1], v[2], v[3]);
      } else if (kind == 1) {
        const int ko = vfrag_key(tok);
#pragma unroll
        for (int e = 0; e < 4; ++e) dst[vfrag_col(coff + c4 + e) + ko] = f2bf(v[e]);
      } else if (kind == 2) {
        const int k1 = vfrag_key(tok), k4 = vfrag_key((tok & 3) * 2048 + (tok >> 2)), k16 = vfrag_key((tok & 15) * 512 + (tok >> 4));
#pragma unroll
        for (int e = 0; e < 4; ++e) {
          const bf16_t b = f2bf(v[e]); const int co = vfrag_col(coff + c4 + e);
          dst[co + k1] = b; dst[SZ_VT / 2 + co + k4] = b; dst[SZ_VT + co + k16] = b;
        }
      } else {
        float* sm = (float*)(ws + O_SM);
#pragma unroll
        for (int e = 0; e < 4; ++e) if (c4 + e < 18) sm[tok * 32 + c4 + e] = v[e];
      }
    }
  }
}

DI void fox_prep(const Params& p, int hh, unsigned char* smem) {
  float* red = (float*)smem;
  const int tid = otid(), lane = tid & 63, wave = tid >> 6;
  const float* sm = (const float*)(p.ws + O_SM);
  float* FF = (float*)(p.ws + O_FF) + hh * TH;
  float loc[32];
#pragma unroll
  for (int j = 0; j < 32; ++j) loc[j] = sm[(tid * 32 + j) * 32 + hh];
  float s = 0.f;
#pragma unroll
  for (int j = 0; j < 32; ++j) { const float xv = loc[j]; s += fminf(xv, 0.f) - log1pf(expf(-fabsf(xv))); loc[j] = s; }
  float inc = s;
#pragma unroll
  for (int o = 1; o < 64; o <<= 1) { const float t = __shfl_up(inc, o); if (lane >= o) inc += t; }
  if (lane == 63) red[wave] = inc;
  sub_sync();
  float off = inc - s;
  for (int w = 0; w < wave; ++w) off += red[w];
#pragma unroll
  for (int j4 = 0; j4 < 8; ++j4) {
    f32x4 o4 = {off + loc[4 * j4], off + loc[4 * j4 + 1], off + loc[4 * j4 + 2], off + loc[4 * j4 + 3]};
    *(f32x4*)(FF + tid * 32 + 4 * j4) = o4;
  }
  sub_sync();
}

DI void kmean_prep(const Params& p, int idx, unsigned* kmaxu) {
  const int lane = otid() & 63;
  const int hh = idx / 32, blk = idx % 32;
  const bf16_t* k = (const bf16_t*)(p.ws + O_KFA) + kfrag_col(hh * 64 + lane) + blk * 8 * 2048;
  float s = 0.f;
#pragma unroll 8
  for (int i = 0; i < 256; ++i) s += bf2f(k[(i >> 5) * 2048 + (i & 31) * 8]);
  s *= (1.f / 256.f);
  const bf16_t hi = f2bf(s);
  bf16_t* km = (bf16_t*)(p.ws + O_KM);
  km[(hh * 32 + blk) * 64 + lane] = hi;
  km[6 * 32 * 64 + (hh * 32 + blk) * 64 + lane] = f2bf(s - bf2f(hi));
  const bf16_t* kc = (const bf16_t*)(p.ws + O_KFC) + (size_t)hh * 524288;
  float mx = 0.f;
#pragma unroll
  for (int t = 0; t < 4; ++t) {
    const int key = blk * 256 + lane * 4 + t;
    float kk = 0.f;
#pragma unroll
    for (int c = 0; c < 8; ++c) { float v[8]; unpk8(*(const bf16x8*)(kc + kfrag_key(key) + c * 256), v);
#pragma unroll
      for (int e = 0; e < 8; ++e) kk += v[e] * v[e]; }
    mx = fmaxf(mx, kk);
  }
#pragma unroll
  for (int o = 32; o >= 1; o >>= 1) mx = fmaxf(mx, __shfl_xor(mx, o));
  if (lane == 0) atomicMax(kmaxu + hh, __float_as_uint(mx));
}

DI void memkv_tile(const Params& p, int layer, int half, int mt, int nt, unsigned char* smem) {
  bf16_t* As = (bf16_t*)smem; bf16_t* Bs = As + 2 * 9216;
  f32x16 acc[2][2]; zero_acc(acc);
  PlainA al{(const bf16_t*)(p.ws + O_MEMN) + (size_t)half * 256 * 1024, 1024};
  const int m0 = mt * 128, n0 = nt * 128;
  gemm_kloop(al, (const bf16_t*)(p.ws + O_WTKV + layer * SZ_WTKV1), 1024, 16, m0, n0, acc, As, Bs);
  const int tid = otid(), lane = tid & 63, wave = tid >> 6, wr = wave >> 1, wc = wave & 1, r = lane & 31, h = lane >> 5;
  bf16_t* mk = (bf16_t*)(p.ws + O_MEMK); bf16_t* mv = (bf16_t*)(p.ws + O_MEMVT);
#pragma unroll
  for (int ni = 0; ni < 2; ++ni)
#pragma unroll
    for (int mi = 0; mi < 2; ++mi) {
      const int m = m0 + wr * 64 + mi * 32 + r;
#pragma unroll
      for (int i = 0; i < 16; ++i) {
        const int col = n0 + wc * 64 + ni * 32 + crow(i, h);
        const bf16_t b = f2bf(acc[mi][ni][i]);
        if (col < 384) { const int hd = col / 96, d = col % 96; mk[(size_t)((half * 4 + hd) * 8 + (m >> 5)) * 3072 + (d >> 4) * 512 + ((d >> 3) & 1) * 256 + (m & 31) * 8 + (d & 7)] = b; }
        else { const int cc = col - 384, hd = cc / 96, d = cc % 96, kk = m & 31;
          mv[(size_t)((half * 4 + hd) * 8 + (m >> 5)) * 3072 + (d >> 5) * 1024 + (kk >> 4) * 512 + ((kk >> 2) & 1) * 256 + (d & 31) * 8 + ((kk >> 3) & 1) * 4 + (kk & 3)] = b; }
      }
    }
}

DI f32x16 mm_quad(const bf16_t* A, const bf16_t* B, int wr, int wc, int r, int h) {
  f32x16 acc;
#pragma unroll
  for (int i = 0; i < 16; ++i) acc[i] = 0.f;
  const bf16_t* a_ = A + (wr * 32 + r) * 72 + 8 * h;
  const bf16_t* b_ = B + (wc * 32 + r) * 72 + 8 * h;
#pragma unroll
  for (int s = 0; s < 4; ++s) acc = MFMA32(*(const bf16x8*)(a_ + 16 * s), *(const bf16x8*)(b_ + 16 * s), acc);
  return acc;
}

DI void gdn_prep(const Params& p, int layer, int half, int hh, int c, unsigned char* smem) {
  bf16_t* QN = (bf16_t*)smem; bf16_t* KN = QN + 4608; bf16_t* KB = KN + 4608; bf16_t* KDT = KB + 4608; bf16_t* VBT = KDT + 4608;
  bf16_t* KBET = VBT + 4608; bf16_t* QKm = KBET + 4608; bf16_t* Tm = QKm + 4608;
  float* gcv = (float*)(smem + 73728); float* betav = gcv + 64; float* egc = gcv + 128;
  float* Mf = (float*)(smem + 9216);
  bf16_t* UT = KN; bf16_t* WT = KB;
  int tid = otid();
  int lane = tid & 63, wave = tid >> 6, wr = wave >> 1, wc = wave & 1, r = lane & 31, h = lane >> 5;
#define REOPAQUE() do { asm volatile("" : "+v"(tid)); lane = tid & 63; wave = tid >> 6; wr = wave >> 1; wc = wave & 1; r = lane & 31; h = lane >> 5; } while (0)
  const float* sm = (const float*)(p.ws + O_SM);
  if (wave == 0) {
    const int tok = c * 64 + lane;
    const float bt = fsigmoid(sm[tok * 32 + 6 + hh]);
    const float xv = sm[tok * 32 + 12 + hh] + p.dt_bias[layer * 6 + hh];
    const float sp = fmaxf(xv, 0.f) + log1pf(expf(-fabsf(xv)));
    float g = -expf(p.a_log[layer * 6 + hh]) * sp;
#pragma unroll
    for (int o = 1; o < 64; o <<= 1) { const float t = __shfl_up(g, o); if (lane >= o) g += t; }
    gcv[lane] = g; betav[lane] = bt; egc[lane] = expf(g);
    if (lane == 63) ((float*)(p.ws + O_GL))[hh * 128 + c] = expf(g);
  }
  sub_sync();
  REOPAQUE();
  {
    const int t = tid >> 2, cg4 = tid & 3, ch0 = cg4 * 16;
    const bf16_t* src = (const bf16_t*)(p.ws + O_QKVD);
    const float* cw = p.conv_w + (size_t)layer * 4 * 1152;
    const float bt = betav[t], gct = gcv[t], eg = egc[t], ed = expf(gcv[63] - gct);
    auto convpart = [&](int pt, float (&val)[16]) {
      const int col = pt * 384 + hh * 64 + ch0;
#pragma unroll
      for (int e = 0; e < 16; ++e) val[e] = 0.f;
#pragma unroll
      for (int j = 0; j < 4; ++j) {
        const int row = c * 64 + t - 3 + j;
        if (row >= 0) {
          float xv[16];
          unpk8(*(const bf16x8*)(src + (size_t)row * 1152 + col), xv);
          unpk8(*(const bf16x8*)(src + (size_t)row * 1152 + col + 8), xv + 8);
#pragma unroll
          for (int e4 = 0; e4 < 4; ++e4) {
            const f32x4 w4 = *(const f32x4*)(cw + j * 1152 + col + 4 * e4);
#pragma unroll
            for (int e = 0; e < 4; ++e) val[4 * e4 + e] += w4[e] * xv[4 * e4 + e];
          }
        }
      }
#pragma unroll
      for (int e = 0; e < 16; ++e) val[e] = fsilu(val[e]);
    };
    {
      float val[16]; convpart(0, val);
      float sq = 0.f;
#pragma unroll
      for (int e = 0; e < 16; ++e) sq += val[e] * val[e];
      sq += __shfl_xor(sq, 1); sq += __shfl_xor(sq, 2);
      const float rq = rsqrtf(sq + 1e-6f) * 0.125f;
#pragma unroll
      for (int e = 0; e < 16; ++e) val[e] *= rq;
      *(bf16x8*)(QN + t * 72 + ch0) = pk8(val); *(bf16x8*)(QN + t * 72 + ch0 + 8) = pk8(val + 8);
    }
    asm volatile("" ::: "memory");
    {
      float val[16]; convpart(1, val);
      float sk = 0.f;
#pragma unroll
      for (int e = 0; e < 16; ++e) sk += val[e] * val[e];
      sk += __shfl_xor(sk, 1); sk += __shfl_xor(sk, 2);
      const float rk = rsqrtf(sk + 1e-6f);
      float kb[16];
#pragma unroll
      for (int e = 0; e < 16; ++e) { val[e] *= rk; kb[e] = val[e] * bt; }
      *(bf16x8*)(KN + t * 72 + ch0) = pk8(val); *(bf16x8*)(KN + t * 72 + ch0 + 8) = pk8(val + 8);
      *(bf16x8*)(KB + t * 72 + ch0) = pk8(kb); *(bf16x8*)(KB + t * 72 + ch0 + 8) = pk8(kb + 8);
#pragma unroll
      for (int e = 0; e < 16; ++e) {
        KDT[(ch0 + e) * 72 + t] = f2bf(val[e] * ed);
        KBET[(ch0 + e) * 72 + t] = f2bf(kb[e] * eg);
      }
    }
    asm volatile("" ::: "memory");
    {
      float val[16]; convpart(2, val);
#pragma unroll
      for (int e = 0; e < 16; ++e) VBT[(ch0 + e) * 72 + t] = f2bf(val[e] * bt);
    }
  }
  sub_sync();
  REOPAQUE();
  {
    const f32x16 kk = mm_quad(KB, KN, wr, wc, r, h);
    const f32x16 qk = mm_quad(QN, KN, wr, wc, r, h);
    sub_sync();
    const int j = wc * 32 + r; const float gj = gcv[j];
#pragma unroll
    for (int i = 0; i < 16; ++i) {
      const int row = wr * 32 + crow(i, h);
      const float dec = (row >= j) ? expf(gcv[row] - gj) : 0.f;
      Mf[row * 68 + j] = (row > j) ? kk[i] * dec : 0.f;
      QKm[row * 72 + j] = f2bf(qk[i] * dec);
    }
  }
  sub_sync();
  REOPAQUE();
  if (wave == 0) {
    float t[64];
#pragma unroll
    for (int i = 0; i < 64; ++i) {
      float a4[4] = {(i == lane) ? 1.f : 0.f, 0.f, 0.f, 0.f};
#pragma unroll
      for (int j4 = 0; j4 < (i + 3) / 4; ++j4) {
        const f32x4 mrow = *(const f32x4*)(Mf + i * 68 + 4 * j4);
#pragma unroll
        for (int e = 0; e < 4; ++e) if (4 * j4 + e < i) a4[e] -= mrow[e] * t[4 * j4 + e];
      }
      const float a = (a4[0] + a4[1]) + (a4[2] + a4[3]);
      t[i] = a;
      Tm[i * 72 + lane] = f2bf(a);
      asm volatile("" ::: "memory");
    }
  }
  sub_sync();
  REOPAQUE();
  {
    const f32x16 u = mm_quad(Tm, VBT, wr, wc, r, h);
    const f32x16 w = mm_quad(Tm, KBET, wr, wc, r, h);
    const int col = wc * 32 + r;
#pragma unroll
    for (int g = 0; g < 4; ++g) {
      const int i0 = wr * 32 + 8 * g + 4 * h;
      *(u32x2*)(UT + col * 72 + i0) = pk4(u[4 * g], u[4 * g + 1], u[4 * g + 2], u[4 * g + 3]);
      *(u32x2*)(WT + col * 72 + i0) = pk4(w[4 * g], w[4 * g + 1], w[4 * g + 2], w[4 * g + 3]);
    }
  }
  sub_sync();
  REOPAQUE();
  {
    bf16_t* base = (bf16_t*)(p.ws + O_DPREP + (size_t)(hh * 128 + c) * 32768);
    const int n = wc * 32 + r;
    {
      const int ks = n >> 5, jh = (n >> 4) & 1, q = (n >> 2) & 3, jl = n & 3, jj = 4 * jh + jl;
      const int cbase = (ks * 64 + 16 * q) * 8 + jj;
      {
        const f32x16 P = mm_quad(KDT, WT, wr, wc, r, h);
#pragma unroll
        for (int i = 0; i < 16; ++i) {
          const int m = wr * 32 + crow(i, h);
          base[((m >> 4) * 128 + (m & 15)) * 8 + cbase] = f2bf(P[i]);
        }
      }
      asm volatile("" ::: "memory");
      {
        const f32x16 QW = mm_quad(QKm, WT, wr, wc, r, h);
#pragma unroll
        for (int i = 0; i < 16; ++i) {
          const int m = wr * 32 + crow(i, h);
          const float qd = bf2f(QN[m * 72 + n]) * egc[m];
          base[4096 + ((m >> 4) * 128 + (m & 15)) * 8 + cbase] = f2bf(qd - QW[i]);
        }
      }
      asm volatile("" ::: "memory");
    }
    const int jsl = n >> 4;
    {
      const f32x16 Bc = mm_quad(KDT, UT, wr, wc, r, h);
#pragma unroll
      for (int g = 0; g < 4; ++g) {
        const int row0 = wr * 32 + 8 * g + 4 * h;
        const int rt = row0 >> 4, lp = 16 * ((row0 >> 2) & 3) + (n & 15);
        *(u32x2*)(base + 8192 + ((jsl * 4 + rt) * 64 + lp) * 4) = pk4(Bc[4 * g], Bc[4 * g + 1], Bc[4 * g + 2], Bc[4 * g + 3]);
      }
    }
    asm volatile("" ::: "memory");
    {
      const f32x16 O0 = mm_quad(QKm, UT, wr, wc, r, h);
#pragma unroll
      for (int g = 0; g < 4; ++g) {
        const int row0 = wr * 32 + 8 * g + 4 * h;
        const int rt = row0 >> 4, lp = 16 * ((row0 >> 2) & 3) + (n & 15);
        *(u32x2*)(base + 12288 + ((jsl * 4 + rt) * 64 + lp) * 4) = pk4(O0[4 * g], O0[4 * g + 1], O0[4 * g + 2], O0[4 * g + 3]);
      }
    }
  }
  sub_sync();
#undef REOPAQUE
}

struct TileDesc { const bf16_t* k; const bf16_t* v; const float* aux; int tag; };

template <int DHT, bool AUX>
struct TileRegs { bf16x8 k[DHT / 16]; bf16x8 v[DHT / 32][2]; f32x4 a[4]; };

template <int DHT, bool AUX>
DI void load_tile(const bf16_t* kp, const bf16_t* vp, const float* ap, long ldv, TileRegs<DHT, AUX>& t) {
#pragma unroll
  for (int s = 0; s < DHT / 16; ++s) t.k[s] = *(const bf16x8*)(kp + 512 * s);
#pragma unroll
  for (int dt = 0; dt < DHT / 32; ++dt)
#pragma unroll
    for (int s = 0; s < 2; ++s) t.v[dt][s] = *(const bf16x8*)(vp + (dt * 2 + s) * 512);
  if (AUX) {
#pragma unroll
    for (int g = 0; g < 4; ++g) t.a[g] = *(const f32x4*)(ap + 8 * g);
  }
}

template <int DHT, bool AUX, class TF, class MF, class SF>
DI void attn_loop(int maxtiles, TF&& tf, MF&& mf, SF&& stopf, const bf16x8 (&qf)[DHT / 16], long ldv, float scale2,
                  f32x16 (&o)[DHT / 32], float& m, float& l) {
  TileRegs<DHT, AUX> cur, nxt;
  int tagc, tagn;
  bf16x8 qf0 = qf[0];
  { const bf16_t* kp; const bf16_t* vp; const float* ap = nullptr; tagc = tf(0, kp, vp, ap); load_tile<DHT, AUX>(kp, vp, ap, ldv, cur); }
#pragma unroll 1
  for (int t = 0; t < maxtiles; ++t) {
    { const bf16_t* kp; const bf16_t* vp; const float* ap = nullptr; tagn = tf(t + 1, kp, vp, ap); load_tile<DHT, AUX>(kp, vp, ap, ldv, nxt); }
    { bf16x8 q0 = qf[0]; asm volatile("" : "+v"(q0) :: "memory"); qf0 = q0; }
    f32x16 sacc;
#pragma unroll
    for (int i = 0; i < 16; ++i) sacc[i] = 0.f;
#pragma unroll
    for (int s = 0; s < DHT / 16; ++s) sacc = MFMA32(cur.k[s], s == 0 ? qf0 : qf[s], sacc);
    float sv[16]; float mx = NEG_INF;
#pragma unroll
    for (int i = 0; i < 16; ++i) { sv[i] = sacc[i] * scale2 + mf(tagc, i, AUX ? cur.a[i >> 2][i & 3] : 0.f); mx = fmaxf(mx, sv[i]); }
    mx = fmaxf(mx, __shfl_xor(mx, 32));
    const float mnew = fmaxf(m, mx);
    const float alpha = __builtin_amdgcn_exp2f(m - mnew);
    m = mnew;
    float pv[16]; float ps = 0.f;
#pragma unroll
    for (int i = 0; i < 16; ++i) { pv[i] = __builtin_amdgcn_exp2f(sv[i] - mnew); ps += pv[i]; }
    l = l * alpha + ps;
#pragma unroll
    for (int dt = 0; dt < DHT / 32; ++dt)
#pragma unroll
      for (int i = 0; i < 16; ++i) o[dt][i] *= alpha;
    bf16x8 pf[2]; pf[0] = pk8(pv); pf[1] = pk8(pv + 8);
#pragma unroll
    for (int dt = 0; dt < DHT / 32; ++dt)
#pragma unroll
      for (int s = 0; s < 2; ++s) {
        o[dt] = MFMA32(cur.v[dt][s], pf[s], o[dt]);
      }
    if (stopf(t, m, AUX ? cur.a[0][0] : 0.f)) break;
    cur = nxt; tagc = tagn;
  }
}

template <int DHT>
DI void attn_store(const f32x16 (&o)[DHT / 32], float l, bf16_t* dstrow, int h, float& ltot_out, bool valid = true) {
  const float ltot = l + __shfl_xor(l, 32);
  ltot_out = ltot;
  const float inv = ltot > 0.f ? 1.f / ltot : 0.f;
  if (valid)
#pragma unroll
  for (int dt = 0; dt < DHT / 32; ++dt)
#pragma unroll
    for (int g = 0; g < 4; ++g)
      *(u32x2*)(dstrow + dt * 32 + 8 * g + 4 * h) = pk4(o[dt][4 * g] * inv, o[dt][4 * g + 1] * inv, o[dt][4 * g + 2] * inv, o[dt][4 * g + 3] * inv);
}

template <int N>
DI void zero_o(f32x16 (&o)[N]) {
#pragma unroll
  for (int a = 0; a < N; ++a)
#pragma unroll
    for (int i = 0; i < 16; ++i) o[a][i] = 0.f;
}

DI void top3_insert(float v, int n, float& v0, float& v1, float& v2, int& i0, int& i1, int& i2) {
  const bool g0 = v > v0, g1 = v > v1, g2 = v > v2;
  v2 = g1 ? v1 : (g2 ? v : v2); i2 = g1 ? i1 : (g2 ? n : i2);
  v1 = g0 ? v0 : (g1 ? v : v1); i1 = g0 ? i0 : (g1 ? n : i1);
  v0 = g0 ? v : v0;             i0 = g0 ? n : i0;
}

DI void moba_select(const Params& p, int a) {
  const int lane = otid() & 63, r = lane & 31, h = lane >> 5;
  const int qtile = a / 6, hh = a % 6, qb = qtile >> 3;
  unsigned mask = 0;
  if (qb > 0) {
    const bf16_t* qrow = (const bf16_t*)(p.ws + O_QKA) + (size_t)(qtile * 32 + r) * 384 + hh * 64 + 8 * h;
    bf16x8 qf[4];
#pragma unroll
    for (int s = 0; s < 4; ++s) qf[s] = *(const bf16x8*)(qrow + 16 * s);
    const bf16_t* kmh = (const bf16_t*)(p.ws + O_KM) + (hh * 32 + r) * 64 + 8 * h;
    const bf16_t* kml = kmh + 6 * 32 * 64;
    f32x16 g;
#pragma unroll
    for (int i = 0; i < 16; ++i) g[i] = 0.f;
#pragma unroll
    for (int s = 0; s < 4; ++s) { g = MFMA32(*(const bf16x8*)(kmh + 16 * s), qf[s], g); g = MFMA32(*(const bf16x8*)(kml + 16 * s), qf[s], g); }
    float v0 = NEG_INF, v1 = NEG_INF, v2 = NEG_INF; int i0 = -1, i1 = -1, i2 = -1;
#pragma unroll
    for (int i = 0; i < 16; ++i) { const int n = crow(i, h); if (n < qb) top3_insert(g[i], n, v0, v1, v2, i0, i1, i2); }
    const float pv0 = __shfl_xor(v0, 32), pv1 = __shfl_xor(v1, 32), pv2 = __shfl_xor(v2, 32);
    const int pi0 = __shfl_xor(i0, 32), pi1 = __shfl_xor(i1, 32), pi2 = __shfl_xor(i2, 32);
    if (pi0 >= 0) top3_insert(pv0, pi0, v0, v1, v2, i0, i1, i2);
    if (pi1 >= 0) top3_insert(pv1, pi1, v0, v1, v2, i0, i1, i2);
    if (pi2 >= 0) top3_insert(pv2, pi2, v0, v1, v2, i0, i1, i2);
    if (i0 >= 0) mask |= 1u << i0;
    if (i1 >= 0) mask |= 1u << i1;
    if (i2 >= 0) mask |= 1u << i2;
  }
  if (h == 0) ((unsigned*)(p.ws + O_MASK))[(qtile * 32 + r) * 8 + hh] = mask;
}

DI void moba_gather(const Params& p, int a, unsigned char* smem) {
  const int tid = otid(), lane = tid & 63, wave = tid >> 6, r = lane & 31, h = lane >> 5;
  const int part = a & 1, a2 = a >> 1;
  const int hh = a2 % 6, idx = a2 / 6;
  int qb = 1;
  while ((qb + 1) * qb / 2 <= idx) ++qb;
  const int n = idx - qb * (qb - 1) / 2;
  const unsigned* MASK = (const unsigned*)(p.ws + O_MASK);
  unsigned* list = (unsigned*)(smem + wave * 1024);
  int cnt = 0;
#pragma unroll
  for (int j = 0; j < 4; ++j) {
    const int qi = j * 64 + lane;
    const unsigned mk = MASK[(qb * 256 + qi) * 8 + hh];
    const bool pred = (mk >> n) & 1u;
    const unsigned long long ball = __ballot(pred);
    const int pos = cnt + __builtin_popcountll(ball & ((1ull << lane) - 1ull));
    if (pred) list[pos] = (unsigned)qi | ((unsigned)__builtin_popcount(mk & ((1u << n) - 1u)) << 8);
    cnt += __builtin_popcountll(ball);
  }
  cnt = __builtin_amdgcn_readfirstlane(cnt);
  if (cnt == 0) return;
  asm volatile("s_waitcnt lgkmcnt(0)" ::: "memory");
  __builtin_amdgcn_wave_barrier();
  const bf16_t* QK = (const bf16_t*)(p.ws + O_QKA);
  const bf16_t* KF = (const bf16_t*)(p.ws + O_KFA) + (size_t)hh * 524288 + (size_t)n * 8 * 2048 + lane * 8;
  const bf16_t* VT = (const bf16_t*)(p.ws + O_VTA) + (size_t)hh * 524288 + (size_t)n * 8 * 2048 + lane * 8;
  const int nch = (cnt + 31) >> 5;
#pragma unroll 1
  for (int c = part; c < nch; c += 2) {
    const int e = c * 32 + r;
    const bool valid = e < cnt;
    const unsigned ent = list[valid ? e : 0];
    const int tok = qb * 256 + (int)(ent & 255u), slot = (int)(ent >> 8);
    bf16x8 qf[4];
    { const bf16_t* qrow = QK + (size_t)tok * 384 + hh * 64 + 8 * h;
#pragma unroll
      for (int s = 0; s < 4; ++s) qf[s] = *(const bf16x8*)(qrow + 16 * s); }
    auto tf = [&](int t, const bf16_t*& kp, const bf16_t*& vp, const float*&) -> int {
      const int tt = t < 7 ? t : 7;
      kp = KF + tt * 2048; vp = VT + tt * 2048;
      return 0;
    };
    auto mf = [&](int, int, float) -> float { return 0.f; };
    auto sf = [&](int, float, float) { return false; };
    f32x16 o[2]; zero_o(o); float m = -1e30f, l = 0.f;
    int nt8 = 8; asm volatile("" : "+s"(nt8));
    attn_loop<64, false>(nt8, tf, mf, sf, qf, (long)TH, 0.125f * LOG2E, o, m, l);
    float lt;
    attn_store<64>(o, l, (bf16_t*)(p.ws + O_OA + slot * SZ_O) + (size_t)tok * 384 + hh * 64, h, lt, valid);
    if (valid && h == 0) { float* st = (float*)(p.ws + O_STA) + ((size_t)(slot * TH + tok) * 6 + hh) * 2; st[0] = m; st[1] = lt; }
  }
}

DI void moba_own(const Params& p, int a) {
  const int lane = otid() & 63, r = lane & 31, h = lane >> 5;
  const int qtile = 255 - a / 6, hh = a % 6, qb = qtile >> 3, own = qtile & 7;
  const bf16_t* QK = (const bf16_t*)(p.ws + O_QKA);
  const bf16_t* KF = (const bf16_t*)(p.ws + O_KFA) + (size_t)hh * 524288 + (size_t)qb * 8 * 2048 + lane * 8;
  const bf16_t* VT = (const bf16_t*)(p.ws + O_VTA) + (size_t)hh * 524288 + (size_t)qb * 8 * 2048 + lane * 8;
  const int tok = qtile * 32 + r;
  bf16x8 qf[4];
  { const bf16_t* qrow = QK + (size_t)tok * 384 + hh * 64 + 8 * h;
#pragma unroll
    for (int s = 0; s < 4; ++s) qf[s] = *(const bf16x8*)(qrow + 16 * s); }
  auto tf = [&](int t, const bf16_t*& kp, const bf16_t*& vp, const float*&) -> int {
    const int kk = t < own ? t : own;
    kp = KF + kk * 2048; vp = VT + kk * 2048;
    return (kk == own) ? 101 : 100;
  };
  auto mf = [&](int tag, int i, float) -> float {
    if (tag == 100) return 0.f;
    return (crow(i, h) <= r) ? 0.f : NEG_INF;
  };
  auto sf = [&](int, float, float) { return false; };
  f32x16 o[2]; zero_o(o); float m = -1e30f, l = 0.f;
  attn_loop<64, false>(own + 1, tf, mf, sf, qf, (long)TH, 0.125f * LOG2E, o, m, l);
  float lt;
  attn_store<64>(o, l, (bf16_t*)(p.ws + O_OA + 3 * SZ_O) + (size_t)tok * 384 + hh * 64, h, lt);
  if (h == 0) {
    float* st = (float*)(p.ws + O_STA);
    st[((size_t)(3 * TH + tok) * 6 + hh) * 2] = m; st[((size_t)(3 * TH + tok) * 6 + hh) * 2 + 1] = lt;
    const int np = __builtin_popcount(((const unsigned*)(p.ws + O_MASK))[tok * 8 + hh]);
    for (int sl = np; sl < 3; ++sl) { st[((size_t)(sl * TH + tok) * 6 + hh) * 2] = -1e30f; st[((size_t)(sl * TH + tok) * 6 + hh) * 2 + 1] = 0.f; }
  }
}

DI void fox_item(const Params& p, int c, const unsigned* kmaxu) {
  const int lane = otid() & 63, r = lane & 31, h = lane >> 5;
  const int qtile = 255 - c / 6, hh = c % 6;
  const bf16_t* QK = (const bf16_t*)(p.ws + O_QKC);
  const bf16_t* KF = (const bf16_t*)(p.ws + O_KFC);
  const bf16_t* VT = (const bf16_t*)(p.ws + O_VTC);
  const float* FF = (const float*)(p.ws + O_FF) + hh * TH;
  bf16x8 qf[4]; float qn2 = 0.f;
  { const bf16_t* qrow = QK + (size_t)(qtile * 32 + r) * 384 + hh * 64 + 8 * h;
#pragma unroll
    for (int s = 0; s < 4; ++s) { qf[s] = *(const bf16x8*)(qrow + 16 * s); float v[8]; unpk8(qf[s], v);
#pragma unroll
      for (int e = 0; e < 8; ++e) qn2 += v[e] * v[e]; } }
  qn2 += __shfl_xor(qn2, 32);
#pragma unroll
  for (int o = 16; o >= 1; o >>= 1) qn2 = fmaxf(qn2, __shfl_xor(qn2, o));
  const float Fq = FF[qtile * 32 + r];
  const float Ffirst = FF[qtile * 32];
  const float kmaxn = sqrtf(__uint_as_float(kmaxu[hh]));
  const float bound = sqrtf(qn2) * kmaxn * 0.125f + Ffirst;
  auto tf = [&](int t, const bf16_t*& kp, const bf16_t*& vp, const float*& ap) -> int {
    const int keybase = (qtile - t > 0 ? qtile - t : 0) * 32;
    kp = KF + (size_t)hh * 524288 + (keybase >> 5) * 2048 + lane * 8;
    vp = VT + (size_t)hh * 524288 + (keybase >> 5) * 2048 + lane * 8;
    ap = FF + keybase + 4 * h;
    return (t == 0) ? 1 : 0;
  };
  auto mf = [&](int tag, int i, float fk) -> float {
    const float b = (Fq - fk) * LOG2E;
    return (tag == 1 && crow(i, h) > r) ? NEG_INF : b;
  };
  auto sf = [&](int, float m, float a0) {
    const float fkb = __builtin_bit_cast(float, __builtin_amdgcn_readfirstlane(__builtin_bit_cast(int, a0)));
    float mm = m;
#pragma unroll
    for (int o = 16; o >= 1; o >>= 1) mm = fminf(mm, __shfl_xor(mm, o));
    return (bound - fkb) * LOG2E < mm - 45.f;
  };
  f32x16 o[2]; zero_o(o); float m = -1e30f, l = 0.f;
  attn_loop<64, true>(qtile + 1, tf, mf, sf, qf, (long)TH, 0.125f * LOG2E, o, m, l);
  float lt;
  attn_store<64>(o, l, (bf16_t*)(p.ws + O_OC) + (size_t)(qtile * 32 + r) * 384 + hh * 64, h, lt);
}

DI void dil_item(const Params& p, int idx) {
  const int lane = otid() & 63, r = lane & 31, h = lane >> 5;
  const int g = idx / 1536, rem = idx % 1536, hh = rem / 256, w = rem % 256;
  const int dsh = 2 * g;
  const int dil = 1 << dsh, L = TH >> dsh, tps = L / 32;
  const int rs = w / tps, lt_ = w % tps, l0 = lt_ * 32;
  const bf16_t* QK = (const bf16_t*)(p.ws + O_QKB);
  const bf16_t* KF = (const bf16_t*)(p.ws + O_KFB + g * SZ_VT);
  const bf16_t* VT = (const bf16_t*)(p.ws + O_VTB + g * SZ_VT);
  const int tq = (l0 + r) * dil + rs;
  bf16x8 qf[4];
  { const bf16_t* qrow = QK + (size_t)tq * 1152 + g * 384 + hh * 64 + 8 * h;
#pragma unroll
    for (int s = 0; s < 4; ++s) qf[s] = *(const bf16x8*)(qrow + 16 * s); }
  const int t0 = (l0 >= 128) ? 0 : (128 - l0) / 32;
  auto tf = [&](int tt, const bf16_t*& kp, const bf16_t*& vp, const float*&) -> int {
    const int t = (t0 + tt < 4) ? t0 + tt : 4; const int keybase = l0 - 128 + 32 * t;
    kp = KF + (size_t)hh * 524288 + ((rs * L + keybase) >> 5) * 2048 + lane * 8;
    vp = VT + (size_t)hh * 524288 + ((rs * L + keybase) >> 5) * 2048 + lane * 8;
    return t;
  };
  auto mf = [&](int tag, int i, float) -> float {
    const int kj = crow(i, h);
    if (tag == 0) return (kj >= r) ? 0.f : NEG_INF;
    if (tag == 4) return (kj <= r) ? 0.f : NEG_INF;
    return 0.f;
  };
  auto sf = [&](int, float, float) { return false; };
  f32x16 o[2]; zero_o(o); float m = -1e30f, l = 0.f;
  attn_loop<64, false>(5 - t0, tf, mf, sf, qf, (long)TH, 0.125f * LOG2E, o, m, l);
  float lt;
  attn_store<64>(o, l, (bf16_t*)(p.ws + O_OB + g * SZ_O) + (size_t)tq * 384 + hh * 64, h, lt);
  if (h == 0) { float* st = (float*)(p.ws + O_STB) + ((size_t)(g * TH + tq) * 6 + hh) * 2; st[0] = m; st[1] = lt; }
}

DI void mem_item(const Params& p, int half, int e) {
  const int lane = otid() & 63, r = lane & 31, h = lane >> 5;
  const int hd = e & 3, qtile = e >> 2;
  const bf16_t* QE = (const bf16_t*)(p.ws + O_QE);
  const bf16_t* MK = (const bf16_t*)(p.ws + O_MEMK);
  const bf16_t* MV = (const bf16_t*)(p.ws + O_MEMVT);
  bf16x8 qf[6];
  { const bf16_t* qrow = QE + (size_t)(qtile * 32 + r) * 384 + hd * 96 + 8 * h;
#pragma unroll
    for (int s = 0; s < 6; ++s) qf[s] = *(const bf16x8*)(qrow + 16 * s); }
  auto tf = [&](int t, const bf16_t*& kp, const bf16_t*& vp, const float*&) -> int {
    const int keybase = 32 * (t < 7 ? t : 7);
    kp = MK + (size_t)((half * 4 + hd) * 8 + (keybase >> 5)) * 3072 + lane * 8;
    vp = MV + (size_t)((half * 4 + hd) * 8 + (keybase >> 5)) * 3072 + lane * 8;
    return 0;
  };
  auto mf = [&](int, int, float) -> float { return 0.f; };
  auto sf = [&](int, float, float) { return false; };
  f32x16 o[3]; zero_o(o); float m = -1e30f, l = 0.f;
  attn_loop<96, false>(8, tf, mf, sf, qf, 256L, 0.10206207261596577f * LOG2E, o, m, l);
  float lt;
  attn_store<96>(o, l, (bf16_t*)(p.ws + O_OE) + (size_t)(qtile * 32 + r) * 384 + hd * 96, h, lt);
}

DI float dpp_ror(float v, int ctrl);
DI float row16_sum(float v) {
  v += __builtin_bit_cast(float, __builtin_amdgcn_update_dpp(0, __builtin_bit_cast(int, v), 0x128, 0xf, 0xf, false));
  v += __builtin_bit_cast(float, __builtin_amdgcn_update_dpp(0, __builtin_bit_cast(int, v), 0x124, 0xf, 0xf, false));
  v += __builtin_bit_cast(float, __builtin_amdgcn_update_dpp(0, __builtin_bit_cast(int, v), 0x122, 0xf, 0xf, false));
  v += __builtin_bit_cast(float, __builtin_amdgcn_update_dpp(0, __builtin_bit_cast(int, v), 0x121, 0xf, 0xf, false));
  return v;
}

struct ScanRegs { bf16x8 pf[4][2]; bf16x8 qe[4][2]; s16x4 bc[4]; s16x4 o0[4]; float gl; };
DI void scan_load(const Params& p, int hh, int j, int c, int lane, ScanRegs& s) {
  const unsigned char* base = p.ws + O_DPREP + (size_t)(hh * 128 + c) * 32768;
#pragma unroll
  for (int mt = 0; mt < 4; ++mt)
#pragma unroll
    for (int ks = 0; ks < 2; ++ks) {
      s.pf[mt][ks] = *(const bf16x8*)(base + ((mt * 2 + ks) * 64 + lane) * 16);
      s.qe[mt][ks] = *(const bf16x8*)(base + 8192 + ((mt * 2 + ks) * 64 + lane) * 16);
    }
#pragma unroll
  for (int rt = 0; rt < 4; ++rt) {
    s.bc[rt] = *(const s16x4*)(base + 16384 + ((j * 4 + rt) * 64 + lane) * 8);
    s.o0[rt] = *(const s16x4*)(base + 24576 + ((j * 4 + rt) * 64 + lane) * 8);
  }
  s.gl = ((const float*)(p.ws + O_GL))[hh * 128 + c];
}
DI f32x4 s4f(s16x4 v) { u32x2 u = __builtin_bit_cast(u32x2, v); f32x4 r; r[0] = bflo(u.x); r[1] = bfhi(u.x); r[2] = bflo(u.y); r[3] = bfhi(u.y); return r; }

DI void scan_item(const Params& p, int it) {
  const int lane = otid() & 63, q = lane >> 4, cl = lane & 15;
  const int hh = it >> 2, j = it & 3;
  f32x4 S[4];
#pragma unroll
  for (int rt = 0; rt < 4; ++rt) S[rt] = (f32x4){0.f, 0.f, 0.f, 0.f};
  bf16_t* OD = (bf16_t*)(p.ws + O_OD);
  float* SSQ = (float*)(p.ws + O_SSQ);
#ifndef SCAN_PREFETCH
#define SCAN_PREFETCH 1
#endif
  ScanRegs cur, nxt;
  if (SCAN_PREFETCH) scan_load(p, hh, j, 0, lane, cur);
  for (int c = 0; c < 128; ++c) {
    if (SCAN_PREFETCH) {
      scan_load(p, hh, j, (c + 1 < 128) ? c + 1 : c, lane, nxt);
      asm volatile("" : "+v"(S[0][0]) :: "memory");
    } else {
      scan_load(p, hh, j, c, lane, cur);
    }
    bf16x8 bfr[2];
#pragma unroll
    for (int ks = 0; ks < 2; ++ks) {
      u32x4 u; u.x = pk2(S[2 * ks][0], S[2 * ks][1]); u.y = pk2(S[2 * ks][2], S[2 * ks][3]); u.z = pk2(S[2 * ks + 1][0], S[2 * ks + 1][1]); u.w = pk2(S[2 * ks + 1][2], S[2 * ks + 1][3]);
      bfr[ks] = __builtin_bit_cast(bf16x8, u);
    }
    f32x4 aP[4], aO[4];
#pragma unroll
    for (int rt = 0; rt < 4; ++rt) {
      aP[rt] = (f32x4){0.f, 0.f, 0.f, 0.f};
      aO[rt] = s4f(cur.o0[rt]);
#pragma unroll
      for (int ks = 0; ks < 2; ++ks) { aP[rt] = MFMA16(cur.pf[rt][ks], bfr[ks], aP[rt]); aO[rt] = MFMA16(cur.qe[rt][ks], bfr[ks], aO[rt]); }
    }
#pragma unroll
    for (int rt = 0; rt < 4; ++rt) S[rt] = S[rt] * cur.gl - aP[rt] + s4f(cur.bc[rt]);
#pragma unroll
    for (int rt = 0; rt < 4; ++rt)
#pragma unroll
      for (int e = 0; e < 4; ++e) {
        const int tok = c * 64 + 16 * rt + 4 * q + e;
        const float v = aO[rt][e];
        OD[(size_t)tok * 384 + hh * 64 + 16 * j + cl] = f2bf(v);
        const float ss = row16_sum(v * v);
        if (cl == 0) SSQ[(tok * 6 + hh) * 4 + j] = ss;
      }
    if (SCAN_PREFETCH) cur = nxt;
  }
}

DI void scan_block(const Params& p, int hh, unsigned char* smem) {
  const int tid = otid(), lane = tid & 63, j = tid >> 6, q = lane >> 4, cl = lane & 15;
  const unsigned char* src = p.ws + O_DPREP + (size_t)hh * 128 * 32768;
  bf16_t* ostg = (bf16_t*)(smem + 65536);
  bf16x8 R0[8], R1[8];
  auto gld = [&](int c, bf16x8 (&R)[8]) {
    c = c < 128 ? c : 127;
    const unsigned char* b = src + (size_t)c * 32768 + tid * 16;
#pragma unroll
    for (int i = 0; i < 8; ++i) R[i] = *(const bf16x8*)(b + i * 4096);
  };
  auto lst = [&](int buf, const bf16x8 (&R)[8]) {
    unsigned char* d = smem + buf * 32768 + tid * 16;
#pragma unroll
    for (int i = 0; i < 8; ++i) *(bf16x8*)(d + i * 4096) = R[i];
  };
  const float* GL = (const float*)(p.ws + O_GL) + hh * 128;
  const float gl_lo = GL[lane], gl_hi = GL[64 + lane];
  f32x4 S[4];
#pragma unroll
  for (int rt = 0; rt < 4; ++rt) S[rt] = (f32x4){0.f, 0.f, 0.f, 0.f};
  bf16_t* OD = (bf16_t*)(p.ws + O_OD);
  float* SSQ = (float*)(p.ws + O_SSQ);
  f32x4 aO[4];
  auto flush = [&](int cp) {
    const int row = tid >> 2, part = tid & 3;
    const bf16x8 v0 = *(const bf16x8*)(ostg + row * 72 + 16 * part), v1 = *(const bf16x8*)(ostg + row * 72 + 16 * part + 8);
    float f[16]; unpk8(v0, f); unpk8(v1, f + 8);
    float ss = 0.f;
#pragma unroll
    for (int e = 0; e < 16; ++e) ss += f[e] * f[e];
    const int tok = cp * 64 + row;
    bf16_t* dst = OD + (size_t)tok * 384 + hh * 64 + 16 * part;
    *(bf16x8*)dst = v0; *(bf16x8*)(dst + 8) = v1;
    SSQ[(tok * 6 + hh) * 4 + part] = ss;
  };
  auto compute = [&](int buf, int c) {
    const unsigned char* base = smem + buf * 32768;
    const float gl = __builtin_bit_cast(float, __builtin_amdgcn_readlane(__builtin_bit_cast(int, c < 64 ? gl_lo : gl_hi), c & 63));
    bf16x8 bfr[2];
#pragma unroll
    for (int ks = 0; ks < 2; ++ks) {
      u32x4 u; u.x = pk2(S[2 * ks][0], S[2 * ks][1]); u.y = pk2(S[2 * ks][2], S[2 * ks][3]); u.z = pk2(S[2 * ks + 1][0], S[2 * ks + 1][1]); u.w = pk2(S[2 * ks + 1][2], S[2 * ks + 1][3]);
      bfr[ks] = __builtin_bit_cast(bf16x8, u);
    }
    f32x4 aP[4];
#pragma unroll
    for (int rt = 0; rt < 4; ++rt) {
      aP[rt] = (f32x4){0.f, 0.f, 0.f, 0.f};
      aO[rt] = s4f(*(const s16x4*)(base + 24576 + ((j * 4 + rt) * 64 + lane) * 8));
#pragma unroll
      for (int ks = 0; ks < 2; ++ks) {
        aP[rt] = MFMA16(*(const bf16x8*)(base + ((rt * 2 + ks) * 64 + lane) * 16), bfr[ks], aP[rt]);
        aO[rt] = MFMA16(*(const bf16x8*)(base + 8192 + ((rt * 2 + ks) * 64 + lane) * 16), bfr[ks], aO[rt]);
      }
    }
#pragma unroll
    for (int rt = 0; rt < 4; ++rt) S[rt] = S[rt] * gl - aP[rt] + s4f(*(const s16x4*)(base + 16384 + ((j * 4 + rt) * 64 + lane) * 8));
  };
  auto stage_out = [&]() {
#pragma unroll
    for (int rt = 0; rt < 4; ++rt)
#pragma unroll
      for (int e = 0; e < 4; ++e) ostg[(16 * rt + 4 * q + e) * 72 + 16 * j + cl] = f2bf(aO[rt][e]);
  };
  __builtin_amdgcn_s_setprio(3);
  gld(0, R0); gld(1, R1);
  lst(0, R0); gld(2, R0);
  sub_sync();
#pragma unroll 1
  for (int c = 0; c < 128; c += 2) {
    lst(1, R1);
    gld(c + 3, R1);
    if (c > 0) flush(c - 1);
    compute(0, c);
    sub_sync();
    stage_out();
    sub_sync();
    lst(0, R0);
    gld(c + 4, R0);
    flush(c);
    compute(1, c + 1);
    sub_sync();
    stage_out();
    sub_sync();
  }
  flush(127);
  sub_sync();
  __builtin_amdgcn_s_setprio(0);
}

DI void phase3(const Params& p, int half, unsigned* ctr, const unsigned* kmaxu, unsigned char* smem, int sub, int limit = 1 << 30) {
  const int tid = otid(), wave = tid >> 6;
  const int hb = (int)blockIdx.x, x = hb & 7, bi = hb >> 3;
  if (hb < 3 && limit >= 0) { if (PH(5)) scan_block(p, hb * 2 + sub, smem); }
  if (bi >= 1 && limit != 0) {
    const int nlw = ((int)(gridDim.x >> 3) - 1) * 8, lw = ((bi - 1) * 2 + sub) * 4 + wave;
    if (x < 6) {
      const int hh = x;
      constexpr int NG = 992, NOWN = 256, NB_ = 640, NTOT = NG + NOWN + NB_;
      for (int pos0 = lw; pos0 < NTOT; pos0 += nlw) {
        int pos = __builtin_amdgcn_readfirstlane(pos0);
        if (pos < NG) { if (PH(6)) moba_gather(p, (((pos >> 1) * 6 + hh) << 1) | (pos & 1), smem); continue; }
        pos -= NG;
        if (pos < NOWN) { if (PH(6)) moba_own(p, pos * 6 + hh); continue; }
        pos -= NOWN;
        const int g = pos < 512 ? (pos >> 8) : 2, w = pos < 512 ? (pos & 255) : 2 * (pos - 512);
        if (PH(8)) dil_item(p, g * 1536 + hh * 256 + w);
      }
    } else {
      const int h0 = (x - 6) * 3;
      constexpr int NE = 512, NC = 768, NB2 = 384, NTOT = NE + NC + NB2;
      for (int pos0 = lw; pos0 < NTOT; pos0 += nlw) {
        int pos = __builtin_amdgcn_readfirstlane(pos0);
        if (pos < NE) { if (PH(7)) mem_item(p, half, (x - 6) * 512 + pos); continue; }
        pos -= NE;
        if (pos < NC) { if (PH(9)) fox_item(p, (pos & 255) * 6 + h0 + (pos >> 8), kmaxu); continue; }
        pos -= NC;
        if (PH(8)) dil_item(p, 2 * 1536 + (h0 + (pos >> 7)) * 256 + 2 * (pos & 127) + 1);
      }
    }
  }
}

DI void gbuild_chunk(const Params& p, int layer, int tok, int c8) {
  const unsigned char* ws = p.ws;
  const int n = c8 / 48, c = (c8 % 48) * 8;
  bf16_t* szp = (bf16_t*)(p.ws + O_SZ) + (size_t)tok * 1920 + n * 384 + c;
  float o[8], z[8];
  unpk8(*(const bf16x8*)szp, z);
  if (n == 1) {
    const int hh = c >> 6;
    const float* st = (const float*)(ws + O_STB);
    float mg[3], lg[3];
#pragma unroll
    for (int g = 0; g < 3; ++g) { const f32x2 s2 = *(const f32x2*)(st + ((size_t)(g * TH + tok) * 6 + hh) * 2); mg[g] = s2[0]; lg[g] = s2[1]; }
    const float mm = fmaxf(mg[0], fmaxf(mg[1], mg[2]));
    float wg[3], ws_ = 0.f;
#pragma unroll
    for (int g = 0; g < 3; ++g) { wg[g] = exp2f(mg[g] - mm) * lg[g]; ws_ += wg[g]; }
    const float inv = 1.f / ws_;
#pragma unroll
    for (int e = 0; e < 8; ++e) o[e] = 0.f;
#pragma unroll
    for (int g = 0; g < 3; ++g) {
      float t[8]; unpk8(*(const bf16x8*)((const bf16_t*)(ws + O_OB + g * SZ_O) + (size_t)tok * 384 + c), t);
      const float wgi = wg[g] * inv;
#pragma unroll
      for (int e = 0; e < 8; ++e) o[e] += wgi * t[e];
    }
  } else if (n == 3) {
    const int hh = c >> 6;
    const f32x4 sq = *(const f32x4*)((const float*)(ws + O_SSQ) + ((size_t)tok * 6 + hh) * 4);
    const float rs = rsqrtf((sq[0] + sq[1] + sq[2] + sq[3]) * (1.f / 64.f) + 1e-6f);
    unpk8(*(const bf16x8*)((const bf16_t*)(ws + O_OD) + (size_t)tok * 384 + c), o);
    const float* gw = p.gdn_w + layer * 64 + (c & 63);
#pragma unroll
    for (int e = 0; e < 8; ++e) o[e] *= rs * gw[e];
  } else if (n == 0) {
    const int hh = c >> 6;
    const float* st = (const float*)(ws + O_STA);
    float mg[4], lg[4], mm = -1e30f;
#pragma unroll
    for (int g = 0; g < 4; ++g) { const f32x2 s2 = *(const f32x2*)(st + ((size_t)(g * TH + tok) * 6 + hh) * 2); mg[g] = s2[0]; lg[g] = s2[1]; mm = fmaxf(mm, mg[g]); }
    float wg[4], ws_ = 0.f;
#pragma unroll
    for (int g = 0; g < 4; ++g) { wg[g] = exp2f(mg[g] - mm) * lg[g]; ws_ += wg[g]; }
    const float inv = 1.f / ws_;
#pragma unroll
    for (int e = 0; e < 8; ++e) o[e] = 0.f;
#pragma unroll
    for (int g = 0; g < 4; ++g) {
      if (lg[g] > 0.f) {
        float t[8]; unpk8(*(const bf16x8*)((const bf16_t*)(ws + O_OA + g * SZ_O) + (size_t)tok * 384 + c), t);
        const float wgi = wg[g] * inv;
#pragma unroll
        for (int e = 0; e < 8; ++e) o[e] += wgi * t[e];
      }
    }
  } else {
    const size_t off = (n == 2) ? O_OC : O_OE;
    unpk8(*(const bf16x8*)((const bf16_t*)(ws + off) + (size_t)tok * 384 + c), o);
  }
#pragma unroll
  for (int e = 0; e < 8; ++e) o[e] *= z[e];
  *(bf16x8*)szp = pk8(o);
}

DI void p4a_tile(const Params& p, int layer, int mt, int nt, unsigned char* smem) {
  sub_sync();
  bf16_t* As = (bf16_t*)smem; bf16_t* Bs = As + 2 * 9216;
  const int tid = otid(), lane = tid & 63, wave = tid >> 6, wr = wave >> 1, wc = wave & 1, r = lane & 31, h = lane >> 5;
  const int m0 = mt * 128, n0 = nt * 128;
  f32x16 tot[2][2]; zero_acc(tot);
  const bf16_t* SIG = (const bf16_t*)(p.ws + O_SIG);
  for (int n = 0; n < 5; ++n) {
    f32x16 acc[2][2]; zero_acc(acc);
    PlainA al{(const bf16_t*)(p.ws + O_SZ) + n * 384, 1920};
    gemm_kloop_t<32>(al, (const bf16_t*)(p.ws + O_WTBR) + (size_t)(layer * 5 + n) * 1024 * 384, 384, 12, m0, n0, acc, As, Bs);
#pragma unroll
    for (int mi = 0; mi < 2; ++mi) {
      const int tok = m0 + wr * 64 + mi * 32 + r;
#pragma unroll
      for (int ni = 0; ni < 2; ++ni)
#pragma unroll
        for (int g = 0; g < 4; ++g) {
          const int col = n0 + wc * 64 + ni * 32 + 8 * g + 4 * h;
          const u32x2 sg = *(const u32x2*)(SIG + (size_t)tok * 5120 + n * 1024 + col);
          tot[mi][ni][4 * g] += bflo(sg.x) * acc[mi][ni][4 * g];
          tot[mi][ni][4 * g + 1] += bfhi(sg.x) * acc[mi][ni][4 * g + 1];
          tot[mi][ni][4 * g + 2] += bflo(sg.y) * acc[mi][ni][4 * g + 2];
          tot[mi][ni][4 * g + 3] += bfhi(sg.y) * acc[mi][ni][4 * g + 3];
          asm volatile("" ::: "memory");
        }
    }
  }
  bf16_t* YM = (bf16_t*)(p.ws + O_YM);
  {
    bf16_t* stg = (bf16_t*)smem + wave * (64 * 72);
#pragma unroll
    for (int ni = 0; ni < 2; ++ni)
#pragma unroll
      for (int mi = 0; mi < 2; ++mi)
#pragma unroll
        for (int g = 0; g < 4; ++g)
          *(u32x2*)(stg + (mi * 32 + r) * 72 + ni * 32 + 8 * g + 4 * h) = pk4(tot[mi][ni][4 * g], tot[mi][ni][4 * g + 1], tot[mi][ni][4 * g + 2], tot[mi][ni][4 * g + 3]);
    asm volatile("s_waitcnt lgkmcnt(0)" ::: "memory");
    __builtin_amdgcn_wave_barrier();
    const int tok0 = m0 + wr * 64, col0 = n0 + wc * 64;
#pragma unroll
    for (int it = 0; it < 8; ++it) {
      const int row = it * 8 + (lane >> 3), ch = (lane & 7) * 8;
      const bf16x8 val = *(const bf16x8*)(stg + row * 72 + ch);
      *(bf16x8*)(YM + (size_t)(tok0 + row) * 1024 + col0 + ch) = val;
    }
  }
}

DI void p4b_tile(const Params& p, int layer, int half, int mt, int nt, unsigned char* smem) {
  bf16_t* As = (bf16_t*)smem; bf16_t* Bs = As + 2 * 9216;
  const int tid = otid(), lane = tid & 63, wave = tid >> 6, wr = wave >> 1, wc = wave & 1, r = lane & 31, h = lane >> 5;
  const int m0 = mt * 128, n0 = nt * 128;
  f32x16 acc[2][2]; zero_acc(acc);
  PlainA al{(const bf16_t*)(p.ws + O_YM), 1024};
  gemm_kloop(al, (const bf16_t*)(p.ws + O_WTOUT + layer * SZ_WTOUT1), 1024, 16, m0, n0, acc, As, Bs);
  const float* xin = layer == 0 ? p.x : p.out;
  const float alpha = 1.4142135623730951f;
#pragma unroll
  for (int mi = 0; mi < 2; ++mi) {
    const size_t gt = (size_t)half * TH + m0 + wr * 64 + mi * 32 + r;
#pragma unroll
    for (int ni = 0; ni < 2; ++ni)
#pragma unroll
      for (int g = 0; g < 4; ++g) {
        const int col = n0 + wc * 64 + ni * 32 + 8 * g + 4 * h;
        const f32x4 xv = *(const f32x4*)(xin + gt * 1024 + col);
        f32x4 o;
#pragma unroll
        for (int e = 0; e < 4; ++e) o[e] = alpha * xv[e] + acc[mi][ni][4 * g + e];
        *(f32x4*)(p.out + gt * 1024 + col) = o;
      }
  }
}

DI void p4c_row(const Params& p, int layer, size_t gt, bool wxb = true) {
  const int lane = otid() & 63;
  float* row = p.out + gt * 1024;
  f32x4 v[4]; float s = 0.f;
#pragma unroll
  for (int j = 0; j < 4; ++j) { v[j] = *(const f32x4*)(row + 4 * lane + 256 * j); s += v[j][0] + v[j][1] + v[j][2] + v[j][3]; }
#pragma unroll
  for (int o = 32; o >= 1; o >>= 1) s += __shfl_xor(s, o);
  const float mu = s * (1.f / 1024.f); float q = 0.f;
#pragma unroll
  for (int j = 0; j < 4; ++j) { v[j] -= mu; q += v[j][0] * v[j][0] + v[j][1] * v[j][1] + v[j][2] * v[j][2] + v[j][3] * v[j][3]; }
#pragma unroll
  for (int o = 32; o >= 1; o >>= 1) q += __shfl_xor(q, o);
  const float rs = rsqrtf(q * (1.f / 1024.f) + 1e-5f);
  bf16_t* xb = (bf16_t*)(p.ws + O_XB) + gt * 1024;
#pragma unroll
  for (int j = 0; j < 4; ++j) {
    const int c = 4 * lane + 256 * j;
    const f32x4 g = *(const f32x4*)(p.ln_g + layer * 1024 + c), b = *(const f32x4*)(p.ln_b + layer * 1024 + c);
    f32x4 y;
#pragma unroll
    for (int e = 0; e < 4; ++e) y[e] = v[j][e] * rs * g[e] + b[e];
    *(f32x4*)(row + c) = y;
    if (wxb) *(u32x2*)(xb + c) = pk4(y[0], y[1], y[2], y[3]);
  }
}


#define XB_TMO      128
#define XB_XCNT(j)  (256  + 64 * (j))
#define XB_XSUB(j)  (1280 + 64 * (j))
#define XB_XGEN(j)  (2304 + 64 * (j))
#define XB_TOP      3328
#define XB_TOPGEN   3392
#define XB_SPIN_CAP (1u << 22)
#define LAS __attribute__((address_space(3)))
DI unsigned xb_ld(unsigned* p) { return __hip_atomic_load(p, __ATOMIC_RELAXED, __HIP_MEMORY_SCOPE_AGENT); }
DI unsigned xb_add(unsigned* p, unsigned v) { return __hip_atomic_fetch_add(p, v, __ATOMIC_RELAXED, __HIP_MEMORY_SCOPE_AGENT); }
DI unsigned xb_xcc_id() { return (unsigned)__builtin_amdgcn_s_getreg((3 << 11) | 20) & 0xFu; }
#define XB_SPIN(cond, bar) do { unsigned _sp = 0; while (cond) { __builtin_amdgcn_s_sleep(1); \
    if ((++_sp & 255u) == 0u) { if (xb_ld(&(bar)[XB_TMO])) break; if (_sp > XB_SPIN_CAP) { atomicAdd(&(bar)[XB_TMO], 1u); break; } } } } while (0)
struct XcdBarrier { unsigned* bar; unsigned x; volatile LAS unsigned* st; };
DI XcdBarrier xcd_barrier_post(unsigned* bar, volatile LAS unsigned* st) {
  XcdBarrier b; b.bar = bar; b.x = xb_xcc_id(); b.st = st;
  if (threadIdx.x == 0) (void)xb_add(&bar[XB_XCNT(b.x)], 1u);
  return b;
}
DI void xcd_barrier_complete(unsigned* bar, unsigned x, unsigned& nloc, unsigned& nx) {
  const unsigned G = gridDim.x;
  unsigned sum, cnt, mine, sp = 0u;
  for (;;) {
    sum = 0u; cnt = 0u; mine = 0u;
#pragma unroll
    for (unsigned j = 0; j < 16; ++j) { const unsigned c = xb_ld(&bar[XB_XCNT(j)]); sum += c; cnt += (c > 0u) ? 1u : 0u; mine = (j == x) ? c : mine; }
    if (sum == G) break;
    __builtin_amdgcn_s_sleep(1);
    if ((++sp & 255u) == 0u) { if (xb_ld(&bar[XB_TMO])) break; if (sp > XB_SPIN_CAP) { atomicAdd(&bar[XB_TMO], 1u); break; } }
  }
  nloc = mine > 0u ? mine : 1u; nx = cnt > 0u ? cnt : 1u;
}
DI void xcd_barrier(const XcdBarrier& b) {
  asm volatile("s_waitcnt vmcnt(0)" ::: "memory");
  __syncthreads();
  if (threadIdx.x == 0) {
    unsigned* bar = b.bar;
    __builtin_amdgcn_s_waitcnt(0);
    unsigned nloc = b.st[0], nx = b.st[1];
    if (nloc == 0u) { xcd_barrier_complete(bar, b.x, nloc, nx); b.st[0] = nloc; b.st[1] = nx; }
    const unsigned old = xb_add(&bar[XB_XSUB(b.x)], 1u);
    const unsigned gen = old / nloc;
    if (old + 1u == (gen + 1u) * nloc) {
      __builtin_amdgcn_fence(__ATOMIC_RELEASE, "agent");
      asm volatile("s_waitcnt vmcnt(0)" ::: "memory");
      const unsigned og = xb_add(&bar[XB_TOP], 1u);
      const unsigned tg = og / nx;
      if (og + 1u == (tg + 1u) * nx) xb_add(&bar[XB_TOPGEN], 1u);
      else XB_SPIN(xb_ld(&bar[XB_TOPGEN]) == tg, bar);
      __builtin_amdgcn_fence(__ATOMIC_ACQUIRE, "agent");
      xb_add(&bar[XB_XGEN(b.x)], 1u);
      asm volatile("s_waitcnt vmcnt(0)" ::: "memory");
    } else {
      XB_SPIN(xb_ld(&bar[XB_XGEN(b.x)]) == gen, bar);
      __builtin_amdgcn_fence(__ATOMIC_ACQUIRE, "agent");
      asm volatile("s_waitcnt vmcnt(0)" ::: "memory");
    }
  }
  __syncthreads();
}

#ifdef PROBE_A
#define STAMP(k) do { if (blockIdx.x == 0 && otid() == 0) { unsigned long long now_ = __builtin_amdgcn_s_memrealtime(); tsacc[k] += (float)(now_ - tlast) * 0.01f; tlast = now_; } } while (0)
#else
#define STAMP(k) do {} while (0)
#endif
__global__ void __launch_bounds__(512, 2) mega(Params p) {
  extern __shared__ __attribute__((aligned(16))) unsigned char smem_all[];
  cg::grid_group grid = cg::this_grid();
  if (p.ws == nullptr) grid.sync();
  volatile LAS unsigned* xbst = (volatile LAS unsigned*)(smem_all + 2 * SUB_LDS);
  if (threadIdx.x < 4) xbst[threadIdx.x] = 0u;
  __syncthreads();
  const XcdBarrier xb = xcd_barrier_post((unsigned*)(p.ws + O_BAR), xbst);
#define GSYNC() xcd_barrier(xb)
  const int sub = __builtin_amdgcn_readfirstlane(__builtin_amdgcn_workitem_id_x() >> 8);
  unsigned char* smem = smem_all + sub * SUB_LDS;
  const int vb = (int)blockIdx.x * 2 + sub, vgrid = (int)gridDim.x * 2;
  const int wave = otid() >> 6;
  const int gw = vb * 4 + wave, ngw = vgrid * 4;
  phase0(p, smem, vb, vgrid);
  GSYNC();
  int pend_layer = -1, pend_half = 0;
  for (int itn = 0; itn < 4; ++itn) {
    const int layer = itn >> 1, half = itn & 1;
    if (pend_layer >= 0) { for (int rw = gw; rw < TH; rw += ngw) p4c_row(p, pend_layer, (size_t)pend_half * TH + rw, true); pend_layer = -1; }
    for (int t = (int)blockIdx.x; t < 32 * 54; t += (int)gridDim.x) {
      const int tn = t + (int)gridDim.x;
      p1_unit(p, layer, half, t & 31, t >> 5, tn < 32 * 54 ? (tn & 31) : 0, tn < 32 * 54 ? (tn >> 5) : -1, t == (int)blockIdx.x, smem_all);
    }
    GSYNC();
    {
      constexpr int N_FOX = 6, N_GDN = 768, N_MKV = 12, N_KM = 48, TOT = N_FOX + N_GDN + N_MKV + N_KM;
      for (int t = vb; t < TOT; t += vgrid) {
        int i = t;
        if (i < N_FOX) { fox_prep(p, i, smem); continue; }
        i -= N_FOX;
        if (i < N_GDN) { gdn_prep(p, layer, half, i / 128, i % 128, smem); continue; }
        i -= N_GDN;
        if (i < N_MKV) { memkv_tile(p, layer, half, i / 6, i % 6, smem); continue; }
        i -= N_MKV;
        kmean_prep(p, i * 4 + wave, (unsigned*)(p.ws + O_CTL) + 64 + (layer * 2 + half) * 8);
      }
    }
    GSYNC();
    for (int a = gw; a < 1536; a += ngw) moba_select(p, a);
    GSYNC();
    phase3(p, half, (unsigned*)(p.ws + O_CTL) + layer * 2 + half, (const unsigned*)(p.ws + O_CTL) + 64 + (layer * 2 + half) * 8, smem, sub);
    GSYNC();
    for (int ci = vb * 256 + otid(); ci < TH * 240; ci += vgrid * 256) gbuild_chunk(p, layer, ci / 240, ci % 240);
    GSYNC();
    for (int t = vb; t < 512; t += vgrid) p4a_tile(p, layer, t % 64, t / 64, smem);
    GSYNC();
    for (int t = vb; t < 512; t += vgrid) p4b_tile(p, layer, half, t % 64, t / 64, smem);
    GSYNC();
    pend_layer = layer; pend_half = half;
  }
  if (pend_layer >= 0) { for (int rw = gw; rw < TH; rw += ngw) p4c_row(p, pend_layer, (size_t)pend_half * TH + rw, true); }
}

extern "C" void kernel_launch(void* const* d_in, const int* in_sizes, int n_in, void* d_out, int out_size, void* d_ws, size_t ws_size,
                              hipStream_t stream) {
  static int grid_blocks = 0;
  if (grid_blocks == 0) {
    if (ws_size < WS_END) { fprintf(stderr, "workspace too small: %zu < %zu\n", ws_size, (size_t)WS_END); grid_blocks = -1; return; }
    int dev = 0, cus = 0, per_cu = 0;
    (void)hipGetDevice(&dev);
    (void)hipDeviceGetAttribute(&cus, hipDeviceAttributeMultiprocessorCount, dev);
    (void)hipFuncSetAttribute((const void*)mega, hipFuncAttributeMaxDynamicSharedMemorySize, LDS_BYTES);
    (void)hipOccupancyMaxActiveBlocksPerMultiprocessor(&per_cu, (const void*)mega, 512, LDS_BYTES);
    if (per_cu < 1) per_cu = 1;
    if (per_cu > 1) per_cu = 1;
    grid_blocks = cus * per_cu;
  }
  if (grid_blocks < 0) return;
  (void)hipMemsetAsync((char*)d_ws + O_CTL, 0, 32768, stream);
  Params p{};
  p.x = (const float*)d_in[0]; p.mem = (const float*)d_in[1]; p.mem_g = (const float*)d_in[2]; p.mem_b = (const float*)d_in[3];
  p.w_in = (const float*)d_in[4]; p.b_in = (const float*)d_in[5]; p.conv_w = (const float*)d_in[6]; p.a_log = (const float*)d_in[7];
  p.dt_bias = (const float*)d_in[8]; p.gdn_w = (const float*)d_in[9]; p.w_kv = (const float*)d_in[10]; p.w_br = (const float*)d_in[11];
  p.w_out = (const float*)d_in[12]; p.ln_g = (const float*)d_in[13]; p.ln_b = (const float*)d_in[14];
  p.out = (float*)d_out; p.ws = (unsigned char*)d_ws;
  void* args[] = {&p};
  hipError_t e = hipLaunchCooperativeKernel((const void*)mega, dim3(grid_blocks), dim3(512), args, LDS_BYTES, stream);
  if (e != hipSuccess) fprintf(stderr, "cooperative launch failed: %s (grid %d)\n", hipGetErrorString(e), grid_blocks);
}
```

```cpp
#include <hip/hip_runtime.h>
#include <hip/hip_cooperative_groups.h>
#include <cstdio>
#include <cstdint>
namespace cg = cooperative_groups;

#define DI __device__ __forceinline__
typedef unsigned short bf16_t;
typedef short bf16x8 __attribute__((ext_vector_type(8)));
typedef short s16x4 __attribute__((ext_vector_type(4)));
typedef float f32x4 __attribute__((ext_vector_type(4)));
typedef float f32x2 __attribute__((ext_vector_type(2)));
typedef float f32x16 __attribute__((ext_vector_type(16)));
typedef unsigned u32x2 __attribute__((ext_vector_type(2)));
typedef unsigned u32x4 __attribute__((ext_vector_type(4)));
typedef __bf16 bfv2 __attribute__((ext_vector_type(2)));

#define MFMA32(a, b, c) __builtin_amdgcn_mfma_f32_32x32x16_bf16((a), (b), (c), 0, 0, 0)
#define MFMA16(a, b, c) __builtin_amdgcn_mfma_f32_16x16x32_bf16((a), (b), (c), 0, 0, 0)

DI unsigned pk2(float a, float b) { f32x2 v = {a, b}; return __builtin_bit_cast(unsigned, __builtin_convertvector(v, bfv2)); }
DI bf16_t f2bf(float a) { return (bf16_t)(pk2(a, 0.f) & 0xffffu); }
DI float bf2f(bf16_t v) { return __uint_as_float(((unsigned)v) << 16); }
DI float bflo(unsigned u) { return __uint_as_float(u << 16); }
DI float bfhi(unsigned u) { return __uint_as_float(u & 0xffff0000u); }
DI int rtid() { int t = __builtin_amdgcn_workitem_id_x(); asm volatile("" : "+v"(t)); return t; }
DI int otid() { return rtid() & 255; }
extern __shared__ __attribute__((aligned(16))) unsigned char g_lds_all[];
#define LAS3 __attribute__((address_space(3)))
DI void sub_sync() {
  asm volatile("s_waitcnt lgkmcnt(0)" ::: "memory");
  const int t = __builtin_amdgcn_workitem_id_x();
  LAS3 unsigned* c = (LAS3 unsigned*)(g_lds_all + 2 * 75776 + 8) + (t >> 8);
  if ((t & 63) == 0) {
    const unsigned old = __hip_atomic_fetch_add(c, 1u, __ATOMIC_RELAXED, __HIP_MEMORY_SCOPE_WORKGROUP);
    const unsigned target = (old / 4u + 1u) * 4u;
    while (__hip_atomic_load(c, __ATOMIC_RELAXED, __HIP_MEMORY_SCOPE_WORKGROUP) < target) __builtin_amdgcn_s_sleep(1);
  }
  asm volatile("s_waitcnt lgkmcnt(0)" ::: "memory");
}
DI int crow(int i, int h) { return (i & 3) + 8 * (i >> 2) + 4 * h; }
DI float fsigmoid(float v) { return __builtin_amdgcn_rcpf(1.f + __expf(-v)); }
DI float fsilu(float v) { return v * fsigmoid(v); }
DI u32x2 pk4(float a, float b, float c, float d) { u32x2 r; r.x = pk2(a, b); r.y = pk2(c, d); return r; }
DI bf16x8 pk8(const float* v) { u32x4 r; r.x = pk2(v[0], v[1]); r.y = pk2(v[2], v[3]); r.z = pk2(v[4], v[5]); r.w = pk2(v[6], v[7]); return __builtin_bit_cast(bf16x8, r); }
DI void unpk8(bf16x8 x, float* v) { u32x4 u = __builtin_bit_cast(u32x4, x); v[0] = bflo(u.x); v[1] = bfhi(u.x); v[2] = bflo(u.y); v[3] = bfhi(u.y); v[4] = bflo(u.z); v[5] = bfhi(u.z); v[6] = bflo(u.w); v[7] = bfhi(u.w); }

constexpr int NB = 2, SQ = 8192, NT = NB * SQ, DM = 1024, NH = 6, BW = 384;
constexpr int TH = 8192;
constexpr int NP = 13824;
constexpr int DIN = 13586;
constexpr float LOG2E = 1.4426950408889634f;
#define NEG_INF (-__builtin_inff())

constexpr int C_AQK = 0, C_AV = 768, C_BQK = 1152, C_BV = 3456, C_CQK = 3840, C_CV = 4608, C_D = 4992, C_E = 6144, C_SM = 6528, C_SMEND = 6546, C_Z = 6656, C_MG = 8576;

__host__ __device__ constexpr int inmap(int n) {
  return n < 4992 ? n : n < 6144 ? n + 6 : n < 6528 ? n + 18 : n < 6534 ? n - 1536 : n < 6546 ? n - 384 : n < 6656 ? -1 : n < 13696 ? n - 110 : -1;
}

constexpr size_t O_CTL = 0;
constexpr size_t O_BAR = 4096;
constexpr size_t O_WTIN = 32768;
constexpr size_t SZ_WTIN1 = (size_t)NP * 1024 * 2;
constexpr size_t O_WTBR = O_WTIN + 2 * SZ_WTIN1;
constexpr size_t SZ_WTBR1 = (size_t)5 * 1024 * 384 * 2;
constexpr size_t O_WTOUT = O_WTBR + 2 * SZ_WTBR1;
constexpr size_t SZ_WTOUT1 = (size_t)1024 * 1024 * 2;
constexpr size_t O_WTKV = O_WTOUT + 2 * SZ_WTOUT1;
constexpr size_t SZ_WTKV1 = (size_t)768 * 1024 * 2;
constexpr size_t O_BIASP = O_WTKV + 2 * SZ_WTKV1;
constexpr size_t O_XB = O_BIASP + (size_t)2 * NP * 4;
constexpr size_t O_MEMN = O_XB + (size_t)NT * 1024 * 2;
constexpr size_t O_MEMK = O_MEMN + (size_t)512 * 1024 * 2;
constexpr size_t O_MEMVT = O_MEMK + (size_t)512 * 384 * 2;
constexpr size_t O_QKA = O_MEMVT + (size_t)512 * 384 * 2;
constexpr size_t SZ_VT = (size_t)384 * TH * 2;
constexpr size_t O_KFA = O_QKA + SZ_VT;
constexpr size_t O_VTA = O_KFA + SZ_VT;
constexpr size_t O_QKB = O_VTA + SZ_VT;
constexpr size_t O_KFB = O_QKB + 3 * SZ_VT;
constexpr size_t O_VTB = O_KFB + 3 * SZ_VT;
constexpr size_t O_QKC = O_VTB + 3 * SZ_VT;
constexpr size_t O_KFC = O_QKC + SZ_VT;
constexpr size_t O_VTC = O_KFC + SZ_VT;
constexpr size_t O_QKVD = O_VTC + SZ_VT;
constexpr size_t O_QE = O_QKVD + (size_t)TH * 1152 * 2;
constexpr size_t O_SM = O_QE + (size_t)TH * 384 * 2;
constexpr size_t O_FF = O_SM + (size_t)TH * 32 * 4;
constexpr size_t O_KM = O_FF + (size_t)6 * TH * 4;
constexpr size_t O_KMAX = O_KM + (size_t)2 * 6 * 32 * 64 * 2;
constexpr size_t O_GL = O_KMAX + 256;
constexpr size_t O_MASK = O_GL + 6 * 128 * 4;
constexpr size_t O_DPREP = O_MASK + (size_t)TH * 8 * 4;
constexpr size_t O_SZ = O_DPREP + (size_t)768 * 32768;
constexpr size_t O_SIG = O_SZ + (size_t)TH * 1920 * 2;
constexpr size_t O_OA = O_SIG + (size_t)TH * 5120 * 2;
constexpr size_t SZ_O = (size_t)TH * 384 * 2;
constexpr size_t O_STA = O_OA + 4 * SZ_O;
constexpr size_t O_OB = O_STA + (size_t)4 * TH * 6 * 2 * 4;
constexpr size_t O_STB = O_OB + 3 * SZ_O;
constexpr size_t O_OC = O_STB + (size_t)3 * TH * 6 * 2 * 4;
constexpr size_t O_OD = O_OC + SZ_O;
constexpr size_t O_SSQ = O_OD + SZ_O;
constexpr size_t O_OE = O_SSQ + (size_t)TH * 6 * 4 * 4;
constexpr size_t WS_END = O_OE + SZ_O;
constexpr size_t O_YM = O_QKB;
static_assert(WS_END < (size_t)443 * 1000 * 1000, "workspace too large");

struct Params {
  const float *x, *mem, *mem_g, *mem_b, *w_in, *b_in, *conv_w, *a_log, *dt_bias, *gdn_w, *w_kv, *w_br, *w_out, *ln_g, *ln_b;
  float* out;
  unsigned char* ws;
};

constexpr int SUB_LDS = 75776;
constexpr int LDS_BYTES = 2 * SUB_LDS + 16;
#ifndef PH_MASK
#define PH_MASK 0xFFFF
#endif
#define PH(x) ((PH_MASK >> (x)) & 1)
#ifndef REP_MASK
#define REP_MASK 0
#endif
#define REP(x) (1 + ((REP_MASK >> (x)) & 1))

DI void transpose_tile(const float* __restrict__ src, int ld, int k0, int n0, bool usemap, bf16_t* __restrict__ dst, int dstld, float* tile) {
  const int tid = otid();
#pragma unroll
  for (int it = 0; it < 16; ++it) {
    const int kk = (tid >> 6) + 4 * it, n2 = (tid & 63) * 2;
    const int sc = usemap ? inmap(n0 + n2) : (n0 + n2);
    f32x2 v = {0.f, 0.f};
    if (sc >= 0) v = *(const f32x2*)(src + (size_t)(k0 + kk) * ld + sc);
    *(f32x2*)(tile + kk * 130 + n2) = v;
  }
  sub_sync();
#pragma unroll
  for (int it = 0; it < 4; ++it) {
    const int nn = (tid >> 3) + 32 * it, kc = (tid & 7) * 8;
    float v[8];
#pragma unroll
    for (int e = 0; e < 8; ++e) v[e] = tile[(kc + e) * 130 + nn];
    *(bf16x8*)(dst + (size_t)(n0 + nn) * dstld + k0 + kc) = pk8(v);
  }
  sub_sync();
}

DI void phase0(const Params& p, unsigned char* smem, int vb, int vgrid) {
  float* tile = (float*)smem;
  const int tid = otid(), lane = tid & 63, wave = tid >> 6;
  constexpr int N_TIN = 2 * 108 * 16, N_TBR = 2 * 5 * 8 * 6, N_TOUT = 2 * 8 * 16, N_TKV = 2 * 6 * 16, N_XB = 1024, N_MEMN = 128, N_BIAS = 108;
  constexpr int TOT = N_TIN + N_TBR + N_TOUT + N_TKV + N_XB + N_MEMN + N_BIAS;
  for (int it = vb; it < TOT; it += vgrid) {
    int i = it;
    if (i < N_TIN) {
      const int l = i / (108 * 16), rr = i % (108 * 16), nt = rr / 16, kt = rr % 16;
      transpose_tile(p.w_in + (size_t)l * 1024 * DIN, DIN, kt * 64, nt * 128, true, (bf16_t*)(p.ws + O_WTIN + l * SZ_WTIN1), 1024, tile);
      continue;
    }
    i -= N_TIN;
    if (i < N_TBR) {
      const int ln = i / 48, rr = i % 48, nt = rr / 6, kt = rr % 6;
      transpose_tile(p.w_br + (size_t)ln * 384 * 1024, 1024, kt * 64, nt * 128, false, (bf16_t*)(p.ws + O_WTBR) + (size_t)ln * 1024 * 384, 384, tile);
      continue;
    }
    i -= N_TBR;
    if (i < N_TOUT) {
      const int l = i / 128, rr = i % 128, nt = rr / 16, kt = rr % 16;
      transpose_tile(p.w_out + (size_t)l * 1024 * 1024, 1024, kt * 64, nt * 128, false, (bf16_t*)(p.ws + O_WTOUT + l * SZ_WTOUT1), 1024, tile);
      continue;
    }
    i -= N_TOUT;
    if (i < N_TKV) {
      const int l = i / 96, rr = i % 96, nt = rr / 16, kt = rr % 16;
      transpose_tile(p.w_kv + (size_t)l * 1024 * 768, 768, kt * 64, nt * 128, false, (bf16_t*)(p.ws + O_WTKV + l * SZ_WTKV1), 1024, tile);
      continue;
    }
    i -= N_TKV;
    if (i < N_XB) {
      const float* src = p.x + (size_t)i * 16 * 1024;
      bf16_t* dst = (bf16_t*)(p.ws + O_XB) + (size_t)i * 16 * 1024;
#pragma unroll
      for (int j = 0; j < 16; ++j) {
        const int e = (j * 256 + tid) * 4;
        const f32x4 v = *(const f32x4*)(src + e);
        *(u32x2*)(dst + e) = pk4(v[0], v[1], v[2], v[3]);
      }
      continue;
    }
    i -= N_XB;
    if (i < N_MEMN) {
      const int row = i * 4 + wave;
      const float* src = p.mem + (size_t)row * 1024;
      f32x4 v[4]; float s = 0.f;
#pragma unroll
      for (int j = 0; j < 4; ++j) { v[j] = *(const f32x4*)(src + 4 * lane + 256 * j); s += v[j][0] + v[j][1] + v[j][2] + v[j][3]; }
#pragma unroll
      for (int o = 32; o >= 1; o >>= 1) s += __shfl_xor(s, o);
      const float mu = s * (1.f / 1024.f); float q = 0.f;
#pragma unroll
      for (int j = 0; j < 4; ++j) { v[j] -= mu; q += v[j][0] * v[j][0] + v[j][1] * v[j][1] + v[j][2] * v[j][2] + v[j][3] * v[j][3]; }
#pragma unroll
      for (int o = 32; o >= 1; o >>= 1) q += __shfl_xor(q, o);
      const float rs = rsqrtf(q * (1.f / 1024.f) + 1e-5f);
      bf16_t* dst = (bf16_t*)(p.ws + O_MEMN) + (size_t)row * 1024;
#pragma unroll
      for (int j = 0; j < 4; ++j) {
        const int c = 4 * lane + 256 * j;
        const f32x4 g = *(const f32x4*)(p.mem_g + c), b = *(const f32x4*)(p.mem_b + c);
        *(u32x2*)(dst + c) = pk4(v[j][0] * rs * g[0] + b[0], v[j][1] * rs * g[1] + b[1], v[j][2] * rs * g[2] + b[2], v[j][3] * rs * g[3] + b[3]);
      }
      continue;
    }
    i -= N_MEMN;
    {
      float* bp = (float*)(p.ws + O_BIASP);
      if (tid < 128) {
        const int n = i * 128 + tid;
        const int sc = inmap(n);
        for (int l = 0; l < 2; ++l) bp[l * NP + n] = sc >= 0 ? p.b_in[l * DIN + sc] : 0.f;
      }
    }
  }
}

template <int BK, class AL>
DI void gemm_kloop_t(const AL& al, const bf16_t* __restrict__ Bt, int ldb, int nkt, int m0, int n0, f32x16 (&acc)[2][2], bf16_t* As, bf16_t* Bs) {
  constexpr int CPR = BK / 8, NCH = BK / 16, PITCH = BK + 8, BUF = 128 * PITCH;
  const int tid = otid(), lane = tid & 63, wave = tid >> 6, wr = wave >> 1, wc = wave & 1, r = lane & 31, h = lane >> 5;
  bf16x8 ra[NCH], rb[NCH];
  auto gload = [&](int kt) {
#pragma unroll
    for (int i = 0; i < NCH; ++i) {
      const int cid = tid + 256 * i, row = cid / CPR, kc = (cid % CPR) * 8;
      ra[i] = al(m0 + row, kt * BK + kc);
      rb[i] = *(const bf16x8*)(Bt + (size_t)(n0 + row) * ldb + kt * BK + kc);
    }
  };
  auto lstore = [&](int buf) {
#pragma unroll
    for (int i = 0; i < NCH; ++i) {
      const int cid = tid + 256 * i, row = cid / CPR, kc = (cid % CPR) * 8;
      *(bf16x8*)(As + buf * BUF + row * PITCH + kc) = ra[i];
      *(bf16x8*)(Bs + buf * BUF + row * PITCH + kc) = rb[i];
    }
  };
  gload(0); lstore(0); sub_sync();
  for (int kt = 0; kt < nkt; ++kt) {
    const int buf = kt & 1;
    if (kt + 1 < nkt) gload(kt + 1);
    asm volatile("" ::: "memory");
    const bf16_t* a_ = As + buf * BUF + (wr * 64 + r) * PITCH + 8 * h;
    const bf16_t* b_ = Bs + buf * BUF + (wc * 64 + r) * PITCH + 8 * h;
#pragma unroll
    for (int s = 0; s < BK / 16; ++s) {
      bf16x8 af[2], bfr[2];
      af[0] = *(const bf16x8*)(a_ + 16 * s); af[1] = *(const bf16x8*)(a_ + 32 * PITCH + 16 * s);
      bfr[0] = *(const bf16x8*)(b_ + 16 * s); bfr[1] = *(const bf16x8*)(b_ + 32 * PITCH + 16 * s);
#pragma unroll
      for (int mi = 0; mi < 2; ++mi)
#pragma unroll
        for (int ni = 0; ni < 2; ++ni) acc[mi][ni] = MFMA32(bfr[ni], af[mi], acc[mi][ni]);
    }
    if (kt + 1 < nkt) lstore(buf ^ 1);
    sub_sync();
  }
}
template <class AL>
DI void gemm_kloop(const AL& al, const bf16_t* __restrict__ Bt, int ldb, int nkt, int m0, int n0, f32x16 (&acc)[2][2], bf16_t* As, bf16_t* Bs) {
  gemm_kloop_t<64>(al, Bt, ldb, nkt, m0, n0, acc, As, Bs);
}

DI void zero_acc(f32x16 (&acc)[2][2]) {
#pragma unroll
  for (int a = 0; a < 2; ++a)
#pragma unroll
    for (int b = 0; b < 2; ++b)
#pragma unroll
      for (int i = 0; i < 16; ++i) acc[a][b][i] = 0.f;
}

DI int vfrag_key(int key) { const int kk = key & 31; return (key >> 5) * 2048 + (kk >> 4) * 512 + ((kk >> 2) & 1) * 256 + ((kk >> 3) & 1) * 4 + (kk & 3); }
DI int vfrag_col(int cw) { const int d = cw & 63; return (cw >> 6) * 524288 + (d >> 5) * 1024 + (d & 31) * 8; }

DI int kfrag_key(int key) { return (key >> 5) * 2048 + (key & 31) * 8; }
DI int kfrag_col(int cw) { const int d = cw & 63; return (cw >> 6) * 524288 + (d >> 4) * 512 + ((d >> 3) & 1) * 256 + (d & 7); }

struct PlainA {
  const bf16_t* A; int lda;
  DI bf16x8 operator()(int row, int k) const { return *(const bf16x8*)(A + (size_t)row * lda + k); }
};

DI void p1_tile(const Params& p, int layer, int half, int mt, int nt, unsigned char* smem) {
  sub_sync();
  bf16_t* As = (bf16_t*)smem; bf16_t* Bs = As + 2 * 9216;
  f32x16 acc[2][2]; zero_acc(acc);
  PlainA al{(const bf16_t*)(p.ws + O_XB) + (size_t)half * TH * 1024, 1024};
  const int m0 = mt * 128, n0 = nt * 128;
  gemm_kloop(al, (const bf16_t*)(p.ws + O_WTIN + layer * SZ_WTIN1), 1024, 16, m0, n0, acc, As, Bs);
  const int tid = otid(), lane = tid & 63, wave = tid >> 6, wr = wave >> 1, wc = wave & 1, r = lane & 31, h = lane >> 5;
  const float* bias = (const float*)(p.ws + O_BIASP) + layer * NP;
  unsigned char* ws = p.ws;
  {
    const int nb0 = n0 + wc * 64;
    bf16_t* dst0 = nullptr; int pitch0 = 0, coff0 = 0, xf0 = 0;
    if (nb0 < 384) { dst0 = (bf16_t*)(ws + O_QKA); pitch0 = 384; coff0 = nb0; }
    else if (nb0 >= C_BQK && nb0 < 2304) { dst0 = (bf16_t*)(ws + O_QKB); pitch0 = 1152; coff0 = nb0 - C_BQK; }
    else if (nb0 >= C_CQK && nb0 < 4224) { dst0 = (bf16_t*)(ws + O_QKC); pitch0 = 384; coff0 = nb0 - C_CQK; }
    else if (nb0 >= C_D && nb0 < C_E) { dst0 = (bf16_t*)(ws + O_QKVD); pitch0 = 1152; coff0 = nb0 - C_D; }
    else if (nb0 >= C_E && nb0 < C_SM) { dst0 = (bf16_t*)(ws + O_QE); pitch0 = 384; coff0 = nb0 - C_E; }
    else if (nb0 >= C_Z && nb0 < C_MG) { dst0 = (bf16_t*)(ws + O_SZ); pitch0 = 1920; coff0 = nb0 - C_Z; xf0 = 1; }
    else if (nb0 >= C_MG) { dst0 = (bf16_t*)(ws + O_SIG); pitch0 = 5120; coff0 = nb0 - C_MG; xf0 = 2; }
    if (dst0 != nullptr) {
      bf16_t* stg = (bf16_t*)smem + wave * (64 * 72);
#pragma unroll
      for (int ni = 0; ni < 2; ++ni)
#pragma unroll
        for (int mi = 0; mi < 2; ++mi)
#pragma unroll
          for (int g = 0; g < 4; ++g) {
            const int cq = ni * 32 + 8 * g + 4 * h;
            const f32x4 bv = *(const f32x4*)(bias + nb0 + cq);
            float v[4];
#pragma unroll
            for (int e = 0; e < 4; ++e) v[e] = acc[mi][ni][4 * g + e] + bv[e];
            if (xf0 == 1) {
#pragma unroll
              for (int e = 0; e < 4; ++e) v[e] = fsilu(v[e]);
            } else if (xf0 == 2) {
#pragma unroll
              for (int e = 0; e < 4; ++e) v[e] = fsigmoid(v[e]);
            }
            *(u32x2*)(stg + (mi * 32 + r) * 72 + cq) = pk4(v[0], v[1], v[2], v[3]);
          }
      asm volatile("s_waitcnt lgkmcnt(0)" ::: "memory");
      __builtin_amdgcn_wave_barrier();
      const int tok0 = m0 + wr * 64;
#pragma unroll
      for (int it = 0; it < 8; ++it) {
        const int row = it * 8 + (lane >> 3), ch = (lane & 7) * 8;
        const bf16x8 val = *(const bf16x8*)(stg + row * 72 + ch);
        *(bf16x8*)(dst0 + (size_t)(tok0 + row) * pitch0 + coff0 + ch) = val;
      }
      return;
    }
  }
#pragma unroll
  for (int ni = 0; ni < 2; ++ni) {
    const int nb = n0 + wc * 64 + ni * 32;
    int kind;
    int xf = 0;
    bf16_t* dst = nullptr; int pitch = 0, coff = 0;
    int kgrp = 0;
    if (nb < 384) { kind = 0; dst = (bf16_t*)(ws + O_QKA); pitch = 384; coff = nb; }
    else if (nb < C_AV) { kind = 5; dst = (bf16_t*)(ws + O_KFA); coff = nb - 384; }
    else if (nb < C_BQK) { kind = 1; dst = (bf16_t*)(ws + O_VTA); coff = nb - C_AV; }
    else if (nb < 2304) { kind = 0; dst = (bf16_t*)(ws + O_QKB); pitch = 1152; coff = nb - C_BQK; }
    else if (nb < C_BV) { kind = 5; kgrp = (nb - 2304) / 384; dst = (bf16_t*)(ws + O_KFB + kgrp * SZ_VT); coff = (nb - 2304) - kgrp * 384; }
    else if (nb < C_CQK) { kind = 2; dst = (bf16_t*)(ws + O_VTB); coff = nb - C_BV; }
    else if (nb < 4224) { kind = 0; dst = (bf16_t*)(ws + O_QKC); pitch = 384; coff = nb - C_CQK; }
    else if (nb < C_CV) { kind = 5; dst = (bf16_t*)(ws + O_KFC); coff = nb - 4224; }
    else if (nb < C_D) { kind = 1; dst = (bf16_t*)(ws + O_VTC); coff = nb - C_CV; }
    else if (nb < C_E) { kind = 0; dst = (bf16_t*)(ws + O_QKVD); pitch = 1152; coff = nb - C_D; }
    else if (nb < C_SM) { kind = 0; dst = (bf16_t*)(ws + O_QE); pitch = 384; coff = nb - C_E; }
    else if (nb < C_Z) { kind = (nb == C_SM) ? 3 : 4; }
    else if (nb < C_MG) { kind = 0; xf = 1; dst = (bf16_t*)(ws + O_SZ); pitch = 1920; coff = nb - C_Z; }
    else { kind = 0; xf = 2; dst = (bf16_t*)(ws + O_SIG); pitch = 5120; coff = nb - C_MG; }
    if (kind == 4) continue;
#pragma unroll
    for (int mi = 0; mi < 2; ++mi) {
      const int tok = m0 + wr * 64 + mi * 32 + r;
#pragma unroll
      for (int g = 0; g < 4; ++g) {
        const int cq = 8 * g + 4 * h;
        const f32x4 bv = *(const f32x4*)(bias + nb + cq);
        float v[4];
#pragma unroll
        for (int e = 0; e < 4; ++e) v[e] = acc[mi][ni][4 * g + e] + bv[e];
        if (kind == 0) {
          if (xf == 1) {
#pragma unroll
            for (int e = 0; e < 4; ++e) v[e] = fsilu(v[e]);
          } else if (xf == 2) {
#pragma unroll
            for (int e = 0; e < 4; ++e) v[e] = fsigmoid(v[e]);
          }
          *(u32x2*)(dst + (size_t)tok * pitch + coff + cq) = pk4(v[0], v[1], v[2], v[3]);
        } else if (kind == 5) {
          const int key = kgrp == 0 ? tok : kgrp == 1 ? (tok & 3) * 2048 + (tok >> 2) : (tok & 15) * 512 + (tok >> 4);
          *(u32x2*)(dst + kfrag_col(coff + cq) + kfrag_key(key)) = pk4(v[0], v[1], v[2], v[3]);
        } else if (kind == 1) {
          const int ko = vfrag_key(tok);
#pragma unroll
          for (int e = 0; e < 4; ++e) dst[vfrag_col(coff + cq + e) + ko] = f2bf(v[e]);
        } else if (kind == 2) {
          const int k1 = vfrag_key(tok), k4 = vfrag_key((tok & 3) * 2048 + (tok >> 2)), k16 = vfrag_key((tok & 15) * 512 + (tok >> 4));
#pragma unroll
          for (int e = 0; e < 4; ++e) {
            const bf16_t b = f2bf(v[e]); const int co = vfrag_col(coff + cq + e);
            dst[co + k1] = b; dst[SZ_VT / 2 + co + k4] = b; dst[SZ_VT + co + k16] = b;
          }
        } else {
          float* sm = (float*)(ws + O_SM);
#pragma unroll
          for (int e = 0; e < 4; ++e) if (cq + e < 18) sm[tok * 32 + cq + e] = v[e];
        }
      }
    }
  }
}


DI int g_lds_byte(int r, int c) { const int st = (r >> 4) * 2 + (c >> 5), ob = (r & 15) * 64 + (c & 31) * 2; return st * 1024 + (ob ^ (((ob >> 9) & 1) << 5)); }
DI void g_stage_rc(int b, int& R, int& C) { const int st = b >> 10, sb = b & 1023, swz = sb ^ (((sb >> 9) & 1) << 5); R = (st >> 1) * 16 + (swz >> 6); C = (st & 1) * 32 + ((swz & 63) >> 1); }

DI void p1_unit(const Params& p, int layer, int half, int pm, int pn, int pm_next, int pn_next  , bool first, unsigned char* lds) {
  const int tid = rtid(), wid = tid >> 6, lane = tid & 63, wr = wid >> 2, wc = wid & 3, fr = lane & 15, fq = lane >> 4;
  const bf16_t* Ab = (const bf16_t*)(p.ws + O_XB) + ((size_t)half * TH + (size_t)pm * 256) * 1024;
  const bf16_t* Bb = (const bf16_t*)(p.ws + O_WTIN + layer * SZ_WTIN1) + (size_t)pn * 256 * 1024;
  int sOff[4];
#pragma unroll
  for (int i = 0; i < 4; ++i) { int R, C; g_stage_rc(wid * 1024 + i * 8192 + lane * 16, R, C); sOff[i] = R * 1024 + C; }
  auto stage2 = [&](const bf16_t* A_, const bf16_t* B_, int buf, int kt) {
#pragma unroll
    for (int i = 0; i < 4; ++i) {
      __builtin_amdgcn_global_load_lds((const unsigned*)(A_ + sOff[i] + kt * 64), (unsigned*)(lds + buf * 65536 + wid * 1024 + i * 8192), 16, 0, 0);
      __builtin_amdgcn_global_load_lds((const unsigned*)(B_ + sOff[i] + kt * 64), (unsigned*)(lds + buf * 65536 + 32768 + wid * 1024 + i * 8192), 16, 0, 0);
    }
  };
  auto stage = [&](int buf, int kt) { stage2(Ab, Bb, buf, kt); };
  f32x4 acc[8][4];
#pragma unroll
  for (int m = 0; m < 8; ++m)
#pragma unroll
    for (int n = 0; n < 4; ++n) acc[m][n] = (f32x4){0.f, 0.f, 0.f, 0.f};
  const int lane_off = (fr * 64 + fq * 16) ^ ((fr >> 3) << 5);
  if (first) { __syncthreads(); stage(0, 0); }
  asm volatile("s_waitcnt vmcnt(0)" ::: "memory");
  __syncthreads();
#pragma unroll 1
  for (int t = 0; t < 16; ++t) {
    const int cur = t & 1;
    {
      const bool last = (t + 1 == 16);
      if (!last || pn_next >= 0) {
        const long dA = last ? (long)(pm_next - pm) * 256 * 1024 - 0 : (long)(t + 1) * 64;
        const long dB = last ? (long)(pn_next - pn) * 256 * 1024 - 0 : (long)(t + 1) * 64;
#pragma unroll
        for (int i = 0; i < 4; ++i) {
          __builtin_amdgcn_global_load_lds((const unsigned*)(Ab + sOff[i] + dA), (unsigned*)(lds + (cur ^ 1) * 65536 + wid * 1024 + i * 8192), 16, 0, 0);
          __builtin_amdgcn_global_load_lds((const unsigned*)(Bb + sOff[i] + dB), (unsigned*)(lds + (cur ^ 1) * 65536 + 32768 + wid * 1024 + i * 8192), 16, 0, 0);
        }
      }
    }
    const unsigned char* SA = lds + cur * 65536 + wr * 16384 + lane_off;
    const unsigned char* SB = lds + cur * 65536 + 32768 + wc * 8192 + lane_off;
    bf16x8 Bf[2][4], At[2][2];
#pragma unroll
    for (int n = 0; n < 4; ++n) Bf[0][n] = *(const bf16x8*)(SB + n * 2048);
#pragma unroll
    for (int m = 0; m < 2; ++m) At[0][m] = *(const bf16x8*)(SA + m * 2048);
#pragma unroll
    for (int g = 0; g < 8; ++g) {
      const int ks = g >> 2, pr = g & 3;
      if (g == 1) {
#pragma unroll
        for (int n = 0; n < 4; ++n) Bf[1][n] = *(const bf16x8*)(SB + n * 2048 + 1024);
      }
      if (g < 7) {
        const int g1 = g + 1;
#pragma unroll
        for (int m = 0; m < 2; ++m) At[g1 & 1][m] = *(const bf16x8*)(SA + ((g1 & 3) * 2 + m) * 2048 + (g1 >> 2) * 1024);
      }
      asm volatile("" : "+v"(acc[pr * 2][0][0]) :: "memory");
#pragma unroll
      for (int m = 0; m < 2; ++m)
#pragma unroll
        for (int n = 0; n < 4; ++n) acc[pr * 2 + m][n] = MFMA16(Bf[ks][n], At[g & 1][m], acc[pr * 2 + m][n]);
    }
    asm volatile("s_waitcnt vmcnt(0)" ::: "memory");
    __syncthreads();
  }
  const int nb0 = pn * 256 + wc * 64, tok0 = pm * 256 + wr * 128;
  const float* bias = (const float*)(p.ws + O_BIASP) + layer * NP;
  unsigned char* ws = p.ws;
  int kind, xf = 0, kgrp = 0, pitch = 0, coff = 0; bf16_t* dst = nullptr;
  if (nb0 < 384) { kind = 0; dst = (bf16_t*)(ws + O_QKA); pitch = 384; coff = nb0; }
  else if (nb0 < C_AV) { kind = 5; dst = (bf16_t*)(ws + O_KFA); coff = nb0 - 384; }
  else if (nb0 < C_BQK) { kind = 1; dst = (bf16_t*)(ws + O_VTA); coff = nb0 - C_AV; }
  else if (nb0 < 2304) { kind = 0; dst = (bf16_t*)(ws + O_QKB); pitch = 1152; coff = nb0 - C_BQK; }
  else if (nb0 < C_BV) { kind = 5; kgrp = (nb0 - 2304) / 384; dst = (bf16_t*)(ws + O_KFB + kgrp * SZ_VT); coff = (nb0 - 2304) - kgrp * 384; }
  else if (nb0 < C_CQK) { kind = 2; dst = (bf16_t*)(ws + O_VTB); coff = nb0 - C_BV; }
  else if (nb0 < 4224) { kind = 0; dst = (bf16_t*)(ws + O_QKC); pitch = 384; coff = nb0 - C_CQK; }
  else if (nb0 < C_CV) { kind = 5; dst = (bf16_t*)(ws + O_KFC); coff = nb0 - 4224; }
  else if (nb0 < C_D) { kind = 1; dst = (bf16_t*)(ws + O_VTC); coff = nb0 - C_CV; }
  else if (nb0 < C_E) { kind = 0; dst = (bf16_t*)(ws + O_QKVD); pitch = 1152; coff = nb0 - C_D; }
  else if (nb0 < C_SM) { kind = 0; dst = (bf16_t*)(ws + O_QE); pitch = 384; coff = nb0 - C_E; }
  else if (nb0 < C_Z) { kind = (nb0 == C_SM) ? 3 : 4; }
  else if (nb0 < C_MG) { kind = 0; xf = 1; dst = (bf16_t*)(ws + O_SZ); pitch = 1920; coff = nb0 - C_Z; }
  else if (nb0 < 13696) { kind = 0; xf = 2; dst = (bf16_t*)(ws + O_SIG); pitch = 5120; coff = nb0 - C_MG; }
  else { kind = 4; }
  if (kind == 4) return;
  if (kind == 0) {
    bf16_t* stg = (bf16_t*)(lds + 65536 + wid * 9216);
#pragma unroll
    for (int mh = 0; mh < 2; ++mh) {
#pragma unroll
      for (int m = 0; m < 4; ++m)
#pragma unroll
        for (int n = 0; n < 4; ++n) {
          const int c4 = n * 16 + fq * 4;
          const f32x4 bv = *(const f32x4*)(bias + nb0 + c4);
          float v[4];
#pragma unroll
          for (int e = 0; e < 4; ++e) v[e] = acc[mh * 4 + m][n][e] + bv[e];
          if (xf == 1) {
#pragma unroll
            for (int e = 0; e < 4; ++e) v[e] = fsilu(v[e]);
          } else if (xf == 2) {
#pragma unroll
            for (int e = 0; e < 4; ++e) v[e] = fsigmoid(v[e]);
          }
          *(u32x2*)(stg + (m * 16 + fr) * 72 + c4) = pk4(v[0], v[1], v[2], v[3]);
        }
      asm volatile("s_waitcnt lgkmcnt(0)" ::: "memory");
      __builtin_amdgcn_wave_barrier();
#pragma unroll
      for (int it = 0; it < 8; ++it) {
        const int row = it * 8 + (lane >> 3), ch = (lane & 7) * 8;
        const bf16x8 val = *(const bf16x8*)(stg + row * 72 + ch);
        *(bf16x8*)(dst + (size_t)(tok0 + mh * 64 + row) * pitch + coff + ch) = val;
      }
      asm volatile("s_waitcnt lgkmcnt(0)" ::: "memory");
      __builtin_amdgcn_wave_barrier();
    }
    return;
  }
#pragma unroll
  for (int m = 0; m < 8; ++m) {
    const int tok = tok0 + m * 16 + fr;
#pragma unroll
    for (int n = 0; n < 4; ++n) {
      const int c4 = n * 16 + fq * 4;
      const f32x4 bv = *(const f32x4*)(bias + nb0 + c4);
      float v[4];
#pragma unroll
      for (int e = 0; e < 4; ++e) v[e] = acc[m][n][e] + bv[e];
      if (kind == 5) {
        const int key = kgrp == 0 ? tok : kgrp == 1 ? (tok & 3) * 2048 + (tok >> 2) : (tok & 15) * 512 + (tok >> 4);
        *(u32x2*)(dst + kfrag_col(coff + c4) + kfrag_key(key)) = pk4(v[0], v[1], v[2], v[3]);
      } else if (kind == 1) {
        const int ko = vfrag_key(tok);
#pragma unroll
        for (int e = 0; e < 4; ++e) dst[vfrag_col(coff + c4 + e) + ko] = f2bf(v[e]);
      } else if (kind == 2) {
        const int k1 = vfrag_key(tok), k4 = vfrag_key((tok & 3) * 2048 + (tok >> 2)), k16 = vfrag_key((tok & 15) * 512 + (tok >> 4));
#pragma unroll
        for (int e = 0; e < 4; ++e) {
          const bf16_t b = f2bf(v[e]); const int co = vfrag_col(coff + c4 + e);
          dst[co + k1] = b; dst[SZ_VT / 2 + co + k4] = b; dst[SZ_VT + co + k16] = b;
        }
      } else {
        float* sm = (float*)(ws + O_SM);
#pragma unroll
        for (int e = 0; e < 4; ++e) if (c4 + e < 18) sm[tok * 32 + c4 + e] = v[e];
      }
    }
  }
}

DI void fox_prep(const Params& p, int hh, unsigned char* smem) {
  float* red = (float*)smem;
  const int tid = otid(), lane = tid & 63, wave = tid >> 6;
  const float* sm = (const float*)(p.ws + O_SM);
  float* FF = (float*)(p.ws + O_FF) + hh * TH;
  float loc[32];
#pragma unroll
  for (int j = 0; j < 32; ++j) loc[j] = sm[(tid * 32 + j) * 32 + hh];
  float s = 0.f;
#pragma unroll
  for (int j = 0; j < 32; ++j) { const float xv = loc[j]; s += fminf(xv, 0.f) - log1pf(expf(-fabsf(xv))); loc[j] = s; }
  float inc = s;
#pragma unroll
  for (int o = 1; o < 64; o <<= 1) { const float t = __shfl_up(inc, o); if (lane >= o) inc += t; }
  if (lane == 63) red[wave] = inc;
  sub_sync();
  float off = inc - s;
  for (int w = 0; w < wave; ++w) off += red[w];
#pragma unroll
  for (int j4 = 0; j4 < 8; ++j4) {
    f32x4 o4 = {off + loc[4 * j4], off + loc[4 * j4 + 1], off + loc[4 * j4 + 2], off + loc[4 * j4 + 3]};
    *(f32x4*)(FF + tid * 32 + 4 * j4) = o4;
  }
  sub_sync();
}

DI void kmean_prep(const Params& p, int idx, unsigned* kmaxu) {
  const int lane = otid() & 63;
  const int hh = idx / 32, blk = idx % 32;
  const bf16_t* k = (const bf16_t*)(p.ws + O_KFA) + kfrag_col(hh * 64 + lane) + blk * 8 * 2048;
  float s = 0.f;
#pragma unroll 8
  for (int i = 0; i < 256; ++i) s += bf2f(k[(i >> 5) * 2048 + (i & 31) * 8]);
  s *= (1.f / 256.f);
  const bf16_t hi = f2bf(s);
  bf16_t* km = (bf16_t*)(p.ws + O_KM);
  km[(hh * 32 + blk) * 64 + lane] = hi;
  km[6 * 32 * 64 + (hh * 32 + blk) * 64 + lane] = f2bf(s - bf2f(hi));
  const bf16_t* kc = (const bf16_t*)(p.ws + O_KFC) + (size_t)hh * 524288;
  float mx = 0.f;
#pragma unroll
  for (int t = 0; t < 4; ++t) {
    const int key = blk * 256 + lane * 4 + t;
    float kk = 0.f;
#pragma unroll
    for (int c = 0; c < 8; ++c) { float v[8]; unpk8(*(const bf16x8*)(kc + kfrag_key(key) + c * 256), v);
#pragma unroll
      for (int e = 0; e < 8; ++e) kk += v[e] * v[e]; }
    mx = fmaxf(mx, kk);
  }
#pragma unroll
  for (int o = 32; o >= 1; o >>= 1) mx = fmaxf(mx, __shfl_xor(mx, o));
  if (lane == 0) atomicMax(kmaxu + hh, __float_as_uint(mx));
}

DI void memkv_tile(const Params& p, int layer, int half, int mt, int nt, unsigned char* smem) {
  bf16_t* As = (bf16_t*)smem; bf16_t* Bs = As + 2 * 9216;
  f32x16 acc[2][2]; zero_acc(acc);
  PlainA al{(const bf16_t*)(p.ws + O_MEMN) + (size_t)half * 256 * 1024, 1024};
  const int m0 = mt * 128, n0 = nt * 128;
  gemm_kloop(al, (const bf16_t*)(p.ws + O_WTKV + layer * SZ_WTKV1), 1024, 16, m0, n0, acc, As, Bs);
  const int tid = otid(), lane = tid & 63, wave = tid >> 6, wr = wave >> 1, wc = wave & 1, r = lane & 31, h = lane >> 5;
  bf16_t* mk = (bf16_t*)(p.ws + O_MEMK); bf16_t* mv = (bf16_t*)(p.ws + O_MEMVT);
#pragma unroll
  for (int ni = 0; ni < 2; ++ni)
#pragma unroll
    for (int mi = 0; mi < 2; ++mi) {
      const int m = m0 + wr * 64 + mi * 32 + r;
#pragma unroll
      for (int i = 0; i < 16; ++i) {
        const int col = n0 + wc * 64 + ni * 32 + crow(i, h);
        const bf16_t b = f2bf(acc[mi][ni][i]);
        if (col < 384) { const int hd = col / 96, d = col % 96; mk[(size_t)((half * 4 + hd) * 8 + (m >> 5)) * 3072 + (d >> 4) * 512 + ((d >> 3) & 1) * 256 + (m & 31) * 8 + (d & 7)] = b; }
        else { const int cc = col - 384, hd = cc / 96, d = cc % 96, kk = m & 31;
          mv[(size_t)((half * 4 + hd) * 8 + (m >> 5)) * 3072 + (d >> 5) * 1024 + (kk >> 4) * 512 + ((kk >> 2) & 1) * 256 + (d & 31) * 8 + ((kk >> 3) & 1) * 4 + (kk & 3)] = b; }
      }
    }
}

DI f32x16 mm_quad(const bf16_t* A, const bf16_t* B, int wr, int wc, int r, int h) {
  f32x16 acc;
#pragma unroll
  for (int i = 0; i < 16; ++i) acc[i] = 0.f;
  const bf16_t* a_ = A + (wr * 32 + r) * 72 + 8 * h;
  const bf16_t* b_ = B + (wc * 32 + r) * 72 + 8 * h;
#pragma unroll
  for (int s = 0; s < 4; ++s) acc = MFMA32(*(const bf16x8*)(a_ + 16 * s), *(const bf16x8*)(b_ + 16 * s), acc);
  return acc;
}

DI void gdn_prep(const Params& p, int layer, int half, int hh, int c, unsigned char* smem) {
  bf16_t* QN = (bf16_t*)smem; bf16_t* KN = QN + 4608; bf16_t* KB = KN + 4608; bf16_t* KDT = KB + 4608; bf16_t* VBT = KDT + 4608;
  bf16_t* KBET = VBT + 4608; bf16_t* QKm = KBET + 4608; bf16_t* Tm = QKm + 4608;
  float* gcv = (float*)(smem + 73728); float* betav = gcv + 64; float* egc = gcv + 128;
  float* Mf = (float*)(smem + 9216);
  bf16_t* UT = KN; bf16_t* WT = KB;
  int tid = otid();
  int lane = tid & 63, wave = tid >> 6, wr = wave >> 1, wc = wave & 1, r = lane & 31, h = lane >> 5;
#define REOPAQUE() do { asm volatile("" : "+v"(tid)); lane = tid & 63; wave = tid >> 6; wr = wave >> 1; wc = wave & 1; r = lane & 31; h = lane >> 5; } while (0)
  const float* sm = (const float*)(p.ws + O_SM);
  if (wave == 0) {
    const int tok = c * 64 + lane;
    const float bt = fsigmoid(sm[tok * 32 + 6 + hh]);
    const float xv = sm[tok * 32 + 12 + hh] + p.dt_bias[layer * 6 + hh];
    const float sp = fmaxf(xv, 0.f) + log1pf(expf(-fabsf(xv)));
    float g = -expf(p.a_log[layer * 6 + hh]) * sp;
#pragma unroll
    for (int o = 1; o < 64; o <<= 1) { const float t = __shfl_up(g, o); if (lane >= o) g += t; }
    gcv[lane] = g; betav[lane] = bt; egc[lane] = expf(g);
    if (lane == 63) ((float*)(p.ws + O_GL))[hh * 128 + c] = expf(g);
  }
  sub_sync();
  REOPAQUE();
  {
    const int t = tid >> 2, cg4 = tid & 3, ch0 = cg4 * 16;
    const bf16_t* src = (const bf16_t*)(p.ws + O_QKVD);
    const float* cw = p.conv_w + (size_t)layer * 4 * 1152;
    const float bt = betav[t], gct = gcv[t], eg = egc[t], ed = expf(gcv[63] - gct);
    auto convpart = [&](int pt, float (&val)[16]) {
      const int col = pt * 384 + hh * 64 + ch0;
#pragma unroll
      for (int e = 0; e < 16; ++e) val[e] = 0.f;
#pragma unroll
      for (int j = 0; j < 4; ++j) {
        const int row = c * 64 + t - 3 + j;
        if (row >= 0) {
          float xv[16];
          unpk8(*(const bf16x8*)(src + (size_t)row * 1152 + col), xv);
          unpk8(*(const bf16x8*)(src + (size_t)row * 1152 + col + 8), xv + 8);
#pragma unroll
          for (int e4 = 0; e4 < 4; ++e4) {
            const f32x4 w4 = *(const f32x4*)(cw + j * 1152 + col + 4 * e4);
#pragma unroll
            for (int e = 0; e < 4; ++e) val[4 * e4 + e] += w4[e] * xv[4 * e4 + e];
          }
        }
      }
#pragma unroll
      for (int e = 0; e < 16; ++e) val[e] = fsilu(val[e]);
    };
    {
      float val[16]; convpart(0, val);
      float sq = 0.f;
#pragma unroll
      for (int e = 0; e < 16; ++e) sq += val[e] * val[e];
      sq += __shfl_xor(sq, 1); sq += __shfl_xor(sq, 2);
      const float rq = rsqrtf(sq + 1e-6f) * 0.125f;
#pragma unroll
      for (int e = 0; e < 16; ++e) val[e] *= rq;
      *(bf16x8*)(QN + t * 72 + ch0) = pk8(val); *(bf16x8*)(QN + t * 72 + ch0 + 8) = pk8(val + 8);
    }
    asm volatile("" ::: "memory");
    {
      float val[16]; convpart(1, val);
      float sk = 0.f;
#pragma unroll
      for (int e = 0; e < 16; ++e) sk += val[e] * val[e];
      sk += __shfl_xor(sk, 1); sk += __shfl_xor(sk, 2);
      const float rk = rsqrtf(sk + 1e-6f);
      float kb[16];
#pragma unroll
      for (int e = 0; e < 16; ++e) { val[e] *= rk; kb[e] = val[e] * bt; }
      *(bf16x8*)(KN + t * 72 + ch0) = pk8(val); *(bf16x8*)(KN + t * 72 + ch0 + 8) = pk8(val + 8);
      *(bf16x8*)(KB + t * 72 + ch0) = pk8(kb); *(bf16x8*)(KB + t * 72 + ch0 + 8) = pk8(kb + 8);
#pragma unroll
      for (int e = 0; e < 16; ++e) {
        KDT[(ch0 + e) * 72 + t] = f2bf(val[e] * ed);
        KBET[(ch0 + e) * 72 + t] = f2bf(kb[e] * eg);
      }
    }
    asm volatile("" ::: "memory");
    {
      float val[16]; convpart(2, val);
#pragma unroll
      for (int e = 0; e < 16; ++e) VBT[(ch0 + e) * 72 + t] = f2bf(val[e] * bt);
    }
  }
  sub_sync();
  REOPAQUE();
  {
    const f32x16 kk = mm_quad(KB, KN, wr, wc, r, h);
    const f32x16 qk = mm_quad(QN, KN, wr, wc, r, h);
    sub_sync();
    const int j = wc * 32 + r; const float gj = gcv[j];
#pragma unroll
    for (int i = 0; i < 16; ++i) {
      const int row = wr * 32 + crow(i, h);
      const float dec = (row >= j) ? expf(gcv[row] - gj) : 0.f;
      Mf[row * 68 + j] = (row > j) ? kk[i] * dec : 0.f;
      QKm[row * 72 + j] = f2bf(qk[i] * dec);
    }
  }
  sub_sync();
  REOPAQUE();
  if (wave == 0) {
    float t[64];
#pragma unroll
    for (int i = 0; i < 64; ++i) {
      float a4[4] = {(i == lane) ? 1.f : 0.f, 0.f, 0.f, 0.f};
#pragma unroll
      for (int j4 = 0; j4 < (i + 3) / 4; ++j4) {
        const f32x4 mrow = *(const f32x4*)(Mf + i * 68 + 4 * j4);
#pragma unroll
        for (int e = 0; e < 4; ++e) if (4 * j4 + e < i) a4[e] -= mrow[e] * t[4 * j4 + e];
      }
      const float a = (a4[0] + a4[1]) + (a4[2] + a4[3]);
      t[i] = a;
      Tm[i * 72 + lane] = f2bf(a);
      asm volatile("" ::: "memory");
    }
  }
  sub_sync();
  REOPAQUE();
  {
    const f32x16 u = mm_quad(Tm, VBT, wr, wc, r, h);
    const f32x16 w = mm_quad(Tm, KBET, wr, wc, r, h);
    const int col = wc * 32 + r;
#pragma unroll
    for (int g = 0; g < 4; ++g) {
      const int i0 = wr * 32 + 8 * g + 4 * h;
      *(u32x2*)(UT + col * 72 + i0) = pk4(u[4 * g], u[4 * g + 1], u[4 * g + 2], u[4 * g + 3]);
      *(u32x2*)(WT + col * 72 + i0) = pk4(w[4 * g], w[4 * g + 1], w[4 * g + 2], w[4 * g + 3]);
    }
  }
  sub_sync();
  REOPAQUE();
  {
    bf16_t* base = (bf16_t*)(p.ws + O_DPREP + (size_t)(hh * 128 + c) * 32768);
    const int n = wc * 32 + r;
    {
      const int ks = n >> 5, jh = (n >> 4) & 1, q = (n >> 2) & 3, jl = n & 3, jj = 4 * jh + jl;
      const int cbase = (ks * 64 + 16 * q) * 8 + jj;
      {
        const f32x16 P = mm_quad(KDT, WT, wr, wc, r, h);
#pragma unroll
        for (int i = 0; i < 16; ++i) {
          const int m = wr * 32 + crow(i, h);
          base[((m >> 4) * 128 + (m & 15)) * 8 + cbase] = f2bf(P[i]);
        }
      }
      asm volatile("" ::: "memory");
      {
        const f32x16 QW = mm_quad(QKm, WT, wr, wc, r, h);
#pragma unroll
        for (int i = 0; i < 16; ++i) {
          const int m = wr * 32 + crow(i, h);
          const float qd = bf2f(QN[m * 72 + n]) * egc[m];
          base[4096 + ((m >> 4) * 128 + (m & 15)) * 8 + cbase] = f2bf(qd - QW[i]);
        }
      }
      asm volatile("" ::: "memory");
    }
    const int jsl = n >> 4;
    {
      const f32x16 Bc = mm_quad(KDT, UT, wr, wc, r, h);
#pragma unroll
      for (int g = 0; g < 4; ++g) {
        const int row0 = wr * 32 + 8 * g + 4 * h;
        const int rt = row0 >> 4, lp = 16 * ((row0 >> 2) & 3) + (n & 15);
        *(u32x2*)(base + 8192 + ((jsl * 4 + rt) * 64 + lp) * 4) = pk4(Bc[4 * g], Bc[4 * g + 1], Bc[4 * g + 2], Bc[4 * g + 3]);
      }
    }
    asm volatile("" ::: "memory");
    {
      const f32x16 O0 = mm_quad(QKm, UT, wr, wc, r, h);
#pragma unroll
      for (int g = 0; g < 4; ++g) {
        const int row0 = wr * 32 + 8 * g + 4 * h;
        const int rt = row0 >> 4, lp = 16 * ((row0 >> 2) & 3) + (n & 15);
        *(u32x2*)(base + 12288 + ((jsl * 4 + rt) * 64 + lp) * 4) = pk4(O0[4 * g], O0[4 * g + 1], O0[4 * g + 2], O0[4 * g + 3]);
      }
    }
  }
  sub_sync();
#undef REOPAQUE
}

struct TileDesc { const bf16_t* k; const bf16_t* v; const float* aux; int tag; };

template <int DHT, bool AUX>
struct TileRegs { bf16x8 k[DHT / 16]; bf16x8 v[DHT / 32][2]; f32x4 a[4]; };

template <int DHT, bool AUX>
DI void load_tile(const bf16_t* kp, const bf16_t* vp, const float* ap, long ldv, TileRegs<DHT, AUX>& t) {
#pragma unroll
  for (int s = 0; s < DHT / 16; ++s) t.k[s] = *(const bf16x8*)(kp + 512 * s);
#pragma unroll
  for (int dt = 0; dt < DHT / 32; ++dt)
#pragma unroll
    for (int s = 0; s < 2; ++s) t.v[dt][s] = *(const bf16x8*)(vp + (dt * 2 + s) * 512);
  if (AUX) {
#pragma unroll
    for (int g = 0; g < 4; ++g) t.a[g] = *(const f32x4*)(ap + 8 * g);
  }
}

template <int DHT, bool AUX, class TF, class MF, class SF>
DI void attn_loop(int maxtiles, TF&& tf, MF&& mf, SF&& stopf, const bf16x8 (&qf)[DHT / 16], long ldv, float scale2,
                  f32x16 (&o)[DHT / 32], float& m, float& l) {
  TileRegs<DHT, AUX> cur, nxt;
  int tagc, tagn;
  bf16x8 qf0 = qf[0];
  { const bf16_t* kp; const bf16_t* vp; const float* ap = nullptr; tagc = tf(0, kp, vp, ap); load_tile<DHT, AUX>(kp, vp, ap, ldv, cur); }
#pragma unroll 1
  for (int t = 0; t < maxtiles; ++t) {
    { const bf16_t* kp; const bf16_t* vp; const float* ap = nullptr; tagn = tf(t + 1, kp, vp, ap); load_tile<DHT, AUX>(kp, vp, ap, ldv, nxt); }
    { bf16x8 q0 = qf[0]; asm volatile("" : "+v"(q0) :: "memory"); qf0 = q0; }
    f32x16 sacc;
#pragma unroll
    for (int i = 0; i < 16; ++i) sacc[i] = 0.f;
#pragma unroll
    for (int s = 0; s < DHT / 16; ++s) sacc = MFMA32(cur.k[s], s == 0 ? qf0 : qf[s], sacc);
    float sv[16]; float mx = NEG_INF;
#pragma unroll
    for (int i = 0; i < 16; ++i) { sv[i] = sacc[i] * scale2 + mf(tagc, i, AUX ? cur.a[i >> 2][i & 3] : 0.f); mx = fmaxf(mx, sv[i]); }
    mx = fmaxf(mx, __shfl_xor(mx, 32));
    const float mnew = fmaxf(m, mx);
    const float alpha = __builtin_amdgcn_exp2f(m - mnew);
    m = mnew;
    float pv[16]; float ps = 0.f;
#pragma unroll
    for (int i = 0; i < 16; ++i) { pv[i] = __builtin_amdgcn_exp2f(sv[i] - mnew); ps += pv[i]; }
    l = l * alpha + ps;
#pragma unroll
    for (int dt = 0; dt < DHT / 32; ++dt)
#pragma unroll
      for (int i = 0; i < 16; ++i) o[dt][i] *= alpha;
    bf16x8 pf[2]; pf[0] = pk8(pv); pf[1] = pk8(pv + 8);
#pragma unroll
    for (int dt = 0; dt < DHT / 32; ++dt)
#pragma unroll
      for (int s = 0; s < 2; ++s) {
        o[dt] = MFMA32(cur.v[dt][s], pf[s], o[dt]);
      }
    if (stopf(t, m, AUX ? cur.a[0][0] : 0.f)) break;
    cur = nxt; tagc = tagn;
  }
}

template <int DHT>
DI void attn_store(const f32x16 (&o)[DHT / 32], float l, bf16_t* dstrow, int h, float& ltot_out, bool valid = true) {
  const float ltot = l + __shfl_xor(l, 32);
  ltot_out = ltot;
  const float inv = ltot > 0.f ? 1.f / ltot : 0.f;
  if (valid)
#pragma unroll
  for (int dt = 0; dt < DHT / 32; ++dt)
#pragma unroll
    for (int g = 0; g < 4; ++g)
      *(u32x2*)(dstrow + dt * 32 + 8 * g + 4 * h) = pk4(o[dt][4 * g] * inv, o[dt][4 * g + 1] * inv, o[dt][4 * g + 2] * inv, o[dt][4 * g + 3] * inv);
}

template <int DHT>
DI void attn_store_gated(const f32x16 (&o)[DHT / 32], float l, bf16_t* szrow, int h) {
  const float ltot = l + __shfl_xor(l, 32);
  const float inv = ltot > 0.f ? 1.f / ltot : 0.f;
#pragma unroll
  for (int dt = 0; dt < DHT / 32; ++dt)
#pragma unroll
    for (int g = 0; g < 4; ++g) {
      bf16_t* q = szrow + dt * 32 + 8 * g + 4 * h;
      const u32x2 z = *(const u32x2*)q;
      *(u32x2*)q = pk4(o[dt][4 * g] * inv * bflo(z.x), o[dt][4 * g + 1] * inv * bfhi(z.x), o[dt][4 * g + 2] * inv * bflo(z.y), o[dt][4 * g + 3] * inv * bfhi(z.y));
    }
}

template <int N>
DI void zero_o(f32x16 (&o)[N]) {
#pragma unroll
  for (int a = 0; a < N; ++a)
#pragma unroll
    for (int i = 0; i < 16; ++i) o[a][i] = 0.f;
}

DI void top3_insert(float v, int n, float& v0, float& v1, float& v2, int& i0, int& i1, int& i2) {
  const bool g0 = v > v0, g1 = v > v1, g2 = v > v2;
  v2 = g1 ? v1 : (g2 ? v : v2); i2 = g1 ? i1 : (g2 ? n : i2);
  v1 = g0 ? v0 : (g1 ? v : v1); i1 = g0 ? i0 : (g1 ? n : i1);
  v0 = g0 ? v : v0;             i0 = g0 ? n : i0;
}

DI void moba_select(const Params& p, int a) {
  const int lane = otid() & 63, r = lane & 31, h = lane >> 5;
  const int qtile = a / 6, hh = a % 6, qb = qtile >> 3;
  unsigned mask = 0;
  if (qb > 0) {
    const bf16_t* qrow = (const bf16_t*)(p.ws + O_QKA) + (size_t)(qtile * 32 + r) * 384 + hh * 64 + 8 * h;
    bf16x8 qf[4];
#pragma unroll
    for (int s = 0; s < 4; ++s) qf[s] = *(const bf16x8*)(qrow + 16 * s);
    const bf16_t* kmh = (const bf16_t*)(p.ws + O_KM) + (hh * 32 + r) * 64 + 8 * h;
    const bf16_t* kml = kmh + 6 * 32 * 64;
    f32x16 g;
#pragma unroll
    for (int i = 0; i < 16; ++i) g[i] = 0.f;
#pragma unroll
    for (int s = 0; s < 4; ++s) { g = MFMA32(*(const bf16x8*)(kmh + 16 * s), qf[s], g); g = MFMA32(*(const bf16x8*)(kml + 16 * s), qf[s], g); }
    float v0 = NEG_INF, v1 = NEG_INF, v2 = NEG_INF; int i0 = -1, i1 = -1, i2 = -1;
#pragma unroll
    for (int i = 0; i < 16; ++i) { const int n = crow(i, h); if (n < qb) top3_insert(g[i], n, v0, v1, v2, i0, i1, i2); }
    const float pv0 = __shfl_xor(v0, 32), pv1 = __shfl_xor(v1, 32), pv2 = __shfl_xor(v2, 32);
    const int pi0 = __shfl_xor(i0, 32), pi1 = __shfl_xor(i1, 32), pi2 = __shfl_xor(i2, 32);
    if (pi0 >= 0) top3_insert(pv0, pi0, v0, v1, v2, i0, i1, i2);
    if (pi1 >= 0) top3_insert(pv1, pi1, v0, v1, v2, i0, i1, i2);
    if (pi2 >= 0) top3_insert(pv2, pi2, v0, v1, v2, i0, i1, i2);
    if (i0 >= 0) mask |= 1u << i0;
    if (i1 >= 0) mask |= 1u << i1;
    if (i2 >= 0) mask |= 1u << i2;
  }
  if (h == 0) ((unsigned*)(p.ws + O_MASK))[(qtile * 32 + r) * 8 + hh] = mask;
}

DI void moba_gather(const Params& p, int a, unsigned char* smem) {
  const int tid = otid(), lane = tid & 63, wave = tid >> 6, r = lane & 31, h = lane >> 5;
  const int part = a & 1, a2 = a >> 1;
  const int hh = a2 % 6, idx = a2 / 6;
  int qb = 1;
  while ((qb + 1) * qb / 2 <= idx) ++qb;
  const int n = idx - qb * (qb - 1) / 2;
  const unsigned* MASK = (const unsigned*)(p.ws + O_MASK);
  unsigned* list = (unsigned*)(smem + wave * 1024);
  int cnt = 0;
#pragma unroll
  for (int j = 0; j < 4; ++j) {
    const int qi = j * 64 + lane;
    const unsigned mk = MASK[(qb * 256 + qi) * 8 + hh];
    const bool pred = (mk >> n) & 1u;
    const unsigned long long ball = __ballot(pred);
    const int pos = cnt + __builtin_popcountll(ball & ((1ull << lane) - 1ull));
    if (pred) list[pos] = (unsigned)qi | ((unsigned)__builtin_popcount(mk & ((1u << n) - 1u)) << 8);
    cnt += __builtin_popcountll(ball);
  }
  cnt = __builtin_amdgcn_readfirstlane(cnt);
  if (cnt == 0) return;
  asm volatile("s_waitcnt lgkmcnt(0)" ::: "memory");
  __builtin_amdgcn_wave_barrier();
  const bf16_t* QK = (const bf16_t*)(p.ws + O_QKA);
  const bf16_t* KF = (const bf16_t*)(p.ws + O_KFA) + (size_t)hh * 524288 + (size_t)n * 8 * 2048 + lane * 8;
  const bf16_t* VT = (const bf16_t*)(p.ws + O_VTA) + (size_t)hh * 524288 + (size_t)n * 8 * 2048 + lane * 8;
  const int nch = (cnt + 31) >> 5;
#pragma unroll 1
  for (int c = part; c < nch; c += 2) {
    const int e = c * 32 + r;
    const bool valid = e < cnt;
    const unsigned ent = list[valid ? e : 0];
    const int tok = qb * 256 + (int)(ent & 255u), slot = (int)(ent >> 8);
    bf16x8 qf[4];
    { const bf16_t* qrow = QK + (size_t)tok * 384 + hh * 64 + 8 * h;
#pragma unroll
      for (int s = 0; s < 4; ++s) qf[s] = *(const bf16x8*)(qrow + 16 * s); }
    auto tf = [&](int t, const bf16_t*& kp, const bf16_t*& vp, const float*&) -> int {
      const int tt = t < 7 ? t : 7;
      kp = KF + tt * 2048; vp = VT + tt * 2048;
      return 0;
    };
    auto mf = [&](int, int, float) -> float { return 0.f; };
    auto sf = [&](int, float, float) { return false; };
    f32x16 o[2]; zero_o(o); float m = -1e30f, l = 0.f;
    int nt8 = 8; asm volatile("" : "+s"(nt8));
    attn_loop<64, false>(nt8, tf, mf, sf, qf, (long)TH, 0.125f * LOG2E, o, m, l);
    float lt;
    attn_store<64>(o, l, (bf16_t*)(p.ws + O_OA + slot * SZ_O) + (size_t)tok * 384 + hh * 64, h, lt, valid);
    if (valid && h == 0) { float* st = (float*)(p.ws + O_STA) + ((size_t)(slot * TH + tok) * 6 + hh) * 2; st[0] = m; st[1] = lt; }
  }
}

DI void moba_own(const Params& p, int a) {
  const int lane = otid() & 63, r = lane & 31, h = lane >> 5;
  const int qtile = 255 - a / 6, hh = a % 6, qb = qtile >> 3, own = qtile & 7;
  const bf16_t* QK = (const bf16_t*)(p.ws + O_QKA);
  const bf16_t* KF = (const bf16_t*)(p.ws + O_KFA) + (size_t)hh * 524288 + (size_t)qb * 8 * 2048 + lane * 8;
  const bf16_t* VT = (const bf16_t*)(p.ws + O_VTA) + (size_t)hh * 524288 + (size_t)qb * 8 * 2048 + lane * 8;
  const int tok = qtile * 32 + r;
  bf16x8 qf[4];
  { const bf16_t* qrow = QK + (size_t)tok * 384 + hh * 64 + 8 * h;
#pragma unroll
    for (int s = 0; s < 4; ++s) qf[s] = *(const bf16x8*)(qrow + 16 * s); }
  auto tf = [&](int t, const bf16_t*& kp, const bf16_t*& vp, const float*&) -> int {
    const int kk = t < own ? t : own;
    kp = KF + kk * 2048; vp = VT + kk * 2048;
    return (kk == own) ? 101 : 100;
  };
  auto mf = [&](int tag, int i, float) -> float {
    if (tag == 100) return 0.f;
    return (crow(i, h) <= r) ? 0.f : NEG_INF;
  };
  auto sf = [&](int, float, float) { return false; };
  f32x16 o[2]; zero_o(o); float m = -1e30f, l = 0.f;
  attn_loop<64, false>(own + 1, tf, mf, sf, qf, (long)TH, 0.125f * LOG2E, o, m, l);
  float lt;
  attn_store<64>(o, l, (bf16_t*)(p.ws + O_OA + 3 * SZ_O) + (size_t)tok * 384 + hh * 64, h, lt);
  if (h == 0) {
    float* st = (float*)(p.ws + O_STA);
    st[((size_t)(3 * TH + tok) * 6 + hh) * 2] = m; st[((size_t)(3 * TH + tok) * 6 + hh) * 2 + 1] = lt;
    const int np = __builtin_popcount(((const unsigned*)(p.ws + O_MASK))[tok * 8 + hh]);
    for (int sl = np; sl < 3; ++sl) { st[((size_t)(sl * TH + tok) * 6 + hh) * 2] = -1e30f; st[((size_t)(sl * TH + tok) * 6 + hh) * 2 + 1] = 0.f; }
  }
}

DI void fox_item(const Params& p, int c, const unsigned* kmaxu) {
  const int lane = otid() & 63, r = lane & 31, h = lane >> 5;
  const int qtile = 255 - c / 6, hh = c % 6;
  const bf16_t* QK = (const bf16_t*)(p.ws + O_QKC);
  const bf16_t* KF = (const bf16_t*)(p.ws + O_KFC);
  const bf16_t* VT = (const bf16_t*)(p.ws + O_VTC);
  const float* FF = (const float*)(p.ws + O_FF) + hh * TH;
  bf16x8 qf[4]; float qn2 = 0.f;
  { const bf16_t* qrow = QK + (size_t)(qtile * 32 + r) * 384 + hh * 64 + 8 * h;
#pragma unroll
    for (int s = 0; s < 4; ++s) { qf[s] = *(const bf16x8*)(qrow + 16 * s); float v[8]; unpk8(qf[s], v);
#pragma unroll
      for (int e = 0; e < 8; ++e) qn2 += v[e] * v[e]; } }
  qn2 += __shfl_xor(qn2, 32);
#pragma unroll
  for (int o = 16; o >= 1; o >>= 1) qn2 = fmaxf(qn2, __shfl_xor(qn2, o));
  const float Fq = FF[qtile * 32 + r];
  const float Ffirst = FF[qtile * 32];
  const float kmaxn = sqrtf(__uint_as_float(kmaxu[hh]));
  const float bound = sqrtf(qn2) * kmaxn * 0.125f + Ffirst;
  auto tf = [&](int t, const bf16_t*& kp, const bf16_t*& vp, const float*& ap) -> int {
    const int keybase = (qtile - t > 0 ? qtile - t : 0) * 32;
    kp = KF + (size_t)hh * 524288 + (keybase >> 5) * 2048 + lane * 8;
    vp = VT + (size_t)hh * 524288 + (keybase >> 5) * 2048 + lane * 8;
    ap = FF + keybase + 4 * h;
    return (t == 0) ? 1 : 0;
  };
  auto mf = [&](int tag, int i, float fk) -> float {
    const float b = (Fq - fk) * LOG2E;
    return (tag == 1 && crow(i, h) > r) ? NEG_INF : b;
  };
  auto sf = [&](int, float m, float a0) {
    const float fkb = __builtin_bit_cast(float, __builtin_amdgcn_readfirstlane(__builtin_bit_cast(int, a0)));
    float mm = m;
#pragma unroll
    for (int o = 16; o >= 1; o >>= 1) mm = fminf(mm, __shfl_xor(mm, o));
    return (bound - fkb) * LOG2E < mm - 45.f;
  };
  f32x16 o[2]; zero_o(o); float m = -1e30f, l = 0.f;
  attn_loop<64, true>(qtile + 1, tf, mf, sf, qf, (long)TH, 0.125f * LOG2E, o, m, l);
  float lt;
  attn_store_gated<64>(o, l, (bf16_t*)(p.ws + O_SZ) + (size_t)(qtile * 32 + r) * 1920 + 2 * 384 + hh * 64, h);
}

DI void dil_item(const Params& p, int idx) {
  const int lane = otid() & 63, r = lane & 31, h = lane >> 5;
  const int g = idx / 1536, rem = idx % 1536, hh = rem / 256, w = rem % 256;
  const int dsh = 2 * g;
  const int dil = 1 << dsh, L = TH >> dsh, tps = L / 32;
  const int rs = w / tps, lt_ = w % tps, l0 = lt_ * 32;
  const bf16_t* QK = (const bf16_t*)(p.ws + O_QKB);
  const bf16_t* KF = (const bf16_t*)(p.ws + O_KFB + g * SZ_VT);
  const bf16_t* VT = (const bf16_t*)(p.ws + O_VTB + g * SZ_VT);
  const int tq = (l0 + r) * dil + rs;
  bf16x8 qf[4];
  { const bf16_t* qrow = QK + (size_t)tq * 1152 + g * 384 + hh * 64 + 8 * h;
#pragma unroll
    for (int s = 0; s < 4; ++s) qf[s] = *(const bf16x8*)(qrow + 16 * s); }
  const int t0 = (l0 >= 128) ? 0 : (128 - l0) / 32;
  auto tf = [&](int tt, const bf16_t*& kp, const bf16_t*& vp, const float*&) -> int {
    const int t = (t0 + tt < 4) ? t0 + tt : 4; const int keybase = l0 - 128 + 32 * t;
    kp = KF + (size_t)hh * 524288 + ((rs * L + keybase) >> 5) * 2048 + lane * 8;
    vp = VT + (size_t)hh * 524288 + ((rs * L + keybase) >> 5) * 2048 + lane * 8;
    return t;
  };
  auto mf = [&](int tag, int i, float) -> float {
    const int kj = crow(i, h);
    if (tag == 0) return (kj >= r) ? 0.f : NEG_INF;
    if (tag == 4) return (kj <= r) ? 0.f : NEG_INF;
    return 0.f;
  };
  auto sf = [&](int, float, float) { return false; };
  f32x16 o[2]; zero_o(o); float m = -1e30f, l = 0.f;
  attn_loop<64, false>(5 - t0, tf, mf, sf, qf, (long)TH, 0.125f * LOG2E, o, m, l);
  float lt;
  attn_store<64>(o, l, (bf16_t*)(p.ws + O_OB + g * SZ_O) + (size_t)tq * 384 + hh * 64, h, lt);
  if (h == 0) { float* st = (float*)(p.ws + O_STB) + ((size_t)(g * TH + tq) * 6 + hh) * 2; st[0] = m; st[1] = lt; }
}

DI void mem_item(const Params& p, int half, int e) {
  const int lane = otid() & 63, r = lane & 31, h = lane >> 5;
  const int hd = e & 3, qtile = e >> 2;
  const bf16_t* QE = (const bf16_t*)(p.ws + O_QE);
  const bf16_t* MK = (const bf16_t*)(p.ws + O_MEMK);
  const bf16_t* MV = (const bf16_t*)(p.ws + O_MEMVT);
  bf16x8 qf[6];
  { const bf16_t* qrow = QE + (size_t)(qtile * 32 + r) * 384 + hd * 96 + 8 * h;
#pragma unroll
    for (int s = 0; s < 6; ++s) qf[s] = *(const bf16x8*)(qrow + 16 * s); }
  auto tf = [&](int t, const bf16_t*& kp, const bf16_t*& vp, const float*&) -> int {
    const int keybase = 32 * (t < 7 ? t : 7);
    kp = MK + (size_t)((half * 4 + hd) * 8 + (keybase >> 5)) * 3072 + lane * 8;
    vp = MV + (size_t)((half * 4 + hd) * 8 + (keybase >> 5)) * 3072 + lane * 8;
    return 0;
  };
  auto mf = [&](int, int, float) -> float { return 0.f; };
  auto sf = [&](int, float, float) { return false; };
  f32x16 o[3]; zero_o(o); float m = -1e30f, l = 0.f;
  attn_loop<96, false>(8, tf, mf, sf, qf, 256L, 0.10206207261596577f * LOG2E, o, m, l);
  float lt;
  attn_store_gated<96>(o, l, (bf16_t*)(p.ws + O_SZ) + (size_t)(qtile * 32 + r) * 1920 + 4 * 384 + hd * 96, h);
}

DI float dpp_ror(float v, int ctrl);
DI float row16_sum(float v) {
  v += __builtin_bit_cast(float, __builtin_amdgcn_update_dpp(0, __builtin_bit_cast(int, v), 0x128, 0xf, 0xf, false));
  v += __builtin_bit_cast(float, __builtin_amdgcn_update_dpp(0, __builtin_bit_cast(int, v), 0x124, 0xf, 0xf, false));
  v += __builtin_bit_cast(float, __builtin_amdgcn_update_dpp(0, __builtin_bit_cast(int, v), 0x122, 0xf, 0xf, false));
  v += __builtin_bit_cast(float, __builtin_amdgcn_update_dpp(0, __builtin_bit_cast(int, v), 0x121, 0xf, 0xf, false));
  return v;
}

struct ScanRegs { bf16x8 pf[4][2]; bf16x8 qe[4][2]; s16x4 bc[4]; s16x4 o0[4]; float gl; };
DI void scan_load(const Params& p, int hh, int j, int c, int lane, ScanRegs& s) {
  const unsigned char* base = p.ws + O_DPREP + (size_t)(hh * 128 + c) * 32768;
#pragma unroll
  for (int mt = 0; mt < 4; ++mt)
#pragma unroll
    for (int ks = 0; ks < 2; ++ks) {
      s.pf[mt][ks] = *(const bf16x8*)(base + ((mt * 2 + ks) * 64 + lane) * 16);
      s.qe[mt][ks] = *(const bf16x8*)(base + 8192 + ((mt * 2 + ks) * 64 + lane) * 16);
    }
#pragma unroll
  for (int rt = 0; rt < 4; ++rt) {
    s.bc[rt] = *(const s16x4*)(base + 16384 + ((j * 4 + rt) * 64 + lane) * 8);
    s.o0[rt] = *(const s16x4*)(base + 24576 + ((j * 4 + rt) * 64 + lane) * 8);
  }
  s.gl = ((const float*)(p.ws + O_GL))[hh * 128 + c];
}
DI f32x4 s4f(s16x4 v) { u32x2 u = __builtin_bit_cast(u32x2, v); f32x4 r; r[0] = bflo(u.x); r[1] = bfhi(u.x); r[2] = bflo(u.y); r[3] = bfhi(u.y); return r; }

DI void scan_item(const Params& p, int it) {
  const int lane = otid() & 63, q = lane >> 4, cl = lane & 15;
  const int hh = it >> 2, j = it & 3;
  f32x4 S[4];
#pragma unroll
  for (int rt = 0; rt < 4; ++rt) S[rt] = (f32x4){0.f, 0.f, 0.f, 0.f};
  bf16_t* OD = (bf16_t*)(p.ws + O_OD);
  float* SSQ = (float*)(p.ws + O_SSQ);
#ifndef SCAN_PREFETCH
#define SCAN_PREFETCH 1
#endif
  ScanRegs cur, nxt;
  if (SCAN_PREFETCH) scan_load(p, hh, j, 0, lane, cur);
  for (int c = 0; c < 128; ++c) {
    if (SCAN_PREFETCH) {
      scan_load(p, hh, j, (c + 1 < 128) ? c + 1 : c, lane, nxt);
      asm volatile("" : "+v"(S[0][0]) :: "memory");
    } else {
      scan_load(p, hh, j, c, lane, cur);
    }
    bf16x8 bfr[2];
#pragma unroll
    for (int ks = 0; ks < 2; ++ks) {
      u32x4 u; u.x = pk2(S[2 * ks][0], S[2 * ks][1]); u.y = pk2(S[2 * ks][2], S[2 * ks][3]); u.z = pk2(S[2 * ks + 1][0], S[2 * ks + 1][1]); u.w = pk2(S[2 * ks + 1][2], S[2 * ks + 1][3]);
      bfr[ks] = __builtin_bit_cast(bf16x8, u);
    }
    f32x4 aP[4], aO[4];
#pragma unroll
    for (int rt = 0; rt < 4; ++rt) {
      aP[rt] = (f32x4){0.f, 0.f, 0.f, 0.f};
      aO[rt] = s4f(cur.o0[rt]);
#pragma unroll
      for (int ks = 0; ks < 2; ++ks) { aP[rt] = MFMA16(cur.pf[rt][ks], bfr[ks], aP[rt]); aO[rt] = MFMA16(cur.qe[rt][ks], bfr[ks], aO[rt]); }
    }
#pragma unroll
    for (int rt = 0; rt < 4; ++rt) S[rt] = S[rt] * cur.gl - aP[rt] + s4f(cur.bc[rt]);
#pragma unroll
    for (int rt = 0; rt < 4; ++rt)
#pragma unroll
      for (int e = 0; e < 4; ++e) {
        const int tok = c * 64 + 16 * rt + 4 * q + e;
        const float v = aO[rt][e];
        OD[(size_t)tok * 384 + hh * 64 + 16 * j + cl] = f2bf(v);
        const float ss = row16_sum(v * v);
        if (cl == 0) SSQ[(tok * 6 + hh) * 4 + j] = ss;
      }
    if (SCAN_PREFETCH) cur = nxt;
  }
}

DI void scan_block(const Params& p, int hh, unsigned char* smem) {
  const int tid = otid(), lane = tid & 63, j = tid >> 6, q = lane >> 4, cl = lane & 15;
  const unsigned char* src = p.ws + O_DPREP + (size_t)hh * 128 * 32768;
  bf16_t* ostg = (bf16_t*)(smem + 65536);
  bf16x8 R0[8], R1[8];
  auto gld = [&](int c, bf16x8 (&R)[8]) {
    c = c < 128 ? c : 127;
    const unsigned char* b = src + (size_t)c * 32768 + tid * 16;
#pragma unroll
    for (int i = 0; i < 8; ++i) R[i] = *(const bf16x8*)(b + i * 4096);
  };
  auto lst = [&](int buf, const bf16x8 (&R)[8]) {
    unsigned char* d = smem + buf * 32768 + tid * 16;
#pragma unroll
    for (int i = 0; i < 8; ++i) *(bf16x8*)(d + i * 4096) = R[i];
  };
  const float* GL = (const float*)(p.ws + O_GL) + hh * 128;
  const float gl_lo = GL[lane], gl_hi = GL[64 + lane];
  f32x4 S[4];
#pragma unroll
  for (int rt = 0; rt < 4; ++rt) S[rt] = (f32x4){0.f, 0.f, 0.f, 0.f};
  bf16_t* OD = (bf16_t*)(p.ws + O_OD);
  float* SSQ = (float*)(p.ws + O_SSQ);
  f32x4 aO[4];
  auto flush = [&](int cp) {
    const int row = tid >> 2, part = tid & 3;
    const bf16x8 v0 = *(const bf16x8*)(ostg + row * 72 + 16 * part), v1 = *(const bf16x8*)(ostg + row * 72 + 16 * part + 8);
    float f[16]; unpk8(v0, f); unpk8(v1, f + 8);
    float ss = 0.f;
#pragma unroll
    for (int e = 0; e < 16; ++e) ss += f[e] * f[e];
    const int tok = cp * 64 + row;
    bf16_t* dst = OD + (size_t)tok * 384 + hh * 64 + 16 * part;
    *(bf16x8*)dst = v0; *(bf16x8*)(dst + 8) = v1;
    SSQ[(tok * 6 + hh) * 4 + part] = ss;
  };
  auto compute = [&](int buf, int c) {
    const unsigned char* base = smem + buf * 32768;
    const float gl = __builtin_bit_cast(float, __builtin_amdgcn_readlane(__builtin_bit_cast(int, c < 64 ? gl_lo : gl_hi), c & 63));
    bf16x8 bfr[2];
#pragma unroll
    for (int ks = 0; ks < 2; ++ks) {
      u32x4 u; u.x = pk2(S[2 * ks][0], S[2 * ks][1]); u.y = pk2(S[2 * ks][2], S[2 * ks][3]); u.z = pk2(S[2 * ks + 1][0], S[2 * ks + 1][1]); u.w = pk2(S[2 * ks + 1][2], S[2 * ks + 1][3]);
      bfr[ks] = __builtin_bit_cast(bf16x8, u);
    }
    f32x4 aP[4];
#pragma unroll
    for (int rt = 0; rt < 4; ++rt) {
      aP[rt] = (f32x4){0.f, 0.f, 0.f, 0.f};
      aO[rt] = s4f(*(const s16x4*)(base + 24576 + ((j * 4 + rt) * 64 + lane) * 8));
#pragma unroll
      for (int ks = 0; ks < 2; ++ks) {
        aP[rt] = MFMA16(*(const bf16x8*)(base + ((rt * 2 + ks) * 64 + lane) * 16), bfr[ks], aP[rt]);
        aO[rt] = MFMA16(*(const bf16x8*)(base + 8192 + ((rt * 2 + ks) * 64 + lane) * 16), bfr[ks], aO[rt]);
      }
    }
#pragma unroll
    for (int rt = 0; rt < 4; ++rt) S[rt] = S[rt] * gl - aP[rt] + s4f(*(const s16x4*)(base + 16384 + ((j * 4 + rt) * 64 + lane) * 8));
  };
  auto stage_out = [&]() {
#pragma unroll
    for (int rt = 0; rt < 4; ++rt)
#pragma unroll
      for (int e = 0; e < 4; ++e) ostg[(16 * rt + 4 * q + e) * 72 + 16 * j + cl] = f2bf(aO[rt][e]);
  };
  __builtin_amdgcn_s_setprio(3);
  gld(0, R0); gld(1, R1);
  lst(0, R0); gld(2, R0);
  sub_sync();
#pragma unroll 1
  for (int c = 0; c < 128; c += 2) {
    lst(1, R1);
    gld(c + 3, R1);
    if (c > 0) flush(c - 1);
    compute(0, c);
    sub_sync();
    stage_out();
    sub_sync();
    lst(0, R0);
    gld(c + 4, R0);
    flush(c);
    compute(1, c + 1);
    sub_sync();
    stage_out();
    sub_sync();
  }
  flush(127);
  sub_sync();
  __builtin_amdgcn_s_setprio(0);
}

DI void phase3(const Params& p, int half, unsigned* ctr, const unsigned* kmaxu, unsigned char* smem, int sub, int limit = 1 << 30) {
  const int tid = otid(), wave = tid >> 6;
  const int hb = (int)blockIdx.x, x = hb & 7, bi = hb >> 3;
  if (hb < 3 && limit >= 0) { if (PH(5)) scan_block(p, hb * 2 + sub, smem); }
  if (bi >= 1 && limit != 0) {
    const int nlw = ((int)(gridDim.x >> 3) - 1) * 8, lw = ((bi - 1) * 2 + sub) * 4 + wave;
    if (x < 6) {
      const int hh = x;
      constexpr int NG = 992, NOWN = 256, NB_ = 640, NTOT = NG + NOWN + NB_;
      for (int pos0 = lw; pos0 < NTOT; pos0 += nlw) {
        int pos = __builtin_amdgcn_readfirstlane(pos0);
        if (pos < NG) { if (PH(6)) moba_gather(p, (((pos >> 1) * 6 + hh) << 1) | (pos & 1), smem); continue; }
        pos -= NG;
        if (pos < NOWN) { if (PH(6)) moba_own(p, pos * 6 + hh); continue; }
        pos -= NOWN;
        const int g = pos < 512 ? (pos >> 8) : 2, w = pos < 512 ? (pos & 255) : 2 * (pos - 512);
        if (PH(8)) dil_item(p, g * 1536 + hh * 256 + w);
      }
    } else {
      const int h0 = (x - 6) * 3;
      constexpr int NE = 512, NC = 768, NB2 = 384, NTOT = NE + NC + NB2;
      for (int pos0 = lw; pos0 < NTOT; pos0 += nlw) {
        int pos = __builtin_amdgcn_readfirstlane(pos0);
        if (pos < NE) { if (PH(7)) mem_item(p, half, (x - 6) * 512 + pos); continue; }
        pos -= NE;
        if (pos < NC) { if (PH(9)) fox_item(p, (pos & 255) * 6 + h0 + (pos >> 8), kmaxu); continue; }
        pos -= NC;
        if (PH(8)) dil_item(p, 2 * 1536 + (h0 + (pos >> 7)) * 256 + 2 * (pos & 127) + 1);
      }
    }
  }
}

DI void gbuild_chunk(const Params& p, int layer, int tok, int c8) {
  const unsigned char* ws = p.ws;
  const int n = c8 / 48, c = (c8 % 48) * 8;
  if (n == 2 || n == 4) return;
  bf16_t* szp = (bf16_t*)(p.ws + O_SZ) + (size_t)tok * 1920 + n * 384 + c;
  float o[8], z[8];
  unpk8(*(const bf16x8*)szp, z);
  if (n == 1) {
    const int hh = c >> 6;
    const float* st = (const float*)(ws + O_STB);
    float mg[3], lg[3];
#pragma unroll
    for (int g = 0; g < 3; ++g) { const f32x2 s2 = *(const f32x2*)(st + ((size_t)(g * TH + tok) * 6 + hh) * 2); mg[g] = s2[0]; lg[g] = s2[1]; }
    const float mm = fmaxf(mg[0], fmaxf(mg[1], mg[2]));
    float wg[3], ws_ = 0.f;
#pragma unroll
    for (int g = 0; g < 3; ++g) { wg[g] = exp2f(mg[g] - mm) * lg[g]; ws_ += wg[g]; }
    const float inv = 1.f / ws_;
#pragma unroll
    for (int e = 0; e < 8; ++e) o[e] = 0.f;
#pragma unroll
    for (int g = 0; g < 3; ++g) {
      float t[8]; unpk8(*(const bf16x8*)((const bf16_t*)(ws + O_OB + g * SZ_O) + (size_t)tok * 384 + c), t);
      const float wgi = wg[g] * inv;
#pragma unroll
      for (int e = 0; e < 8; ++e) o[e] += wgi * t[e];
    }
  } else if (n == 3) {
    const int hh = c >> 6;
    const f32x4 sq = *(const f32x4*)((const float*)(ws + O_SSQ) + ((size_t)tok * 6 + hh) * 4);
    const float rs = rsqrtf((sq[0] + sq[1] + sq[2] + sq[3]) * (1.f / 64.f) + 1e-6f);
    unpk8(*(const bf16x8*)((const bf16_t*)(ws + O_OD) + (size_t)tok * 384 + c), o);
    const float* gw = p.gdn_w + layer * 64 + (c & 63);
#pragma unroll
    for (int e = 0; e < 8; ++e) o[e] *= rs * gw[e];
  } else if (n == 0) {
    const int hh = c >> 6;
    const float* st = (const float*)(ws + O_STA);
    float mg[4], lg[4], mm = -1e30f;
#pragma unroll
    for (int g = 0; g < 4; ++g) { const f32x2 s2 = *(const f32x2*)(st + ((size_t)(g * TH + tok) * 6 + hh) * 2); mg[g] = s2[0]; lg[g] = s2[1]; mm = fmaxf(mm, mg[g]); }
    float wg[4], ws_ = 0.f;
#pragma unroll
    for (int g = 0; g < 4; ++g) { wg[g] = exp2f(mg[g] - mm) * lg[g]; ws_ += wg[g]; }
    const float inv = 1.f / ws_;
#pragma unroll
    for (int e = 0; e < 8; ++e) o[e] = 0.f;
#pragma unroll
    for (int g = 0; g < 4; ++g) {
      if (lg[g] > 0.f) {
        float t[8]; unpk8(*(const bf16x8*)((const bf16_t*)(ws + O_OA + g * SZ_O) + (size_t)tok * 384 + c), t);
        const float wgi = wg[g] * inv;
#pragma unroll
        for (int e = 0; e < 8; ++e) o[e] += wgi * t[e];
      }
    }
  } else {
    const size_t off = (n == 2) ? O_OC : O_OE;
    unpk8(*(const bf16x8*)((const bf16_t*)(ws + off) + (size_t)tok * 384 + c), o);
  }
#pragma unroll
  for (int e = 0; e < 8; ++e) o[e] *= z[e];
  *(bf16x8*)szp = pk8(o);
}

DI void p4a_tile(const Params& p, int layer, int mt, int nt, unsigned char* smem) {
  sub_sync();
  bf16_t* As = (bf16_t*)smem; bf16_t* Bs = As + 2 * 9216;
  const int tid = otid(), lane = tid & 63, wave = tid >> 6, wr = wave >> 1, wc = wave & 1, r = lane & 31, h = lane >> 5;
  const int m0 = mt * 128, n0 = nt * 128;
  f32x16 tot[2][2]; zero_acc(tot);
  const bf16_t* SIG = (const bf16_t*)(p.ws + O_SIG);
  for (int n = 0; n < 5; ++n) {
    f32x16 acc[2][2]; zero_acc(acc);
    PlainA al{(const bf16_t*)(p.ws + O_SZ) + n * 384, 1920};
    gemm_kloop_t<32>(al, (const bf16_t*)(p.ws + O_WTBR) + (size_t)(layer * 5 + n) * 1024 * 384, 384, 12, m0, n0, acc, As, Bs);
#pragma unroll
    for (int mi = 0; mi < 2; ++mi) {
      const int tok = m0 + wr * 64 + mi * 32 + r;
#pragma unroll
      for (int ni = 0; ni < 2; ++ni)
#pragma unroll
        for (int g = 0; g < 4; ++g) {
          const int col = n0 + wc * 64 + ni * 32 + 8 * g + 4 * h;
          const u32x2 sg = *(const u32x2*)(SIG + (size_t)tok * 5120 + n * 1024 + col);
          tot[mi][ni][4 * g] += bflo(sg.x) * acc[mi][ni][4 * g];
          tot[mi][ni][4 * g + 1] += bfhi(sg.x) * acc[mi][ni][4 * g + 1];
          tot[mi][ni][4 * g + 2] += bflo(sg.y) * acc[mi][ni][4 * g + 2];
          tot[mi][ni][4 * g + 3] += bfhi(sg.y) * acc[mi][ni][4 * g + 3];
          asm volatile("" ::: "memory");
        }
    }
  }
  bf16_t* YM = (bf16_t*)(p.ws + O_YM);
  {
    bf16_t* stg = (bf16_t*)smem + wave * (64 * 72);
#pragma unroll
    for (int ni = 0; ni < 2; ++ni)
#pragma unroll
      for (int mi = 0; mi < 2; ++mi)
#pragma unroll
        for (int g = 0; g < 4; ++g)
          *(u32x2*)(stg + (mi * 32 + r) * 72 + ni * 32 + 8 * g + 4 * h) = pk4(tot[mi][ni][4 * g], tot[mi][ni][4 * g + 1], tot[mi][ni][4 * g + 2], tot[mi][ni][4 * g + 3]);
    asm volatile("s_waitcnt lgkmcnt(0)" ::: "memory");
    __builtin_amdgcn_wave_barrier();
    const int tok0 = m0 + wr * 64, col0 = n0 + wc * 64;
#pragma unroll
    for (int it = 0; it < 8; ++it) {
      const int row = it * 8 + (lane >> 3), ch = (lane & 7) * 8;
      const bf16x8 val = *(const bf16x8*)(stg + row * 72 + ch);
      *(bf16x8*)(YM + (size_t)(tok0 + row) * 1024 + col0 + ch) = val;
    }
  }
}

DI void p4b_tile(const Params& p, int layer, int half, int mt, int nt, unsigned char* smem) {
  bf16_t* As = (bf16_t*)smem; bf16_t* Bs = As + 2 * 9216;
  const int tid = otid(), lane = tid & 63, wave = tid >> 6, wr = wave >> 1, wc = wave & 1, r = lane & 31, h = lane >> 5;
  const int m0 = mt * 128, n0 = nt * 128;
  f32x16 acc[2][2]; zero_acc(acc);
  PlainA al{(const bf16_t*)(p.ws + O_YM), 1024};
  gemm_kloop(al, (const bf16_t*)(p.ws + O_WTOUT + layer * SZ_WTOUT1), 1024, 16, m0, n0, acc, As, Bs);
  const float* xin = layer == 0 ? p.x : p.out;
  const float alpha = 1.4142135623730951f;
#pragma unroll
  for (int mi = 0; mi < 2; ++mi) {
    const size_t gt = (size_t)half * TH + m0 + wr * 64 + mi * 32 + r;
#pragma unroll
    for (int ni = 0; ni < 2; ++ni)
#pragma unroll
      for (int g = 0; g < 4; ++g) {
        const int col = n0 + wc * 64 + ni * 32 + 8 * g + 4 * h;
        const f32x4 xv = *(const f32x4*)(xin + gt * 1024 + col);
        f32x4 o;
#pragma unroll
        for (int e = 0; e < 4; ++e) o[e] = alpha * xv[e] + acc[mi][ni][4 * g + e];
        *(f32x4*)(p.out + gt * 1024 + col) = o;
      }
  }
}

DI void p4c_row(const Params& p, int layer, size_t gt, bool wxb = true) {
  const int lane = otid() & 63;
  float* row = p.out + gt * 1024;
  f32x4 v[4]; float s = 0.f;
#pragma unroll
  for (int j = 0; j < 4; ++j) { v[j] = *(const f32x4*)(row + 4 * lane + 256 * j); s += v[j][0] + v[j][1] + v[j][2] + v[j][3]; }
#pragma unroll
  for (int o = 32; o >= 1; o >>= 1) s += __shfl_xor(s, o);
  const float mu = s * (1.f / 1024.f); float q = 0.f;
#pragma unroll
  for (int j = 0; j < 4; ++j) { v[j] -= mu; q += v[j][0] * v[j][0] + v[j][1] * v[j][1] + v[j][2] * v[j][2] + v[j][3] * v[j][3]; }
#pragma unroll
  for (int o = 32; o >= 1; o >>= 1) q += __shfl_xor(q, o);
  const float rs = rsqrtf(q * (1.f / 1024.f) + 1e-5f);
  bf16_t* xb = (bf16_t*)(p.ws + O_XB) + gt * 1024;
#pragma unroll
  for (int j = 0; j < 4; ++j) {
    const int c = 4 * lane + 256 * j;
    const f32x4 g = *(const f32x4*)(p.ln_g + layer * 1024 + c), b = *(const f32x4*)(p.ln_b + layer * 1024 + c);
    f32x4 y;
#pragma unroll
    for (int e = 0; e < 4; ++e) y[e] = v[j][e] * rs * g[e] + b[e];
    *(f32x4*)(row + c) = y;
    if (wxb) *(u32x2*)(xb + c) = pk4(y[0], y[1], y[2], y[3]);
  }
}


#define XB_TMO      128
#define XB_XCNT(j)  (256  + 64 * (j))
#define XB_XSUB(j)  (1280 + 64 * (j))
#define XB_XGEN(j)  (2304 + 64 * (j))
#define XB_TOP      3328
#define XB_TOPGEN   3392
#define XB_SPIN_CAP (1u << 22)
#define LAS __attribute__((address_space(3)))
DI unsigned xb_ld(unsigned* p) { return __hip_atomic_load(p, __ATOMIC_RELAXED, __HIP_MEMORY_SCOPE_AGENT); }
DI unsigned xb_add(unsigned* p, unsigned v) { return __hip_atomic_fetch_add(p, v, __ATOMIC_RELAXED, __HIP_MEMORY_SCOPE_AGENT); }
DI unsigned xb_xcc_id() { return (unsigned)__builtin_amdgcn_s_getreg((3 << 11) | 20) & 0xFu; }
#define XB_SPIN(cond, bar) do { unsigned _sp = 0; while (cond) { __builtin_amdgcn_s_sleep(1); \
    if ((++_sp & 255u) == 0u) { if (xb_ld(&(bar)[XB_TMO])) break; if (_sp > XB_SPIN_CAP) { atomicAdd(&(bar)[XB_TMO], 1u); break; } } } } while (0)
struct XcdBarrier { unsigned* bar; unsigned x; volatile LAS unsigned* st; };
DI XcdBarrier xcd_barrier_post(unsigned* bar, volatile LAS unsigned* st) {
  XcdBarrier b; b.bar = bar; b.x = xb_xcc_id(); b.st = st;
  if (threadIdx.x == 0) (void)xb_add(&bar[XB_XCNT(b.x)], 1u);
  return b;
}
DI void xcd_barrier_complete(unsigned* bar, unsigned x, unsigned& nloc, unsigned& nx) {
  const unsigned G = gridDim.x;
  unsigned sum, cnt, mine, sp = 0u;
  for (;;) {
    sum = 0u; cnt = 0u; mine = 0u;
#pragma unroll
    for (unsigned j = 0; j < 16; ++j) { const unsigned c = xb_ld(&bar[XB_XCNT(j)]); sum += c; cnt += (c > 0u) ? 1u : 0u; mine = (j == x) ? c : mine; }
    if (sum == G) break;
    __builtin_amdgcn_s_sleep(1);
    if ((++sp & 255u) == 0u) { if (xb_ld(&bar[XB_TMO])) break; if (sp > XB_SPIN_CAP) { atomicAdd(&bar[XB_TMO], 1u); break; } }
  }
  nloc = mine > 0u ? mine : 1u; nx = cnt > 0u ? cnt : 1u;
}
DI void xcd_barrier(const XcdBarrier& b) {
  asm volatile("s_waitcnt vmcnt(0)" ::: "memory");
  __syncthreads();
  if (threadIdx.x == 0) {
    unsigned* bar = b.bar;
    __builtin_amdgcn_s_waitcnt(0);
    unsigned nloc = b.st[0], nx = b.st[1];
    if (nloc == 0u) { xcd_barrier_complete(bar, b.x, nloc, nx); b.st[0] = nloc; b.st[1] = nx; }
    const unsigned old = xb_add(&bar[XB_XSUB(b.x)], 1u);
    const unsigned gen = old / nloc;
    if (old + 1u == (gen + 1u) * nloc) {
      __builtin_amdgcn_fence(__ATOMIC_RELEASE, "agent");
      asm volatile("s_waitcnt vmcnt(0)" ::: "memory");
      const unsigned og = xb_add(&bar[XB_TOP], 1u);
      const unsigned tg = og / nx;
      if (og + 1u == (tg + 1u) * nx) xb_add(&bar[XB_TOPGEN], 1u);
      else XB_SPIN(xb_ld(&bar[XB_TOPGEN]) == tg, bar);
      __builtin_amdgcn_fence(__ATOMIC_ACQUIRE, "agent");
      xb_add(&bar[XB_XGEN(b.x)], 1u);
      asm volatile("s_waitcnt vmcnt(0)" ::: "memory");
    } else {
      XB_SPIN(xb_ld(&bar[XB_XGEN(b.x)]) == gen, bar);
      __builtin_amdgcn_fence(__ATOMIC_ACQUIRE, "agent");
      asm volatile("s_waitcnt vmcnt(0)" ::: "memory");
    }
  }
  __syncthreads();
}

#ifdef PROBE_A
#define STAMP(k) do { if (blockIdx.x == 0 && otid() == 0) { unsigned long long now_ = __builtin_amdgcn_s_memrealtime(); tsacc[k] += (float)(now_ - tlast) * 0.01f; tlast = now_; } } while (0)
#else
#define STAMP(k) do {} while (0)
#endif
__global__ void __launch_bounds__(512, 2) mega(Params p) {
  extern __shared__ __attribute__((aligned(16))) unsigned char smem_all[];
  cg::grid_group grid = cg::this_grid();
  if (p.ws == nullptr) grid.sync();
  volatile LAS unsigned* xbst = (volatile LAS unsigned*)(smem_all + 2 * SUB_LDS);
  if (threadIdx.x < 4) xbst[threadIdx.x] = 0u;
  __syncthreads();
  const XcdBarrier xb = xcd_barrier_post((unsigned*)(p.ws + O_BAR), xbst);
#define GSYNC() xcd_barrier(xb)
  const int sub = __builtin_amdgcn_readfirstlane(__builtin_amdgcn_workitem_id_x() >> 8);
  unsigned char* smem = smem_all + sub * SUB_LDS;
  const int vb = (int)blockIdx.x * 2 + sub, vgrid = (int)gridDim.x * 2;
  const int wave = otid() >> 6;
  const int gw = vb * 4 + wave, ngw = vgrid * 4;
  phase0(p, smem, vb, vgrid);
  GSYNC();
  int pend_layer = -1, pend_half = 0;
  for (int itn = 0; itn < 4; ++itn) {
    const int layer = itn >> 1, half = itn & 1;
    if (pend_layer >= 0) { for (int rw = gw; rw < TH; rw += ngw) p4c_row(p, pend_layer, (size_t)pend_half * TH + rw, true); pend_layer = -1; }
    for (int t = (int)blockIdx.x; t < 32 * 54; t += (int)gridDim.x) {
      const int tn = t + (int)gridDim.x;
      p1_unit(p, layer, half, t & 31, t >> 5, tn < 32 * 54 ? (tn & 31) : 0, tn < 32 * 54 ? (tn >> 5) : -1, t == (int)blockIdx.x, smem_all);
    }
    GSYNC();
    {
      constexpr int N_FOX = 6, N_GDN = 768, N_MKV = 12, N_KM = 48, TOT = N_FOX + N_GDN + N_MKV + N_KM;
      for (int t = vb; t < TOT; t += vgrid) {
        int i = t;
        if (i < N_FOX) { fox_prep(p, i, smem); continue; }
        i -= N_FOX;
        if (i < N_GDN) { gdn_prep(p, layer, half, i / 128, i % 128, smem); continue; }
        i -= N_GDN;
        if (i < N_MKV) { memkv_tile(p, layer, half, i / 6, i % 6, smem); continue; }
        i -= N_MKV;
        kmean_prep(p, i * 4 + wave, (unsigned*)(p.ws + O_CTL) + 64 + (layer * 2 + half) * 8);
      }
    }
    GSYNC();
    for (int a = gw; a < 1536; a += ngw) moba_select(p, a);
    GSYNC();
    phase3(p, half, (unsigned*)(p.ws + O_CTL) + layer * 2 + half, (const unsigned*)(p.ws + O_CTL) + 64 + (layer * 2 + half) * 8, smem, sub);
    GSYNC();
    for (int ci = vb * 256 + otid(); ci < TH * 240; ci += vgrid * 256) gbuild_chunk(p, layer, ci / 240, ci % 240);
    GSYNC();
    for (int t = vb; t < 512; t += vgrid) p4a_tile(p, layer, t % 64, t / 64, smem);
    GSYNC();
    for (int t = vb; t < 512; t += vgrid) p4b_tile(p, layer, half, t % 64, t / 64, smem);
    GSYNC();
    pend_layer = layer; pend_half = half;
  }
  if (pend_layer >= 0) { for (int rw = gw; rw < TH; rw += ngw) p4c_row(p, pend_layer, (size_t)pend_half * TH + rw, true); }
}

extern "C" void kernel_launch(void* const* d_in, const int* in_sizes, int n_in, void* d_out, int out_size, void* d_ws, size_t ws_size,
                              hipStream_t stream) {
  static int grid_blocks = 0;
  if (grid_blocks == 0) {
    if (ws_size < WS_END) { fprintf(stderr, "workspace too small: %zu < %zu\n", ws_size, (size_t)WS_END); grid_blocks = -1; return; }
    int dev = 0, cus = 0, per_cu = 0;
    (void)hipGetDevice(&dev);
    (void)hipDeviceGetAttribute(&cus, hipDeviceAttributeMultiprocessorCount, dev);
    (void)hipFuncSetAttribute((const void*)mega, hipFuncAttributeMaxDynamicSharedMemorySize, LDS_BYTES);
    (void)hipOccupancyMaxActiveBlocksPerMultiprocessor(&per_cu, (const void*)mega, 512, LDS_BYTES);
    if (per_cu < 1) per_cu = 1;
    if (per_cu > 1) per_cu = 1;
    grid_blocks = cus * per_cu;
  }
  if (grid_blocks < 0) return;
  (void)hipMemsetAsync((char*)d_ws + O_CTL, 0, 32768, stream);
  Params p{};
  p.x = (const float*)d_in[0]; p.mem = (const float*)d_in[1]; p.mem_g = (const float*)d_in[2]; p.mem_b = (const float*)d_in[3];
  p.w_in = (const float*)d_in[4]; p.b_in = (const float*)d_in[5]; p.conv_w = (const float*)d_in[6]; p.a_log = (const float*)d_in[7];
  p.dt_bias = (const float*)d_in[8]; p.gdn_w = (const float*)d_in[9]; p.w_kv = (const float*)d_in[10]; p.w_br = (const float*)d_in[11];
  p.w_out = (const float*)d_in[12]; p.ln_g = (const float*)d_in[13]; p.ln_b = (const float*)d_in[14];
  p.out = (float*)d_out; p.ws = (unsigned char*)d_ws;
  void* args[] = {&p};
  hipError_t e = hipLaunchCooperativeKernel((const void*)mega, dim3(grid_blocks), dim3(512), args, LDS_BYTES, stream);
  if (e != hipSuccess) fprintf(stderr, "cooperative launch failed: %s (grid %d)\n", hipGetErrorString(e), grid_blocks);
}
```

```cpp
#include <hip/hip_runtime.h>
#include <hip/hip_cooperative_groups.h>
#include <cstdio>
#include <cstdint>
namespace cg = cooperative_groups;

#define DI __device__ __forceinline__
typedef unsigned short bf16_t;
typedef short bf16x8 __attribute__((ext_vector_type(8)));
typedef short s16x4 __attribute__((ext_vector_type(4)));
typedef float f32x4 __attribute__((ext_vector_type(4)));
typedef float f32x2 __attribute__((ext_vector_type(2)));
typedef float f32x16 __attribute__((ext_vector_type(16)));
typedef unsigned u32x2 __attribute__((ext_vector_type(2)));
typedef unsigned u32x4 __attribute__((ext_vector_type(4)));
typedef __bf16 bfv2 __attribute__((ext_vector_type(2)));

#define MFMA32(a, b, c) __builtin_amdgcn_mfma_f32_32x32x16_bf16((a), (b), (c), 0, 0, 0)
#define MFMA16(a, b, c) __builtin_amdgcn_mfma_f32_16x16x32_bf16((a), (b), (c), 0, 0, 0)

DI unsigned pk2(float a, float b) { f32x2 v = {a, b}; return __builtin_bit_cast(unsigned, __builtin_convertvector(v, bfv2)); }
DI bf16_t f2bf(float a) { return (bf16_t)(pk2(a, 0.f) & 0xffffu); }
DI float bf2f(bf16_t v) { return __uint_as_float(((unsigned)v) << 16); }
DI float bflo(unsigned u) { return __uint_as_float(u << 16); }
DI float bfhi(unsigned u) { return __uint_as_float(u & 0xffff0000u); }
DI int rtid() { int t = __builtin_amdgcn_workitem_id_x(); asm volatile("" : "+v"(t)); return t; }
DI int otid() { return rtid() & 255; }
extern __shared__ __attribute__((aligned(16))) unsigned char g_lds_all[];
#define LAS3 __attribute__((address_space(3)))
DI void sub_sync() {
  asm volatile("s_waitcnt lgkmcnt(0)" ::: "memory");
  const int t = __builtin_amdgcn_workitem_id_x();
  LAS3 unsigned* c = (LAS3 unsigned*)(g_lds_all + 2 * 75776 + 8) + (t >> 8);
  if ((t & 63) == 0) {
    const unsigned old = __hip_atomic_fetch_add(c, 1u, __ATOMIC_RELAXED, __HIP_MEMORY_SCOPE_WORKGROUP);
    const unsigned target = (old / 4u + 1u) * 4u;
    while (__hip_atomic_load(c, __ATOMIC_RELAXED, __HIP_MEMORY_SCOPE_WORKGROUP) < target) __builtin_amdgcn_s_sleep(1);
  }
  asm volatile("s_waitcnt lgkmcnt(0)" ::: "memory");
}
DI int crow(int i, int h) { return (i & 3) + 8 * (i >> 2) + 4 * h; }
DI float fsigmoid(float v) { return __builtin_amdgcn_rcpf(1.f + __expf(-v)); }
DI float fsilu(float v) { return v * fsigmoid(v); }
DI u32x2 pk4(float a, float b, float c, float d) { u32x2 r; r.x = pk2(a, b); r.y = pk2(c, d); return r; }
DI bf16x8 pk8(const float* v) { u32x4 r; r.x = pk2(v[0], v[1]); r.y = pk2(v[2], v[3]); r.z = pk2(v[4], v[5]); r.w = pk2(v[6], v[7]); return __builtin_bit_cast(bf16x8, r); }
DI void unpk8(bf16x8 x, float* v) { u32x4 u = __builtin_bit_cast(u32x4, x); v[0] = bflo(u.x); v[1] = bfhi(u.x); v[2] = bflo(u.y); v[3] = bfhi(u.y); v[4] = bflo(u.z); v[5] = bfhi(u.z); v[6] = bflo(u.w); v[7] = bfhi(u.w); }

constexpr int NB = 2, SQ = 8192, NT = NB * SQ, DM = 1024, NH = 6, BW = 384;
constexpr int TH = 8192;
constexpr int NP = 13824;
constexpr int DIN = 13586;
constexpr float LOG2E = 1.4426950408889634f;
#define NEG_INF (-__builtin_inff())

constexpr int C_AQK = 0, C_AV = 768, C_BQK = 1152, C_BV = 3456, C_CQK = 3840, C_CV = 4608, C_D = 4992, C_E = 6144, C_SM = 6528, C_SMEND = 6546, C_Z = 6656, C_MG = 8576;

__host__ __device__ constexpr int inmap(int n) {
  return n < 4992 ? n : n < 6144 ? n + 6 : n < 6528 ? n + 18 : n < 6534 ? n - 1536 : n < 6546 ? n - 384 : n < 6656 ? -1 : n < 13696 ? n - 110 : -1;
}

constexpr size_t O_CTL = 0;
constexpr size_t O_BAR = 4096;
constexpr size_t O_WTIN = 32768;
constexpr size_t SZ_WTIN1 = (size_t)NP * 1024 * 2;
constexpr size_t O_WTBR = O_WTIN + 2 * SZ_WTIN1;
constexpr size_t SZ_WTBR1 = (size_t)5 * 1024 * 384 * 2;
constexpr size_t O_WTOUT = O_WTBR + 2 * SZ_WTBR1;
constexpr size_t SZ_WTOUT1 = (size_t)1024 * 1024 * 2;
constexpr size_t O_WTKV = O_WTOUT + 2 * SZ_WTOUT1;
constexpr size_t SZ_WTKV1 = (size_t)768 * 1024 * 2;
constexpr size_t O_BIASP = O_WTKV + 2 * SZ_WTKV1;
constexpr size_t O_XB = O_BIASP + (size_t)2 * NP * 4;
constexpr size_t O_MEMN = O_XB + (size_t)NT * 1024 * 2;
constexpr size_t O_MEMK = O_MEMN + (size_t)512 * 1024 * 2;
constexpr size_t O_MEMVT = O_MEMK + (size_t)512 * 384 * 2;
constexpr size_t O_QKA = O_MEMVT + (size_t)512 * 384 * 2;
constexpr size_t SZ_VT = (size_t)384 * TH * 2;
constexpr size_t O_KFA = O_QKA + SZ_VT;
constexpr size_t O_VTA = O_KFA + SZ_VT;
constexpr size_t O_QKB = O_VTA + SZ_VT;
constexpr size_t O_KFB = O_QKB + 3 * SZ_VT;
constexpr size_t O_VTB = O_KFB + 3 * SZ_VT;
constexpr size_t O_QKC = O_VTB + 3 * SZ_VT;
constexpr size_t O_KFC = O_QKC + SZ_VT;
constexpr size_t O_VTC = O_KFC + SZ_VT;
constexpr size_t O_QKVD = O_VTC + SZ_VT;
constexpr size_t O_QE = O_QKVD + (size_t)TH * 1152 * 2;
constexpr size_t O_SM = O_QE + (size_t)TH * 384 * 2;
constexpr size_t O_FF = O_SM + (size_t)TH * 32 * 4;
constexpr size_t O_KM = O_FF + (size_t)6 * TH * 4;
constexpr size_t O_KMAX = O_KM + (size_t)2 * 6 * 32 * 64 * 2;
constexpr size_t O_GL = O_KMAX + 256;
constexpr size_t O_MASK = O_GL + 6 * 128 * 4;
constexpr size_t O_KSUM = O_MASK + (size_t)TH * 8 * 4;
constexpr size_t O_DPREP = O_KSUM + (size_t)32 * 2 * 384 * 4;
constexpr size_t O_SZ = O_DPREP + (size_t)768 * 32768;
constexpr size_t O_SIG = O_SZ + (size_t)TH * 1920 * 2;
constexpr size_t O_OA = O_SIG + (size_t)TH * 5120 * 2;
constexpr size_t SZ_O = (size_t)TH * 384 * 2;
constexpr size_t O_STA = O_OA + 4 * SZ_O;
constexpr size_t O_OB = O_STA + (size_t)4 * TH * 6 * 2 * 4;
constexpr size_t O_STB = O_OB + 3 * SZ_O;
constexpr size_t O_OC = O_STB + (size_t)3 * TH * 6 * 2 * 4;
constexpr size_t O_OD = O_OC + SZ_O;
constexpr size_t O_SSQ = O_OD + SZ_O;
constexpr size_t O_OE = O_SSQ + (size_t)TH * 6 * 4 * 4;
constexpr size_t WS_END = O_OE + SZ_O;
constexpr size_t O_YM = O_QKB;
static_assert(WS_END < (size_t)443 * 1000 * 1000, "workspace too large");

struct Params {
  const float *x, *mem, *mem_g, *mem_b, *w_in, *b_in, *conv_w, *a_log, *dt_bias, *gdn_w, *w_kv, *w_br, *w_out, *ln_g, *ln_b;
  float* out;
  unsigned char* ws;
};

constexpr int SUB_LDS = 75776;
constexpr int LDS_BYTES = 2 * SUB_LDS + 16;
#ifndef PH_MASK
#define PH_MASK 0xFFFF
#endif
#define PH(x) ((PH_MASK >> (x)) & 1)
#ifndef REP_MASK
#define REP_MASK 0
#endif
#define REP(x) (1 + ((REP_MASK >> (x)) & 1))

DI void transpose_tile(const float* __restrict__ src, int ld, int k0, int n0, bool usemap, bf16_t* __restrict__ dst, int dstld, float* tile) {
  const int tid = otid();
#pragma unroll
  for (int it = 0; it < 16; ++it) {
    const int kk = (tid >> 6) + 4 * it, n2 = (tid & 63) * 2;
    const int sc = usemap ? inmap(n0 + n2) : (n0 + n2);
    f32x2 v = {0.f, 0.f};
    if (sc >= 0) v = *(const f32x2*)(src + (size_t)(k0 + kk) * ld + sc);
    *(f32x2*)(tile + kk * 130 + n2) = v;
  }
  sub_sync();
#pragma unroll
  for (int it = 0; it < 4; ++it) {
    const int nn = (tid >> 3) + 32 * it, kc = (tid & 7) * 8;
    float v[8];
#pragma unroll
    for (int e = 0; e < 8; ++e) v[e] = tile[(kc + e) * 130 + nn];
    *(bf16x8*)(dst + (size_t)(n0 + nn) * dstld + k0 + kc) = pk8(v);
  }
  sub_sync();
}

DI void phase0(const Params& p, unsigned char* smem, int vb, int vgrid) {
  float* tile = (float*)smem;
  const int tid = otid(), lane = tid & 63, wave = tid >> 6;
  constexpr int N_TIN = 2 * 108 * 16, N_TBR = 2 * 5 * 8 * 6, N_TOUT = 2 * 8 * 16, N_TKV = 2 * 6 * 16, N_XB = 1024, N_MEMN = 128, N_BIAS = 108;
  constexpr int TOT = N_TIN + N_TBR + N_TOUT + N_TKV + N_XB + N_MEMN + N_BIAS;
  for (int it = vb; it < TOT; it += vgrid) {
    int i = it;
    if (i < N_TIN) {
      const int l = i / (108 * 16), rr = i % (108 * 16), nt = rr / 16, kt = rr % 16;
      transpose_tile(p.w_in + (size_t)l * 1024 * DIN, DIN, kt * 64, nt * 128, true, (bf16_t*)(p.ws + O_WTIN + l * SZ_WTIN1), 1024, tile);
      continue;
    }
    i -= N_TIN;
    if (i < N_TBR) {
      const int ln = i / 48, rr = i % 48, nt = rr / 6, kt = rr % 6;
      transpose_tile(p.w_br + (size_t)ln * 384 * 1024, 1024, kt * 64, nt * 128, false, (bf16_t*)(p.ws + O_WTBR) + (size_t)ln * 1024 * 384, 384, tile);
      continue;
    }
    i -= N_TBR;
    if (i < N_TOUT) {
      const int l = i / 128, rr = i % 128, nt = rr / 16, kt = rr % 16;
      transpose_tile(p.w_out + (size_t)l * 1024 * 1024, 1024, kt * 64, nt * 128, false, (bf16_t*)(p.ws + O_WTOUT + l * SZ_WTOUT1), 1024, tile);
      continue;
    }
    i -= N_TOUT;
    if (i < N_TKV) {
      const int l = i / 96, rr = i % 96, nt = rr / 16, kt = rr % 16;
      transpose_tile(p.w_kv + (size_t)l * 1024 * 768, 768, kt * 64, nt * 128, false, (bf16_t*)(p.ws + O_WTKV + l * SZ_WTKV1), 1024, tile);
      continue;
    }
    i -= N_TKV;
    if (i < N_XB) {
      const float* src = p.x + (size_t)i * 16 * 1024;
      bf16_t* dst = (bf16_t*)(p.ws + O_XB) + (size_t)i * 16 * 1024;
#pragma unroll
      for (int j = 0; j < 16; ++j) {
        const int e = (j * 256 + tid) * 4;
        const f32x4 v = *(const f32x4*)(src + e);
        *(u32x2*)(dst + e) = pk4(v[0], v[1], v[2], v[3]);
      }
      continue;
    }
    i -= N_XB;
    if (i < N_MEMN) {
      const int row = i * 4 + wave;
      const float* src = p.mem + (size_t)row * 1024;
      f32x4 v[4]; float s = 0.f;
#pragma unroll
      for (int j = 0; j < 4; ++j) { v[j] = *(const f32x4*)(src + 4 * lane + 256 * j); s += v[j][0] + v[j][1] + v[j][2] + v[j][3]; }
#pragma unroll
      for (int o = 32; o >= 1; o >>= 1) s += __shfl_xor(s, o);
      const float mu = s * (1.f / 1024.f); float q = 0.f;
#pragma unroll
      for (int j = 0; j < 4; ++j) { v[j] -= mu; q += v[j][0] * v[j][0] + v[j][1] * v[j][1] + v[j][2] * v[j][2] + v[j][3] * v[j][3]; }
#pragma unroll
      for (int o = 32; o >= 1; o >>= 1) q += __shfl_xor(q, o);
      const float rs = rsqrtf(q * (1.f / 1024.f) + 1e-5f);
      bf16_t* dst = (bf16_t*)(p.ws + O_MEMN) + (size_t)row * 1024;
#pragma unroll
      for (int j = 0; j < 4; ++j) {
        const int c = 4 * lane + 256 * j;
        const f32x4 g = *(const f32x4*)(p.mem_g + c), b = *(const f32x4*)(p.mem_b + c);
        *(u32x2*)(dst + c) = pk4(v[j][0] * rs * g[0] + b[0], v[j][1] * rs * g[1] + b[1], v[j][2] * rs * g[2] + b[2], v[j][3] * rs * g[3] + b[3]);
      }
      continue;
    }
    i -= N_MEMN;
    {
      float* bp = (float*)(p.ws + O_BIASP);
      if (tid < 128) {
        const int n = i * 128 + tid;
        const int sc = inmap(n);
        for (int l = 0; l < 2; ++l) bp[l * NP + n] = sc >= 0 ? p.b_in[l * DIN + sc] : 0.f;
      }
    }
  }
}

template <int BK, class AL>
DI void gemm_kloop_t(const AL& al, const bf16_t* __restrict__ Bt, int ldb, int nkt, int m0, int n0, f32x16 (&acc)[2][2], bf16_t* As, bf16_t* Bs) {
  constexpr int CPR = BK / 8, NCH = BK / 16, PITCH = BK + 8, BUF = 128 * PITCH;
  const int tid = otid(), lane = tid & 63, wave = tid >> 6, wr = wave >> 1, wc = wave & 1, r = lane & 31, h = lane >> 5;
  bf16x8 ra[NCH], rb[NCH];
  auto gload = [&](int kt) {
#pragma unroll
    for (int i = 0; i < NCH; ++i) {
      const int cid = tid + 256 * i, row = cid / CPR, kc = (cid % CPR) * 8;
      ra[i] = al(m0 + row, kt * BK + kc);
      rb[i] = *(const bf16x8*)(Bt + (size_t)(n0 + row) * ldb + kt * BK + kc);
    }
  };
  auto lstore = [&](int buf) {
#pragma unroll
    for (int i = 0; i < NCH; ++i) {
      const int cid = tid + 256 * i, row = cid / CPR, kc = (cid % CPR) * 8;
      *(bf16x8*)(As + buf * BUF + row * PITCH + kc) = ra[i];
      *(bf16x8*)(Bs + buf * BUF + row * PITCH + kc) = rb[i];
    }
  };
  gload(0); lstore(0); sub_sync();
  for (int kt = 0; kt < nkt; ++kt) {
    const int buf = kt & 1;
    if (kt + 1 < nkt) gload(kt + 1);
    asm volatile("" ::: "memory");
    const bf16_t* a_ = As + buf * BUF + (wr * 64 + r) * PITCH + 8 * h;
    const bf16_t* b_ = Bs + buf * BUF + (wc * 64 + r) * PITCH + 8 * h;
#pragma unroll
    for (int s = 0; s < BK / 16; ++s) {
      bf16x8 af[2], bfr[2];
      af[0] = *(const bf16x8*)(a_ + 16 * s); af[1] = *(const bf16x8*)(a_ + 32 * PITCH + 16 * s);
      bfr[0] = *(const bf16x8*)(b_ + 16 * s); bfr[1] = *(const bf16x8*)(b_ + 32 * PITCH + 16 * s);
#pragma unroll
      for (int mi = 0; mi < 2; ++mi)
#pragma unroll
        for (int ni = 0; ni < 2; ++ni) acc[mi][ni] = MFMA32(bfr[ni], af[mi], acc[mi][ni]);
    }
    if (kt + 1 < nkt) lstore(buf ^ 1);
    sub_sync();
  }
}
template <class AL>
DI void gemm_kloop(const AL& al, const bf16_t* __restrict__ Bt, int ldb, int nkt, int m0, int n0, f32x16 (&acc)[2][2], bf16_t* As, bf16_t* Bs) {
  gemm_kloop_t<64>(al, Bt, ldb, nkt, m0, n0, acc, As, Bs);
}

DI void zero_acc(f32x16 (&acc)[2][2]) {
#pragma unroll
  for (int a = 0; a < 2; ++a)
#pragma unroll
    for (int b = 0; b < 2; ++b)
#pragma unroll
      for (int i = 0; i < 16; ++i) acc[a][b][i] = 0.f;
}

DI int vfrag_key(int key) { const int kk = key & 31; return (key >> 5) * 2048 + (kk >> 4) * 512 + ((kk >> 2) & 1) * 256 + ((kk >> 3) & 1) * 4 + (kk & 3); }
DI int vfrag_col(int cw) { const int d = cw & 63; return (cw >> 6) * 524288 + (d >> 5) * 1024 + (d & 31) * 8; }

DI int kfrag_key(int key) { return (key >> 5) * 2048 + (key & 31) * 8; }
DI int kfrag_col(int cw) { const int d = cw & 63; return (cw >> 6) * 524288 + (d >> 4) * 512 + ((d >> 3) & 1) * 256 + (d & 7); }

struct PlainA {
  const bf16_t* A; int lda;
  DI bf16x8 operator()(int row, int k) const { return *(const bf16x8*)(A + (size_t)row * lda + k); }
};

DI void p1_tile(const Params& p, int layer, int half, int mt, int nt, unsigned char* smem) {
  sub_sync();
  bf16_t* As = (bf16_t*)smem; bf16_t* Bs = As + 2 * 9216;
  f32x16 acc[2][2]; zero_acc(acc);
  PlainA al{(const bf16_t*)(p.ws + O_XB) + (size_t)half * TH * 1024, 1024};
  const int m0 = mt * 128, n0 = nt * 128;
  gemm_kloop(al, (const bf16_t*)(p.ws + O_WTIN + layer * SZ_WTIN1), 1024, 16, m0, n0, acc, As, Bs);
  const int tid = otid(), lane = tid & 63, wave = tid >> 6, wr = wave >> 1, wc = wave & 1, r = lane & 31, h = lane >> 5;
  const float* bias = (const float*)(p.ws + O_BIASP) + layer * NP;
  unsigned char* ws = p.ws;
  {
    const int nb0 = n0 + wc * 64;
    bf16_t* dst0 = nullptr; int pitch0 = 0, coff0 = 0, xf0 = 0;
    if (nb0 < 384) { dst0 = (bf16_t*)(ws + O_QKA); pitch0 = 384; coff0 = nb0; }
    else if (nb0 >= C_BQK && nb0 < 2304) { dst0 = (bf16_t*)(ws + O_QKB); pitch0 = 1152; coff0 = nb0 - C_BQK; }
    else if (nb0 >= C_CQK && nb0 < 4224) { dst0 = (bf16_t*)(ws + O_QKC); pitch0 = 384; coff0 = nb0 - C_CQK; }
    else if (nb0 >= C_D && nb0 < C_E) { dst0 = (bf16_t*)(ws + O_QKVD); pitch0 = 1152; coff0 = nb0 - C_D; }
    else if (nb0 >= C_E && nb0 < C_SM) { dst0 = (bf16_t*)(ws + O_QE); pitch0 = 384; coff0 = nb0 - C_E; }
    else if (nb0 >= C_Z && nb0 < C_MG) { dst0 = (bf16_t*)(ws + O_SZ); pitch0 = 1920; coff0 = nb0 - C_Z; xf0 = 1; }
    else if (nb0 >= C_MG) { dst0 = (bf16_t*)(ws + O_SIG); pitch0 = 5120; coff0 = nb0 - C_MG; xf0 = 2; }
    if (dst0 != nullptr) {
      bf16_t* stg = (bf16_t*)smem + wave * (64 * 72);
#pragma unroll
      for (int ni = 0; ni < 2; ++ni)
#pragma unroll
        for (int mi = 0; mi < 2; ++mi)
#pragma unroll
          for (int g = 0; g < 4; ++g) {
            const int cq = ni * 32 + 8 * g + 4 * h;
            const f32x4 bv = *(const f32x4*)(bias + nb0 + cq);
            float v[4];
#pragma unroll
            for (int e = 0; e < 4; ++e) v[e] = acc[mi][ni][4 * g + e] + bv[e];
            if (xf0 == 1) {
#pragma unroll
              for (int e = 0; e < 4; ++e) v[e] = fsilu(v[e]);
            } else if (xf0 == 2) {
#pragma unroll
              for (int e = 0; e < 4; ++e) v[e] = fsigmoid(v[e]);
            }
            *(u32x2*)(stg + (mi * 32 + r) * 72 + cq) = pk4(v[0], v[1], v[2], v[3]);
          }
      asm volatile("s_waitcnt lgkmcnt(0)" ::: "memory");
      __builtin_amdgcn_wave_barrier();
      const int tok0 = m0 + wr * 64;
#pragma unroll
      for (int it = 0; it < 8; ++it) {
        const int row = it * 8 + (lane >> 3), ch = (lane & 7) * 8;
        const bf16x8 val = *(const bf16x8*)(stg + row * 72 + ch);
        *(bf16x8*)(dst0 + (size_t)(tok0 + row) * pitch0 + coff0 + ch) = val;
      }
      return;
    }
  }
#pragma unroll
  for (int ni = 0; ni < 2; ++ni) {
    const int nb = n0 + wc * 64 + ni * 32;
    int kind;
    int xf = 0;
    bf16_t* dst = nullptr; int pitch = 0, coff = 0;
    int kgrp = 0;
    if (nb < 384) { kind = 0; dst = (bf16_t*)(ws + O_QKA); pitch = 384; coff = nb; }
    else if (nb < C_AV) { kind = 5; dst = (bf16_t*)(ws + O_KFA); coff = nb - 384; }
    else if (nb < C_BQK) { kind = 1; dst = (bf16_t*)(ws + O_VTA); coff = nb - C_AV; }
    else if (nb < 2304) { kind = 0; dst = (bf16_t*)(ws + O_QKB); pitch = 1152; coff = nb - C_BQK; }
    else if (nb < C_BV) { kind = 5; kgrp = (nb - 2304) / 384; dst = (bf16_t*)(ws + O_KFB + kgrp * SZ_VT); coff = (nb - 2304) - kgrp * 384; }
    else if (nb < C_CQK) { kind = 2; dst = (bf16_t*)(ws + O_VTB); coff = nb - C_BV; }
    else if (nb < 4224) { kind = 0; dst = (bf16_t*)(ws + O_QKC); pitch = 384; coff = nb - C_CQK; }
    else if (nb < C_CV) { kind = 5; dst = (bf16_t*)(ws + O_KFC); coff = nb - 4224; }
    else if (nb < C_D) { kind = 1; dst = (bf16_t*)(ws + O_VTC); coff = nb - C_CV; }
    else if (nb < C_E) { kind = 0; dst = (bf16_t*)(ws + O_QKVD); pitch = 1152; coff = nb - C_D; }
    else if (nb < C_SM) { kind = 0; dst = (bf16_t*)(ws + O_QE); pitch = 384; coff = nb - C_E; }
    else if (nb < C_Z) { kind = (nb == C_SM) ? 3 : 4; }
    else if (nb < C_MG) { kind = 0; xf = 1; dst = (bf16_t*)(ws + O_SZ); pitch = 1920; coff = nb - C_Z; }
    else { kind = 0; xf = 2; dst = (bf16_t*)(ws + O_SIG); pitch = 5120; coff = nb - C_MG; }
    if (kind == 4) continue;
#pragma unroll
    for (int mi = 0; mi < 2; ++mi) {
      const int tok = m0 + wr * 64 + mi * 32 + r;
#pragma unroll
      for (int g = 0; g < 4; ++g) {
        const int cq = 8 * g + 4 * h;
        const f32x4 bv = *(const f32x4*)(bias + nb + cq);
        float v[4];
#pragma unroll
        for (int e = 0; e < 4; ++e) v[e] = acc[mi][ni][4 * g + e] + bv[e];
        if (kind == 0) {
          if (xf == 1) {
#pragma unroll
            for (int e = 0; e < 4; ++e) v[e] = fsilu(v[e]);
          } else if (xf == 2) {
#pragma unroll
            for (int e = 0; e < 4; ++e) v[e] = fsigmoid(v[e]);
          }
          *(u32x2*)(dst + (size_t)tok * pitch + coff + cq) = pk4(v[0], v[1], v[2], v[3]);
        } else if (kind == 5) {
          const int key = kgrp == 0 ? tok : kgrp == 1 ? (tok & 3) * 2048 + (tok >> 2) : (tok & 15) * 512 + (tok >> 4);
          *(u32x2*)(dst + kfrag_col(coff + cq) + kfrag_key(key)) = pk4(v[0], v[1], v[2], v[3]);
        } else if (kind == 1) {
          const int ko = vfrag_key(tok);
#pragma unroll
          for (int e = 0; e < 4; ++e) dst[vfrag_col(coff + cq + e) + ko] = f2bf(v[e]);
        } else if (kind == 2) {
          const int k1 = vfrag_key(tok), k4 = vfrag_key((tok & 3) * 2048 + (tok >> 2)), k16 = vfrag_key((tok & 15) * 512 + (tok >> 4));
#pragma unroll
          for (int e = 0; e < 4; ++e) {
            const bf16_t b = f2bf(v[e]); const int co = vfrag_col(coff + cq + e);
            dst[co + k1] = b; dst[SZ_VT / 2 + co + k4] = b; dst[SZ_VT + co + k16] = b;
          }
        } else {
          float* sm = (float*)(ws + O_SM);
#pragma unroll
          for (int e = 0; e < 4; ++e) if (cq + e < 18) sm[tok * 32 + cq + e] = v[e];
        }
      }
    }
  }
}


DI int g_lds_byte(int r, int c) { const int st = (r >> 4) * 2 + (c >> 5), ob = (r & 15) * 64 + (c & 31) * 2; return st * 1024 + (ob ^ (((ob >> 9) & 1) << 5)); }
DI void g_stage_rc(int b, int& R, int& C) { const int st = b >> 10, sb = b & 1023, swz = sb ^ (((sb >> 9) & 1) << 5); R = (st >> 1) * 16 + (swz >> 6); C = (st & 1) * 32 + ((swz & 63) >> 1); }

DI float row16_sum(float v);
DI void p1_unit(const Params& p, int layer, int half, int pm, int pn, int pm_next, int pn_next  , bool first, unsigned char* lds) {
  const int tid = rtid(), wid = tid >> 6, lane = tid & 63, wr = wid >> 2, wc = wid & 3, fr = lane & 15, fq = lane >> 4;
  const bf16_t* Ab = (const bf16_t*)(p.ws + O_XB) + ((size_t)half * TH + (size_t)pm * 256) * 1024;
  const bf16_t* Bb = (const bf16_t*)(p.ws + O_WTIN + layer * SZ_WTIN1) + (size_t)pn * 256 * 1024;
  int sOff[4];
#pragma unroll
  for (int i = 0; i < 4; ++i) { int R, C; g_stage_rc(wid * 1024 + i * 8192 + lane * 16, R, C); sOff[i] = R * 1024 + C; }
  auto stage2 = [&](const bf16_t* A_, const bf16_t* B_, int buf, int kt) {
#pragma unroll
    for (int i = 0; i < 4; ++i) {
      __builtin_amdgcn_global_load_lds((const unsigned*)(A_ + sOff[i] + kt * 64), (unsigned*)(lds + buf * 65536 + wid * 1024 + i * 8192), 16, 0, 0);
      __builtin_amdgcn_global_load_lds((const unsigned*)(B_ + sOff[i] + kt * 64), (unsigned*)(lds + buf * 65536 + 32768 + wid * 1024 + i * 8192), 16, 0, 0);
    }
  };
  auto stage = [&](int buf, int kt) { stage2(Ab, Bb, buf, kt); };
  f32x4 acc[8][4];
#pragma unroll
  for (int m = 0; m < 8; ++m)
#pragma unroll
    for (int n = 0; n < 4; ++n) acc[m][n] = (f32x4){0.f, 0.f, 0.f, 0.f};
  const int lane_off = (fr * 64 + fq * 16) ^ ((fr >> 3) << 5);
  if (first) { __syncthreads(); stage(0, 0); }
  asm volatile("s_waitcnt vmcnt(0)" ::: "memory");
  __syncthreads();
#pragma unroll 1
  for (int t = 0; t < 16; ++t) {
    const int cur = t & 1;
    {
      const bool last = (t + 1 == 16);
      if (!last || pn_next >= 0) {
        const long dA = last ? (long)(pm_next - pm) * 256 * 1024 - 0 : (long)(t + 1) * 64;
        const long dB = last ? (long)(pn_next - pn) * 256 * 1024 - 0 : (long)(t + 1) * 64;
#pragma unroll
        for (int i = 0; i < 4; ++i) {
          __builtin_amdgcn_global_load_lds((const unsigned*)(Ab + sOff[i] + dA), (unsigned*)(lds + (cur ^ 1) * 65536 + wid * 1024 + i * 8192), 16, 0, 0);
          __builtin_amdgcn_global_load_lds((const unsigned*)(Bb + sOff[i] + dB), (unsigned*)(lds + (cur ^ 1) * 65536 + 32768 + wid * 1024 + i * 8192), 16, 0, 0);
        }
      }
    }
    const unsigned char* SA = lds + cur * 65536 + wr * 16384 + lane_off;
    const unsigned char* SB = lds + cur * 65536 + 32768 + wc * 8192 + lane_off;
    bf16x8 Bf[2][4], At[2][2];
#pragma unroll
    for (int n = 0; n < 4; ++n) Bf[0][n] = *(const bf16x8*)(SB + n * 2048);
#pragma unroll
    for (int m = 0; m < 2; ++m) At[0][m] = *(const bf16x8*)(SA + m * 2048);
#pragma unroll
    for (int g = 0; g < 8; ++g) {
      const int ks = g >> 2, pr = g & 3;
      if (g == 1) {
#pragma unroll
        for (int n = 0; n < 4; ++n) Bf[1][n] = *(const bf16x8*)(SB + n * 2048 + 1024);
      }
      if (g < 7) {
        const int g1 = g + 1;
#pragma unroll
        for (int m = 0; m < 2; ++m) At[g1 & 1][m] = *(const bf16x8*)(SA + ((g1 & 3) * 2 + m) * 2048 + (g1 >> 2) * 1024);
      }
      asm volatile("" : "+v"(acc[pr * 2][0][0]) :: "memory");
#pragma unroll
      for (int m = 0; m < 2; ++m)
#pragma unroll
        for (int n = 0; n < 4; ++n) acc[pr * 2 + m][n] = MFMA16(Bf[ks][n], At[g & 1][m], acc[pr * 2 + m][n]);
    }
    asm volatile("s_waitcnt vmcnt(0)" ::: "memory");
    __syncthreads();
  }
  const int nb0 = pn * 256 + wc * 64, tok0 = pm * 256 + wr * 128;
  const float* bias = (const float*)(p.ws + O_BIASP) + layer * NP;
  unsigned char* ws = p.ws;
  int kind, xf = 0, kgrp = 0, pitch = 0, coff = 0; bf16_t* dst = nullptr;
  if (nb0 < 384) { kind = 0; dst = (bf16_t*)(ws + O_QKA); pitch = 384; coff = nb0; }
  else if (nb0 < C_AV) { kind = 5; dst = (bf16_t*)(ws + O_KFA); coff = nb0 - 384; }
  else if (nb0 < C_BQK) { kind = 1; dst = (bf16_t*)(ws + O_VTA); coff = nb0 - C_AV; }
  else if (nb0 < 2304) { kind = 0; dst = (bf16_t*)(ws + O_QKB); pitch = 1152; coff = nb0 - C_BQK; }
  else if (nb0 < C_BV) { kind = 5; kgrp = (nb0 - 2304) / 384; dst = (bf16_t*)(ws + O_KFB + kgrp * SZ_VT); coff = (nb0 - 2304) - kgrp * 384; }
  else if (nb0 < C_CQK) { kind = 2; dst = (bf16_t*)(ws + O_VTB); coff = nb0 - C_BV; }
  else if (nb0 < 4224) { kind = 0; dst = (bf16_t*)(ws + O_QKC); pitch = 384; coff = nb0 - C_CQK; }
  else if (nb0 < C_CV) { kind = 5; dst = (bf16_t*)(ws + O_KFC); coff = nb0 - 4224; }
  else if (nb0 < C_D) { kind = 1; dst = (bf16_t*)(ws + O_VTC); coff = nb0 - C_CV; }
  else if (nb0 < C_E) { kind = 0; dst = (bf16_t*)(ws + O_QKVD); pitch = 1152; coff = nb0 - C_D; }
  else if (nb0 < C_SM) { kind = 0; dst = (bf16_t*)(ws + O_QE); pitch = 384; coff = nb0 - C_E; }
  else if (nb0 < C_Z) { kind = (nb0 == C_SM) ? 3 : 4; }
  else if (nb0 < C_MG) { kind = 0; xf = 1; dst = (bf16_t*)(ws + O_SZ); pitch = 1920; coff = nb0 - C_Z; }
  else if (nb0 < 13696) { kind = 0; xf = 2; dst = (bf16_t*)(ws + O_SIG); pitch = 5120; coff = nb0 - C_MG; }
  else { kind = 4; }
  if (kind == 4) return;
  if (kind == 0) {
    bf16_t* stg = (bf16_t*)(lds + 65536 + wid * 9216);
#pragma unroll
    for (int mh = 0; mh < 2; ++mh) {
#pragma unroll
      for (int m = 0; m < 4; ++m)
#pragma unroll
        for (int n = 0; n < 4; ++n) {
          const int c4 = n * 16 + fq * 4;
          const f32x4 bv = *(const f32x4*)(bias + nb0 + c4);
          float v[4];
#pragma unroll
          for (int e = 0; e < 4; ++e) v[e] = acc[mh * 4 + m][n][e] + bv[e];
          if (xf == 1) {
#pragma unroll
            for (int e = 0; e < 4; ++e) v[e] = fsilu(v[e]);
          } else if (xf == 2) {
#pragma unroll
            for (int e = 0; e < 4; ++e) v[e] = fsigmoid(v[e]);
          }
          *(u32x2*)(stg + (m * 16 + fr) * 72 + c4) = pk4(v[0], v[1], v[2], v[3]);
        }
      asm volatile("s_waitcnt lgkmcnt(0)" ::: "memory");
      __builtin_amdgcn_wave_barrier();
#pragma unroll
      for (int it = 0; it < 8; ++it) {
        const int row = it * 8 + (lane >> 3), ch = (lane & 7) * 8;
        const bf16x8 val = *(const bf16x8*)(stg + row * 72 + ch);
        *(bf16x8*)(dst + (size_t)(tok0 + mh * 64 + row) * pitch + coff + ch) = val;
      }
      asm volatile("s_waitcnt lgkmcnt(0)" ::: "memory");
      __builtin_amdgcn_wave_barrier();
    }
    return;
  }
  if (nb0 >= 384 && nb0 < C_AV) {
    float* ksum = (float*)(ws + O_KSUM) + (size_t)(pm * 2 + wr) * 384 + (nb0 - 384);
#pragma unroll
    for (int n = 0; n < 4; ++n) {
      const f32x4 bv = *(const f32x4*)(bias + nb0 + n * 16 + fq * 4);
#pragma unroll
      for (int e = 0; e < 4; ++e) {
        float t = 8.f * bv[e];
#pragma unroll
        for (int m = 0; m < 8; ++m) t += acc[m][n][e];
        t = row16_sum(t);
        if (fr == 0) ksum[n * 16 + fq * 4 + e] = t;
      }
    }
  }
#pragma unroll
  for (int m = 0; m < 8; ++m) {
    const int tok = tok0 + m * 16 + fr;
#pragma unroll
    for (int n = 0; n < 4; ++n) {
      const int c4 = n * 16 + fq * 4;
      const f32x4 bv = *(const f32x4*)(bias + nb0 + c4);
      float v[4];
#pragma unroll
      for (int e = 0; e < 4; ++e) v[e] = acc[m][n][e] + bv[e];
      if (kind == 5) {
        const int key = kgrp == 0 ? tok : kgrp == 1 ? (tok & 3) * 2048 + (tok >> 2) : (tok & 15) * 512 + (tok >> 4);
        *(u32x2*)(dst + kfrag_col(coff + c4) + kfrag_key(key)) = pk4(v[0], v[1], v[2], v[3]);
      } else if (kind == 1) {
        const int ko = vfrag_key(tok);
#pragma unroll
        for (int e = 0; e < 4; ++e) dst[vfrag_col(coff + c4 + e) + ko] = f2bf(v[e]);
      } else if (kind == 2) {
        const int k1 = vfrag_key(tok), k4 = vfrag_key((tok & 3) * 2048 + (tok >> 2)), k16 = vfrag_key((tok & 15) * 512 + (tok >> 4));
#pragma unroll
        for (int e = 0; e < 4; ++e) {
          const bf16_t b = f2bf(v[e]); const int co = vfrag_col(coff + c4 + e);
          dst[co + k1] = b; dst[SZ_VT / 2 + co + k4] = b; dst[SZ_VT + co + k16] = b;
        }
      } else {
        float* sm = (float*)(ws + O_SM);
#pragma unroll
        for (int e = 0; e < 4; ++e) if (c4 + e < 18) sm[tok * 32 + c4 + e] = v[e];
      }
    }
  }
}

DI void fox_prep(const Params& p, int hh, unsigned char* smem) {
  float* red = (float*)smem;
  const int tid = otid(), lane = tid & 63, wave = tid >> 6;
  const float* sm = (const float*)(p.ws + O_SM);
  float* FF = (float*)(p.ws + O_FF) + hh * TH;
  float loc[32];
#pragma unroll
  for (int j = 0; j < 32; ++j) loc[j] = sm[(tid * 32 + j) * 32 + hh];
  float s = 0.f;
#pragma unroll
  for (int j = 0; j < 32; ++j) { const float xv = loc[j]; s += fminf(xv, 0.f) - log1pf(expf(-fabsf(xv))); loc[j] = s; }
  float inc = s;
#pragma unroll
  for (int o = 1; o < 64; o <<= 1) { const float t = __shfl_up(inc, o); if (lane >= o) inc += t; }
  if (lane == 63) red[wave] = inc;
  sub_sync();
  float off = inc - s;
  for (int w = 0; w < wave; ++w) off += red[w];
#pragma unroll
  for (int j4 = 0; j4 < 8; ++j4) {
    f32x4 o4 = {off + loc[4 * j4], off + loc[4 * j4 + 1], off + loc[4 * j4 + 2], off + loc[4 * j4 + 3]};
    *(f32x4*)(FF + tid * 32 + 4 * j4) = o4;
  }
  sub_sync();
}

DI void kmean_prep(const Params& p, int idx, unsigned* kmaxu) {
  const int lane = otid() & 63;
  const int hh = idx / 32, blk = idx % 32;
  const bf16_t* k = (const bf16_t*)(p.ws + O_KFA) + kfrag_col(hh * 64 + lane) + blk * 8 * 2048;
  float s = 0.f;
#pragma unroll 8
  for (int i = 0; i < 256; ++i) s += bf2f(k[(i >> 5) * 2048 + (i & 31) * 8]);
  s *= (1.f / 256.f);
  const bf16_t hi = f2bf(s);
  bf16_t* km = (bf16_t*)(p.ws + O_KM);
  km[(hh * 32 + blk) * 64 + lane] = hi;
  km[6 * 32 * 64 + (hh * 32 + blk) * 64 + lane] = f2bf(s - bf2f(hi));
  const bf16_t* kc = (const bf16_t*)(p.ws + O_KFC) + (size_t)hh * 524288;
  float mx = 0.f;
#pragma unroll
  for (int t = 0; t < 4; ++t) {
    const int key = blk * 256 + lane * 4 + t;
    float kk = 0.f;
#pragma unroll
    for (int c = 0; c < 8; ++c) { float v[8]; unpk8(*(const bf16x8*)(kc + kfrag_key(key) + c * 256), v);
#pragma unroll
      for (int e = 0; e < 8; ++e) kk += v[e] * v[e]; }
    mx = fmaxf(mx, kk);
  }
#pragma unroll
  for (int o = 32; o >= 1; o >>= 1) mx = fmaxf(mx, __shfl_xor(mx, o));
  if (lane == 0) atomicMax(kmaxu + hh, __float_as_uint(mx));
}

DI void memkv_tile(const Params& p, int layer, int half, int mt, int nt, unsigned char* smem) {
  bf16_t* As = (bf16_t*)smem; bf16_t* Bs = As + 2 * 9216;
  f32x16 acc[2][2]; zero_acc(acc);
  PlainA al{(const bf16_t*)(p.ws + O_MEMN) + (size_t)half * 256 * 1024, 1024};
  const int m0 = mt * 128, n0 = nt * 128;
  gemm_kloop(al, (const bf16_t*)(p.ws + O_WTKV + layer * SZ_WTKV1), 1024, 16, m0, n0, acc, As, Bs);
  const int tid = otid(), lane = tid & 63, wave = tid >> 6, wr = wave >> 1, wc = wave & 1, r = lane & 31, h = lane >> 5;
  bf16_t* mk = (bf16_t*)(p.ws + O_MEMK); bf16_t* mv = (bf16_t*)(p.ws + O_MEMVT);
#pragma unroll
  for (int ni = 0; ni < 2; ++ni)
#pragma unroll
    for (int mi = 0; mi < 2; ++mi) {
      const int m = m0 + wr * 64 + mi * 32 + r;
#pragma unroll
      for (int i = 0; i < 16; ++i) {
        const int col = n0 + wc * 64 + ni * 32 + crow(i, h);
        const bf16_t b = f2bf(acc[mi][ni][i]);
        if (col < 384) { const int hd = col / 96, d = col % 96; mk[(size_t)((half * 4 + hd) * 8 + (m >> 5)) * 3072 + (d >> 4) * 512 + ((d >> 3) & 1) * 256 + (m & 31) * 8 + (d & 7)] = b; }
        else { const int cc = col - 384, hd = cc / 96, d = cc % 96, kk = m & 31;
          mv[(size_t)((half * 4 + hd) * 8 + (m >> 5)) * 3072 + (d >> 5) * 1024 + (kk >> 4) * 512 + ((kk >> 2) & 1) * 256 + (d & 31) * 8 + ((kk >> 3) & 1) * 4 + (kk & 3)] = b; }
      }
    }
}

DI f32x16 mm_quad(const bf16_t* A, const bf16_t* B, int wr, int wc, int r, int h) {
  f32x16 acc;
#pragma unroll
  for (int i = 0; i < 16; ++i) acc[i] = 0.f;
  const bf16_t* a_ = A + (wr * 32 + r) * 72 + 8 * h;
  const bf16_t* b_ = B + (wc * 32 + r) * 72 + 8 * h;
#pragma unroll
  for (int s = 0; s < 4; ++s) acc = MFMA32(*(const bf16x8*)(a_ + 16 * s), *(const bf16x8*)(b_ + 16 * s), acc);
  return acc;
}

DI void gdn_prep(const Params& p, int layer, int half, int hh, int c, unsigned char* smem) {
  bf16_t* QN = (bf16_t*)smem; bf16_t* KN = QN + 4608; bf16_t* KB = KN + 4608; bf16_t* KDT = KB + 4608; bf16_t* VBT = KDT + 4608;
  bf16_t* KBET = VBT + 4608; bf16_t* QKm = KBET + 4608; bf16_t* Tm = QKm + 4608;
  float* gcv = (float*)(smem + 73728); float* betav = gcv + 64; float* egc = gcv + 128;
  float* Mf = (float*)(smem + 9216);
  bf16_t* UT = KN; bf16_t* WT = KB;
  int tid = otid();
  int lane = tid & 63, wave = tid >> 6, wr = wave >> 1, wc = wave & 1, r = lane & 31, h = lane >> 5;
#define REOPAQUE() do { asm volatile("" : "+v"(tid)); lane = tid & 63; wave = tid >> 6; wr = wave >> 1; wc = wave & 1; r = lane & 31; h = lane >> 5; } while (0)
  const float* sm = (const float*)(p.ws + O_SM);
  if (wave == 0) {
    const int tok = c * 64 + lane;
    const float bt = fsigmoid(sm[tok * 32 + 6 + hh]);
    const float xv = sm[tok * 32 + 12 + hh] + p.dt_bias[layer * 6 + hh];
    const float sp = fmaxf(xv, 0.f) + log1pf(expf(-fabsf(xv)));
    float g = -expf(p.a_log[layer * 6 + hh]) * sp;
#pragma unroll
    for (int o = 1; o < 64; o <<= 1) { const float t = __shfl_up(g, o); if (lane >= o) g += t; }
    gcv[lane] = g; betav[lane] = bt; egc[lane] = expf(g);
    if (lane == 63) ((float*)(p.ws + O_GL))[hh * 128 + c] = expf(g);
  }
  sub_sync();
  REOPAQUE();
  {
    const int t = tid >> 2, cg4 = tid & 3, ch0 = cg4 * 16;
    const bf16_t* src = (const bf16_t*)(p.ws + O_QKVD);
    const float* cw = p.conv_w + (size_t)layer * 4 * 1152;
    const float bt = betav[t], gct = gcv[t], eg = egc[t], ed = expf(gcv[63] - gct);
    auto convpart = [&](int pt, float (&val)[16]) {
      const int col = pt * 384 + hh * 64 + ch0;
#pragma unroll
      for (int e = 0; e < 16; ++e) val[e] = 0.f;
#pragma unroll
      for (int j = 0; j < 4; ++j) {
        const int row = c * 64 + t - 3 + j;
        if (row >= 0) {
          float xv[16];
          unpk8(*(const bf16x8*)(src + (size_t)row * 1152 + col), xv);
          unpk8(*(const bf16x8*)(src + (size_t)row * 1152 + col + 8), xv + 8);
#pragma unroll
          for (int e4 = 0; e4 < 4; ++e4) {
            const f32x4 w4 = *(const f32x4*)(cw + j * 1152 + col + 4 * e4);
#pragma unroll
            for (int e = 0; e < 4; ++e) val[4 * e4 + e] += w4[e] * xv[4 * e4 + e];
          }
        }
      }
#pragma unroll
      for (int e = 0; e < 16; ++e) val[e] = fsilu(val[e]);
    };
    {
      float val[16]; convpart(0, val);
      float sq = 0.f;
#pragma unroll
      for (int e = 0; e < 16; ++e) sq += val[e] * val[e];
      sq += __shfl_xor(sq, 1); sq += __shfl_xor(sq, 2);
      const float rq = rsqrtf(sq + 1e-6f) * 0.125f;
#pragma unroll
      for (int e = 0; e < 16; ++e) val[e] *= rq;
      *(bf16x8*)(QN + t * 72 + ch0) = pk8(val); *(bf16x8*)(QN + t * 72 + ch0 + 8) = pk8(val + 8);
    }
    asm volatile("" ::: "memory");
    {
      float val[16]; convpart(1, val);
      float sk = 0.f;
#pragma unroll
      for (int e = 0; e < 16; ++e) sk += val[e] * val[e];
      sk += __shfl_xor(sk, 1); sk += __shfl_xor(sk, 2);
      const float rk = rsqrtf(sk + 1e-6f);
      float kb[16];
#pragma unroll
      for (int e = 0; e < 16; ++e) { val[e] *= rk; kb[e] = val[e] * bt; }
      *(bf16x8*)(KN + t * 72 + ch0) = pk8(val); *(bf16x8*)(KN + t * 72 + ch0 + 8) = pk8(val + 8);
      *(bf16x8*)(KB + t * 72 + ch0) = pk8(kb); *(bf16x8*)(KB + t * 72 + ch0 + 8) = pk8(kb + 8);
#pragma unroll
      for (int e = 0; e < 16; ++e) {
        KDT[(ch0 + e) * 72 + t] = f2bf(val[e] * ed);
        KBET[(ch0 + e) * 72 + t] = f2bf(kb[e] * eg);
      }
    }
    asm volatile("" ::: "memory");
    {
      float val[16]; convpart(2, val);
#pragma unroll
      for (int e = 0; e < 16; ++e) VBT[(ch0 + e) * 72 + t] = f2bf(val[e] * bt);
    }
  }
  sub_sync();
  REOPAQUE();
  {
    const f32x16 kk = mm_quad(KB, KN, wr, wc, r, h);
    const f32x16 qk = mm_quad(QN, KN, wr, wc, r, h);
    sub_sync();
    const int j = wc * 32 + r; const float gj = gcv[j];
#pragma unroll
    for (int i = 0; i < 16; ++i) {
      const int row = wr * 32 + crow(i, h);
      const float dec = (row >= j) ? expf(gcv[row] - gj) : 0.f;
      Mf[row * 68 + j] = (row > j) ? kk[i] * dec : 0.f;
      QKm[row * 72 + j] = f2bf(qk[i] * dec);
    }
  }
  sub_sync();
  REOPAQUE();
  if (wave == 0) {
    float t[64];
#pragma unroll
    for (int i = 0; i < 64; ++i) {
      float a4[4] = {(i == lane) ? 1.f : 0.f, 0.f, 0.f, 0.f};
#pragma unroll
      for (int j4 = 0; j4 < (i + 3) / 4; ++j4) {
        const f32x4 mrow = *(const f32x4*)(Mf + i * 68 + 4 * j4);
#pragma unroll
        for (int e = 0; e < 4; ++e) if (4 * j4 + e < i) a4[e] -= mrow[e] * t[4 * j4 + e];
      }
      const float a = (a4[0] + a4[1]) + (a4[2] + a4[3]);
      t[i] = a;
      Tm[i * 72 + lane] = f2bf(a);
      asm volatile("" ::: "memory");
    }
  }
  sub_sync();
  REOPAQUE();
  {
    const f32x16 u = mm_quad(Tm, VBT, wr, wc, r, h);
    const f32x16 w = mm_quad(Tm, KBET, wr, wc, r, h);
    const int col = wc * 32 + r;
#pragma unroll
    for (int g = 0; g < 4; ++g) {
      const int i0 = wr * 32 + 8 * g + 4 * h;
      *(u32x2*)(UT + col * 72 + i0) = pk4(u[4 * g], u[4 * g + 1], u[4 * g + 2], u[4 * g + 3]);
      *(u32x2*)(WT + col * 72 + i0) = pk4(w[4 * g], w[4 * g + 1], w[4 * g + 2], w[4 * g + 3]);
    }
  }
  sub_sync();
  REOPAQUE();
  {
    bf16_t* base = (bf16_t*)(p.ws + O_DPREP + (size_t)(hh * 128 + c) * 32768);
    const int n = wc * 32 + r;
    {
      const int ks = n >> 5, jh = (n >> 4) & 1, q = (n >> 2) & 3, jl = n & 3, jj = 4 * jh + jl;
      const int cbase = (ks * 64 + 16 * q) * 8 + jj;
      {
        const f32x16 P = mm_quad(KDT, WT, wr, wc, r, h);
#pragma unroll
        for (int i = 0; i < 16; ++i) {
          const int m = wr * 32 + crow(i, h);
          base[((m >> 4) * 128 + (m & 15)) * 8 + cbase] = f2bf(P[i]);
        }
      }
      asm volatile("" ::: "memory");
      {
        const f32x16 QW = mm_quad(QKm, WT, wr, wc, r, h);
#pragma unroll
        for (int i = 0; i < 16; ++i) {
          const int m = wr * 32 + crow(i, h);
          const float qd = bf2f(QN[m * 72 + n]) * egc[m];
          base[4096 + ((m >> 4) * 128 + (m & 15)) * 8 + cbase] = f2bf(qd - QW[i]);
        }
      }
      asm volatile("" ::: "memory");
    }
    const int jsl = n >> 4;
    {
      const f32x16 Bc = mm_quad(KDT, UT, wr, wc, r, h);
#pragma unroll
      for (int g = 0; g < 4; ++g) {
        const int row0 = wr * 32 + 8 * g + 4 * h;
        const int rt = row0 >> 4, lp = 16 * ((row0 >> 2) & 3) + (n & 15);
        *(u32x2*)(base + 8192 + ((jsl * 4 + rt) * 64 + lp) * 4) = pk4(Bc[4 * g], Bc[4 * g + 1], Bc[4 * g + 2], Bc[4 * g + 3]);
      }
    }
    asm volatile("" ::: "memory");
    {
      const f32x16 O0 = mm_quad(QKm, UT, wr, wc, r, h);
#pragma unroll
      for (int g = 0; g < 4; ++g) {
        const int row0 = wr * 32 + 8 * g + 4 * h;
        const int rt = row0 >> 4, lp = 16 * ((row0 >> 2) & 3) + (n & 15);
        *(u32x2*)(base + 12288 + ((jsl * 4 + rt) * 64 + lp) * 4) = pk4(O0[4 * g], O0[4 * g + 1], O0[4 * g + 2], O0[4 * g + 3]);
      }
    }
  }
  sub_sync();
#undef REOPAQUE
}

struct TileDesc { const bf16_t* k; const bf16_t* v; const float* aux; int tag; };

template <int DHT, bool AUX>
struct TileRegs { bf16x8 k[DHT / 16]; bf16x8 v[DHT / 32][2]; f32x4 a[4]; };

template <int DHT, bool AUX>
DI void load_tile(const bf16_t* kp, const bf16_t* vp, const float* ap, long ldv, TileRegs<DHT, AUX>& t) {
#pragma unroll
  for (int s = 0; s < DHT / 16; ++s) t.k[s] = *(const bf16x8*)(kp + 512 * s);
#pragma unroll
  for (int dt = 0; dt < DHT / 32; ++dt)
#pragma unroll
    for (int s = 0; s < 2; ++s) t.v[dt][s] = *(const bf16x8*)(vp + (dt * 2 + s) * 512);
  if (AUX) {
#pragma unroll
    for (int g = 0; g < 4; ++g) t.a[g] = *(const f32x4*)(ap + 8 * g);
  }
}

template <int DHT, bool AUX, class TF, class MF, class SF>
DI void attn_loop(int maxtiles, TF&& tf, MF&& mf, SF&& stopf, const bf16x8 (&qf)[DHT / 16], long ldv, float scale2,
                  f32x16 (&o)[DHT / 32], float& m, float& l) {
  TileRegs<DHT, AUX> cur, nxt;
  int tagc, tagn;
  bf16x8 qf0 = qf[0];
  { const bf16_t* kp; const bf16_t* vp; const float* ap = nullptr; tagc = tf(0, kp, vp, ap); load_tile<DHT, AUX>(kp, vp, ap, ldv, cur); }
#pragma unroll 1
  for (int t = 0; t < maxtiles; ++t) {
    { const bf16_t* kp; const bf16_t* vp; const float* ap = nullptr; tagn = tf(t + 1, kp, vp, ap); load_tile<DHT, AUX>(kp, vp, ap, ldv, nxt); }
    { bf16x8 q0 = qf[0]; asm volatile("" : "+v"(q0) :: "memory"); qf0 = q0; }
    f32x16 sacc;
#pragma unroll
    for (int i = 0; i < 16; ++i) sacc[i] = 0.f;
#pragma unroll
    for (int s = 0; s < DHT / 16; ++s) sacc = MFMA32(cur.k[s], s == 0 ? qf0 : qf[s], sacc);
    float sv[16]; float mx = NEG_INF;
#pragma unroll
    for (int i = 0; i < 16; ++i) { sv[i] = sacc[i] * scale2 + mf(tagc, i, AUX ? cur.a[i >> 2][i & 3] : 0.f); mx = fmaxf(mx, sv[i]); }
    mx = fmaxf(mx, __shfl_xor(mx, 32));
    const float mnew = fmaxf(m, mx);
    const float alpha = __builtin_amdgcn_exp2f(m - mnew);
    m = mnew;
    float pv[16]; float ps = 0.f;
#pragma unroll
    for (int i = 0; i < 16; ++i) { pv[i] = __builtin_amdgcn_exp2f(sv[i] - mnew); ps += pv[i]; }
    l = l * alpha + ps;
#pragma unroll
    for (int dt = 0; dt < DHT / 32; ++dt)
#pragma unroll
      for (int i = 0; i < 16; ++i) o[dt][i] *= alpha;
    bf16x8 pf[2]; pf[0] = pk8(pv); pf[1] = pk8(pv + 8);
#pragma unroll
    for (int dt = 0; dt < DHT / 32; ++dt)
#pragma unroll
      for (int s = 0; s < 2; ++s) {
        o[dt] = MFMA32(cur.v[dt][s], pf[s], o[dt]);
      }
    if (stopf(t, m, AUX ? cur.a[0][0] : 0.f)) break;
    cur = nxt; tagc = tagn;
  }
}

template <int DHT>
DI void attn_store(const f32x16 (&o)[DHT / 32], float l, bf16_t* dstrow, int h, float& ltot_out, bool valid = true) {
  const float ltot = l + __shfl_xor(l, 32);
  ltot_out = ltot;
  const float inv = ltot > 0.f ? 1.f / ltot : 0.f;
  if (valid)
#pragma unroll
  for (int dt = 0; dt < DHT / 32; ++dt)
#pragma unroll
    for (int g = 0; g < 4; ++g)
      *(u32x2*)(dstrow + dt * 32 + 8 * g + 4 * h) = pk4(o[dt][4 * g] * inv, o[dt][4 * g + 1] * inv, o[dt][4 * g + 2] * inv, o[dt][4 * g + 3] * inv);
}

template <int DHT>
DI void attn_store_gated(const f32x16 (&o)[DHT / 32], float l, bf16_t* szrow, int h) {
  const float ltot = l + __shfl_xor(l, 32);
  const float inv = ltot > 0.f ? 1.f / ltot : 0.f;
#pragma unroll
  for (int dt = 0; dt < DHT / 32; ++dt)
#pragma unroll
    for (int g = 0; g < 4; ++g) {
      bf16_t* q = szrow + dt * 32 + 8 * g + 4 * h;
      const u32x2 z = *(const u32x2*)q;
      *(u32x2*)q = pk4(o[dt][4 * g] * inv * bflo(z.x), o[dt][4 * g + 1] * inv * bfhi(z.x), o[dt][4 * g + 2] * inv * bflo(z.y), o[dt][4 * g + 3] * inv * bfhi(z.y));
    }
}

template <int N>
DI void zero_o(f32x16 (&o)[N]) {
#pragma unroll
  for (int a = 0; a < N; ++a)
#pragma unroll
    for (int i = 0; i < 16; ++i) o[a][i] = 0.f;
}

DI void top3_insert(float v, int n, float& v0, float& v1, float& v2, int& i0, int& i1, int& i2) {
  const bool g0 = v > v0, g1 = v > v1, g2 = v > v2;
  v2 = g1 ? v1 : (g2 ? v : v2); i2 = g1 ? i1 : (g2 ? n : i2);
  v1 = g0 ? v0 : (g1 ? v : v1); i1 = g0 ? i0 : (g1 ? n : i1);
  v0 = g0 ? v : v0;             i0 = g0 ? n : i0;
}

DI void moba_select(const Params& p, int a) {
  const int lane = otid() & 63, r = lane & 31, h = lane >> 5;
  const int qtile = a / 6, hh = a % 6, qb = qtile >> 3;
  unsigned mask = 0;
  if (qb > 0) {
    const bf16_t* qrow = (const bf16_t*)(p.ws + O_QKA) + (size_t)(qtile * 32 + r) * 384 + hh * 64 + 8 * h;
    bf16x8 qf[4];
#pragma unroll
    for (int s = 0; s < 4; ++s) qf[s] = *(const bf16x8*)(qrow + 16 * s);
    const float* ks0 = (const float*)(p.ws + O_KSUM) + (size_t)(r * 2) * 384 + hh * 64 + 8 * h;
    f32x16 g;
#pragma unroll
    for (int i = 0; i < 16; ++i) g[i] = 0.f;
#pragma unroll
    for (int s = 0; s < 4; ++s) {
      const f32x4 a0 = *(const f32x4*)(ks0 + 16 * s), a1 = *(const f32x4*)(ks0 + 16 * s + 4);
      const f32x4 b0 = *(const f32x4*)(ks0 + 384 + 16 * s), b1 = *(const f32x4*)(ks0 + 384 + 16 * s + 4);
      float hi[8], lo[8];
#pragma unroll
      for (int e = 0; e < 4; ++e) {
        const float m0 = (a0[e] + b0[e]) * (1.f / 256.f), m1 = (a1[e] + b1[e]) * (1.f / 256.f);
        hi[e] = bf2f(f2bf(m0)); lo[e] = m0 - hi[e];
        hi[4 + e] = bf2f(f2bf(m1)); lo[4 + e] = m1 - hi[4 + e];
      }
      g = MFMA32(pk8(hi), qf[s], g); g = MFMA32(pk8(lo), qf[s], g);
    }
    float v0 = NEG_INF, v1 = NEG_INF, v2 = NEG_INF; int i0 = -1, i1 = -1, i2 = -1;
#pragma unroll
    for (int i = 0; i < 16; ++i) { const int n = crow(i, h); if (n < qb) top3_insert(g[i], n, v0, v1, v2, i0, i1, i2); }
    const float pv0 = __shfl_xor(v0, 32), pv1 = __shfl_xor(v1, 32), pv2 = __shfl_xor(v2, 32);
    const int pi0 = __shfl_xor(i0, 32), pi1 = __shfl_xor(i1, 32), pi2 = __shfl_xor(i2, 32);
    if (pi0 >= 0) top3_insert(pv0, pi0, v0, v1, v2, i0, i1, i2);
    if (pi1 >= 0) top3_insert(pv1, pi1, v0, v1, v2, i0, i1, i2);
    if (pi2 >= 0) top3_insert(pv2, pi2, v0, v1, v2, i0, i1, i2);
    if (i0 >= 0) mask |= 1u << i0;
    if (i1 >= 0) mask |= 1u << i1;
    if (i2 >= 0) mask |= 1u << i2;
  }
  if (h == 0) ((unsigned*)(p.ws + O_MASK))[(qtile * 32 + r) * 8 + hh] = mask;
}

DI void moba_gather(const Params& p, int a, unsigned char* smem) {
  const int tid = otid(), lane = tid & 63, wave = tid >> 6, r = lane & 31, h = lane >> 5;
  const int part = a & 1, a2 = a >> 1;
  const int hh = a2 % 6, idx = a2 / 6;
  int qb = 1;
  while ((qb + 1) * qb / 2 <= idx) ++qb;
  const int n = idx - qb * (qb - 1) / 2;
  const unsigned* MASK = (const unsigned*)(p.ws + O_MASK);
  unsigned* list = (unsigned*)(smem + wave * 1024);
  int cnt = 0;
#pragma unroll
  for (int j = 0; j < 4; ++j) {
    const int qi = j * 64 + lane;
    const unsigned mk = MASK[(qb * 256 + qi) * 8 + hh];
    const bool pred = (mk >> n) & 1u;
    const unsigned long long ball = __ballot(pred);
    const int pos = cnt + __builtin_popcountll(ball & ((1ull << lane) - 1ull));
    if (pred) list[pos] = (unsigned)qi | ((unsigned)__builtin_popcount(mk & ((1u << n) - 1u)) << 8);
    cnt += __builtin_popcountll(ball);
  }
  cnt = __builtin_amdgcn_readfirstlane(cnt);
  if (cnt == 0) return;
  asm volatile("s_waitcnt lgkmcnt(0)" ::: "memory");
  __builtin_amdgcn_wave_barrier();
  const bf16_t* QK = (const bf16_t*)(p.ws + O_QKA);
  const bf16_t* KF = (const bf16_t*)(p.ws + O_KFA) + (size_t)hh * 524288 + (size_t)n * 8 * 2048 + lane * 8;
  const bf16_t* VT = (const bf16_t*)(p.ws + O_VTA) + (size_t)hh * 524288 + (size_t)n * 8 * 2048 + lane * 8;
  const int nch = (cnt + 31) >> 5;
#pragma unroll 1
  for (int c = part; c < nch; c += 2) {
    const int e = c * 32 + r;
    const bool valid = e < cnt;
    const unsigned ent = list[valid ? e : 0];
    const int tok = qb * 256 + (int)(ent & 255u), slot = (int)(ent >> 8);
    bf16x8 qf[4];
    { const bf16_t* qrow = QK + (size_t)tok * 384 + hh * 64 + 8 * h;
#pragma unroll
      for (int s = 0; s < 4; ++s) qf[s] = *(const bf16x8*)(qrow + 16 * s); }
    auto tf = [&](int t, const bf16_t*& kp, const bf16_t*& vp, const float*&) -> int {
      const int tt = t < 7 ? t : 7;
      kp = KF + tt * 2048; vp = VT + tt * 2048;
      return 0;
    };
    auto mf = [&](int, int, float) -> float { return 0.f; };
    auto sf = [&](int, float, float) { return false; };
    f32x16 o[2]; zero_o(o); float m = -1e30f, l = 0.f;
    int nt8 = 8; asm volatile("" : "+s"(nt8));
    attn_loop<64, false>(nt8, tf, mf, sf, qf, (long)TH, 0.125f * LOG2E, o, m, l);
    float lt;
    attn_store<64>(o, l, (bf16_t*)(p.ws + O_OA + slot * SZ_O) + (size_t)tok * 384 + hh * 64, h, lt, valid);
    if (valid && h == 0) { float* st = (float*)(p.ws + O_STA) + ((size_t)(slot * TH + tok) * 6 + hh) * 2; st[0] = m; st[1] = lt; }
  }
}

DI void moba_own(const Params& p, int a) {
  const int lane = otid() & 63, r = lane & 31, h = lane >> 5;
  const int qtile = 255 - a / 6, hh = a % 6, qb = qtile >> 3, own = qtile & 7;
  const bf16_t* QK = (const bf16_t*)(p.ws + O_QKA);
  const bf16_t* KF = (const bf16_t*)(p.ws + O_KFA) + (size_t)hh * 524288 + (size_t)qb * 8 * 2048 + lane * 8;
  const bf16_t* VT = (const bf16_t*)(p.ws + O_VTA) + (size_t)hh * 524288 + (size_t)qb * 8 * 2048 + lane * 8;
  const int tok = qtile * 32 + r;
  bf16x8 qf[4];
  { const bf16_t* qrow = QK + (size_t)tok * 384 + hh * 64 + 8 * h;
#pragma unroll
    for (int s = 0; s < 4; ++s) qf[s] = *(const bf16x8*)(qrow + 16 * s); }
  auto tf = [&](int t, const bf16_t*& kp, const bf16_t*& vp, const float*&) -> int {
    const int kk = t < own ? t : own;
    kp = KF + kk * 2048; vp = VT + kk * 2048;
    return (kk == own) ? 101 : 100;
  };
  auto mf = [&](int tag, int i, float) -> float {
    if (tag == 100) return 0.f;
    return (crow(i, h) <= r) ? 0.f : NEG_INF;
  };
  auto sf = [&](int, float, float) { return false; };
  f32x16 o[2]; zero_o(o); float m = -1e30f, l = 0.f;
  attn_loop<64, false>(own + 1, tf, mf, sf, qf, (long)TH, 0.125f * LOG2E, o, m, l);
  float lt;
  attn_store<64>(o, l, (bf16_t*)(p.ws + O_OA + 3 * SZ_O) + (size_t)tok * 384 + hh * 64, h, lt);
  if (h == 0) {
    float* st = (float*)(p.ws + O_STA);
    st[((size_t)(3 * TH + tok) * 6 + hh) * 2] = m; st[((size_t)(3 * TH + tok) * 6 + hh) * 2 + 1] = lt;
    const int np = __builtin_popcount(((const unsigned*)(p.ws + O_MASK))[tok * 8 + hh]);
    for (int sl = np; sl < 3; ++sl) { st[((size_t)(sl * TH + tok) * 6 + hh) * 2] = -1e30f; st[((size_t)(sl * TH + tok) * 6 + hh) * 2 + 1] = 0.f; }
  }
}

DI void fox_item(const Params& p, int c, const unsigned* kmaxu) {
  const int lane = otid() & 63, r = lane & 31, h = lane >> 5;
  const int qtile = 255 - c / 6, hh = c % 6;
  const bf16_t* QK = (const bf16_t*)(p.ws + O_QKC);
  const bf16_t* KF = (const bf16_t*)(p.ws + O_KFC);
  const bf16_t* VT = (const bf16_t*)(p.ws + O_VTC);
  const float* FF = (const float*)(p.ws + O_FF) + hh * TH;
  bf16x8 qf[4]; float qn2 = 0.f;
  { const bf16_t* qrow = QK + (size_t)(qtile * 32 + r) * 384 + hh * 64 + 8 * h;
#pragma unroll
    for (int s = 0; s < 4; ++s) { qf[s] = *(const bf16x8*)(qrow + 16 * s); float v[8]; unpk8(qf[s], v);
#pragma unroll
      for (int e = 0; e < 8; ++e) qn2 += v[e] * v[e]; } }
  qn2 += __shfl_xor(qn2, 32);
#pragma unroll
  for (int o = 16; o >= 1; o >>= 1) qn2 = fmaxf(qn2, __shfl_xor(qn2, o));
  const float Fq = FF[qtile * 32 + r];
  const float Ffirst = FF[qtile * 32];
  const float kmaxn = sqrtf(__uint_as_float(kmaxu[hh]));
  const float bound = sqrtf(qn2) * kmaxn * 0.125f + Ffirst;
  auto tf = [&](int t, const bf16_t*& kp, const bf16_t*& vp, const float*& ap) -> int {
    const int keybase = (qtile - t > 0 ? qtile - t : 0) * 32;
    kp = KF + (size_t)hh * 524288 + (keybase >> 5) * 2048 + lane * 8;
    vp = VT + (size_t)hh * 524288 + (keybase >> 5) * 2048 + lane * 8;
    ap = FF + keybase + 4 * h;
    return (t == 0) ? 1 : 0;
  };
  auto mf = [&](int tag, int i, float fk) -> float {
    const float b = (Fq - fk) * LOG2E;
    return (tag == 1 && crow(i, h) > r) ? NEG_INF : b;
  };
  auto sf = [&](int, float m, float a0) {
    const float fkb = __builtin_bit_cast(float, __builtin_amdgcn_readfirstlane(__builtin_bit_cast(int, a0)));
    float mm = m;
#pragma unroll
    for (int o = 16; o >= 1; o >>= 1) mm = fminf(mm, __shfl_xor(mm, o));
    return (bound - fkb) * LOG2E < mm - 45.f;
  };
  f32x16 o[2]; zero_o(o); float m = -1e30f, l = 0.f;
  attn_loop<64, true>(qtile + 1, tf, mf, sf, qf, (long)TH, 0.125f * LOG2E, o, m, l);
  float lt;
  attn_store_gated<64>(o, l, (bf16_t*)(p.ws + O_SZ) + (size_t)(qtile * 32 + r) * 1920 + 2 * 384 + hh * 64, h);
}

DI void dil_item(const Params& p, int idx) {
  const int lane = otid() & 63, r = lane & 31, h = lane >> 5;
  const int g = idx / 1536, rem = idx % 1536, hh = rem / 256, w = rem % 256;
  const int dsh = 2 * g;
  const int dil = 1 << dsh, L = TH >> dsh, tps = L / 32;
  const int rs = w / tps, lt_ = w % tps, l0 = lt_ * 32;
  const bf16_t* QK = (const bf16_t*)(p.ws + O_QKB);
  const bf16_t* KF = (const bf16_t*)(p.ws + O_KFB + g * SZ_VT);
  const bf16_t* VT = (const bf16_t*)(p.ws + O_VTB + g * SZ_VT);
  const int tq = (l0 + r) * dil + rs;
  bf16x8 qf[4];
  { const bf16_t* qrow = QK + (size_t)tq * 1152 + g * 384 + hh * 64 + 8 * h;
#pragma unroll
    for (int s = 0; s < 4; ++s) qf[s] = *(const bf16x8*)(qrow + 16 * s); }
  const int t0 = (l0 >= 128) ? 0 : (128 - l0) / 32;
  auto tf = [&](int tt, const bf16_t*& kp, const bf16_t*& vp, const float*&) -> int {
    const int t = (t0 + tt < 4) ? t0 + tt : 4; const int keybase = l0 - 128 + 32 * t;
    kp = KF + (size_t)hh * 524288 + ((rs * L + keybase) >> 5) * 2048 + lane * 8;
    vp = VT + (size_t)hh * 524288 + ((rs * L + keybase) >> 5) * 2048 + lane * 8;
    return t;
  };
  auto mf = [&](int tag, int i, float) -> float {
    const int kj = crow(i, h);
    if (tag == 0) return (kj >= r) ? 0.f : NEG_INF;
    if (tag == 4) return (kj <= r) ? 0.f : NEG_INF;
    return 0.f;
  };
  auto sf = [&](int, float, float) { return false; };
  f32x16 o[2]; zero_o(o); float m = -1e30f, l = 0.f;
  attn_loop<64, false>(5 - t0, tf, mf, sf, qf, (long)TH, 0.125f * LOG2E, o, m, l);
  float lt;
  attn_store<64>(o, l, (bf16_t*)(p.ws + O_OB + g * SZ_O) + (size_t)tq * 384 + hh * 64, h, lt);
  if (h == 0) { float* st = (float*)(p.ws + O_STB) + ((size_t)(g * TH + tq) * 6 + hh) * 2; st[0] = m; st[1] = lt; }
}

DI void mem_item(const Params& p, int half, int e) {
  const int lane = otid() & 63, r = lane & 31, h = lane >> 5;
  const int hd = e & 3, qtile = e >> 2;
  const bf16_t* QE = (const bf16_t*)(p.ws + O_QE);
  const bf16_t* MK = (const bf16_t*)(p.ws + O_MEMK);
  const bf16_t* MV = (const bf16_t*)(p.ws + O_MEMVT);
  bf16x8 qf[6];
  { const bf16_t* qrow = QE + (size_t)(qtile * 32 + r) * 384 + hd * 96 + 8 * h;
#pragma unroll
    for (int s = 0; s < 6; ++s) qf[s] = *(const bf16x8*)(qrow + 16 * s); }
  auto tf = [&](int t, const bf16_t*& kp, const bf16_t*& vp, const float*&) -> int {
    const int keybase = 32 * (t < 7 ? t : 7);
    kp = MK + (size_t)((half * 4 + hd) * 8 + (keybase >> 5)) * 3072 + lane * 8;
    vp = MV + (size_t)((half * 4 + hd) * 8 + (keybase >> 5)) * 3072 + lane * 8;
    return 0;
  };
  auto mf = [&](int, int, float) -> float { return 0.f; };
  auto sf = [&](int, float, float) { return false; };
  f32x16 o[3]; zero_o(o); float m = -1e30f, l = 0.f;
  attn_loop<96, false>(8, tf, mf, sf, qf, 256L, 0.10206207261596577f * LOG2E, o, m, l);
  float lt;
  attn_store_gated<96>(o, l, (bf16_t*)(p.ws + O_SZ) + (size_t)(qtile * 32 + r) * 1920 + 4 * 384 + hd * 96, h);
}

DI float dpp_ror(float v, int ctrl);
DI float row16_sum(float v) {
  v += __builtin_bit_cast(float, __builtin_amdgcn_update_dpp(0, __builtin_bit_cast(int, v), 0x128, 0xf, 0xf, false));
  v += __builtin_bit_cast(float, __builtin_amdgcn_update_dpp(0, __builtin_bit_cast(int, v), 0x124, 0xf, 0xf, false));
  v += __builtin_bit_cast(float, __builtin_amdgcn_update_dpp(0, __builtin_bit_cast(int, v), 0x122, 0xf, 0xf, false));
  v += __builtin_bit_cast(float, __builtin_amdgcn_update_dpp(0, __builtin_bit_cast(int, v), 0x121, 0xf, 0xf, false));
  return v;
}

struct ScanRegs { bf16x8 pf[4][2]; bf16x8 qe[4][2]; s16x4 bc[4]; s16x4 o0[4]; float gl; };
DI void scan_load(const Params& p, int hh, int j, int c, int lane, ScanRegs& s) {
  const unsigned char* base = p.ws + O_DPREP + (size_t)(hh * 128 + c) * 32768;
#pragma unroll
  for (int mt = 0; mt < 4; ++mt)
#pragma unroll
    for (int ks = 0; ks < 2; ++ks) {
      s.pf[mt][ks] = *(const bf16x8*)(base + ((mt * 2 + ks) * 64 + lane) * 16);
      s.qe[mt][ks] = *(const bf16x8*)(base + 8192 + ((mt * 2 + ks) * 64 + lane) * 16);
    }
#pragma unroll
  for (int rt = 0; rt < 4; ++rt) {
    s.bc[rt] = *(const s16x4*)(base + 16384 + ((j * 4 + rt) * 64 + lane) * 8);
    s.o0[rt] = *(const s16x4*)(base + 24576 + ((j * 4 + rt) * 64 + lane) * 8);
  }
  s.gl = ((const float*)(p.ws + O_GL))[hh * 128 + c];
}
DI f32x4 s4f(s16x4 v) { u32x2 u = __builtin_bit_cast(u32x2, v); f32x4 r; r[0] = bflo(u.x); r[1] = bfhi(u.x); r[2] = bflo(u.y); r[3] = bfhi(u.y); return r; }

DI void scan_item(const Params& p, int it) {
  const int lane = otid() & 63, q = lane >> 4, cl = lane & 15;
  const int hh = it >> 2, j = it & 3;
  f32x4 S[4];
#pragma unroll
  for (int rt = 0; rt < 4; ++rt) S[rt] = (f32x4){0.f, 0.f, 0.f, 0.f};
  bf16_t* OD = (bf16_t*)(p.ws + O_OD);
  float* SSQ = (float*)(p.ws + O_SSQ);
#ifndef SCAN_PREFETCH
#define SCAN_PREFETCH 1
#endif
  ScanRegs cur, nxt;
  if (SCAN_PREFETCH) scan_load(p, hh, j, 0, lane, cur);
  for (int c = 0; c < 128; ++c) {
    if (SCAN_PREFETCH) {
      scan_load(p, hh, j, (c + 1 < 128) ? c + 1 : c, lane, nxt);
      asm volatile("" : "+v"(S[0][0]) :: "memory");
    } else {
      scan_load(p, hh, j, c, lane, cur);
    }
    bf16x8 bfr[2];
#pragma unroll
    for (int ks = 0; ks < 2; ++ks) {
      u32x4 u; u.x = pk2(S[2 * ks][0], S[2 * ks][1]); u.y = pk2(S[2 * ks][2], S[2 * ks][3]); u.z = pk2(S[2 * ks + 1][0], S[2 * ks + 1][1]); u.w = pk2(S[2 * ks + 1][2], S[2 * ks + 1][3]);
      bfr[ks] = __builtin_bit_cast(bf16x8, u);
    }
    f32x4 aP[4], aO[4];
#pragma unroll
    for (int rt = 0; rt < 4; ++rt) {
      aP[rt] = (f32x4){0.f, 0.f, 0.f, 0.f};
      aO[rt] = s4f(cur.o0[rt]);
#pragma unroll
      for (int ks = 0; ks < 2; ++ks) { aP[rt] = MFMA16(cur.pf[rt][ks], bfr[ks], aP[rt]); aO[rt] = MFMA16(cur.qe[rt][ks], bfr[ks], aO[rt]); }
    }
#pragma unroll
    for (int rt = 0; rt < 4; ++rt) S[rt] = S[rt] * cur.gl - aP[rt] + s4f(cur.bc[rt]);
#pragma unroll
    for (int rt = 0; rt < 4; ++rt)
#pragma unroll
      for (int e = 0; e < 4; ++e) {
        const int tok = c * 64 + 16 * rt + 4 * q + e;
        const float v = aO[rt][e];
        OD[(size_t)tok * 384 + hh * 64 + 16 * j + cl] = f2bf(v);
        const float ss = row16_sum(v * v);
        if (cl == 0) SSQ[(tok * 6 + hh) * 4 + j] = ss;
      }
    if (SCAN_PREFETCH) cur = nxt;
  }
}

DI void scan_block(const Params& p, int hh, unsigned char* smem) {
  const int tid = otid(), lane = tid & 63, j = tid >> 6, q = lane >> 4, cl = lane & 15;
  const unsigned char* src = p.ws + O_DPREP + (size_t)hh * 128 * 32768;
  bf16_t* ostg = (bf16_t*)(smem + 65536);
  bf16x8 R0[8], R1[8];
  auto gld = [&](int c, bf16x8 (&R)[8]) {
    c = c < 128 ? c : 127;
    const unsigned char* b = src + (size_t)c * 32768 + tid * 16;
#pragma unroll
    for (int i = 0; i < 8; ++i) R[i] = *(const bf16x8*)(b + i * 4096);
  };
  auto lst = [&](int buf, const bf16x8 (&R)[8]) {
    unsigned char* d = smem + buf * 32768 + tid * 16;
#pragma unroll
    for (int i = 0; i < 8; ++i) *(bf16x8*)(d + i * 4096) = R[i];
  };
  const float* GL = (const float*)(p.ws + O_GL) + hh * 128;
  const float gl_lo = GL[lane], gl_hi = GL[64 + lane];
  f32x4 S[4];
#pragma unroll
  for (int rt = 0; rt < 4; ++rt) S[rt] = (f32x4){0.f, 0.f, 0.f, 0.f};
  bf16_t* OD = (bf16_t*)(p.ws + O_OD);
  float* SSQ = (float*)(p.ws + O_SSQ);
  f32x4 aO[4];
  auto flush = [&](int cp) {
    const int row = tid >> 2, part = tid & 3;
    const bf16x8 v0 = *(const bf16x8*)(ostg + row * 72 + 16 * part), v1 = *(const bf16x8*)(ostg + row * 72 + 16 * part + 8);
    float f[16]; unpk8(v0, f); unpk8(v1, f + 8);
    float ss = 0.f;
#pragma unroll
    for (int e = 0; e < 16; ++e) ss += f[e] * f[e];
    const int tok = cp * 64 + row;
    bf16_t* dst = OD + (size_t)tok * 384 + hh * 64 + 16 * part;
    *(bf16x8*)dst = v0; *(bf16x8*)(dst + 8) = v1;
    SSQ[(tok * 6 + hh) * 4 + part] = ss;
  };
  auto compute = [&](int buf, int c) {
    const unsigned char* base = smem + buf * 32768;
    const float gl = __builtin_bit_cast(float, __builtin_amdgcn_readlane(__builtin_bit_cast(int, c < 64 ? gl_lo : gl_hi), c & 63));
    bf16x8 bfr[2];
#pragma unroll
    for (int ks = 0; ks < 2; ++ks) {
      u32x4 u; u.x = pk2(S[2 * ks][0], S[2 * ks][1]); u.y = pk2(S[2 * ks][2], S[2 * ks][3]); u.z = pk2(S[2 * ks + 1][0], S[2 * ks + 1][1]); u.w = pk2(S[2 * ks + 1][2], S[2 * ks + 1][3]);
      bfr[ks] = __builtin_bit_cast(bf16x8, u);
    }
    f32x4 aP[4];
#pragma unroll
    for (int rt = 0; rt < 4; ++rt) {
      aP[rt] = (f32x4){0.f, 0.f, 0.f, 0.f};
      aO[rt] = s4f(*(const s16x4*)(base + 24576 + ((j * 4 + rt) * 64 + lane) * 8));
#pragma unroll
      for (int ks = 0; ks < 2; ++ks) {
        aP[rt] = MFMA16(*(const bf16x8*)(base + ((rt * 2 + ks) * 64 + lane) * 16), bfr[ks], aP[rt]);
        aO[rt] = MFMA16(*(const bf16x8*)(base + 8192 + ((rt * 2 + ks) * 64 + lane) * 16), bfr[ks], aO[rt]);
      }
    }
#pragma unroll
    for (int rt = 0; rt < 4; ++rt) S[rt] = S[rt] * gl - aP[rt] + s4f(*(const s16x4*)(base + 16384 + ((j * 4 + rt) * 64 + lane) * 8));
  };
  auto stage_out = [&]() {
#pragma unroll
    for (int rt = 0; rt < 4; ++rt)
#pragma unroll
      for (int e = 0; e < 4; ++e) ostg[(16 * rt + 4 * q + e) * 72 + 16 * j + cl] = f2bf(aO[rt][e]);
  };
  __builtin_amdgcn_s_setprio(3);
  gld(0, R0); gld(1, R1);
  lst(0, R0); gld(2, R0);
  sub_sync();
#pragma unroll 1
  for (int c = 0; c < 128; c += 2) {
    lst(1, R1);
    gld(c + 3, R1);
    if (c > 0) flush(c - 1);
    compute(0, c);
    sub_sync();
    stage_out();
    sub_sync();
    lst(0, R0);
    gld(c + 4, R0);
    flush(c);
    compute(1, c + 1);
    sub_sync();
    stage_out();
    sub_sync();
  }
  flush(127);
  sub_sync();
  __builtin_amdgcn_s_setprio(0);
}

DI void phase3(const Params& p, int half, unsigned* ctr, const unsigned* kmaxu, unsigned char* smem, int sub, int limit = 1 << 30) {
  const int tid = otid(), wave = tid >> 6;
  const int hb = (int)blockIdx.x, x = hb & 7, bi = hb >> 3;
  if (hb < 3 && limit >= 0) { if (PH(5)) scan_block(p, hb * 2 + sub, smem); }
  if (bi >= 1 && limit != 0) {
    const int nlw = ((int)(gridDim.x >> 3) - 1) * 8, lw = ((bi - 1) * 2 + sub) * 4 + wave;
    if (x < 6) {
      const int hh = x;
      constexpr int NG = 992, NOWN = 256, NB_ = 640, NTOT = NG + NOWN + NB_;
      for (int pos0 = lw; pos0 < NTOT; pos0 += nlw) {
        int pos = __builtin_amdgcn_readfirstlane(pos0);
        if (pos < NG) { if (PH(6)) moba_gather(p, (((pos >> 1) * 6 + hh) << 1) | (pos & 1), smem); continue; }
        pos -= NG;
        if (pos < NOWN) { if (PH(6)) moba_own(p, pos * 6 + hh); continue; }
        pos -= NOWN;
        const int g = pos < 512 ? (pos >> 8) : 2, w = pos < 512 ? (pos & 255) : 2 * (pos - 512);
        if (PH(8)) dil_item(p, g * 1536 + hh * 256 + w);
      }
    } else {
      const int h0 = (x - 6) * 3;
      constexpr int NE = 512, NC = 768, NB2 = 384, NTOT = NE + NC + NB2;
      for (int pos0 = lw; pos0 < NTOT; pos0 += nlw) {
        int pos = __builtin_amdgcn_readfirstlane(pos0);
        if (pos < NE) { if (PH(7)) mem_item(p, half, (x - 6) * 512 + pos); continue; }
        pos -= NE;
        if (pos < NC) { if (PH(9)) fox_item(p, (pos & 255) * 6 + h0 + (pos >> 8), kmaxu); continue; }
        pos -= NC;
        if (PH(8)) dil_item(p, 2 * 1536 + (h0 + (pos >> 7)) * 256 + 2 * (pos & 127) + 1);
      }
    }
  }
}

DI void gbuild_chunk(const Params& p, int layer, int tok, int c8) {
  const unsigned char* ws = p.ws;
  const int n = c8 / 48, c = (c8 % 48) * 8;
  if (n == 2 || n == 4) return;
  bf16_t* szp = (bf16_t*)(p.ws + O_SZ) + (size_t)tok * 1920 + n * 384 + c;
  float o[8], z[8];
  unpk8(*(const bf16x8*)szp, z);
  if (n == 1) {
    const int hh = c >> 6;
    const float* st = (const float*)(ws + O_STB);
    float mg[3], lg[3];
#pragma unroll
    for (int g = 0; g < 3; ++g) { const f32x2 s2 = *(const f32x2*)(st + ((size_t)(g * TH + tok) * 6 + hh) * 2); mg[g] = s2[0]; lg[g] = s2[1]; }
    const float mm = fmaxf(mg[0], fmaxf(mg[1], mg[2]));
    float wg[3], ws_ = 0.f;
#pragma unroll
    for (int g = 0; g < 3; ++g) { wg[g] = exp2f(mg[g] - mm) * lg[g]; ws_ += wg[g]; }
    const float inv = 1.f / ws_;
#pragma unroll
    for (int e = 0; e < 8; ++e) o[e] = 0.f;
#pragma unroll
    for (int g = 0; g < 3; ++g) {
      float t[8]; unpk8(*(const bf16x8*)((const bf16_t*)(ws + O_OB + g * SZ_O) + (size_t)tok * 384 + c), t);
      const float wgi = wg[g] * inv;
#pragma unroll
      for (int e = 0; e < 8; ++e) o[e] += wgi * t[e];
    }
  } else if (n == 3) {
    const int hh = c >> 6;
    const f32x4 sq = *(const f32x4*)((const float*)(ws + O_SSQ) + ((size_t)tok * 6 + hh) * 4);
    const float rs = rsqrtf((sq[0] + sq[1] + sq[2] + sq[3]) * (1.f / 64.f) + 1e-6f);
    unpk8(*(const bf16x8*)((const bf16_t*)(ws + O_OD) + (size_t)tok * 384 + c), o);
    const float* gw = p.gdn_w + layer * 64 + (c & 63);
#pragma unroll
    for (int e = 0; e < 8; ++e) o[e] *= rs * gw[e];
  } else if (n == 0) {
    const int hh = c >> 6;
    const float* st = (const float*)(ws + O_STA);
    float mg[4], lg[4], mm = -1e30f;
#pragma unroll
    for (int g = 0; g < 4; ++g) { const f32x2 s2 = *(const f32x2*)(st + ((size_t)(g * TH + tok) * 6 + hh) * 2); mg[g] = s2[0]; lg[g] = s2[1]; mm = fmaxf(mm, mg[g]); }
    float wg[4], ws_ = 0.f;
#pragma unroll
    for (int g = 0; g < 4; ++g) { wg[g] = exp2f(mg[g] - mm) * lg[g]; ws_ += wg[g]; }
    const float inv = 1.f / ws_;
#pragma unroll
    for (int e = 0; e < 8; ++e) o[e] = 0.f;
#pragma unroll
    for (int g = 0; g < 4; ++g) {
      if (lg[g] > 0.f) {
        float t[8]; unpk8(*(const bf16x8*)((const bf16_t*)(ws + O_OA + g * SZ_O) + (size_t)tok * 384 + c), t);
        const float wgi = wg[g] * inv;
#pragma unroll
        for (int e = 0; e < 8; ++e) o[e] += wgi * t[e];
      }
    }
  } else {
    const size_t off = (n == 2) ? O_OC : O_OE;
    unpk8(*(const bf16x8*)((const bf16_t*)(ws + off) + (size_t)tok * 384 + c), o);
  }
#pragma unroll
  for (int e = 0; e < 8; ++e) o[e] *= z[e];
  *(bf16x8*)szp = pk8(o);
}

DI void p4a_tile(const Params& p, int layer, int mt, int nt, unsigned char* smem) {
  sub_sync();
  bf16_t* As = (bf16_t*)smem; bf16_t* Bs = As + 2 * 9216;
  const int tid = otid(), lane = tid & 63, wave = tid >> 6, wr = wave >> 1, wc = wave & 1, r = lane & 31, h = lane >> 5;
  const int m0 = mt * 128, n0 = nt * 128;
  f32x16 tot[2][2]; zero_acc(tot);
  const bf16_t* SIG = (const bf16_t*)(p.ws + O_SIG);
  for (int n = 0; n < 5; ++n) {
    f32x16 acc[2][2]; zero_acc(acc);
    PlainA al{(const bf16_t*)(p.ws + O_SZ) + n * 384, 1920};
    gemm_kloop_t<32>(al, (const bf16_t*)(p.ws + O_WTBR) + (size_t)(layer * 5 + n) * 1024 * 384, 384, 12, m0, n0, acc, As, Bs);
#pragma unroll
    for (int mi = 0; mi < 2; ++mi) {
      const int tok = m0 + wr * 64 + mi * 32 + r;
#pragma unroll
      for (int ni = 0; ni < 2; ++ni)
#pragma unroll
        for (int g = 0; g < 4; ++g) {
          const int col = n0 + wc * 64 + ni * 32 + 8 * g + 4 * h;
          const u32x2 sg = *(const u32x2*)(SIG + (size_t)tok * 5120 + n * 1024 + col);
          tot[mi][ni][4 * g] += bflo(sg.x) * acc[mi][ni][4 * g];
          tot[mi][ni][4 * g + 1] += bfhi(sg.x) * acc[mi][ni][4 * g + 1];
          tot[mi][ni][4 * g + 2] += bflo(sg.y) * acc[mi][ni][4 * g + 2];
          tot[mi][ni][4 * g + 3] += bfhi(sg.y) * acc[mi][ni][4 * g + 3];
          asm volatile("" ::: "memory");
        }
    }
  }
  bf16_t* YM = (bf16_t*)(p.ws + O_YM);
  {
    bf16_t* stg = (bf16_t*)smem + wave * (64 * 72);
#pragma unroll
    for (int ni = 0; ni < 2; ++ni)
#pragma unroll
      for (int mi = 0; mi < 2; ++mi)
#pragma unroll
        for (int g = 0; g < 4; ++g)
          *(u32x2*)(stg + (mi * 32 + r) * 72 + ni * 32 + 8 * g + 4 * h) = pk4(tot[mi][ni][4 * g], tot[mi][ni][4 * g + 1], tot[mi][ni][4 * g + 2], tot[mi][ni][4 * g + 3]);
    asm volatile("s_waitcnt lgkmcnt(0)" ::: "memory");
    __builtin_amdgcn_wave_barrier();
    const int tok0 = m0 + wr * 64, col0 = n0 + wc * 64;
#pragma unroll
    for (int it = 0; it < 8; ++it) {
      const int row = it * 8 + (lane >> 3), ch = (lane & 7) * 8;
      const bf16x8 val = *(const bf16x8*)(stg + row * 72 + ch);
      *(bf16x8*)(YM + (size_t)(tok0 + row) * 1024 + col0 + ch) = val;
    }
  }
}

DI void p4b_tile(const Params& p, int layer, int half, int mt, int nt, unsigned char* smem) {
  bf16_t* As = (bf16_t*)smem; bf16_t* Bs = As + 2 * 9216;
  const int tid = otid(), lane = tid & 63, wave = tid >> 6, wr = wave >> 1, wc = wave & 1, r = lane & 31, h = lane >> 5;
  const int m0 = mt * 128, n0 = nt * 128;
  f32x16 acc[2][2]; zero_acc(acc);
  PlainA al{(const bf16_t*)(p.ws + O_YM), 1024};
  gemm_kloop(al, (const bf16_t*)(p.ws + O_WTOUT + layer * SZ_WTOUT1), 1024, 16, m0, n0, acc, As, Bs);
  const float* xin = layer == 0 ? p.x : p.out;
  const float alpha = 1.4142135623730951f;
#pragma unroll
  for (int mi = 0; mi < 2; ++mi) {
    const size_t gt = (size_t)half * TH + m0 + wr * 64 + mi * 32 + r;
#pragma unroll
    for (int ni = 0; ni < 2; ++ni)
#pragma unroll
      for (int g = 0; g < 4; ++g) {
        const int col = n0 + wc * 64 + ni * 32 + 8 * g + 4 * h;
        const f32x4 xv = *(const f32x4*)(xin + gt * 1024 + col);
        f32x4 o;
#pragma unroll
        for (int e = 0; e < 4; ++e) o[e] = alpha * xv[e] + acc[mi][ni][4 * g + e];
        *(f32x4*)(p.out + gt * 1024 + col) = o;
      }
  }
}

DI void p4c_row(const Params& p, int layer, size_t gt, bool wxb = true) {
  const int lane = otid() & 63;
  float* row = p.out + gt * 1024;
  f32x4 v[4]; float s = 0.f;
#pragma unroll
  for (int j = 0; j < 4; ++j) { v[j] = *(const f32x4*)(row + 4 * lane + 256 * j); s += v[j][0] + v[j][1] + v[j][2] + v[j][3]; }
#pragma unroll
  for (int o = 32; o >= 1; o >>= 1) s += __shfl_xor(s, o);
  const float mu = s * (1.f / 1024.f); float q = 0.f;
#pragma unroll
  for (int j = 0; j < 4; ++j) { v[j] -= mu; q += v[j][0] * v[j][0] + v[j][1] * v[j][1] + v[j][2] * v[j][2] + v[j][3] * v[j][3]; }
#pragma unroll
  for (int o = 32; o >= 1; o >>= 1) q += __shfl_xor(q, o);
  const float rs = rsqrtf(q * (1.f / 1024.f) + 1e-5f);
  bf16_t* xb = (bf16_t*)(p.ws + O_XB) + gt * 1024;
#pragma unroll
  for (int j = 0; j < 4; ++j) {
    const int c = 4 * lane + 256 * j;
    const f32x4 g = *(const f32x4*)(p.ln_g + layer * 1024 + c), b = *(const f32x4*)(p.ln_b + layer * 1024 + c);
    f32x4 y;
#pragma unroll
    for (int e = 0; e < 4; ++e) y[e] = v[j][e] * rs * g[e] + b[e];
    *(f32x4*)(row + c) = y;
    if (wxb) *(u32x2*)(xb + c) = pk4(y[0], y[1], y[2], y[3]);
  }
}


#define XB_TMO      128
#define XB_XCNT(j)  (256  + 64 * (j))
#define XB_XSUB(j)  (1280 + 64 * (j))
#define XB_XGEN(j)  (2304 + 64 * (j))
#define XB_TOP      3328
#define XB_TOPGEN   3392
#define XB_SPIN_CAP (1u << 22)
#define LAS __attribute__((address_space(3)))
DI unsigned xb_ld(unsigned* p) { return __hip_atomic_load(p, __ATOMIC_RELAXED, __HIP_MEMORY_SCOPE_AGENT); }
DI unsigned xb_add(unsigned* p, unsigned v) { return __hip_atomic_fetch_add(p, v, __ATOMIC_RELAXED, __HIP_MEMORY_SCOPE_AGENT); }
DI unsigned xb_xcc_id() { return (unsigned)__builtin_amdgcn_s_getreg((3 << 11) | 20) & 0xFu; }
#define XB_SPIN(cond, bar) do { unsigned _sp = 0; while (cond) { __builtin_amdgcn_s_sleep(1); \
    if ((++_sp & 255u) == 0u) { if (xb_ld(&(bar)[XB_TMO])) break; if (_sp > XB_SPIN_CAP) { atomicAdd(&(bar)[XB_TMO], 1u); break; } } } } while (0)
struct XcdBarrier { unsigned* bar; unsigned x; volatile LAS unsigned* st; };
DI XcdBarrier xcd_barrier_post(unsigned* bar, volatile LAS unsigned* st) {
  XcdBarrier b; b.bar = bar; b.x = xb_xcc_id(); b.st = st;
  if (threadIdx.x == 0) (void)xb_add(&bar[XB_XCNT(b.x)], 1u);
  return b;
}
DI void xcd_barrier_complete(unsigned* bar, unsigned x, unsigned& nloc, unsigned& nx) {
  const unsigned G = gridDim.x;
  unsigned sum, cnt, mine, sp = 0u;
  for (;;) {
    sum = 0u; cnt = 0u; mine = 0u;
#pragma unroll
    for (unsigned j = 0; j < 16; ++j) { const unsigned c = xb_ld(&bar[XB_XCNT(j)]); sum += c; cnt += (c > 0u) ? 1u : 0u; mine = (j == x) ? c : mine; }
    if (sum == G) break;
    __builtin_amdgcn_s_sleep(1);
    if ((++sp & 255u) == 0u) { if (xb_ld(&bar[XB_TMO])) break; if (sp > XB_SPIN_CAP) { atomicAdd(&bar[XB_TMO], 1u); break; } }
  }
  nloc = mine > 0u ? mine : 1u; nx = cnt > 0u ? cnt : 1u;
}
DI void xcd_barrier(const XcdBarrier& b) {
  asm volatile("s_waitcnt vmcnt(0)" ::: "memory");
  __syncthreads();
  if (threadIdx.x == 0) {
    unsigned* bar = b.bar;
    __builtin_amdgcn_s_waitcnt(0);
    unsigned nloc = b.st[0], nx = b.st[1];
    if (nloc == 0u) { xcd_barrier_complete(bar, b.x, nloc, nx); b.st[0] = nloc; b.st[1] = nx; }
    const unsigned old = xb_add(&bar[XB_XSUB(b.x)], 1u);
    const unsigned gen = old / nloc;
    if (old + 1u == (gen + 1u) * nloc) {
      __builtin_amdgcn_fence(__ATOMIC_RELEASE, "agent");
      asm volatile("s_waitcnt vmcnt(0)" ::: "memory");
      const unsigned og = xb_add(&bar[XB_TOP], 1u);
      const unsigned tg = og / nx;
      if (og + 1u == (tg + 1u) * nx) xb_add(&bar[XB_TOPGEN], 1u);
      else XB_SPIN(xb_ld(&bar[XB_TOPGEN]) == tg, bar);
      __builtin_amdgcn_fence(__ATOMIC_ACQUIRE, "agent");
      xb_add(&bar[XB_XGEN(b.x)], 1u);
      asm volatile("s_waitcnt vmcnt(0)" ::: "memory");
    } else {
      XB_SPIN(xb_ld(&bar[XB_XGEN(b.x)]) == gen, bar);
      __builtin_amdgcn_fence(__ATOMIC_ACQUIRE, "agent");
      asm volatile("s_waitcnt vmcnt(0)" ::: "memory");
    }
  }
  __syncthreads();
}

#ifdef PROBE_A
#define STAMP(k) do { if (blockIdx.x == 0 && otid() == 0) { unsigned long long now_ = __builtin_amdgcn_s_memrealtime(); tsacc[k] += (float)(now_ - tlast) * 0.01f; tlast = now_; } } while (0)
#else
#define STAMP(k) do {} while (0)
#endif
__global__ void __launch_bounds__(512, 2) mega(Params p) {
  extern __shared__ __attribute__((aligned(16))) unsigned char smem_all[];
  cg::grid_group grid = cg::this_grid();
  if (p.ws == nullptr) grid.sync();
  volatile LAS unsigned* xbst = (volatile LAS unsigned*)(smem_all + 2 * SUB_LDS);
  if (threadIdx.x < 4) xbst[threadIdx.x] = 0u;
  __syncthreads();
  const XcdBarrier xb = xcd_barrier_post((unsigned*)(p.ws + O_BAR), xbst);
#define GSYNC() xcd_barrier(xb)
  const int sub = __builtin_amdgcn_readfirstlane(__builtin_amdgcn_workitem_id_x() >> 8);
  unsigned char* smem = smem_all + sub * SUB_LDS;
  const int vb = (int)blockIdx.x * 2 + sub, vgrid = (int)gridDim.x * 2;
  const int wave = otid() >> 6;
  const int gw = vb * 4 + wave, ngw = vgrid * 4;
  phase0(p, smem, vb, vgrid);
  GSYNC();
  int pend_layer = -1, pend_half = 0;
  for (int itn = 0; itn < 4; ++itn) {
    const int layer = itn >> 1, half = itn & 1;
    if (pend_layer >= 0) { for (int rw = gw; rw < TH; rw += ngw) p4c_row(p, pend_layer, (size_t)pend_half * TH + rw, true); pend_layer = -1; }
    for (int t = (int)blockIdx.x; t < 32 * 54; t += (int)gridDim.x) {
      const int tn = t + (int)gridDim.x;
      p1_unit(p, layer, half, t & 31, t >> 5, tn < 32 * 54 ? (tn & 31) : 0, tn < 32 * 54 ? (tn >> 5) : -1, t == (int)blockIdx.x, smem_all);
    }
    GSYNC();
    {
      constexpr int N_FOX = 6, N_GDN = 768, N_MKV = 12, N_KM = 48, TOT = N_FOX + N_GDN + N_MKV + N_KM;
      for (int t = vb; t < TOT; t += vgrid) {
        int i = t;
        if (i < N_FOX) { fox_prep(p, i, smem); continue; }
        i -= N_FOX;
        if (i < N_GDN) { gdn_prep(p, layer, half, i / 128, i % 128, smem); continue; }
        i -= N_GDN;
        if (i < N_MKV) { memkv_tile(p, layer, half, i / 6, i % 6, smem); continue; }
        i -= N_MKV;
        kmean_prep(p, i * 4 + wave, (unsigned*)(p.ws + O_CTL) + 64 + (layer * 2 + half) * 8);
      }
    }
    for (int a = gw; a < 1536; a += ngw) moba_select(p, a);
    GSYNC();
    phase3(p, half, (unsigned*)(p.ws + O_CTL) + layer * 2 + half, (const unsigned*)(p.ws + O_CTL) + 64 + (layer * 2 + half) * 8, smem, sub);
    GSYNC();
    for (int ci = vb * 256 + otid(); ci < TH * 240; ci += vgrid * 256) gbuild_chunk(p, layer, ci / 240, ci % 240);
    GSYNC();
    for (int t = vb; t < 512; t += vgrid) p4a_tile(p, layer, t % 64, t / 64, smem);
    GSYNC();
    for (int t = vb; t < 512; t += vgrid) p4b_tile(p, layer, half, t % 64, t / 64, smem);
    GSYNC();
    pend_layer = layer; pend_half = half;
  }
  if (pend_layer >= 0) { for (int rw = gw; rw < TH; rw += ngw) p4c_row(p, pend_layer, (size_t)pend_half * TH + rw, true); }
}

extern "C" void kernel_launch(void* const* d_in, const int* in_sizes, int n_in, void* d_out, int out_size, void* d_ws, size_t ws_size,
                              hipStream_t stream) {
  static int grid_blocks = 0;
  if (grid_blocks == 0) {
    if (ws_size < WS_END) { fprintf(stderr, "workspace too small: %zu < %zu\n", ws_size, (size_t)WS_END); grid_blocks = -1; return; }
    int dev = 0, cus = 0, per_cu = 0;
    (void)hipGetDevice(&dev);
    (void)hipDeviceGetAttribute(&cus, hipDeviceAttributeMultiprocessorCount, dev);
    (void)hipFuncSetAttribute((const void*)mega, hipFuncAttributeMaxDynamicSharedMemorySize, LDS_BYTES);
    (void)hipOccupancyMaxActiveBlocksPerMultiprocessor(&per_cu, (const void*)mega, 512, LDS_BYTES);
    if (per_cu < 1) per_cu = 1;
    if (per_cu > 1) per_cu = 1;
    grid_blocks = cus * per_cu;
  }
  if (grid_blocks < 0) return;
  (void)hipMemsetAsync((char*)d_ws + O_CTL, 0, 32768, stream);
  Params p{};
  p.x = (const float*)d_in[0]; p.mem = (const float*)d_in[1]; p.mem_g = (const float*)d_in[2]; p.mem_b = (const float*)d_in[3];
  p.w_in = (const float*)d_in[4]; p.b_in = (const float*)d_in[5]; p.conv_w = (const float*)d_in[6]; p.a_log = (const float*)d_in[7];
  p.dt_bias = (const float*)d_in[8]; p.gdn_w = (const float*)d_in[9]; p.w_kv = (const float*)d_in[10]; p.w_br = (const float*)d_in[11];
  p.w_out = (const float*)d_in[12]; p.ln_g = (const float*)d_in[13]; p.ln_b = (const float*)d_in[14];
  p.out = (float*)d_out; p.ws = (unsigned char*)d_ws;
  void* args[] = {&p};
  hipError_t e = hipLaunchCooperativeKernel((const void*)mega, dim3(grid_blocks), dim3(512), args, LDS_BYTES, stream);
  if (e != hipSuccess) fprintf(stderr, "cooperative launch failed: %s (grid %d)\n", hipGetErrorString(e), grid_blocks);
}
```

```cpp
#include <hip/hip_runtime.h>
#include <hip/hip_cooperative_groups.h>
#include <cstdio>
#include <cstdint>
namespace cg = cooperative_groups;

#define DI __device__ __forceinline__
typedef unsigned short bf16_t;
typedef short bf16x8 __attribute__((ext_vector_type(8)));
typedef short s16x4 __attribute__((ext_vector_type(4)));
typedef float f32x4 __attribute__((ext_vector_type(4)));
typedef float f32x2 __attribute__((ext_vector_type(2)));
typedef float f32x16 __attribute__((ext_vector_type(16)));
typedef unsigned u32x2 __attribute__((ext_vector_type(2)));
typedef unsigned u32x4 __attribute__((ext_vector_type(4)));
typedef __bf16 bfv2 __attribute__((ext_vector_type(2)));

#define MFMA32(a, b, c) __builtin_amdgcn_mfma_f32_32x32x16_bf16((a), (b), (c), 0, 0, 0)
#define MFMA16(a, b, c) __builtin_amdgcn_mfma_f32_16x16x32_bf16((a), (b), (c), 0, 0, 0)

DI unsigned pk2(float a, float b) { f32x2 v = {a, b}; return __builtin_bit_cast(unsigned, __builtin_convertvector(v, bfv2)); }
DI bf16_t f2bf(float a) { return (bf16_t)(pk2(a, 0.f) & 0xffffu); }
DI float bf2f(bf16_t v) { return __uint_as_float(((unsigned)v) << 16); }
DI float bflo(unsigned u) { return __uint_as_float(u << 16); }
DI float bfhi(unsigned u) { return __uint_as_float(u & 0xffff0000u); }
DI int rtid() { int t = __builtin_amdgcn_workitem_id_x(); asm volatile("" : "+v"(t)); return t; }
DI int otid() { return rtid() & 255; }
extern __shared__ __attribute__((aligned(16))) unsigned char g_lds_all[];
#define LAS3 __attribute__((address_space(3)))
DI void sub_sync() {
  asm volatile("s_waitcnt lgkmcnt(0)" ::: "memory");
  const int t = __builtin_amdgcn_workitem_id_x();
  LAS3 unsigned* c = (LAS3 unsigned*)(g_lds_all + 2 * 75776 + 8) + (t >> 8);
  if ((t & 63) == 0) {
    const unsigned old = __hip_atomic_fetch_add(c, 1u, __ATOMIC_RELAXED, __HIP_MEMORY_SCOPE_WORKGROUP);
    const unsigned target = (old / 4u + 1u) * 4u;
    while (__hip_atomic_load(c, __ATOMIC_RELAXED, __HIP_MEMORY_SCOPE_WORKGROUP) < target) __builtin_amdgcn_s_sleep(1);
  }
  asm volatile("s_waitcnt lgkmcnt(0)" ::: "memory");
}
DI int crow(int i, int h) { return (i & 3) + 8 * (i >> 2) + 4 * h; }
DI float fsigmoid(float v) { return __builtin_amdgcn_rcpf(1.f + __expf(-v)); }
DI float fsilu(float v) { return v * fsigmoid(v); }
DI u32x2 pk4(float a, float b, float c, float d) { u32x2 r; r.x = pk2(a, b); r.y = pk2(c, d); return r; }
DI bf16x8 pk8(const float* v) { u32x4 r; r.x = pk2(v[0], v[1]); r.y = pk2(v[2], v[3]); r.z = pk2(v[4], v[5]); r.w = pk2(v[6], v[7]); return __builtin_bit_cast(bf16x8, r); }
DI void unpk8(bf16x8 x, float* v) { u32x4 u = __builtin_bit_cast(u32x4, x); v[0] = bflo(u.x); v[1] = bfhi(u.x); v[2] = bflo(u.y); v[3] = bfhi(u.y); v[4] = bflo(u.z); v[5] = bfhi(u.z); v[6] = bflo(u.w); v[7] = bfhi(u.w); }

constexpr int NB = 2, SQ = 8192, NT = NB * SQ, DM = 1024, NH = 6, BW = 384;
constexpr int TH = 8192;
constexpr int NP = 13824;
constexpr int DIN = 13586;
constexpr float LOG2E = 1.4426950408889634f;
#define NEG_INF (-__builtin_inff())

constexpr int C_AQK = 0, C_AV = 768, C_BQK = 1152, C_BV = 3456, C_CQK = 3840, C_CV = 4608, C_D = 4992, C_E = 6144, C_SM = 6528, C_SMEND = 6546, C_Z = 6656, C_MG = 8576;

__host__ __device__ constexpr int inmap(int n) {
  return n < 4992 ? n : n < 6144 ? n + 6 : n < 6528 ? n + 18 : n < 6534 ? n - 1536 : n < 6546 ? n - 384 : n < 6656 ? -1 : n < 13696 ? n - 110 : -1;
}

constexpr size_t O_CTL = 0;
constexpr size_t O_BAR = 4096;
constexpr size_t O_WTIN = 32768;
constexpr size_t SZ_WTIN1 = (size_t)NP * 1024 * 2;
constexpr size_t O_WTBR = O_WTIN + 2 * SZ_WTIN1;
constexpr size_t SZ_WTBR1 = (size_t)5 * 1024 * 384 * 2;
constexpr size_t O_WTOUT = O_WTBR + 2 * SZ_WTBR1;
constexpr size_t SZ_WTOUT1 = (size_t)1024 * 1024 * 2;
constexpr size_t O_WTKV = O_WTOUT + 2 * SZ_WTOUT1;
constexpr size_t SZ_WTKV1 = (size_t)768 * 1024 * 2;
constexpr size_t O_BIASP = O_WTKV + 2 * SZ_WTKV1;
constexpr size_t O_XB = O_BIASP + (size_t)2 * NP * 4;
constexpr size_t O_MEMN = O_XB + (size_t)NT * 1024 * 2;
constexpr size_t O_MEMK = O_MEMN + (size_t)512 * 1024 * 2;
constexpr size_t O_MEMVT = O_MEMK + (size_t)512 * 384 * 2;
constexpr size_t O_QKA = O_MEMVT + (size_t)512 * 384 * 2;
constexpr size_t SZ_VT = (size_t)384 * TH * 2;
constexpr size_t O_KFA = O_QKA + SZ_VT;
constexpr size_t O_VTA = O_KFA + SZ_VT;
constexpr size_t O_QKB = O_VTA + SZ_VT;
constexpr size_t O_KFB = O_QKB + 3 * SZ_VT;
constexpr size_t O_VTB = O_KFB + 3 * SZ_VT;
constexpr size_t O_QKC = O_VTB + 3 * SZ_VT;
constexpr size_t O_KFC = O_QKC + SZ_VT;
constexpr size_t O_VTC = O_KFC + SZ_VT;
constexpr size_t O_QKVD = O_VTC + SZ_VT;
constexpr size_t O_QE = O_QKVD + (size_t)TH * 1152 * 2;
constexpr size_t O_SM = O_QE + (size_t)TH * 384 * 2;
constexpr size_t O_FF = O_SM + (size_t)TH * 32 * 4;
constexpr size_t O_KM = O_FF + (size_t)6 * TH * 4;
constexpr size_t O_KMAX = O_KM + (size_t)2 * 6 * 32 * 64 * 2;
constexpr size_t O_GL = O_KMAX + 256;
constexpr size_t O_MASK = O_GL + 6 * 128 * 4;
constexpr size_t O_KSUM = O_MASK + (size_t)TH * 8 * 4;
constexpr size_t O_DPREP = O_KSUM + (size_t)32 * 2 * 384 * 4;
constexpr size_t O_SZ = O_DPREP + (size_t)768 * 32768;
constexpr size_t O_SIG = O_SZ + (size_t)TH * 1920 * 2;
constexpr size_t O_OA = O_SIG + (size_t)TH * 5120 * 2;
constexpr size_t SZ_O = (size_t)TH * 384 * 2;
constexpr size_t O_STA = O_OA + 4 * SZ_O;
constexpr size_t O_OB = O_STA + (size_t)4 * TH * 6 * 2 * 4;
constexpr size_t O_STB = O_OB + 3 * SZ_O;
constexpr size_t O_OC = O_STB + (size_t)3 * TH * 6 * 2 * 4;
constexpr size_t O_OD = O_OC + SZ_O;
constexpr size_t O_SSQ = O_OD + SZ_O;
constexpr size_t O_OE = O_SSQ + (size_t)TH * 6 * 4 * 4;
constexpr size_t WS_END = O_OE + SZ_O;
constexpr size_t O_YM = O_QKB;
static_assert(WS_END < (size_t)443 * 1000 * 1000, "workspace too large");

struct Params {
  const float *x, *mem, *mem_g, *mem_b, *w_in, *b_in, *conv_w, *a_log, *dt_bias, *gdn_w, *w_kv, *w_br, *w_out, *ln_g, *ln_b;
  float* out;
  unsigned char* ws;
};

constexpr int SUB_LDS = 75776;
constexpr int LDS_BYTES = 2 * SUB_LDS + 16;
#ifndef PH_MASK
#define PH_MASK 0xFFFF
#endif
#define PH(x) ((PH_MASK >> (x)) & 1)
#ifndef REP_MASK
#define REP_MASK 0
#endif
#define REP(x) (1 + ((REP_MASK >> (x)) & 1))

DI void transpose_tile(const float* __restrict__ src, int ld, int k0, int n0, bool usemap, bf16_t* __restrict__ dst, int dstld, float* tile) {
  const int tid = otid();
#pragma unroll
  for (int it = 0; it < 16; ++it) {
    const int kk = (tid >> 6) + 4 * it, n2 = (tid & 63) * 2;
    const int sc = usemap ? inmap(n0 + n2) : (n0 + n2);
    f32x2 v = {0.f, 0.f};
    if (sc >= 0) v = *(const f32x2*)(src + (size_t)(k0 + kk) * ld + sc);
    *(f32x2*)(tile + kk * 130 + n2) = v;
  }
  sub_sync();
#pragma unroll
  for (int it = 0; it < 4; ++it) {
    const int nn = (tid >> 3) + 32 * it, kc = (tid & 7) * 8;
    float v[8];
#pragma unroll
    for (int e = 0; e < 8; ++e) v[e] = tile[(kc + e) * 130 + nn];
    *(bf16x8*)(dst + (size_t)(n0 + nn) * dstld + k0 + kc) = pk8(v);
  }
  sub_sync();
}

DI void phase0(const Params& p, unsigned char* smem, int vb, int vgrid) {
  float* tile = (float*)smem;
  const int tid = otid(), lane = tid & 63, wave = tid >> 6;
  constexpr int N_TIN = 2 * 108 * 16, N_TBR = 2 * 5 * 8 * 6, N_TOUT = 2 * 8 * 16, N_TKV = 2 * 6 * 16, N_XB = 1024, N_MEMN = 128, N_BIAS = 108;
  constexpr int TOT = N_TIN + N_TBR + N_TOUT + N_TKV + N_XB + N_MEMN + N_BIAS;
  for (int it = vb; it < TOT; it += vgrid) {
    int i = it;
    if (i < N_TIN) {
      const int l = i / (108 * 16), rr = i % (108 * 16), nt = rr / 16, kt = rr % 16;
      transpose_tile(p.w_in + (size_t)l * 1024 * DIN, DIN, kt * 64, nt * 128, true, (bf16_t*)(p.ws + O_WTIN + l * SZ_WTIN1), 1024, tile);
      continue;
    }
    i -= N_TIN;
    if (i < N_TBR) {
      const int ln = i / 48, rr = i % 48, nt = rr / 6, kt = rr % 6;
      transpose_tile(p.w_br + (size_t)ln * 384 * 1024, 1024, kt * 64, nt * 128, false, (bf16_t*)(p.ws + O_WTBR) + (size_t)ln * 1024 * 384, 384, tile);
      continue;
    }
    i -= N_TBR;
    if (i < N_TOUT) {
      const int l = i / 128, rr = i % 128, nt = rr / 16, kt = rr % 16;
      transpose_tile(p.w_out + (size_t)l * 1024 * 1024, 1024, kt * 64, nt * 128, false, (bf16_t*)(p.ws + O_WTOUT + l * SZ_WTOUT1), 1024, tile);
      continue;
    }
    i -= N_TOUT;
    if (i < N_TKV) {
      const int l = i / 96, rr = i % 96, nt = rr / 16, kt = rr % 16;
      transpose_tile(p.w_kv + (size_t)l * 1024 * 768, 768, kt * 64, nt * 128, false, (bf16_t*)(p.ws + O_WTKV + l * SZ_WTKV1), 1024, tile);
      continue;
    }
    i -= N_TKV;
    if (i < N_XB) {
      const float* src = p.x + (size_t)i * 16 * 1024;
      bf16_t* dst = (bf16_t*)(p.ws + O_XB) + (size_t)i * 16 * 1024;
#pragma unroll
      for (int j = 0; j < 16; ++j) {
        const int e = (j * 256 + tid) * 4;
        const f32x4 v = *(const f32x4*)(src + e);
        *(u32x2*)(dst + e) = pk4(v[0], v[1], v[2], v[3]);
      }
      continue;
    }
    i -= N_XB;
    if (i < N_MEMN) {
      const int row = i * 4 + wave;
      const float* src = p.mem + (size_t)row * 1024;
      f32x4 v[4]; float s = 0.f;
#pragma unroll
      for (int j = 0; j < 4; ++j) { v[j] = *(const f32x4*)(src + 4 * lane + 256 * j); s += v[j][0] + v[j][1] + v[j][2] + v[j][3]; }
#pragma unroll
      for (int o = 32; o >= 1; o >>= 1) s += __shfl_xor(s, o);
      const float mu = s * (1.f / 1024.f); float q = 0.f;
#pragma unroll
      for (int j = 0; j < 4; ++j) { v[j] -= mu; q += v[j][0] * v[j][0] + v[j][1] * v[j][1] + v[j][2] * v[j][2] + v[j][3] * v[j][3]; }
#pragma unroll
      for (int o = 32; o >= 1; o >>= 1) q += __shfl_xor(q, o);
      const float rs = rsqrtf(q * (1.f / 1024.f) + 1e-5f);
      bf16_t* dst = (bf16_t*)(p.ws + O_MEMN) + (size_t)row * 1024;
#pragma unroll
      for (int j = 0; j < 4; ++j) {
        const int c = 4 * lane + 256 * j;
        const f32x4 g = *(const f32x4*)(p.mem_g + c), b = *(const f32x4*)(p.mem_b + c);
        *(u32x2*)(dst + c) = pk4(v[j][0] * rs * g[0] + b[0], v[j][1] * rs * g[1] + b[1], v[j][2] * rs * g[2] + b[2], v[j][3] * rs * g[3] + b[3]);
      }
      continue;
    }
    i -= N_MEMN;
    {
      float* bp = (float*)(p.ws + O_BIASP);
      if (tid < 128) {
        const int n = i * 128 + tid;
        const int sc = inmap(n);
        for (int l = 0; l < 2; ++l) bp[l * NP + n] = sc >= 0 ? p.b_in[l * DIN + sc] : 0.f;
      }
    }
  }
}

template <int BK, class AL>
DI void gemm_kloop_t(const AL& al, const bf16_t* __restrict__ Bt, int ldb, int nkt, int m0, int n0, f32x16 (&acc)[2][2], bf16_t* As, bf16_t* Bs) {
  constexpr int CPR = BK / 8, NCH = BK / 16, PITCH = BK + 8, BUF = 128 * PITCH;
  const int tid = otid(), lane = tid & 63, wave = tid >> 6, wr = wave >> 1, wc = wave & 1, r = lane & 31, h = lane >> 5;
  bf16x8 ra[NCH], rb[NCH];
  auto gload = [&](int kt) {
#pragma unroll
    for (int i = 0; i < NCH; ++i) {
      const int cid = tid + 256 * i, row = cid / CPR, kc = (cid % CPR) * 8;
      ra[i] = al(m0 + row, kt * BK + kc);
      rb[i] = *(const bf16x8*)(Bt + (size_t)(n0 + row) * ldb + kt * BK + kc);
    }
  };
  auto lstore = [&](int buf) {
#pragma unroll
    for (int i = 0; i < NCH; ++i) {
      const int cid = tid + 256 * i, row = cid / CPR, kc = (cid % CPR) * 8;
      *(bf16x8*)(As + buf * BUF + row * PITCH + kc) = ra[i];
      *(bf16x8*)(Bs + buf * BUF + row * PITCH + kc) = rb[i];
    }
  };
  gload(0); lstore(0); sub_sync();
  for (int kt = 0; kt < nkt; ++kt) {
    const int buf = kt & 1;
    if (kt + 1 < nkt) gload(kt + 1);
    asm volatile("" ::: "memory");
    const bf16_t* a_ = As + buf * BUF + (wr * 64 + r) * PITCH + 8 * h;
    const bf16_t* b_ = Bs + buf * BUF + (wc * 64 + r) * PITCH + 8 * h;
#pragma unroll
    for (int s = 0; s < BK / 16; ++s) {
      bf16x8 af[2], bfr[2];
      af[0] = *(const bf16x8*)(a_ + 16 * s); af[1] = *(const bf16x8*)(a_ + 32 * PITCH + 16 * s);
      bfr[0] = *(const bf16x8*)(b_ + 16 * s); bfr[1] = *(const bf16x8*)(b_ + 32 * PITCH + 16 * s);
#pragma unroll
      for (int mi = 0; mi < 2; ++mi)
#pragma unroll
        for (int ni = 0; ni < 2; ++ni) acc[mi][ni] = MFMA32(bfr[ni], af[mi], acc[mi][ni]);
    }
    if (kt + 1 < nkt) lstore(buf ^ 1);
    sub_sync();
  }
}
template <class AL>
DI void gemm_kloop(const AL& al, const bf16_t* __restrict__ Bt, int ldb, int nkt, int m0, int n0, f32x16 (&acc)[2][2], bf16_t* As, bf16_t* Bs) {
  gemm_kloop_t<64>(al, Bt, ldb, nkt, m0, n0, acc, As, Bs);
}

DI void zero_acc(f32x16 (&acc)[2][2]) {
#pragma unroll
  for (int a = 0; a < 2; ++a)
#pragma unroll
    for (int b = 0; b < 2; ++b)
#pragma unroll
      for (int i = 0; i < 16; ++i) acc[a][b][i] = 0.f;
}

DI int vfrag_key(int key) { const int kk = key & 31; return (key >> 5) * 2048 + (kk >> 4) * 512 + ((kk >> 2) & 1) * 256 + ((kk >> 3) & 1) * 4 + (kk & 3); }
DI int vfrag_col(int cw) { const int d = cw & 63; return (cw >> 6) * 524288 + (d >> 5) * 1024 + (d & 31) * 8; }

DI int kfrag_key(int key) { return (key >> 5) * 2048 + (key & 31) * 8; }
DI int kfrag_col(int cw) { const int d = cw & 63; return (cw >> 6) * 524288 + (d >> 4) * 512 + ((d >> 3) & 1) * 256 + (d & 7); }

struct PlainA {
  const bf16_t* A; int lda;
  DI bf16x8 operator()(int row, int k) const { return *(const bf16x8*)(A + (size_t)row * lda + k); }
};

DI void p1_tile(const Params& p, int layer, int half, int mt, int nt, unsigned char* smem) {
  sub_sync();
  bf16_t* As = (bf16_t*)smem; bf16_t* Bs = As + 2 * 9216;
  f32x16 acc[2][2]; zero_acc(acc);
  PlainA al{(const bf16_t*)(p.ws + O_XB) + (size_t)half * TH * 1024, 1024};
  const int m0 = mt * 128, n0 = nt * 128;
  gemm_kloop(al, (const bf16_t*)(p.ws + O_WTIN + layer * SZ_WTIN1), 1024, 16, m0, n0, acc, As, Bs);
  const int tid = otid(), lane = tid & 63, wave = tid >> 6, wr = wave >> 1, wc = wave & 1, r = lane & 31, h = lane >> 5;
  const float* bias = (const float*)(p.ws + O_BIASP) + layer * NP;
  unsigned char* ws = p.ws;
  {
    const int nb0 = n0 + wc * 64;
    bf16_t* dst0 = nullptr; int pitch0 = 0, coff0 = 0, xf0 = 0;
    if (nb0 < 384) { dst0 = (bf16_t*)(ws + O_QKA); pitch0 = 384; coff0 = nb0; }
    else if (nb0 >= C_BQK && nb0 < 2304) { dst0 = (bf16_t*)(ws + O_QKB); pitch0 = 1152; coff0 = nb0 - C_BQK; }
    else if (nb0 >= C_CQK && nb0 < 4224) { dst0 = (bf16_t*)(ws + O_QKC); pitch0 = 384; coff0 = nb0 - C_CQK; }
    else if (nb0 >= C_D && nb0 < C_E) { dst0 = (bf16_t*)(ws + O_QKVD); pitch0 = 1152; coff0 = nb0 - C_D; }
    else if (nb0 >= C_E && nb0 < C_SM) { dst0 = (bf16_t*)(ws + O_QE); pitch0 = 384; coff0 = nb0 - C_E; }
    else if (nb0 >= C_Z && nb0 < C_MG) { dst0 = (bf16_t*)(ws + O_SZ); pitch0 = 1920; coff0 = nb0 - C_Z; xf0 = 1; }
    else if (nb0 >= C_MG) { dst0 = (bf16_t*)(ws + O_SIG); pitch0 = 5120; coff0 = nb0 - C_MG; xf0 = 2; }
    if (dst0 != nullptr) {
      bf16_t* stg = (bf16_t*)smem + wave * (64 * 72);
#pragma unroll
      for (int ni = 0; ni < 2; ++ni)
#pragma unroll
        for (int mi = 0; mi < 2; ++mi)
#pragma unroll
          for (int g = 0; g < 4; ++g) {
            const int cq = ni * 32 + 8 * g + 4 * h;
            const f32x4 bv = *(const f32x4*)(bias + nb0 + cq);
            float v[4];
#pragma unroll
            for (int e = 0; e < 4; ++e) v[e] = acc[mi][ni][4 * g + e] + bv[e];
            if (xf0 == 1) {
#pragma unroll
              for (int e = 0; e < 4; ++e) v[e] = fsilu(v[e]);
            } else if (xf0 == 2) {
#pragma unroll
              for (int e = 0; e < 4; ++e) v[e] = fsigmoid(v[e]);
            }
            *(u32x2*)(stg + (mi * 32 + r) * 72 + cq) = pk4(v[0], v[1], v[2], v[3]);
          }
      asm volatile("s_waitcnt lgkmcnt(0)" ::: "memory");
      __builtin_amdgcn_wave_barrier();
      const int tok0 = m0 + wr * 64;
#pragma unroll
      for (int it = 0; it < 8; ++it) {
        const int row = it * 8 + (lane >> 3), ch = (lane & 7) * 8;
        const bf16x8 val = *(const bf16x8*)(stg + row * 72 + ch);
        *(bf16x8*)(dst0 + (size_t)(tok0 + row) * pitch0 + coff0 + ch) = val;
      }
      return;
    }
  }
#pragma unroll
  for (int ni = 0; ni < 2; ++ni) {
    const int nb = n0 + wc * 64 + ni * 32;
    int kind;
    int xf = 0;
    bf16_t* dst = nullptr; int pitch = 0, coff = 0;
    int kgrp = 0;
    if (nb < 384) { kind = 0; dst = (bf16_t*)(ws + O_QKA); pitch = 384; coff = nb; }
    else if (nb < C_AV) { kind = 5; dst = (bf16_t*)(ws + O_KFA); coff = nb - 384; }
    else if (nb < C_BQK) { kind = 1; dst = (bf16_t*)(ws + O_VTA); coff = nb - C_AV; }
    else if (nb < 2304) { kind = 0; dst = (bf16_t*)(ws + O_QKB); pitch = 1152; coff = nb - C_BQK; }
    else if (nb < C_BV) { kind = 5; kgrp = (nb - 2304) / 384; dst = (bf16_t*)(ws + O_KFB + kgrp * SZ_VT); coff = (nb - 2304) - kgrp * 384; }
    else if (nb < C_CQK) { kind = 2; dst = (bf16_t*)(ws + O_VTB); coff = nb - C_BV; }
    else if (nb < 4224) { kind = 0; dst = (bf16_t*)(ws + O_QKC); pitch = 384; coff = nb - C_CQK; }
    else if (nb < C_CV) { kind = 5; dst = (bf16_t*)(ws + O_KFC); coff = nb - 4224; }
    else if (nb < C_D) { kind = 1; dst = (bf16_t*)(ws + O_VTC); coff = nb - C_CV; }
    else if (nb < C_E) { kind = 0; dst = (bf16_t*)(ws + O_QKVD); pitch = 1152; coff = nb - C_D; }
    else if (nb < C_SM) { kind = 0; dst = (bf16_t*)(ws + O_QE); pitch = 384; coff = nb - C_E; }
    else if (nb < C_Z) { kind = (nb == C_SM) ? 3 : 4; }
    else if (nb < C_MG) { kind = 0; xf = 1; dst = (bf16_t*)(ws + O_SZ); pitch = 1920; coff = nb - C_Z; }
    else { kind = 0; xf = 2; dst = (bf16_t*)(ws + O_SIG); pitch = 5120; coff = nb - C_MG; }
    if (kind == 4) continue;
#pragma unroll
    for (int mi = 0; mi < 2; ++mi) {
      const int tok = m0 + wr * 64 + mi * 32 + r;
#pragma unroll
      for (int g = 0; g < 4; ++g) {
        const int cq = 8 * g + 4 * h;
        const f32x4 bv = *(const f32x4*)(bias + nb + cq);
        float v[4];
#pragma unroll
        for (int e = 0; e < 4; ++e) v[e] = acc[mi][ni][4 * g + e] + bv[e];
        if (kind == 0) {
          if (xf == 1) {
#pragma unroll
            for (int e = 0; e < 4; ++e) v[e] = fsilu(v[e]);
          } else if (xf == 2) {
#pragma unroll
            for (int e = 0; e < 4; ++e) v[e] = fsigmoid(v[e]);
          }
          *(u32x2*)(dst + (size_t)tok * pitch + coff + cq) = pk4(v[0], v[1], v[2], v[3]);
        } else if (kind == 5) {
          const int key = kgrp == 0 ? tok : kgrp == 1 ? (tok & 3) * 2048 + (tok >> 2) : (tok & 15) * 512 + (tok >> 4);
          *(u32x2*)(dst + kfrag_col(coff + cq) + kfrag_key(key)) = pk4(v[0], v[1], v[2], v[3]);
        } else if (kind == 1) {
          const int ko = vfrag_key(tok);
#pragma unroll
          for (int e = 0; e < 4; ++e) dst[vfrag_col(coff + cq + e) + ko] = f2bf(v[e]);
        } else if (kind == 2) {
          const int k1 = vfrag_key(tok), k4 = vfrag_key((tok & 3) * 2048 + (tok >> 2)), k16 = vfrag_key((tok & 15) * 512 + (tok >> 4));
#pragma unroll
          for (int e = 0; e < 4; ++e) {
            const bf16_t b = f2bf(v[e]); const int co = vfrag_col(coff + cq + e);
            dst[co + k1] = b; dst[SZ_VT / 2 + co + k4] = b; dst[SZ_VT + co + k16] = b;
          }
        } else {
          float* sm = (float*)(ws + O_SM);
#pragma unroll
          for (int e = 0; e < 4; ++e) if (cq + e < 18) sm[tok * 32 + cq + e] = v[e];
        }
      }
    }
  }
}


DI int g_lds_byte(int r, int c) { const int st = (r >> 4) * 2 + (c >> 5), ob = (r & 15) * 64 + (c & 31) * 2; return st * 1024 + (ob ^ (((ob >> 9) & 1) << 5)); }
DI void g_stage_rc(int b, int& R, int& C) { const int st = b >> 10, sb = b & 1023, swz = sb ^ (((sb >> 9) & 1) << 5); R = (st >> 1) * 16 + (swz >> 6); C = (st & 1) * 32 + ((swz & 63) >> 1); }

DI float row16_sum(float v);
DI void p1_unit(const Params& p, int layer, int half, int pm, int pn, int pm_next, int pn_next  , bool first, unsigned char* lds) {
  const int tid = rtid(), wid = tid >> 6, lane = tid & 63, wr = wid >> 2, wc = wid & 3, fr = lane & 15, fq = lane >> 4;
  const bf16_t* Ab = (const bf16_t*)(p.ws + O_XB) + ((size_t)half * TH + (size_t)pm * 256) * 1024;
  const bf16_t* Bb = (const bf16_t*)(p.ws + O_WTIN + layer * SZ_WTIN1) + (size_t)pn * 256 * 1024;
  int sOff[4];
#pragma unroll
  for (int i = 0; i < 4; ++i) { int R, C; g_stage_rc(wid * 1024 + i * 8192 + lane * 16, R, C); sOff[i] = R * 1024 + C; }
  auto stage2 = [&](const bf16_t* A_, const bf16_t* B_, int buf, int kt) {
#pragma unroll
    for (int i = 0; i < 4; ++i) {
      __builtin_amdgcn_global_load_lds((const unsigned*)(A_ + sOff[i] + kt * 64), (unsigned*)(lds + buf * 65536 + wid * 1024 + i * 8192), 16, 0, 0);
      __builtin_amdgcn_global_load_lds((const unsigned*)(B_ + sOff[i] + kt * 64), (unsigned*)(lds + buf * 65536 + 32768 + wid * 1024 + i * 8192), 16, 0, 0);
    }
  };
  auto stage = [&](int buf, int kt) { stage2(Ab, Bb, buf, kt); };
  f32x4 acc[8][4];
#pragma unroll
  for (int m = 0; m < 8; ++m)
#pragma unroll
    for (int n = 0; n < 4; ++n) acc[m][n] = (f32x4){0.f, 0.f, 0.f, 0.f};
  const int lane_off = (fr * 64 + fq * 16) ^ ((fr >> 3) << 5);
  if (first) { __syncthreads(); stage(0, 0); }
  asm volatile("s_waitcnt vmcnt(0)" ::: "memory");
  __syncthreads();
#pragma unroll 1
  for (int t = 0; t < 16; ++t) {
    const int cur = t & 1;
    {
      const bool last = (t + 1 == 16);
      if (!last || pn_next >= 0) {
        const long dA = last ? (long)(pm_next - pm) * 256 * 1024 - 0 : (long)(t + 1) * 64;
        const long dB = last ? (long)(pn_next - pn) * 256 * 1024 - 0 : (long)(t + 1) * 64;
#pragma unroll
        for (int i = 0; i < 4; ++i) {
          __builtin_amdgcn_global_load_lds((const unsigned*)(Ab + sOff[i] + dA), (unsigned*)(lds + (cur ^ 1) * 65536 + wid * 1024 + i * 8192), 16, 0, 0);
          __builtin_amdgcn_global_load_lds((const unsigned*)(Bb + sOff[i] + dB), (unsigned*)(lds + (cur ^ 1) * 65536 + 32768 + wid * 1024 + i * 8192), 16, 0, 0);
        }
      }
    }
    const unsigned char* SA = lds + cur * 65536 + wr * 16384 + lane_off;
    const unsigned char* SB = lds + cur * 65536 + 32768 + wc * 8192 + lane_off;
    bf16x8 Bf[2][4], At[2][2];
#pragma unroll
    for (int n = 0; n < 4; ++n) Bf[0][n] = *(const bf16x8*)(SB + n * 2048);
#pragma unroll
    for (int m = 0; m < 2; ++m) At[0][m] = *(const bf16x8*)(SA + m * 2048);
#pragma unroll
    for (int g = 0; g < 8; ++g) {
      const int ks = g >> 2, pr = g & 3;
      if (g == 1) {
#pragma unroll
        for (int n = 0; n < 4; ++n) Bf[1][n] = *(const bf16x8*)(SB + n * 2048 + 1024);
      }
      if (g < 7) {
        const int g1 = g + 1;
#pragma unroll
        for (int m = 0; m < 2; ++m) At[g1 & 1][m] = *(const bf16x8*)(SA + ((g1 & 3) * 2 + m) * 2048 + (g1 >> 2) * 1024);
      }
      asm volatile("" : "+v"(acc[pr * 2][0][0]) :: "memory");
#pragma unroll
      for (int m = 0; m < 2; ++m)
#pragma unroll
        for (int n = 0; n < 4; ++n) acc[pr * 2 + m][n] = MFMA16(Bf[ks][n], At[g & 1][m], acc[pr * 2 + m][n]);
    }
    asm volatile("s_waitcnt vmcnt(0)" ::: "memory");
    __syncthreads();
  }
  const int nb0 = pn * 256 + wc * 64, tok0 = pm * 256 + wr * 128;
  const float* bias = (const float*)(p.ws + O_BIASP) + layer * NP;
  unsigned char* ws = p.ws;
  int kind, xf = 0, kgrp = 0, pitch = 0, coff = 0; bf16_t* dst = nullptr;
  if (nb0 < 384) { kind = 0; dst = (bf16_t*)(ws + O_QKA); pitch = 384; coff = nb0; }
  else if (nb0 < C_AV) { kind = 5; dst = (bf16_t*)(ws + O_KFA); coff = nb0 - 384; }
  else if (nb0 < C_BQK) { kind = 1; dst = (bf16_t*)(ws + O_VTA); coff = nb0 - C_AV; }
  else if (nb0 < 2304) { kind = 0; dst = (bf16_t*)(ws + O_QKB); pitch = 1152; coff = nb0 - C_BQK; }
  else if (nb0 < C_BV) { kind = 5; kgrp = (nb0 - 2304) / 384; dst = (bf16_t*)(ws + O_KFB + kgrp * SZ_VT); coff = (nb0 - 2304) - kgrp * 384; }
  else if (nb0 < C_CQK) { kind = 2; dst = (bf16_t*)(ws + O_VTB); coff = nb0 - C_BV; }
  else if (nb0 < 4224) { kind = 0; dst = (bf16_t*)(ws + O_QKC); pitch = 384; coff = nb0 - C_CQK; }
  else if (nb0 < C_CV) { kind = 5; dst = (bf16_t*)(ws + O_KFC); coff = nb0 - 4224; }
  else if (nb0 < C_D) { kind = 1; dst = (bf16_t*)(ws + O_VTC); coff = nb0 - C_CV; }
  else if (nb0 < C_E) { kind = 0; dst = (bf16_t*)(ws + O_QKVD); pitch = 1152; coff = nb0 - C_D; }
  else if (nb0 < C_SM) { kind = 0; dst = (bf16_t*)(ws + O_QE); pitch = 384; coff = nb0 - C_E; }
  else if (nb0 < C_Z) { kind = (nb0 == C_SM) ? 3 : 4; }
  else if (nb0 < C_MG) { kind = 0; xf = 1; dst = (bf16_t*)(ws + O_SZ); pitch = 1920; coff = nb0 - C_Z; }
  else if (nb0 < 13696) { kind = 0; xf = 2; dst = (bf16_t*)(ws + O_SIG); pitch = 5120; coff = nb0 - C_MG; }
  else { kind = 4; }
  if (kind == 4) return;
  if (kind == 0) {
    bf16_t* stg = (bf16_t*)(lds + 65536 + wid * 9216);
#pragma unroll
    for (int mh = 0; mh < 2; ++mh) {
#pragma unroll
      for (int m = 0; m < 4; ++m)
#pragma unroll
        for (int n = 0; n < 4; ++n) {
          const int c4 = n * 16 + fq * 4;
          const f32x4 bv = *(const f32x4*)(bias + nb0 + c4);
          float v[4];
#pragma unroll
          for (int e = 0; e < 4; ++e) v[e] = acc[mh * 4 + m][n][e] + bv[e];
          if (xf == 1) {
#pragma unroll
            for (int e = 0; e < 4; ++e) v[e] = fsilu(v[e]);
          } else if (xf == 2) {
#pragma unroll
            for (int e = 0; e < 4; ++e) v[e] = fsigmoid(v[e]);
          }
          *(u32x2*)(stg + (m * 16 + fr) * 72 + c4) = pk4(v[0], v[1], v[2], v[3]);
        }
      asm volatile("s_waitcnt lgkmcnt(0)" ::: "memory");
      __builtin_amdgcn_wave_barrier();
#pragma unroll
      for (int it = 0; it < 8; ++it) {
        const int row = it * 8 + (lane >> 3), ch = (lane & 7) * 8;
        const bf16x8 val = *(const bf16x8*)(stg + row * 72 + ch);
        *(bf16x8*)(dst + (size_t)(tok0 + mh * 64 + row) * pitch + coff + ch) = val;
      }
      asm volatile("s_waitcnt lgkmcnt(0)" ::: "memory");
      __builtin_amdgcn_wave_barrier();
    }
    return;
  }
  if (nb0 >= 384 && nb0 < C_AV) {
    float* ksum = (float*)(ws + O_KSUM) + (size_t)(pm * 2 + wr) * 384 + (nb0 - 384);
#pragma unroll
    for (int n = 0; n < 4; ++n) {
      const f32x4 bv = *(const f32x4*)(bias + nb0 + n * 16 + fq * 4);
#pragma unroll
      for (int e = 0; e < 4; ++e) {
        float t = 8.f * bv[e];
#pragma unroll
        for (int m = 0; m < 8; ++m) t += acc[m][n][e];
        t = row16_sum(t);
        if (fr == 0) ksum[n * 16 + fq * 4 + e] = t;
      }
    }
  }
#pragma unroll
  for (int m = 0; m < 8; ++m) {
    const int tok = tok0 + m * 16 + fr;
#pragma unroll
    for (int n = 0; n < 4; ++n) {
      const int c4 = n * 16 + fq * 4;
      const f32x4 bv = *(const f32x4*)(bias + nb0 + c4);
      float v[4];
#pragma unroll
      for (int e = 0; e < 4; ++e) v[e] = acc[m][n][e] + bv[e];
      if (kind == 5) {
        const int key = kgrp == 0 ? tok : kgrp == 1 ? (tok & 3) * 2048 + (tok >> 2) : (tok & 15) * 512 + (tok >> 4);
        *(u32x2*)(dst + kfrag_col(coff + c4) + kfrag_key(key)) = pk4(v[0], v[1], v[2], v[3]);
      } else if (kind == 1) {
        const int ko = vfrag_key(tok);
#pragma unroll
        for (int e = 0; e < 4; ++e) dst[vfrag_col(coff + c4 + e) + ko] = f2bf(v[e]);
      } else if (kind == 2) {
        const int k1 = vfrag_key(tok), k4 = vfrag_key((tok & 3) * 2048 + (tok >> 2)), k16 = vfrag_key((tok & 15) * 512 + (tok >> 4));
#pragma unroll
        for (int e = 0; e < 4; ++e) {
          const bf16_t b = f2bf(v[e]); const int co = vfrag_col(coff + c4 + e);
          dst[co + k1] = b; dst[SZ_VT / 2 + co + k4] = b; dst[SZ_VT + co + k16] = b;
        }
      } else {
        float* sm = (float*)(ws + O_SM);
#pragma unroll
        for (int e = 0; e < 4; ++e) if (c4 + e < 18) sm[tok * 32 + c4 + e] = v[e];
      }
    }
  }
}

DI void fox_prep(const Params& p, int hh, unsigned char* smem) {
  float* red = (float*)smem;
  const int tid = otid(), lane = tid & 63, wave = tid >> 6;
  const float* sm = (const float*)(p.ws + O_SM);
  float* FF = (float*)(p.ws + O_FF) + hh * TH;
  float loc[32];
#pragma unroll
  for (int j = 0; j < 32; ++j) loc[j] = sm[(tid * 32 + j) * 32 + hh];
  float s = 0.f;
#pragma unroll
  for (int j = 0; j < 32; ++j) { const float xv = loc[j]; s += fminf(xv, 0.f) - log1pf(expf(-fabsf(xv))); loc[j] = s; }
  float inc = s;
#pragma unroll
  for (int o = 1; o < 64; o <<= 1) { const float t = __shfl_up(inc, o); if (lane >= o) inc += t; }
  if (lane == 63) red[wave] = inc;
  sub_sync();
  float off = inc - s;
  for (int w = 0; w < wave; ++w) off += red[w];
#pragma unroll
  for (int j4 = 0; j4 < 8; ++j4) {
    f32x4 o4 = {off + loc[4 * j4], off + loc[4 * j4 + 1], off + loc[4 * j4 + 2], off + loc[4 * j4 + 3]};
    *(f32x4*)(FF + tid * 32 + 4 * j4) = o4;
  }
  sub_sync();
}

DI void kmean_prep(const Params& p, int idx, unsigned* kmaxu) {
  const int lane = otid() & 63;
  const int hh = idx / 32, blk = idx % 32;
  const bf16_t* k = (const bf16_t*)(p.ws + O_KFA) + kfrag_col(hh * 64 + lane) + blk * 8 * 2048;
  float s = 0.f;
#pragma unroll 8
  for (int i = 0; i < 256; ++i) s += bf2f(k[(i >> 5) * 2048 + (i & 31) * 8]);
  s *= (1.f / 256.f);
  const bf16_t hi = f2bf(s);
  bf16_t* km = (bf16_t*)(p.ws + O_KM);
  km[(hh * 32 + blk) * 64 + lane] = hi;
  km[6 * 32 * 64 + (hh * 32 + blk) * 64 + lane] = f2bf(s - bf2f(hi));
  const bf16_t* kc = (const bf16_t*)(p.ws + O_KFC) + (size_t)hh * 524288;
  float mx = 0.f;
#pragma unroll
  for (int t = 0; t < 4; ++t) {
    const int key = blk * 256 + lane * 4 + t;
    float kk = 0.f;
#pragma unroll
    for (int c = 0; c < 8; ++c) { float v[8]; unpk8(*(const bf16x8*)(kc + kfrag_key(key) + c * 256), v);
#pragma unroll
      for (int e = 0; e < 8; ++e) kk += v[e] * v[e]; }
    mx = fmaxf(mx, kk);
  }
#pragma unroll
  for (int o = 32; o >= 1; o >>= 1) mx = fmaxf(mx, __shfl_xor(mx, o));
  if (lane == 0) atomicMax(kmaxu + hh, __float_as_uint(mx));
}

DI void memkv_tile(const Params& p, int layer, int half, int mt, int nt, unsigned char* smem) {
  bf16_t* As = (bf16_t*)smem; bf16_t* Bs = As + 2 * 9216;
  f32x16 acc[2][2]; zero_acc(acc);
  PlainA al{(const bf16_t*)(p.ws + O_MEMN) + (size_t)half * 256 * 1024, 1024};
  const int m0 = mt * 128, n0 = nt * 128;
  gemm_kloop(al, (const bf16_t*)(p.ws + O_WTKV + layer * SZ_WTKV1), 1024, 16, m0, n0, acc, As, Bs);
  const int tid = otid(), lane = tid & 63, wave = tid >> 6, wr = wave >> 1, wc = wave & 1, r = lane & 31, h = lane >> 5;
  bf16_t* mk = (bf16_t*)(p.ws + O_MEMK); bf16_t* mv = (bf16_t*)(p.ws + O_MEMVT);
#pragma unroll
  for (int ni = 0; ni < 2; ++ni)
#pragma unroll
    for (int mi = 0; mi < 2; ++mi) {
      const int m = m0 + wr * 64 + mi * 32 + r;
#pragma unroll
      for (int i = 0; i < 16; ++i) {
        const int col = n0 + wc * 64 + ni * 32 + crow(i, h);
        const bf16_t b = f2bf(acc[mi][ni][i]);
        if (col < 384) { const int hd = col / 96, d = col % 96; mk[(size_t)((half * 4 + hd) * 8 + (m >> 5)) * 3072 + (d >> 4) * 512 + ((d >> 3) & 1) * 256 + (m & 31) * 8 + (d & 7)] = b; }
        else { const int cc = col - 384, hd = cc / 96, d = cc % 96, kk = m & 31;
          mv[(size_t)((half * 4 + hd) * 8 + (m >> 5)) * 3072 + (d >> 5) * 1024 + (kk >> 4) * 512 + ((kk >> 2) & 1) * 256 + (d & 31) * 8 + ((kk >> 3) & 1) * 4 + (kk & 3)] = b; }
      }
    }
}

DI f32x16 mm_quad(const bf16_t* A, const bf16_t* B, int wr, int wc, int r, int h) {
  f32x16 acc;
#pragma unroll
  for (int i = 0; i < 16; ++i) acc[i] = 0.f;
  const bf16_t* a_ = A + (wr * 32 + r) * 72 + 8 * h;
  const bf16_t* b_ = B + (wc * 32 + r) * 72 + 8 * h;
#pragma unroll
  for (int s = 0; s < 4; ++s) acc = MFMA32(*(const bf16x8*)(a_ + 16 * s), *(const bf16x8*)(b_ + 16 * s), acc);
  return acc;
}

DI void gdn_prep(const Params& p, int layer, int half, int hh, int c, unsigned char* smem) {
  bf16_t* QN = (bf16_t*)smem; bf16_t* KN = QN + 4608; bf16_t* KB = KN + 4608; bf16_t* KDT = KB + 4608; bf16_t* VBT = KDT + 4608;
  bf16_t* KBET = VBT + 4608; bf16_t* QKm = KBET + 4608; bf16_t* Tm = QKm + 4608;
  float* gcv = (float*)(smem + 73728); float* betav = gcv + 64; float* egc = gcv + 128;
  float* Mf = (float*)(smem + 9216);
  bf16_t* UT = KN; bf16_t* WT = KB;
  int tid = otid();
  int lane = tid & 63, wave = tid >> 6, wr = wave >> 1, wc = wave & 1, r = lane & 31, h = lane >> 5;
#define REOPAQUE() do { asm volatile("" : "+v"(tid)); lane = tid & 63; wave = tid >> 6; wr = wave >> 1; wc = wave & 1; r = lane & 31; h = lane >> 5; } while (0)
  const float* sm = (const float*)(p.ws + O_SM);
  if (wave == 0) {
    const int tok = c * 64 + lane;
    const float bt = fsigmoid(sm[tok * 32 + 6 + hh]);
    const float xv = sm[tok * 32 + 12 + hh] + p.dt_bias[layer * 6 + hh];
    const float sp = fmaxf(xv, 0.f) + log1pf(expf(-fabsf(xv)));
    float g = -expf(p.a_log[layer * 6 + hh]) * sp;
#pragma unroll
    for (int o = 1; o < 64; o <<= 1) { const float t = __shfl_up(g, o); if (lane >= o) g += t; }
    gcv[lane] = g; betav[lane] = bt; egc[lane] = expf(g);
    if (lane == 63) ((float*)(p.ws + O_GL))[hh * 128 + c] = expf(g);
  }
  sub_sync();
  REOPAQUE();
  {
    const int t = tid >> 2, cg4 = tid & 3, ch0 = cg4 * 16;
    const bf16_t* src = (const bf16_t*)(p.ws + O_QKVD);
    const float* cw = p.conv_w + (size_t)layer * 4 * 1152;
    const float bt = betav[t], gct = gcv[t], eg = egc[t], ed = expf(gcv[63] - gct);
    auto convpart = [&](int pt, float (&val)[16]) {
      const int col = pt * 384 + hh * 64 + ch0;
#pragma unroll
      for (int e = 0; e < 16; ++e) val[e] = 0.f;
#pragma unroll
      for (int j = 0; j < 4; ++j) {
        const int row = c * 64 + t - 3 + j;
        if (row >= 0) {
          float xv[16];
          unpk8(*(const bf16x8*)(src + (size_t)row * 1152 + col), xv);
          unpk8(*(const bf16x8*)(src + (size_t)row * 1152 + col + 8), xv + 8);
#pragma unroll
          for (int e4 = 0; e4 < 4; ++e4) {
            const f32x4 w4 = *(const f32x4*)(cw + j * 1152 + col + 4 * e4);
#pragma unroll
            for (int e = 0; e < 4; ++e) val[4 * e4 + e] += w4[e] * xv[4 * e4 + e];
          }
        }
      }
#pragma unroll
      for (int e = 0; e < 16; ++e) val[e] = fsilu(val[e]);
    };
    {
      float val[16]; convpart(0, val);
      float sq = 0.f;
#pragma unroll
      for (int e = 0; e < 16; ++e) sq += val[e] * val[e];
      sq += __shfl_xor(sq, 1); sq += __shfl_xor(sq, 2);
      const float rq = rsqrtf(sq + 1e-6f) * 0.125f;
#pragma unroll
      for (int e = 0; e < 16; ++e) val[e] *= rq;
      *(bf16x8*)(QN + t * 72 + ch0) = pk8(val); *(bf16x8*)(QN + t * 72 + ch0 + 8) = pk8(val + 8);
    }
    asm volatile("" ::: "memory");
    {
      float val[16]; convpart(1, val);
      float sk = 0.f;
#pragma unroll
      for (int e = 0; e < 16; ++e) sk += val[e] * val[e];
      sk += __shfl_xor(sk, 1); sk += __shfl_xor(sk, 2);
      const float rk = rsqrtf(sk + 1e-6f);
      float kb[16];
#pragma unroll
      for (int e = 0; e < 16; ++e) { val[e] *= rk; kb[e] = val[e] * bt; }
      *(bf16x8*)(KN + t * 72 + ch0) = pk8(val); *(bf16x8*)(KN + t * 72 + ch0 + 8) = pk8(val + 8);
      *(bf16x8*)(KB + t * 72 + ch0) = pk8(kb); *(bf16x8*)(KB + t * 72 + ch0 + 8) = pk8(kb + 8);
#pragma unroll
      for (int e = 0; e < 16; ++e) {
        KDT[(ch0 + e) * 72 + t] = f2bf(val[e] * ed);
        KBET[(ch0 + e) * 72 + t] = f2bf(kb[e] * eg);
      }
    }
    asm volatile("" ::: "memory");
    {
      float val[16]; convpart(2, val);
#pragma unroll
      for (int e = 0; e < 16; ++e) VBT[(ch0 + e) * 72 + t] = f2bf(val[e] * bt);
    }
  }
  sub_sync();
  REOPAQUE();
  {
    const f32x16 kk = mm_quad(KB, KN, wr, wc, r, h);
    const f32x16 qk = mm_quad(QN, KN, wr, wc, r, h);
    sub_sync();
    const int j = wc * 32 + r; const float gj = gcv[j];
#pragma unroll
    for (int i = 0; i < 16; ++i) {
      const int row = wr * 32 + crow(i, h);
      const float dec = (row >= j) ? expf(gcv[row] - gj) : 0.f;
      Mf[row * 68 + j] = (row > j) ? kk[i] * dec : 0.f;
      QKm[row * 72 + j] = f2bf(qk[i] * dec);
    }
  }
  sub_sync();
  REOPAQUE();
  if (wave == 0) {
    float t[64];
#pragma unroll
    for (int i = 0; i < 64; ++i) {
      float a4[4] = {(i == lane) ? 1.f : 0.f, 0.f, 0.f, 0.f};
#pragma unroll
      for (int j4 = 0; j4 < (i + 3) / 4; ++j4) {
        const f32x4 mrow = *(const f32x4*)(Mf + i * 68 + 4 * j4);
#pragma unroll
        for (int e = 0; e < 4; ++e) if (4 * j4 + e < i) a4[e] -= mrow[e] * t[4 * j4 + e];
      }
      const float a = (a4[0] + a4[1]) + (a4[2] + a4[3]);
      t[i] = a;
      Tm[i * 72 + lane] = f2bf(a);
      asm volatile("" ::: "memory");
    }
  }
  sub_sync();
  REOPAQUE();
  {
    const f32x16 u = mm_quad(Tm, VBT, wr, wc, r, h);
    const f32x16 w = mm_quad(Tm, KBET, wr, wc, r, h);
    const int col = wc * 32 + r;
#pragma unroll
    for (int g = 0; g < 4; ++g) {
      const int i0 = wr * 32 + 8 * g + 4 * h;
      *(u32x2*)(UT + col * 72 + i0) = pk4(u[4 * g], u[4 * g + 1], u[4 * g + 2], u[4 * g + 3]);
      *(u32x2*)(WT + col * 72 + i0) = pk4(w[4 * g], w[4 * g + 1], w[4 * g + 2], w[4 * g + 3]);
    }
  }
  sub_sync();
  REOPAQUE();
  {
    bf16_t* base = (bf16_t*)(p.ws + O_DPREP + (size_t)(hh * 128 + c) * 32768);
    const int n = wc * 32 + r;
    {
      const int ks = n >> 5, jh = (n >> 4) & 1, q = (n >> 2) & 3, jl = n & 3, jj = 4 * jh + jl;
      const int cbase = (ks * 64 + 16 * q) * 8 + jj;
      {
        const f32x16 P = mm_quad(KDT, WT, wr, wc, r, h);
#pragma unroll
        for (int i = 0; i < 16; ++i) {
          const int m = wr * 32 + crow(i, h);
          base[((m >> 4) * 128 + (m & 15)) * 8 + cbase] = f2bf(P[i]);
        }
      }
      asm volatile("" ::: "memory");
      {
        const f32x16 QW = mm_quad(QKm, WT, wr, wc, r, h);
#pragma unroll
        for (int i = 0; i < 16; ++i) {
          const int m = wr * 32 + crow(i, h);
          const float qd = bf2f(QN[m * 72 + n]) * egc[m];
          base[4096 + ((m >> 4) * 128 + (m & 15)) * 8 + cbase] = f2bf(qd - QW[i]);
        }
      }
      asm volatile("" ::: "memory");
    }
    const int jsl = n >> 4;
    {
      const f32x16 Bc = mm_quad(KDT, UT, wr, wc, r, h);
#pragma unroll
      for (int g = 0; g < 4; ++g) {
        const int row0 = wr * 32 + 8 * g + 4 * h;
        const int rt = row0 >> 4, lp = 16 * ((row0 >> 2) & 3) + (n & 15);
        *(u32x2*)(base + 8192 + ((jsl * 4 + rt) * 64 + lp) * 4) = pk4(Bc[4 * g], Bc[4 * g + 1], Bc[4 * g + 2], Bc[4 * g + 3]);
      }
    }
    asm volatile("" ::: "memory");
    {
      const f32x16 O0 = mm_quad(QKm, UT, wr, wc, r, h);
#pragma unroll
      for (int g = 0; g < 4; ++g) {
        const int row0 = wr * 32 + 8 * g + 4 * h;
        const int rt = row0 >> 4, lp = 16 * ((row0 >> 2) & 3) + (n & 15);
        *(u32x2*)(base + 12288 + ((jsl * 4 + rt) * 64 + lp) * 4) = pk4(O0[4 * g], O0[4 * g + 1], O0[4 * g + 2], O0[4 * g + 3]);
      }
    }
  }
  sub_sync();
#undef REOPAQUE
}

struct TileDesc { const bf16_t* k; const bf16_t* v; const float* aux; int tag; };

template <int DHT, bool AUX>
struct TileRegs { bf16x8 k[DHT / 16]; bf16x8 v[DHT / 32][2]; f32x4 a[4]; };

template <int DHT, bool AUX>
DI void load_tile(const bf16_t* kp, const bf16_t* vp, const float* ap, long ldv, TileRegs<DHT, AUX>& t) {
#pragma unroll
  for (int s = 0; s < DHT / 16; ++s) t.k[s] = *(const bf16x8*)(kp + 512 * s);
#pragma unroll
  for (int dt = 0; dt < DHT / 32; ++dt)
#pragma unroll
    for (int s = 0; s < 2; ++s) t.v[dt][s] = *(const bf16x8*)(vp + (dt * 2 + s) * 512);
  if (AUX) {
#pragma unroll
    for (int g = 0; g < 4; ++g) t.a[g] = *(const f32x4*)(ap + 8 * g);
  }
}

template <int DHT, bool AUX, class TF, class MF, class SF>
DI void attn_loop(int maxtiles, TF&& tf, MF&& mf, SF&& stopf, const bf16x8 (&qf)[DHT / 16], long ldv, float scale2,
                  f32x16 (&o)[DHT / 32], float& m, float& l) {
  TileRegs<DHT, AUX> cur, nxt;
  int tagc, tagn;
  bf16x8 qf0 = qf[0];
  { const bf16_t* kp; const bf16_t* vp; const float* ap = nullptr; tagc = tf(0, kp, vp, ap); load_tile<DHT, AUX>(kp, vp, ap, ldv, cur); }
#pragma unroll 1
  for (int t = 0; t < maxtiles; ++t) {
    { const bf16_t* kp; const bf16_t* vp; const float* ap = nullptr; tagn = tf(t + 1, kp, vp, ap); load_tile<DHT, AUX>(kp, vp, ap, ldv, nxt); }
    { bf16x8 q0 = qf[0]; asm volatile("" : "+v"(q0) :: "memory"); qf0 = q0; }
    f32x16 sacc;
#pragma unroll
    for (int i = 0; i < 16; ++i) sacc[i] = 0.f;
#pragma unroll
    for (int s = 0; s < DHT / 16; ++s) sacc = MFMA32(cur.k[s], s == 0 ? qf0 : qf[s], sacc);
    float sv[16]; float mx = NEG_INF;
#pragma unroll
    for (int i = 0; i < 16; ++i) { sv[i] = sacc[i] * scale2 + mf(tagc, i, AUX ? cur.a[i >> 2][i & 3] : 0.f); mx = fmaxf(mx, sv[i]); }
    mx = fmaxf(mx, __shfl_xor(mx, 32));
    const float mnew = fmaxf(m, mx);
    const float alpha = __builtin_amdgcn_exp2f(m - mnew);
    m = mnew;
    float pv[16]; float ps = 0.f;
#pragma unroll
    for (int i = 0; i < 16; ++i) { pv[i] = __builtin_amdgcn_exp2f(sv[i] - mnew); ps += pv[i]; }
    l = l * alpha + ps;
#pragma unroll
    for (int dt = 0; dt < DHT / 32; ++dt)
#pragma unroll
      for (int i = 0; i < 16; ++i) o[dt][i] *= alpha;
    bf16x8 pf[2]; pf[0] = pk8(pv); pf[1] = pk8(pv + 8);
#pragma unroll
    for (int dt = 0; dt < DHT / 32; ++dt)
#pragma unroll
      for (int s = 0; s < 2; ++s) {
        o[dt] = MFMA32(cur.v[dt][s], pf[s], o[dt]);
      }
    if (stopf(t, m, AUX ? cur.a[0][0] : 0.f)) break;
    cur = nxt; tagc = tagn;
  }
}

template <int DHT>
DI void attn_store(const f32x16 (&o)[DHT / 32], float l, bf16_t* dstrow, int h, float& ltot_out, bool valid = true) {
  const float ltot = l + __shfl_xor(l, 32);
  ltot_out = ltot;
  const float inv = ltot > 0.f ? 1.f / ltot : 0.f;
  if (valid)
#pragma unroll
  for (int dt = 0; dt < DHT / 32; ++dt)
#pragma unroll
    for (int g = 0; g < 4; ++g)
      *(u32x2*)(dstrow + dt * 32 + 8 * g + 4 * h) = pk4(o[dt][4 * g] * inv, o[dt][4 * g + 1] * inv, o[dt][4 * g + 2] * inv, o[dt][4 * g + 3] * inv);
}

template <int DHT>
DI void attn_store_gated(const f32x16 (&o)[DHT / 32], float l, bf16_t* szrow, int h) {
  const float ltot = l + __shfl_xor(l, 32);
  const float inv = ltot > 0.f ? 1.f / ltot : 0.f;
#pragma unroll
  for (int dt = 0; dt < DHT / 32; ++dt)
#pragma unroll
    for (int g = 0; g < 4; ++g) {
      bf16_t* q = szrow + dt * 32 + 8 * g + 4 * h;
      const u32x2 z = *(const u32x2*)q;
      *(u32x2*)q = pk4(o[dt][4 * g] * inv * bflo(z.x), o[dt][4 * g + 1] * inv * bfhi(z.x), o[dt][4 * g + 2] * inv * bflo(z.y), o[dt][4 * g + 3] * inv * bfhi(z.y));
    }
}

template <int N>
DI void zero_o(f32x16 (&o)[N]) {
#pragma unroll
  for (int a = 0; a < N; ++a)
#pragma unroll
    for (int i = 0; i < 16; ++i) o[a][i] = 0.f;
}

DI void top3_insert(float v, int n, float& v0, float& v1, float& v2, int& i0, int& i1, int& i2) {
  const bool g0 = v > v0, g1 = v > v1, g2 = v > v2;
  v2 = g1 ? v1 : (g2 ? v : v2); i2 = g1 ? i1 : (g2 ? n : i2);
  v1 = g0 ? v0 : (g1 ? v : v1); i1 = g0 ? i0 : (g1 ? n : i1);
  v0 = g0 ? v : v0;             i0 = g0 ? n : i0;
}

DI void moba_select(const Params& p, int a) {
  const int lane = otid() & 63, r = lane & 31, h = lane >> 5;
  const int qtile = a / 6, hh = a % 6, qb = qtile >> 3;
  unsigned mask = 0;
  if (qb > 0) {
    const bf16_t* qrow = (const bf16_t*)(p.ws + O_QKA) + (size_t)(qtile * 32 + r) * 384 + hh * 64 + 8 * h;
    bf16x8 qf[4];
#pragma unroll
    for (int s = 0; s < 4; ++s) qf[s] = *(const bf16x8*)(qrow + 16 * s);
    const float* ks0 = (const float*)(p.ws + O_KSUM) + (size_t)(r * 2) * 384 + hh * 64 + 8 * h;
    f32x16 g;
#pragma unroll
    for (int i = 0; i < 16; ++i) g[i] = 0.f;
#pragma unroll
    for (int s = 0; s < 4; ++s) {
      const f32x4 a0 = *(const f32x4*)(ks0 + 16 * s), a1 = *(const f32x4*)(ks0 + 16 * s + 4);
      const f32x4 b0 = *(const f32x4*)(ks0 + 384 + 16 * s), b1 = *(const f32x4*)(ks0 + 384 + 16 * s + 4);
      float hi[8], lo[8];
#pragma unroll
      for (int e = 0; e < 4; ++e) {
        const float m0 = (a0[e] + b0[e]) * (1.f / 256.f), m1 = (a1[e] + b1[e]) * (1.f / 256.f);
        hi[e] = bf2f(f2bf(m0)); lo[e] = m0 - hi[e];
        hi[4 + e] = bf2f(f2bf(m1)); lo[4 + e] = m1 - hi[4 + e];
      }
      g = MFMA32(pk8(hi), qf[s], g); g = MFMA32(pk8(lo), qf[s], g);
    }
    float v0 = NEG_INF, v1 = NEG_INF, v2 = NEG_INF; int i0 = -1, i1 = -1, i2 = -1;
#pragma unroll
    for (int i = 0; i < 16; ++i) { const int n = crow(i, h); if (n < qb) top3_insert(g[i], n, v0, v1, v2, i0, i1, i2); }
    const float pv0 = __shfl_xor(v0, 32), pv1 = __shfl_xor(v1, 32), pv2 = __shfl_xor(v2, 32);
    const int pi0 = __shfl_xor(i0, 32), pi1 = __shfl_xor(i1, 32), pi2 = __shfl_xor(i2, 32);
    if (pi0 >= 0) top3_insert(pv0, pi0, v0, v1, v2, i0, i1, i2);
    if (pi1 >= 0) top3_insert(pv1, pi1, v0, v1, v2, i0, i1, i2);
    if (pi2 >= 0) top3_insert(pv2, pi2, v0, v1, v2, i0, i1, i2);
    if (i0 >= 0) mask |= 1u << i0;
    if (i1 >= 0) mask |= 1u << i1;
    if (i2 >= 0) mask |= 1u << i2;
  }
  if (h == 0) ((unsigned*)(p.ws + O_MASK))[(qtile * 32 + r) * 8 + hh] = mask;
}

DI void moba_gather(const Params& p, int a, unsigned char* smem) {
  const int tid = otid(), lane = tid & 63, wave = tid >> 6, r = lane & 31, h = lane >> 5;
  const int part = a & 1, a2 = a >> 1;
  const int hh = a2 % 6, idx = a2 / 6;
  int qb = 1;
  while ((qb + 1) * qb / 2 <= idx) ++qb;
  const int n = idx - qb * (qb - 1) / 2;
  const unsigned* MASK = (const unsigned*)(p.ws + O_MASK);
  unsigned* list = (unsigned*)(smem + wave * 1024);
  int cnt = 0;
#pragma unroll
  for (int j = 0; j < 4; ++j) {
    const int qi = j * 64 + lane;
    const unsigned mk = MASK[(qb * 256 + qi) * 8 + hh];
    const bool pred = (mk >> n) & 1u;
    const unsigned long long ball = __ballot(pred);
    const int pos = cnt + __builtin_popcountll(ball & ((1ull << lane) - 1ull));
    if (pred) list[pos] = (unsigned)qi | ((unsigned)__builtin_popcount(mk & ((1u << n) - 1u)) << 8);
    cnt += __builtin_popcountll(ball);
  }
  cnt = __builtin_amdgcn_readfirstlane(cnt);
  if (cnt == 0) return;
  asm volatile("s_waitcnt lgkmcnt(0)" ::: "memory");
  __builtin_amdgcn_wave_barrier();
  const bf16_t* QK = (const bf16_t*)(p.ws + O_QKA);
  const bf16_t* KF = (const bf16_t*)(p.ws + O_KFA) + (size_t)hh * 524288 + (size_t)n * 8 * 2048 + lane * 8;
  const bf16_t* VT = (const bf16_t*)(p.ws + O_VTA) + (size_t)hh * 524288 + (size_t)n * 8 * 2048 + lane * 8;
  const int nch = (cnt + 31) >> 5;
#pragma unroll 1
  for (int c = part; c < nch; c += 2) {
    const int e = c * 32 + r;
    const bool valid = e < cnt;
    const unsigned ent = list[valid ? e : 0];
    const int tok = qb * 256 + (int)(ent & 255u), slot = (int)(ent >> 8);
    bf16x8 qf[4];
    { const bf16_t* qrow = QK + (size_t)tok * 384 + hh * 64 + 8 * h;
#pragma unroll
      for (int s = 0; s < 4; ++s) qf[s] = *(const bf16x8*)(qrow + 16 * s); }
    auto tf = [&](int t, const bf16_t*& kp, const bf16_t*& vp, const float*&) -> int {
      const int tt = t < 7 ? t : 7;
      kp = KF + tt * 2048; vp = VT + tt * 2048;
      return 0;
    };
    auto mf = [&](int, int, float) -> float { return 0.f; };
    auto sf = [&](int, float, float) { return false; };
    f32x16 o[2]; zero_o(o); float m = -1e30f, l = 0.f;
    int nt8 = 8; asm volatile("" : "+s"(nt8));
    attn_loop<64, false>(nt8, tf, mf, sf, qf, (long)TH, 0.125f * LOG2E, o, m, l);
    float lt;
    attn_store<64>(o, l, (bf16_t*)(p.ws + O_OA + slot * SZ_O) + (size_t)tok * 384 + hh * 64, h, lt, valid);
    if (valid && h == 0) { float* st = (float*)(p.ws + O_STA) + ((size_t)(slot * TH + tok) * 6 + hh) * 2; st[0] = m; st[1] = lt; }
  }
}

DI void moba_own(const Params& p, int a) {
  const int lane = otid() & 63, r = lane & 31, h = lane >> 5;
  const int qtile = 255 - a / 6, hh = a % 6, qb = qtile >> 3, own = qtile & 7;
  const bf16_t* QK = (const bf16_t*)(p.ws + O_QKA);
  const bf16_t* KF = (const bf16_t*)(p.ws + O_KFA) + (size_t)hh * 524288 + (size_t)qb * 8 * 2048 + lane * 8;
  const bf16_t* VT = (const bf16_t*)(p.ws + O_VTA) + (size_t)hh * 524288 + (size_t)qb * 8 * 2048 + lane * 8;
  const int tok = qtile * 32 + r;
  bf16x8 qf[4];
  { const bf16_t* qrow = QK + (size_t)tok * 384 + hh * 64 + 8 * h;
#pragma unroll
    for (int s = 0; s < 4; ++s) qf[s] = *(const bf16x8*)(qrow + 16 * s); }
  auto tf = [&](int t, const bf16_t*& kp, const bf16_t*& vp, const float*&) -> int {
    const int kk = t < own ? t : own;
    kp = KF + kk * 2048; vp = VT + kk * 2048;
    return (kk == own) ? 101 : 100;
  };
  auto mf = [&](int tag, int i, float) -> float {
    if (tag == 100) return 0.f;
    return (crow(i, h) <= r) ? 0.f : NEG_INF;
  };
  auto sf = [&](int, float, float) { return false; };
  f32x16 o[2]; zero_o(o); float m = -1e30f, l = 0.f;
  attn_loop<64, false>(own + 1, tf, mf, sf, qf, (long)TH, 0.125f * LOG2E, o, m, l);
  float lt;
  attn_store<64>(o, l, (bf16_t*)(p.ws + O_OA + 3 * SZ_O) + (size_t)tok * 384 + hh * 64, h, lt);
  if (h == 0) {
    float* st = (float*)(p.ws + O_STA);
    st[((size_t)(3 * TH + tok) * 6 + hh) * 2] = m; st[((size_t)(3 * TH + tok) * 6 + hh) * 2 + 1] = lt;
    const int np = __builtin_popcount(((const unsigned*)(p.ws + O_MASK))[tok * 8 + hh]);
    for (int sl = np; sl < 3; ++sl) { st[((size_t)(sl * TH + tok) * 6 + hh) * 2] = -1e30f; st[((size_t)(sl * TH + tok) * 6 + hh) * 2 + 1] = 0.f; }
  }
}

DI void fox_item(const Params& p, int c, const unsigned* kmaxu) {
  const int lane = otid() & 63, r = lane & 31, h = lane >> 5;
  const int qtile = 255 - c / 6, hh = c % 6;
  const bf16_t* QK = (const bf16_t*)(p.ws + O_QKC);
  const bf16_t* KF = (const bf16_t*)(p.ws + O_KFC);
  const bf16_t* VT = (const bf16_t*)(p.ws + O_VTC);
  const float* FF = (const float*)(p.ws + O_FF) + hh * TH;
  bf16x8 qf[4]; float qn2 = 0.f;
  { const bf16_t* qrow = QK + (size_t)(qtile * 32 + r) * 384 + hh * 64 + 8 * h;
#pragma unroll
    for (int s = 0; s < 4; ++s) { qf[s] = *(const bf16x8*)(qrow + 16 * s); float v[8]; unpk8(qf[s], v);
#pragma unroll
      for (int e = 0; e < 8; ++e) qn2 += v[e] * v[e]; } }
  qn2 += __shfl_xor(qn2, 32);
#pragma unroll
  for (int o = 16; o >= 1; o >>= 1) qn2 = fmaxf(qn2, __shfl_xor(qn2, o));
  const float Fq = FF[qtile * 32 + r];
  const float Ffirst = FF[qtile * 32];
  const float kmaxn = sqrtf(__uint_as_float(kmaxu[hh]));
  const float bound = sqrtf(qn2) * kmaxn * 0.125f + Ffirst;
  auto tf = [&](int t, const bf16_t*& kp, const bf16_t*& vp, const float*& ap) -> int {
    const int keybase = (qtile - t > 0 ? qtile - t : 0) * 32;
    kp = KF + (size_t)hh * 524288 + (keybase >> 5) * 2048 + lane * 8;
    vp = VT + (size_t)hh * 524288 + (keybase >> 5) * 2048 + lane * 8;
    ap = FF + keybase + 4 * h;
    return (t == 0) ? 1 : 0;
  };
  auto mf = [&](int tag, int i, float fk) -> float {
    const float b = (Fq - fk) * LOG2E;
    return (tag == 1 && crow(i, h) > r) ? NEG_INF : b;
  };
  auto sf = [&](int, float m, float a0) {
    const float fkb = __builtin_bit_cast(float, __builtin_amdgcn_readfirstlane(__builtin_bit_cast(int, a0)));
    float mm = m;
#pragma unroll
    for (int o = 16; o >= 1; o >>= 1) mm = fminf(mm, __shfl_xor(mm, o));
    return (bound - fkb) * LOG2E < mm - 45.f;
  };
  f32x16 o[2]; zero_o(o); float m = -1e30f, l = 0.f;
  attn_loop<64, true>(qtile + 1, tf, mf, sf, qf, (long)TH, 0.125f * LOG2E, o, m, l);
  float lt;
  attn_store_gated<64>(o, l, (bf16_t*)(p.ws + O_SZ) + (size_t)(qtile * 32 + r) * 1920 + 2 * 384 + hh * 64, h);
}

DI void dil_item(const Params& p, int idx) {
  const int lane = otid() & 63, r = lane & 31, h = lane >> 5;
  const int g = idx / 1536, rem = idx % 1536, hh = rem / 256, w = rem % 256;
  const int dsh = 2 * g;
  const int dil = 1 << dsh, L = TH >> dsh, tps = L / 32;
  const int rs = w / tps, lt_ = w % tps, l0 = lt_ * 32;
  const bf16_t* QK = (const bf16_t*)(p.ws + O_QKB);
  const bf16_t* KF = (const bf16_t*)(p.ws + O_KFB + g * SZ_VT);
  const bf16_t* VT = (const bf16_t*)(p.ws + O_VTB + g * SZ_VT);
  const int tq = (l0 + r) * dil + rs;
  bf16x8 qf[4];
  { const bf16_t* qrow = QK + (size_t)tq * 1152 + g * 384 + hh * 64 + 8 * h;
#pragma unroll
    for (int s = 0; s < 4; ++s) qf[s] = *(const bf16x8*)(qrow + 16 * s); }
  const int t0 = (l0 >= 128) ? 0 : (128 - l0) / 32;
  auto tf = [&](int tt, const bf16_t*& kp, const bf16_t*& vp, const float*&) -> int {
    const int t = (t0 + tt < 4) ? t0 + tt : 4; const int keybase = l0 - 128 + 32 * t;
    kp = KF + (size_t)hh * 524288 + ((rs * L + keybase) >> 5) * 2048 + lane * 8;
    vp = VT + (size_t)hh * 524288 + ((rs * L + keybase) >> 5) * 2048 + lane * 8;
    return t;
  };
  auto mf = [&](int tag, int i, float) -> float {
    const int kj = crow(i, h);
    if (tag == 0) return (kj >= r) ? 0.f : NEG_INF;
    if (tag == 4) return (kj <= r) ? 0.f : NEG_INF;
    return 0.f;
  };
  auto sf = [&](int, float, float) { return false; };
  f32x16 o[2]; zero_o(o); float m = -1e30f, l = 0.f;
  attn_loop<64, false>(5 - t0, tf, mf, sf, qf, (long)TH, 0.125f * LOG2E, o, m, l);
  float lt;
  attn_store<64>(o, l, (bf16_t*)(p.ws + O_OB + g * SZ_O) + (size_t)tq * 384 + hh * 64, h, lt);
  if (h == 0) { float* st = (float*)(p.ws + O_STB) + ((size_t)(g * TH + tq) * 6 + hh) * 2; st[0] = m; st[1] = lt; }
}

DI void mem_item(const Params& p, int half, int e) {
  const int lane = otid() & 63, r = lane & 31, h = lane >> 5;
  const int hd = e & 3, qtile = e >> 2;
  const bf16_t* QE = (const bf16_t*)(p.ws + O_QE);
  const bf16_t* MK = (const bf16_t*)(p.ws + O_MEMK);
  const bf16_t* MV = (const bf16_t*)(p.ws + O_MEMVT);
  bf16x8 qf[6];
  { const bf16_t* qrow = QE + (size_t)(qtile * 32 + r) * 384 + hd * 96 + 8 * h;
#pragma unroll
    for (int s = 0; s < 6; ++s) qf[s] = *(const bf16x8*)(qrow + 16 * s); }
  auto tf = [&](int t, const bf16_t*& kp, const bf16_t*& vp, const float*&) -> int {
    const int keybase = 32 * (t < 7 ? t : 7);
    kp = MK + (size_t)((half * 4 + hd) * 8 + (keybase >> 5)) * 3072 + lane * 8;
    vp = MV + (size_t)((half * 4 + hd) * 8 + (keybase >> 5)) * 3072 + lane * 8;
    return 0;
  };
  auto mf = [&](int, int, float) -> float { return 0.f; };
  auto sf = [&](int, float, float) { return false; };
  f32x16 o[3]; zero_o(o); float m = -1e30f, l = 0.f;
  attn_loop<96, false>(8, tf, mf, sf, qf, 256L, 0.10206207261596577f * LOG2E, o, m, l);
  float lt;
  attn_store_gated<96>(o, l, (bf16_t*)(p.ws + O_SZ) + (size_t)(qtile * 32 + r) * 1920 + 4 * 384 + hd * 96, h);
}

DI float dpp_ror(float v, int ctrl);
DI float row16_sum(float v) {
  v += __builtin_bit_cast(float, __builtin_amdgcn_update_dpp(0, __builtin_bit_cast(int, v), 0x128, 0xf, 0xf, false));
  v += __builtin_bit_cast(float, __builtin_amdgcn_update_dpp(0, __builtin_bit_cast(int, v), 0x124, 0xf, 0xf, false));
  v += __builtin_bit_cast(float, __builtin_amdgcn_update_dpp(0, __builtin_bit_cast(int, v), 0x122, 0xf, 0xf, false));
  v += __builtin_bit_cast(float, __builtin_amdgcn_update_dpp(0, __builtin_bit_cast(int, v), 0x121, 0xf, 0xf, false));
  return v;
}

struct ScanRegs { bf16x8 pf[4][2]; bf16x8 qe[4][2]; s16x4 bc[4]; s16x4 o0[4]; float gl; };
DI void scan_load(const Params& p, int hh, int j, int c, int lane, ScanRegs& s) {
  const unsigned char* base = p.ws + O_DPREP + (size_t)(hh * 128 + c) * 32768;
#pragma unroll
  for (int mt = 0; mt < 4; ++mt)
#pragma unroll
    for (int ks = 0; ks < 2; ++ks) {
      s.pf[mt][ks] = *(const bf16x8*)(base + ((mt * 2 + ks) * 64 + lane) * 16);
      s.qe[mt][ks] = *(const bf16x8*)(base + 8192 + ((mt * 2 + ks) * 64 + lane) * 16);
    }
#pragma unroll
  for (int rt = 0; rt < 4; ++rt) {
    s.bc[rt] = *(const s16x4*)(base + 16384 + ((j * 4 + rt) * 64 + lane) * 8);
    s.o0[rt] = *(const s16x4*)(base + 24576 + ((j * 4 + rt) * 64 + lane) * 8);
  }
  s.gl = ((const float*)(p.ws + O_GL))[hh * 128 + c];
}
DI f32x4 s4f(s16x4 v) { u32x2 u = __builtin_bit_cast(u32x2, v); f32x4 r; r[0] = bflo(u.x); r[1] = bfhi(u.x); r[2] = bflo(u.y); r[3] = bfhi(u.y); return r; }

DI void scan_item(const Params& p, int it) {
  const int lane = otid() & 63, q = lane >> 4, cl = lane & 15;
  const int hh = it >> 2, j = it & 3;
  f32x4 S[4];
#pragma unroll
  for (int rt = 0; rt < 4; ++rt) S[rt] = (f32x4){0.f, 0.f, 0.f, 0.f};
  bf16_t* OD = (bf16_t*)(p.ws + O_OD);
  float* SSQ = (float*)(p.ws + O_SSQ);
#ifndef SCAN_PREFETCH
#define SCAN_PREFETCH 1
#endif
  ScanRegs cur, nxt;
  if (SCAN_PREFETCH) scan_load(p, hh, j, 0, lane, cur);
  for (int c = 0; c < 128; ++c) {
    if (SCAN_PREFETCH) {
      scan_load(p, hh, j, (c + 1 < 128) ? c + 1 : c, lane, nxt);
      asm volatile("" : "+v"(S[0][0]) :: "memory");
    } else {
      scan_load(p, hh, j, c, lane, cur);
    }
    bf16x8 bfr[2];
#pragma unroll
    for (int ks = 0; ks < 2; ++ks) {
      u32x4 u; u.x = pk2(S[2 * ks][0], S[2 * ks][1]); u.y = pk2(S[2 * ks][2], S[2 * ks][3]); u.z = pk2(S[2 * ks + 1][0], S[2 * ks + 1][1]); u.w = pk2(S[2 * ks + 1][2], S[2 * ks + 1][3]);
      bfr[ks] = __builtin_bit_cast(bf16x8, u);
    }
    f32x4 aP[4], aO[4];
#pragma unroll
    for (int rt = 0; rt < 4; ++rt) {
      aP[rt] = (f32x4){0.f, 0.f, 0.f, 0.f};
      aO[rt] = s4f(cur.o0[rt]);
#pragma unroll
      for (int ks = 0; ks < 2; ++ks) { aP[rt] = MFMA16(cur.pf[rt][ks], bfr[ks], aP[rt]); aO[rt] = MFMA16(cur.qe[rt][ks], bfr[ks], aO[rt]); }
    }
#pragma unroll
    for (int rt = 0; rt < 4; ++rt) S[rt] = S[rt] * cur.gl - aP[rt] + s4f(cur.bc[rt]);
#pragma unroll
    for (int rt = 0; rt < 4; ++rt)
#pragma unroll
      for (int e = 0; e < 4; ++e) {
        const int tok = c * 64 + 16 * rt + 4 * q + e;
        const float v = aO[rt][e];
        OD[(size_t)tok * 384 + hh * 64 + 16 * j + cl] = f2bf(v);
        const float ss = row16_sum(v * v);
        if (cl == 0) SSQ[(tok * 6 + hh) * 4 + j] = ss;
      }
    if (SCAN_PREFETCH) cur = nxt;
  }
}

DI void scan_block(const Params& p, int hh, unsigned char* smem) {
  const int tid = otid(), lane = tid & 63, j = tid >> 6, q = lane >> 4, cl = lane & 15;
  const unsigned char* src = p.ws + O_DPREP + (size_t)hh * 128 * 32768;
  bf16_t* ostg = (bf16_t*)(smem + 65536);
  bf16x8 R0[8], R1[8];
  auto gld = [&](int c, bf16x8 (&R)[8]) {
    c = c < 128 ? c : 127;
    const unsigned char* b = src + (size_t)c * 32768 + tid * 16;
#pragma unroll
    for (int i = 0; i < 8; ++i) R[i] = *(const bf16x8*)(b + i * 4096);
  };
  auto lst = [&](int buf, const bf16x8 (&R)[8]) {
    unsigned char* d = smem + buf * 32768 + tid * 16;
#pragma unroll
    for (int i = 0; i < 8; ++i) *(bf16x8*)(d + i * 4096) = R[i];
  };
  const float* GL = (const float*)(p.ws + O_GL) + hh * 128;
  const float gl_lo = GL[lane], gl_hi = GL[64 + lane];
  f32x4 S[4];
#pragma unroll
  for (int rt = 0; rt < 4; ++rt) S[rt] = (f32x4){0.f, 0.f, 0.f, 0.f};
  bf16_t* OD = (bf16_t*)(p.ws + O_OD);
  float* SSQ = (float*)(p.ws + O_SSQ);
  f32x4 aO[4];
  auto flush = [&](int cp) {
    const int row = tid >> 2, part = tid & 3;
    const bf16x8 v0 = *(const bf16x8*)(ostg + row * 72 + 16 * part), v1 = *(const bf16x8*)(ostg + row * 72 + 16 * part + 8);
    float f[16]; unpk8(v0, f); unpk8(v1, f + 8);
    float ss = 0.f;
#pragma unroll
    for (int e = 0; e < 16; ++e) ss += f[e] * f[e];
    const int tok = cp * 64 + row;
    bf16_t* dst = OD + (size_t)tok * 384 + hh * 64 + 16 * part;
    *(bf16x8*)dst = v0; *(bf16x8*)(dst + 8) = v1;
    SSQ[(tok * 6 + hh) * 4 + part] = ss;
  };
  auto compute = [&](int buf, int c) {
    const unsigned char* base = smem + buf * 32768;
    const float gl = __builtin_bit_cast(float, __builtin_amdgcn_readlane(__builtin_bit_cast(int, c < 64 ? gl_lo : gl_hi), c & 63));
    bf16x8 bfr[2];
#pragma unroll
    for (int ks = 0; ks < 2; ++ks) {
      u32x4 u; u.x = pk2(S[2 * ks][0], S[2 * ks][1]); u.y = pk2(S[2 * ks][2], S[2 * ks][3]); u.z = pk2(S[2 * ks + 1][0], S[2 * ks + 1][1]); u.w = pk2(S[2 * ks + 1][2], S[2 * ks + 1][3]);
      bfr[ks] = __builtin_bit_cast(bf16x8, u);
    }
    f32x4 aP[4];
#pragma unroll
    for (int rt = 0; rt < 4; ++rt) {
      aP[rt] = (f32x4){0.f, 0.f, 0.f, 0.f};
      aO[rt] = s4f(*(const s16x4*)(base + 24576 + ((j * 4 + rt) * 64 + lane) * 8));
#pragma unroll
      for (int ks = 0; ks < 2; ++ks) {
        aP[rt] = MFMA16(*(const bf16x8*)(base + ((rt * 2 + ks) * 64 + lane) * 16), bfr[ks], aP[rt]);
        aO[rt] = MFMA16(*(const bf16x8*)(base + 8192 + ((rt * 2 + ks) * 64 + lane) * 16), bfr[ks], aO[rt]);
      }
    }
#pragma unroll
    for (int rt = 0; rt < 4; ++rt) S[rt] = S[rt] * gl - aP[rt] + s4f(*(const s16x4*)(base + 16384 + ((j * 4 + rt) * 64 + lane) * 8));
  };
  auto stage_out = [&]() {
#pragma unroll
    for (int rt = 0; rt < 4; ++rt)
#pragma unroll
      for (int e = 0; e < 4; ++e) ostg[(16 * rt + 4 * q + e) * 72 + 16 * j + cl] = f2bf(aO[rt][e]);
  };
  __builtin_amdgcn_s_setprio(3);
  gld(0, R0); gld(1, R1);
  lst(0, R0); gld(2, R0);
  sub_sync();
#pragma unroll 1
  for (int c = 0; c < 128; c += 2) {
    lst(1, R1);
    gld(c + 3, R1);
    if (c > 0) flush(c - 1);
    compute(0, c);
    sub_sync();
    stage_out();
    sub_sync();
    lst(0, R0);
    gld(c + 4, R0);
    flush(c);
    compute(1, c + 1);
    sub_sync();
    stage_out();
    sub_sync();
  }
  flush(127);
  sub_sync();
  __builtin_amdgcn_s_setprio(0);
}

DI void phase3(const Params& p, int half, unsigned* ctr, const unsigned* kmaxu, unsigned char* smem, int sub, int limit = 1 << 30) {
  const int tid = otid(), wave = tid >> 6;
  const int hb = (int)blockIdx.x, x = hb & 7, bi = hb >> 3;
  if (hb < 3 && limit >= 0) { if (PH(5)) scan_block(p, hb * 2 + sub, smem); }
  if (bi >= 1 && limit != 0) {
    const int nlw = ((int)(gridDim.x >> 3) - 1) * 8, lw = ((bi - 1) * 2 + sub) * 4 + wave;
    if (x < 6) {
      const int hh = x;
      constexpr int NG = 992, NOWN = 256, NB_ = 640, NTOT = NG + NOWN + NB_;
      for (int pos0 = lw; pos0 < NTOT; pos0 += nlw) {
        int pos = __builtin_amdgcn_readfirstlane(pos0);
        if (pos < NG) { if (PH(6)) moba_gather(p, (((pos >> 1) * 6 + hh) << 1) | (pos & 1), smem); continue; }
        pos -= NG;
        if (pos < NOWN) { if (PH(6)) moba_own(p, pos * 6 + hh); continue; }
        pos -= NOWN;
        const int g = pos < 512 ? (pos >> 8) : 2, w = pos < 512 ? (pos & 255) : 2 * (pos - 512);
        if (PH(8)) dil_item(p, g * 1536 + hh * 256 + w);
      }
    } else {
      const int h0 = (x - 6) * 3;
      constexpr int NE = 512, NC = 768, NB2 = 384, NTOT = NE + NC + NB2;
      for (int pos0 = lw; pos0 < NTOT; pos0 += nlw) {
        int pos = __builtin_amdgcn_readfirstlane(pos0);
        if (pos < NE) { if (PH(7)) mem_item(p, half, (x - 6) * 512 + pos); continue; }
        pos -= NE;
        if (pos < NC) { if (PH(9)) fox_item(p, (pos & 255) * 6 + h0 + (pos >> 8), kmaxu); continue; }
        pos -= NC;
        if (PH(8)) dil_item(p, 2 * 1536 + (h0 + (pos >> 7)) * 256 + 2 * (pos & 127) + 1);
      }
    }
  }
}

DI void gbuild_chunk(const Params& p, int layer, int tok, int c8) {
  const unsigned char* ws = p.ws;
  const int n = c8 / 48, c = (c8 % 48) * 8;
  if (n == 2 || n == 4) return;
  bf16_t* szp = (bf16_t*)(p.ws + O_SZ) + (size_t)tok * 1920 + n * 384 + c;
  float o[8], z[8];
  unpk8(*(const bf16x8*)szp, z);
  if (n == 1) {
    const int hh = c >> 6;
    const float* st = (const float*)(ws + O_STB);
    float mg[3], lg[3];
#pragma unroll
    for (int g = 0; g < 3; ++g) { const f32x2 s2 = *(const f32x2*)(st + ((size_t)(g * TH + tok) * 6 + hh) * 2); mg[g] = s2[0]; lg[g] = s2[1]; }
    const float mm = fmaxf(mg[0], fmaxf(mg[1], mg[2]));
    float wg[3], ws_ = 0.f;
#pragma unroll
    for (int g = 0; g < 3; ++g) { wg[g] = exp2f(mg[g] - mm) * lg[g]; ws_ += wg[g]; }
    const float inv = 1.f / ws_;
#pragma unroll
    for (int e = 0; e < 8; ++e) o[e] = 0.f;
#pragma unroll
    for (int g = 0; g < 3; ++g) {
      float t[8]; unpk8(*(const bf16x8*)((const bf16_t*)(ws + O_OB + g * SZ_O) + (size_t)tok * 384 + c), t);
      const float wgi = wg[g] * inv;
#pragma unroll
      for (int e = 0; e < 8; ++e) o[e] += wgi * t[e];
    }
  } else if (n == 3) {
    const int hh = c >> 6;
    const f32x4 sq = *(const f32x4*)((const float*)(ws + O_SSQ) + ((size_t)tok * 6 + hh) * 4);
    const float rs = rsqrtf((sq[0] + sq[1] + sq[2] + sq[3]) * (1.f / 64.f) + 1e-6f);
    unpk8(*(const bf16x8*)((const bf16_t*)(ws + O_OD) + (size_t)tok * 384 + c), o);
    const float* gw = p.gdn_w + layer * 64 + (c & 63);
#pragma unroll
    for (int e = 0; e < 8; ++e) o[e] *= rs * gw[e];
  } else if (n == 0) {
    const int hh = c >> 6;
    const float* st = (const float*)(ws + O_STA);
    float mg[4], lg[4], mm = -1e30f;
#pragma unroll
    for (int g = 0; g < 4; ++g) { const f32x2 s2 = *(const f32x2*)(st + ((size_t)(g * TH + tok) * 6 + hh) * 2); mg[g] = s2[0]; lg[g] = s2[1]; mm = fmaxf(mm, mg[g]); }
    float wg[4], ws_ = 0.f;
#pragma unroll
    for (int g = 0; g < 4; ++g) { wg[g] = exp2f(mg[g] - mm) * lg[g]; ws_ += wg[g]; }
    const float inv = 1.f / ws_;
#pragma unroll
    for (int e = 0; e < 8; ++e) o[e] = 0.f;
#pragma unroll
    for (int g = 0; g < 4; ++g) {
      if (lg[g] > 0.f) {
        float t[8]; unpk8(*(const bf16x8*)((const bf16_t*)(ws + O_OA + g * SZ_O) + (size_t)tok * 384 + c), t);
        const float wgi = wg[g] * inv;
#pragma unroll
        for (int e = 0; e < 8; ++e) o[e] += wgi * t[e];
      }
    }
  } else {
    const size_t off = (n == 2) ? O_OC : O_OE;
    unpk8(*(const bf16x8*)((const bf16_t*)(ws + off) + (size_t)tok * 384 + c), o);
  }
#pragma unroll
  for (int e = 0; e < 8; ++e) o[e] *= z[e];
  *(bf16x8*)szp = pk8(o);
}

DI void p4a_tile(const Params& p, int layer, int mt, int nt, unsigned char* smem) {
  sub_sync();
  bf16_t* As = (bf16_t*)smem; bf16_t* Bs = As + 2 * 9216;
  const int tid = otid(), lane = tid & 63, wave = tid >> 6, wr = wave >> 1, wc = wave & 1, r = lane & 31, h = lane >> 5;
  const int m0 = mt * 128, n0 = nt * 128;
  f32x16 tot[2][2]; zero_acc(tot);
  const bf16_t* SIG = (const bf16_t*)(p.ws + O_SIG);
  for (int n = 0; n < 5; ++n) {
    f32x16 acc[2][2]; zero_acc(acc);
    PlainA al{(const bf16_t*)(p.ws + O_SZ) + n * 384, 1920};
    gemm_kloop_t<32>(al, (const bf16_t*)(p.ws + O_WTBR) + (size_t)(layer * 5 + n) * 1024 * 384, 384, 12, m0, n0, acc, As, Bs);
#pragma unroll
    for (int mi = 0; mi < 2; ++mi) {
      const int tok = m0 + wr * 64 + mi * 32 + r;
#pragma unroll
      for (int ni = 0; ni < 2; ++ni)
#pragma unroll
        for (int g = 0; g < 4; ++g) {
          const int col = n0 + wc * 64 + ni * 32 + 8 * g + 4 * h;
          const u32x2 sg = *(const u32x2*)(SIG + (size_t)tok * 5120 + n * 1024 + col);
          tot[mi][ni][4 * g] += bflo(sg.x) * acc[mi][ni][4 * g];
          tot[mi][ni][4 * g + 1] += bfhi(sg.x) * acc[mi][ni][4 * g + 1];
          tot[mi][ni][4 * g + 2] += bflo(sg.y) * acc[mi][ni][4 * g + 2];
          tot[mi][ni][4 * g + 3] += bfhi(sg.y) * acc[mi][ni][4 * g + 3];
          asm volatile("" ::: "memory");
        }
    }
  }
  bf16_t* YM = (bf16_t*)(p.ws + O_YM);
  {
    bf16_t* stg = (bf16_t*)smem + wave * (64 * 72);
#pragma unroll
    for (int ni = 0; ni < 2; ++ni)
#pragma unroll
      for (int mi = 0; mi < 2; ++mi)
#pragma unroll
        for (int g = 0; g < 4; ++g)
          *(u32x2*)(stg + (mi * 32 + r) * 72 + ni * 32 + 8 * g + 4 * h) = pk4(tot[mi][ni][4 * g], tot[mi][ni][4 * g + 1], tot[mi][ni][4 * g + 2], tot[mi][ni][4 * g + 3]);
    asm volatile("s_waitcnt lgkmcnt(0)" ::: "memory");
    __builtin_amdgcn_wave_barrier();
    const int tok0 = m0 + wr * 64, col0 = n0 + wc * 64;
#pragma unroll
    for (int it = 0; it < 8; ++it) {
      const int row = it * 8 + (lane >> 3), ch = (lane & 7) * 8;
      const bf16x8 val = *(const bf16x8*)(stg + row * 72 + ch);
      *(bf16x8*)(YM + (size_t)(tok0 + row) * 1024 + col0 + ch) = val;
    }
  }
}

DI void p4b_tile(const Params& p, int layer, int half, int mt, int nt, unsigned char* smem) {
  bf16_t* As = (bf16_t*)smem; bf16_t* Bs = As + 2 * 9216;
  const int tid = otid(), lane = tid & 63, wave = tid >> 6, wr = wave >> 1, wc = wave & 1, r = lane & 31, h = lane >> 5;
  const int m0 = mt * 128, n0 = nt * 128;
  f32x16 acc[2][2]; zero_acc(acc);
  PlainA al{(const bf16_t*)(p.ws + O_YM), 1024};
  gemm_kloop(al, (const bf16_t*)(p.ws + O_WTOUT + layer * SZ_WTOUT1), 1024, 16, m0, n0, acc, As, Bs);
  const float* xin = layer == 0 ? p.x : p.out;
  const float alpha = 1.4142135623730951f;
#pragma unroll
  for (int mi = 0; mi < 2; ++mi) {
    const size_t gt = (size_t)half * TH + m0 + wr * 64 + mi * 32 + r;
#pragma unroll
    for (int ni = 0; ni < 2; ++ni)
#pragma unroll
      for (int g = 0; g < 4; ++g) {
        const int col = n0 + wc * 64 + ni * 32 + 8 * g + 4 * h;
        const f32x4 xv = *(const f32x4*)(xin + gt * 1024 + col);
        f32x4 o;
#pragma unroll
        for (int e = 0; e < 4; ++e) o[e] = alpha * xv[e] + acc[mi][ni][4 * g + e];
        *(f32x4*)(p.out + gt * 1024 + col) = o;
      }
  }
}

DI void gemm8_kloop(const bf16_t* __restrict__ Ab, int lda, const bf16_t* __restrict__ Bb, int ldb, int nkt, f32x4 (&acc)[4][4], unsigned char* lds) {
  const int tid = rtid(), wid = tid >> 6, lane = tid & 63, wr = wid >> 1, wc = wid & 1, fr = lane & 15, fq = lane >> 4;
  int aOff[4], bOff[2];
#pragma unroll
  for (int i = 0; i < 4; ++i) { int R, C; g_stage_rc(wid * 1024 + i * 8192 + lane * 16, R, C); aOff[i] = R * lda + C; }
#pragma unroll
  for (int i = 0; i < 2; ++i) { int R, C; g_stage_rc(wid * 1024 + i * 8192 + lane * 16, R, C); bOff[i] = R * ldb + C; }
  auto stage = [&](int buf, int kt) {
#pragma unroll
    for (int i = 0; i < 4; ++i)
      __builtin_amdgcn_global_load_lds((const unsigned*)(Ab + aOff[i] + kt * 64), (unsigned*)(lds + buf * 49152 + wid * 1024 + i * 8192), 16, 0, 0);
#pragma unroll
    for (int i = 0; i < 2; ++i)
      __builtin_amdgcn_global_load_lds((const unsigned*)(Bb + bOff[i] + kt * 64), (unsigned*)(lds + buf * 49152 + 32768 + wid * 1024 + i * 8192), 16, 0, 0);
  };
  const int lane_off = (fr * 64 + fq * 16) ^ ((fr >> 3) << 5);
  __syncthreads();
  stage(0, 0);
  asm volatile("s_waitcnt vmcnt(0)" ::: "memory");
  __syncthreads();
#pragma unroll 1
  for (int t = 0; t < nkt; ++t) {
    const int cur = t & 1;
    if (t + 1 < nkt) stage(cur ^ 1, t + 1);
    const unsigned char* SA = lds + cur * 49152 + wr * 8192 + lane_off;
    const unsigned char* SB = lds + cur * 49152 + 32768 + wc * 8192 + lane_off;
#pragma unroll
    for (int ks = 0; ks < 2; ++ks) {
      bf16x8 At[4], Bf[4];
#pragma unroll
      for (int n = 0; n < 4; ++n) Bf[n] = *(const bf16x8*)(SB + n * 2048 + ks * 1024);
#pragma unroll
      for (int m = 0; m < 4; ++m) At[m] = *(const bf16x8*)(SA + m * 2048 + ks * 1024);
#pragma unroll
      for (int m = 0; m < 4; ++m)
#pragma unroll
        for (int n = 0; n < 4; ++n) acc[m][n] = MFMA16(Bf[n], At[m], acc[m][n]);
    }
    asm volatile("s_waitcnt vmcnt(0)" ::: "memory");
    __syncthreads();
  }
}

DI void p4a_unit(const Params& p, int layer, int pm, int pn, unsigned char* lds) {
  const int tid = rtid(), wid = tid >> 6, lane = tid & 63, wr = wid >> 1, wc = wid & 1, fr = lane & 15, fq = lane >> 4;
  const int tok0 = pm * 256 + wr * 64, col0 = pn * 128 + wc * 64;
  const bf16_t* SIG = (const bf16_t*)(p.ws + O_SIG);
  f32x4 tot[4][4];
#pragma unroll
  for (int m = 0; m < 4; ++m)
#pragma unroll
    for (int n = 0; n < 4; ++n) tot[m][n] = (f32x4){0.f, 0.f, 0.f, 0.f};
#pragma unroll 1
  for (int nb = 0; nb < 5; ++nb) {
    f32x4 acc[4][4];
#pragma unroll
    for (int m = 0; m < 4; ++m)
#pragma unroll
      for (int n = 0; n < 4; ++n) acc[m][n] = (f32x4){0.f, 0.f, 0.f, 0.f};
    gemm8_kloop((const bf16_t*)(p.ws + O_SZ) + (size_t)pm * 256 * 1920 + nb * 384, 1920,
                (const bf16_t*)(p.ws + O_WTBR) + (size_t)(layer * 5 + nb) * 1024 * 384 + (size_t)pn * 128 * 384, 384, 6, acc, lds);
#pragma unroll
    for (int m = 0; m < 4; ++m) {
      const int tok = tok0 + m * 16 + fr;
#pragma unroll
      for (int n = 0; n < 4; ++n) {
        const u32x2 sg = *(const u32x2*)(SIG + (size_t)tok * 5120 + nb * 1024 + col0 + n * 16 + fq * 4);
        tot[m][n][0] += bflo(sg.x) * acc[m][n][0]; tot[m][n][1] += bfhi(sg.x) * acc[m][n][1];
        tot[m][n][2] += bflo(sg.y) * acc[m][n][2]; tot[m][n][3] += bfhi(sg.y) * acc[m][n][3];
      }
    }
  }
  bf16_t* YM = (bf16_t*)(p.ws + O_YM);
  bf16_t* stg = (bf16_t*)(lds + wid * 9216);
#pragma unroll
  for (int m = 0; m < 4; ++m)
#pragma unroll
    for (int n = 0; n < 4; ++n) *(u32x2*)(stg + (m * 16 + fr) * 72 + n * 16 + fq * 4) = pk4(tot[m][n][0], tot[m][n][1], tot[m][n][2], tot[m][n][3]);
  asm volatile("s_waitcnt lgkmcnt(0)" ::: "memory");
  __builtin_amdgcn_wave_barrier();
#pragma unroll
  for (int it = 0; it < 8; ++it) {
    const int row = it * 8 + (lane >> 3), ch = (lane & 7) * 8;
    const bf16x8 val = *(const bf16x8*)(stg + row * 72 + ch);
    *(bf16x8*)(YM + (size_t)(tok0 + row) * 1024 + col0 + ch) = val;
  }
}

DI void p4b_unit(const Params& p, int layer, int half, int pm, int pn, unsigned char* lds) {
  const int tid = rtid(), wid = tid >> 6, lane = tid & 63, wr = wid >> 1, wc = wid & 1, fr = lane & 15, fq = lane >> 4;
  f32x4 acc[4][4];
#pragma unroll
  for (int m = 0; m < 4; ++m)
#pragma unroll
    for (int n = 0; n < 4; ++n) acc[m][n] = (f32x4){0.f, 0.f, 0.f, 0.f};
  gemm8_kloop((const bf16_t*)(p.ws + O_YM) + (size_t)pm * 256 * 1024, 1024,
              (const bf16_t*)(p.ws + O_WTOUT + layer * SZ_WTOUT1) + (size_t)pn * 128 * 1024, 1024, 16, acc, lds);
  const float* xin = layer == 0 ? p.x : p.out;
  const float alpha = 1.4142135623730951f;
#pragma unroll
  for (int m = 0; m < 4; ++m) {
    const size_t gt = (size_t)half * TH + pm * 256 + wr * 64 + m * 16 + fr;
#pragma unroll
    for (int n = 0; n < 4; ++n) {
      const int col = pn * 128 + wc * 64 + n * 16 + fq * 4;
      const f32x4 xv = *(const f32x4*)(xin + gt * 1024 + col);
      f32x4 o;
#pragma unroll
      for (int e = 0; e < 4; ++e) o[e] = alpha * xv[e] + acc[m][n][e];
      *(f32x4*)(p.out + gt * 1024 + col) = o;
    }
  }
}

DI void p4c_row(const Params& p, int layer, size_t gt, bool wxb = true) {
  const int lane = otid() & 63;
  float* row = p.out + gt * 1024;
  f32x4 v[4]; float s = 0.f;
#pragma unroll
  for (int j = 0; j < 4; ++j) { v[j] = *(const f32x4*)(row + 4 * lane + 256 * j); s += v[j][0] + v[j][1] + v[j][2] + v[j][3]; }
#pragma unroll
  for (int o = 32; o >= 1; o >>= 1) s += __shfl_xor(s, o);
  const float mu = s * (1.f / 1024.f); float q = 0.f;
#pragma unroll
  for (int j = 0; j < 4; ++j) { v[j] -= mu; q += v[j][0] * v[j][0] + v[j][1] * v[j][1] + v[j][2] * v[j][2] + v[j][3] * v[j][3]; }
#pragma unroll
  for (int o = 32; o >= 1; o >>= 1) q += __shfl_xor(q, o);
  const float rs = rsqrtf(q * (1.f / 1024.f) + 1e-5f);
  bf16_t* xb = (bf16_t*)(p.ws + O_XB) + gt * 1024;
#pragma unroll
  for (int j = 0; j < 4; ++j) {
    const int c = 4 * lane + 256 * j;
    const f32x4 g = *(const f32x4*)(p.ln_g + layer * 1024 + c), b = *(const f32x4*)(p.ln_b + layer * 1024 + c);
    f32x4 y;
#pragma unroll
    for (int e = 0; e < 4; ++e) y[e] = v[j][e] * rs * g[e] + b[e];
    *(f32x4*)(row + c) = y;
    if (wxb) *(u32x2*)(xb + c) = pk4(y[0], y[1], y[2], y[3]);
  }
}


#define XB_TMO      128
#define XB_XCNT(j)  (256  + 64 * (j))
#define XB_XSUB(j)  (1280 + 64 * (j))
#define XB_XGEN(j)  (2304 + 64 * (j))
#define XB_TOP      3328
#define XB_TOPGEN   3392
#define XB_SPIN_CAP (1u << 22)
#define LAS __attribute__((address_space(3)))
DI unsigned xb_ld(unsigned* p) { return __hip_atomic_load(p, __ATOMIC_RELAXED, __HIP_MEMORY_SCOPE_AGENT); }
DI unsigned xb_add(unsigned* p, unsigned v) { return __hip_atomic_fetch_add(p, v, __ATOMIC_RELAXED, __HIP_MEMORY_SCOPE_AGENT); }
DI unsigned xb_xcc_id() { return (unsigned)__builtin_amdgcn_s_getreg((3 << 11) | 20) & 0xFu; }
#define XB_SPIN(cond, bar) do { unsigned _sp = 0; while (cond) { __builtin_amdgcn_s_sleep(1); \
    if ((++_sp & 255u) == 0u) { if (xb_ld(&(bar)[XB_TMO])) break; if (_sp > XB_SPIN_CAP) { atomicAdd(&(bar)[XB_TMO], 1u); break; } } } } while (0)
struct XcdBarrier { unsigned* bar; unsigned x; volatile LAS unsigned* st; };
DI XcdBarrier xcd_barrier_post(unsigned* bar, volatile LAS unsigned* st) {
  XcdBarrier b; b.bar = bar; b.x = xb_xcc_id(); b.st = st;
  if (threadIdx.x == 0) (void)xb_add(&bar[XB_XCNT(b.x)], 1u);
  return b;
}
DI void xcd_barrier_complete(unsigned* bar, unsigned x, unsigned& nloc, unsigned& nx) {
  const unsigned G = gridDim.x;
  unsigned sum, cnt, mine, sp = 0u;
  for (;;) {
    sum = 0u; cnt = 0u; mine = 0u;
#pragma unroll
    for (unsigned j = 0; j < 16; ++j) { const unsigned c = xb_ld(&bar[XB_XCNT(j)]); sum += c; cnt += (c > 0u) ? 1u : 0u; mine = (j == x) ? c : mine; }
    if (sum == G) break;
    __builtin_amdgcn_s_sleep(1);
    if ((++sp & 255u) == 0u) { if (xb_ld(&bar[XB_TMO])) break; if (sp > XB_SPIN_CAP) { atomicAdd(&bar[XB_TMO], 1u); break; } }
  }
  nloc = mine > 0u ? mine : 1u; nx = cnt > 0u ? cnt : 1u;
}
DI void xcd_barrier(const XcdBarrier& b) {
  asm volatile("s_waitcnt vmcnt(0)" ::: "memory");
  __syncthreads();
  if (threadIdx.x == 0) {
    unsigned* bar = b.bar;
    __builtin_amdgcn_s_waitcnt(0);
    unsigned nloc = b.st[0], nx = b.st[1];
    if (nloc == 0u) { xcd_barrier_complete(bar, b.x, nloc, nx); b.st[0] = nloc; b.st[1] = nx; }
    const unsigned old = xb_add(&bar[XB_XSUB(b.x)], 1u);
    const unsigned gen = old / nloc;
    if (old + 1u == (gen + 1u) * nloc) {
      __builtin_amdgcn_fence(__ATOMIC_RELEASE, "agent");
      asm volatile("s_waitcnt vmcnt(0)" ::: "memory");
      const unsigned og = xb_add(&bar[XB_TOP], 1u);
      const unsigned tg = og / nx;
      if (og + 1u == (tg + 1u) * nx) xb_add(&bar[XB_TOPGEN], 1u);
      else XB_SPIN(xb_ld(&bar[XB_TOPGEN]) == tg, bar);
      __builtin_amdgcn_fence(__ATOMIC_ACQUIRE, "agent");
      xb_add(&bar[XB_XGEN(b.x)], 1u);
      asm volatile("s_waitcnt vmcnt(0)" ::: "memory");
    } else {
      XB_SPIN(xb_ld(&bar[XB_XGEN(b.x)]) == gen, bar);
      __builtin_amdgcn_fence(__ATOMIC_ACQUIRE, "agent");
      asm volatile("s_waitcnt vmcnt(0)" ::: "memory");
    }
  }
  __syncthreads();
}

#ifdef PROBE_A
#define STAMP(k) do { if (blockIdx.x == 0 && otid() == 0) { unsigned long long now_ = __builtin_amdgcn_s_memrealtime(); tsacc[k] += (float)(now_ - tlast) * 0.01f; tlast = now_; } } while (0)
#else
#define STAMP(k) do {} while (0)
#endif
__global__ void __launch_bounds__(512, 2) mega(Params p) {
  extern __shared__ __attribute__((aligned(16))) unsigned char smem_all[];
  cg::grid_group grid = cg::this_grid();
  if (p.ws == nullptr) grid.sync();
  volatile LAS unsigned* xbst = (volatile LAS unsigned*)(smem_all + 2 * SUB_LDS);
  if (threadIdx.x < 4) xbst[threadIdx.x] = 0u;
  __syncthreads();
  const XcdBarrier xb = xcd_barrier_post((unsigned*)(p.ws + O_BAR), xbst);
#define GSYNC() xcd_barrier(xb)
  const int sub = __builtin_amdgcn_readfirstlane(__builtin_amdgcn_workitem_id_x() >> 8);
  unsigned char* smem = smem_all + sub * SUB_LDS;
  const int vb = (int)blockIdx.x * 2 + sub, vgrid = (int)gridDim.x * 2;
  const int wave = otid() >> 6;
  const int gw = vb * 4 + wave, ngw = vgrid * 4;
  phase0(p, smem, vb, vgrid);
  GSYNC();
  int pend_layer = -1, pend_half = 0;
  for (int itn = 0; itn < 4; ++itn) {
    const int layer = itn >> 1, half = itn & 1;
    if (pend_layer >= 0) { for (int rw = gw; rw < TH; rw += ngw) p4c_row(p, pend_layer, (size_t)pend_half * TH + rw, true); pend_layer = -1; }
    for (int t = (int)blockIdx.x; t < 32 * 54; t += (int)gridDim.x) {
      const int tn = t + (int)gridDim.x;
      p1_unit(p, layer, half, t & 31, t >> 5, tn < 32 * 54 ? (tn & 31) : 0, tn < 32 * 54 ? (tn >> 5) : -1, t == (int)blockIdx.x, smem_all);
    }
    GSYNC();
    {
      constexpr int N_FOX = 6, N_GDN = 768, N_MKV = 12, N_KM = 48, TOT = N_FOX + N_GDN + N_MKV + N_KM;
      for (int t = vb; t < TOT; t += vgrid) {
        int i = t;
        if (i < N_FOX) { fox_prep(p, i, smem); continue; }
        i -= N_FOX;
        if (i < N_GDN) { gdn_prep(p, layer, half, i / 128, i % 128, smem); continue; }
        i -= N_GDN;
        if (i < N_MKV) { memkv_tile(p, layer, half, i / 6, i % 6, smem); continue; }
        i -= N_MKV;
        kmean_prep(p, i * 4 + wave, (unsigned*)(p.ws + O_CTL) + 64 + (layer * 2 + half) * 8);
      }
    }
    for (int a = gw; a < 1536; a += ngw) moba_select(p, a);
    GSYNC();
    phase3(p, half, (unsigned*)(p.ws + O_CTL) + layer * 2 + half, (const unsigned*)(p.ws + O_CTL) + 64 + (layer * 2 + half) * 8, smem, sub);
    GSYNC();
    for (int ci = vb * 256 + otid(); ci < TH * 240; ci += vgrid * 256) gbuild_chunk(p, layer, ci / 240, ci % 240);
    GSYNC();
    for (int t = (int)blockIdx.x; t < 256; t += (int)gridDim.x) p4a_unit(p, layer, t & 31, t >> 5, smem_all);
    GSYNC();
    for (int t = (int)blockIdx.x; t < 256; t += (int)gridDim.x) p4b_unit(p, layer, half, t & 31, t >> 5, smem_all);
    GSYNC();
    pend_layer = layer; pend_half = half;
  }
  if (pend_layer >= 0) { for (int rw = gw; rw < TH; rw += ngw) p4c_row(p, pend_layer, (size_t)pend_half * TH + rw, true); }
}

extern "C" void kernel_launch(void* const* d_in, const int* in_sizes, int n_in, void* d_out, int out_size, void* d_ws, size_t ws_size,
                              hipStream_t stream) {
  static int grid_blocks = 0;
  if (grid_blocks == 0) {
    if (ws_size < WS_END) { fprintf(stderr, "workspace too small: %zu < %zu\n", ws_size, (size_t)WS_END); grid_blocks = -1; return; }
    int dev = 0, cus = 0, per_cu = 0;
    (void)hipGetDevice(&dev);
    (void)hipDeviceGetAttribute(&cus, hipDeviceAttributeMultiprocessorCount, dev);
    (void)hipFuncSetAttribute((const void*)mega, hipFuncAttributeMaxDynamicSharedMemorySize, LDS_BYTES);
    (void)hipOccupancyMaxActiveBlocksPerMultiprocessor(&per_cu, (const void*)mega, 512, LDS_BYTES);
    if (per_cu < 1) per_cu = 1;
    if (per_cu > 1) per_cu = 1;
    grid_blocks = cus * per_cu;
  }
  if (grid_blocks < 0) return;
  (void)hipMemsetAsync((char*)d_ws + O_CTL, 0, 32768, stream);
  Params p{};
  p.x = (const float*)d_in[0]; p.mem = (const float*)d_in[1]; p.mem_g = (const float*)d_in[2]; p.mem_b = (const float*)d_in[3];
  p.w_in = (const float*)d_in[4]; p.b_in = (const float*)d_in[5]; p.conv_w = (const float*)d_in[6]; p.a_log = (const float*)d_in[7];
  p.dt_bias = (const float*)d_in[8]; p.gdn_w = (const float*)d_in[9]; p.w_kv = (const float*)d_in[10]; p.w_br = (const float*)d_in[11];
  p.w_out = (const float*)d_in[12]; p.ln_g = (const float*)d_in[13]; p.ln_b = (const float*)d_in[14];
  p.out = (float*)d_out; p.ws = (unsigned char*)d_ws;
  void* args[] = {&p};
  hipError_t e = hipLaunchCooperativeKernel((const void*)mega, dim3(grid_blocks), dim3(512), args, LDS_BYTES, stream);
  if (e != hipSuccess) fprintf(stderr, "cooperative launch failed: %s (grid %d)\n", hipGetErrorString(e), grid_blocks);
}
```

```cpp
#include <hip/hip_runtime.h>
#include <hip/hip_cooperative_groups.h>
#include <cstdio>
#include <cstdint>
namespace cg = cooperative_groups;

#define DI __device__ __forceinline__
typedef unsigned short bf16_t;
typedef short bf16x8 __attribute__((ext_vector_type(8)));
typedef short s16x4 __attribute__((ext_vector_type(4)));
typedef float f32x4 __attribute__((ext_vector_type(4)));
typedef float f32x2 __attribute__((ext_vector_type(2)));
typedef float f32x16 __attribute__((ext_vector_type(16)));
typedef unsigned u32x2 __attribute__((ext_vector_type(2)));
typedef unsigned u32x4 __attribute__((ext_vector_type(4)));
typedef __bf16 bfv2 __attribute__((ext_vector_type(2)));

#define MFMA32(a, b, c) __builtin_amdgcn_mfma_f32_32x32x16_bf16((a), (b), (c), 0, 0, 0)
#define MFMA16(a, b, c) __builtin_amdgcn_mfma_f32_16x16x32_bf16((a), (b), (c), 0, 0, 0)

DI unsigned pk2(float a, float b) { f32x2 v = {a, b}; return __builtin_bit_cast(unsigned, __builtin_convertvector(v, bfv2)); }
DI bf16_t f2bf(float a) { return (bf16_t)(pk2(a, 0.f) & 0xffffu); }
DI float bf2f(bf16_t v) { return __uint_as_float(((unsigned)v) << 16); }
DI float bflo(unsigned u) { return __uint_as_float(u << 16); }
DI float bfhi(unsigned u) { return __uint_as_float(u & 0xffff0000u); }
DI int rtid() { int t = __builtin_amdgcn_workitem_id_x(); asm volatile("" : "+v"(t)); return t; }
DI int otid() { return rtid() & 255; }
extern __shared__ __attribute__((aligned(16))) unsigned char g_lds_all[];
#define LAS3 __attribute__((address_space(3)))
DI void sub_sync() {
  asm volatile("s_waitcnt lgkmcnt(0)" ::: "memory");
  const int t = __builtin_amdgcn_workitem_id_x();
  LAS3 unsigned* c = (LAS3 unsigned*)(g_lds_all + 2 * 75776 + 8) + (t >> 8);
  if ((t & 63) == 0) {
    const unsigned old = __hip_atomic_fetch_add(c, 1u, __ATOMIC_RELAXED, __HIP_MEMORY_SCOPE_WORKGROUP);
    const unsigned target = (old / 4u + 1u) * 4u;
    while (__hip_atomic_load(c, __ATOMIC_RELAXED, __HIP_MEMORY_SCOPE_WORKGROUP) < target) __builtin_amdgcn_s_sleep(1);
  }
  asm volatile("s_waitcnt lgkmcnt(0)" ::: "memory");
}
DI int crow(int i, int h) { return (i & 3) + 8 * (i >> 2) + 4 * h; }
DI float fsigmoid(float v) { return __builtin_amdgcn_rcpf(1.f + __expf(-v)); }
DI float fsilu(float v) { return v * fsigmoid(v); }
DI u32x2 pk4(float a, float b, float c, float d) { u32x2 r; r.x = pk2(a, b); r.y = pk2(c, d); return r; }
DI bf16x8 pk8(const float* v) { u32x4 r; r.x = pk2(v[0], v[1]); r.y = pk2(v[2], v[3]); r.z = pk2(v[4], v[5]); r.w = pk2(v[6], v[7]); return __builtin_bit_cast(bf16x8, r); }
DI void unpk8(bf16x8 x, float* v) { u32x4 u = __builtin_bit_cast(u32x4, x); v[0] = bflo(u.x); v[1] = bfhi(u.x); v[2] = bflo(u.y); v[3] = bfhi(u.y); v[4] = bflo(u.z); v[5] = bfhi(u.z); v[6] = bflo(u.w); v[7] = bfhi(u.w); }

constexpr int NB = 2, SQ = 8192, NT = NB * SQ, DM = 1024, NH = 6, BW = 384;
constexpr int TH = 8192;
constexpr int NP = 13824;
constexpr int DIN = 13586;
constexpr float LOG2E = 1.4426950408889634f;
#define NEG_INF (-__builtin_inff())

constexpr int C_AQK = 0, C_AV = 768, C_BQK = 1152, C_BV = 3456, C_CQK = 3840, C_CV = 4608, C_D = 4992, C_E = 6144, C_SM = 6528, C_SMEND = 6546, C_Z = 6656, C_MG = 8576;

__host__ __device__ constexpr int inmap(int n) {
  return n < 4992 ? n : n < 6144 ? n + 6 : n < 6528 ? n + 18 : n < 6534 ? n - 1536 : n < 6546 ? n - 384 : n < 6656 ? -1 : n < 13696 ? n - 110 : -1;
}

constexpr size_t O_CTL = 0;
constexpr size_t O_BAR = 4096;
constexpr size_t O_WTIN = 32768;
constexpr size_t SZ_WTIN1 = (size_t)NP * 1024 * 2;
constexpr size_t O_WTBR = O_WTIN + 2 * SZ_WTIN1;
constexpr size_t SZ_WTBR1 = (size_t)5 * 1024 * 384 * 2;
constexpr size_t O_WTOUT = O_WTBR + 2 * SZ_WTBR1;
constexpr size_t SZ_WTOUT1 = (size_t)1024 * 1024 * 2;
constexpr size_t O_WTKV = O_WTOUT + 2 * SZ_WTOUT1;
constexpr size_t SZ_WTKV1 = (size_t)768 * 1024 * 2;
constexpr size_t O_BIASP = O_WTKV + 2 * SZ_WTKV1;
constexpr size_t O_XB = O_BIASP + (size_t)2 * NP * 4;
constexpr size_t O_MEMN = O_XB + (size_t)NT * 1024 * 2;
constexpr size_t O_MEMK = O_MEMN + (size_t)512 * 1024 * 2;
constexpr size_t O_MEMVT = O_MEMK + (size_t)512 * 384 * 2;
constexpr size_t O_QKA = O_MEMVT + (size_t)512 * 384 * 2;
constexpr size_t SZ_VT = (size_t)384 * TH * 2;
constexpr size_t O_KFA = O_QKA + SZ_VT;
constexpr size_t O_VTA = O_KFA + SZ_VT;
constexpr size_t O_QKB = O_VTA + SZ_VT;
constexpr size_t O_KFB = O_QKB + 3 * SZ_VT;
constexpr size_t O_VTB = O_KFB + 3 * SZ_VT;
constexpr size_t O_QKC = O_VTB + 3 * SZ_VT;
constexpr size_t O_KFC = O_QKC + SZ_VT;
constexpr size_t O_VTC = O_KFC + SZ_VT;
constexpr size_t O_QKVD = O_VTC + SZ_VT;
constexpr size_t O_QE = O_QKVD + (size_t)TH * 1152 * 2;
constexpr size_t O_SM = O_QE + (size_t)TH * 384 * 2;
constexpr size_t O_FF = O_SM + (size_t)TH * 32 * 4;
constexpr size_t O_KM = O_FF + (size_t)6 * TH * 4;
constexpr size_t O_KMAX = O_KM + (size_t)2 * 6 * 32 * 64 * 2;
constexpr size_t O_GL = O_KMAX + 256;
constexpr size_t O_MASK = O_GL + 6 * 128 * 4;
constexpr size_t O_KSUM = O_MASK + (size_t)TH * 8 * 4;
constexpr size_t O_DPREP = O_KSUM + (size_t)32 * 2 * 384 * 4;
constexpr size_t O_SZ = O_DPREP + (size_t)768 * 32768;
constexpr size_t O_SIG = O_SZ + (size_t)TH * 1920 * 2;
constexpr size_t O_OA = O_SIG + (size_t)TH * 5120 * 2;
constexpr size_t SZ_O = (size_t)TH * 384 * 2;
constexpr size_t O_STA = O_OA + 4 * SZ_O;
constexpr size_t O_OB = O_STA + (size_t)4 * TH * 6 * 2 * 4;
constexpr size_t O_STB = O_OB + 3 * SZ_O;
constexpr size_t O_OC = O_STB + (size_t)3 * TH * 6 * 2 * 4;
constexpr size_t O_OD = O_OC + SZ_O;
constexpr size_t O_SSQ = O_OD + SZ_O;
constexpr size_t O_OE = O_SSQ + (size_t)TH * 6 * 4 * 4;
constexpr size_t WS_END = O_OE + SZ_O;
constexpr size_t O_YM = O_QKB;
static_assert(WS_END < (size_t)443 * 1000 * 1000, "workspace too large");

struct Params {
  const float *x, *mem, *mem_g, *mem_b, *w_in, *b_in, *conv_w, *a_log, *dt_bias, *gdn_w, *w_kv, *w_br, *w_out, *ln_g, *ln_b;
  float* out;
  unsigned char* ws;
};

constexpr int SUB_LDS = 75776;
constexpr int LDS_BYTES = 2 * SUB_LDS + 16;
#ifndef PH_MASK
#define PH_MASK 0xFFFF
#endif
#define PH(x) ((PH_MASK >> (x)) & 1)
#ifndef REP_MASK
#define REP_MASK 0
#endif
#define REP(x) (1 + ((REP_MASK >> (x)) & 1))

DI void transpose_tile(const float* __restrict__ src, int ld, int k0, int n0, bool usemap, bf16_t* __restrict__ dst, int dstld, float* tile) {
  const int tid = otid();
#pragma unroll
  for (int it = 0; it < 16; ++it) {
    const int kk = (tid >> 6) + 4 * it, n2 = (tid & 63) * 2;
    const int sc = usemap ? inmap(n0 + n2) : (n0 + n2);
    f32x2 v = {0.f, 0.f};
    if (sc >= 0) v = *(const f32x2*)(src + (size_t)(k0 + kk) * ld + sc);
    *(f32x2*)(tile + kk * 130 + n2) = v;
  }
  sub_sync();
#pragma unroll
  for (int it = 0; it < 4; ++it) {
    const int nn = (tid >> 3) + 32 * it, kc = (tid & 7) * 8;
    float v[8];
#pragma unroll
    for (int e = 0; e < 8; ++e) v[e] = tile[(kc + e) * 130 + nn];
    *(bf16x8*)(dst + (size_t)(n0 + nn) * dstld + k0 + kc) = pk8(v);
  }
  sub_sync();
}

DI void phase0(const Params& p, unsigned char* smem, int vb, int vgrid) {
  float* tile = (float*)smem;
  const int tid = otid(), lane = tid & 63, wave = tid >> 6;
  constexpr int N_TIN = 2 * 108 * 16, N_TBR = 2 * 5 * 8 * 6, N_TOUT = 2 * 8 * 16, N_TKV = 2 * 6 * 16, N_XB = 1024, N_MEMN = 128, N_BIAS = 108;
  constexpr int TOT = N_TIN + N_TBR + N_TOUT + N_TKV + N_XB + N_MEMN + N_BIAS;
  for (int it = vb; it < TOT; it += vgrid) {
    int i = it;
    if (i < N_TIN) {
      const int l = i / (108 * 16), rr = i % (108 * 16), nt = rr / 16, kt = rr % 16;
      transpose_tile(p.w_in + (size_t)l * 1024 * DIN, DIN, kt * 64, nt * 128, true, (bf16_t*)(p.ws + O_WTIN + l * SZ_WTIN1), 1024, tile);
      continue;
    }
    i -= N_TIN;
    if (i < N_TBR) {
      const int ln = i / 48, rr = i % 48, nt = rr / 6, kt = rr % 6;
      transpose_tile(p.w_br + (size_t)ln * 384 * 1024, 1024, kt * 64, nt * 128, false, (bf16_t*)(p.ws + O_WTBR) + (size_t)ln * 1024 * 384, 384, tile);
      continue;
    }
    i -= N_TBR;
    if (i < N_TOUT) {
      const int l = i / 128, rr = i % 128, nt = rr / 16, kt = rr % 16;
      transpose_tile(p.w_out + (size_t)l * 1024 * 1024, 1024, kt * 64, nt * 128, false, (bf16_t*)(p.ws + O_WTOUT + l * SZ_WTOUT1), 1024, tile);
      continue;
    }
    i -= N_TOUT;
    if (i < N_TKV) {
      const int l = i / 96, rr = i % 96, nt = rr / 16, kt = rr % 16;
      transpose_tile(p.w_kv + (size_t)l * 1024 * 768, 768, kt * 64, nt * 128, false, (bf16_t*)(p.ws + O_WTKV + l * SZ_WTKV1), 1024, tile);
      continue;
    }
    i -= N_TKV;
    if (i < N_XB) {
      const float* src = p.x + (size_t)i * 16 * 1024;
      bf16_t* dst = (bf16_t*)(p.ws + O_XB) + (size_t)i * 16 * 1024;
#pragma unroll
      for (int j = 0; j < 16; ++j) {
        const int e = (j * 256 + tid) * 4;
        const f32x4 v = *(const f32x4*)(src + e);
        *(u32x2*)(dst + e) = pk4(v[0], v[1], v[2], v[3]);
      }
      continue;
    }
    i -= N_XB;
    if (i < N_MEMN) {
      const int row = i * 4 + wave;
      const float* src = p.mem + (size_t)row * 1024;
      f32x4 v[4]; float s = 0.f;
#pragma unroll
      for (int j = 0; j < 4; ++j) { v[j] = *(const f32x4*)(src + 4 * lane + 256 * j); s += v[j][0] + v[j][1] + v[j][2] + v[j][3]; }
#pragma unroll
      for (int o = 32; o >= 1; o >>= 1) s += __shfl_xor(s, o);
      const float mu = s * (1.f / 1024.f); float q = 0.f;
#pragma unroll
      for (int j = 0; j < 4; ++j) { v[j] -= mu; q += v[j][0] * v[j][0] + v[j][1] * v[j][1] + v[j][2] * v[j][2] + v[j][3] * v[j][3]; }
#pragma unroll
      for (int o = 32; o >= 1; o >>= 1) q += __shfl_xor(q, o);
      const float rs = rsqrtf(q * (1.f / 1024.f) + 1e-5f);
      bf16_t* dst = (bf16_t*)(p.ws + O_MEMN) + (size_t)row * 1024;
#pragma unroll
      for (int j = 0; j < 4; ++j) {
        const int c = 4 * lane + 256 * j;
        const f32x4 g = *(const f32x4*)(p.mem_g + c), b = *(const f32x4*)(p.mem_b + c);
        *(u32x2*)(dst + c) = pk4(v[j][0] * rs * g[0] + b[0], v[j][1] * rs * g[1] + b[1], v[j][2] * rs * g[2] + b[2], v[j][3] * rs * g[3] + b[3]);
      }
      continue;
    }
    i -= N_MEMN;
    {
      float* bp = (float*)(p.ws + O_BIASP);
      if (tid < 128) {
        const int n = i * 128 + tid;
        const int sc = inmap(n);
        for (int l = 0; l < 2; ++l) bp[l * NP + n] = sc >= 0 ? p.b_in[l * DIN + sc] : 0.f;
      }
    }
  }
}

template <int BK, class AL>
DI void gemm_kloop_t(const AL& al, const bf16_t* __restrict__ Bt, int ldb, int nkt, int m0, int n0, f32x16 (&acc)[2][2], bf16_t* As, bf16_t* Bs) {
  constexpr int CPR = BK / 8, NCH = BK / 16, PITCH = BK + 8, BUF = 128 * PITCH;
  const int tid = otid(), lane = tid & 63, wave = tid >> 6, wr = wave >> 1, wc = wave & 1, r = lane & 31, h = lane >> 5;
  bf16x8 ra[NCH], rb[NCH];
  auto gload = [&](int kt) {
#pragma unroll
    for (int i = 0; i < NCH; ++i) {
      const int cid = tid + 256 * i, row = cid / CPR, kc = (cid % CPR) * 8;
      ra[i] = al(m0 + row, kt * BK + kc);
      rb[i] = *(const bf16x8*)(Bt + (size_t)(n0 + row) * ldb + kt * BK + kc);
    }
  };
  auto lstore = [&](int buf) {
#pragma unroll
    for (int i = 0; i < NCH; ++i) {
      const int cid = tid + 256 * i, row = cid / CPR, kc = (cid % CPR) * 8;
      *(bf16x8*)(As + buf * BUF + row * PITCH + kc) = ra[i];
      *(bf16x8*)(Bs + buf * BUF + row * PITCH + kc) = rb[i];
    }
  };
  gload(0); lstore(0); sub_sync();
  for (int kt = 0; kt < nkt; ++kt) {
    const int buf = kt & 1;
    if (kt + 1 < nkt) gload(kt + 1);
    asm volatile("" ::: "memory");
    const bf16_t* a_ = As + buf * BUF + (wr * 64 + r) * PITCH + 8 * h;
    const bf16_t* b_ = Bs + buf * BUF + (wc * 64 + r) * PITCH + 8 * h;
#pragma unroll
    for (int s = 0; s < BK / 16; ++s) {
      bf16x8 af[2], bfr[2];
      af[0] = *(const bf16x8*)(a_ + 16 * s); af[1] = *(const bf16x8*)(a_ + 32 * PITCH + 16 * s);
      bfr[0] = *(const bf16x8*)(b_ + 16 * s); bfr[1] = *(const bf16x8*)(b_ + 32 * PITCH + 16 * s);
#pragma unroll
      for (int mi = 0; mi < 2; ++mi)
#pragma unroll
        for (int ni = 0; ni < 2; ++ni) acc[mi][ni] = MFMA32(bfr[ni], af[mi], acc[mi][ni]);
    }
    if (kt + 1 < nkt) lstore(buf ^ 1);
    sub_sync();
  }
}
template <class AL>
DI void gemm_kloop(const AL& al, const bf16_t* __restrict__ Bt, int ldb, int nkt, int m0, int n0, f32x16 (&acc)[2][2], bf16_t* As, bf16_t* Bs) {
  gemm_kloop_t<64>(al, Bt, ldb, nkt, m0, n0, acc, As, Bs);
}

DI void zero_acc(f32x16 (&acc)[2][2]) {
#pragma unroll
  for (int a = 0; a < 2; ++a)
#pragma unroll
    for (int b = 0; b < 2; ++b)
#pragma unroll
      for (int i = 0; i < 16; ++i) acc[a][b][i] = 0.f;
}

DI int vfrag_key(int key) { const int kk = key & 31; return (key >> 5) * 2048 + (kk >> 4) * 512 + ((kk >> 2) & 1) * 256 + ((kk >> 3) & 1) * 4 + (kk & 3); }
DI int vfrag_col(int cw) { const int d = cw & 63; return (cw >> 6) * 524288 + (d >> 5) * 1024 + (d & 31) * 8; }

DI int kfrag_key(int key) { return (key >> 5) * 2048 + (key & 31) * 8; }
DI int kfrag_col(int cw) { const int d = cw & 63; return (cw >> 6) * 524288 + (d >> 4) * 512 + ((d >> 3) & 1) * 256 + (d & 7); }

struct PlainA {
  const bf16_t* A; int lda;
  DI bf16x8 operator()(int row, int k) const { return *(const bf16x8*)(A + (size_t)row * lda + k); }
};

DI void p1_tile(const Params& p, int layer, int half, int mt, int nt, unsigned char* smem) {
  sub_sync();
  bf16_t* As = (bf16_t*)smem; bf16_t* Bs = As + 2 * 9216;
  f32x16 acc[2][2]; zero_acc(acc);
  PlainA al{(const bf16_t*)(p.ws + O_XB) + (size_t)half * TH * 1024, 1024};
  const int m0 = mt * 128, n0 = nt * 128;
  gemm_kloop(al, (const bf16_t*)(p.ws + O_WTIN + layer * SZ_WTIN1), 1024, 16, m0, n0, acc, As, Bs);
  const int tid = otid(), lane = tid & 63, wave = tid >> 6, wr = wave >> 1, wc = wave & 1, r = lane & 31, h = lane >> 5;
  const float* bias = (const float*)(p.ws + O_BIASP) + layer * NP;
  unsigned char* ws = p.ws;
  {
    const int nb0 = n0 + wc * 64;
    bf16_t* dst0 = nullptr; int pitch0 = 0, coff0 = 0, xf0 = 0;
    if (nb0 < 384) { dst0 = (bf16_t*)(ws + O_QKA); pitch0 = 384; coff0 = nb0; }
    else if (nb0 >= C_BQK && nb0 < 2304) { dst0 = (bf16_t*)(ws + O_QKB); pitch0 = 1152; coff0 = nb0 - C_BQK; }
    else if (nb0 >= C_CQK && nb0 < 4224) { dst0 = (bf16_t*)(ws + O_QKC); pitch0 = 384; coff0 = nb0 - C_CQK; }
    else if (nb0 >= C_D && nb0 < C_E) { dst0 = (bf16_t*)(ws + O_QKVD); pitch0 = 1152; coff0 = nb0 - C_D; }
    else if (nb0 >= C_E && nb0 < C_SM) { dst0 = (bf16_t*)(ws + O_QE); pitch0 = 384; coff0 = nb0 - C_E; }
    else if (nb0 >= C_Z && nb0 < C_MG) { dst0 = (bf16_t*)(ws + O_SZ); pitch0 = 1920; coff0 = nb0 - C_Z; xf0 = 1; }
    else if (nb0 >= C_MG) { dst0 = (bf16_t*)(ws + O_SIG); pitch0 = 5120; coff0 = nb0 - C_MG; xf0 = 2; }
    if (dst0 != nullptr) {
      bf16_t* stg = (bf16_t*)smem + wave * (64 * 72);
#pragma unroll
      for (int ni = 0; ni < 2; ++ni)
#pragma unroll
        for (int mi = 0; mi < 2; ++mi)
#pragma unroll
          for (int g = 0; g < 4; ++g) {
            const int cq = ni * 32 + 8 * g + 4 * h;
            const f32x4 bv = *(const f32x4*)(bias + nb0 + cq);
            float v[4];
#pragma unroll
            for (int e = 0; e < 4; ++e) v[e] = acc[mi][ni][4 * g + e] + bv[e];
            if (xf0 == 1) {
#pragma unroll
              for (int e = 0; e < 4; ++e) v[e] = fsilu(v[e]);
            } else if (xf0 == 2) {
#pragma unroll
              for (int e = 0; e < 4; ++e) v[e] = fsigmoid(v[e]);
            }
            *(u32x2*)(stg + (mi * 32 + r) * 72 + cq) = pk4(v[0], v[1], v[2], v[3]);
          }
      asm volatile("s_waitcnt lgkmcnt(0)" ::: "memory");
      __builtin_amdgcn_wave_barrier();
      const int tok0 = m0 + wr * 64;
#pragma unroll
      for (int it = 0; it < 8; ++it) {
        const int row = it * 8 + (lane >> 3), ch = (lane & 7) * 8;
        const bf16x8 val = *(const bf16x8*)(stg + row * 72 + ch);
        *(bf16x8*)(dst0 + (size_t)(tok0 + row) * pitch0 + coff0 + ch) = val;
      }
      return;
    }
  }
#pragma unroll
  for (int ni = 0; ni < 2; ++ni) {
    const int nb = n0 + wc * 64 + ni * 32;
    int kind;
    int xf = 0;
    bf16_t* dst = nullptr; int pitch = 0, coff = 0;
    int kgrp = 0;
    if (nb < 384) { kind = 0; dst = (bf16_t*)(ws + O_QKA); pitch = 384; coff = nb; }
    else if (nb < C_AV) { kind = 5; dst = (bf16_t*)(ws + O_KFA); coff = nb - 384; }
    else if (nb < C_BQK) { kind = 1; dst = (bf16_t*)(ws + O_VTA); coff = nb - C_AV; }
    else if (nb < 2304) { kind = 0; dst = (bf16_t*)(ws + O_QKB); pitch = 1152; coff = nb - C_BQK; }
    else if (nb < C_BV) { kind = 5; kgrp = (nb - 2304) / 384; dst = (bf16_t*)(ws + O_KFB + kgrp * SZ_VT); coff = (nb - 2304) - kgrp * 384; }
    else if (nb < C_CQK) { kind = 2; dst = (bf16_t*)(ws + O_VTB); coff = nb - C_BV; }
    else if (nb < 4224) { kind = 0; dst = (bf16_t*)(ws + O_QKC); pitch = 384; coff = nb - C_CQK; }
    else if (nb < C_CV) { kind = 5; dst = (bf16_t*)(ws + O_KFC); coff = nb - 4224; }
    else if (nb < C_D) { kind = 1; dst = (bf16_t*)(ws + O_VTC); coff = nb - C_CV; }
    else if (nb < C_E) { kind = 0; dst = (bf16_t*)(ws + O_QKVD); pitch = 1152; coff = nb - C_D; }
    else if (nb < C_SM) { kind = 0; dst = (bf16_t*)(ws + O_QE); pitch = 384; coff = nb - C_E; }
    else if (nb < C_Z) { kind = (nb == C_SM) ? 3 : 4; }
    else if (nb < C_MG) { kind = 0; xf = 1; dst = (bf16_t*)(ws + O_SZ); pitch = 1920; coff = nb - C_Z; }
    else { kind = 0; xf = 2; dst = (bf16_t*)(ws + O_SIG); pitch = 5120; coff = nb - C_MG; }
    if (kind == 4) continue;
#pragma unroll
    for (int mi = 0; mi < 2; ++mi) {
      const int tok = m0 + wr * 64 + mi * 32 + r;
#pragma unroll
      for (int g = 0; g < 4; ++g) {
        const int cq = 8 * g + 4 * h;
        const f32x4 bv = *(const f32x4*)(bias + nb + cq);
        float v[4];
#pragma unroll
        for (int e = 0; e < 4; ++e) v[e] = acc[mi][ni][4 * g + e] + bv[e];
        if (kind == 0) {
          if (xf == 1) {
#pragma unroll
            for (int e = 0; e < 4; ++e) v[e] = fsilu(v[e]);
          } else if (xf == 2) {
#pragma unroll
            for (int e = 0; e < 4; ++e) v[e] = fsigmoid(v[e]);
          }
          *(u32x2*)(dst + (size_t)tok * pitch + coff + cq) = pk4(v[0], v[1], v[2], v[3]);
        } else if (kind == 5) {
          const int key = kgrp == 0 ? tok : kgrp == 1 ? (tok & 3) * 2048 + (tok >> 2) : (tok & 15) * 512 + (tok >> 4);
          *(u32x2*)(dst + kfrag_col(coff + cq) + kfrag_key(key)) = pk4(v[0], v[1], v[2], v[3]);
        } else if (kind == 1) {
          const int ko = vfrag_key(tok);
#pragma unroll
          for (int e = 0; e < 4; ++e) dst[vfrag_col(coff + cq + e) + ko] = f2bf(v[e]);
        } else if (kind == 2) {
          const int k1 = vfrag_key(tok), k4 = vfrag_key((tok & 3) * 2048 + (tok >> 2)), k16 = vfrag_key((tok & 15) * 512 + (tok >> 4));
#pragma unroll
          for (int e = 0; e < 4; ++e) {
            const bf16_t b = f2bf(v[e]); const int co = vfrag_col(coff + cq + e);
            dst[co + k1] = b; dst[SZ_VT / 2 + co + k4] = b; dst[SZ_VT + co + k16] = b;
          }
        } else {
          float* sm = (float*)(ws + O_SM);
#pragma unroll
          for (int e = 0; e < 4; ++e) if (cq + e < 18) sm[tok * 32 + cq + e] = v[e];
        }
      }
    }
  }
}


DI int g_lds_byte(int r, int c) { const int st = (r >> 4) * 2 + (c >> 5), ob = (r & 15) * 64 + (c & 31) * 2; return st * 1024 + (ob ^ (((ob >> 9) & 1) << 5)); }
DI void g_stage_rc(int b, int& R, int& C) { const int st = b >> 10, sb = b & 1023, swz = sb ^ (((sb >> 9) & 1) << 5); R = (st >> 1) * 16 + (swz >> 6); C = (st & 1) * 32 + ((swz & 63) >> 1); }

DI float row16_sum(float v);
DI void p1_unit(const Params& p, int layer, int half, int pm, int pn, int pm_next, int pn_next  , bool first, unsigned char* lds) {
  const int tid = rtid(), wid = tid >> 6, lane = tid & 63, wr = wid >> 2, wc = wid & 3, fr = lane & 15, fq = lane >> 4;
  const bf16_t* Ab = (const bf16_t*)(p.ws + O_XB) + ((size_t)half * TH + (size_t)pm * 256) * 1024;
  const bf16_t* Bb = (const bf16_t*)(p.ws + O_WTIN + layer * SZ_WTIN1) + (size_t)pn * 256 * 1024;
  int sOff[4];
#pragma unroll
  for (int i = 0; i < 4; ++i) { int R, C; g_stage_rc(wid * 1024 + i * 8192 + lane * 16, R, C); sOff[i] = R * 1024 + C; }
  auto stage2 = [&](const bf16_t* A_, const bf16_t* B_, int buf, int kt) {
#pragma unroll
    for (int i = 0; i < 4; ++i) {
      __builtin_amdgcn_global_load_lds((const unsigned*)(A_ + sOff[i] + kt * 64), (unsigned*)(lds + buf * 65536 + wid * 1024 + i * 8192), 16, 0, 0);
      __builtin_amdgcn_global_load_lds((const unsigned*)(B_ + sOff[i] + kt * 64), (unsigned*)(lds + buf * 65536 + 32768 + wid * 1024 + i * 8192), 16, 0, 0);
    }
  };
  auto stage = [&](int buf, int kt) { stage2(Ab, Bb, buf, kt); };
  f32x4 acc[8][4];
#pragma unroll
  for (int m = 0; m < 8; ++m)
#pragma unroll
    for (int n = 0; n < 4; ++n) acc[m][n] = (f32x4){0.f, 0.f, 0.f, 0.f};
  const int lane_off = (fr * 64 + fq * 16) ^ ((fr >> 3) << 5);
  if (first) { __syncthreads(); stage(0, 0); }
  asm volatile("s_waitcnt vmcnt(0)" ::: "memory");
  __syncthreads();
#pragma unroll 1
  for (int t = 0; t < 16; ++t) {
    const int cur = t & 1;
    {
      const bool last = (t + 1 == 16);
      if (!last || pn_next >= 0) {
        const long dA = last ? (long)(pm_next - pm) * 256 * 1024 - 0 : (long)(t + 1) * 64;
        const long dB = last ? (long)(pn_next - pn) * 256 * 1024 - 0 : (long)(t + 1) * 64;
#pragma unroll
        for (int i = 0; i < 4; ++i) {
          __builtin_amdgcn_global_load_lds((const unsigned*)(Ab + sOff[i] + dA), (unsigned*)(lds + (cur ^ 1) * 65536 + wid * 1024 + i * 8192), 16, 0, 0);
          __builtin_amdgcn_global_load_lds((const unsigned*)(Bb + sOff[i] + dB), (unsigned*)(lds + (cur ^ 1) * 65536 + 32768 + wid * 1024 + i * 8192), 16, 0, 0);
        }
      }
    }
    const unsigned char* SA = lds + cur * 65536 + wr * 16384 + lane_off;
    const unsigned char* SB = lds + cur * 65536 + 32768 + wc * 8192 + lane_off;
    bf16x8 Bf[2][4], At[2][2];
#pragma unroll
    for (int n = 0; n < 4; ++n) Bf[0][n] = *(const bf16x8*)(SB + n * 2048);
#pragma unroll
    for (int m = 0; m < 2; ++m) At[0][m] = *(const bf16x8*)(SA + m * 2048);
#pragma unroll
    for (int g = 0; g < 8; ++g) {
      const int ks = g >> 2, pr = g & 3;
      if (g == 1) {
#pragma unroll
        for (int n = 0; n < 4; ++n) Bf[1][n] = *(const bf16x8*)(SB + n * 2048 + 1024);
      }
      if (g < 7) {
        const int g1 = g + 1;
#pragma unroll
        for (int m = 0; m < 2; ++m) At[g1 & 1][m] = *(const bf16x8*)(SA + ((g1 & 3) * 2 + m) * 2048 + (g1 >> 2) * 1024);
      }
      asm volatile("" : "+v"(acc[pr * 2][0][0]) :: "memory");
#pragma unroll
      for (int m = 0; m < 2; ++m)
#pragma unroll
        for (int n = 0; n < 4; ++n) acc[pr * 2 + m][n] = MFMA16(Bf[ks][n], At[g & 1][m], acc[pr * 2 + m][n]);
    }
    asm volatile("s_waitcnt vmcnt(0)" ::: "memory");
    __syncthreads();
  }
  const int nb0 = pn * 256 + wc * 64, tok0 = pm * 256 + wr * 128;
  const float* bias = (const float*)(p.ws + O_BIASP) + layer * NP;
  unsigned char* ws = p.ws;
  int kind, xf = 0, kgrp = 0, pitch = 0, coff = 0; bf16_t* dst = nullptr;
  if (nb0 < 384) { kind = 0; dst = (bf16_t*)(ws + O_QKA); pitch = 384; coff = nb0; }
  else if (nb0 < C_AV) { kind = 5; dst = (bf16_t*)(ws + O_KFA); coff = nb0 - 384; }
  else if (nb0 < C_BQK) { kind = 1; dst = (bf16_t*)(ws + O_VTA); coff = nb0 - C_AV; }
  else if (nb0 < 2304) { kind = 0; dst = (bf16_t*)(ws + O_QKB); pitch = 1152; coff = nb0 - C_BQK; }
  else if (nb0 < C_BV) { kind = 5; kgrp = (nb0 - 2304) / 384; dst = (bf16_t*)(ws + O_KFB + kgrp * SZ_VT); coff = (nb0 - 2304) - kgrp * 384; }
  else if (nb0 < C_CQK) { kind = 2; dst = (bf16_t*)(ws + O_VTB); coff = nb0 - C_BV; }
  else if (nb0 < 4224) { kind = 0; dst = (bf16_t*)(ws + O_QKC); pitch = 384; coff = nb0 - C_CQK; }
  else if (nb0 < C_CV) { kind = 5; dst = (bf16_t*)(ws + O_KFC); coff = nb0 - 4224; }
  else if (nb0 < C_D) { kind = 1; dst = (bf16_t*)(ws + O_VTC); coff = nb0 - C_CV; }
  else if (nb0 < C_E) { kind = 0; dst = (bf16_t*)(ws + O_QKVD); pitch = 1152; coff = nb0 - C_D; }
  else if (nb0 < C_SM) { kind = 0; dst = (bf16_t*)(ws + O_QE); pitch = 384; coff = nb0 - C_E; }
  else if (nb0 < C_Z) { kind = (nb0 == C_SM) ? 3 : 4; }
  else if (nb0 < C_MG) { kind = 0; xf = 1; dst = (bf16_t*)(ws + O_SZ); pitch = 1920; coff = nb0 - C_Z; }
  else if (nb0 < 13696) { kind = 0; xf = 2; dst = (bf16_t*)(ws + O_SIG); pitch = 5120; coff = nb0 - C_MG; }
  else { kind = 4; }
  if (kind == 4) return;
  if (kind == 0) {
    bf16_t* stg = (bf16_t*)(lds + 65536 + wid * 9216);
#pragma unroll
    for (int mh = 0; mh < 2; ++mh) {
#pragma unroll
      for (int m = 0; m < 4; ++m)
#pragma unroll
        for (int n = 0; n < 4; ++n) {
          const int c4 = n * 16 + fq * 4;
          const f32x4 bv = *(const f32x4*)(bias + nb0 + c4);
          float v[4];
#pragma unroll
          for (int e = 0; e < 4; ++e) v[e] = acc[mh * 4 + m][n][e] + bv[e];
          if (xf == 1) {
#pragma unroll
            for (int e = 0; e < 4; ++e) v[e] = fsilu(v[e]);
          } else if (xf == 2) {
#pragma unroll
            for (int e = 0; e < 4; ++e) v[e] = fsigmoid(v[e]);
          }
          *(u32x2*)(stg + (m * 16 + fr) * 72 + c4) = pk4(v[0], v[1], v[2], v[3]);
        }
      asm volatile("s_waitcnt lgkmcnt(0)" ::: "memory");
      __builtin_amdgcn_wave_barrier();
#pragma unroll
      for (int it = 0; it < 8; ++it) {
        const int row = it * 8 + (lane >> 3), ch = (lane & 7) * 8;
        const bf16x8 val = *(const bf16x8*)(stg + row * 72 + ch);
        *(bf16x8*)(dst + (size_t)(tok0 + mh * 64 + row) * pitch + coff + ch) = val;
      }
      asm volatile("s_waitcnt lgkmcnt(0)" ::: "memory");
      __builtin_amdgcn_wave_barrier();
    }
    return;
  }
  if (nb0 >= 384 && nb0 < C_AV) {
    float* ksum = (float*)(ws + O_KSUM) + (size_t)(pm * 2 + wr) * 384 + (nb0 - 384);
#pragma unroll
    for (int n = 0; n < 4; ++n) {
      const f32x4 bv = *(const f32x4*)(bias + nb0 + n * 16 + fq * 4);
#pragma unroll
      for (int e = 0; e < 4; ++e) {
        float t = 8.f * bv[e];
#pragma unroll
        for (int m = 0; m < 8; ++m) t += acc[m][n][e];
        t = row16_sum(t);
        if (fr == 0) ksum[n * 16 + fq * 4 + e] = t;
      }
    }
  }
#pragma unroll
  for (int m = 0; m < 8; ++m) {
    const int tok = tok0 + m * 16 + fr;
#pragma unroll
    for (int n = 0; n < 4; ++n) {
      const int c4 = n * 16 + fq * 4;
      const f32x4 bv = *(const f32x4*)(bias + nb0 + c4);
      float v[4];
#pragma unroll
      for (int e = 0; e < 4; ++e) v[e] = acc[m][n][e] + bv[e];
      if (kind == 5) {
        const int key = kgrp == 0 ? tok : kgrp == 1 ? (tok & 3) * 2048 + (tok >> 2) : (tok & 15) * 512 + (tok >> 4);
        *(u32x2*)(dst + kfrag_col(coff + c4) + kfrag_key(key)) = pk4(v[0], v[1], v[2], v[3]);
      } else if (kind == 1) {
        const int ko = vfrag_key(tok);
#pragma unroll
        for (int e = 0; e < 4; ++e) dst[vfrag_col(coff + c4 + e) + ko] = f2bf(v[e]);
      } else if (kind == 2) {
        const int k1 = vfrag_key(tok), k4 = vfrag_key((tok & 3) * 2048 + (tok >> 2)), k16 = vfrag_key((tok & 15) * 512 + (tok >> 4));
#pragma unroll
        for (int e = 0; e < 4; ++e) {
          const bf16_t b = f2bf(v[e]); const int co = vfrag_col(coff + c4 + e);
          dst[co + k1] = b; dst[SZ_VT / 2 + co + k4] = b; dst[SZ_VT + co + k16] = b;
        }
      } else {
        float* sm = (float*)(ws + O_SM);
#pragma unroll
        for (int e = 0; e < 4; ++e) if (c4 + e < 18) sm[tok * 32 + c4 + e] = v[e];
      }
    }
  }
}

DI void fox_prep(const Params& p, int hh, unsigned char* smem) {
  float* red = (float*)smem;
  const int tid = otid(), lane = tid & 63, wave = tid >> 6;
  const float* sm = (const float*)(p.ws + O_SM);
  float* FF = (float*)(p.ws + O_FF) + hh * TH;
  float loc[32];
#pragma unroll
  for (int j = 0; j < 32; ++j) loc[j] = sm[(tid * 32 + j) * 32 + hh];
  float s = 0.f;
#pragma unroll
  for (int j = 0; j < 32; ++j) { const float xv = loc[j]; s += fminf(xv, 0.f) - log1pf(expf(-fabsf(xv))); loc[j] = s; }
  float inc = s;
#pragma unroll
  for (int o = 1; o < 64; o <<= 1) { const float t = __shfl_up(inc, o); if (lane >= o) inc += t; }
  if (lane == 63) red[wave] = inc;
  sub_sync();
  float off = inc - s;
  for (int w = 0; w < wave; ++w) off += red[w];
#pragma unroll
  for (int j4 = 0; j4 < 8; ++j4) {
    f32x4 o4 = {off + loc[4 * j4], off + loc[4 * j4 + 1], off + loc[4 * j4 + 2], off + loc[4 * j4 + 3]};
    *(f32x4*)(FF + tid * 32 + 4 * j4) = o4;
  }
  sub_sync();
}

DI void kmean_prep(const Params& p, int idx, unsigned* kmaxu) {
  const int lane = otid() & 63;
  const int hh = idx / 32, blk = idx % 32;
  const bf16_t* k = (const bf16_t*)(p.ws + O_KFA) + kfrag_col(hh * 64 + lane) + blk * 8 * 2048;
  float s = 0.f;
#pragma unroll 8
  for (int i = 0; i < 256; ++i) s += bf2f(k[(i >> 5) * 2048 + (i & 31) * 8]);
  s *= (1.f / 256.f);
  const bf16_t hi = f2bf(s);
  bf16_t* km = (bf16_t*)(p.ws + O_KM);
  km[(hh * 32 + blk) * 64 + lane] = hi;
  km[6 * 32 * 64 + (hh * 32 + blk) * 64 + lane] = f2bf(s - bf2f(hi));
  const bf16_t* kc = (const bf16_t*)(p.ws + O_KFC) + (size_t)hh * 524288;
  float mx = 0.f;
#pragma unroll
  for (int t = 0; t < 4; ++t) {
    const int key = blk * 256 + lane * 4 + t;
    float kk = 0.f;
#pragma unroll
    for (int c = 0; c < 8; ++c) { float v[8]; unpk8(*(const bf16x8*)(kc + kfrag_key(key) + c * 256), v);
#pragma unroll
      for (int e = 0; e < 8; ++e) kk += v[e] * v[e]; }
    mx = fmaxf(mx, kk);
  }
#pragma unroll
  for (int o = 32; o >= 1; o >>= 1) mx = fmaxf(mx, __shfl_xor(mx, o));
  if (lane == 0) atomicMax(kmaxu + hh, __float_as_uint(mx));
}

DI void memkv_tile(const Params& p, int layer, int half, int mt, int nt, unsigned char* smem) {
  bf16_t* As = (bf16_t*)smem; bf16_t* Bs = As + 2 * 9216;
  f32x16 acc[2][2]; zero_acc(acc);
  PlainA al{(const bf16_t*)(p.ws + O_MEMN) + (size_t)half * 256 * 1024, 1024};
  const int m0 = mt * 128, n0 = nt * 128;
  gemm_kloop(al, (const bf16_t*)(p.ws + O_WTKV + layer * SZ_WTKV1), 1024, 16, m0, n0, acc, As, Bs);
  const int tid = otid(), lane = tid & 63, wave = tid >> 6, wr = wave >> 1, wc = wave & 1, r = lane & 31, h = lane >> 5;
  bf16_t* mk = (bf16_t*)(p.ws + O_MEMK); bf16_t* mv = (bf16_t*)(p.ws + O_MEMVT);
#pragma unroll
  for (int ni = 0; ni < 2; ++ni)
#pragma unroll
    for (int mi = 0; mi < 2; ++mi) {
      const int m = m0 + wr * 64 + mi * 32 + r;
#pragma unroll
      for (int i = 0; i < 16; ++i) {
        const int col = n0 + wc * 64 + ni * 32 + crow(i, h);
        const bf16_t b = f2bf(acc[mi][ni][i]);
        if (col < 384) { const int hd = col / 96, d = col % 96; mk[(size_t)((half * 4 + hd) * 8 + (m >> 5)) * 3072 + (d >> 4) * 512 + ((d >> 3) & 1) * 256 + (m & 31) * 8 + (d & 7)] = b; }
        else { const int cc = col - 384, hd = cc / 96, d = cc % 96, kk = m & 31;
          mv[(size_t)((half * 4 + hd) * 8 + (m >> 5)) * 3072 + (d >> 5) * 1024 + (kk >> 4) * 512 + ((kk >> 2) & 1) * 256 + (d & 31) * 8 + ((kk >> 3) & 1) * 4 + (kk & 3)] = b; }
      }
    }
}

DI f32x16 mm_quad(const bf16_t* A, const bf16_t* B, int wr, int wc, int r, int h) {
  f32x16 acc;
#pragma unroll
  for (int i = 0; i < 16; ++i) acc[i] = 0.f;
  const bf16_t* a_ = A + (wr * 32 + r) * 72 + 8 * h;
  const bf16_t* b_ = B + (wc * 32 + r) * 72 + 8 * h;
#pragma unroll
  for (int s = 0; s < 4; ++s) acc = MFMA32(*(const bf16x8*)(a_ + 16 * s), *(const bf16x8*)(b_ + 16 * s), acc);
  return acc;
}

DI void gdn_prep(const Params& p, int layer, int half, int hh, int c, unsigned char* smem) {
  bf16_t* QN = (bf16_t*)smem; bf16_t* KN = QN + 4608; bf16_t* KB = KN + 4608; bf16_t* KDT = KB + 4608; bf16_t* VBT = KDT + 4608;
  bf16_t* KBET = VBT + 4608; bf16_t* QKm = KBET + 4608; bf16_t* Tm = QKm + 4608;
  float* gcv = (float*)(smem + 73728); float* betav = gcv + 64; float* egc = gcv + 128;
  float* Mf = (float*)(smem + 9216);
  bf16_t* UT = KN; bf16_t* WT = KB;
  int tid = otid();
  int lane = tid & 63, wave = tid >> 6, wr = wave >> 1, wc = wave & 1, r = lane & 31, h = lane >> 5;
#define REOPAQUE() do { asm volatile("" : "+v"(tid)); lane = tid & 63; wave = tid >> 6; wr = wave >> 1; wc = wave & 1; r = lane & 31; h = lane >> 5; } while (0)
  const float* sm = (const float*)(p.ws + O_SM);
  if (wave == 0) {
    const int tok = c * 64 + lane;
    const float bt = fsigmoid(sm[tok * 32 + 6 + hh]);
    const float xv = sm[tok * 32 + 12 + hh] + p.dt_bias[layer * 6 + hh];
    const float sp = fmaxf(xv, 0.f) + log1pf(expf(-fabsf(xv)));
    float g = -expf(p.a_log[layer * 6 + hh]) * sp;
#pragma unroll
    for (int o = 1; o < 64; o <<= 1) { const float t = __shfl_up(g, o); if (lane >= o) g += t; }
    gcv[lane] = g; betav[lane] = bt; egc[lane] = expf(g);
    if (lane == 63) ((float*)(p.ws + O_GL))[hh * 128 + c] = expf(g);
  }
  sub_sync();
  REOPAQUE();
  {
    const int t = tid >> 2, cg4 = tid & 3, ch0 = cg4 * 16;
    const bf16_t* src = (const bf16_t*)(p.ws + O_QKVD);
    const float* cw = p.conv_w + (size_t)layer * 4 * 1152;
    const float bt = betav[t], gct = gcv[t], eg = egc[t], ed = expf(gcv[63] - gct);
    auto convpart = [&](int pt, float (&val)[16]) {
      const int col = pt * 384 + hh * 64 + ch0;
#pragma unroll
      for (int e = 0; e < 16; ++e) val[e] = 0.f;
#pragma unroll
      for (int j = 0; j < 4; ++j) {
        const int row = c * 64 + t - 3 + j;
        if (row >= 0) {
          float xv[16];
          unpk8(*(const bf16x8*)(src + (size_t)row * 1152 + col), xv);
          unpk8(*(const bf16x8*)(src + (size_t)row * 1152 + col + 8), xv + 8);
#pragma unroll
          for (int e4 = 0; e4 < 4; ++e4) {
            const f32x4 w4 = *(const f32x4*)(cw + j * 1152 + col + 4 * e4);
#pragma unroll
            for (int e = 0; e < 4; ++e) val[4 * e4 + e] += w4[e] * xv[4 * e4 + e];
          }
        }
      }
#pragma unroll
      for (int e = 0; e < 16; ++e) val[e] = fsilu(val[e]);
    };
    {
      float val[16]; convpart(0, val);
      float sq = 0.f;
#pragma unroll
      for (int e = 0; e < 16; ++e) sq += val[e] * val[e];
      sq += __shfl_xor(sq, 1); sq += __shfl_xor(sq, 2);
      const float rq = rsqrtf(sq + 1e-6f) * 0.125f;
#pragma unroll
      for (int e = 0; e < 16; ++e) val[e] *= rq;
      *(bf16x8*)(QN + t * 72 + ch0) = pk8(val); *(bf16x8*)(QN + t * 72 + ch0 + 8) = pk8(val + 8);
    }
    asm volatile("" ::: "memory");
    {
      float val[16]; convpart(1, val);
      float sk = 0.f;
#pragma unroll
      for (int e = 0; e < 16; ++e) sk += val[e] * val[e];
      sk += __shfl_xor(sk, 1); sk += __shfl_xor(sk, 2);
      const float rk = rsqrtf(sk + 1e-6f);
      float kb[16];
#pragma unroll
      for (int e = 0; e < 16; ++e) { val[e] *= rk; kb[e] = val[e] * bt; }
      *(bf16x8*)(KN + t * 72 + ch0) = pk8(val); *(bf16x8*)(KN + t * 72 + ch0 + 8) = pk8(val + 8);
      *(bf16x8*)(KB + t * 72 + ch0) = pk8(kb); *(bf16x8*)(KB + t * 72 + ch0 + 8) = pk8(kb + 8);
#pragma unroll
      for (int e = 0; e < 16; ++e) {
        KDT[(ch0 + e) * 72 + t] = f2bf(val[e] * ed);
        KBET[(ch0 + e) * 72 + t] = f2bf(kb[e] * eg);
      }
    }
    asm volatile("" ::: "memory");
    {
      float val[16]; convpart(2, val);
#pragma unroll
      for (int e = 0; e < 16; ++e) VBT[(ch0 + e) * 72 + t] = f2bf(val[e] * bt);
    }
  }
  sub_sync();
  REOPAQUE();
  {
    const f32x16 kk = mm_quad(KB, KN, wr, wc, r, h);
    const f32x16 qk = mm_quad(QN, KN, wr, wc, r, h);
    sub_sync();
    const int j = wc * 32 + r; const float gj = gcv[j];
#pragma unroll
    for (int i = 0; i < 16; ++i) {
      const int row = wr * 32 + crow(i, h);
      const float dec = (row >= j) ? expf(gcv[row] - gj) : 0.f;
      Mf[row * 68 + j] = (row > j) ? kk[i] * dec : 0.f;
      QKm[row * 72 + j] = f2bf(qk[i] * dec);
    }
  }
  sub_sync();
  REOPAQUE();
  if (wave == 0) {
    float t[64];
#pragma unroll
    for (int i = 0; i < 64; ++i) {
      float a4[4] = {(i == lane) ? 1.f : 0.f, 0.f, 0.f, 0.f};
#pragma unroll
      for (int j4 = 0; j4 < (i + 3) / 4; ++j4) {
        const f32x4 mrow = *(const f32x4*)(Mf + i * 68 + 4 * j4);
#pragma unroll
        for (int e = 0; e < 4; ++e) if (4 * j4 + e < i) a4[e] -= mrow[e] * t[4 * j4 + e];
      }
      const float a = (a4[0] + a4[1]) + (a4[2] + a4[3]);
      t[i] = a;
      Tm[i * 72 + lane] = f2bf(a);
      asm volatile("" ::: "memory");
    }
  }
  sub_sync();
  REOPAQUE();
  {
    const f32x16 u = mm_quad(Tm, VBT, wr, wc, r, h);
    const f32x16 w = mm_quad(Tm, KBET, wr, wc, r, h);
    const int col = wc * 32 + r;
#pragma unroll
    for (int g = 0; g < 4; ++g) {
      const int i0 = wr * 32 + 8 * g + 4 * h;
      *(u32x2*)(UT + col * 72 + i0) = pk4(u[4 * g], u[4 * g + 1], u[4 * g + 2], u[4 * g + 3]);
      *(u32x2*)(WT + col * 72 + i0) = pk4(w[4 * g], w[4 * g + 1], w[4 * g + 2], w[4 * g + 3]);
    }
  }
  sub_sync();
  REOPAQUE();
  {
    bf16_t* base = (bf16_t*)(p.ws + O_DPREP + (size_t)(hh * 128 + c) * 32768);
    const int n = wc * 32 + r;
    {
      const int ks = n >> 5, jh = (n >> 4) & 1, q = (n >> 2) & 3, jl = n & 3, jj = 4 * jh + jl;
      const int cbase = (ks * 64 + 16 * q) * 8 + jj;
      {
        const f32x16 P = mm_quad(KDT, WT, wr, wc, r, h);
#pragma unroll
        for (int i = 0; i < 16; ++i) {
          const int m = wr * 32 + crow(i, h);
          base[((m >> 4) * 128 + (m & 15)) * 8 + cbase] = f2bf(P[i]);
        }
      }
      asm volatile("" ::: "memory");
      {
        const f32x16 QW = mm_quad(QKm, WT, wr, wc, r, h);
#pragma unroll
        for (int i = 0; i < 16; ++i) {
          const int m = wr * 32 + crow(i, h);
          const float qd = bf2f(QN[m * 72 + n]) * egc[m];
          base[4096 + ((m >> 4) * 128 + (m & 15)) * 8 + cbase] = f2bf(qd - QW[i]);
        }
      }
      asm volatile("" ::: "memory");
    }
    const int jsl = n >> 4;
    {
      const f32x16 Bc = mm_quad(KDT, UT, wr, wc, r, h);
#pragma unroll
      for (int g = 0; g < 4; ++g) {
        const int row0 = wr * 32 + 8 * g + 4 * h;
        const int rt = row0 >> 4, lp = 16 * ((row0 >> 2) & 3) + (n & 15);
        *(u32x2*)(base + 8192 + ((jsl * 4 + rt) * 64 + lp) * 4) = pk4(Bc[4 * g], Bc[4 * g + 1], Bc[4 * g + 2], Bc[4 * g + 3]);
      }
    }
    asm volatile("" ::: "memory");
    {
      const f32x16 O0 = mm_quad(QKm, UT, wr, wc, r, h);
#pragma unroll
      for (int g = 0; g < 4; ++g) {
        const int row0 = wr * 32 + 8 * g + 4 * h;
        const int rt = row0 >> 4, lp = 16 * ((row0 >> 2) & 3) + (n & 15);
        *(u32x2*)(base + 12288 + ((jsl * 4 + rt) * 64 + lp) * 4) = pk4(O0[4 * g], O0[4 * g + 1], O0[4 * g + 2], O0[4 * g + 3]);
      }
    }
  }
  sub_sync();
#undef REOPAQUE
}

struct TileDesc { const bf16_t* k; const bf16_t* v; const float* aux; int tag; };

template <int DHT, bool AUX>
struct TileRegs { bf16x8 k[DHT / 16]; bf16x8 v[DHT / 32][2]; f32x4 a[4]; };

template <int DHT, bool AUX>
DI void load_tile(const bf16_t* kp, const bf16_t* vp, const float* ap, long ldv, TileRegs<DHT, AUX>& t) {
#pragma unroll
  for (int s = 0; s < DHT / 16; ++s) t.k[s] = *(const bf16x8*)(kp + 512 * s);
#pragma unroll
  for (int dt = 0; dt < DHT / 32; ++dt)
#pragma unroll
    for (int s = 0; s < 2; ++s) t.v[dt][s] = *(const bf16x8*)(vp + (dt * 2 + s) * 512);
  if (AUX) {
#pragma unroll
    for (int g = 0; g < 4; ++g) t.a[g] = *(const f32x4*)(ap + 8 * g);
  }
}

template <int DHT, bool AUX, class TF, class MF, class SF>
DI void attn_loop(int maxtiles, TF&& tf, MF&& mf, SF&& stopf, const bf16x8 (&qf)[DHT / 16], long ldv, float scale2,
                  f32x16 (&o)[DHT / 32], float& m, float& l) {
  TileRegs<DHT, AUX> cur, nxt;
  int tagc, tagn;
  bf16x8 qf0 = qf[0];
  { const bf16_t* kp; const bf16_t* vp; const float* ap = nullptr; tagc = tf(0, kp, vp, ap); load_tile<DHT, AUX>(kp, vp, ap, ldv, cur); }
#pragma unroll 1
  for (int t = 0; t < maxtiles; ++t) {
    { const bf16_t* kp; const bf16_t* vp; const float* ap = nullptr; tagn = tf(t + 1, kp, vp, ap); load_tile<DHT, AUX>(kp, vp, ap, ldv, nxt); }
    { bf16x8 q0 = qf[0]; asm volatile("" : "+v"(q0) :: "memory"); qf0 = q0; }
    f32x16 sacc;
#pragma unroll
    for (int i = 0; i < 16; ++i) sacc[i] = 0.f;
#pragma unroll
    for (int s = 0; s < DHT / 16; ++s) sacc = MFMA32(cur.k[s], s == 0 ? qf0 : qf[s], sacc);
    float sv[16]; float mx = NEG_INF;
#pragma unroll
    for (int i = 0; i < 16; ++i) { sv[i] = sacc[i] * scale2 + mf(tagc, i, AUX ? cur.a[i >> 2][i & 3] : 0.f); mx = fmaxf(mx, sv[i]); }
    mx = fmaxf(mx, __shfl_xor(mx, 32));
    const float mnew = fmaxf(m, mx);
    const float alpha = __builtin_amdgcn_exp2f(m - mnew);
    m = mnew;
    float pv[16]; float ps = 0.f;
#pragma unroll
    for (int i = 0; i < 16; ++i) { pv[i] = __builtin_amdgcn_exp2f(sv[i] - mnew); ps += pv[i]; }
    l = l * alpha + ps;
#pragma unroll
    for (int dt = 0; dt < DHT / 32; ++dt)
#pragma unroll
      for (int i = 0; i < 16; ++i) o[dt][i] *= alpha;
    bf16x8 pf[2]; pf[0] = pk8(pv); pf[1] = pk8(pv + 8);
#pragma unroll
    for (int dt = 0; dt < DHT / 32; ++dt)
#pragma unroll
      for (int s = 0; s < 2; ++s) {
        o[dt] = MFMA32(cur.v[dt][s], pf[s], o[dt]);
      }
    if (stopf(t, m, AUX ? cur.a[0][0] : 0.f)) break;
    cur = nxt; tagc = tagn;
  }
}

template <int DHT>
DI void attn_store(const f32x16 (&o)[DHT / 32], float l, bf16_t* dstrow, int h, float& ltot_out, bool valid = true) {
  const float ltot = l + __shfl_xor(l, 32);
  ltot_out = ltot;
  const float inv = ltot > 0.f ? 1.f / ltot : 0.f;
  if (valid)
#pragma unroll
  for (int dt = 0; dt < DHT / 32; ++dt)
#pragma unroll
    for (int g = 0; g < 4; ++g)
      *(u32x2*)(dstrow + dt * 32 + 8 * g + 4 * h) = pk4(o[dt][4 * g] * inv, o[dt][4 * g + 1] * inv, o[dt][4 * g + 2] * inv, o[dt][4 * g + 3] * inv);
}

template <int DHT>
DI void attn_store_gated(const f32x16 (&o)[DHT / 32], float l, bf16_t* szrow, int h) {
  const float ltot = l + __shfl_xor(l, 32);
  const float inv = ltot > 0.f ? 1.f / ltot : 0.f;
#pragma unroll
  for (int dt = 0; dt < DHT / 32; ++dt)
#pragma unroll
    for (int g = 0; g < 4; ++g) {
      bf16_t* q = szrow + dt * 32 + 8 * g + 4 * h;
      const u32x2 z = *(const u32x2*)q;
      *(u32x2*)q = pk4(o[dt][4 * g] * inv * bflo(z.x), o[dt][4 * g + 1] * inv * bfhi(z.x), o[dt][4 * g + 2] * inv * bflo(z.y), o[dt][4 * g + 3] * inv * bfhi(z.y));
    }
}

template <int N>
DI void zero_o(f32x16 (&o)[N]) {
#pragma unroll
  for (int a = 0; a < N; ++a)
#pragma unroll
    for (int i = 0; i < 16; ++i) o[a][i] = 0.f;
}

DI void top3_insert(float v, int n, float& v0, float& v1, float& v2, int& i0, int& i1, int& i2) {
  const bool g0 = v > v0, g1 = v > v1, g2 = v > v2;
  v2 = g1 ? v1 : (g2 ? v : v2); i2 = g1 ? i1 : (g2 ? n : i2);
  v1 = g0 ? v0 : (g1 ? v : v1); i1 = g0 ? i0 : (g1 ? n : i1);
  v0 = g0 ? v : v0;             i0 = g0 ? n : i0;
}

DI void moba_select(const Params& p, int a) {
  const int lane = otid() & 63, r = lane & 31, h = lane >> 5;
  const int qtile = a / 6, hh = a % 6, qb = qtile >> 3;
  unsigned mask = 0;
  if (qb > 0) {
    const bf16_t* qrow = (const bf16_t*)(p.ws + O_QKA) + (size_t)(qtile * 32 + r) * 384 + hh * 64 + 8 * h;
    bf16x8 qf[4];
#pragma unroll
    for (int s = 0; s < 4; ++s) qf[s] = *(const bf16x8*)(qrow + 16 * s);
    const float* ks0 = (const float*)(p.ws + O_KSUM) + (size_t)(r * 2) * 384 + hh * 64 + 8 * h;
    f32x16 g;
#pragma unroll
    for (int i = 0; i < 16; ++i) g[i] = 0.f;
#pragma unroll
    for (int s = 0; s < 4; ++s) {
      const f32x4 a0 = *(const f32x4*)(ks0 + 16 * s), a1 = *(const f32x4*)(ks0 + 16 * s + 4);
      const f32x4 b0 = *(const f32x4*)(ks0 + 384 + 16 * s), b1 = *(const f32x4*)(ks0 + 384 + 16 * s + 4);
      float hi[8], lo[8];
#pragma unroll
      for (int e = 0; e < 4; ++e) {
        const float m0 = (a0[e] + b0[e]) * (1.f / 256.f), m1 = (a1[e] + b1[e]) * (1.f / 256.f);
        hi[e] = bf2f(f2bf(m0)); lo[e] = m0 - hi[e];
        hi[4 + e] = bf2f(f2bf(m1)); lo[4 + e] = m1 - hi[4 + e];
      }
      g = MFMA32(pk8(hi), qf[s], g); g = MFMA32(pk8(lo), qf[s], g);
    }
    float v0 = NEG_INF, v1 = NEG_INF, v2 = NEG_INF; int i0 = -1, i1 = -1, i2 = -1;
#pragma unroll
    for (int i = 0; i < 16; ++i) { const int n = crow(i, h); if (n < qb) top3_insert(g[i], n, v0, v1, v2, i0, i1, i2); }
    const float pv0 = __shfl_xor(v0, 32), pv1 = __shfl_xor(v1, 32), pv2 = __shfl_xor(v2, 32);
    const int pi0 = __shfl_xor(i0, 32), pi1 = __shfl_xor(i1, 32), pi2 = __shfl_xor(i2, 32);
    if (pi0 >= 0) top3_insert(pv0, pi0, v0, v1, v2, i0, i1, i2);
    if (pi1 >= 0) top3_insert(pv1, pi1, v0, v1, v2, i0, i1, i2);
    if (pi2 >= 0) top3_insert(pv2, pi2, v0, v1, v2, i0, i1, i2);
    if (i0 >= 0) mask |= 1u << i0;
    if (i1 >= 0) mask |= 1u << i1;
    if (i2 >= 0) mask |= 1u << i2;
  }
  if (h == 0) ((unsigned*)(p.ws + O_MASK))[(qtile * 32 + r) * 8 + hh] = mask;
}

DI void moba_gather(const Params& p, int a, unsigned char* smem) {
  const int tid = otid(), lane = tid & 63, wave = tid >> 6, r = lane & 31, h = lane >> 5;
  const int part = a & 1, a2 = a >> 1;
  const int hh = a2 % 6, idx = a2 / 6;
  int qb = 1;
  while ((qb + 1) * qb / 2 <= idx) ++qb;
  const int n = idx - qb * (qb - 1) / 2;
  const unsigned* MASK = (const unsigned*)(p.ws + O_MASK);
  unsigned* list = (unsigned*)(smem + wave * 1024);
  int cnt = 0;
#pragma unroll
  for (int j = 0; j < 4; ++j) {
    const int qi = j * 64 + lane;
    const unsigned mk = MASK[(qb * 256 + qi) * 8 + hh];
    const bool pred = (mk >> n) & 1u;
    const unsigned long long ball = __ballot(pred);
    const int pos = cnt + __builtin_popcountll(ball & ((1ull << lane) - 1ull));
    if (pred) list[pos] = (unsigned)qi | ((unsigned)__builtin_popcount(mk & ((1u << n) - 1u)) << 8);
    cnt += __builtin_popcountll(ball);
  }
  cnt = __builtin_amdgcn_readfirstlane(cnt);
  if (cnt == 0) return;
  asm volatile("s_waitcnt lgkmcnt(0)" ::: "memory");
  __builtin_amdgcn_wave_barrier();
  const bf16_t* QK = (const bf16_t*)(p.ws + O_QKA);
  const bf16_t* KF = (const bf16_t*)(p.ws + O_KFA) + (size_t)hh * 524288 + (size_t)n * 8 * 2048 + lane * 8;
  const bf16_t* VT = (const bf16_t*)(p.ws + O_VTA) + (size_t)hh * 524288 + (size_t)n * 8 * 2048 + lane * 8;
  const int nch = (cnt + 31) >> 5;
#pragma unroll 1
  for (int c = part; c < nch; c += 2) {
    const int e = c * 32 + r;
    const bool valid = e < cnt;
    const unsigned ent = list[valid ? e : 0];
    const int tok = qb * 256 + (int)(ent & 255u), slot = (int)(ent >> 8);
    bf16x8 qf[4];
    { const bf16_t* qrow = QK + (size_t)tok * 384 + hh * 64 + 8 * h;
#pragma unroll
      for (int s = 0; s < 4; ++s) qf[s] = *(const bf16x8*)(qrow + 16 * s); }
    auto tf = [&](int t, const bf16_t*& kp, const bf16_t*& vp, const float*&) -> int {
      const int tt = t < 7 ? t : 7;
      kp = KF + tt * 2048; vp = VT + tt * 2048;
      return 0;
    };
    auto mf = [&](int, int, float) -> float { return 0.f; };
    auto sf = [&](int, float, float) { return false; };
    f32x16 o[2]; zero_o(o); float m = -1e30f, l = 0.f;
    int nt8 = 8; asm volatile("" : "+s"(nt8));
    attn_loop<64, false>(nt8, tf, mf, sf, qf, (long)TH, 0.125f * LOG2E, o, m, l);
    float lt;
    attn_store<64>(o, l, (bf16_t*)(p.ws + O_OA + slot * SZ_O) + (size_t)tok * 384 + hh * 64, h, lt, valid);
    if (valid && h == 0) { float* st = (float*)(p.ws + O_STA) + ((size_t)(slot * TH + tok) * 6 + hh) * 2; st[0] = m; st[1] = lt; }
  }
}

DI void moba_own(const Params& p, int a) {
  const int lane = otid() & 63, r = lane & 31, h = lane >> 5;
  const int qtile = 255 - a / 6, hh = a % 6, qb = qtile >> 3, own = qtile & 7;
  const bf16_t* QK = (const bf16_t*)(p.ws + O_QKA);
  const bf16_t* KF = (const bf16_t*)(p.ws + O_KFA) + (size_t)hh * 524288 + (size_t)qb * 8 * 2048 + lane * 8;
  const bf16_t* VT = (const bf16_t*)(p.ws + O_VTA) + (size_t)hh * 524288 + (size_t)qb * 8 * 2048 + lane * 8;
  const int tok = qtile * 32 + r;
  bf16x8 qf[4];
  { const bf16_t* qrow = QK + (size_t)tok * 384 + hh * 64 + 8 * h;
#pragma unroll
    for (int s = 0; s < 4; ++s) qf[s] = *(const bf16x8*)(qrow + 16 * s); }
  auto tf = [&](int t, const bf16_t*& kp, const bf16_t*& vp, const float*&) -> int {
    const int kk = t < own ? t : own;
    kp = KF + kk * 2048; vp = VT + kk * 2048;
    return (kk == own) ? 101 : 100;
  };
  auto mf = [&](int tag, int i, float) -> float {
    if (tag == 100) return 0.f;
    return (crow(i, h) <= r) ? 0.f : NEG_INF;
  };
  auto sf = [&](int, float, float) { return false; };
  f32x16 o[2]; zero_o(o); float m = -1e30f, l = 0.f;
  attn_loop<64, false>(own + 1, tf, mf, sf, qf, (long)TH, 0.125f * LOG2E, o, m, l);
  float lt;
  attn_store<64>(o, l, (bf16_t*)(p.ws + O_OA + 3 * SZ_O) + (size_t)tok * 384 + hh * 64, h, lt);
  if (h == 0) {
    float* st = (float*)(p.ws + O_STA);
    st[((size_t)(3 * TH + tok) * 6 + hh) * 2] = m; st[((size_t)(3 * TH + tok) * 6 + hh) * 2 + 1] = lt;
    const int np = __builtin_popcount(((const unsigned*)(p.ws + O_MASK))[tok * 8 + hh]);
    for (int sl = np; sl < 3; ++sl) { st[((size_t)(sl * TH + tok) * 6 + hh) * 2] = -1e30f; st[((size_t)(sl * TH + tok) * 6 + hh) * 2 + 1] = 0.f; }
  }
}

DI void fox_item(const Params& p, int c, const unsigned* kmaxu) {
  const int lane = otid() & 63, r = lane & 31, h = lane >> 5;
  const int qtile = 255 - c / 6, hh = c % 6;
  const bf16_t* QK = (const bf16_t*)(p.ws + O_QKC);
  const bf16_t* KF = (const bf16_t*)(p.ws + O_KFC);
  const bf16_t* VT = (const bf16_t*)(p.ws + O_VTC);
  const float* FF = (const float*)(p.ws + O_FF) + hh * TH;
  bf16x8 qf[4]; float qn2 = 0.f;
  { const bf16_t* qrow = QK + (size_t)(qtile * 32 + r) * 384 + hh * 64 + 8 * h;
#pragma unroll
    for (int s = 0; s < 4; ++s) { qf[s] = *(const bf16x8*)(qrow + 16 * s); float v[8]; unpk8(qf[s], v);
#pragma unroll
      for (int e = 0; e < 8; ++e) qn2 += v[e] * v[e]; } }
  qn2 += __shfl_xor(qn2, 32);
#pragma unroll
  for (int o = 16; o >= 1; o >>= 1) qn2 = fmaxf(qn2, __shfl_xor(qn2, o));
  const float Fq = FF[qtile * 32 + r];
  const float Ffirst = FF[qtile * 32];
  const float kmaxn = sqrtf(__uint_as_float(kmaxu[hh]));
  const float bound = sqrtf(qn2) * kmaxn * 0.125f + Ffirst;
  auto tf = [&](int t, const bf16_t*& kp, const bf16_t*& vp, const float*& ap) -> int {
    const int keybase = (qtile - t > 0 ? qtile - t : 0) * 32;
    kp = KF + (size_t)hh * 524288 + (keybase >> 5) * 2048 + lane * 8;
    vp = VT + (size_t)hh * 524288 + (keybase >> 5) * 2048 + lane * 8;
    ap = FF + keybase + 4 * h;
    return (t == 0) ? 1 : 0;
  };
  auto mf = [&](int tag, int i, float fk) -> float {
    const float b = (Fq - fk) * LOG2E;
    return (tag == 1 && crow(i, h) > r) ? NEG_INF : b;
  };
  auto sf = [&](int, float m, float a0) {
    const float fkb = __builtin_bit_cast(float, __builtin_amdgcn_readfirstlane(__builtin_bit_cast(int, a0)));
    float mm = m;
#pragma unroll
    for (int o = 16; o >= 1; o >>= 1) mm = fminf(mm, __shfl_xor(mm, o));
    return (bound - fkb) * LOG2E < mm - 45.f;
  };
  f32x16 o[2]; zero_o(o); float m = -1e30f, l = 0.f;
  attn_loop<64, true>(qtile + 1, tf, mf, sf, qf, (long)TH, 0.125f * LOG2E, o, m, l);
  float lt;
  attn_store_gated<64>(o, l, (bf16_t*)(p.ws + O_SZ) + (size_t)(qtile * 32 + r) * 1920 + 2 * 384 + hh * 64, h);
}

DI void dil_item(const Params& p, int idx) {
  const int lane = otid() & 63, r = lane & 31, h = lane >> 5;
  const int g = idx / 1536, rem = idx % 1536, hh = rem / 256, w = rem % 256;
  const int dsh = 2 * g;
  const int dil = 1 << dsh, L = TH >> dsh, tps = L / 32;
  const int rs = w / tps, lt_ = w % tps, l0 = lt_ * 32;
  const bf16_t* QK = (const bf16_t*)(p.ws + O_QKB);
  const bf16_t* KF = (const bf16_t*)(p.ws + O_KFB + g * SZ_VT);
  const bf16_t* VT = (const bf16_t*)(p.ws + O_VTB + g * SZ_VT);
  const int tq = (l0 + r) * dil + rs;
  bf16x8 qf[4];
  { const bf16_t* qrow = QK + (size_t)tq * 1152 + g * 384 + hh * 64 + 8 * h;
#pragma unroll
    for (int s = 0; s < 4; ++s) qf[s] = *(const bf16x8*)(qrow + 16 * s); }
  const int t0 = (l0 >= 128) ? 0 : (128 - l0) / 32;
  auto tf = [&](int tt, const bf16_t*& kp, const bf16_t*& vp, const float*&) -> int {
    const int t = (t0 + tt < 4) ? t0 + tt : 4; const int keybase = l0 - 128 + 32 * t;
    kp = KF + (size_t)hh * 524288 + ((rs * L + keybase) >> 5) * 2048 + lane * 8;
    vp = VT + (size_t)hh * 524288 + ((rs * L + keybase) >> 5) * 2048 + lane * 8;
    return t;
  };
  auto mf = [&](int tag, int i, float) -> float {
    const int kj = crow(i, h);
    if (tag == 0) return (kj >= r) ? 0.f : NEG_INF;
    if (tag == 4) return (kj <= r) ? 0.f : NEG_INF;
    return 0.f;
  };
  auto sf = [&](int, float, float) { return false; };
  f32x16 o[2]; zero_o(o); float m = -1e30f, l = 0.f;
  attn_loop<64, false>(5 - t0, tf, mf, sf, qf, (long)TH, 0.125f * LOG2E, o, m, l);
  float lt;
  attn_store<64>(o, l, (bf16_t*)(p.ws + O_OB + g * SZ_O) + (size_t)tq * 384 + hh * 64, h, lt);
  if (h == 0) { float* st = (float*)(p.ws + O_STB) + ((size_t)(g * TH + tq) * 6 + hh) * 2; st[0] = m; st[1] = lt; }
}

DI void mem_item(const Params& p, int half, int e) {
  const int lane = otid() & 63, r = lane & 31, h = lane >> 5;
  const int hd = e & 3, qtile = e >> 2;
  const bf16_t* QE = (const bf16_t*)(p.ws + O_QE);
  const bf16_t* MK = (const bf16_t*)(p.ws + O_MEMK);
  const bf16_t* MV = (const bf16_t*)(p.ws + O_MEMVT);
  bf16x8 qf[6];
  { const bf16_t* qrow = QE + (size_t)(qtile * 32 + r) * 384 + hd * 96 + 8 * h;
#pragma unroll
    for (int s = 0; s < 6; ++s) qf[s] = *(const bf16x8*)(qrow + 16 * s); }
  auto tf = [&](int t, const bf16_t*& kp, const bf16_t*& vp, const float*&) -> int {
    const int keybase = 32 * (t < 7 ? t : 7);
    kp = MK + (size_t)((half * 4 + hd) * 8 + (keybase >> 5)) * 3072 + lane * 8;
    vp = MV + (size_t)((half * 4 + hd) * 8 + (keybase >> 5)) * 3072 + lane * 8;
    return 0;
  };
  auto mf = [&](int, int, float) -> float { return 0.f; };
  auto sf = [&](int, float, float) { return false; };
  f32x16 o[3]; zero_o(o); float m = -1e30f, l = 0.f;
  attn_loop<96, false>(8, tf, mf, sf, qf, 256L, 0.10206207261596577f * LOG2E, o, m, l);
  float lt;
  attn_store_gated<96>(o, l, (bf16_t*)(p.ws + O_SZ) + (size_t)(qtile * 32 + r) * 1920 + 4 * 384 + hd * 96, h);
}

DI float dpp_ror(float v, int ctrl);
DI float row16_sum(float v) {
  v += __builtin_bit_cast(float, __builtin_amdgcn_update_dpp(0, __builtin_bit_cast(int, v), 0x128, 0xf, 0xf, false));
  v += __builtin_bit_cast(float, __builtin_amdgcn_update_dpp(0, __builtin_bit_cast(int, v), 0x124, 0xf, 0xf, false));
  v += __builtin_bit_cast(float, __builtin_amdgcn_update_dpp(0, __builtin_bit_cast(int, v), 0x122, 0xf, 0xf, false));
  v += __builtin_bit_cast(float, __builtin_amdgcn_update_dpp(0, __builtin_bit_cast(int, v), 0x121, 0xf, 0xf, false));
  return v;
}

struct ScanRegs { bf16x8 pf[4][2]; bf16x8 qe[4][2]; s16x4 bc[4]; s16x4 o0[4]; float gl; };
DI void scan_load(const Params& p, int hh, int j, int c, int lane, ScanRegs& s) {
  const unsigned char* base = p.ws + O_DPREP + (size_t)(hh * 128 + c) * 32768;
#pragma unroll
  for (int mt = 0; mt < 4; ++mt)
#pragma unroll
    for (int ks = 0; ks < 2; ++ks) {
      s.pf[mt][ks] = *(const bf16x8*)(base + ((mt * 2 + ks) * 64 + lane) * 16);
      s.qe[mt][ks] = *(const bf16x8*)(base + 8192 + ((mt * 2 + ks) * 64 + lane) * 16);
    }
#pragma unroll
  for (int rt = 0; rt < 4; ++rt) {
    s.bc[rt] = *(const s16x4*)(base + 16384 + ((j * 4 + rt) * 64 + lane) * 8);
    s.o0[rt] = *(const s16x4*)(base + 24576 + ((j * 4 + rt) * 64 + lane) * 8);
  }
  s.gl = ((const float*)(p.ws + O_GL))[hh * 128 + c];
}
DI f32x4 s4f(s16x4 v) { u32x2 u = __builtin_bit_cast(u32x2, v); f32x4 r; r[0] = bflo(u.x); r[1] = bfhi(u.x); r[2] = bflo(u.y); r[3] = bfhi(u.y); return r; }

DI void scan_item(const Params& p, int it) {
  const int lane = otid() & 63, q = lane >> 4, cl = lane & 15;
  const int hh = it >> 2, j = it & 3;
  f32x4 S[4];
#pragma unroll
  for (int rt = 0; rt < 4; ++rt) S[rt] = (f32x4){0.f, 0.f, 0.f, 0.f};
  bf16_t* OD = (bf16_t*)(p.ws + O_OD);
  float* SSQ = (float*)(p.ws + O_SSQ);
#ifndef SCAN_PREFETCH
#define SCAN_PREFETCH 1
#endif
  ScanRegs cur, nxt;
  if (SCAN_PREFETCH) scan_load(p, hh, j, 0, lane, cur);
  for (int c = 0; c < 128; ++c) {
    if (SCAN_PREFETCH) {
      scan_load(p, hh, j, (c + 1 < 128) ? c + 1 : c, lane, nxt);
      asm volatile("" : "+v"(S[0][0]) :: "memory");
    } else {
      scan_load(p, hh, j, c, lane, cur);
    }
    bf16x8 bfr[2];
#pragma unroll
    for (int ks = 0; ks < 2; ++ks) {
      u32x4 u; u.x = pk2(S[2 * ks][0], S[2 * ks][1]); u.y = pk2(S[2 * ks][2], S[2 * ks][3]); u.z = pk2(S[2 * ks + 1][0], S[2 * ks + 1][1]); u.w = pk2(S[2 * ks + 1][2], S[2 * ks + 1][3]);
      bfr[ks] = __builtin_bit_cast(bf16x8, u);
    }
    f32x4 aP[4], aO[4];
#pragma unroll
    for (int rt = 0; rt < 4; ++rt) {
      aP[rt] = (f32x4){0.f, 0.f, 0.f, 0.f};
      aO[rt] = s4f(cur.o0[rt]);
#pragma unroll
      for (int ks = 0; ks < 2; ++ks) { aP[rt] = MFMA16(cur.pf[rt][ks], bfr[ks], aP[rt]); aO[rt] = MFMA16(cur.qe[rt][ks], bfr[ks], aO[rt]); }
    }
#pragma unroll
    for (int rt = 0; rt < 4; ++rt) S[rt] = S[rt] * cur.gl - aP[rt] + s4f(cur.bc[rt]);
#pragma unroll
    for (int rt = 0; rt < 4; ++rt)
#pragma unroll
      for (int e = 0; e < 4; ++e) {
        const int tok = c * 64 + 16 * rt + 4 * q + e;
        const float v = aO[rt][e];
        OD[(size_t)tok * 384 + hh * 64 + 16 * j + cl] = f2bf(v);
        const float ss = row16_sum(v * v);
        if (cl == 0) SSQ[(tok * 6 + hh) * 4 + j] = ss;
      }
    if (SCAN_PREFETCH) cur = nxt;
  }
}

DI void scan_block(const Params& p, int hh, unsigned char* smem) {
  const int tid = otid(), lane = tid & 63, j = tid >> 6, q = lane >> 4, cl = lane & 15;
  const unsigned char* src = p.ws + O_DPREP + (size_t)hh * 128 * 32768;
  bf16_t* ostg = (bf16_t*)(smem + 65536);
  bf16x8 R0[8], R1[8];
  auto gld = [&](int c, bf16x8 (&R)[8]) {
    c = c < 128 ? c : 127;
    const unsigned char* b = src + (size_t)c * 32768 + tid * 16;
#pragma unroll
    for (int i = 0; i < 8; ++i) R[i] = *(const bf16x8*)(b + i * 4096);
  };
  auto lst = [&](int buf, const bf16x8 (&R)[8]) {
    unsigned char* d = smem + buf * 32768 + tid * 16;
#pragma unroll
    for (int i = 0; i < 8; ++i) *(bf16x8*)(d + i * 4096) = R[i];
  };
  const float* GL = (const float*)(p.ws + O_GL) + hh * 128;
  const float gl_lo = GL[lane], gl_hi = GL[64 + lane];
  f32x4 S[4];
#pragma unroll
  for (int rt = 0; rt < 4; ++rt) S[rt] = (f32x4){0.f, 0.f, 0.f, 0.f};
  bf16_t* OD = (bf16_t*)(p.ws + O_OD);
  float* SSQ = (float*)(p.ws + O_SSQ);
  f32x4 aO[4];
  auto flush = [&](int cp) {
    const int row = tid >> 2, part = tid & 3;
    const bf16x8 v0 = *(const bf16x8*)(ostg + row * 72 + 16 * part), v1 = *(const bf16x8*)(ostg + row * 72 + 16 * part + 8);
    float f[16]; unpk8(v0, f); unpk8(v1, f + 8);
    float ss = 0.f;
#pragma unroll
    for (int e = 0; e < 16; ++e) ss += f[e] * f[e];
    const int tok = cp * 64 + row;
    bf16_t* dst = OD + (size_t)tok * 384 + hh * 64 + 16 * part;
    *(bf16x8*)dst = v0; *(bf16x8*)(dst + 8) = v1;
    SSQ[(tok * 6 + hh) * 4 + part] = ss;
  };
  auto compute = [&](int buf, int c) {
    const unsigned char* base = smem + buf * 32768;
    const float gl = __builtin_bit_cast(float, __builtin_amdgcn_readlane(__builtin_bit_cast(int, c < 64 ? gl_lo : gl_hi), c & 63));
    bf16x8 bfr[2];
#pragma unroll
    for (int ks = 0; ks < 2; ++ks) {
      u32x4 u; u.x = pk2(S[2 * ks][0], S[2 * ks][1]); u.y = pk2(S[2 * ks][2], S[2 * ks][3]); u.z = pk2(S[2 * ks + 1][0], S[2 * ks + 1][1]); u.w = pk2(S[2 * ks + 1][2], S[2 * ks + 1][3]);
      bfr[ks] = __builtin_bit_cast(bf16x8, u);
    }
    f32x4 aP[4];
#pragma unroll
    for (int rt = 0; rt < 4; ++rt) {
      aP[rt] = (f32x4){0.f, 0.f, 0.f, 0.f};
      aO[rt] = s4f(*(const s16x4*)(base + 24576 + ((j * 4 + rt) * 64 + lane) * 8));
#pragma unroll
      for (int ks = 0; ks < 2; ++ks) {
        aP[rt] = MFMA16(*(const bf16x8*)(base + ((rt * 2 + ks) * 64 + lane) * 16), bfr[ks], aP[rt]);
        aO[rt] = MFMA16(*(const bf16x8*)(base + 8192 + ((rt * 2 + ks) * 64 + lane) * 16), bfr[ks], aO[rt]);
      }
    }
#pragma unroll
    for (int rt = 0; rt < 4; ++rt) S[rt] = S[rt] * gl - aP[rt] + s4f(*(const s16x4*)(base + 16384 + ((j * 4 + rt) * 64 + lane) * 8));
  };
  auto stage_out = [&]() {
#pragma unroll
    for (int rt = 0; rt < 4; ++rt)
#pragma unroll
      for (int e = 0; e < 4; ++e) ostg[(16 * rt + 4 * q + e) * 72 + 16 * j + cl] = f2bf(aO[rt][e]);
  };
  __builtin_amdgcn_s_setprio(3);
  gld(0, R0); gld(1, R1);
  lst(0, R0); gld(2, R0);
  sub_sync();
#pragma unroll 1
  for (int c = 0; c < 128; c += 2) {
    lst(1, R1);
    gld(c + 3, R1);
    if (c > 0) flush(c - 1);
    compute(0, c);
    sub_sync();
    stage_out();
    sub_sync();
    lst(0, R0);
    gld(c + 4, R0);
    flush(c);
    compute(1, c + 1);
    sub_sync();
    stage_out();
    sub_sync();
  }
  flush(127);
  sub_sync();
  __builtin_amdgcn_s_setprio(0);
}

DI void phase3(const Params& p, int half, unsigned* ctr, const unsigned* kmaxu, unsigned char* smem, int sub, int limit = 1 << 30) {
  const int tid = otid(), wave = tid >> 6;
  const int hb = (int)blockIdx.x, x = hb & 7, bi = hb >> 3;
  if (hb < 3 && limit >= 0) { if (PH(5)) scan_block(p, hb * 2 + sub, smem); }
  if (bi >= 1 && limit != 0) {
    const int nlw = ((int)(gridDim.x >> 3) - 1) * 8, lw = ((bi - 1) * 2 + sub) * 4 + wave;
    if (x < 6) {
      const int hh = x;
      constexpr int NG = 992, NOWN = 256, NB_ = 640, NTOT = NG + NOWN + NB_;
      for (int pos0 = lw; pos0 < NTOT; pos0 += nlw) {
        int pos = __builtin_amdgcn_readfirstlane(pos0);
        if (pos < NG) { if (PH(6)) moba_gather(p, (((pos >> 1) * 6 + hh) << 1) | (pos & 1), smem); continue; }
        pos -= NG;
        if (pos < NOWN) { if (PH(6)) moba_own(p, pos * 6 + hh); continue; }
        pos -= NOWN;
        const int g = pos < 512 ? (pos >> 8) : 2, w = pos < 512 ? (pos & 255) : 2 * (pos - 512);
        if (PH(8)) dil_item(p, g * 1536 + hh * 256 + w);
      }
    } else {
      const int h0 = (x - 6) * 3;
      constexpr int NE = 512, NC = 768, NB2 = 384, NTOT = NE + NC + NB2;
      for (int pos0 = lw; pos0 < NTOT; pos0 += nlw) {
        int pos = __builtin_amdgcn_readfirstlane(pos0);
        if (pos < NE) { if (PH(7)) mem_item(p, half, (x - 6) * 512 + pos); continue; }
        pos -= NE;
        if (pos < NC) { if (PH(9)) fox_item(p, (pos & 255) * 6 + h0 + (pos >> 8), kmaxu); continue; }
        pos -= NC;
        if (PH(8)) dil_item(p, 2 * 1536 + (h0 + (pos >> 7)) * 256 + 2 * (pos & 127) + 1);
      }
    }
  }
}

DI void gbuild_chunk(const Params& p, int layer, int tok, int c8) {
  const unsigned char* ws = p.ws;
  const int n = c8 / 48, c = (c8 % 48) * 8;
  if (n == 2 || n == 4) return;
  bf16_t* szp = (bf16_t*)(p.ws + O_SZ) + (size_t)tok * 1920 + n * 384 + c;
  float o[8], z[8];
  unpk8(*(const bf16x8*)szp, z);
  if (n == 1) {
    const int hh = c >> 6;
    const float* st = (const float*)(ws + O_STB);
    float mg[3], lg[3];
#pragma unroll
    for (int g = 0; g < 3; ++g) { const f32x2 s2 = *(const f32x2*)(st + ((size_t)(g * TH + tok) * 6 + hh) * 2); mg[g] = s2[0]; lg[g] = s2[1]; }
    const float mm = fmaxf(mg[0], fmaxf(mg[1], mg[2]));
    float wg[3], ws_ = 0.f;
#pragma unroll
    for (int g = 0; g < 3; ++g) { wg[g] = exp2f(mg[g] - mm) * lg[g]; ws_ += wg[g]; }
    const float inv = 1.f / ws_;
#pragma unroll
    for (int e = 0; e < 8; ++e) o[e] = 0.f;
#pragma unroll
    for (int g = 0; g < 3; ++g) {
      float t[8]; unpk8(*(const bf16x8*)((const bf16_t*)(ws + O_OB + g * SZ_O) + (size_t)tok * 384 + c), t);
      const float wgi = wg[g] * inv;
#pragma unroll
      for (int e = 0; e < 8; ++e) o[e] += wgi * t[e];
    }
  } else if (n == 3) {
    const int hh = c >> 6;
    const f32x4 sq = *(const f32x4*)((const float*)(ws + O_SSQ) + ((size_t)tok * 6 + hh) * 4);
    const float rs = rsqrtf((sq[0] + sq[1] + sq[2] + sq[3]) * (1.f / 64.f) + 1e-6f);
    unpk8(*(const bf16x8*)((const bf16_t*)(ws + O_OD) + (size_t)tok * 384 + c), o);
    const float* gw = p.gdn_w + layer * 64 + (c & 63);
#pragma unroll
    for (int e = 0; e < 8; ++e) o[e] *= rs * gw[e];
  } else if (n == 0) {
    const int hh = c >> 6;
    const float* st = (const float*)(ws + O_STA);
    float mg[4], lg[4], mm = -1e30f;
#pragma unroll
    for (int g = 0; g < 4; ++g) { const f32x2 s2 = *(const f32x2*)(st + ((size_t)(g * TH + tok) * 6 + hh) * 2); mg[g] = s2[0]; lg[g] = s2[1]; mm = fmaxf(mm, mg[g]); }
    float wg[4], ws_ = 0.f;
#pragma unroll
    for (int g = 0; g < 4; ++g) { wg[g] = exp2f(mg[g] - mm) * lg[g]; ws_ += wg[g]; }
    const float inv = 1.f / ws_;
#pragma unroll
    for (int e = 0; e < 8; ++e) o[e] = 0.f;
#pragma unroll
    for (int g = 0; g < 4; ++g) {
      if (lg[g] > 0.f) {
        float t[8]; unpk8(*(const bf16x8*)((const bf16_t*)(ws + O_OA + g * SZ_O) + (size_t)tok * 384 + c), t);
        const float wgi = wg[g] * inv;
#pragma unroll
        for (int e = 0; e < 8; ++e) o[e] += wgi * t[e];
      }
    }
  } else {
    const size_t off = (n == 2) ? O_OC : O_OE;
    unpk8(*(const bf16x8*)((const bf16_t*)(ws + off) + (size_t)tok * 384 + c), o);
  }
#pragma unroll
  for (int e = 0; e < 8; ++e) o[e] *= z[e];
  *(bf16x8*)szp = pk8(o);
}

DI void p4a_tile(const Params& p, int layer, int mt, int nt, unsigned char* smem) {
  sub_sync();
  bf16_t* As = (bf16_t*)smem; bf16_t* Bs = As + 2 * 9216;
  const int tid = otid(), lane = tid & 63, wave = tid >> 6, wr = wave >> 1, wc = wave & 1, r = lane & 31, h = lane >> 5;
  const int m0 = mt * 128, n0 = nt * 128;
  f32x16 tot[2][2]; zero_acc(tot);
  const bf16_t* SIG = (const bf16_t*)(p.ws + O_SIG);
  for (int n = 0; n < 5; ++n) {
    f32x16 acc[2][2]; zero_acc(acc);
    PlainA al{(const bf16_t*)(p.ws + O_SZ) + n * 384, 1920};
    gemm_kloop_t<32>(al, (const bf16_t*)(p.ws + O_WTBR) + (size_t)(layer * 5 + n) * 1024 * 384, 384, 12, m0, n0, acc, As, Bs);
#pragma unroll
    for (int mi = 0; mi < 2; ++mi) {
      const int tok = m0 + wr * 64 + mi * 32 + r;
#pragma unroll
      for (int ni = 0; ni < 2; ++ni)
#pragma unroll
        for (int g = 0; g < 4; ++g) {
          const int col = n0 + wc * 64 + ni * 32 + 8 * g + 4 * h;
          const u32x2 sg = *(const u32x2*)(SIG + (size_t)tok * 5120 + n * 1024 + col);
          tot[mi][ni][4 * g] += bflo(sg.x) * acc[mi][ni][4 * g];
          tot[mi][ni][4 * g + 1] += bfhi(sg.x) * acc[mi][ni][4 * g + 1];
          tot[mi][ni][4 * g + 2] += bflo(sg.y) * acc[mi][ni][4 * g + 2];
          tot[mi][ni][4 * g + 3] += bfhi(sg.y) * acc[mi][ni][4 * g + 3];
          asm volatile("" ::: "memory");
        }
    }
  }
  bf16_t* YM = (bf16_t*)(p.ws + O_YM);
  {
    bf16_t* stg = (bf16_t*)smem + wave * (64 * 72);
#pragma unroll
    for (int ni = 0; ni < 2; ++ni)
#pragma unroll
      for (int mi = 0; mi < 2; ++mi)
#pragma unroll
        for (int g = 0; g < 4; ++g)
          *(u32x2*)(stg + (mi * 32 + r) * 72 + ni * 32 + 8 * g + 4 * h) = pk4(tot[mi][ni][4 * g], tot[mi][ni][4 * g + 1], tot[mi][ni][4 * g + 2], tot[mi][ni][4 * g + 3]);
    asm volatile("s_waitcnt lgkmcnt(0)" ::: "memory");
    __builtin_amdgcn_wave_barrier();
    const int tok0 = m0 + wr * 64, col0 = n0 + wc * 64;
#pragma unroll
    for (int it = 0; it < 8; ++it) {
      const int row = it * 8 + (lane >> 3), ch = (lane & 7) * 8;
      const bf16x8 val = *(const bf16x8*)(stg + row * 72 + ch);
      *(bf16x8*)(YM + (size_t)(tok0 + row) * 1024 + col0 + ch) = val;
    }
  }
}

DI void p4b_tile(const Params& p, int layer, int half, int mt, int nt, unsigned char* smem) {
  bf16_t* As = (bf16_t*)smem; bf16_t* Bs = As + 2 * 9216;
  const int tid = otid(), lane = tid & 63, wave = tid >> 6, wr = wave >> 1, wc = wave & 1, r = lane & 31, h = lane >> 5;
  const int m0 = mt * 128, n0 = nt * 128;
  f32x16 acc[2][2]; zero_acc(acc);
  PlainA al{(const bf16_t*)(p.ws + O_YM), 1024};
  gemm_kloop(al, (const bf16_t*)(p.ws + O_WTOUT + layer * SZ_WTOUT1), 1024, 16, m0, n0, acc, As, Bs);
  const float* xin = layer == 0 ? p.x : p.out;
  const float alpha = 1.4142135623730951f;
#pragma unroll
  for (int mi = 0; mi < 2; ++mi) {
    const size_t gt = (size_t)half * TH + m0 + wr * 64 + mi * 32 + r;
#pragma unroll
    for (int ni = 0; ni < 2; ++ni)
#pragma unroll
      for (int g = 0; g < 4; ++g) {
        const int col = n0 + wc * 64 + ni * 32 + 8 * g + 4 * h;
        const f32x4 xv = *(const f32x4*)(xin + gt * 1024 + col);
        f32x4 o;
#pragma unroll
        for (int e = 0; e < 4; ++e) o[e] = alpha * xv[e] + acc[mi][ni][4 * g + e];
        *(f32x4*)(p.out + gt * 1024 + col) = o;
      }
  }
}

DI void gemm8_kloop(const bf16_t* __restrict__ Ab, int lda, const bf16_t* __restrict__ Bb, int ldb, int nkt, f32x4 (&acc)[4][4], unsigned char* lds) {
  const int tid = rtid(), wid = tid >> 6, lane = tid & 63, wr = wid >> 1, wc = wid & 1, fr = lane & 15, fq = lane >> 4;
  int aOff[4], bOff[2];
#pragma unroll
  for (int i = 0; i < 4; ++i) { int R, C; g_stage_rc(wid * 1024 + i * 8192 + lane * 16, R, C); aOff[i] = R * lda + C; }
#pragma unroll
  for (int i = 0; i < 2; ++i) { int R, C; g_stage_rc(wid * 1024 + i * 8192 + lane * 16, R, C); bOff[i] = R * ldb + C; }
  auto stage = [&](int buf, int kt) {
#pragma unroll
    for (int i = 0; i < 4; ++i)
      __builtin_amdgcn_global_load_lds((const unsigned*)(Ab + aOff[i] + kt * 64), (unsigned*)(lds + buf * 49152 + wid * 1024 + i * 8192), 16, 0, 0);
#pragma unroll
    for (int i = 0; i < 2; ++i)
      __builtin_amdgcn_global_load_lds((const unsigned*)(Bb + bOff[i] + kt * 64), (unsigned*)(lds + buf * 49152 + 32768 + wid * 1024 + i * 8192), 16, 0, 0);
  };
  const int lane_off = (fr * 64 + fq * 16) ^ ((fr >> 3) << 5);
  __syncthreads();
  stage(0, 0);
  asm volatile("s_waitcnt vmcnt(0)" ::: "memory");
  __syncthreads();
#pragma unroll 1
  for (int t = 0; t < nkt; ++t) {
    const int cur = t & 1;
    if (t + 1 < nkt) stage(cur ^ 1, t + 1);
    const unsigned char* SA = lds + cur * 49152 + wr * 8192 + lane_off;
    const unsigned char* SB = lds + cur * 49152 + 32768 + wc * 8192 + lane_off;
#pragma unroll
    for (int ks = 0; ks < 2; ++ks) {
      bf16x8 At[4], Bf[4];
#pragma unroll
      for (int n = 0; n < 4; ++n) Bf[n] = *(const bf16x8*)(SB + n * 2048 + ks * 1024);
#pragma unroll
      for (int m = 0; m < 4; ++m) At[m] = *(const bf16x8*)(SA + m * 2048 + ks * 1024);
#pragma unroll
      for (int m = 0; m < 4; ++m)
#pragma unroll
        for (int n = 0; n < 4; ++n) acc[m][n] = MFMA16(Bf[n], At[m], acc[m][n]);
    }
    asm volatile("s_waitcnt vmcnt(0)" ::: "memory");
    __syncthreads();
  }
}

DI void p4a_unit(const Params& p, int layer, int pm, int pn, unsigned char* lds) {
  const int tid = rtid(), wid = tid >> 6, lane = tid & 63, wr = wid >> 1, wc = wid & 1, fr = lane & 15, fq = lane >> 4;
  const int tok0 = pm * 256 + wr * 64, col0 = pn * 128 + wc * 64;
  const bf16_t* SIG = (const bf16_t*)(p.ws + O_SIG);
  const bf16_t* Ab = (const bf16_t*)(p.ws + O_SZ) + (size_t)pm * 256 * 1920;
  const bf16_t* Bb = (const bf16_t*)(p.ws + O_WTBR) + (size_t)layer * 5 * 1024 * 384 + (size_t)pn * 128 * 384;
  int aOff[4], bOff[2];
#pragma unroll
  for (int i = 0; i < 4; ++i) { int R, C; g_stage_rc(wid * 1024 + i * 8192 + lane * 16, R, C); aOff[i] = R * 1920 + C; }
#pragma unroll
  for (int i = 0; i < 2; ++i) { int R, C; g_stage_rc(wid * 1024 + i * 8192 + lane * 16, R, C); bOff[i] = R * 384 + C; }
  auto stage = [&](int buf, int T) {
    const int nb = T / 6, kk = T - nb * 6;
    const long bo = (long)nb * (1024 * 384) + kk * 64;
#pragma unroll
    for (int i = 0; i < 4; ++i)
      __builtin_amdgcn_global_load_lds((const unsigned*)(Ab + aOff[i] + T * 64), (unsigned*)(lds + buf * 49152 + wid * 1024 + i * 8192), 16, 0, 0);
#pragma unroll
    for (int i = 0; i < 2; ++i)
      __builtin_amdgcn_global_load_lds((const unsigned*)(Bb + bOff[i] + bo), (unsigned*)(lds + buf * 49152 + 32768 + wid * 1024 + i * 8192), 16, 0, 0);
  };
  f32x4 tot[4][4], acc[4][4];
#pragma unroll
  for (int m = 0; m < 4; ++m)
#pragma unroll
    for (int n = 0; n < 4; ++n) { tot[m][n] = (f32x4){0.f, 0.f, 0.f, 0.f}; acc[m][n] = (f32x4){0.f, 0.f, 0.f, 0.f}; }
  const int lane_off = (fr * 64 + fq * 16) ^ ((fr >> 3) << 5);
  __syncthreads();
  stage(0, 0);
  asm volatile("s_waitcnt vmcnt(0)" ::: "memory");
  __syncthreads();
#pragma unroll 1
  for (int t = 0; t < 30; ++t) {
    const int cur = t & 1;
    if (t + 1 < 30) stage(cur ^ 1, t + 1);
    const unsigned char* SA = lds + cur * 49152 + wr * 8192 + lane_off;
    const unsigned char* SB = lds + cur * 49152 + 32768 + wc * 8192 + lane_off;
#pragma unroll
    for (int ks = 0; ks < 2; ++ks) {
      bf16x8 At[4], Bf[4];
#pragma unroll
      for (int n = 0; n < 4; ++n) Bf[n] = *(const bf16x8*)(SB + n * 2048 + ks * 1024);
#pragma unroll
      for (int m = 0; m < 4; ++m) At[m] = *(const bf16x8*)(SA + m * 2048 + ks * 1024);
#pragma unroll
      for (int m = 0; m < 4; ++m)
#pragma unroll
        for (int n = 0; n < 4; ++n) acc[m][n] = MFMA16(Bf[n], At[m], acc[m][n]);
    }
    const int nb = t / 6;
    if (t - nb * 6 == 5) {
#pragma unroll
      for (int m = 0; m < 4; ++m) {
        const int tok = tok0 + m * 16 + fr;
#pragma unroll
        for (int n = 0; n < 4; ++n) {
          const u32x2 sg = *(const u32x2*)(SIG + (size_t)tok * 5120 + nb * 1024 + col0 + n * 16 + fq * 4);
          tot[m][n][0] += bflo(sg.x) * acc[m][n][0]; tot[m][n][1] += bfhi(sg.x) * acc[m][n][1];
          tot[m][n][2] += bflo(sg.y) * acc[m][n][2]; tot[m][n][3] += bfhi(sg.y) * acc[m][n][3];
          acc[m][n] = (f32x4){0.f, 0.f, 0.f, 0.f};
        }
      }
    }
    asm volatile("s_waitcnt vmcnt(0)" ::: "memory");
    __syncthreads();
  }
  bf16_t* YM = (bf16_t*)(p.ws + O_YM);
  bf16_t* stg = (bf16_t*)(lds + wid * 9216);
#pragma unroll
  for (int m = 0; m < 4; ++m)
#pragma unroll
    for (int n = 0; n < 4; ++n) *(u32x2*)(stg + (m * 16 + fr) * 72 + n * 16 + fq * 4) = pk4(tot[m][n][0], tot[m][n][1], tot[m][n][2], tot[m][n][3]);
  asm volatile("s_waitcnt lgkmcnt(0)" ::: "memory");
  __builtin_amdgcn_wave_barrier();
#pragma unroll
  for (int it = 0; it < 8; ++it) {
    const int row = it * 8 + (lane >> 3), ch = (lane & 7) * 8;
    const bf16x8 val = *(const bf16x8*)(stg + row * 72 + ch);
    *(bf16x8*)(YM + (size_t)(tok0 + row) * 1024 + col0 + ch) = val;
  }
}

DI void p4b_unit(const Params& p, int layer, int half, int pm, int pn, unsigned char* lds) {
  const int tid = rtid(), wid = tid >> 6, lane = tid & 63, wr = wid >> 1, wc = wid & 1, fr = lane & 15, fq = lane >> 4;
  f32x4 acc[4][4];
#pragma unroll
  for (int m = 0; m < 4; ++m)
#pragma unroll
    for (int n = 0; n < 4; ++n) acc[m][n] = (f32x4){0.f, 0.f, 0.f, 0.f};
  gemm8_kloop((const bf16_t*)(p.ws + O_YM) + (size_t)pm * 256 * 1024, 1024,
              (const bf16_t*)(p.ws + O_WTOUT + layer * SZ_WTOUT1) + (size_t)pn * 128 * 1024, 1024, 16, acc, lds);
  const float* xin = layer == 0 ? p.x : p.out;
  const float alpha = 1.4142135623730951f;
#pragma unroll
  for (int m = 0; m < 4; ++m) {
    const size_t gt = (size_t)half * TH + pm * 256 + wr * 64 + m * 16 + fr;
#pragma unroll
    for (int n = 0; n < 4; ++n) {
      const int col = pn * 128 + wc * 64 + n * 16 + fq * 4;
      const f32x4 xv = *(const f32x4*)(xin + gt * 1024 + col);
      f32x4 o;
#pragma unroll
      for (int e = 0; e < 4; ++e) o[e] = alpha * xv[e] + acc[m][n][e];
      *(f32x4*)(p.out + gt * 1024 + col) = o;
    }
  }
}

DI void p4c_row(const Params& p, int layer, size_t gt, bool wxb = true) {
  const int lane = otid() & 63;
  float* row = p.out + gt * 1024;
  f32x4 v[4]; float s = 0.f;
#pragma unroll
  for (int j = 0; j < 4; ++j) { v[j] = *(const f32x4*)(row + 4 * lane + 256 * j); s += v[j][0] + v[j][1] + v[j][2] + v[j][3]; }
#pragma unroll
  for (int o = 32; o >= 1; o >>= 1) s += __shfl_xor(s, o);
  const float mu = s * (1.f / 1024.f); float q = 0.f;
#pragma unroll
  for (int j = 0; j < 4; ++j) { v[j] -= mu; q += v[j][0] * v[j][0] + v[j][1] * v[j][1] + v[j][2] * v[j][2] + v[j][3] * v[j][3]; }
#pragma unroll
  for (int o = 32; o >= 1; o >>= 1) q += __shfl_xor(q, o);
  const float rs = rsqrtf(q * (1.f / 1024.f) + 1e-5f);
  bf16_t* xb = (bf16_t*)(p.ws + O_XB) + gt * 1024;
#pragma unroll
  for (int j = 0; j < 4; ++j) {
    const int c = 4 * lane + 256 * j;
    const f32x4 g = *(const f32x4*)(p.ln_g + layer * 1024 + c), b = *(const f32x4*)(p.ln_b + layer * 1024 + c);
    f32x4 y;
#pragma unroll
    for (int e = 0; e < 4; ++e) y[e] = v[j][e] * rs * g[e] + b[e];
    *(f32x4*)(row + c) = y;
    if (wxb) *(u32x2*)(xb + c) = pk4(y[0], y[1], y[2], y[3]);
  }
}


#define XB_TMO      128
#define XB_XCNT(j)  (256  + 64 * (j))
#define XB_XSUB(j)  (1280 + 64 * (j))
#define XB_XGEN(j)  (2304 + 64 * (j))
#define XB_TOP      3328
#define XB_TOPGEN   3392
#define XB_SPIN_CAP (1u << 22)
#define LAS __attribute__((address_space(3)))
DI unsigned xb_ld(unsigned* p) { return __hip_atomic_load(p, __ATOMIC_RELAXED, __HIP_MEMORY_SCOPE_AGENT); }
DI unsigned xb_add(unsigned* p, unsigned v) { return __hip_atomic_fetch_add(p, v, __ATOMIC_RELAXED, __HIP_MEMORY_SCOPE_AGENT); }
DI unsigned xb_xcc_id() { return (unsigned)__builtin_amdgcn_s_getreg((3 << 11) | 20) & 0xFu; }
#define XB_SPIN(cond, bar) do { unsigned _sp = 0; while (cond) { __builtin_amdgcn_s_sleep(1); \
    if ((++_sp & 255u) == 0u) { if (xb_ld(&(bar)[XB_TMO])) break; if (_sp > XB_SPIN_CAP) { atomicAdd(&(bar)[XB_TMO], 1u); break; } } } } while (0)
struct XcdBarrier { unsigned* bar; unsigned x; volatile LAS unsigned* st; };
DI XcdBarrier xcd_barrier_post(unsigned* bar, volatile LAS unsigned* st) {
  XcdBarrier b; b.bar = bar; b.x = xb_xcc_id(); b.st = st;
  if (threadIdx.x == 0) (void)xb_add(&bar[XB_XCNT(b.x)], 1u);
  return b;
}
DI void xcd_barrier_complete(unsigned* bar, unsigned x, unsigned& nloc, unsigned& nx) {
  const unsigned G = gridDim.x;
  unsigned sum, cnt, mine, sp = 0u;
  for (;;) {
    sum = 0u; cnt = 0u; mine = 0u;
#pragma unroll
    for (unsigned j = 0; j < 16; ++j) { const unsigned c = xb_ld(&bar[XB_XCNT(j)]); sum += c; cnt += (c > 0u) ? 1u : 0u; mine = (j == x) ? c : mine; }
    if (sum == G) break;
    __builtin_amdgcn_s_sleep(1);
    if ((++sp & 255u) == 0u) { if (xb_ld(&bar[XB_TMO])) break; if (sp > XB_SPIN_CAP) { atomicAdd(&bar[XB_TMO], 1u); break; } }
  }
  nloc = mine > 0u ? mine : 1u; nx = cnt > 0u ? cnt : 1u;
}
DI void xcd_barrier(const XcdBarrier& b) {
  asm volatile("s_waitcnt vmcnt(0)" ::: "memory");
  __syncthreads();
  if (threadIdx.x == 0) {
    unsigned* bar = b.bar;
    __builtin_amdgcn_s_waitcnt(0);
    unsigned nloc = b.st[0], nx = b.st[1];
    if (nloc == 0u) { xcd_barrier_complete(bar, b.x, nloc, nx); b.st[0] = nloc; b.st[1] = nx; }
    const unsigned old = xb_add(&bar[XB_XSUB(b.x)], 1u);
    const unsigned gen = old / nloc;
    if (old + 1u == (gen + 1u) * nloc) {
      __builtin_amdgcn_fence(__ATOMIC_RELEASE, "agent");
      asm volatile("s_waitcnt vmcnt(0)" ::: "memory");
      const unsigned og = xb_add(&bar[XB_TOP], 1u);
      const unsigned tg = og / nx;
      if (og + 1u == (tg + 1u) * nx) xb_add(&bar[XB_TOPGEN], 1u);
      else XB_SPIN(xb_ld(&bar[XB_TOPGEN]) == tg, bar);
      __builtin_amdgcn_fence(__ATOMIC_ACQUIRE, "agent");
      xb_add(&bar[XB_XGEN(b.x)], 1u);
      asm volatile("s_waitcnt vmcnt(0)" ::: "memory");
    } else {
      XB_SPIN(xb_ld(&bar[XB_XGEN(b.x)]) == gen, bar);
      __builtin_amdgcn_fence(__ATOMIC_ACQUIRE, "agent");
      asm volatile("s_waitcnt vmcnt(0)" ::: "memory");
    }
  }
  __syncthreads();
}

#ifdef PROBE_A
#define STAMP(k) do { if (blockIdx.x == 0 && otid() == 0) { unsigned long long now_ = __builtin_amdgcn_s_memrealtime(); tsacc[k] += (float)(now_ - tlast) * 0.01f; tlast = now_; } } while (0)
#else
#define STAMP(k) do {} while (0)
#endif
__global__ void __launch_bounds__(512, 2) mega(Params p) {
  extern __shared__ __attribute__((aligned(16))) unsigned char smem_all[];
  cg::grid_group grid = cg::this_grid();
  if (p.ws == nullptr) grid.sync();
  volatile LAS unsigned* xbst = (volatile LAS unsigned*)(smem_all + 2 * SUB_LDS);
  if (threadIdx.x < 4) xbst[threadIdx.x] = 0u;
  __syncthreads();
  const XcdBarrier xb = xcd_barrier_post((unsigned*)(p.ws + O_BAR), xbst);
#define GSYNC() xcd_barrier(xb)
  const int sub = __builtin_amdgcn_readfirstlane(__builtin_amdgcn_workitem_id_x() >> 8);
  unsigned char* smem = smem_all + sub * SUB_LDS;
  const int vb = (int)blockIdx.x * 2 + sub, vgrid = (int)gridDim.x * 2;
  const int wave = otid() >> 6;
  const int gw = vb * 4 + wave, ngw = vgrid * 4;
  phase0(p, smem, vb, vgrid);
  GSYNC();
  int pend_layer = -1, pend_half = 0;
  for (int itn = 0; itn < 4; ++itn) {
    const int layer = itn >> 1, half = itn & 1;
    if (pend_layer >= 0) { for (int rw = gw; rw < TH; rw += ngw) p4c_row(p, pend_layer, (size_t)pend_half * TH + rw, true); pend_layer = -1; }
    for (int t = (int)blockIdx.x; t < 32 * 54; t += (int)gridDim.x) {
      const int tn = t + (int)gridDim.x;
      p1_unit(p, layer, half, t & 31, t >> 5, tn < 32 * 54 ? (tn & 31) : 0, tn < 32 * 54 ? (tn >> 5) : -1, t == (int)blockIdx.x, smem_all);
    }
    GSYNC();
    {
      constexpr int N_FOX = 6, N_GDN = 768, N_MKV = 12, N_KM = 48, TOT = N_FOX + N_GDN + N_MKV + N_KM;
      for (int t = vb; t < TOT; t += vgrid) {
        int i = t;
        if (i < N_FOX) { fox_prep(p, i, smem); continue; }
        i -= N_FOX;
        if (i < N_GDN) { gdn_prep(p, layer, half, i / 128, i % 128, smem); continue; }
        i -= N_GDN;
        if (i < N_MKV) { memkv_tile(p, layer, half, i / 6, i % 6, smem); continue; }
        i -= N_MKV;
        kmean_prep(p, i * 4 + wave, (unsigned*)(p.ws + O_CTL) + 64 + (layer * 2 + half) * 8);
      }
    }
    for (int a = gw; a < 1536; a += ngw) moba_select(p, a);
    GSYNC();
    phase3(p, half, (unsigned*)(p.ws + O_CTL) + layer * 2 + half, (const unsigned*)(p.ws + O_CTL) + 64 + (layer * 2 + half) * 8, smem, sub);
    GSYNC();
    for (int ci = vb * 256 + otid(); ci < TH * 240; ci += vgrid * 256) gbuild_chunk(p, layer, ci / 240, ci % 240);
    GSYNC();
    for (int t = (int)blockIdx.x; t < 256; t += (int)gridDim.x) p4a_unit(p, layer, t & 31, t >> 5, smem_all);
    GSYNC();
    for (int t = (int)blockIdx.x; t < 256; t += (int)gridDim.x) p4b_unit(p, layer, half, t & 31, t >> 5, smem_all);
    GSYNC();
    pend_layer = layer; pend_half = half;
  }
  if (pend_layer >= 0) { for (int rw = gw; rw < TH; rw += ngw) p4c_row(p, pend_layer, (size_t)pend_half * TH + rw, true); }
}

extern "C" void kernel_launch(void* const* d_in, const int* in_sizes, int n_in, void* d_out, int out_size, void* d_ws, size_t ws_size,
                              hipStream_t stream) {
  static int grid_blocks = 0;
  if (grid_blocks == 0) {
    if (ws_size < WS_END) { fprintf(stderr, "workspace too small: %zu < %zu\n", ws_size, (size_t)WS_END); grid_blocks = -1; return; }
    int dev = 0, cus = 0, per_cu = 0;
    (void)hipGetDevice(&dev);
    (void)hipDeviceGetAttribute(&cus, hipDeviceAttributeMultiprocessorCount, dev);
    (void)hipFuncSetAttribute((const void*)mega, hipFuncAttributeMaxDynamicSharedMemorySize, LDS_BYTES);
    (void)hipOccupancyMaxActiveBlocksPerMultiprocessor(&per_cu, (const void*)mega, 512, LDS_BYTES);
    if (per_cu < 1) per_cu = 1;
    if (per_cu > 1) per_cu = 1;
    grid_blocks = cus * per_cu;
  }
  if (grid_blocks < 0) return;
  (void)hipMemsetAsync((char*)d_ws + O_CTL, 0, 32768, stream);
  Params p{};
  p.x = (const float*)d_in[0]; p.mem = (const float*)d_in[1]; p.mem_g = (const float*)d_in[2]; p.mem_b = (const float*)d_in[3];
  p.w_in = (const float*)d_in[4]; p.b_in = (const float*)d_in[5]; p.conv_w = (const float*)d_in[6]; p.a_log = (const float*)d_in[7];
  p.dt_bias = (const float*)d_in[8]; p.gdn_w = (const float*)d_in[9]; p.w_kv = (const float*)d_in[10]; p.w_br = (const float*)d_in[11];
  p.w_out = (const float*)d_in[12]; p.ln_g = (const float*)d_in[13]; p.ln_b = (const float*)d_in[14];
  p.out = (float*)d_out; p.ws = (unsigned char*)d_ws;
  void* args[] = {&p};
  hipError_t e = hipLaunchCooperativeKernel((const void*)mega, dim3(grid_blocks), dim3(512), args, LDS_BYTES, stream);
  if (e != hipSuccess) fprintf(stderr, "cooperative launch failed: %s (grid %d)\n", hipGetErrorString(e), grid_blocks);
}
```

```cpp
#include <hip/hip_runtime.h>
#include <hip/hip_cooperative_groups.h>
#include <cstdio>
#include <cstdint>
namespace cg = cooperative_groups;

#define DI __device__ __forceinline__
typedef unsigned short bf16_t;
typedef short bf16x8 __attribute__((ext_vector_type(8)));
typedef short s16x4 __attribute__((ext_vector_type(4)));
typedef float f32x4 __attribute__((ext_vector_type(4)));
typedef float f32x2 __attribute__((ext_vector_type(2)));
typedef float f32x16 __attribute__((ext_vector_type(16)));
typedef unsigned u32x2 __attribute__((ext_vector_type(2)));
typedef unsigned u32x4 __attribute__((ext_vector_type(4)));
typedef __bf16 bfv2 __attribute__((ext_vector_type(2)));

#define MFMA32(a, b, c) __builtin_amdgcn_mfma_f32_32x32x16_bf16((a), (b), (c), 0, 0, 0)
#define MFMA16(a, b, c) __builtin_amdgcn_mfma_f32_16x16x32_bf16((a), (b), (c), 0, 0, 0)

DI unsigned pk2(float a, float b) { f32x2 v = {a, b}; return __builtin_bit_cast(unsigned, __builtin_convertvector(v, bfv2)); }
DI bf16_t f2bf(float a) { return (bf16_t)(pk2(a, 0.f) & 0xffffu); }
DI float bf2f(bf16_t v) { return __uint_as_float(((unsigned)v) << 16); }
DI float bflo(unsigned u) { return __uint_as_float(u << 16); }
DI float bfhi(unsigned u) { return __uint_as_float(u & 0xffff0000u); }
DI int rtid() { int t = __builtin_amdgcn_workitem_id_x(); asm volatile("" : "+v"(t)); return t; }
DI int otid() { return rtid() & 255; }
extern __shared__ __attribute__((aligned(16))) unsigned char g_lds_all[];
#define LAS3 __attribute__((address_space(3)))
DI void sub_sync() {
  asm volatile("s_waitcnt lgkmcnt(0)" ::: "memory");
  const int t = __builtin_amdgcn_workitem_id_x();
  LAS3 unsigned* c = (LAS3 unsigned*)(g_lds_all + 2 * 75776 + 8) + (t >> 8);
  if ((t & 63) == 0) {
    const unsigned old = __hip_atomic_fetch_add(c, 1u, __ATOMIC_RELAXED, __HIP_MEMORY_SCOPE_WORKGROUP);
    const unsigned target = (old / 4u + 1u) * 4u;
    while (__hip_atomic_load(c, __ATOMIC_RELAXED, __HIP_MEMORY_SCOPE_WORKGROUP) < target) __builtin_amdgcn_s_sleep(1);
  }
  asm volatile("s_waitcnt lgkmcnt(0)" ::: "memory");
}
DI int crow(int i, int h) { return (i & 3) + 8 * (i >> 2) + 4 * h; }
DI float fsigmoid(float v) { return __builtin_amdgcn_rcpf(1.f + __expf(-v)); }
DI float fsilu(float v) { return v * fsigmoid(v); }
DI u32x2 pk4(float a, float b, float c, float d) { u32x2 r; r.x = pk2(a, b); r.y = pk2(c, d); return r; }
DI bf16x8 pk8(const float* v) { u32x4 r; r.x = pk2(v[0], v[1]); r.y = pk2(v[2], v[3]); r.z = pk2(v[4], v[5]); r.w = pk2(v[6], v[7]); return __builtin_bit_cast(bf16x8, r); }
DI void unpk8(bf16x8 x, float* v) { u32x4 u = __builtin_bit_cast(u32x4, x); v[0] = bflo(u.x); v[1] = bfhi(u.x); v[2] = bflo(u.y); v[3] = bfhi(u.y); v[4] = bflo(u.z); v[5] = bfhi(u.z); v[6] = bflo(u.w); v[7] = bfhi(u.w); }

constexpr int NB = 2, SQ = 8192, NT = NB * SQ, DM = 1024, NH = 6, BW = 384;
constexpr int TH = 8192;
constexpr int NP = 13824;
constexpr int DIN = 13586;
constexpr float LOG2E = 1.4426950408889634f;
#define NEG_INF (-__builtin_inff())

constexpr int C_AQK = 0, C_AV = 768, C_BQK = 1152, C_BV = 3456, C_CQK = 3840, C_CV = 4608, C_D = 4992, C_E = 6144, C_SM = 6528, C_SMEND = 6546, C_Z = 6656, C_MG = 8576;

__host__ __device__ constexpr int inmap(int n) {
  return n < 4992 ? n : n < 6144 ? n + 6 : n < 6528 ? n + 18 : n < 6534 ? n - 1536 : n < 6546 ? n - 384 : n < 6656 ? -1 : n < 13696 ? n - 110 : -1;
}

constexpr size_t O_CTL = 0;
constexpr size_t O_BAR = 4096;
constexpr size_t O_WTIN = 32768;
constexpr size_t SZ_WTIN1 = (size_t)NP * 1024 * 2;
constexpr size_t O_WTBR = O_WTIN + 2 * SZ_WTIN1;
constexpr size_t SZ_WTBR1 = (size_t)5 * 1024 * 384 * 2;
constexpr size_t O_WTOUT = O_WTBR + 2 * SZ_WTBR1;
constexpr size_t SZ_WTOUT1 = (size_t)1024 * 1024 * 2;
constexpr size_t O_WTKV = O_WTOUT + 2 * SZ_WTOUT1;
constexpr size_t SZ_WTKV1 = (size_t)768 * 1024 * 2;
constexpr size_t O_BIASP = O_WTKV + 2 * SZ_WTKV1;
constexpr size_t O_XB = O_BIASP + (size_t)2 * NP * 4;
constexpr size_t O_MEMN = O_XB + (size_t)NT * 1024 * 2;
constexpr size_t O_MEMK = O_MEMN + (size_t)512 * 1024 * 2;
constexpr size_t O_MEMVT = O_MEMK + (size_t)512 * 384 * 2;
constexpr size_t O_QKA = O_MEMVT + (size_t)512 * 384 * 2;
constexpr size_t SZ_VT = (size_t)384 * TH * 2;
constexpr size_t O_KFA = O_QKA + SZ_VT;
constexpr size_t O_VTA = O_KFA + SZ_VT;
constexpr size_t O_QKB = O_VTA + SZ_VT;
constexpr size_t O_KFB = O_QKB + 3 * SZ_VT;
constexpr size_t O_VTB = O_KFB + 3 * SZ_VT;
constexpr size_t O_QKC = O_VTB + 3 * SZ_VT;
constexpr size_t O_KFC = O_QKC + SZ_VT;
constexpr size_t O_VTC = O_KFC + SZ_VT;
constexpr size_t O_QKVD = O_VTC + SZ_VT;
constexpr size_t O_QE = O_QKVD + (size_t)TH * 1152 * 2;
constexpr size_t O_SM = O_QE + (size_t)TH * 384 * 2;
constexpr size_t O_FF = O_SM + (size_t)TH * 32 * 4;
constexpr size_t O_KM = O_FF + (size_t)6 * TH * 4;
constexpr size_t O_KMAX = O_KM + (size_t)2 * 6 * 32 * 64 * 2;
constexpr size_t O_GL = O_KMAX + 256;
constexpr size_t O_MASK = O_GL + 6 * 128 * 4;
constexpr size_t O_KSUM = O_MASK + (size_t)TH * 8 * 4;
constexpr size_t O_DPREP = O_KSUM + (size_t)32 * 2 * 384 * 4;
constexpr size_t O_SZ = O_DPREP + (size_t)768 * 32768;
constexpr size_t O_SIG = O_SZ + (size_t)TH * 1920 * 2;
constexpr size_t O_OA = O_SIG + (size_t)TH * 5120 * 2;
constexpr size_t SZ_O = (size_t)TH * 384 * 2;
constexpr size_t O_STA = O_OA + 4 * SZ_O;
constexpr size_t O_OB = O_STA + (size_t)4 * TH * 6 * 2 * 4;
constexpr size_t O_STB = O_OB + 3 * SZ_O;
constexpr size_t O_OC = O_STB + (size_t)3 * TH * 6 * 2 * 4;
constexpr size_t O_OD = O_OC + SZ_O;
constexpr size_t O_SSQ = O_OD + SZ_O;
constexpr size_t O_OE = O_SSQ + (size_t)TH * 6 * 4 * 4;
constexpr size_t WS_END = O_OE + SZ_O;
constexpr size_t O_YM = O_QKB;
static_assert(WS_END < (size_t)443 * 1000 * 1000, "workspace too large");

struct Params {
  const float *x, *mem, *mem_g, *mem_b, *w_in, *b_in, *conv_w, *a_log, *dt_bias, *gdn_w, *w_kv, *w_br, *w_out, *ln_g, *ln_b;
  float* out;
  unsigned char* ws;
};

constexpr int SUB_LDS = 75776;
constexpr int LDS_BYTES = 2 * SUB_LDS + 16;
#ifndef PH_MASK
#define PH_MASK 0xFFFF
#endif
#define PH(x) ((PH_MASK >> (x)) & 1)
#ifndef REP_MASK
#define REP_MASK 0
#endif
#define REP(x) (1 + ((REP_MASK >> (x)) & 1))

DI void transpose_tile(const float* __restrict__ src, int ld, int k0, int n0, bool usemap, bf16_t* __restrict__ dst, int dstld, float* tile) {
  const int tid = otid();
#pragma unroll
  for (int it = 0; it < 16; ++it) {
    const int kk = (tid >> 6) + 4 * it, n2 = (tid & 63) * 2;
    const int sc = usemap ? inmap(n0 + n2) : (n0 + n2);
    f32x2 v = {0.f, 0.f};
    if (sc >= 0) v = *(const f32x2*)(src + (size_t)(k0 + kk) * ld + sc);
    *(f32x2*)(tile + kk * 130 + n2) = v;
  }
  sub_sync();
#pragma unroll
  for (int it = 0; it < 4; ++it) {
    const int nn = (tid >> 3) + 32 * it, kc = (tid & 7) * 8;
    float v[8];
#pragma unroll
    for (int e = 0; e < 8; ++e) v[e] = tile[(kc + e) * 130 + nn];
    *(bf16x8*)(dst + (size_t)(n0 + nn) * dstld + k0 + kc) = pk8(v);
  }
  sub_sync();
}

DI void transpose_in_pair(const Params& p, int iA, int iB, float* tile) {
  const int tid = otid();
  const float* srcA; const float* srcB; bf16_t* dstA; bf16_t* dstB; int k0A, n0A, k0B, n0B;
  { const int l = iA / (108 * 16), rr = iA % (108 * 16); srcA = p.w_in + (size_t)l * 1024 * DIN; dstA = (bf16_t*)(p.ws + O_WTIN + l * SZ_WTIN1); n0A = (rr / 16) * 128; k0A = (rr % 16) * 64; }
  const bool hasB = iB >= 0;
  { const int i = hasB ? iB : iA; const int l = i / (108 * 16), rr = i % (108 * 16); srcB = p.w_in + (size_t)l * 1024 * DIN; dstB = (bf16_t*)(p.ws + O_WTIN + l * SZ_WTIN1); n0B = (rr / 16) * 128; k0B = (rr % 16) * 64; }
  float* tileB = tile + 64 * 130;
  f32x2 va[16], vb2[16];
#pragma unroll
  for (int it = 0; it < 16; ++it) {
    const int kk = (tid >> 6) + 4 * it, n2 = (tid & 63) * 2;
    const int scA = inmap(n0A + n2), scB = inmap(n0B + n2);
    va[it] = (f32x2){0.f, 0.f}; vb2[it] = (f32x2){0.f, 0.f};
    if (scA >= 0) va[it] = *(const f32x2*)(srcA + (size_t)(k0A + kk) * DIN + scA);
    if (scB >= 0) vb2[it] = *(const f32x2*)(srcB + (size_t)(k0B + kk) * DIN + scB);
  }
#pragma unroll
  for (int it = 0; it < 16; ++it) {
    const int kk = (tid >> 6) + 4 * it, n2 = (tid & 63) * 2;
    *(f32x2*)(tile + kk * 130 + n2) = va[it];
    *(f32x2*)(tileB + kk * 130 + n2) = vb2[it];
  }
  sub_sync();
#pragma unroll
  for (int it = 0; it < 4; ++it) {
    const int nn = (tid >> 3) + 32 * it, kc = (tid & 7) * 8;
    float v[8], w[8];
#pragma unroll
    for (int e = 0; e < 8; ++e) { v[e] = tile[(kc + e) * 130 + nn]; w[e] = tileB[(kc + e) * 130 + nn]; }
    *(bf16x8*)(dstA + (size_t)(n0A + nn) * 1024 + k0A + kc) = pk8(v);
    if (hasB) *(bf16x8*)(dstB + (size_t)(n0B + nn) * 1024 + k0B + kc) = pk8(w);
  }
  sub_sync();
}

DI void phase0(const Params& p, unsigned char* smem, int vb, int vgrid) {
  float* tile = (float*)smem;
  const int tid = otid(), lane = tid & 63, wave = tid >> 6;
  constexpr int N_TIN = 2 * 108 * 16, N_TBR = 2 * 5 * 8 * 6, N_TOUT = 2 * 8 * 16, N_TKV = 2 * 6 * 16, N_XB = 1024, N_MEMN = 128, N_BIAS = 108;
  constexpr int TOT = N_TIN + N_TBR + N_TOUT + N_TKV + N_XB + N_MEMN + N_BIAS;
  for (int it = vb; it < N_TIN; it += 2 * vgrid) transpose_in_pair(p, it, it + vgrid < N_TIN ? it + vgrid : -1, tile);
  for (int it = vb; it < TOT - N_TIN; it += vgrid) {
    int i = it;
    if (i < N_TBR) {
      const int ln = i / 48, rr = i % 48, nt = rr / 6, kt = rr % 6;
      transpose_tile(p.w_br + (size_t)ln * 384 * 1024, 1024, kt * 64, nt * 128, false, (bf16_t*)(p.ws + O_WTBR) + (size_t)ln * 1024 * 384, 384, tile);
      continue;
    }
    i -= N_TBR;
    if (i < N_TOUT) {
      const int l = i / 128, rr = i % 128, nt = rr / 16, kt = rr % 16;
      transpose_tile(p.w_out + (size_t)l * 1024 * 1024, 1024, kt * 64, nt * 128, false, (bf16_t*)(p.ws + O_WTOUT + l * SZ_WTOUT1), 1024, tile);
      continue;
    }
    i -= N_TOUT;
    if (i < N_TKV) {
      const int l = i / 96, rr = i % 96, nt = rr / 16, kt = rr % 16;
      transpose_tile(p.w_kv + (size_t)l * 1024 * 768, 768, kt * 64, nt * 128, false, (bf16_t*)(p.ws + O_WTKV + l * SZ_WTKV1), 1024, tile);
      continue;
    }
    i -= N_TKV;
    if (i < N_XB) {
      const float* src = p.x + (size_t)i * 16 * 1024;
      bf16_t* dst = (bf16_t*)(p.ws + O_XB) + (size_t)i * 16 * 1024;
#pragma unroll
      for (int j = 0; j < 16; ++j) {
        const int e = (j * 256 + tid) * 4;
        const f32x4 v = *(const f32x4*)(src + e);
        *(u32x2*)(dst + e) = pk4(v[0], v[1], v[2], v[3]);
      }
      continue;
    }
    i -= N_XB;
    if (i < N_MEMN) {
      const int row = i * 4 + wave;
      const float* src = p.mem + (size_t)row * 1024;
      f32x4 v[4]; float s = 0.f;
#pragma unroll
      for (int j = 0; j < 4; ++j) { v[j] = *(const f32x4*)(src + 4 * lane + 256 * j); s += v[j][0] + v[j][1] + v[j][2] + v[j][3]; }
#pragma unroll
      for (int o = 32; o >= 1; o >>= 1) s += __shfl_xor(s, o);
      const float mu = s * (1.f / 1024.f); float q = 0.f;
#pragma unroll
      for (int j = 0; j < 4; ++j) { v[j] -= mu; q += v[j][0] * v[j][0] + v[j][1] * v[j][1] + v[j][2] * v[j][2] + v[j][3] * v[j][3]; }
#pragma unroll
      for (int o = 32; o >= 1; o >>= 1) q += __shfl_xor(q, o);
      const float rs = rsqrtf(q * (1.f / 1024.f) + 1e-5f);
      bf16_t* dst = (bf16_t*)(p.ws + O_MEMN) + (size_t)row * 1024;
#pragma unroll
      for (int j = 0; j < 4; ++j) {
        const int c = 4 * lane + 256 * j;
        const f32x4 g = *(const f32x4*)(p.mem_g + c), b = *(const f32x4*)(p.mem_b + c);
        *(u32x2*)(dst + c) = pk4(v[j][0] * rs * g[0] + b[0], v[j][1] * rs * g[1] + b[1], v[j][2] * rs * g[2] + b[2], v[j][3] * rs * g[3] + b[3]);
      }
      continue;
    }
    i -= N_MEMN;
    {
      float* bp = (float*)(p.ws + O_BIASP);
      if (tid < 128) {
        const int n = i * 128 + tid;
        const int sc = inmap(n);
        for (int l = 0; l < 2; ++l) bp[l * NP + n] = sc >= 0 ? p.b_in[l * DIN + sc] : 0.f;
      }
    }
  }
}

template <int BK, class AL>
DI void gemm_kloop_t(const AL& al, const bf16_t* __restrict__ Bt, int ldb, int nkt, int m0, int n0, f32x16 (&acc)[2][2], bf16_t* As, bf16_t* Bs) {
  constexpr int CPR = BK / 8, NCH = BK / 16, PITCH = BK + 8, BUF = 128 * PITCH;
  const int tid = otid(), lane = tid & 63, wave = tid >> 6, wr = wave >> 1, wc = wave & 1, r = lane & 31, h = lane >> 5;
  bf16x8 ra[NCH], rb[NCH];
  auto gload = [&](int kt) {
#pragma unroll
    for (int i = 0; i < NCH; ++i) {
      const int cid = tid + 256 * i, row = cid / CPR, kc = (cid % CPR) * 8;
      ra[i] = al(m0 + row, kt * BK + kc);
      rb[i] = *(const bf16x8*)(Bt + (size_t)(n0 + row) * ldb + kt * BK + kc);
    }
  };
  auto lstore = [&](int buf) {
#pragma unroll
    for (int i = 0; i < NCH; ++i) {
      const int cid = tid + 256 * i, row = cid / CPR, kc = (cid % CPR) * 8;
      *(bf16x8*)(As + buf * BUF + row * PITCH + kc) = ra[i];
      *(bf16x8*)(Bs + buf * BUF + row * PITCH + kc) = rb[i];
    }
  };
  gload(0); lstore(0); sub_sync();
  for (int kt = 0; kt < nkt; ++kt) {
    const int buf = kt & 1;
    if (kt + 1 < nkt) gload(kt + 1);
    asm volatile("" ::: "memory");
    const bf16_t* a_ = As + buf * BUF + (wr * 64 + r) * PITCH + 8 * h;
    const bf16_t* b_ = Bs + buf * BUF + (wc * 64 + r) * PITCH + 8 * h;
#pragma unroll
    for (int s = 0; s < BK / 16; ++s) {
      bf16x8 af[2], bfr[2];
      af[0] = *(const bf16x8*)(a_ + 16 * s); af[1] = *(const bf16x8*)(a_ + 32 * PITCH + 16 * s);
      bfr[0] = *(const bf16x8*)(b_ + 16 * s); bfr[1] = *(const bf16x8*)(b_ + 32 * PITCH + 16 * s);
#pragma unroll
      for (int mi = 0; mi < 2; ++mi)
#pragma unroll
        for (int ni = 0; ni < 2; ++ni) acc[mi][ni] = MFMA32(bfr[ni], af[mi], acc[mi][ni]);
    }
    if (kt + 1 < nkt) lstore(buf ^ 1);
    sub_sync();
  }
}
template <class AL>
DI void gemm_kloop(const AL& al, const bf16_t* __restrict__ Bt, int ldb, int nkt, int m0, int n0, f32x16 (&acc)[2][2], bf16_t* As, bf16_t* Bs) {
  gemm_kloop_t<64>(al, Bt, ldb, nkt, m0, n0, acc, As, Bs);
}

DI void zero_acc(f32x16 (&acc)[2][2]) {
#pragma unroll
  for (int a = 0; a < 2; ++a)
#pragma unroll
    for (int b = 0; b < 2; ++b)
#pragma unroll
      for (int i = 0; i < 16; ++i) acc[a][b][i] = 0.f;
}

DI int vfrag_key(int key) { const int kk = key & 31; return (key >> 5) * 2048 + (kk >> 4) * 512 + ((kk >> 2) & 1) * 256 + ((kk >> 3) & 1) * 4 + (kk & 3); }
DI int vfrag_col(int cw) { const int d = cw & 63; return (cw >> 6) * 524288 + (d >> 5) * 1024 + (d & 31) * 8; }

DI int kfrag_key(int key) { return (key >> 5) * 2048 + (key & 31) * 8; }
DI int kfrag_col(int cw) { const int d = cw & 63; return (cw >> 6) * 524288 + (d >> 4) * 512 + ((d >> 3) & 1) * 256 + (d & 7); }

struct PlainA {
  const bf16_t* A; int lda;
  DI bf16x8 operator()(int row, int k) const { return *(const bf16x8*)(A + (size_t)row * lda + k); }
};

DI void p1_tile(const Params& p, int layer, int half, int mt, int nt, unsigned char* smem) {
  sub_sync();
  bf16_t* As = (bf16_t*)smem; bf16_t* Bs = As + 2 * 9216;
  f32x16 acc[2][2]; zero_acc(acc);
  PlainA al{(const bf16_t*)(p.ws + O_XB) + (size_t)half * TH * 1024, 1024};
  const int m0 = mt * 128, n0 = nt * 128;
  gemm_kloop(al, (const bf16_t*)(p.ws + O_WTIN + layer * SZ_WTIN1), 1024, 16, m0, n0, acc, As, Bs);
  const int tid = otid(), lane = tid & 63, wave = tid >> 6, wr = wave >> 1, wc = wave & 1, r = lane & 31, h = lane >> 5;
  const float* bias = (const float*)(p.ws + O_BIASP) + layer * NP;
  unsigned char* ws = p.ws;
  {
    const int nb0 = n0 + wc * 64;
    bf16_t* dst0 = nullptr; int pitch0 = 0, coff0 = 0, xf0 = 0;
    if (nb0 < 384) { dst0 = (bf16_t*)(ws + O_QKA); pitch0 = 384; coff0 = nb0; }
    else if (nb0 >= C_BQK && nb0 < 2304) { dst0 = (bf16_t*)(ws + O_QKB); pitch0 = 1152; coff0 = nb0 - C_BQK; }
    else if (nb0 >= C_CQK && nb0 < 4224) { dst0 = (bf16_t*)(ws + O_QKC); pitch0 = 384; coff0 = nb0 - C_CQK; }
    else if (nb0 >= C_D && nb0 < C_E) { dst0 = (bf16_t*)(ws + O_QKVD); pitch0 = 1152; coff0 = nb0 - C_D; }
    else if (nb0 >= C_E && nb0 < C_SM) { dst0 = (bf16_t*)(ws + O_QE); pitch0 = 384; coff0 = nb0 - C_E; }
    else if (nb0 >= C_Z && nb0 < C_MG) { dst0 = (bf16_t*)(ws + O_SZ); pitch0 = 1920; coff0 = nb0 - C_Z; xf0 = 1; }
    else if (nb0 >= C_MG) { dst0 = (bf16_t*)(ws + O_SIG); pitch0 = 5120; coff0 = nb0 - C_MG; xf0 = 2; }
    if (dst0 != nullptr) {
      bf16_t* stg = (bf16_t*)smem + wave * (64 * 72);
#pragma unroll
      for (int ni = 0; ni < 2; ++ni)
#pragma unroll
        for (int mi = 0; mi < 2; ++mi)
#pragma unroll
          for (int g = 0; g < 4; ++g) {
            const int cq = ni * 32 + 8 * g + 4 * h;
            const f32x4 bv = *(const f32x4*)(bias + nb0 + cq);
            float v[4];
#pragma unroll
            for (int e = 0; e < 4; ++e) v[e] = acc[mi][ni][4 * g + e] + bv[e];
            if (xf0 == 1) {
#pragma unroll
              for (int e = 0; e < 4; ++e) v[e] = fsilu(v[e]);
            } else if (xf0 == 2) {
#pragma unroll
              for (int e = 0; e < 4; ++e) v[e] = fsigmoid(v[e]);
            }
            *(u32x2*)(stg + (mi * 32 + r) * 72 + cq) = pk4(v[0], v[1], v[2], v[3]);
          }
      asm volatile("s_waitcnt lgkmcnt(0)" ::: "memory");
      __builtin_amdgcn_wave_barrier();
      const int tok0 = m0 + wr * 64;
#pragma unroll
      for (int it = 0; it < 8; ++it) {
        const int row = it * 8 + (lane >> 3), ch = (lane & 7) * 8;
        const bf16x8 val = *(const bf16x8*)(stg + row * 72 + ch);
        *(bf16x8*)(dst0 + (size_t)(tok0 + row) * pitch0 + coff0 + ch) = val;
      }
      return;
    }
  }
#pragma unroll
  for (int ni = 0; ni < 2; ++ni) {
    const int nb = n0 + wc * 64 + ni * 32;
    int kind;
    int xf = 0;
    bf16_t* dst = nullptr; int pitch = 0, coff = 0;
    int kgrp = 0;
    if (nb < 384) { kind = 0; dst = (bf16_t*)(ws + O_QKA); pitch = 384; coff = nb; }
    else if (nb < C_AV) { kind = 5; dst = (bf16_t*)(ws + O_KFA); coff = nb - 384; }
    else if (nb < C_BQK) { kind = 1; dst = (bf16_t*)(ws + O_VTA); coff = nb - C_AV; }
    else if (nb < 2304) { kind = 0; dst = (bf16_t*)(ws + O_QKB); pitch = 1152; coff = nb - C_BQK; }
    else if (nb < C_BV) { kind = 5; kgrp = (nb - 2304) / 384; dst = (bf16_t*)(ws + O_KFB + kgrp * SZ_VT); coff = (nb - 2304) - kgrp * 384; }
    else if (nb < C_CQK) { kind = 2; dst = (bf16_t*)(ws + O_VTB); coff = nb - C_BV; }
    else if (nb < 4224) { kind = 0; dst = (bf16_t*)(ws + O_QKC); pitch = 384; coff = nb - C_CQK; }
    else if (nb < C_CV) { kind = 5; dst = (bf16_t*)(ws + O_KFC); coff = nb - 4224; }
    else if (nb < C_D) { kind = 1; dst = (bf16_t*)(ws + O_VTC); coff = nb - C_CV; }
    else if (nb < C_E) { kind = 0; dst = (bf16_t*)(ws + O_QKVD); pitch = 1152; coff = nb - C_D; }
    else if (nb < C_SM) { kind = 0; dst = (bf16_t*)(ws + O_QE); pitch = 384; coff = nb - C_E; }
    else if (nb < C_Z) { kind = (nb == C_SM) ? 3 : 4; }
    else if (nb < C_MG) { kind = 0; xf = 1; dst = (bf16_t*)(ws + O_SZ); pitch = 1920; coff = nb - C_Z; }
    else { kind = 0; xf = 2; dst = (bf16_t*)(ws + O_SIG); pitch = 5120; coff = nb - C_MG; }
    if (kind == 4) continue;
#pragma unroll
    for (int mi = 0; mi < 2; ++mi) {
      const int tok = m0 + wr * 64 + mi * 32 + r;
#pragma unroll
      for (int g = 0; g < 4; ++g) {
        const int cq = 8 * g + 4 * h;
        const f32x4 bv = *(const f32x4*)(bias + nb + cq);
        float v[4];
#pragma unroll
        for (int e = 0; e < 4; ++e) v[e] = acc[mi][ni][4 * g + e] + bv[e];
        if (kind == 0) {
          if (xf == 1) {
#pragma unroll
            for (int e = 0; e < 4; ++e) v[e] = fsilu(v[e]);
          } else if (xf == 2) {
#pragma unroll
            for (int e = 0; e < 4; ++e) v[e] = fsigmoid(v[e]);
          }
          *(u32x2*)(dst + (size_t)tok * pitch + coff + cq) = pk4(v[0], v[1], v[2], v[3]);
        } else if (kind == 5) {
          const int key = kgrp == 0 ? tok : kgrp == 1 ? (tok & 3) * 2048 + (tok >> 2) : (tok & 15) * 512 + (tok >> 4);
          *(u32x2*)(dst + kfrag_col(coff + cq) + kfrag_key(key)) = pk4(v[0], v[1], v[2], v[3]);
        } else if (kind == 1) {
          const int ko = vfrag_key(tok);
#pragma unroll
          for (int e = 0; e < 4; ++e) dst[vfrag_col(coff + cq + e) + ko] = f2bf(v[e]);
        } else if (kind == 2) {
          const int k1 = vfrag_key(tok), k4 = vfrag_key((tok & 3) * 2048 + (tok >> 2)), k16 = vfrag_key((tok & 15) * 512 + (tok >> 4));
#pragma unroll
          for (int e = 0; e < 4; ++e) {
            const bf16_t b = f2bf(v[e]); const int co = vfrag_col(coff + cq + e);
            dst[co + k1] = b; dst[SZ_VT / 2 + co + k4] = b; dst[SZ_VT + co + k16] = b;
          }
        } else {
          float* sm = (float*)(ws + O_SM);
#pragma unroll
          for (int e = 0; e < 4; ++e) if (cq + e < 18) sm[tok * 32 + cq + e] = v[e];
        }
      }
    }
  }
}


DI int g_lds_byte(int r, int c) { const int st = (r >> 4) * 2 + (c >> 5), ob = (r & 15) * 64 + (c & 31) * 2; return st * 1024 + (ob ^ (((ob >> 9) & 1) << 5)); }
DI void g_stage_rc(int b, int& R, int& C) { const int st = b >> 10, sb = b & 1023, swz = sb ^ (((sb >> 9) & 1) << 5); R = (st >> 1) * 16 + (swz >> 6); C = (st & 1) * 32 + ((swz & 63) >> 1); }

DI float row16_sum(float v);
DI void p1_unit(const Params& p, int layer, int half, int pm, int pn, int pm_next, int pn_next  , bool first, unsigned char* lds) {
  const int tid = rtid(), wid = tid >> 6, lane = tid & 63, wr = wid >> 2, wc = wid & 3, fr = lane & 15, fq = lane >> 4;
  const bf16_t* Ab = (const bf16_t*)(p.ws + O_XB) + ((size_t)half * TH + (size_t)pm * 256) * 1024;
  const bf16_t* Bb = (const bf16_t*)(p.ws + O_WTIN + layer * SZ_WTIN1) + (size_t)pn * 256 * 1024;
  int sOff[4];
#pragma unroll
  for (int i = 0; i < 4; ++i) { int R, C; g_stage_rc(wid * 1024 + i * 8192 + lane * 16, R, C); sOff[i] = R * 1024 + C; }
  auto stage2 = [&](const bf16_t* A_, const bf16_t* B_, int buf, int kt) {
#pragma unroll
    for (int i = 0; i < 4; ++i) {
      __builtin_amdgcn_global_load_lds((const unsigned*)(A_ + sOff[i] + kt * 64), (unsigned*)(lds + buf * 65536 + wid * 1024 + i * 8192), 16, 0, 0);
      __builtin_amdgcn_global_load_lds((const unsigned*)(B_ + sOff[i] + kt * 64), (unsigned*)(lds + buf * 65536 + 32768 + wid * 1024 + i * 8192), 16, 0, 0);
    }
  };
  auto stage = [&](int buf, int kt) { stage2(Ab, Bb, buf, kt); };
  f32x4 acc[8][4];
#pragma unroll
  for (int m = 0; m < 8; ++m)
#pragma unroll
    for (int n = 0; n < 4; ++n) acc[m][n] = (f32x4){0.f, 0.f, 0.f, 0.f};
  const int lane_off = (fr * 64 + fq * 16) ^ ((fr >> 3) << 5);
  if (first) { __syncthreads(); stage(0, 0); }
  asm volatile("s_waitcnt vmcnt(0)" ::: "memory");
  __syncthreads();
#pragma unroll 1
  for (int t = 0; t < 16; ++t) {
    const int cur = t & 1;
    {
      const bool last = (t + 1 == 16);
      if (!last || pn_next >= 0) {
        const long dA = last ? (long)(pm_next - pm) * 256 * 1024 - 0 : (long)(t + 1) * 64;
        const long dB = last ? (long)(pn_next - pn) * 256 * 1024 - 0 : (long)(t + 1) * 64;
#pragma unroll
        for (int i = 0; i < 4; ++i) {
          __builtin_amdgcn_global_load_lds((const unsigned*)(Ab + sOff[i] + dA), (unsigned*)(lds + (cur ^ 1) * 65536 + wid * 1024 + i * 8192), 16, 0, 0);
          __builtin_amdgcn_global_load_lds((const unsigned*)(Bb + sOff[i] + dB), (unsigned*)(lds + (cur ^ 1) * 65536 + 32768 + wid * 1024 + i * 8192), 16, 0, 0);
        }
      }
    }
    const unsigned char* SA = lds + cur * 65536 + wr * 16384 + lane_off;
    const unsigned char* SB = lds + cur * 65536 + 32768 + wc * 8192 + lane_off;
    bf16x8 Bf[2][4], At[2][2];
#pragma unroll
    for (int n = 0; n < 4; ++n) Bf[0][n] = *(const bf16x8*)(SB + n * 2048);
#pragma unroll
    for (int m = 0; m < 2; ++m) At[0][m] = *(const bf16x8*)(SA + m * 2048);
#pragma unroll
    for (int g = 0; g < 8; ++g) {
      const int ks = g >> 2, pr = g & 3;
      if (g == 1) {
#pragma unroll
        for (int n = 0; n < 4; ++n) Bf[1][n] = *(const bf16x8*)(SB + n * 2048 + 1024);
      }
      if (g < 7) {
        const int g1 = g + 1;
#pragma unroll
        for (int m = 0; m < 2; ++m) At[g1 & 1][m] = *(const bf16x8*)(SA + ((g1 & 3) * 2 + m) * 2048 + (g1 >> 2) * 1024);
      }
      asm volatile("" : "+v"(acc[pr * 2][0][0]) :: "memory");
#pragma unroll
      for (int m = 0; m < 2; ++m)
#pragma unroll
        for (int n = 0; n < 4; ++n) acc[pr * 2 + m][n] = MFMA16(Bf[ks][n], At[g & 1][m], acc[pr * 2 + m][n]);
    }
    asm volatile("s_waitcnt vmcnt(0)" ::: "memory");
    __syncthreads();
  }
  const int nb0 = pn * 256 + wc * 64, tok0 = pm * 256 + wr * 128;
  const float* bias = (const float*)(p.ws + O_BIASP) + layer * NP;
  unsigned char* ws = p.ws;
  int kind, xf = 0, kgrp = 0, pitch = 0, coff = 0; bf16_t* dst = nullptr;
  if (nb0 < 384) { kind = 0; dst = (bf16_t*)(ws + O_QKA); pitch = 384; coff = nb0; }
  else if (nb0 < C_AV) { kind = 5; dst = (bf16_t*)(ws + O_KFA); coff = nb0 - 384; }
  else if (nb0 < C_BQK) { kind = 1; dst = (bf16_t*)(ws + O_VTA); coff = nb0 - C_AV; }
  else if (nb0 < 2304) { kind = 0; dst = (bf16_t*)(ws + O_QKB); pitch = 1152; coff = nb0 - C_BQK; }
  else if (nb0 < C_BV) { kind = 5; kgrp = (nb0 - 2304) / 384; dst = (bf16_t*)(ws + O_KFB + kgrp * SZ_VT); coff = (nb0 - 2304) - kgrp * 384; }
  else if (nb0 < C_CQK) { kind = 2; dst = (bf16_t*)(ws + O_VTB); coff = nb0 - C_BV; }
  else if (nb0 < 4224) { kind = 0; dst = (bf16_t*)(ws + O_QKC); pitch = 384; coff = nb0 - C_CQK; }
  else if (nb0 < C_CV) { kind = 5; dst = (bf16_t*)(ws + O_KFC); coff = nb0 - 4224; }
  else if (nb0 < C_D) { kind = 1; dst = (bf16_t*)(ws + O_VTC); coff = nb0 - C_CV; }
  else if (nb0 < C_E) { kind = 0; dst = (bf16_t*)(ws + O_QKVD); pitch = 1152; coff = nb0 - C_D; }
  else if (nb0 < C_SM) { kind = 0; dst = (bf16_t*)(ws + O_QE); pitch = 384; coff = nb0 - C_E; }
  else if (nb0 < C_Z) { kind = (nb0 == C_SM) ? 3 : 4; }
  else if (nb0 < C_MG) { kind = 0; xf = 1; dst = (bf16_t*)(ws + O_SZ); pitch = 1920; coff = nb0 - C_Z; }
  else if (nb0 < 13696) { kind = 0; xf = 2; dst = (bf16_t*)(ws + O_SIG); pitch = 5120; coff = nb0 - C_MG; }
  else { kind = 4; }
  if (kind == 4) return;
  if (kind == 0) {
    bf16_t* stg = (bf16_t*)(lds + 65536 + wid * 9216);
#pragma unroll
    for (int mh = 0; mh < 2; ++mh) {
#pragma unroll
      for (int m = 0; m < 4; ++m)
#pragma unroll
        for (int n = 0; n < 4; ++n) {
          const int c4 = n * 16 + fq * 4;
          const f32x4 bv = *(const f32x4*)(bias + nb0 + c4);
          float v[4];
#pragma unroll
          for (int e = 0; e < 4; ++e) v[e] = acc[mh * 4 + m][n][e] + bv[e];
          if (xf == 1) {
#pragma unroll
            for (int e = 0; e < 4; ++e) v[e] = fsilu(v[e]);
          } else if (xf == 2) {
#pragma unroll
            for (int e = 0; e < 4; ++e) v[e] = fsigmoid(v[e]);
          }
          *(u32x2*)(stg + (m * 16 + fr) * 72 + c4) = pk4(v[0], v[1], v[2], v[3]);
        }
      asm volatile("s_waitcnt lgkmcnt(0)" ::: "memory");
      __builtin_amdgcn_wave_barrier();
#pragma unroll
      for (int it = 0; it < 8; ++it) {
        const int row = it * 8 + (lane >> 3), ch = (lane & 7) * 8;
        const bf16x8 val = *(const bf16x8*)(stg + row * 72 + ch);
        *(bf16x8*)(dst + (size_t)(tok0 + mh * 64 + row) * pitch + coff + ch) = val;
      }
      asm volatile("s_waitcnt lgkmcnt(0)" ::: "memory");
      __builtin_amdgcn_wave_barrier();
    }
    return;
  }
  if (nb0 >= 384 && nb0 < C_AV) {
    float* ksum = (float*)(ws + O_KSUM) + (size_t)(pm * 2 + wr) * 384 + (nb0 - 384);
#pragma unroll
    for (int n = 0; n < 4; ++n) {
      const f32x4 bv = *(const f32x4*)(bias + nb0 + n * 16 + fq * 4);
#pragma unroll
      for (int e = 0; e < 4; ++e) {
        float t = 8.f * bv[e];
#pragma unroll
        for (int m = 0; m < 8; ++m) t += acc[m][n][e];
        t = row16_sum(t);
        if (fr == 0) ksum[n * 16 + fq * 4 + e] = t;
      }
    }
  }
#pragma unroll
  for (int m = 0; m < 8; ++m) {
    const int tok = tok0 + m * 16 + fr;
#pragma unroll
    for (int n = 0; n < 4; ++n) {
      const int c4 = n * 16 + fq * 4;
      const f32x4 bv = *(const f32x4*)(bias + nb0 + c4);
      float v[4];
#pragma unroll
      for (int e = 0; e < 4; ++e) v[e] = acc[m][n][e] + bv[e];
      if (kind == 5) {
        const int key = kgrp == 0 ? tok : kgrp == 1 ? (tok & 3) * 2048 + (tok >> 2) : (tok & 15) * 512 + (tok >> 4);
        *(u32x2*)(dst + kfrag_col(coff + c4) + kfrag_key(key)) = pk4(v[0], v[1], v[2], v[3]);
      } else if (kind == 1) {
        const int ko = vfrag_key(tok);
#pragma unroll
        for (int e = 0; e < 4; ++e) dst[vfrag_col(coff + c4 + e) + ko] = f2bf(v[e]);
      } else if (kind == 2) {
        const int k1 = vfrag_key(tok), k4 = vfrag_key((tok & 3) * 2048 + (tok >> 2)), k16 = vfrag_key((tok & 15) * 512 + (tok >> 4));
#pragma unroll
        for (int e = 0; e < 4; ++e) {
          const bf16_t b = f2bf(v[e]); const int co = vfrag_col(coff + c4 + e);
          dst[co + k1] = b; dst[SZ_VT / 2 + co + k4] = b; dst[SZ_VT + co + k16] = b;
        }
      } else {
        float* sm = (float*)(ws + O_SM);
#pragma unroll
        for (int e = 0; e < 4; ++e) if (c4 + e < 18) sm[tok * 32 + c4 + e] = v[e];
      }
    }
  }
}

DI void fox_prep(const Params& p, int hh, unsigned char* smem) {
  float* red = (float*)smem;
  const int tid = otid(), lane = tid & 63, wave = tid >> 6;
  const float* sm = (const float*)(p.ws + O_SM);
  float* FF = (float*)(p.ws + O_FF) + hh * TH;
  float loc[32];
#pragma unroll
  for (int j = 0; j < 32; ++j) loc[j] = sm[(tid * 32 + j) * 32 + hh];
  float s = 0.f;
#pragma unroll
  for (int j = 0; j < 32; ++j) { const float xv = loc[j]; s += fminf(xv, 0.f) - log1pf(expf(-fabsf(xv))); loc[j] = s; }
  float inc = s;
#pragma unroll
  for (int o = 1; o < 64; o <<= 1) { const float t = __shfl_up(inc, o); if (lane >= o) inc += t; }
  if (lane == 63) red[wave] = inc;
  sub_sync();
  float off = inc - s;
  for (int w = 0; w < wave; ++w) off += red[w];
#pragma unroll
  for (int j4 = 0; j4 < 8; ++j4) {
    f32x4 o4 = {off + loc[4 * j4], off + loc[4 * j4 + 1], off + loc[4 * j4 + 2], off + loc[4 * j4 + 3]};
    *(f32x4*)(FF + tid * 32 + 4 * j4) = o4;
  }
  sub_sync();
}

DI void kmean_prep(const Params& p, int idx, unsigned* kmaxu) {
  const int lane = otid() & 63;
  const int hh = idx / 32, blk = idx % 32;
  const bf16_t* k = (const bf16_t*)(p.ws + O_KFA) + kfrag_col(hh * 64 + lane) + blk * 8 * 2048;
  float s = 0.f;
#pragma unroll 8
  for (int i = 0; i < 256; ++i) s += bf2f(k[(i >> 5) * 2048 + (i & 31) * 8]);
  s *= (1.f / 256.f);
  const bf16_t hi = f2bf(s);
  bf16_t* km = (bf16_t*)(p.ws + O_KM);
  km[(hh * 32 + blk) * 64 + lane] = hi;
  km[6 * 32 * 64 + (hh * 32 + blk) * 64 + lane] = f2bf(s - bf2f(hi));
  const bf16_t* kc = (const bf16_t*)(p.ws + O_KFC) + (size_t)hh * 524288;
  float mx = 0.f;
#pragma unroll
  for (int t = 0; t < 4; ++t) {
    const int key = blk * 256 + lane * 4 + t;
    float kk = 0.f;
#pragma unroll
    for (int c = 0; c < 8; ++c) { float v[8]; unpk8(*(const bf16x8*)(kc + kfrag_key(key) + c * 256), v);
#pragma unroll
      for (int e = 0; e < 8; ++e) kk += v[e] * v[e]; }
    mx = fmaxf(mx, kk);
  }
#pragma unroll
  for (int o = 32; o >= 1; o >>= 1) mx = fmaxf(mx, __shfl_xor(mx, o));
  if (lane == 0) atomicMax(kmaxu + hh, __float_as_uint(mx));
}

DI void memkv_tile(const Params& p, int layer, int half, int mt, int nt, unsigned char* smem) {
  bf16_t* As = (bf16_t*)smem; bf16_t* Bs = As + 2 * 9216;
  f32x16 acc[2][2]; zero_acc(acc);
  PlainA al{(const bf16_t*)(p.ws + O_MEMN) + (size_t)half * 256 * 1024, 1024};
  const int m0 = mt * 128, n0 = nt * 128;
  gemm_kloop(al, (const bf16_t*)(p.ws + O_WTKV + layer * SZ_WTKV1), 1024, 16, m0, n0, acc, As, Bs);
  const int tid = otid(), lane = tid & 63, wave = tid >> 6, wr = wave >> 1, wc = wave & 1, r = lane & 31, h = lane >> 5;
  bf16_t* mk = (bf16_t*)(p.ws + O_MEMK); bf16_t* mv = (bf16_t*)(p.ws + O_MEMVT);
#pragma unroll
  for (int ni = 0; ni < 2; ++ni)
#pragma unroll
    for (int mi = 0; mi < 2; ++mi) {
      const int m = m0 + wr * 64 + mi * 32 + r;
#pragma unroll
      for (int i = 0; i < 16; ++i) {
        const int col = n0 + wc * 64 + ni * 32 + crow(i, h);
        const bf16_t b = f2bf(acc[mi][ni][i]);
        if (col < 384) { const int hd = col / 96, d = col % 96; mk[(size_t)((half * 4 + hd) * 8 + (m >> 5)) * 3072 + (d >> 4) * 512 + ((d >> 3) & 1) * 256 + (m & 31) * 8 + (d & 7)] = b; }
        else { const int cc = col - 384, hd = cc / 96, d = cc % 96, kk = m & 31;
          mv[(size_t)((half * 4 + hd) * 8 + (m >> 5)) * 3072 + (d >> 5) * 1024 + (kk >> 4) * 512 + ((kk >> 2) & 1) * 256 + (d & 31) * 8 + ((kk >> 3) & 1) * 4 + (kk & 3)] = b; }
      }
    }
}

DI f32x16 mm_quad(const bf16_t* A, const bf16_t* B, int wr, int wc, int r, int h) {
  f32x16 acc;
#pragma unroll
  for (int i = 0; i < 16; ++i) acc[i] = 0.f;
  const bf16_t* a_ = A + (wr * 32 + r) * 72 + 8 * h;
  const bf16_t* b_ = B + (wc * 32 + r) * 72 + 8 * h;
#pragma unroll
  for (int s = 0; s < 4; ++s) acc = MFMA32(*(const bf16x8*)(a_ + 16 * s), *(const bf16x8*)(b_ + 16 * s), acc);
  return acc;
}

DI void gdn_prep(const Params& p, int layer, int half, int hh, int c, unsigned char* smem) {
  bf16_t* QN = (bf16_t*)smem; bf16_t* KN = QN + 4608; bf16_t* KB = KN + 4608; bf16_t* KDT = KB + 4608; bf16_t* VBT = KDT + 4608;
  bf16_t* KBET = VBT + 4608; bf16_t* QKm = KBET + 4608; bf16_t* Tm = QKm + 4608;
  float* gcv = (float*)(smem + 73728); float* betav = gcv + 64; float* egc = gcv + 128;
  float* Mf = (float*)(smem + 9216);
  bf16_t* UT = KN; bf16_t* WT = KB;
  int tid = otid();
  int lane = tid & 63, wave = tid >> 6, wr = wave >> 1, wc = wave & 1, r = lane & 31, h = lane >> 5;
#define REOPAQUE() do { asm volatile("" : "+v"(tid)); lane = tid & 63; wave = tid >> 6; wr = wave >> 1; wc = wave & 1; r = lane & 31; h = lane >> 5; } while (0)
  const float* sm = (const float*)(p.ws + O_SM);
  if (wave == 0) {
    const int tok = c * 64 + lane;
    const float bt = fsigmoid(sm[tok * 32 + 6 + hh]);
    const float xv = sm[tok * 32 + 12 + hh] + p.dt_bias[layer * 6 + hh];
    const float sp = fmaxf(xv, 0.f) + log1pf(expf(-fabsf(xv)));
    float g = -expf(p.a_log[layer * 6 + hh]) * sp;
#pragma unroll
    for (int o = 1; o < 64; o <<= 1) { const float t = __shfl_up(g, o); if (lane >= o) g += t; }
    gcv[lane] = g; betav[lane] = bt; egc[lane] = expf(g);
    if (lane == 63) ((float*)(p.ws + O_GL))[hh * 128 + c] = expf(g);
  }
  sub_sync();
  REOPAQUE();
  {
    const int t = tid >> 2, cg4 = tid & 3, ch0 = cg4 * 16;
    const bf16_t* src = (const bf16_t*)(p.ws + O_QKVD);
    const float* cw = p.conv_w + (size_t)layer * 4 * 1152;
    const float bt = betav[t], gct = gcv[t], eg = egc[t], ed = expf(gcv[63] - gct);
    auto convpart = [&](int pt, float (&val)[16]) {
      const int col = pt * 384 + hh * 64 + ch0;
#pragma unroll
      for (int e = 0; e < 16; ++e) val[e] = 0.f;
#pragma unroll
      for (int j = 0; j < 4; ++j) {
        const int row = c * 64 + t - 3 + j;
        if (row >= 0) {
          float xv[16];
          unpk8(*(const bf16x8*)(src + (size_t)row * 1152 + col), xv);
          unpk8(*(const bf16x8*)(src + (size_t)row * 1152 + col + 8), xv + 8);
#pragma unroll
          for (int e4 = 0; e4 < 4; ++e4) {
            const f32x4 w4 = *(const f32x4*)(cw + j * 1152 + col + 4 * e4);
#pragma unroll
            for (int e = 0; e < 4; ++e) val[4 * e4 + e] += w4[e] * xv[4 * e4 + e];
          }
        }
      }
#pragma unroll
      for (int e = 0; e < 16; ++e) val[e] = fsilu(val[e]);
    };
    {
      float val[16]; convpart(0, val);
      float sq = 0.f;
#pragma unroll
      for (int e = 0; e < 16; ++e) sq += val[e] * val[e];
      sq += __shfl_xor(sq, 1); sq += __shfl_xor(sq, 2);
      const float rq = rsqrtf(sq + 1e-6f) * 0.125f;
#pragma unroll
      for (int e = 0; e < 16; ++e) val[e] *= rq;
      *(bf16x8*)(QN + t * 72 + ch0) = pk8(val); *(bf16x8*)(QN + t * 72 + ch0 + 8) = pk8(val + 8);
    }
    asm volatile("" ::: "memory");
    {
      float val[16]; convpart(1, val);
      float sk = 0.f;
#pragma unroll
      for (int e = 0; e < 16; ++e) sk += val[e] * val[e];
      sk += __shfl_xor(sk, 1); sk += __shfl_xor(sk, 2);
      const float rk = rsqrtf(sk + 1e-6f);
      float kb[16];
#pragma unroll
      for (int e = 0; e < 16; ++e) { val[e] *= rk; kb[e] = val[e] * bt; }
      *(bf16x8*)(KN + t * 72 + ch0) = pk8(val); *(bf16x8*)(KN + t * 72 + ch0 + 8) = pk8(val + 8);
      *(bf16x8*)(KB + t * 72 + ch0) = pk8(kb); *(bf16x8*)(KB + t * 72 + ch0 + 8) = pk8(kb + 8);
#pragma unroll
      for (int e = 0; e < 16; ++e) {
        KDT[(ch0 + e) * 72 + t] = f2bf(val[e] * ed);
        KBET[(ch0 + e) * 72 + t] = f2bf(kb[e] * eg);
      }
    }
    asm volatile("" ::: "memory");
    {
      float val[16]; convpart(2, val);
#pragma unroll
      for (int e = 0; e < 16; ++e) VBT[(ch0 + e) * 72 + t] = f2bf(val[e] * bt);
    }
  }
  sub_sync();
  REOPAQUE();
  {
    const f32x16 kk = mm_quad(KB, KN, wr, wc, r, h);
    const f32x16 qk = mm_quad(QN, KN, wr, wc, r, h);
    sub_sync();
    const int j = wc * 32 + r; const float gj = gcv[j];
#pragma unroll
    for (int i = 0; i < 16; ++i) {
      const int row = wr * 32 + crow(i, h);
      const float dec = (row >= j) ? expf(gcv[row] - gj) : 0.f;
      Mf[row * 68 + j] = (row > j) ? kk[i] * dec : 0.f;
      QKm[row * 72 + j] = f2bf(qk[i] * dec);
    }
  }
  sub_sync();
  REOPAQUE();
  if (wave == 0) {
    float t[64];
#pragma unroll
    for (int i = 0; i < 64; ++i) {
      float a4[4] = {(i == lane) ? 1.f : 0.f, 0.f, 0.f, 0.f};
#pragma unroll
      for (int j4 = 0; j4 < (i + 3) / 4; ++j4) {
        const f32x4 mrow = *(const f32x4*)(Mf + i * 68 + 4 * j4);
#pragma unroll
        for (int e = 0; e < 4; ++e) if (4 * j4 + e < i) a4[e] -= mrow[e] * t[4 * j4 + e];
      }
      const float a = (a4[0] + a4[1]) + (a4[2] + a4[3]);
      t[i] = a;
      Tm[i * 72 + lane] = f2bf(a);
      asm volatile("" ::: "memory");
    }
  }
  sub_sync();
  REOPAQUE();
  {
    const f32x16 u = mm_quad(Tm, VBT, wr, wc, r, h);
    const f32x16 w = mm_quad(Tm, KBET, wr, wc, r, h);
    const int col = wc * 32 + r;
#pragma unroll
    for (int g = 0; g < 4; ++g) {
      const int i0 = wr * 32 + 8 * g + 4 * h;
      *(u32x2*)(UT + col * 72 + i0) = pk4(u[4 * g], u[4 * g + 1], u[4 * g + 2], u[4 * g + 3]);
      *(u32x2*)(WT + col * 72 + i0) = pk4(w[4 * g], w[4 * g + 1], w[4 * g + 2], w[4 * g + 3]);
    }
  }
  sub_sync();
  REOPAQUE();
  {
    bf16_t* base = (bf16_t*)(p.ws + O_DPREP + (size_t)(hh * 128 + c) * 32768);
    const int n = wc * 32 + r;
    {
      const int ks = n >> 5, jh = (n >> 4) & 1, q = (n >> 2) & 3, jl = n & 3, jj = 4 * jh + jl;
      const int cbase = (ks * 64 + 16 * q) * 8 + jj;
      {
        const f32x16 P = mm_quad(KDT, WT, wr, wc, r, h);
#pragma unroll
        for (int i = 0; i < 16; ++i) {
          const int m = wr * 32 + crow(i, h);
          base[((m >> 4) * 128 + (m & 15)) * 8 + cbase] = f2bf(P[i]);
        }
      }
      asm volatile("" ::: "memory");
      {
        const f32x16 QW = mm_quad(QKm, WT, wr, wc, r, h);
#pragma unroll
        for (int i = 0; i < 16; ++i) {
          const int m = wr * 32 + crow(i, h);
          const float qd = bf2f(QN[m * 72 + n]) * egc[m];
          base[4096 + ((m >> 4) * 128 + (m & 15)) * 8 + cbase] = f2bf(qd - QW[i]);
        }
      }
      asm volatile("" ::: "memory");
    }
    const int jsl = n >> 4;
    {
      const f32x16 Bc = mm_quad(KDT, UT, wr, wc, r, h);
#pragma unroll
      for (int g = 0; g < 4; ++g) {
        const int row0 = wr * 32 + 8 * g + 4 * h;
        const int rt = row0 >> 4, lp = 16 * ((row0 >> 2) & 3) + (n & 15);
        *(u32x2*)(base + 8192 + ((jsl * 4 + rt) * 64 + lp) * 4) = pk4(Bc[4 * g], Bc[4 * g + 1], Bc[4 * g + 2], Bc[4 * g + 3]);
      }
    }
    asm volatile("" ::: "memory");
    {
      const f32x16 O0 = mm_quad(QKm, UT, wr, wc, r, h);
#pragma unroll
      for (int g = 0; g < 4; ++g) {
        const int row0 = wr * 32 + 8 * g + 4 * h;
        const int rt = row0 >> 4, lp = 16 * ((row0 >> 2) & 3) + (n & 15);
        *(u32x2*)(base + 12288 + ((jsl * 4 + rt) * 64 + lp) * 4) = pk4(O0[4 * g], O0[4 * g + 1], O0[4 * g + 2], O0[4 * g + 3]);
      }
    }
  }
  sub_sync();
#undef REOPAQUE
}

struct TileDesc { const bf16_t* k; const bf16_t* v; const float* aux; int tag; };

template <int DHT, bool AUX>
struct TileRegs { bf16x8 k[DHT / 16]; bf16x8 v[DHT / 32][2]; f32x4 a[4]; };

template <int DHT, bool AUX>
DI void load_tile(const bf16_t* kp, const bf16_t* vp, const float* ap, long ldv, TileRegs<DHT, AUX>& t) {
#pragma unroll
  for (int s = 0; s < DHT / 16; ++s) t.k[s] = *(const bf16x8*)(kp + 512 * s);
#pragma unroll
  for (int dt = 0; dt < DHT / 32; ++dt)
#pragma unroll
    for (int s = 0; s < 2; ++s) t.v[dt][s] = *(const bf16x8*)(vp + (dt * 2 + s) * 512);
  if (AUX) {
#pragma unroll
    for (int g = 0; g < 4; ++g) t.a[g] = *(const f32x4*)(ap + 8 * g);
  }
}

template <int DHT, bool AUX, class TF, class MF, class SF>
DI void attn_loop(int maxtiles, TF&& tf, MF&& mf, SF&& stopf, const bf16x8 (&qf)[DHT / 16], long ldv, float scale2,
                  f32x16 (&o)[DHT / 32], float& m, float& l) {
  TileRegs<DHT, AUX> cur, nxt;
  int tagc, tagn;
  bf16x8 qf0 = qf[0];
  { const bf16_t* kp; const bf16_t* vp; const float* ap = nullptr; tagc = tf(0, kp, vp, ap); load_tile<DHT, AUX>(kp, vp, ap, ldv, cur); }
#pragma unroll 1
  for (int t = 0; t < maxtiles; ++t) {
    { const bf16_t* kp; const bf16_t* vp; const float* ap = nullptr; tagn = tf(t + 1, kp, vp, ap); load_tile<DHT, AUX>(kp, vp, ap, ldv, nxt); }
    { bf16x8 q0 = qf[0]; asm volatile("" : "+v"(q0) :: "memory"); qf0 = q0; }
    f32x16 sacc;
#pragma unroll
    for (int i = 0; i < 16; ++i) sacc[i] = 0.f;
#pragma unroll
    for (int s = 0; s < DHT / 16; ++s) sacc = MFMA32(cur.k[s], s == 0 ? qf0 : qf[s], sacc);
    float sv[16]; float mx = NEG_INF;
#pragma unroll
    for (int i = 0; i < 16; ++i) { sv[i] = sacc[i] * scale2 + mf(tagc, i, AUX ? cur.a[i >> 2][i & 3] : 0.f); mx = fmaxf(mx, sv[i]); }
    mx = fmaxf(mx, __shfl_xor(mx, 32));
    const float mnew = fmaxf(m, mx);
    const float alpha = __builtin_amdgcn_exp2f(m - mnew);
    m = mnew;
    float pv[16]; float ps = 0.f;
#pragma unroll
    for (int i = 0; i < 16; ++i) { pv[i] = __builtin_amdgcn_exp2f(sv[i] - mnew); ps += pv[i]; }
    l = l * alpha + ps;
#pragma unroll
    for (int dt = 0; dt < DHT / 32; ++dt)
#pragma unroll
      for (int i = 0; i < 16; ++i) o[dt][i] *= alpha;
    bf16x8 pf[2]; pf[0] = pk8(pv); pf[1] = pk8(pv + 8);
#pragma unroll
    for (int dt = 0; dt < DHT / 32; ++dt)
#pragma unroll
      for (int s = 0; s < 2; ++s) {
        o[dt] = MFMA32(cur.v[dt][s], pf[s], o[dt]);
      }
    if (stopf(t, m, AUX ? cur.a[0][0] : 0.f)) break;
    cur = nxt; tagc = tagn;
  }
}

template <int DHT>
DI void attn_store(const f32x16 (&o)[DHT / 32], float l, bf16_t* dstrow, int h, float& ltot_out, bool valid = true) {
  const float ltot = l + __shfl_xor(l, 32);
  ltot_out = ltot;
  const float inv = ltot > 0.f ? 1.f / ltot : 0.f;
  if (valid)
#pragma unroll
  for (int dt = 0; dt < DHT / 32; ++dt)
#pragma unroll
    for (int g = 0; g < 4; ++g)
      *(u32x2*)(dstrow + dt * 32 + 8 * g + 4 * h) = pk4(o[dt][4 * g] * inv, o[dt][4 * g + 1] * inv, o[dt][4 * g + 2] * inv, o[dt][4 * g + 3] * inv);
}

template <int DHT>
DI void attn_store_gated(const f32x16 (&o)[DHT / 32], float l, bf16_t* szrow, int h) {
  const float ltot = l + __shfl_xor(l, 32);
  const float inv = ltot > 0.f ? 1.f / ltot : 0.f;
#pragma unroll
  for (int dt = 0; dt < DHT / 32; ++dt)
#pragma unroll
    for (int g = 0; g < 4; ++g) {
      bf16_t* q = szrow + dt * 32 + 8 * g + 4 * h;
      const u32x2 z = *(const u32x2*)q;
      *(u32x2*)q = pk4(o[dt][4 * g] * inv * bflo(z.x), o[dt][4 * g + 1] * inv * bfhi(z.x), o[dt][4 * g + 2] * inv * bflo(z.y), o[dt][4 * g + 3] * inv * bfhi(z.y));
    }
}

template <int N>
DI void zero_o(f32x16 (&o)[N]) {
#pragma unroll
  for (int a = 0; a < N; ++a)
#pragma unroll
    for (int i = 0; i < 16; ++i) o[a][i] = 0.f;
}

DI void top3_insert(float v, int n, float& v0, float& v1, float& v2, int& i0, int& i1, int& i2) {
  const bool g0 = v > v0, g1 = v > v1, g2 = v > v2;
  v2 = g1 ? v1 : (g2 ? v : v2); i2 = g1 ? i1 : (g2 ? n : i2);
  v1 = g0 ? v0 : (g1 ? v : v1); i1 = g0 ? i0 : (g1 ? n : i1);
  v0 = g0 ? v : v0;             i0 = g0 ? n : i0;
}

DI void moba_select(const Params& p, int a) {
  const int lane = otid() & 63, r = lane & 31, h = lane >> 5;
  const int qtile = a / 6, hh = a % 6, qb = qtile >> 3;
  unsigned mask = 0;
  if (qb > 0) {
    const bf16_t* qrow = (const bf16_t*)(p.ws + O_QKA) + (size_t)(qtile * 32 + r) * 384 + hh * 64 + 8 * h;
    bf16x8 qf[4];
#pragma unroll
    for (int s = 0; s < 4; ++s) qf[s] = *(const bf16x8*)(qrow + 16 * s);
    const float* ks0 = (const float*)(p.ws + O_KSUM) + (size_t)(r * 2) * 384 + hh * 64 + 8 * h;
    f32x16 g;
#pragma unroll
    for (int i = 0; i < 16; ++i) g[i] = 0.f;
#pragma unroll
    for (int s = 0; s < 4; ++s) {
      const f32x4 a0 = *(const f32x4*)(ks0 + 16 * s), a1 = *(const f32x4*)(ks0 + 16 * s + 4);
      const f32x4 b0 = *(const f32x4*)(ks0 + 384 + 16 * s), b1 = *(const f32x4*)(ks0 + 384 + 16 * s + 4);
      float hi[8], lo[8];
#pragma unroll
      for (int e = 0; e < 4; ++e) {
        const float m0 = (a0[e] + b0[e]) * (1.f / 256.f), m1 = (a1[e] + b1[e]) * (1.f / 256.f);
        hi[e] = bf2f(f2bf(m0)); lo[e] = m0 - hi[e];
        hi[4 + e] = bf2f(f2bf(m1)); lo[4 + e] = m1 - hi[4 + e];
      }
      g = MFMA32(pk8(hi), qf[s], g); g = MFMA32(pk8(lo), qf[s], g);
    }
    float v0 = NEG_INF, v1 = NEG_INF, v2 = NEG_INF; int i0 = -1, i1 = -1, i2 = -1;
#pragma unroll
    for (int i = 0; i < 16; ++i) { const int n = crow(i, h); if (n < qb) top3_insert(g[i], n, v0, v1, v2, i0, i1, i2); }
    const float pv0 = __shfl_xor(v0, 32), pv1 = __shfl_xor(v1, 32), pv2 = __shfl_xor(v2, 32);
    const int pi0 = __shfl_xor(i0, 32), pi1 = __shfl_xor(i1, 32), pi2 = __shfl_xor(i2, 32);
    if (pi0 >= 0) top3_insert(pv0, pi0, v0, v1, v2, i0, i1, i2);
    if (pi1 >= 0) top3_insert(pv1, pi1, v0, v1, v2, i0, i1, i2);
    if (pi2 >= 0) top3_insert(pv2, pi2, v0, v1, v2, i0, i1, i2);
    if (i0 >= 0) mask |= 1u << i0;
    if (i1 >= 0) mask |= 1u << i1;
    if (i2 >= 0) mask |= 1u << i2;
  }
  if (h == 0) ((unsigned*)(p.ws + O_MASK))[(qtile * 32 + r) * 8 + hh] = mask;
}

DI void moba_gather(const Params& p, int a, unsigned char* smem) {
  const int tid = otid(), lane = tid & 63, wave = tid >> 6, r = lane & 31, h = lane >> 5;
  const int part = a & 1, a2 = a >> 1;
  const int hh = a2 % 6, idx = a2 / 6;
  int qb = 1;
  while ((qb + 1) * qb / 2 <= idx) ++qb;
  const int n = idx - qb * (qb - 1) / 2;
  const unsigned* MASK = (const unsigned*)(p.ws + O_MASK);
  unsigned* list = (unsigned*)(smem + wave * 1024);
  int cnt = 0;
#pragma unroll
  for (int j = 0; j < 4; ++j) {
    const int qi = j * 64 + lane;
    const unsigned mk = MASK[(qb * 256 + qi) * 8 + hh];
    const bool pred = (mk >> n) & 1u;
    const unsigned long long ball = __ballot(pred);
    const int pos = cnt + __builtin_popcountll(ball & ((1ull << lane) - 1ull));
    if (pred) list[pos] = (unsigned)qi | ((unsigned)__builtin_popcount(mk & ((1u << n) - 1u)) << 8);
    cnt += __builtin_popcountll(ball);
  }
  cnt = __builtin_amdgcn_readfirstlane(cnt);
  if (cnt == 0) return;
  asm volatile("s_waitcnt lgkmcnt(0)" ::: "memory");
  __builtin_amdgcn_wave_barrier();
  const bf16_t* QK = (const bf16_t*)(p.ws + O_QKA);
  const bf16_t* KF = (const bf16_t*)(p.ws + O_KFA) + (size_t)hh * 524288 + (size_t)n * 8 * 2048 + lane * 8;
  const bf16_t* VT = (const bf16_t*)(p.ws + O_VTA) + (size_t)hh * 524288 + (size_t)n * 8 * 2048 + lane * 8;
  const int nch = (cnt + 31) >> 5;
#pragma unroll 1
  for (int c = part; c < nch; c += 2) {
    const int e = c * 32 + r;
    const bool valid = e < cnt;
    const unsigned ent = list[valid ? e : 0];
    const int tok = qb * 256 + (int)(ent & 255u), slot = (int)(ent >> 8);
    bf16x8 qf[4];
    { const bf16_t* qrow = QK + (size_t)tok * 384 + hh * 64 + 8 * h;
#pragma unroll
      for (int s = 0; s < 4; ++s) qf[s] = *(const bf16x8*)(qrow + 16 * s); }
    auto tf = [&](int t, const bf16_t*& kp, const bf16_t*& vp, const float*&) -> int {
      const int tt = t < 7 ? t : 7;
      kp = KF + tt * 2048; vp = VT + tt * 2048;
      return 0;
    };
    auto mf = [&](int, int, float) -> float { return 0.f; };
    auto sf = [&](int, float, float) { return false; };
    f32x16 o[2]; zero_o(o); float m = -1e30f, l = 0.f;
    int nt8 = 8; asm volatile("" : "+s"(nt8));
    attn_loop<64, false>(nt8, tf, mf, sf, qf, (long)TH, 0.125f * LOG2E, o, m, l);
    float lt;
    attn_store<64>(o, l, (bf16_t*)(p.ws + O_OA + slot * SZ_O) + (size_t)tok * 384 + hh * 64, h, lt, valid);
    if (valid && h == 0) { float* st = (float*)(p.ws + O_STA) + ((size_t)(slot * TH + tok) * 6 + hh) * 2; st[0] = m; st[1] = lt; }
  }
}

DI void moba_own(const Params& p, int a) {
  const int lane = otid() & 63, r = lane & 31, h = lane >> 5;
  const int qtile = 255 - a / 6, hh = a % 6, qb = qtile >> 3, own = qtile & 7;
  const bf16_t* QK = (const bf16_t*)(p.ws + O_QKA);
  const bf16_t* KF = (const bf16_t*)(p.ws + O_KFA) + (size_t)hh * 524288 + (size_t)qb * 8 * 2048 + lane * 8;
  const bf16_t* VT = (const bf16_t*)(p.ws + O_VTA) + (size_t)hh * 524288 + (size_t)qb * 8 * 2048 + lane * 8;
  const int tok = qtile * 32 + r;
  bf16x8 qf[4];
  { const bf16_t* qrow = QK + (size_t)tok * 384 + hh * 64 + 8 * h;
#pragma unroll
    for (int s = 0; s < 4; ++s) qf[s] = *(const bf16x8*)(qrow + 16 * s); }
  auto tf = [&](int t, const bf16_t*& kp, const bf16_t*& vp, const float*&) -> int {
    const int kk = t < own ? t : own;
    kp = KF + kk * 2048; vp = VT + kk * 2048;
    return (kk == own) ? 101 : 100;
  };
  auto mf = [&](int tag, int i, float) -> float {
    if (tag == 100) return 0.f;
    return (crow(i, h) <= r) ? 0.f : NEG_INF;
  };
  auto sf = [&](int, float, float) { return false; };
  f32x16 o[2]; zero_o(o); float m = -1e30f, l = 0.f;
  attn_loop<64, false>(own + 1, tf, mf, sf, qf, (long)TH, 0.125f * LOG2E, o, m, l);
  float lt;
  attn_store<64>(o, l, (bf16_t*)(p.ws + O_OA + 3 * SZ_O) + (size_t)tok * 384 + hh * 64, h, lt);
  if (h == 0) {
    float* st = (float*)(p.ws + O_STA);
    st[((size_t)(3 * TH + tok) * 6 + hh) * 2] = m; st[((size_t)(3 * TH + tok) * 6 + hh) * 2 + 1] = lt;
    const int np = __builtin_popcount(((const unsigned*)(p.ws + O_MASK))[tok * 8 + hh]);
    for (int sl = np; sl < 3; ++sl) { st[((size_t)(sl * TH + tok) * 6 + hh) * 2] = -1e30f; st[((size_t)(sl * TH + tok) * 6 + hh) * 2 + 1] = 0.f; }
  }
}

DI void fox_item(const Params& p, int c, const unsigned* kmaxu) {
  const int lane = otid() & 63, r = lane & 31, h = lane >> 5;
  const int qtile = 255 - c / 6, hh = c % 6;
  const bf16_t* QK = (const bf16_t*)(p.ws + O_QKC);
  const bf16_t* KF = (const bf16_t*)(p.ws + O_KFC);
  const bf16_t* VT = (const bf16_t*)(p.ws + O_VTC);
  const float* FF = (const float*)(p.ws + O_FF) + hh * TH;
  bf16x8 qf[4]; float qn2 = 0.f;
  { const bf16_t* qrow = QK + (size_t)(qtile * 32 + r) * 384 + hh * 64 + 8 * h;
#pragma unroll
    for (int s = 0; s < 4; ++s) { qf[s] = *(const bf16x8*)(qrow + 16 * s); float v[8]; unpk8(qf[s], v);
#pragma unroll
      for (int e = 0; e < 8; ++e) qn2 += v[e] * v[e]; } }
  qn2 += __shfl_xor(qn2, 32);
#pragma unroll
  for (int o = 16; o >= 1; o >>= 1) qn2 = fmaxf(qn2, __shfl_xor(qn2, o));
  const float Fq = FF[qtile * 32 + r];
  const float Ffirst = FF[qtile * 32];
  const float kmaxn = sqrtf(__uint_as_float(kmaxu[hh]));
  const float bound = sqrtf(qn2) * kmaxn * 0.125f + Ffirst;
  auto tf = [&](int t, const bf16_t*& kp, const bf16_t*& vp, const float*& ap) -> int {
    const int keybase = (qtile - t > 0 ? qtile - t : 0) * 32;
    kp = KF + (size_t)hh * 524288 + (keybase >> 5) * 2048 + lane * 8;
    vp = VT + (size_t)hh * 524288 + (keybase >> 5) * 2048 + lane * 8;
    ap = FF + keybase + 4 * h;
    return (t == 0) ? 1 : 0;
  };
  auto mf = [&](int tag, int i, float fk) -> float {
    const float b = (Fq - fk) * LOG2E;
    return (tag == 1 && crow(i, h) > r) ? NEG_INF : b;
  };
  auto sf = [&](int, float m, float a0) {
    const float fkb = __builtin_bit_cast(float, __builtin_amdgcn_readfirstlane(__builtin_bit_cast(int, a0)));
    float mm = m;
#pragma unroll
    for (int o = 16; o >= 1; o >>= 1) mm = fminf(mm, __shfl_xor(mm, o));
    return (bound - fkb) * LOG2E < mm - 45.f;
  };
  f32x16 o[2]; zero_o(o); float m = -1e30f, l = 0.f;
  attn_loop<64, true>(qtile + 1, tf, mf, sf, qf, (long)TH, 0.125f * LOG2E, o, m, l);
  float lt;
  attn_store_gated<64>(o, l, (bf16_t*)(p.ws + O_SZ) + (size_t)(qtile * 32 + r) * 1920 + 2 * 384 + hh * 64, h);
}

DI void dil_item(const Params& p, int idx) {
  const int lane = otid() & 63, r = lane & 31, h = lane >> 5;
  const int g = idx / 1536, rem = idx % 1536, hh = rem / 256, w = rem % 256;
  const int dsh = 2 * g;
  const int dil = 1 << dsh, L = TH >> dsh, tps = L / 32;
  const int rs = w / tps, lt_ = w % tps, l0 = lt_ * 32;
  const bf16_t* QK = (const bf16_t*)(p.ws + O_QKB);
  const bf16_t* KF = (const bf16_t*)(p.ws + O_KFB + g * SZ_VT);
  const bf16_t* VT = (const bf16_t*)(p.ws + O_VTB + g * SZ_VT);
  const int tq = (l0 + r) * dil + rs;
  bf16x8 qf[4];
  { const bf16_t* qrow = QK + (size_t)tq * 1152 + g * 384 + hh * 64 + 8 * h;
#pragma unroll
    for (int s = 0; s < 4; ++s) qf[s] = *(const bf16x8*)(qrow + 16 * s); }
  const int t0 = (l0 >= 128) ? 0 : (128 - l0) / 32;
  auto tf = [&](int tt, const bf16_t*& kp, const bf16_t*& vp, const float*&) -> int {
    const int t = (t0 + tt < 4) ? t0 + tt : 4; const int keybase = l0 - 128 + 32 * t;
    kp = KF + (size_t)hh * 524288 + ((rs * L + keybase) >> 5) * 2048 + lane * 8;
    vp = VT + (size_t)hh * 524288 + ((rs * L + keybase) >> 5) * 2048 + lane * 8;
    return t;
  };
  auto mf = [&](int tag, int i, float) -> float {
    const int kj = crow(i, h);
    if (tag == 0) return (kj >= r) ? 0.f : NEG_INF;
    if (tag == 4) return (kj <= r) ? 0.f : NEG_INF;
    return 0.f;
  };
  auto sf = [&](int, float, float) { return false; };
  f32x16 o[2]; zero_o(o); float m = -1e30f, l = 0.f;
  attn_loop<64, false>(5 - t0, tf, mf, sf, qf, (long)TH, 0.125f * LOG2E, o, m, l);
  float lt;
  attn_store<64>(o, l, (bf16_t*)(p.ws + O_OB + g * SZ_O) + (size_t)tq * 384 + hh * 64, h, lt);
  if (h == 0) { float* st = (float*)(p.ws + O_STB) + ((size_t)(g * TH + tq) * 6 + hh) * 2; st[0] = m; st[1] = lt; }
}

DI void mem_item(const Params& p, int half, int e) {
  const int lane = otid() & 63, r = lane & 31, h = lane >> 5;
  const int hd = e & 3, qtile = e >> 2;
  const bf16_t* QE = (const bf16_t*)(p.ws + O_QE);
  const bf16_t* MK = (const bf16_t*)(p.ws + O_MEMK);
  const bf16_t* MV = (const bf16_t*)(p.ws + O_MEMVT);
  bf16x8 qf[6];
  { const bf16_t* qrow = QE + (size_t)(qtile * 32 + r) * 384 + hd * 96 + 8 * h;
#pragma unroll
    for (int s = 0; s < 6; ++s) qf[s] = *(const bf16x8*)(qrow + 16 * s); }
  auto tf = [&](int t, const bf16_t*& kp, const bf16_t*& vp, const float*&) -> int {
    const int keybase = 32 * (t < 7 ? t : 7);
    kp = MK + (size_t)((half * 4 + hd) * 8 + (keybase >> 5)) * 3072 + lane * 8;
    vp = MV + (size_t)((half * 4 + hd) * 8 + (keybase >> 5)) * 3072 + lane * 8;
    return 0;
  };
  auto mf = [&](int, int, float) -> float { return 0.f; };
  auto sf = [&](int, float, float) { return false; };
  f32x16 o[3]; zero_o(o); float m = -1e30f, l = 0.f;
  attn_loop<96, false>(8, tf, mf, sf, qf, 256L, 0.10206207261596577f * LOG2E, o, m, l);
  float lt;
  attn_store_gated<96>(o, l, (bf16_t*)(p.ws + O_SZ) + (size_t)(qtile * 32 + r) * 1920 + 4 * 384 + hd * 96, h);
}

DI float dpp_ror(float v, int ctrl);
DI float row16_sum(float v) {
  v += __builtin_bit_cast(float, __builtin_amdgcn_update_dpp(0, __builtin_bit_cast(int, v), 0x128, 0xf, 0xf, false));
  v += __builtin_bit_cast(float, __builtin_amdgcn_update_dpp(0, __builtin_bit_cast(int, v), 0x124, 0xf, 0xf, false));
  v += __builtin_bit_cast(float, __builtin_amdgcn_update_dpp(0, __builtin_bit_cast(int, v), 0x122, 0xf, 0xf, false));
  v += __builtin_bit_cast(float, __builtin_amdgcn_update_dpp(0, __builtin_bit_cast(int, v), 0x121, 0xf, 0xf, false));
  return v;
}

struct ScanRegs { bf16x8 pf[4][2]; bf16x8 qe[4][2]; s16x4 bc[4]; s16x4 o0[4]; float gl; };
DI void scan_load(const Params& p, int hh, int j, int c, int lane, ScanRegs& s) {
  const unsigned char* base = p.ws + O_DPREP + (size_t)(hh * 128 + c) * 32768;
#pragma unroll
  for (int mt = 0; mt < 4; ++mt)
#pragma unroll
    for (int ks = 0; ks < 2; ++ks) {
      s.pf[mt][ks] = *(const bf16x8*)(base + ((mt * 2 + ks) * 64 + lane) * 16);
      s.qe[mt][ks] = *(const bf16x8*)(base + 8192 + ((mt * 2 + ks) * 64 + lane) * 16);
    }
#pragma unroll
  for (int rt = 0; rt < 4; ++rt) {
    s.bc[rt] = *(const s16x4*)(base + 16384 + ((j * 4 + rt) * 64 + lane) * 8);
    s.o0[rt] = *(const s16x4*)(base + 24576 + ((j * 4 + rt) * 64 + lane) * 8);
  }
  s.gl = ((const float*)(p.ws + O_GL))[hh * 128 + c];
}
DI f32x4 s4f(s16x4 v) { u32x2 u = __builtin_bit_cast(u32x2, v); f32x4 r; r[0] = bflo(u.x); r[1] = bfhi(u.x); r[2] = bflo(u.y); r[3] = bfhi(u.y); return r; }

DI void scan_item(const Params& p, int it) {
  const int lane = otid() & 63, q = lane >> 4, cl = lane & 15;
  const int hh = it >> 2, j = it & 3;
  f32x4 S[4];
#pragma unroll
  for (int rt = 0; rt < 4; ++rt) S[rt] = (f32x4){0.f, 0.f, 0.f, 0.f};
  bf16_t* OD = (bf16_t*)(p.ws + O_OD);
  float* SSQ = (float*)(p.ws + O_SSQ);
#ifndef SCAN_PREFETCH
#define SCAN_PREFETCH 1
#endif
  ScanRegs cur, nxt;
  if (SCAN_PREFETCH) scan_load(p, hh, j, 0, lane, cur);
  for (int c = 0; c < 128; ++c) {
    if (SCAN_PREFETCH) {
      scan_load(p, hh, j, (c + 1 < 128) ? c + 1 : c, lane, nxt);
      asm volatile("" : "+v"(S[0][0]) :: "memory");
    } else {
      scan_load(p, hh, j, c, lane, cur);
    }
    bf16x8 bfr[2];
#pragma unroll
    for (int ks = 0; ks < 2; ++ks) {
      u32x4 u; u.x = pk2(S[2 * ks][0], S[2 * ks][1]); u.y = pk2(S[2 * ks][2], S[2 * ks][3]); u.z = pk2(S[2 * ks + 1][0], S[2 * ks + 1][1]); u.w = pk2(S[2 * ks + 1][2], S[2 * ks + 1][3]);
      bfr[ks] = __builtin_bit_cast(bf16x8, u);
    }
    f32x4 aP[4], aO[4];
#pragma unroll
    for (int rt = 0; rt < 4; ++rt) {
      aP[rt] = (f32x4){0.f, 0.f, 0.f, 0.f};
      aO[rt] = s4f(cur.o0[rt]);
#pragma unroll
      for (int ks = 0; ks < 2; ++ks) { aP[rt] = MFMA16(cur.pf[rt][ks], bfr[ks], aP[rt]); aO[rt] = MFMA16(cur.qe[rt][ks], bfr[ks], aO[rt]); }
    }
#pragma unroll
    for (int rt = 0; rt < 4; ++rt) S[rt] = S[rt] * cur.gl - aP[rt] + s4f(cur.bc[rt]);
#pragma unroll
    for (int rt = 0; rt < 4; ++rt)
#pragma unroll
      for (int e = 0; e < 4; ++e) {
        const int tok = c * 64 + 16 * rt + 4 * q + e;
        const float v = aO[rt][e];
        OD[(size_t)tok * 384 + hh * 64 + 16 * j + cl] = f2bf(v);
        const float ss = row16_sum(v * v);
        if (cl == 0) SSQ[(tok * 6 + hh) * 4 + j] = ss;
      }
    if (SCAN_PREFETCH) cur = nxt;
  }
}

DI void scan_block(const Params& p, int hh, unsigned char* smem) {
  const int tid = otid(), lane = tid & 63, j = tid >> 6, q = lane >> 4, cl = lane & 15;
  const unsigned char* src = p.ws + O_DPREP + (size_t)hh * 128 * 32768;
  bf16_t* ostg = (bf16_t*)(smem + 65536);
  bf16x8 R0[8], R1[8];
  auto gld = [&](int c, bf16x8 (&R)[8]) {
    c = c < 128 ? c : 127;
    const unsigned char* b = src + (size_t)c * 32768 + tid * 16;
#pragma unroll
    for (int i = 0; i < 8; ++i) R[i] = *(const bf16x8*)(b + i * 4096);
  };
  auto lst = [&](int buf, const bf16x8 (&R)[8]) {
    unsigned char* d = smem + buf * 32768 + tid * 16;
#pragma unroll
    for (int i = 0; i < 8; ++i) *(bf16x8*)(d + i * 4096) = R[i];
  };
  const float* GL = (const float*)(p.ws + O_GL) + hh * 128;
  const float gl_lo = GL[lane], gl_hi = GL[64 + lane];
  f32x4 S[4];
#pragma unroll
  for (int rt = 0; rt < 4; ++rt) S[rt] = (f32x4){0.f, 0.f, 0.f, 0.f};
  bf16_t* OD = (bf16_t*)(p.ws + O_OD);
  float* SSQ = (float*)(p.ws + O_SSQ);
  f32x4 aO[4];
  auto flush = [&](int cp) {
    const int row = tid >> 2, part = tid & 3;
    const bf16x8 v0 = *(const bf16x8*)(ostg + row * 72 + 16 * part), v1 = *(const bf16x8*)(ostg + row * 72 + 16 * part + 8);
    float f[16]; unpk8(v0, f); unpk8(v1, f + 8);
    float ss = 0.f;
#pragma unroll
    for (int e = 0; e < 16; ++e) ss += f[e] * f[e];
    const int tok = cp * 64 + row;
    bf16_t* dst = OD + (size_t)tok * 384 + hh * 64 + 16 * part;
    *(bf16x8*)dst = v0; *(bf16x8*)(dst + 8) = v1;
    SSQ[(tok * 6 + hh) * 4 + part] = ss;
  };
  auto compute = [&](int buf, int c) {
    const unsigned char* base = smem + buf * 32768;
    const float gl = __builtin_bit_cast(float, __builtin_amdgcn_readlane(__builtin_bit_cast(int, c < 64 ? gl_lo : gl_hi), c & 63));
    bf16x8 bfr[2];
#pragma unroll
    for (int ks = 0; ks < 2; ++ks) {
      u32x4 u; u.x = pk2(S[2 * ks][0], S[2 * ks][1]); u.y = pk2(S[2 * ks][2], S[2 * ks][3]); u.z = pk2(S[2 * ks + 1][0], S[2 * ks + 1][1]); u.w = pk2(S[2 * ks + 1][2], S[2 * ks + 1][3]);
      bfr[ks] = __builtin_bit_cast(bf16x8, u);
    }
    f32x4 aP[4];
#pragma unroll
    for (int rt = 0; rt < 4; ++rt) {
      aP[rt] = (f32x4){0.f, 0.f, 0.f, 0.f};
      aO[rt] = s4f(*(const s16x4*)(base + 24576 + ((j * 4 + rt) * 64 + lane) * 8));
#pragma unroll
      for (int ks = 0; ks < 2; ++ks) {
        aP[rt] = MFMA16(*(const bf16x8*)(base + ((rt * 2 + ks) * 64 + lane) * 16), bfr[ks], aP[rt]);
        aO[rt] = MFMA16(*(const bf16x8*)(base + 8192 + ((rt * 2 + ks) * 64 + lane) * 16), bfr[ks], aO[rt]);
      }
    }
#pragma unroll
    for (int rt = 0; rt < 4; ++rt) S[rt] = S[rt] * gl - aP[rt] + s4f(*(const s16x4*)(base + 16384 + ((j * 4 + rt) * 64 + lane) * 8));
  };
  auto stage_out = [&]() {
#pragma unroll
    for (int rt = 0; rt < 4; ++rt)
#pragma unroll
      for (int e = 0; e < 4; ++e) ostg[(16 * rt + 4 * q + e) * 72 + 16 * j + cl] = f2bf(aO[rt][e]);
  };
  __builtin_amdgcn_s_setprio(3);
  gld(0, R0); gld(1, R1);
  lst(0, R0); gld(2, R0);
  sub_sync();
#pragma unroll 1
  for (int c = 0; c < 128; c += 2) {
    lst(1, R1);
    gld(c + 3, R1);
    if (c > 0) flush(c - 1);
    compute(0, c);
    sub_sync();
    stage_out();
    sub_sync();
    lst(0, R0);
    gld(c + 4, R0);
    flush(c);
    compute(1, c + 1);
    sub_sync();
    stage_out();
    sub_sync();
  }
  flush(127);
  sub_sync();
  __builtin_amdgcn_s_setprio(0);
}

DI void phase3(const Params& p, int half, unsigned* ctr, const unsigned* kmaxu, unsigned char* smem, int sub, int limit = 1 << 30) {
  const int tid = otid(), wave = tid >> 6;
  const int hb = (int)blockIdx.x, x = hb & 7, bi = hb >> 3;
  if (hb < 3 && limit >= 0) { if (PH(5)) scan_block(p, hb * 2 + sub, smem); }
  if (bi >= 1 && limit != 0) {
    const int nlw = ((int)(gridDim.x >> 3) - 1) * 8, lw = ((bi - 1) * 2 + sub) * 4 + wave;
    if (x < 6) {
      const int hh = x;
      constexpr int NG = 992, NOWN = 256, NB_ = 640, NTOT = NG + NOWN + NB_;
      for (int pos0 = lw; pos0 < NTOT; pos0 += nlw) {
        int pos = __builtin_amdgcn_readfirstlane(pos0);
        if (pos < NG) { if (PH(6)) moba_gather(p, (((pos >> 1) * 6 + hh) << 1) | (pos & 1), smem); continue; }
        pos -= NG;
        if (pos < NOWN) { if (PH(6)) moba_own(p, pos * 6 + hh); continue; }
        pos -= NOWN;
        const int g = pos < 512 ? (pos >> 8) : 2, w = pos < 512 ? (pos & 255) : 2 * (pos - 512);
        if (PH(8)) dil_item(p, g * 1536 + hh * 256 + w);
      }
    } else {
      const int h0 = (x - 6) * 3;
      constexpr int NE = 512, NC = 768, NB2 = 384, NTOT = NE + NC + NB2;
      for (int pos0 = lw; pos0 < NTOT; pos0 += nlw) {
        int pos = __builtin_amdgcn_readfirstlane(pos0);
        if (pos < NE) { if (PH(7)) mem_item(p, half, (x - 6) * 512 + pos); continue; }
        pos -= NE;
        if (pos < NC) { if (PH(9)) fox_item(p, (pos & 255) * 6 + h0 + (pos >> 8), kmaxu); continue; }
        pos -= NC;
        if (PH(8)) dil_item(p, 2 * 1536 + (h0 + (pos >> 7)) * 256 + 2 * (pos & 127) + 1);
      }
    }
  }
}

DI void gbuild_chunk(const Params& p, int layer, int tok, int c8) {
  const unsigned char* ws = p.ws;
  const int n = c8 / 48, c = (c8 % 48) * 8;
  if (n == 2 || n == 4) return;
  bf16_t* szp = (bf16_t*)(p.ws + O_SZ) + (size_t)tok * 1920 + n * 384 + c;
  float o[8], z[8];
  unpk8(*(const bf16x8*)szp, z);
  if (n == 1) {
    const int hh = c >> 6;
    const float* st = (const float*)(ws + O_STB);
    float mg[3], lg[3];
#pragma unroll
    for (int g = 0; g < 3; ++g) { const f32x2 s2 = *(const f32x2*)(st + ((size_t)(g * TH + tok) * 6 + hh) * 2); mg[g] = s2[0]; lg[g] = s2[1]; }
    const float mm = fmaxf(mg[0], fmaxf(mg[1], mg[2]));
    float wg[3], ws_ = 0.f;
#pragma unroll
    for (int g = 0; g < 3; ++g) { wg[g] = exp2f(mg[g] - mm) * lg[g]; ws_ += wg[g]; }
    const float inv = 1.f / ws_;
#pragma unroll
    for (int e = 0; e < 8; ++e) o[e] = 0.f;
#pragma unroll
    for (int g = 0; g < 3; ++g) {
      float t[8]; unpk8(*(const bf16x8*)((const bf16_t*)(ws + O_OB + g * SZ_O) + (size_t)tok * 384 + c), t);
      const float wgi = wg[g] * inv;
#pragma unroll
      for (int e = 0; e < 8; ++e) o[e] += wgi * t[e];
    }
  } else if (n == 3) {
    const int hh = c >> 6;
    const f32x4 sq = *(const f32x4*)((const float*)(ws + O_SSQ) + ((size_t)tok * 6 + hh) * 4);
    const float rs = rsqrtf((sq[0] + sq[1] + sq[2] + sq[3]) * (1.f / 64.f) + 1e-6f);
    unpk8(*(const bf16x8*)((const bf16_t*)(ws + O_OD) + (size_t)tok * 384 + c), o);
    const float* gw = p.gdn_w + layer * 64 + (c & 63);
#pragma unroll
    for (int e = 0; e < 8; ++e) o[e] *= rs * gw[e];
  } else if (n == 0) {
    const int hh = c >> 6;
    const float* st = (const float*)(ws + O_STA);
    float mg[4], lg[4], mm = -1e30f;
#pragma unroll
    for (int g = 0; g < 4; ++g) { const f32x2 s2 = *(const f32x2*)(st + ((size_t)(g * TH + tok) * 6 + hh) * 2); mg[g] = s2[0]; lg[g] = s2[1]; mm = fmaxf(mm, mg[g]); }
    float wg[4], ws_ = 0.f;
#pragma unroll
    for (int g = 0; g < 4; ++g) { wg[g] = exp2f(mg[g] - mm) * lg[g]; ws_ += wg[g]; }
    const float inv = 1.f / ws_;
#pragma unroll
    for (int e = 0; e < 8; ++e) o[e] = 0.f;
#pragma unroll
    for (int g = 0; g < 4; ++g) {
      if (lg[g] > 0.f) {
        float t[8]; unpk8(*(const bf16x8*)((const bf16_t*)(ws + O_OA + g * SZ_O) + (size_t)tok * 384 + c), t);
        const float wgi = wg[g] * inv;
#pragma unroll
        for (int e = 0; e < 8; ++e) o[e] += wgi * t[e];
      }
    }
  } else {
    const size_t off = (n == 2) ? O_OC : O_OE;
    unpk8(*(const bf16x8*)((const bf16_t*)(ws + off) + (size_t)tok * 384 + c), o);
  }
#pragma unroll
  for (int e = 0; e < 8; ++e) o[e] *= z[e];
  *(bf16x8*)szp = pk8(o);
}

DI void p4a_tile(const Params& p, int layer, int mt, int nt, unsigned char* smem) {
  sub_sync();
  bf16_t* As = (bf16_t*)smem; bf16_t* Bs = As + 2 * 9216;
  const int tid = otid(), lane = tid & 63, wave = tid >> 6, wr = wave >> 1, wc = wave & 1, r = lane & 31, h = lane >> 5;
  const int m0 = mt * 128, n0 = nt * 128;
  f32x16 tot[2][2]; zero_acc(tot);
  const bf16_t* SIG = (const bf16_t*)(p.ws + O_SIG);
  for (int n = 0; n < 5; ++n) {
    f32x16 acc[2][2]; zero_acc(acc);
    PlainA al{(const bf16_t*)(p.ws + O_SZ) + n * 384, 1920};
    gemm_kloop_t<32>(al, (const bf16_t*)(p.ws + O_WTBR) + (size_t)(layer * 5 + n) * 1024 * 384, 384, 12, m0, n0, acc, As, Bs);
#pragma unroll
    for (int mi = 0; mi < 2; ++mi) {
      const int tok = m0 + wr * 64 + mi * 32 + r;
#pragma unroll
      for (int ni = 0; ni < 2; ++ni)
#pragma unroll
        for (int g = 0; g < 4; ++g) {
          const int col = n0 + wc * 64 + ni * 32 + 8 * g + 4 * h;
          const u32x2 sg = *(const u32x2*)(SIG + (size_t)tok * 5120 + n * 1024 + col);
          tot[mi][ni][4 * g] += bflo(sg.x) * acc[mi][ni][4 * g];
          tot[mi][ni][4 * g + 1] += bfhi(sg.x) * acc[mi][ni][4 * g + 1];
          tot[mi][ni][4 * g + 2] += bflo(sg.y) * acc[mi][ni][4 * g + 2];
          tot[mi][ni][4 * g + 3] += bfhi(sg.y) * acc[mi][ni][4 * g + 3];
          asm volatile("" ::: "memory");
        }
    }
  }
  bf16_t* YM = (bf16_t*)(p.ws + O_YM);
  {
    bf16_t* stg = (bf16_t*)smem + wave * (64 * 72);
#pragma unroll
    for (int ni = 0; ni < 2; ++ni)
#pragma unroll
      for (int mi = 0; mi < 2; ++mi)
#pragma unroll
        for (int g = 0; g < 4; ++g)
          *(u32x2*)(stg + (mi * 32 + r) * 72 + ni * 32 + 8 * g + 4 * h) = pk4(tot[mi][ni][4 * g], tot[mi][ni][4 * g + 1], tot[mi][ni][4 * g + 2], tot[mi][ni][4 * g + 3]);
    asm volatile("s_waitcnt lgkmcnt(0)" ::: "memory");
    __builtin_amdgcn_wave_barrier();
    const int tok0 = m0 + wr * 64, col0 = n0 + wc * 64;
#pragma unroll
    for (int it = 0; it < 8; ++it) {
      const int row = it * 8 + (lane >> 3), ch = (lane & 7) * 8;
      const bf16x8 val = *(const bf16x8*)(stg + row * 72 + ch);
      *(bf16x8*)(YM + (size_t)(tok0 + row) * 1024 + col0 + ch) = val;
    }
  }
}

DI void p4b_tile(const Params& p, int layer, int half, int mt, int nt, unsigned char* smem) {
  bf16_t* As = (bf16_t*)smem; bf16_t* Bs = As + 2 * 9216;
  const int tid = otid(), lane = tid & 63, wave = tid >> 6, wr = wave >> 1, wc = wave & 1, r = lane & 31, h = lane >> 5;
  const int m0 = mt * 128, n0 = nt * 128;
  f32x16 acc[2][2]; zero_acc(acc);
  PlainA al{(const bf16_t*)(p.ws + O_YM), 1024};
  gemm_kloop(al, (const bf16_t*)(p.ws + O_WTOUT + layer * SZ_WTOUT1), 1024, 16, m0, n0, acc, As, Bs);
  const float* xin = layer == 0 ? p.x : p.out;
  const float alpha = 1.4142135623730951f;
#pragma unroll
  for (int mi = 0; mi < 2; ++mi) {
    const size_t gt = (size_t)half * TH + m0 + wr * 64 + mi * 32 + r;
#pragma unroll
    for (int ni = 0; ni < 2; ++ni)
#pragma unroll
      for (int g = 0; g < 4; ++g) {
        const int col = n0 + wc * 64 + ni * 32 + 8 * g + 4 * h;
        const f32x4 xv = *(const f32x4*)(xin + gt * 1024 + col);
        f32x4 o;
#pragma unroll
        for (int e = 0; e < 4; ++e) o[e] = alpha * xv[e] + acc[mi][ni][4 * g + e];
        *(f32x4*)(p.out + gt * 1024 + col) = o;
      }
  }
}

DI void gemm8_kloop(const bf16_t* __restrict__ Ab, int lda, const bf16_t* __restrict__ Bb, int ldb, int nkt, f32x4 (&acc)[4][4], unsigned char* lds) {
  const int tid = rtid(), wid = tid >> 6, lane = tid & 63, wr = wid >> 1, wc = wid & 1, fr = lane & 15, fq = lane >> 4;
  int aOff[4], bOff[2];
#pragma unroll
  for (int i = 0; i < 4; ++i) { int R, C; g_stage_rc(wid * 1024 + i * 8192 + lane * 16, R, C); aOff[i] = R * lda + C; }
#pragma unroll
  for (int i = 0; i < 2; ++i) { int R, C; g_stage_rc(wid * 1024 + i * 8192 + lane * 16, R, C); bOff[i] = R * ldb + C; }
  auto stage = [&](int buf, int kt) {
#pragma unroll
    for (int i = 0; i < 4; ++i)
      __builtin_amdgcn_global_load_lds((const unsigned*)(Ab + aOff[i] + kt * 64), (unsigned*)(lds + buf * 49152 + wid * 1024 + i * 8192), 16, 0, 0);
#pragma unroll
    for (int i = 0; i < 2; ++i)
      __builtin_amdgcn_global_load_lds((const unsigned*)(Bb + bOff[i] + kt * 64), (unsigned*)(lds + buf * 49152 + 32768 + wid * 1024 + i * 8192), 16, 0, 0);
  };
  const int lane_off = (fr * 64 + fq * 16) ^ ((fr >> 3) << 5);
  __syncthreads();
  stage(0, 0);
  asm volatile("s_waitcnt vmcnt(0)" ::: "memory");
  __syncthreads();
#pragma unroll 1
  for (int t = 0; t < nkt; ++t) {
    const int cur = t & 1;
    if (t + 1 < nkt) stage(cur ^ 1, t + 1);
    const unsigned char* SA = lds + cur * 49152 + wr * 8192 + lane_off;
    const unsigned char* SB = lds + cur * 49152 + 32768 + wc * 8192 + lane_off;
#pragma unroll
    for (int ks = 0; ks < 2; ++ks) {
      bf16x8 At[4], Bf[4];
#pragma unroll
      for (int n = 0; n < 4; ++n) Bf[n] = *(const bf16x8*)(SB + n * 2048 + ks * 1024);
#pragma unroll
      for (int m = 0; m < 4; ++m) At[m] = *(const bf16x8*)(SA + m * 2048 + ks * 1024);
#pragma unroll
      for (int m = 0; m < 4; ++m)
#pragma unroll
        for (int n = 0; n < 4; ++n) acc[m][n] = MFMA16(Bf[n], At[m], acc[m][n]);
    }
    asm volatile("s_waitcnt vmcnt(0)" ::: "memory");
    __syncthreads();
  }
}

DI void p4a_unit(const Params& p, int layer, int pm, int pn, unsigned char* lds) {
  const int tid = rtid(), wid = tid >> 6, lane = tid & 63, wr = wid >> 1, wc = wid & 1, fr = lane & 15, fq = lane >> 4;
  const int tok0 = pm * 256 + wr * 64, col0 = pn * 128 + wc * 64;
  const bf16_t* SIG = (const bf16_t*)(p.ws + O_SIG);
  const bf16_t* Ab = (const bf16_t*)(p.ws + O_SZ) + (size_t)pm * 256 * 1920;
  const bf16_t* Bb = (const bf16_t*)(p.ws + O_WTBR) + (size_t)layer * 5 * 1024 * 384 + (size_t)pn * 128 * 384;
  int aOff[4], bOff[2];
#pragma unroll
  for (int i = 0; i < 4; ++i) { int R, C; g_stage_rc(wid * 1024 + i * 8192 + lane * 16, R, C); aOff[i] = R * 1920 + C; }
#pragma unroll
  for (int i = 0; i < 2; ++i) { int R, C; g_stage_rc(wid * 1024 + i * 8192 + lane * 16, R, C); bOff[i] = R * 384 + C; }
  auto stage = [&](int buf, int T) {
    const int nb = T / 6, kk = T - nb * 6;
    const long bo = (long)nb * (1024 * 384) + kk * 64;
#pragma unroll
    for (int i = 0; i < 4; ++i)
      __builtin_amdgcn_global_load_lds((const unsigned*)(Ab + aOff[i] + T * 64), (unsigned*)(lds + buf * 49152 + wid * 1024 + i * 8192), 16, 0, 0);
#pragma unroll
    for (int i = 0; i < 2; ++i)
      __builtin_amdgcn_global_load_lds((const unsigned*)(Bb + bOff[i] + bo), (unsigned*)(lds + buf * 49152 + 32768 + wid * 1024 + i * 8192), 16, 0, 0);
  };
  f32x4 tot[4][4], acc[4][4];
#pragma unroll
  for (int m = 0; m < 4; ++m)
#pragma unroll
    for (int n = 0; n < 4; ++n) { tot[m][n] = (f32x4){0.f, 0.f, 0.f, 0.f}; acc[m][n] = (f32x4){0.f, 0.f, 0.f, 0.f}; }
  const int lane_off = (fr * 64 + fq * 16) ^ ((fr >> 3) << 5);
  __syncthreads();
  stage(0, 0);
  asm volatile("s_waitcnt vmcnt(0)" ::: "memory");
  __syncthreads();
#pragma unroll 1
  for (int t = 0; t < 30; ++t) {
    const int cur = t & 1;
    if (t + 1 < 30) stage(cur ^ 1, t + 1);
    const unsigned char* SA = lds + cur * 49152 + wr * 8192 + lane_off;
    const unsigned char* SB = lds + cur * 49152 + 32768 + wc * 8192 + lane_off;
#pragma unroll
    for (int ks = 0; ks < 2; ++ks) {
      bf16x8 At[4], Bf[4];
#pragma unroll
      for (int n = 0; n < 4; ++n) Bf[n] = *(const bf16x8*)(SB + n * 2048 + ks * 1024);
#pragma unroll
      for (int m = 0; m < 4; ++m) At[m] = *(const bf16x8*)(SA + m * 2048 + ks * 1024);
#pragma unroll
      for (int m = 0; m < 4; ++m)
#pragma unroll
        for (int n = 0; n < 4; ++n) acc[m][n] = MFMA16(Bf[n], At[m], acc[m][n]);
    }
    const int nb = t / 6;
    if (t - nb * 6 == 5) {
#pragma unroll
      for (int m = 0; m < 4; ++m) {
        const int tok = tok0 + m * 16 + fr;
#pragma unroll
        for (int n = 0; n < 4; ++n) {
          const u32x2 sg = *(const u32x2*)(SIG + (size_t)tok * 5120 + nb * 1024 + col0 + n * 16 + fq * 4);
          tot[m][n][0] += bflo(sg.x) * acc[m][n][0]; tot[m][n][1] += bfhi(sg.x) * acc[m][n][1];
          tot[m][n][2] += bflo(sg.y) * acc[m][n][2]; tot[m][n][3] += bfhi(sg.y) * acc[m][n][3];
          acc[m][n] = (f32x4){0.f, 0.f, 0.f, 0.f};
        }
      }
    }
    asm volatile("s_waitcnt vmcnt(0)" ::: "memory");
    __syncthreads();
  }
  bf16_t* YM = (bf16_t*)(p.ws + O_YM);
  bf16_t* stg = (bf16_t*)(lds + wid * 9216);
#pragma unroll
  for (int m = 0; m < 4; ++m)
#pragma unroll
    for (int n = 0; n < 4; ++n) *(u32x2*)(stg + (m * 16 + fr) * 72 + n * 16 + fq * 4) = pk4(tot[m][n][0], tot[m][n][1], tot[m][n][2], tot[m][n][3]);
  asm volatile("s_waitcnt lgkmcnt(0)" ::: "memory");
  __builtin_amdgcn_wave_barrier();
#pragma unroll
  for (int it = 0; it < 8; ++it) {
    const int row = it * 8 + (lane >> 3), ch = (lane & 7) * 8;
    const bf16x8 val = *(const bf16x8*)(stg + row * 72 + ch);
    *(bf16x8*)(YM + (size_t)(tok0 + row) * 1024 + col0 + ch) = val;
  }
}

DI void p4b_unit(const Params& p, int layer, int half, int pm, int pn, unsigned char* lds) {
  const int tid = rtid(), wid = tid >> 6, lane = tid & 63, wr = wid >> 1, wc = wid & 1, fr = lane & 15, fq = lane >> 4;
  f32x4 acc[4][4];
#pragma unroll
  for (int m = 0; m < 4; ++m)
#pragma unroll
    for (int n = 0; n < 4; ++n) acc[m][n] = (f32x4){0.f, 0.f, 0.f, 0.f};
  gemm8_kloop((const bf16_t*)(p.ws + O_YM) + (size_t)pm * 256 * 1024, 1024,
              (const bf16_t*)(p.ws + O_WTOUT + layer * SZ_WTOUT1) + (size_t)pn * 128 * 1024, 1024, 16, acc, lds);
  const float* xin = layer == 0 ? p.x : p.out;
  const float alpha = 1.4142135623730951f;
#pragma unroll
  for (int m = 0; m < 4; ++m) {
    const size_t gt = (size_t)half * TH + pm * 256 + wr * 64 + m * 16 + fr;
#pragma unroll
    for (int n = 0; n < 4; ++n) {
      const int col = pn * 128 + wc * 64 + n * 16 + fq * 4;
      const f32x4 xv = *(const f32x4*)(xin + gt * 1024 + col);
      f32x4 o;
#pragma unroll
      for (int e = 0; e < 4; ++e) o[e] = alpha * xv[e] + acc[m][n][e];
      *(f32x4*)(p.out + gt * 1024 + col) = o;
    }
  }
}

DI void p4c_row(const Params& p, int layer, size_t gt, bool wxb = true) {
  const int lane = otid() & 63;
  float* row = p.out + gt * 1024;
  f32x4 v[4]; float s = 0.f;
#pragma unroll
  for (int j = 0; j < 4; ++j) { v[j] = *(const f32x4*)(row + 4 * lane + 256 * j); s += v[j][0] + v[j][1] + v[j][2] + v[j][3]; }
#pragma unroll
  for (int o = 32; o >= 1; o >>= 1) s += __shfl_xor(s, o);
  const float mu = s * (1.f / 1024.f); float q = 0.f;
#pragma unroll
  for (int j = 0; j < 4; ++j) { v[j] -= mu; q += v[j][0] * v[j][0] + v[j][1] * v[j][1] + v[j][2] * v[j][2] + v[j][3] * v[j][3]; }
#pragma unroll
  for (int o = 32; o >= 1; o >>= 1) q += __shfl_xor(q, o);
  const float rs = rsqrtf(q * (1.f / 1024.f) + 1e-5f);
  bf16_t* xb = (bf16_t*)(p.ws + O_XB) + gt * 1024;
#pragma unroll
  for (int j = 0; j < 4; ++j) {
    const int c = 4 * lane + 256 * j;
    const f32x4 g = *(const f32x4*)(p.ln_g + layer * 1024 + c), b = *(const f32x4*)(p.ln_b + layer * 1024 + c);
    f32x4 y;
#pragma unroll
    for (int e = 0; e < 4; ++e) y[e] = v[j][e] * rs * g[e] + b[e];
    *(f32x4*)(row + c) = y;
    if (wxb) *(u32x2*)(xb + c) = pk4(y[0], y[1], y[2], y[3]);
  }
}


#define XB_TMO      128
#define XB_XCNT(j)  (256  + 64 * (j))
#define XB_XSUB(j)  (1280 + 64 * (j))
#define XB_XGEN(j)  (2304 + 64 * (j))
#define XB_TOP      3328
#define XB_TOPGEN   3392
#define XB_SPIN_CAP (1u << 22)
#define LAS __attribute__((address_space(3)))
DI unsigned xb_ld(unsigned* p) { return __hip_atomic_load(p, __ATOMIC_RELAXED, __HIP_MEMORY_SCOPE_AGENT); }
DI unsigned xb_add(unsigned* p, unsigned v) { return __hip_atomic_fetch_add(p, v, __ATOMIC_RELAXED, __HIP_MEMORY_SCOPE_AGENT); }
DI unsigned xb_xcc_id() { return (unsigned)__builtin_amdgcn_s_getreg((3 << 11) | 20) & 0xFu; }
#define XB_SPIN(cond, bar) do { unsigned _sp = 0; while (cond) { __builtin_amdgcn_s_sleep(1); \
    if ((++_sp & 255u) == 0u) { if (xb_ld(&(bar)[XB_TMO])) break; if (_sp > XB_SPIN_CAP) { atomicAdd(&(bar)[XB_TMO], 1u); break; } } } } while (0)
struct XcdBarrier { unsigned* bar; unsigned x; volatile LAS unsigned* st; };
DI XcdBarrier xcd_barrier_post(unsigned* bar, volatile LAS unsigned* st) {
  XcdBarrier b; b.bar = bar; b.x = xb_xcc_id(); b.st = st;
  if (threadIdx.x == 0) (void)xb_add(&bar[XB_XCNT(b.x)], 1u);
  return b;
}
DI void xcd_barrier_complete(unsigned* bar, unsigned x, unsigned& nloc, unsigned& nx) {
  const unsigned G = gridDim.x;
  unsigned sum, cnt, mine, sp = 0u;
  for (;;) {
    sum = 0u; cnt = 0u; mine = 0u;
#pragma unroll
    for (unsigned j = 0; j < 16; ++j) { const unsigned c = xb_ld(&bar[XB_XCNT(j)]); sum += c; cnt += (c > 0u) ? 1u : 0u; mine = (j == x) ? c : mine; }
    if (sum == G) break;
    __builtin_amdgcn_s_sleep(1);
    if ((++sp & 255u) == 0u) { if (xb_ld(&bar[XB_TMO])) break; if (sp > XB_SPIN_CAP) { atomicAdd(&bar[XB_TMO], 1u); break; } }
  }
  nloc = mine > 0u ? mine : 1u; nx = cnt > 0u ? cnt : 1u;
}
DI void xcd_barrier(const XcdBarrier& b) {
  asm volatile("s_waitcnt vmcnt(0)" ::: "memory");
  __syncthreads();
  if (threadIdx.x == 0) {
    unsigned* bar = b.bar;
    __builtin_amdgcn_s_waitcnt(0);
    unsigned nloc = b.st[0], nx = b.st[1];
    if (nloc == 0u) { xcd_barrier_complete(bar, b.x, nloc, nx); b.st[0] = nloc; b.st[1] = nx; }
    const unsigned old = xb_add(&bar[XB_XSUB(b.x)], 1u);
    const unsigned gen = old / nloc;
    if (old + 1u == (gen + 1u) * nloc) {
      __builtin_amdgcn_fence(__ATOMIC_RELEASE, "agent");
      asm volatile("s_waitcnt vmcnt(0)" ::: "memory");
      const unsigned og = xb_add(&bar[XB_TOP], 1u);
      const unsigned tg = og / nx;
      if (og + 1u == (tg + 1u) * nx) xb_add(&bar[XB_TOPGEN], 1u);
      else XB_SPIN(xb_ld(&bar[XB_TOPGEN]) == tg, bar);
      __builtin_amdgcn_fence(__ATOMIC_ACQUIRE, "agent");
      xb_add(&bar[XB_XGEN(b.x)], 1u);
      asm volatile("s_waitcnt vmcnt(0)" ::: "memory");
    } else {
      XB_SPIN(xb_ld(&bar[XB_XGEN(b.x)]) == gen, bar);
      __builtin_amdgcn_fence(__ATOMIC_ACQUIRE, "agent");
      asm volatile("s_waitcnt vmcnt(0)" ::: "memory");
    }
  }
  __syncthreads();
}

#ifdef PROBE_A
#define STAMP(k) do { if (blockIdx.x == 0 && otid() == 0) { unsigned long long now_ = __builtin_amdgcn_s_memrealtime(); tsacc[k] += (float)(now_ - tlast) * 0.01f; tlast = now_; } } while (0)
#else
#define STAMP(k) do {} while (0)
#endif
__global__ void __launch_bounds__(512, 2) mega(Params p) {
  extern __shared__ __attribute__((aligned(16))) unsigned char smem_all[];
  cg::grid_group grid = cg::this_grid();
  if (p.ws == nullptr) grid.sync();
  volatile LAS unsigned* xbst = (volatile LAS unsigned*)(smem_all + 2 * SUB_LDS);
  if (threadIdx.x < 4) xbst[threadIdx.x] = 0u;
  __syncthreads();
  const XcdBarrier xb = xcd_barrier_post((unsigned*)(p.ws + O_BAR), xbst);
#define GSYNC() xcd_barrier(xb)
  const int sub = __builtin_amdgcn_readfirstlane(__builtin_amdgcn_workitem_id_x() >> 8);
  unsigned char* smem = smem_all + sub * SUB_LDS;
  const int vb = (int)blockIdx.x * 2 + sub, vgrid = (int)gridDim.x * 2;
  const int wave = otid() >> 6;
  const int gw = vb * 4 + wave, ngw = vgrid * 4;
  phase0(p, smem, vb, vgrid);
  GSYNC();
  int pend_layer = -1, pend_half = 0;
  for (int itn = 0; itn < 4; ++itn) {
    const int layer = itn >> 1, half = itn & 1;
    if (pend_layer >= 0) { for (int rw = gw; rw < TH; rw += ngw) p4c_row(p, pend_layer, (size_t)pend_half * TH + rw, true); pend_layer = -1; }
    for (int t = (int)blockIdx.x; t < 32 * 54; t += (int)gridDim.x) {
      const int tn = t + (int)gridDim.x;
      p1_unit(p, layer, half, t & 31, t >> 5, tn < 32 * 54 ? (tn & 31) : 0, tn < 32 * 54 ? (tn >> 5) : -1, t == (int)blockIdx.x, smem_all);
    }
    GSYNC();
    {
      constexpr int N_FOX = 6, N_GDN = 768, N_MKV = 12, N_KM = 48, TOT = N_FOX + N_GDN + N_MKV + N_KM;
      for (int t = vb; t < TOT; t += vgrid) {
        int i = t;
        if (i < N_FOX) { fox_prep(p, i, smem); continue; }
        i -= N_FOX;
        if (i < N_GDN) { gdn_prep(p, layer, half, i / 128, i % 128, smem); continue; }
        i -= N_GDN;
        if (i < N_MKV) { memkv_tile(p, layer, half, i / 6, i % 6, smem); continue; }
        i -= N_MKV;
        kmean_prep(p, i * 4 + wave, (unsigned*)(p.ws + O_CTL) + 64 + (layer * 2 + half) * 8);
      }
    }
    for (int a = gw; a < 1536; a += ngw) moba_select(p, a);
    GSYNC();
    phase3(p, half, (unsigned*)(p.ws + O_CTL) + layer * 2 + half, (const unsigned*)(p.ws + O_CTL) + 64 + (layer * 2 + half) * 8, smem, sub);
    GSYNC();
    for (int ci = vb * 256 + otid(); ci < TH * 240; ci += vgrid * 256) gbuild_chunk(p, layer, ci / 240, ci % 240);
    GSYNC();
    for (int t = (int)blockIdx.x; t < 256; t += (int)gridDim.x) p4a_unit(p, layer, t & 31, t >> 5, smem_all);
    GSYNC();
    for (int t = (int)blockIdx.x; t < 256; t += (int)gridDim.x) p4b_unit(p, layer, half, t & 31, t >> 5, smem_all);
    GSYNC();
    pend_layer = layer; pend_half = half;
  }
  if (pend_layer >= 0) { for (int rw = gw; rw < TH; rw += ngw) p4c_row(p, pend_layer, (size_t)pend_half * TH + rw, true); }
}

extern "C" void kernel_launch(void* const* d_in, const int* in_sizes, int n_in, void* d_out, int out_size, void* d_ws, size_t ws_size,
                              hipStream_t stream) {
  static int grid_blocks = 0;
  if (grid_blocks == 0) {
    if (ws_size < WS_END) { fprintf(stderr, "workspace too small: %zu < %zu\n", ws_size, (size_t)WS_END); grid_blocks = -1; return; }
    int dev = 0, cus = 0, per_cu = 0;
    (void)hipGetDevice(&dev);
    (void)hipDeviceGetAttribute(&cus, hipDeviceAttributeMultiprocessorCount, dev);
    (void)hipFuncSetAttribute((const void*)mega, hipFuncAttributeMaxDynamicSharedMemorySize, LDS_BYTES);
    (void)hipOccupancyMaxActiveBlocksPerMultiprocessor(&per_cu, (const void*)mega, 512, LDS_BYTES);
    if (per_cu < 1) per_cu = 1;
    if (per_cu > 1) per_cu = 1;
    grid_blocks = cus * per_cu;
  }
  if (grid_blocks < 0) return;
  (void)hipMemsetAsync((char*)d_ws + O_CTL, 0, 32768, stream);
  Params p{};
  p.x = (const float*)d_in[0]; p.mem = (const float*)d_in[1]; p.mem_g = (const float*)d_in[2]; p.mem_b = (const float*)d_in[3];
  p.w_in = (const float*)d_in[4]; p.b_in = (const float*)d_in[5]; p.conv_w = (const float*)d_in[6]; p.a_log = (const float*)d_in[7];
  p.dt_bias = (const float*)d_in[8]; p.gdn_w = (const float*)d_in[9]; p.w_kv = (const float*)d_in[10]; p.w_br = (const float*)d_in[11];
  p.w_out = (const float*)d_in[12]; p.ln_g = (const float*)d_in[13]; p.ln_b = (const float*)d_in[14];
  p.out = (float*)d_out; p.ws = (unsigned char*)d_ws;
  void* args[] = {&p};
  hipError_t e = hipLaunchCooperativeKernel((const void*)mega, dim3(grid_blocks), dim3(512), args, LDS_BYTES, stream);
  if (e != hipSuccess) fprintf(stderr, "cooperative launch failed: %s (grid %d)\n", hipGetErrorString(e), grid_blocks);
}
```

```cpp
#include <hip/hip_runtime.h>
#include <hip/hip_cooperative_groups.h>
#include <cstdio>
#include <cstdint>
namespace cg = cooperative_groups;

#define DI __device__ __forceinline__
typedef unsigned short bf16_t;
typedef short bf16x8 __attribute__((ext_vector_type(8)));
typedef short s16x4 __attribute__((ext_vector_type(4)));
typedef float f32x4 __attribute__((ext_vector_type(4)));
typedef float f32x2 __attribute__((ext_vector_type(2)));
typedef float f32x16 __attribute__((ext_vector_type(16)));
typedef unsigned u32x2 __attribute__((ext_vector_type(2)));
typedef unsigned u32x4 __attribute__((ext_vector_type(4)));
typedef __bf16 bfv2 __attribute__((ext_vector_type(2)));

#define MFMA32(a, b, c) __builtin_amdgcn_mfma_f32_32x32x16_bf16((a), (b), (c), 0, 0, 0)
#define MFMA16(a, b, c) __builtin_amdgcn_mfma_f32_16x16x32_bf16((a), (b), (c), 0, 0, 0)

DI unsigned pk2(float a, float b) { f32x2 v = {a, b}; return __builtin_bit_cast(unsigned, __builtin_convertvector(v, bfv2)); }
DI bf16_t f2bf(float a) { return (bf16_t)(pk2(a, 0.f) & 0xffffu); }
DI float bf2f(bf16_t v) { return __uint_as_float(((unsigned)v) << 16); }
DI float bflo(unsigned u) { return __uint_as_float(u << 16); }
DI float bfhi(unsigned u) { return __uint_as_float(u & 0xffff0000u); }
DI int rtid() { int t = __builtin_amdgcn_workitem_id_x(); asm volatile("" : "+v"(t)); return t; }
DI int otid() { return rtid() & 255; }
extern __shared__ __attribute__((aligned(16))) unsigned char g_lds_all[];
#define LAS3 __attribute__((address_space(3)))
DI void sub_sync() {
  asm volatile("s_waitcnt lgkmcnt(0)" ::: "memory");
  const int t = __builtin_amdgcn_workitem_id_x();
  LAS3 unsigned* c = (LAS3 unsigned*)(g_lds_all + 2 * 75776 + 8) + (t >> 8);
  if ((t & 63) == 0) {
    const unsigned old = __hip_atomic_fetch_add(c, 1u, __ATOMIC_RELAXED, __HIP_MEMORY_SCOPE_WORKGROUP);
    const unsigned target = (old / 4u + 1u) * 4u;
    while (__hip_atomic_load(c, __ATOMIC_RELAXED, __HIP_MEMORY_SCOPE_WORKGROUP) < target) __builtin_amdgcn_s_sleep(1);
  }
  asm volatile("s_waitcnt lgkmcnt(0)" ::: "memory");
}
DI int crow(int i, int h) { return (i & 3) + 8 * (i >> 2) + 4 * h; }
DI float fsigmoid(float v) { return __builtin_amdgcn_rcpf(1.f + __expf(-v)); }
DI float fsilu(float v) { return v * fsigmoid(v); }
DI u32x2 pk4(float a, float b, float c, float d) { u32x2 r; r.x = pk2(a, b); r.y = pk2(c, d); return r; }
DI bf16x8 pk8(const float* v) { u32x4 r; r.x = pk2(v[0], v[1]); r.y = pk2(v[2], v[3]); r.z = pk2(v[4], v[5]); r.w = pk2(v[6], v[7]); return __builtin_bit_cast(bf16x8, r); }
DI void unpk8(bf16x8 x, float* v) { u32x4 u = __builtin_bit_cast(u32x4, x); v[0] = bflo(u.x); v[1] = bfhi(u.x); v[2] = bflo(u.y); v[3] = bfhi(u.y); v[4] = bflo(u.z); v[5] = bfhi(u.z); v[6] = bflo(u.w); v[7] = bfhi(u.w); }

constexpr int NB = 2, SQ = 8192, NT = NB * SQ, DM = 1024, NH = 6, BW = 384;
constexpr int TH = 8192;
constexpr int NP = 13824;
constexpr int DIN = 13586;
constexpr float LOG2E = 1.4426950408889634f;
#define NEG_INF (-__builtin_inff())

constexpr int C_AQK = 0, C_AV = 768, C_BQK = 1152, C_BV = 3456, C_CQK = 3840, C_CV = 4608, C_D = 4992, C_E = 6144, C_SM = 6528, C_SMEND = 6546, C_Z = 6656, C_MG = 8576;

__host__ __device__ constexpr int inmap(int n) {
  return n < 4992 ? n : n < 6144 ? n + 6 : n < 6528 ? n + 18 : n < 6534 ? n - 1536 : n < 6546 ? n - 384 : n < 6656 ? -1 : n < 13696 ? n - 110 : -1;
}

constexpr size_t O_CTL = 0;
constexpr size_t O_BAR = 4096;
constexpr size_t O_WTIN = 32768;
constexpr size_t SZ_WTIN1 = (size_t)NP * 1024 * 2;
constexpr size_t O_WTBR = O_WTIN + 2 * SZ_WTIN1;
constexpr size_t SZ_WTBR1 = (size_t)5 * 1024 * 384 * 2;
constexpr size_t O_WTOUT = O_WTBR + 2 * SZ_WTBR1;
constexpr size_t SZ_WTOUT1 = (size_t)1024 * 1024 * 2;
constexpr size_t O_WTKV = O_WTOUT + 2 * SZ_WTOUT1;
constexpr size_t SZ_WTKV1 = (size_t)768 * 1024 * 2;
constexpr size_t O_BIASP = O_WTKV + 2 * SZ_WTKV1;
constexpr size_t O_XB = O_BIASP + (size_t)2 * NP * 4;
constexpr size_t O_MEMN = O_XB + (size_t)NT * 1024 * 2;
constexpr size_t O_MEMK = O_MEMN + (size_t)512 * 1024 * 2;
constexpr size_t O_MEMVT = O_MEMK + (size_t)512 * 384 * 2;
constexpr size_t O_QKA = O_MEMVT + (size_t)512 * 384 * 2;
constexpr size_t SZ_VT = (size_t)384 * TH * 2;
constexpr size_t O_KFA = O_QKA + SZ_VT;
constexpr size_t O_VTA = O_KFA + SZ_VT;
constexpr size_t O_QKB = O_VTA + SZ_VT;
constexpr size_t O_KFB = O_QKB + 3 * SZ_VT;
constexpr size_t O_VTB = O_KFB + 3 * SZ_VT;
constexpr size_t O_QKC = O_VTB + 3 * SZ_VT;
constexpr size_t O_KFC = O_QKC + SZ_VT;
constexpr size_t O_VTC = O_KFC + SZ_VT;
constexpr size_t O_QKVD = O_VTC + SZ_VT;
constexpr size_t O_QE = O_QKVD + (size_t)TH * 1152 * 2;
constexpr size_t O_SM = O_QE + (size_t)TH * 384 * 2;
constexpr size_t O_FF = O_SM + (size_t)TH * 32 * 4;
constexpr size_t O_KM = O_FF + (size_t)6 * TH * 4;
constexpr size_t O_KMAX = O_KM + (size_t)2 * 6 * 32 * 64 * 2;
constexpr size_t O_GL = O_KMAX + 256;
constexpr size_t O_MASK = O_GL + 6 * 128 * 4;
constexpr size_t O_KSUM = O_MASK + (size_t)TH * 8 * 4;
constexpr size_t O_DPREP = O_KSUM + (size_t)32 * 2 * 384 * 4;
constexpr size_t O_SZ = O_DPREP + (size_t)768 * 32768;
constexpr size_t O_SIG = O_SZ + (size_t)TH * 1920 * 2;
constexpr size_t O_OA = O_SIG + (size_t)TH * 5120 * 2;
constexpr size_t SZ_O = (size_t)TH * 384 * 2;
constexpr size_t O_STA = O_OA + 4 * SZ_O;
constexpr size_t O_OB = O_STA + (size_t)4 * TH * 6 * 2 * 4;
constexpr size_t O_STB = O_OB + 3 * SZ_O;
constexpr size_t O_OC = O_STB + (size_t)3 * TH * 6 * 2 * 4;
constexpr size_t O_OD = O_OC + SZ_O;
constexpr size_t O_SSQ = O_OD + SZ_O;
constexpr size_t O_OE = O_SSQ + (size_t)TH * 6 * 4 * 4;
constexpr size_t WS_END = O_OE + SZ_O;
constexpr size_t O_YM = O_QKB;
static_assert(WS_END < (size_t)443 * 1000 * 1000, "workspace too large");

struct Params {
  const float *x, *mem, *mem_g, *mem_b, *w_in, *b_in, *conv_w, *a_log, *dt_bias, *gdn_w, *w_kv, *w_br, *w_out, *ln_g, *ln_b;
  float* out;
  unsigned char* ws;
};

constexpr int SUB_LDS = 75776;
constexpr int LDS_BYTES = 2 * SUB_LDS + 16;
#ifndef PH_MASK
#define PH_MASK 0xFFFF
#endif
#define PH(x) ((PH_MASK >> (x)) & 1)
#ifndef REP_MASK
#define REP_MASK 0
#endif
#define REP(x) (1 + ((REP_MASK >> (x)) & 1))

DI void transpose_tile(const float* __restrict__ src, int ld, int k0, int n0, bool usemap, bf16_t* __restrict__ dst, int dstld, float* tile) {
  const int tid = otid();
#pragma unroll
  for (int it = 0; it < 16; ++it) {
    const int kk = (tid >> 6) + 4 * it, n2 = (tid & 63) * 2;
    const int sc = usemap ? inmap(n0 + n2) : (n0 + n2);
    f32x2 v = {0.f, 0.f};
    if (sc >= 0) v = *(const f32x2*)(src + (size_t)(k0 + kk) * ld + sc);
    *(f32x2*)(tile + kk * 130 + n2) = v;
  }
  sub_sync();
#pragma unroll
  for (int it = 0; it < 4; ++it) {
    const int nn = (tid >> 3) + 32 * it, kc = (tid & 7) * 8;
    float v[8];
#pragma unroll
    for (int e = 0; e < 8; ++e) v[e] = tile[(kc + e) * 130 + nn];
    *(bf16x8*)(dst + (size_t)(n0 + nn) * dstld + k0 + kc) = pk8(v);
  }
  sub_sync();
}

DI void transpose_in_pair(const Params& p, int iA, int iB, float* tile) {
  const int tid = otid();
  const float* srcA; const float* srcB; bf16_t* dstA; bf16_t* dstB; int k0A, n0A, k0B, n0B;
  { const int l = iA / (108 * 16), rr = iA % (108 * 16); srcA = p.w_in + (size_t)l * 1024 * DIN; dstA = (bf16_t*)(p.ws + O_WTIN + l * SZ_WTIN1); n0A = (rr / 16) * 128; k0A = (rr % 16) * 64; }
  const bool hasB = iB >= 0;
  { const int i = hasB ? iB : iA; const int l = i / (108 * 16), rr = i % (108 * 16); srcB = p.w_in + (size_t)l * 1024 * DIN; dstB = (bf16_t*)(p.ws + O_WTIN + l * SZ_WTIN1); n0B = (rr / 16) * 128; k0B = (rr % 16) * 64; }
  float* tileB = tile + 64 * 130;
  f32x2 va[16], vb2[16];
#pragma unroll
  for (int it = 0; it < 16; ++it) {
    const int kk = (tid >> 6) + 4 * it, n2 = (tid & 63) * 2;
    const int scA = inmap(n0A + n2), scB = inmap(n0B + n2);
    va[it] = (f32x2){0.f, 0.f}; vb2[it] = (f32x2){0.f, 0.f};
    if (scA >= 0) va[it] = *(const f32x2*)(srcA + (size_t)(k0A + kk) * DIN + scA);
    if (scB >= 0) vb2[it] = *(const f32x2*)(srcB + (size_t)(k0B + kk) * DIN + scB);
  }
#pragma unroll
  for (int it = 0; it < 16; ++it) {
    const int kk = (tid >> 6) + 4 * it, n2 = (tid & 63) * 2;
    *(f32x2*)(tile + kk * 130 + n2) = va[it];
    *(f32x2*)(tileB + kk * 130 + n2) = vb2[it];
  }
  sub_sync();
#pragma unroll
  for (int it = 0; it < 4; ++it) {
    const int nn = (tid >> 3) + 32 * it, kc = (tid & 7) * 8;
    float v[8], w[8];
#pragma unroll
    for (int e = 0; e < 8; ++e) { v[e] = tile[(kc + e) * 130 + nn]; w[e] = tileB[(kc + e) * 130 + nn]; }
    *(bf16x8*)(dstA + (size_t)(n0A + nn) * 1024 + k0A + kc) = pk8(v);
    if (hasB) *(bf16x8*)(dstB + (size_t)(n0B + nn) * 1024 + k0B + kc) = pk8(w);
  }
  sub_sync();
}

DI void phase0(const Params& p, unsigned char* smem, int vb, int vgrid) {
  float* tile = (float*)smem;
  const int tid = otid(), lane = tid & 63, wave = tid >> 6;
  constexpr int N_TIN = 2 * 108 * 16, N_TBR = 2 * 5 * 8 * 6, N_TOUT = 2 * 8 * 16, N_TKV = 2 * 6 * 16, N_XB = 1024, N_MEMN = 128, N_BIAS = 108;
  constexpr int TOT = N_TIN + N_TBR + N_TOUT + N_TKV + N_XB + N_MEMN + N_BIAS;
  for (int it = vb; it < N_TIN; it += 2 * vgrid) transpose_in_pair(p, it, it + vgrid < N_TIN ? it + vgrid : -1, tile);
  for (int it = vb; it < TOT - N_TIN; it += vgrid) {
    int i = it;
    if (i < N_TBR) {
      const int ln = i / 48, rr = i % 48, nt = rr / 6, kt = rr % 6;
      transpose_tile(p.w_br + (size_t)ln * 384 * 1024, 1024, kt * 64, nt * 128, false, (bf16_t*)(p.ws + O_WTBR) + (size_t)ln * 1024 * 384, 384, tile);
      continue;
    }
    i -= N_TBR;
    if (i < N_TOUT) {
      const int l = i / 128, rr = i % 128, nt = rr / 16, kt = rr % 16;
      transpose_tile(p.w_out + (size_t)l * 1024 * 1024, 1024, kt * 64, nt * 128, false, (bf16_t*)(p.ws + O_WTOUT + l * SZ_WTOUT1), 1024, tile);
      continue;
    }
    i -= N_TOUT;
    if (i < N_TKV) {
      const int l = i / 96, rr = i % 96, nt = rr / 16, kt = rr % 16;
      transpose_tile(p.w_kv + (size_t)l * 1024 * 768, 768, kt * 64, nt * 128, false, (bf16_t*)(p.ws + O_WTKV + l * SZ_WTKV1), 1024, tile);
      continue;
    }
    i -= N_TKV;
    if (i < N_XB) {
      const float* src = p.x + (size_t)i * 16 * 1024;
      bf16_t* dst = (bf16_t*)(p.ws + O_XB) + (size_t)i * 16 * 1024;
#pragma unroll
      for (int j = 0; j < 16; ++j) {
        const int e = (j * 256 + tid) * 4;
        const f32x4 v = *(const f32x4*)(src + e);
        *(u32x2*)(dst + e) = pk4(v[0], v[1], v[2], v[3]);
      }
      continue;
    }
    i -= N_XB;
    if (i < N_MEMN) {
      const int row = i * 4 + wave;
      const float* src = p.mem + (size_t)row * 1024;
      f32x4 v[4]; float s = 0.f;
#pragma unroll
      for (int j = 0; j < 4; ++j) { v[j] = *(const f32x4*)(src + 4 * lane + 256 * j); s += v[j][0] + v[j][1] + v[j][2] + v[j][3]; }
#pragma unroll
      for (int o = 32; o >= 1; o >>= 1) s += __shfl_xor(s, o);
      const float mu = s * (1.f / 1024.f); float q = 0.f;
#pragma unroll
      for (int j = 0; j < 4; ++j) { v[j] -= mu; q += v[j][0] * v[j][0] + v[j][1] * v[j][1] + v[j][2] * v[j][2] + v[j][3] * v[j][3]; }
#pragma unroll
      for (int o = 32; o >= 1; o >>= 1) q += __shfl_xor(q, o);
      const float rs = rsqrtf(q * (1.f / 1024.f) + 1e-5f);
      bf16_t* dst = (bf16_t*)(p.ws + O_MEMN) + (size_t)row * 1024;
#pragma unroll
      for (int j = 0; j < 4; ++j) {
        const int c = 4 * lane + 256 * j;
        const f32x4 g = *(const f32x4*)(p.mem_g + c), b = *(const f32x4*)(p.mem_b + c);
        *(u32x2*)(dst + c) = pk4(v[j][0] * rs * g[0] + b[0], v[j][1] * rs * g[1] + b[1], v[j][2] * rs * g[2] + b[2], v[j][3] * rs * g[3] + b[3]);
      }
      continue;
    }
    i -= N_MEMN;
    {
      float* bp = (float*)(p.ws + O_BIASP);
      if (tid < 128) {
        const int n = i * 128 + tid;
        const int sc = inmap(n);
        for (int l = 0; l < 2; ++l) bp[l * NP + n] = sc >= 0 ? p.b_in[l * DIN + sc] : 0.f;
      }
    }
  }
}

template <int BK, class AL>
DI void gemm_kloop_t(const AL& al, const bf16_t* __restrict__ Bt, int ldb, int nkt, int m0, int n0, f32x16 (&acc)[2][2], bf16_t* As, bf16_t* Bs) {
  constexpr int CPR = BK / 8, NCH = BK / 16, PITCH = BK + 8, BUF = 128 * PITCH;
  const int tid = otid(), lane = tid & 63, wave = tid >> 6, wr = wave >> 1, wc = wave & 1, r = lane & 31, h = lane >> 5;
  bf16x8 ra[NCH], rb[NCH];
  auto gload = [&](int kt) {
#pragma unroll
    for (int i = 0; i < NCH; ++i) {
      const int cid = tid + 256 * i, row = cid / CPR, kc = (cid % CPR) * 8;
      ra[i] = al(m0 + row, kt * BK + kc);
      rb[i] = *(const bf16x8*)(Bt + (size_t)(n0 + row) * ldb + kt * BK + kc);
    }
  };
  auto lstore = [&](int buf) {
#pragma unroll
    for (int i = 0; i < NCH; ++i) {
      const int cid = tid + 256 * i, row = cid / CPR, kc = (cid % CPR) * 8;
      *(bf16x8*)(As + buf * BUF + row * PITCH + kc) = ra[i];
      *(bf16x8*)(Bs + buf * BUF + row * PITCH + kc) = rb[i];
    }
  };
  gload(0); lstore(0); sub_sync();
  for (int kt = 0; kt < nkt; ++kt) {
    const int buf = kt & 1;
    if (kt + 1 < nkt) gload(kt + 1);
    asm volatile("" ::: "memory");
    const bf16_t* a_ = As + buf * BUF + (wr * 64 + r) * PITCH + 8 * h;
    const bf16_t* b_ = Bs + buf * BUF + (wc * 64 + r) * PITCH + 8 * h;
#pragma unroll
    for (int s = 0; s < BK / 16; ++s) {
      bf16x8 af[2], bfr[2];
      af[0] = *(const bf16x8*)(a_ + 16 * s); af[1] = *(const bf16x8*)(a_ + 32 * PITCH + 16 * s);
      bfr[0] = *(const bf16x8*)(b_ + 16 * s); bfr[1] = *(const bf16x8*)(b_ + 32 * PITCH + 16 * s);
#pragma unroll
      for (int mi = 0; mi < 2; ++mi)
#pragma unroll
        for (int ni = 0; ni < 2; ++ni) acc[mi][ni] = MFMA32(bfr[ni], af[mi], acc[mi][ni]);
    }
    if (kt + 1 < nkt) lstore(buf ^ 1);
    sub_sync();
  }
}
template <class AL>
DI void gemm_kloop(const AL& al, const bf16_t* __restrict__ Bt, int ldb, int nkt, int m0, int n0, f32x16 (&acc)[2][2], bf16_t* As, bf16_t* Bs) {
  gemm_kloop_t<64>(al, Bt, ldb, nkt, m0, n0, acc, As, Bs);
}

DI void zero_acc(f32x16 (&acc)[2][2]) {
#pragma unroll
  for (int a = 0; a < 2; ++a)
#pragma unroll
    for (int b = 0; b < 2; ++b)
#pragma unroll
      for (int i = 0; i < 16; ++i) acc[a][b][i] = 0.f;
}

DI int vfrag_key(int key) { const int kk = key & 31; return (key >> 5) * 2048 + (kk >> 4) * 512 + ((kk >> 2) & 1) * 256 + ((kk >> 3) & 1) * 4 + (kk & 3); }
DI int vfrag_col(int cw) { const int d = cw & 63; return (cw >> 6) * 524288 + (d >> 5) * 1024 + (d & 31) * 8; }

DI int kfrag_key(int key) { return (key >> 5) * 2048 + (key & 31) * 8; }
DI int kfrag_col(int cw) { const int d = cw & 63; return (cw >> 6) * 524288 + (d >> 4) * 512 + ((d >> 3) & 1) * 256 + (d & 7); }

struct PlainA {
  const bf16_t* A; int lda;
  DI bf16x8 operator()(int row, int k) const { return *(const bf16x8*)(A + (size_t)row * lda + k); }
};

DI void p1_tile(const Params& p, int layer, int half, int mt, int nt, unsigned char* smem) {
  sub_sync();
  bf16_t* As = (bf16_t*)smem; bf16_t* Bs = As + 2 * 9216;
  f32x16 acc[2][2]; zero_acc(acc);
  PlainA al{(const bf16_t*)(p.ws + O_XB) + (size_t)half * TH * 1024, 1024};
  const int m0 = mt * 128, n0 = nt * 128;
  gemm_kloop(al, (const bf16_t*)(p.ws + O_WTIN + layer * SZ_WTIN1), 1024, 16, m0, n0, acc, As, Bs);
  const int tid = otid(), lane = tid & 63, wave = tid >> 6, wr = wave >> 1, wc = wave & 1, r = lane & 31, h = lane >> 5;
  const float* bias = (const float*)(p.ws + O_BIASP) + layer * NP;
  unsigned char* ws = p.ws;
  {
    const int nb0 = n0 + wc * 64;
    bf16_t* dst0 = nullptr; int pitch0 = 0, coff0 = 0, xf0 = 0;
    if (nb0 < 384) { dst0 = (bf16_t*)(ws + O_QKA); pitch0 = 384; coff0 = nb0; }
    else if (nb0 >= C_BQK && nb0 < 2304) { dst0 = (bf16_t*)(ws + O_QKB); pitch0 = 1152; coff0 = nb0 - C_BQK; }
    else if (nb0 >= C_CQK && nb0 < 4224) { dst0 = (bf16_t*)(ws + O_QKC); pitch0 = 384; coff0 = nb0 - C_CQK; }
    else if (nb0 >= C_D && nb0 < C_E) { dst0 = (bf16_t*)(ws + O_QKVD); pitch0 = 1152; coff0 = nb0 - C_D; }
    else if (nb0 >= C_E && nb0 < C_SM) { dst0 = (bf16_t*)(ws + O_QE); pitch0 = 384; coff0 = nb0 - C_E; }
    else if (nb0 >= C_Z && nb0 < C_MG) { dst0 = (bf16_t*)(ws + O_SZ); pitch0 = 1920; coff0 = nb0 - C_Z; xf0 = 1; }
    else if (nb0 >= C_MG) { dst0 = (bf16_t*)(ws + O_SIG); pitch0 = 5120; coff0 = nb0 - C_MG; xf0 = 2; }
    if (dst0 != nullptr) {
      bf16_t* stg = (bf16_t*)smem + wave * (64 * 72);
#pragma unroll
      for (int ni = 0; ni < 2; ++ni)
#pragma unroll
        for (int mi = 0; mi < 2; ++mi)
#pragma unroll
          for (int g = 0; g < 4; ++g) {
            const int cq = ni * 32 + 8 * g + 4 * h;
            const f32x4 bv = *(const f32x4*)(bias + nb0 + cq);
            float v[4];
#pragma unroll
            for (int e = 0; e < 4; ++e) v[e] = acc[mi][ni][4 * g + e] + bv[e];
            if (xf0 == 1) {
#pragma unroll
              for (int e = 0; e < 4; ++e) v[e] = fsilu(v[e]);
            } else if (xf0 == 2) {
#pragma unroll
              for (int e = 0; e < 4; ++e) v[e] = fsigmoid(v[e]);
            }
            *(u32x2*)(stg + (mi * 32 + r) * 72 + cq) = pk4(v[0], v[1], v[2], v[3]);
          }
      asm volatile("s_waitcnt lgkmcnt(0)" ::: "memory");
      __builtin_amdgcn_wave_barrier();
      const int tok0 = m0 + wr * 64;
#pragma unroll
      for (int it = 0; it < 8; ++it) {
        const int row = it * 8 + (lane >> 3), ch = (lane & 7) * 8;
        const bf16x8 val = *(const bf16x8*)(stg + row * 72 + ch);
        *(bf16x8*)(dst0 + (size_t)(tok0 + row) * pitch0 + coff0 + ch) = val;
      }
      return;
    }
  }
#pragma unroll
  for (int ni = 0; ni < 2; ++ni) {
    const int nb = n0 + wc * 64 + ni * 32;
    int kind;
    int xf = 0;
    bf16_t* dst = nullptr; int pitch = 0, coff = 0;
    int kgrp = 0;
    if (nb < 384) { kind = 0; dst = (bf16_t*)(ws + O_QKA); pitch = 384; coff = nb; }
    else if (nb < C_AV) { kind = 5; dst = (bf16_t*)(ws + O_KFA); coff = nb - 384; }
    else if (nb < C_BQK) { kind = 1; dst = (bf16_t*)(ws + O_VTA); coff = nb - C_AV; }
    else if (nb < 2304) { kind = 0; dst = (bf16_t*)(ws + O_QKB); pitch = 1152; coff = nb - C_BQK; }
    else if (nb < C_BV) { kind = 5; kgrp = (nb - 2304) / 384; dst = (bf16_t*)(ws + O_KFB + kgrp * SZ_VT); coff = (nb - 2304) - kgrp * 384; }
    else if (nb < C_CQK) { kind = 2; dst = (bf16_t*)(ws + O_VTB); coff = nb - C_BV; }
    else if (nb < 4224) { kind = 0; dst = (bf16_t*)(ws + O_QKC); pitch = 384; coff = nb - C_CQK; }
    else if (nb < C_CV) { kind = 5; dst = (bf16_t*)(ws + O_KFC); coff = nb - 4224; }
    else if (nb < C_D) { kind = 1; dst = (bf16_t*)(ws + O_VTC); coff = nb - C_CV; }
    else if (nb < C_E) { kind = 0; dst = (bf16_t*)(ws + O_QKVD); pitch = 1152; coff = nb - C_D; }
    else if (nb < C_SM) { kind = 0; dst = (bf16_t*)(ws + O_QE); pitch = 384; coff = nb - C_E; }
    else if (nb < C_Z) { kind = (nb == C_SM) ? 3 : 4; }
    else if (nb < C_MG) { kind = 0; xf = 1; dst = (bf16_t*)(ws + O_SZ); pitch = 1920; coff = nb - C_Z; }
    else { kind = 0; xf = 2; dst = (bf16_t*)(ws + O_SIG); pitch = 5120; coff = nb - C_MG; }
    if (kind == 4) continue;
#pragma unroll
    for (int mi = 0; mi < 2; ++mi) {
      const int tok = m0 + wr * 64 + mi * 32 + r;
#pragma unroll
      for (int g = 0; g < 4; ++g) {
        const int cq = 8 * g + 4 * h;
        const f32x4 bv = *(const f32x4*)(bias + nb + cq);
        float v[4];
#pragma unroll
        for (int e = 0; e < 4; ++e) v[e] = acc[mi][ni][4 * g + e] + bv[e];
        if (kind == 0) {
          if (xf == 1) {
#pragma unroll
            for (int e = 0; e < 4; ++e) v[e] = fsilu(v[e]);
          } else if (xf == 2) {
#pragma unroll
            for (int e = 0; e < 4; ++e) v[e] = fsigmoid(v[e]);
          }
          *(u32x2*)(dst + (size_t)tok * pitch + coff + cq) = pk4(v[0], v[1], v[2], v[3]);
        } else if (kind == 5) {
          const int key = kgrp == 0 ? tok : kgrp == 1 ? (tok & 3) * 2048 + (tok >> 2) : (tok & 15) * 512 + (tok >> 4);
          *(u32x2*)(dst + kfrag_col(coff + cq) + kfrag_key(key)) = pk4(v[0], v[1], v[2], v[3]);
        } else if (kind == 1) {
          const int ko = vfrag_key(tok);
#pragma unroll
          for (int e = 0; e < 4; ++e) dst[vfrag_col(coff + cq + e) + ko] = f2bf(v[e]);
        } else if (kind == 2) {
          const int k1 = vfrag_key(tok), k4 = vfrag_key((tok & 3) * 2048 + (tok >> 2)), k16 = vfrag_key((tok & 15) * 512 + (tok >> 4));
#pragma unroll
          for (int e = 0; e < 4; ++e) {
            const bf16_t b = f2bf(v[e]); const int co = vfrag_col(coff + cq + e);
            dst[co + k1] = b; dst[SZ_VT / 2 + co + k4] = b; dst[SZ_VT + co + k16] = b;
          }
        } else {
          float* sm = (float*)(ws + O_SM);
#pragma unroll
          for (int e = 0; e < 4; ++e) if (cq + e < 18) sm[tok * 32 + cq + e] = v[e];
        }
      }
    }
  }
}


DI int g_lds_byte(int r, int c) { const int st = (r >> 4) * 2 + (c >> 5), ob = (r & 15) * 64 + (c & 31) * 2; return st * 1024 + (ob ^ (((ob >> 9) & 1) << 5)); }
DI void g_stage_rc(int b, int& R, int& C) { const int st = b >> 10, sb = b & 1023, swz = sb ^ (((sb >> 9) & 1) << 5); R = (st >> 1) * 16 + (swz >> 6); C = (st & 1) * 32 + ((swz & 63) >> 1); }

DI float row16_sum(float v);
DI void p1_unit(const Params& p, int layer, int half, int pm, int pn, int pm_next, int pn_next  , bool first, unsigned char* lds) {
  const int tid = rtid(), wid = tid >> 6, lane = tid & 63, wr = wid >> 2, wc = wid & 3, fr = lane & 15, fq = lane >> 4;
  const bf16_t* Ab = (const bf16_t*)(p.ws + O_XB) + ((size_t)half * TH + (size_t)pm * 256) * 1024;
  const bf16_t* Bb = (const bf16_t*)(p.ws + O_WTIN + layer * SZ_WTIN1) + (size_t)pn * 256 * 1024;
  int sOff[4];
#pragma unroll
  for (int i = 0; i < 4; ++i) { int R, C; g_stage_rc(wid * 1024 + i * 8192 + lane * 16, R, C); sOff[i] = R * 1024 + C; }
  auto stage2 = [&](const bf16_t* A_, const bf16_t* B_, int buf, int kt) {
#pragma unroll
    for (int i = 0; i < 4; ++i) {
      __builtin_amdgcn_global_load_lds((const unsigned*)(A_ + sOff[i] + kt * 64), (unsigned*)(lds + buf * 65536 + wid * 1024 + i * 8192), 16, 0, 0);
      __builtin_amdgcn_global_load_lds((const unsigned*)(B_ + sOff[i] + kt * 64), (unsigned*)(lds + buf * 65536 + 32768 + wid * 1024 + i * 8192), 16, 0, 0);
    }
  };
  auto stage = [&](int buf, int kt) { stage2(Ab, Bb, buf, kt); };
  f32x4 acc[8][4];
#pragma unroll
  for (int m = 0; m < 8; ++m)
#pragma unroll
    for (int n = 0; n < 4; ++n) acc[m][n] = (f32x4){0.f, 0.f, 0.f, 0.f};
  const int lane_off = (fr * 64 + fq * 16) ^ ((fr >> 3) << 5);
  if (first) { __syncthreads(); stage(0, 0); }
  asm volatile("s_waitcnt vmcnt(0)" ::: "memory");
  __syncthreads();
#pragma unroll 1
  for (int t = 0; t < 16; ++t) {
    const int cur = t & 1;
    {
      const bool last = (t + 1 == 16);
      if (!last || pn_next >= 0) {
        const long dA = last ? (long)(pm_next - pm) * 256 * 1024 - 0 : (long)(t + 1) * 64;
        const long dB = last ? (long)(pn_next - pn) * 256 * 1024 - 0 : (long)(t + 1) * 64;
#pragma unroll
        for (int i = 0; i < 4; ++i) {
          __builtin_amdgcn_global_load_lds((const unsigned*)(Ab + sOff[i] + dA), (unsigned*)(lds + (cur ^ 1) * 65536 + wid * 1024 + i * 8192), 16, 0, 0);
          __builtin_amdgcn_global_load_lds((const unsigned*)(Bb + sOff[i] + dB), (unsigned*)(lds + (cur ^ 1) * 65536 + 32768 + wid * 1024 + i * 8192), 16, 0, 0);
        }
      }
    }
    const unsigned char* SA = lds + cur * 65536 + wr * 16384 + lane_off;
    const unsigned char* SB = lds + cur * 65536 + 32768 + wc * 8192 + lane_off;
    bf16x8 Bf[2][4], At[2][2];
#pragma unroll
    for (int n = 0; n < 4; ++n) Bf[0][n] = *(const bf16x8*)(SB + n * 2048);
#pragma unroll
    for (int m = 0; m < 2; ++m) At[0][m] = *(const bf16x8*)(SA + m * 2048);
#pragma unroll
    for (int g = 0; g < 8; ++g) {
      const int ks = g >> 2, pr = g & 3;
      if (g == 1) {
#pragma unroll
        for (int n = 0; n < 4; ++n) Bf[1][n] = *(const bf16x8*)(SB + n * 2048 + 1024);
      }
      if (g < 7) {
        const int g1 = g + 1;
#pragma unroll
        for (int m = 0; m < 2; ++m) At[g1 & 1][m] = *(const bf16x8*)(SA + ((g1 & 3) * 2 + m) * 2048 + (g1 >> 2) * 1024);
      }
      asm volatile("" : "+v"(acc[pr * 2][0][0]) :: "memory");
#pragma unroll
      for (int m = 0; m < 2; ++m)
#pragma unroll
        for (int n = 0; n < 4; ++n) acc[pr * 2 + m][n] = MFMA16(Bf[ks][n], At[g & 1][m], acc[pr * 2 + m][n]);
    }
    asm volatile("s_waitcnt vmcnt(0)" ::: "memory");
    __syncthreads();
  }
  const int nb0 = pn * 256 + wc * 64, tok0 = pm * 256 + wr * 128;
  const float* bias = (const float*)(p.ws + O_BIASP) + layer * NP;
  unsigned char* ws = p.ws;
  int kind, xf = 0, kgrp = 0, pitch = 0, coff = 0; bf16_t* dst = nullptr;
  if (nb0 < 384) { kind = 0; dst = (bf16_t*)(ws + O_QKA); pitch = 384; coff = nb0; }
  else if (nb0 < C_AV) { kind = 5; dst = (bf16_t*)(ws + O_KFA); coff = nb0 - 384; }
  else if (nb0 < C_BQK) { kind = 1; dst = (bf16_t*)(ws + O_VTA); coff = nb0 - C_AV; }
  else if (nb0 < 2304) { kind = 0; dst = (bf16_t*)(ws + O_QKB); pitch = 1152; coff = nb0 - C_BQK; }
  else if (nb0 < C_BV) { kind = 5; kgrp = (nb0 - 2304) / 384; dst = (bf16_t*)(ws + O_KFB + kgrp * SZ_VT); coff = (nb0 - 2304) - kgrp * 384; }
  else if (nb0 < C_CQK) { kind = 2; dst = (bf16_t*)(ws + O_VTB); coff = nb0 - C_BV; }
  else if (nb0 < 4224) { kind = 0; dst = (bf16_t*)(ws + O_QKC); pitch = 384; coff = nb0 - C_CQK; }
  else if (nb0 < C_CV) { kind = 5; dst = (bf16_t*)(ws + O_KFC); coff = nb0 - 4224; }
  else if (nb0 < C_D) { kind = 1; dst = (bf16_t*)(ws + O_VTC); coff = nb0 - C_CV; }
  else if (nb0 < C_E) { kind = 0; dst = (bf16_t*)(ws + O_QKVD); pitch = 1152; coff = nb0 - C_D; }
  else if (nb0 < C_SM) { kind = 0; dst = (bf16_t*)(ws + O_QE); pitch = 384; coff = nb0 - C_E; }
  else if (nb0 < C_Z) { kind = (nb0 == C_SM) ? 3 : 4; }
  else if (nb0 < C_MG) { kind = 0; xf = 1; dst = (bf16_t*)(ws + O_SZ); pitch = 1920; coff = nb0 - C_Z; }
  else if (nb0 < 13696) { kind = 0; xf = 2; dst = (bf16_t*)(ws + O_SIG); pitch = 5120; coff = nb0 - C_MG; }
  else { kind = 4; }
  if (kind == 4) return;
  if (kind == 0) {
    bf16_t* stg = (bf16_t*)(lds + 65536 + wid * 9216);
#pragma unroll
    for (int mh = 0; mh < 2; ++mh) {
#pragma unroll
      for (int m = 0; m < 4; ++m)
#pragma unroll
        for (int n = 0; n < 4; ++n) {
          const int c4 = n * 16 + fq * 4;
          const f32x4 bv = *(const f32x4*)(bias + nb0 + c4);
          float v[4];
#pragma unroll
          for (int e = 0; e < 4; ++e) v[e] = acc[mh * 4 + m][n][e] + bv[e];
          if (xf == 1) {
#pragma unroll
            for (int e = 0; e < 4; ++e) v[e] = fsilu(v[e]);
          } else if (xf == 2) {
#pragma unroll
            for (int e = 0; e < 4; ++e) v[e] = fsigmoid(v[e]);
          }
          *(u32x2*)(stg + (m * 16 + fr) * 72 + c4) = pk4(v[0], v[1], v[2], v[3]);
        }
      asm volatile("s_waitcnt lgkmcnt(0)" ::: "memory");
      __builtin_amdgcn_wave_barrier();
#pragma unroll
      for (int it = 0; it < 8; ++it) {
        const int row = it * 8 + (lane >> 3), ch = (lane & 7) * 8;
        const bf16x8 val = *(const bf16x8*)(stg + row * 72 + ch);
        *(bf16x8*)(dst + (size_t)(tok0 + mh * 64 + row) * pitch + coff + ch) = val;
      }
      asm volatile("s_waitcnt lgkmcnt(0)" ::: "memory");
      __builtin_amdgcn_wave_barrier();
    }
    return;
  }
  if (nb0 >= 384 && nb0 < C_AV) {
    float* ksum = (float*)(ws + O_KSUM) + (size_t)(pm * 2 + wr) * 384 + (nb0 - 384);
#pragma unroll
    for (int n = 0; n < 4; ++n) {
      const f32x4 bv = *(const f32x4*)(bias + nb0 + n * 16 + fq * 4);
#pragma unroll
      for (int e = 0; e < 4; ++e) {
        float t = 8.f * bv[e];
#pragma unroll
        for (int m = 0; m < 8; ++m) t += acc[m][n][e];
        t = row16_sum(t);
        if (fr == 0) ksum[n * 16 + fq * 4 + e] = t;
      }
    }
  }
#pragma unroll
  for (int m = 0; m < 8; ++m) {
    const int tok = tok0 + m * 16 + fr;
#pragma unroll
    for (int n = 0; n < 4; ++n) {
      const int c4 = n * 16 + fq * 4;
      const f32x4 bv = *(const f32x4*)(bias + nb0 + c4);
      float v[4];
#pragma unroll
      for (int e = 0; e < 4; ++e) v[e] = acc[m][n][e] + bv[e];
      if (kind == 5) {
        const int key = kgrp == 0 ? tok : kgrp == 1 ? (tok & 3) * 2048 + (tok >> 2) : (tok & 15) * 512 + (tok >> 4);
        *(u32x2*)(dst + kfrag_col(coff + c4) + kfrag_key(key)) = pk4(v[0], v[1], v[2], v[3]);
      } else if (kind == 1) {
        const int ko = vfrag_key(tok);
#pragma unroll
        for (int e = 0; e < 4; ++e) dst[vfrag_col(coff + c4 + e) + ko] = f2bf(v[e]);
      } else if (kind == 2) {
        const int k1 = vfrag_key(tok), k4 = vfrag_key((tok & 3) * 2048 + (tok >> 2)), k16 = vfrag_key((tok & 15) * 512 + (tok >> 4));
#pragma unroll
        for (int e = 0; e < 4; ++e) {
          const bf16_t b = f2bf(v[e]); const int co = vfrag_col(coff + c4 + e);
          dst[co + k1] = b; dst[SZ_VT / 2 + co + k4] = b; dst[SZ_VT + co + k16] = b;
        }
      } else {
        float* sm = (float*)(ws + O_SM);
#pragma unroll
        for (int e = 0; e < 4; ++e) if (c4 + e < 18) sm[tok * 32 + c4 + e] = v[e];
      }
    }
  }
}

DI void fox_prep(const Params& p, int hh, unsigned char* smem) {
  float* red = (float*)smem;
  const int tid = otid(), lane = tid & 63, wave = tid >> 6;
  const float* sm = (const float*)(p.ws + O_SM);
  float* FF = (float*)(p.ws + O_FF) + hh * TH;
  float loc[32];
#pragma unroll
  for (int j = 0; j < 32; ++j) loc[j] = sm[(tid * 32 + j) * 32 + hh];
  float s = 0.f;
#pragma unroll
  for (int j = 0; j < 32; ++j) { const float xv = loc[j]; s += fminf(xv, 0.f) - log1pf(expf(-fabsf(xv))); loc[j] = s; }
  float inc = s;
#pragma unroll
  for (int o = 1; o < 64; o <<= 1) { const float t = __shfl_up(inc, o); if (lane >= o) inc += t; }
  if (lane == 63) red[wave] = inc;
  sub_sync();
  float off = inc - s;
  for (int w = 0; w < wave; ++w) off += red[w];
#pragma unroll
  for (int j4 = 0; j4 < 8; ++j4) {
    f32x4 o4 = {off + loc[4 * j4], off + loc[4 * j4 + 1], off + loc[4 * j4 + 2], off + loc[4 * j4 + 3]};
    *(f32x4*)(FF + tid * 32 + 4 * j4) = o4;
  }
  sub_sync();
}

DI void kmean_prep(const Params& p, int idx, unsigned* kmaxu) {
  const int lane = otid() & 63;
  const int hh = idx / 32, blk = idx % 32;
  const bf16_t* kc = (const bf16_t*)(p.ws + O_KFC) + (size_t)hh * 524288;
  float mx = 0.f;
#pragma unroll
  for (int t = 0; t < 4; ++t) {
    const int key = blk * 256 + lane * 4 + t;
    float kk = 0.f;
#pragma unroll
    for (int c = 0; c < 8; ++c) { float v[8]; unpk8(*(const bf16x8*)(kc + kfrag_key(key) + c * 256), v);
#pragma unroll
      for (int e = 0; e < 8; ++e) kk += v[e] * v[e]; }
    mx = fmaxf(mx, kk);
  }
#pragma unroll
  for (int o = 32; o >= 1; o >>= 1) mx = fmaxf(mx, __shfl_xor(mx, o));
  if (lane == 0) atomicMax(kmaxu + hh, __float_as_uint(mx));
}

DI void memkv_tile(const Params& p, int layer, int half, int mt, int nt, unsigned char* smem) {
  bf16_t* As = (bf16_t*)smem; bf16_t* Bs = As + 2 * 9216;
  f32x16 acc[2][2]; zero_acc(acc);
  PlainA al{(const bf16_t*)(p.ws + O_MEMN) + (size_t)half * 256 * 1024, 1024};
  const int m0 = mt * 128, n0 = nt * 128;
  gemm_kloop(al, (const bf16_t*)(p.ws + O_WTKV + layer * SZ_WTKV1), 1024, 16, m0, n0, acc, As, Bs);
  const int tid = otid(), lane = tid & 63, wave = tid >> 6, wr = wave >> 1, wc = wave & 1, r = lane & 31, h = lane >> 5;
  bf16_t* mk = (bf16_t*)(p.ws + O_MEMK); bf16_t* mv = (bf16_t*)(p.ws + O_MEMVT);
#pragma unroll
  for (int ni = 0; ni < 2; ++ni)
#pragma unroll
    for (int mi = 0; mi < 2; ++mi) {
      const int m = m0 + wr * 64 + mi * 32 + r;
#pragma unroll
      for (int i = 0; i < 16; ++i) {
        const int col = n0 + wc * 64 + ni * 32 + crow(i, h);
        const bf16_t b = f2bf(acc[mi][ni][i]);
        if (col < 384) { const int hd = col / 96, d = col % 96; mk[(size_t)((half * 4 + hd) * 8 + (m >> 5)) * 3072 + (d >> 4) * 512 + ((d >> 3) & 1) * 256 + (m & 31) * 8 + (d & 7)] = b; }
        else { const int cc = col - 384, hd = cc / 96, d = cc % 96, kk = m & 31;
          mv[(size_t)((half * 4 + hd) * 8 + (m >> 5)) * 3072 + (d >> 5) * 1024 + (kk >> 4) * 512 + ((kk >> 2) & 1) * 256 + (d & 31) * 8 + ((kk >> 3) & 1) * 4 + (kk & 3)] = b; }
      }
    }
}

DI f32x16 mm_quad(const bf16_t* A, const bf16_t* B, int wr, int wc, int r, int h) {
  f32x16 acc;
#pragma unroll
  for (int i = 0; i < 16; ++i) acc[i] = 0.f;
  const bf16_t* a_ = A + (wr * 32 + r) * 72 + 8 * h;
  const bf16_t* b_ = B + (wc * 32 + r) * 72 + 8 * h;
#pragma unroll
  for (int s = 0; s < 4; ++s) acc = MFMA32(*(const bf16x8*)(a_ + 16 * s), *(const bf16x8*)(b_ + 16 * s), acc);
  return acc;
}

DI void gdn_prep(const Params& p, int layer, int half, int hh, int c, unsigned char* smem) {
  bf16_t* QN = (bf16_t*)smem; bf16_t* KN = QN + 4608; bf16_t* KB = KN + 4608; bf16_t* KDT = KB + 4608; bf16_t* VBT = KDT + 4608;
  bf16_t* KBET = VBT + 4608; bf16_t* QKm = KBET + 4608; bf16_t* Tm = QKm + 4608;
  float* gcv = (float*)(smem + 73728); float* betav = gcv + 64; float* egc = gcv + 128;
  float* Mf = (float*)(smem + 9216);
  bf16_t* UT = KN; bf16_t* WT = KB;
  int tid = otid();
  int lane = tid & 63, wave = tid >> 6, wr = wave >> 1, wc = wave & 1, r = lane & 31, h = lane >> 5;
#define REOPAQUE() do { asm volatile("" : "+v"(tid)); lane = tid & 63; wave = tid >> 6; wr = wave >> 1; wc = wave & 1; r = lane & 31; h = lane >> 5; } while (0)
  const float* sm = (const float*)(p.ws + O_SM);
  if (wave == 0) {
    const int tok = c * 64 + lane;
    const float bt = fsigmoid(sm[tok * 32 + 6 + hh]);
    const float xv = sm[tok * 32 + 12 + hh] + p.dt_bias[layer * 6 + hh];
    const float sp = fmaxf(xv, 0.f) + log1pf(expf(-fabsf(xv)));
    float g = -expf(p.a_log[layer * 6 + hh]) * sp;
#pragma unroll
    for (int o = 1; o < 64; o <<= 1) { const float t = __shfl_up(g, o); if (lane >= o) g += t; }
    gcv[lane] = g; betav[lane] = bt; egc[lane] = expf(g);
    if (lane == 63) ((float*)(p.ws + O_GL))[hh * 128 + c] = expf(g);
  }
  sub_sync();
  REOPAQUE();
  {
    const int t = tid >> 2, cg4 = tid & 3, ch0 = cg4 * 16;
    const bf16_t* src = (const bf16_t*)(p.ws + O_QKVD);
    const float* cw = p.conv_w + (size_t)layer * 4 * 1152;
    const float bt = betav[t], gct = gcv[t], eg = egc[t], ed = expf(gcv[63] - gct);
    auto convpart = [&](int pt, float (&val)[16]) {
      const int col = pt * 384 + hh * 64 + ch0;
#pragma unroll
      for (int e = 0; e < 16; ++e) val[e] = 0.f;
#pragma unroll
      for (int j = 0; j < 4; ++j) {
        const int row = c * 64 + t - 3 + j;
        if (row >= 0) {
          float xv[16];
          unpk8(*(const bf16x8*)(src + (size_t)row * 1152 + col), xv);
          unpk8(*(const bf16x8*)(src + (size_t)row * 1152 + col + 8), xv + 8);
#pragma unroll
          for (int e4 = 0; e4 < 4; ++e4) {
            const f32x4 w4 = *(const f32x4*)(cw + j * 1152 + col + 4 * e4);
#pragma unroll
            for (int e = 0; e < 4; ++e) val[4 * e4 + e] += w4[e] * xv[4 * e4 + e];
          }
        }
      }
#pragma unroll
      for (int e = 0; e < 16; ++e) val[e] = fsilu(val[e]);
    };
    {
      float val[16]; convpart(0, val);
      float sq = 0.f;
#pragma unroll
      for (int e = 0; e < 16; ++e) sq += val[e] * val[e];
      sq += __shfl_xor(sq, 1); sq += __shfl_xor(sq, 2);
      const float rq = rsqrtf(sq + 1e-6f) * 0.125f;
#pragma unroll
      for (int e = 0; e < 16; ++e) val[e] *= rq;
      *(bf16x8*)(QN + t * 72 + ch0) = pk8(val); *(bf16x8*)(QN + t * 72 + ch0 + 8) = pk8(val + 8);
    }
    asm volatile("" ::: "memory");
    {
      float val[16]; convpart(1, val);
      float sk = 0.f;
#pragma unroll
      for (int e = 0; e < 16; ++e) sk += val[e] * val[e];
      sk += __shfl_xor(sk, 1); sk += __shfl_xor(sk, 2);
      const float rk = rsqrtf(sk + 1e-6f);
      float kb[16];
#pragma unroll
      for (int e = 0; e < 16; ++e) { val[e] *= rk; kb[e] = val[e] * bt; }
      *(bf16x8*)(KN + t * 72 + ch0) = pk8(val); *(bf16x8*)(KN + t * 72 + ch0 + 8) = pk8(val + 8);
      *(bf16x8*)(KB + t * 72 + ch0) = pk8(kb); *(bf16x8*)(KB + t * 72 + ch0 + 8) = pk8(kb + 8);
#pragma unroll
      for (int e = 0; e < 16; ++e) {
        KDT[(ch0 + e) * 72 + t] = f2bf(val[e] * ed);
        KBET[(ch0 + e) * 72 + t] = f2bf(kb[e] * eg);
      }
    }
    asm volatile("" ::: "memory");
    {
      float val[16]; convpart(2, val);
#pragma unroll
      for (int e = 0; e < 16; ++e) VBT[(ch0 + e) * 72 + t] = f2bf(val[e] * bt);
    }
  }
  sub_sync();
  REOPAQUE();
  {
    const f32x16 kk = mm_quad(KB, KN, wr, wc, r, h);
    const f32x16 qk = mm_quad(QN, KN, wr, wc, r, h);
    sub_sync();
    const int j = wc * 32 + r; const float gj = gcv[j];
#pragma unroll
    for (int i = 0; i < 16; ++i) {
      const int row = wr * 32 + crow(i, h);
      const float dec = (row >= j) ? expf(gcv[row] - gj) : 0.f;
      Mf[row * 68 + j] = (row > j) ? kk[i] * dec : 0.f;
      QKm[row * 72 + j] = f2bf(qk[i] * dec);
    }
  }
  sub_sync();
  REOPAQUE();
  if (wave == 0) {
    float t[64];
#pragma unroll
    for (int i = 0; i < 64; ++i) {
      float a4[4] = {(i == lane) ? 1.f : 0.f, 0.f, 0.f, 0.f};
#pragma unroll
      for (int j4 = 0; j4 < (i + 3) / 4; ++j4) {
        const f32x4 mrow = *(const f32x4*)(Mf + i * 68 + 4 * j4);
#pragma unroll
        for (int e = 0; e < 4; ++e) if (4 * j4 + e < i) a4[e] -= mrow[e] * t[4 * j4 + e];
      }
      const float a = (a4[0] + a4[1]) + (a4[2] + a4[3]);
      t[i] = a;
      Tm[i * 72 + lane] = f2bf(a);
      asm volatile("" ::: "memory");
    }
  }
  sub_sync();
  REOPAQUE();
  {
    const f32x16 u = mm_quad(Tm, VBT, wr, wc, r, h);
    const f32x16 w = mm_quad(Tm, KBET, wr, wc, r, h);
    const int col = wc * 32 + r;
#pragma unroll
    for (int g = 0; g < 4; ++g) {
      const int i0 = wr * 32 + 8 * g + 4 * h;
      *(u32x2*)(UT + col * 72 + i0) = pk4(u[4 * g], u[4 * g + 1], u[4 * g + 2], u[4 * g + 3]);
      *(u32x2*)(WT + col * 72 + i0) = pk4(w[4 * g], w[4 * g + 1], w[4 * g + 2], w[4 * g + 3]);
    }
  }
  sub_sync();
  REOPAQUE();
  {
    bf16_t* base = (bf16_t*)(p.ws + O_DPREP + (size_t)(hh * 128 + c) * 32768);
    const int n = wc * 32 + r;
    {
      const int ks = n >> 5, jh = (n >> 4) & 1, q = (n >> 2) & 3, jl = n & 3, jj = 4 * jh + jl;
      const int cbase = (ks * 64 + 16 * q) * 8 + jj;
      {
        const f32x16 P = mm_quad(KDT, WT, wr, wc, r, h);
#pragma unroll
        for (int i = 0; i < 16; ++i) {
          const int m = wr * 32 + crow(i, h);
          base[((m >> 4) * 128 + (m & 15)) * 8 + cbase] = f2bf(P[i]);
        }
      }
      asm volatile("" ::: "memory");
      {
        const f32x16 QW = mm_quad(QKm, WT, wr, wc, r, h);
#pragma unroll
        for (int i = 0; i < 16; ++i) {
          const int m = wr * 32 + crow(i, h);
          const float qd = bf2f(QN[m * 72 + n]) * egc[m];
          base[4096 + ((m >> 4) * 128 + (m & 15)) * 8 + cbase] = f2bf(qd - QW[i]);
        }
      }
      asm volatile("" ::: "memory");
    }
    const int jsl = n >> 4;
    {
      const f32x16 Bc = mm_quad(KDT, UT, wr, wc, r, h);
#pragma unroll
      for (int g = 0; g < 4; ++g) {
        const int row0 = wr * 32 + 8 * g + 4 * h;
        const int rt = row0 >> 4, lp = 16 * ((row0 >> 2) & 3) + (n & 15);
        *(u32x2*)(base + 8192 + ((jsl * 4 + rt) * 64 + lp) * 4) = pk4(Bc[4 * g], Bc[4 * g + 1], Bc[4 * g + 2], Bc[4 * g + 3]);
      }
    }
    asm volatile("" ::: "memory");
    {
      const f32x16 O0 = mm_quad(QKm, UT, wr, wc, r, h);
#pragma unroll
      for (int g = 0; g < 4; ++g) {
        const int row0 = wr * 32 + 8 * g + 4 * h;
        const int rt = row0 >> 4, lp = 16 * ((row0 >> 2) & 3) + (n & 15);
        *(u32x2*)(base + 12288 + ((jsl * 4 + rt) * 64 + lp) * 4) = pk4(O0[4 * g], O0[4 * g + 1], O0[4 * g + 2], O0[4 * g + 3]);
      }
    }
  }
  sub_sync();
#undef REOPAQUE
}

struct TileDesc { const bf16_t* k; const bf16_t* v; const float* aux; int tag; };

template <int DHT, bool AUX>
struct TileRegs { bf16x8 k[DHT / 16]; bf16x8 v[DHT / 32][2]; f32x4 a[4]; };

template <int DHT, bool AUX>
DI void load_tile(const bf16_t* kp, const bf16_t* vp, const float* ap, long ldv, TileRegs<DHT, AUX>& t) {
#pragma unroll
  for (int s = 0; s < DHT / 16; ++s) t.k[s] = *(const bf16x8*)(kp + 512 * s);
#pragma unroll
  for (int dt = 0; dt < DHT / 32; ++dt)
#pragma unroll
    for (int s = 0; s < 2; ++s) t.v[dt][s] = *(const bf16x8*)(vp + (dt * 2 + s) * 512);
  if (AUX) {
#pragma unroll
    for (int g = 0; g < 4; ++g) t.a[g] = *(const f32x4*)(ap + 8 * g);
  }
}

template <int DHT, bool AUX, class TF, class MF, class SF>
DI void attn_loop(int maxtiles, TF&& tf, MF&& mf, SF&& stopf, const bf16x8 (&qf)[DHT / 16], long ldv, float scale2,
                  f32x16 (&o)[DHT / 32], float& m, float& l) {
  TileRegs<DHT, AUX> cur, nxt;
  int tagc, tagn;
  bf16x8 qf0 = qf[0];
  { const bf16_t* kp; const bf16_t* vp; const float* ap = nullptr; tagc = tf(0, kp, vp, ap); load_tile<DHT, AUX>(kp, vp, ap, ldv, cur); }
#pragma unroll 1
  for (int t = 0; t < maxtiles; ++t) {
    { const bf16_t* kp; const bf16_t* vp; const float* ap = nullptr; tagn = tf(t + 1, kp, vp, ap); load_tile<DHT, AUX>(kp, vp, ap, ldv, nxt); }
    { bf16x8 q0 = qf[0]; asm volatile("" : "+v"(q0) :: "memory"); qf0 = q0; }
    f32x16 sacc;
#pragma unroll
    for (int i = 0; i < 16; ++i) sacc[i] = 0.f;
#pragma unroll
    for (int s = 0; s < DHT / 16; ++s) sacc = MFMA32(cur.k[s], s == 0 ? qf0 : qf[s], sacc);
    float sv[16]; float mx = NEG_INF;
#pragma unroll
    for (int i = 0; i < 16; ++i) { sv[i] = sacc[i] * scale2 + mf(tagc, i, AUX ? cur.a[i >> 2][i & 3] : 0.f); mx = fmaxf(mx, sv[i]); }
    mx = fmaxf(mx, __shfl_xor(mx, 32));
    const float mnew = fmaxf(m, mx);
    const float alpha = __builtin_amdgcn_exp2f(m - mnew);
    m = mnew;
    float pv[16]; float ps = 0.f;
#pragma unroll
    for (int i = 0; i < 16; ++i) { pv[i] = __builtin_amdgcn_exp2f(sv[i] - mnew); ps += pv[i]; }
    l = l * alpha + ps;
#pragma unroll
    for (int dt = 0; dt < DHT / 32; ++dt)
#pragma unroll
      for (int i = 0; i < 16; ++i) o[dt][i] *= alpha;
    bf16x8 pf[2]; pf[0] = pk8(pv); pf[1] = pk8(pv + 8);
#pragma unroll
    for (int dt = 0; dt < DHT / 32; ++dt)
#pragma unroll
      for (int s = 0; s < 2; ++s) {
        o[dt] = MFMA32(cur.v[dt][s], pf[s], o[dt]);
      }
    if (stopf(t, m, AUX ? cur.a[0][0] : 0.f)) break;
    cur = nxt; tagc = tagn;
  }
}

template <int DHT>
DI void attn_store(const f32x16 (&o)[DHT / 32], float l, bf16_t* dstrow, int h, float& ltot_out, bool valid = true) {
  const float ltot = l + __shfl_xor(l, 32);
  ltot_out = ltot;
  const float inv = ltot > 0.f ? 1.f / ltot : 0.f;
  if (valid)
#pragma unroll
  for (int dt = 0; dt < DHT / 32; ++dt)
#pragma unroll
    for (int g = 0; g < 4; ++g)
      *(u32x2*)(dstrow + dt * 32 + 8 * g + 4 * h) = pk4(o[dt][4 * g] * inv, o[dt][4 * g + 1] * inv, o[dt][4 * g + 2] * inv, o[dt][4 * g + 3] * inv);
}

template <int DHT>
DI void attn_store_gated(const f32x16 (&o)[DHT / 32], float l, bf16_t* szrow, int h) {
  const float ltot = l + __shfl_xor(l, 32);
  const float inv = ltot > 0.f ? 1.f / ltot : 0.f;
#pragma unroll
  for (int dt = 0; dt < DHT / 32; ++dt)
#pragma unroll
    for (int g = 0; g < 4; ++g) {
      bf16_t* q = szrow + dt * 32 + 8 * g + 4 * h;
      const u32x2 z = *(const u32x2*)q;
      *(u32x2*)q = pk4(o[dt][4 * g] * inv * bflo(z.x), o[dt][4 * g + 1] * inv * bfhi(z.x), o[dt][4 * g + 2] * inv * bflo(z.y), o[dt][4 * g + 3] * inv * bfhi(z.y));
    }
}

template <int N>
DI void zero_o(f32x16 (&o)[N]) {
#pragma unroll
  for (int a = 0; a < N; ++a)
#pragma unroll
    for (int i = 0; i < 16; ++i) o[a][i] = 0.f;
}

DI void top3_insert(float v, int n, float& v0, float& v1, float& v2, int& i0, int& i1, int& i2) {
  const bool g0 = v > v0, g1 = v > v1, g2 = v > v2;
  v2 = g1 ? v1 : (g2 ? v : v2); i2 = g1 ? i1 : (g2 ? n : i2);
  v1 = g0 ? v0 : (g1 ? v : v1); i1 = g0 ? i0 : (g1 ? n : i1);
  v0 = g0 ? v : v0;             i0 = g0 ? n : i0;
}

DI void moba_select(const Params& p, int a) {
  const int lane = otid() & 63, r = lane & 31, h = lane >> 5;
  const int qtile = a / 6, hh = a % 6, qb = qtile >> 3;
  unsigned mask = 0;
  if (qb > 0) {
    const bf16_t* qrow = (const bf16_t*)(p.ws + O_QKA) + (size_t)(qtile * 32 + r) * 384 + hh * 64 + 8 * h;
    bf16x8 qf[4];
#pragma unroll
    for (int s = 0; s < 4; ++s) qf[s] = *(const bf16x8*)(qrow + 16 * s);
    const float* ks0 = (const float*)(p.ws + O_KSUM) + (size_t)(r * 2) * 384 + hh * 64 + 8 * h;
    f32x16 g;
#pragma unroll
    for (int i = 0; i < 16; ++i) g[i] = 0.f;
#pragma unroll
    for (int s = 0; s < 4; ++s) {
      const f32x4 a0 = *(const f32x4*)(ks0 + 16 * s), a1 = *(const f32x4*)(ks0 + 16 * s + 4);
      const f32x4 b0 = *(const f32x4*)(ks0 + 384 + 16 * s), b1 = *(const f32x4*)(ks0 + 384 + 16 * s + 4);
      float hi[8], lo[8];
#pragma unroll
      for (int e = 0; e < 4; ++e) {
        const float m0 = (a0[e] + b0[e]) * (1.f / 256.f), m1 = (a1[e] + b1[e]) * (1.f / 256.f);
        hi[e] = bf2f(f2bf(m0)); lo[e] = m0 - hi[e];
        hi[4 + e] = bf2f(f2bf(m1)); lo[4 + e] = m1 - hi[4 + e];
      }
      g = MFMA32(pk8(hi), qf[s], g); g = MFMA32(pk8(lo), qf[s], g);
    }
    float v0 = NEG_INF, v1 = NEG_INF, v2 = NEG_INF; int i0 = -1, i1 = -1, i2 = -1;
#pragma unroll
    for (int i = 0; i < 16; ++i) { const int n = crow(i, h); if (n < qb) top3_insert(g[i], n, v0, v1, v2, i0, i1, i2); }
    const float pv0 = __shfl_xor(v0, 32), pv1 = __shfl_xor(v1, 32), pv2 = __shfl_xor(v2, 32);
    const int pi0 = __shfl_xor(i0, 32), pi1 = __shfl_xor(i1, 32), pi2 = __shfl_xor(i2, 32);
    if (pi0 >= 0) top3_insert(pv0, pi0, v0, v1, v2, i0, i1, i2);
    if (pi1 >= 0) top3_insert(pv1, pi1, v0, v1, v2, i0, i1, i2);
    if (pi2 >= 0) top3_insert(pv2, pi2, v0, v1, v2, i0, i1, i2);
    if (i0 >= 0) mask |= 1u << i0;
    if (i1 >= 0) mask |= 1u << i1;
    if (i2 >= 0) mask |= 1u << i2;
  }
  if (h == 0) ((unsigned*)(p.ws + O_MASK))[(qtile * 32 + r) * 8 + hh] = mask;
}

DI void moba_gather(const Params& p, int a, unsigned char* smem) {
  const int tid = otid(), lane = tid & 63, wave = tid >> 6, r = lane & 31, h = lane >> 5;
  const int part = a & 1, a2 = a >> 1;
  const int hh = a2 % 6, idx = a2 / 6;
  int qb = 1;
  while ((qb + 1) * qb / 2 <= idx) ++qb;
  const int n = idx - qb * (qb - 1) / 2;
  const unsigned* MASK = (const unsigned*)(p.ws + O_MASK);
  unsigned* list = (unsigned*)(smem + wave * 1024);
  int cnt = 0;
#pragma unroll
  for (int j = 0; j < 4; ++j) {
    const int qi = j * 64 + lane;
    const unsigned mk = MASK[(qb * 256 + qi) * 8 + hh];
    const bool pred = (mk >> n) & 1u;
    const unsigned long long ball = __ballot(pred);
    const int pos = cnt + __builtin_popcountll(ball & ((1ull << lane) - 1ull));
    if (pred) list[pos] = (unsigned)qi | ((unsigned)__builtin_popcount(mk & ((1u << n) - 1u)) << 8);
    cnt += __builtin_popcountll(ball);
  }
  cnt = __builtin_amdgcn_readfirstlane(cnt);
  if (cnt == 0) return;
  asm volatile("s_waitcnt lgkmcnt(0)" ::: "memory");
  __builtin_amdgcn_wave_barrier();
  const bf16_t* QK = (const bf16_t*)(p.ws + O_QKA);
  const bf16_t* KF = (const bf16_t*)(p.ws + O_KFA) + (size_t)hh * 524288 + (size_t)n * 8 * 2048 + lane * 8;
  const bf16_t* VT = (const bf16_t*)(p.ws + O_VTA) + (size_t)hh * 524288 + (size_t)n * 8 * 2048 + lane * 8;
  const int nch = (cnt + 31) >> 5;
#pragma unroll 1
  for (int c = part; c < nch; c += 2) {
    const int e = c * 32 + r;
    const bool valid = e < cnt;
    const unsigned ent = list[valid ? e : 0];
    const int tok = qb * 256 + (int)(ent & 255u), slot = (int)(ent >> 8);
    bf16x8 qf[4];
    { const bf16_t* qrow = QK + (size_t)tok * 384 + hh * 64 + 8 * h;
#pragma unroll
      for (int s = 0; s < 4; ++s) qf[s] = *(const bf16x8*)(qrow + 16 * s); }
    auto tf = [&](int t, const bf16_t*& kp, const bf16_t*& vp, const float*&) -> int {
      const int tt = t < 7 ? t : 7;
      kp = KF + tt * 2048; vp = VT + tt * 2048;
      return 0;
    };
    auto mf = [&](int, int, float) -> float { return 0.f; };
    auto sf = [&](int, float, float) { return false; };
    f32x16 o[2]; zero_o(o); float m = -1e30f, l = 0.f;
    int nt8 = 8; asm volatile("" : "+s"(nt8));
    attn_loop<64, false>(nt8, tf, mf, sf, qf, (long)TH, 0.125f * LOG2E, o, m, l);
    float lt;
    attn_store<64>(o, l, (bf16_t*)(p.ws + O_OA + slot * SZ_O) + (size_t)tok * 384 + hh * 64, h, lt, valid);
    if (valid && h == 0) { float* st = (float*)(p.ws + O_STA) + ((size_t)(slot * TH + tok) * 6 + hh) * 2; st[0] = m; st[1] = lt; }
  }
}

DI void moba_own(const Params& p, int a) {
  const int lane = otid() & 63, r = lane & 31, h = lane >> 5;
  const int qtile = 255 - a / 6, hh = a % 6, qb = qtile >> 3, own = qtile & 7;
  const bf16_t* QK = (const bf16_t*)(p.ws + O_QKA);
  const bf16_t* KF = (const bf16_t*)(p.ws + O_KFA) + (size_t)hh * 524288 + (size_t)qb * 8 * 2048 + lane * 8;
  const bf16_t* VT = (const bf16_t*)(p.ws + O_VTA) + (size_t)hh * 524288 + (size_t)qb * 8 * 2048 + lane * 8;
  const int tok = qtile * 32 + r;
  bf16x8 qf[4];
  { const bf16_t* qrow = QK + (size_t)tok * 384 + hh * 64 + 8 * h;
#pragma unroll
    for (int s = 0; s < 4; ++s) qf[s] = *(const bf16x8*)(qrow + 16 * s); }
  auto tf = [&](int t, const bf16_t*& kp, const bf16_t*& vp, const float*&) -> int {
    const int kk = t < own ? t : own;
    kp = KF + kk * 2048; vp = VT + kk * 2048;
    return (kk == own) ? 101 : 100;
  };
  auto mf = [&](int tag, int i, float) -> float {
    if (tag == 100) return 0.f;
    return (crow(i, h) <= r) ? 0.f : NEG_INF;
  };
  auto sf = [&](int, float, float) { return false; };
  f32x16 o[2]; zero_o(o); float m = -1e30f, l = 0.f;
  attn_loop<64, false>(own + 1, tf, mf, sf, qf, (long)TH, 0.125f * LOG2E, o, m, l);
  float lt;
  attn_store<64>(o, l, (bf16_t*)(p.ws + O_OA + 3 * SZ_O) + (size_t)tok * 384 + hh * 64, h, lt);
  if (h == 0) {
    float* st = (float*)(p.ws + O_STA);
    st[((size_t)(3 * TH + tok) * 6 + hh) * 2] = m; st[((size_t)(3 * TH + tok) * 6 + hh) * 2 + 1] = lt;
    const int np = __builtin_popcount(((const unsigned*)(p.ws + O_MASK))[tok * 8 + hh]);
    for (int sl = np; sl < 3; ++sl) { st[((size_t)(sl * TH + tok) * 6 + hh) * 2] = -1e30f; st[((size_t)(sl * TH + tok) * 6 + hh) * 2 + 1] = 0.f; }
  }
}

DI void fox_item(const Params& p, int c, const unsigned* kmaxu) {
  const int lane = otid() & 63, r = lane & 31, h = lane >> 5;
  const int qtile = 255 - c / 6, hh = c % 6;
  const bf16_t* QK = (const bf16_t*)(p.ws + O_QKC);
  const bf16_t* KF = (const bf16_t*)(p.ws + O_KFC);
  const bf16_t* VT = (const bf16_t*)(p.ws + O_VTC);
  const float* FF = (const float*)(p.ws + O_FF) + hh * TH;
  bf16x8 qf[4]; float qn2 = 0.f;
  { const bf16_t* qrow = QK + (size_t)(qtile * 32 + r) * 384 + hh * 64 + 8 * h;
#pragma unroll
    for (int s = 0; s < 4; ++s) { qf[s] = *(const bf16x8*)(qrow + 16 * s); float v[8]; unpk8(qf[s], v);
#pragma unroll
      for (int e = 0; e < 8; ++e) qn2 += v[e] * v[e]; } }
  qn2 += __shfl_xor(qn2, 32);
#pragma unroll
  for (int o = 16; o >= 1; o >>= 1) qn2 = fmaxf(qn2, __shfl_xor(qn2, o));
  const float Fq = FF[qtile * 32 + r];
  const float Ffirst = FF[qtile * 32];
  const float kmaxn = sqrtf(__uint_as_float(kmaxu[hh]));
  const float bound = sqrtf(qn2) * kmaxn * 0.125f + Ffirst;
  auto tf = [&](int t, const bf16_t*& kp, const bf16_t*& vp, const float*& ap) -> int {
    const int keybase = (qtile - t > 0 ? qtile - t : 0) * 32;
    kp = KF + (size_t)hh * 524288 + (keybase >> 5) * 2048 + lane * 8;
    vp = VT + (size_t)hh * 524288 + (keybase >> 5) * 2048 + lane * 8;
    ap = FF + keybase + 4 * h;
    return (t == 0) ? 1 : 0;
  };
  auto mf = [&](int tag, int i, float fk) -> float {
    const float b = (Fq - fk) * LOG2E;
    return (tag == 1 && crow(i, h) > r) ? NEG_INF : b;
  };
  auto sf = [&](int, float m, float a0) {
    const float fkb = __builtin_bit_cast(float, __builtin_amdgcn_readfirstlane(__builtin_bit_cast(int, a0)));
    float mm = m;
#pragma unroll
    for (int o = 16; o >= 1; o >>= 1) mm = fminf(mm, __shfl_xor(mm, o));
    return (bound - fkb) * LOG2E < mm - 45.f;
  };
  f32x16 o[2]; zero_o(o); float m = -1e30f, l = 0.f;
  attn_loop<64, true>(qtile + 1, tf, mf, sf, qf, (long)TH, 0.125f * LOG2E, o, m, l);
  float lt;
  attn_store_gated<64>(o, l, (bf16_t*)(p.ws + O_SZ) + (size_t)(qtile * 32 + r) * 1920 + 2 * 384 + hh * 64, h);
}

DI void dil_item(const Params& p, int idx) {
  const int lane = otid() & 63, r = lane & 31, h = lane >> 5;
  const int g = idx / 1536, rem = idx % 1536, hh = rem / 256, w = rem % 256;
  const int dsh = 2 * g;
  const int dil = 1 << dsh, L = TH >> dsh, tps = L / 32;
  const int rs = w / tps, lt_ = w % tps, l0 = lt_ * 32;
  const bf16_t* QK = (const bf16_t*)(p.ws + O_QKB);
  const bf16_t* KF = (const bf16_t*)(p.ws + O_KFB + g * SZ_VT);
  const bf16_t* VT = (const bf16_t*)(p.ws + O_VTB + g * SZ_VT);
  const int tq = (l0 + r) * dil + rs;
  bf16x8 qf[4];
  { const bf16_t* qrow = QK + (size_t)tq * 1152 + g * 384 + hh * 64 + 8 * h;
#pragma unroll
    for (int s = 0; s < 4; ++s) qf[s] = *(const bf16x8*)(qrow + 16 * s); }
  const int t0 = (l0 >= 128) ? 0 : (128 - l0) / 32;
  auto tf = [&](int tt, const bf16_t*& kp, const bf16_t*& vp, const float*&) -> int {
    const int t = (t0 + tt < 4) ? t0 + tt : 4; const int keybase = l0 - 128 + 32 * t;
    kp = KF + (size_t)hh * 524288 + ((rs * L + keybase) >> 5) * 2048 + lane * 8;
    vp = VT + (size_t)hh * 524288 + ((rs * L + keybase) >> 5) * 2048 + lane * 8;
    return t;
  };
  auto mf = [&](int tag, int i, float) -> float {
    const int kj = crow(i, h);
    if (tag == 0) return (kj >= r) ? 0.f : NEG_INF;
    if (tag == 4) return (kj <= r) ? 0.f : NEG_INF;
    return 0.f;
  };
  auto sf = [&](int, float, float) { return false; };
  f32x16 o[2]; zero_o(o); float m = -1e30f, l = 0.f;
  attn_loop<64, false>(5 - t0, tf, mf, sf, qf, (long)TH, 0.125f * LOG2E, o, m, l);
  float lt;
  attn_store<64>(o, l, (bf16_t*)(p.ws + O_OB + g * SZ_O) + (size_t)tq * 384 + hh * 64, h, lt);
  if (h == 0) { float* st = (float*)(p.ws + O_STB) + ((size_t)(g * TH + tq) * 6 + hh) * 2; st[0] = m; st[1] = lt; }
}

DI void mem_item(const Params& p, int half, int e) {
  const int lane = otid() & 63, r = lane & 31, h = lane >> 5;
  const int hd = e & 3, qtile = e >> 2;
  const bf16_t* QE = (const bf16_t*)(p.ws + O_QE);
  const bf16_t* MK = (const bf16_t*)(p.ws + O_MEMK);
  const bf16_t* MV = (const bf16_t*)(p.ws + O_MEMVT);
  bf16x8 qf[6];
  { const bf16_t* qrow = QE + (size_t)(qtile * 32 + r) * 384 + hd * 96 + 8 * h;
#pragma unroll
    for (int s = 0; s < 6; ++s) qf[s] = *(const bf16x8*)(qrow + 16 * s); }
  auto tf = [&](int t, const bf16_t*& kp, const bf16_t*& vp, const float*&) -> int {
    const int keybase = 32 * (t < 7 ? t : 7);
    kp = MK + (size_t)((half * 4 + hd) * 8 + (keybase >> 5)) * 3072 + lane * 8;
    vp = MV + (size_t)((half * 4 + hd) * 8 + (keybase >> 5)) * 3072 + lane * 8;
    return 0;
  };
  auto mf = [&](int, int, float) -> float { return 0.f; };
  auto sf = [&](int, float, float) { return false; };
  f32x16 o[3]; zero_o(o); float m = -1e30f, l = 0.f;
  attn_loop<96, false>(8, tf, mf, sf, qf, 256L, 0.10206207261596577f * LOG2E, o, m, l);
  float lt;
  attn_store_gated<96>(o, l, (bf16_t*)(p.ws + O_SZ) + (size_t)(qtile * 32 + r) * 1920 + 4 * 384 + hd * 96, h);
}

DI float dpp_ror(float v, int ctrl);
DI float row16_sum(float v) {
  v += __builtin_bit_cast(float, __builtin_amdgcn_update_dpp(0, __builtin_bit_cast(int, v), 0x128, 0xf, 0xf, false));
  v += __builtin_bit_cast(float, __builtin_amdgcn_update_dpp(0, __builtin_bit_cast(int, v), 0x124, 0xf, 0xf, false));
  v += __builtin_bit_cast(float, __builtin_amdgcn_update_dpp(0, __builtin_bit_cast(int, v), 0x122, 0xf, 0xf, false));
  v += __builtin_bit_cast(float, __builtin_amdgcn_update_dpp(0, __builtin_bit_cast(int, v), 0x121, 0xf, 0xf, false));
  return v;
}

struct ScanRegs { bf16x8 pf[4][2]; bf16x8 qe[4][2]; s16x4 bc[4]; s16x4 o0[4]; float gl; };
DI void scan_load(const Params& p, int hh, int j, int c, int lane, ScanRegs& s) {
  const unsigned char* base = p.ws + O_DPREP + (size_t)(hh * 128 + c) * 32768;
#pragma unroll
  for (int mt = 0; mt < 4; ++mt)
#pragma unroll
    for (int ks = 0; ks < 2; ++ks) {
      s.pf[mt][ks] = *(const bf16x8*)(base + ((mt * 2 + ks) * 64 + lane) * 16);
      s.qe[mt][ks] = *(const bf16x8*)(base + 8192 + ((mt * 2 + ks) * 64 + lane) * 16);
    }
#pragma unroll
  for (int rt = 0; rt < 4; ++rt) {
    s.bc[rt] = *(const s16x4*)(base + 16384 + ((j * 4 + rt) * 64 + lane) * 8);
    s.o0[rt] = *(const s16x4*)(base + 24576 + ((j * 4 + rt) * 64 + lane) * 8);
  }
  s.gl = ((const float*)(p.ws + O_GL))[hh * 128 + c];
}
DI f32x4 s4f(s16x4 v) { u32x2 u = __builtin_bit_cast(u32x2, v); f32x4 r; r[0] = bflo(u.x); r[1] = bfhi(u.x); r[2] = bflo(u.y); r[3] = bfhi(u.y); return r; }

DI void scan_item(const Params& p, int it) {
  const int lane = otid() & 63, q = lane >> 4, cl = lane & 15;
  const int hh = it >> 2, j = it & 3;
  f32x4 S[4];
#pragma unroll
  for (int rt = 0; rt < 4; ++rt) S[rt] = (f32x4){0.f, 0.f, 0.f, 0.f};
  bf16_t* OD = (bf16_t*)(p.ws + O_OD);
  float* SSQ = (float*)(p.ws + O_SSQ);
#ifndef SCAN_PREFETCH
#define SCAN_PREFETCH 1
#endif
  ScanRegs cur, nxt;
  if (SCAN_PREFETCH) scan_load(p, hh, j, 0, lane, cur);
  for (int c = 0; c < 128; ++c) {
    if (SCAN_PREFETCH) {
      scan_load(p, hh, j, (c + 1 < 128) ? c + 1 : c, lane, nxt);
      asm volatile("" : "+v"(S[0][0]) :: "memory");
    } else {
      scan_load(p, hh, j, c, lane, cur);
    }
    bf16x8 bfr[2];
#pragma unroll
    for (int ks = 0; ks < 2; ++ks) {
      u32x4 u; u.x = pk2(S[2 * ks][0], S[2 * ks][1]); u.y = pk2(S[2 * ks][2], S[2 * ks][3]); u.z = pk2(S[2 * ks + 1][0], S[2 * ks + 1][1]); u.w = pk2(S[2 * ks + 1][2], S[2 * ks + 1][3]);
      bfr[ks] = __builtin_bit_cast(bf16x8, u);
    }
    f32x4 aP[4], aO[4];
#pragma unroll
    for (int rt = 0; rt < 4; ++rt) {
      aP[rt] = (f32x4){0.f, 0.f, 0.f, 0.f};
      aO[rt] = s4f(cur.o0[rt]);
#pragma unroll
      for (int ks = 0; ks < 2; ++ks) { aP[rt] = MFMA16(cur.pf[rt][ks], bfr[ks], aP[rt]); aO[rt] = MFMA16(cur.qe[rt][ks], bfr[ks], aO[rt]); }
    }
#pragma unroll
    for (int rt = 0; rt < 4; ++rt) S[rt] = S[rt] * cur.gl - aP[rt] + s4f(cur.bc[rt]);
#pragma unroll
    for (int rt = 0; rt < 4; ++rt)
#pragma unroll
      for (int e = 0; e < 4; ++e) {
        const int tok = c * 64 + 16 * rt + 4 * q + e;
        const float v = aO[rt][e];
        OD[(size_t)tok * 384 + hh * 64 + 16 * j + cl] = f2bf(v);
        const float ss = row16_sum(v * v);
        if (cl == 0) SSQ[(tok * 6 + hh) * 4 + j] = ss;
      }
    if (SCAN_PREFETCH) cur = nxt;
  }
}

DI void scan_block(const Params& p, int hh, unsigned char* smem) {
  const int tid = otid(), lane = tid & 63, j = tid >> 6, q = lane >> 4, cl = lane & 15;
  const unsigned char* src = p.ws + O_DPREP + (size_t)hh * 128 * 32768;
  bf16_t* ostg = (bf16_t*)(smem + 65536);
  bf16x8 R0[8], R1[8];
  auto gld = [&](int c, bf16x8 (&R)[8]) {
    c = c < 128 ? c : 127;
    const unsigned char* b = src + (size_t)c * 32768 + tid * 16;
#pragma unroll
    for (int i = 0; i < 8; ++i) R[i] = *(const bf16x8*)(b + i * 4096);
  };
  auto lst = [&](int buf, const bf16x8 (&R)[8]) {
    unsigned char* d = smem + buf * 32768 + tid * 16;
#pragma unroll
    for (int i = 0; i < 8; ++i) *(bf16x8*)(d + i * 4096) = R[i];
  };
  const float* GL = (const float*)(p.ws + O_GL) + hh * 128;
  const float gl_lo = GL[lane], gl_hi = GL[64 + lane];
  f32x4 S[4];
#pragma unroll
  for (int rt = 0; rt < 4; ++rt) S[rt] = (f32x4){0.f, 0.f, 0.f, 0.f};
  bf16_t* OD = (bf16_t*)(p.ws + O_OD);
  float* SSQ = (float*)(p.ws + O_SSQ);
  f32x4 aO[4];
  auto flush = [&](int cp) {
    const int row = tid >> 2, part = tid & 3;
    const bf16x8 v0 = *(const bf16x8*)(ostg + row * 72 + 16 * part), v1 = *(const bf16x8*)(ostg + row * 72 + 16 * part + 8);
    float f[16]; unpk8(v0, f); unpk8(v1, f + 8);
    float ss = 0.f;
#pragma unroll
    for (int e = 0; e < 16; ++e) ss += f[e] * f[e];
    const int tok = cp * 64 + row;
    bf16_t* dst = OD + (size_t)tok * 384 + hh * 64 + 16 * part;
    *(bf16x8*)dst = v0; *(bf16x8*)(dst + 8) = v1;
    SSQ[(tok * 6 + hh) * 4 + part] = ss;
  };
  auto compute = [&](int buf, int c) {
    const unsigned char* base = smem + buf * 32768;
    const float gl = __builtin_bit_cast(float, __builtin_amdgcn_readlane(__builtin_bit_cast(int, c < 64 ? gl_lo : gl_hi), c & 63));
    bf16x8 bfr[2];
#pragma unroll
    for (int ks = 0; ks < 2; ++ks) {
      u32x4 u; u.x = pk2(S[2 * ks][0], S[2 * ks][1]); u.y = pk2(S[2 * ks][2], S[2 * ks][3]); u.z = pk2(S[2 * ks + 1][0], S[2 * ks + 1][1]); u.w = pk2(S[2 * ks + 1][2], S[2 * ks + 1][3]);
      bfr[ks] = __builtin_bit_cast(bf16x8, u);
    }
    f32x4 aP[4];
#pragma unroll
    for (int rt = 0; rt < 4; ++rt) {
      aP[rt] = (f32x4){0.f, 0.f, 0.f, 0.f};
      aO[rt] = s4f(*(const s16x4*)(base + 24576 + ((j * 4 + rt) * 64 + lane) * 8));
#pragma unroll
      for (int ks = 0; ks < 2; ++ks) {
        aP[rt] = MFMA16(*(const bf16x8*)(base + ((rt * 2 + ks) * 64 + lane) * 16), bfr[ks], aP[rt]);
        aO[rt] = MFMA16(*(const bf16x8*)(base + 8192 + ((rt * 2 + ks) * 64 + lane) * 16), bfr[ks], aO[rt]);
      }
    }
#pragma unroll
    for (int rt = 0; rt < 4; ++rt) S[rt] = S[rt] * gl - aP[rt] + s4f(*(const s16x4*)(base + 16384 + ((j * 4 + rt) * 64 + lane) * 8));
  };
  auto stage_out = [&]() {
#pragma unroll
    for (int rt = 0; rt < 4; ++rt)
#pragma unroll
      for (int e = 0; e < 4; ++e) ostg[(16 * rt + 4 * q + e) * 72 + 16 * j + cl] = f2bf(aO[rt][e]);
  };
  __builtin_amdgcn_s_setprio(3);
  gld(0, R0); gld(1, R1);
  lst(0, R0); gld(2, R0);
  sub_sync();
#pragma unroll 1
  for (int c = 0; c < 128; c += 2) {
    lst(1, R1);
    gld(c + 3, R1);
    if (c > 0) flush(c - 1);
    compute(0, c);
    sub_sync();
    stage_out();
    sub_sync();
    lst(0, R0);
    gld(c + 4, R0);
    flush(c);
    compute(1, c + 1);
    sub_sync();
    stage_out();
    sub_sync();
  }
  flush(127);
  sub_sync();
  __builtin_amdgcn_s_setprio(0);
}

DI void phase3(const Params& p, int half, unsigned* ctr, const unsigned* kmaxu, unsigned char* smem, int sub, int limit = 1 << 30) {
  const int tid = otid(), wave = tid >> 6;
  const int hb = (int)blockIdx.x, x = hb & 7, bi = hb >> 3;
  if (hb < 3 && limit >= 0) { if (PH(5)) scan_block(p, hb * 2 + sub, smem); }
  if (bi >= 1 && limit != 0) {
    const int nlw = ((int)(gridDim.x >> 3) - 1) * 8, lw = ((bi - 1) * 2 + sub) * 4 + wave;
    if (x < 6) {
      const int hh = x;
      constexpr int NG = 992, NOWN = 256, NB_ = 640, NTOT = NG + NOWN + NB_;
      for (int pos0 = lw; pos0 < NTOT; pos0 += nlw) {
        int pos = __builtin_amdgcn_readfirstlane(pos0);
        if (pos < NG) { if (PH(6)) moba_gather(p, (((pos >> 1) * 6 + hh) << 1) | (pos & 1), smem); continue; }
        pos -= NG;
        if (pos < NOWN) { if (PH(6)) moba_own(p, pos * 6 + hh); continue; }
        pos -= NOWN;
        const int g = pos < 512 ? (pos >> 8) : 2, w = pos < 512 ? (pos & 255) : 2 * (pos - 512);
        if (PH(8)) dil_item(p, g * 1536 + hh * 256 + w);
      }
    } else {
      const int h0 = (x - 6) * 3;
      constexpr int NE = 512, NC = 768, NB2 = 384, NTOT = NE + NC + NB2;
      for (int pos0 = lw; pos0 < NTOT; pos0 += nlw) {
        int pos = __builtin_amdgcn_readfirstlane(pos0);
        if (pos < NE) { if (PH(7)) mem_item(p, half, (x - 6) * 512 + pos); continue; }
        pos -= NE;
        if (pos < NC) { if (PH(9)) fox_item(p, (pos & 255) * 6 + h0 + (pos >> 8), kmaxu); continue; }
        pos -= NC;
        if (PH(8)) dil_item(p, 2 * 1536 + (h0 + (pos >> 7)) * 256 + 2 * (pos & 127) + 1);
      }
    }
  }
}

DI void gbuild_chunk(const Params& p, int layer, int tok, int c8) {
  const unsigned char* ws = p.ws;
  const int n = c8 / 48, c = (c8 % 48) * 8;
  if (n == 2 || n == 4) return;
  bf16_t* szp = (bf16_t*)(p.ws + O_SZ) + (size_t)tok * 1920 + n * 384 + c;
  float o[8], z[8];
  unpk8(*(const bf16x8*)szp, z);
  if (n == 1) {
    const int hh = c >> 6;
    const float* st = (const float*)(ws + O_STB);
    float mg[3], lg[3];
#pragma unroll
    for (int g = 0; g < 3; ++g) { const f32x2 s2 = *(const f32x2*)(st + ((size_t)(g * TH + tok) * 6 + hh) * 2); mg[g] = s2[0]; lg[g] = s2[1]; }
    const float mm = fmaxf(mg[0], fmaxf(mg[1], mg[2]));
    float wg[3], ws_ = 0.f;
#pragma unroll
    for (int g = 0; g < 3; ++g) { wg[g] = exp2f(mg[g] - mm) * lg[g]; ws_ += wg[g]; }
    const float inv = 1.f / ws_;
#pragma unroll
    for (int e = 0; e < 8; ++e) o[e] = 0.f;
#pragma unroll
    for (int g = 0; g < 3; ++g) {
      float t[8]; unpk8(*(const bf16x8*)((const bf16_t*)(ws + O_OB + g * SZ_O) + (size_t)tok * 384 + c), t);
      const float wgi = wg[g] * inv;
#pragma unroll
      for (int e = 0; e < 8; ++e) o[e] += wgi * t[e];
    }
  } else if (n == 3) {
    const int hh = c >> 6;
    const f32x4 sq = *(const f32x4*)((const float*)(ws + O_SSQ) + ((size_t)tok * 6 + hh) * 4);
    const float rs = rsqrtf((sq[0] + sq[1] + sq[2] + sq[3]) * (1.f / 64.f) + 1e-6f);
    unpk8(*(const bf16x8*)((const bf16_t*)(ws + O_OD) + (size_t)tok * 384 + c), o);
    const float* gw = p.gdn_w + layer * 64 + (c & 63);
#pragma unroll
    for (int e = 0; e < 8; ++e) o[e] *= rs * gw[e];
  } else if (n == 0) {
    const int hh = c >> 6;
    const float* st = (const float*)(ws + O_STA);
    float mg[4], lg[4], mm = -1e30f;
#pragma unroll
    for (int g = 0; g < 4; ++g) { const f32x2 s2 = *(const f32x2*)(st + ((size_t)(g * TH + tok) * 6 + hh) * 2); mg[g] = s2[0]; lg[g] = s2[1]; mm = fmaxf(mm, mg[g]); }
    float wg[4], ws_ = 0.f;
#pragma unroll
    for (int g = 0; g < 4; ++g) { wg[g] = exp2f(mg[g] - mm) * lg[g]; ws_ += wg[g]; }
    const float inv = 1.f / ws_;
#pragma unroll
    for (int e = 0; e < 8; ++e) o[e] = 0.f;
#pragma unroll
    for (int g = 0; g < 4; ++g) {
      if (lg[g] > 0.f) {
        float t[8]; unpk8(*(const bf16x8*)((const bf16_t*)(ws + O_OA + g * SZ_O) + (size_t)tok * 384 + c), t);
        const float wgi = wg[g] * inv;
#pragma unroll
        for (int e = 0; e < 8; ++e) o[e] += wgi * t[e];
      }
    }
  } else {
    const size_t off = (n == 2) ? O_OC : O_OE;
    unpk8(*(const bf16x8*)((const bf16_t*)(ws + off) + (size_t)tok * 384 + c), o);
  }
#pragma unroll
  for (int e = 0; e < 8; ++e) o[e] *= z[e];
  *(bf16x8*)szp = pk8(o);
}

DI void p4a_tile(const Params& p, int layer, int mt, int nt, unsigned char* smem) {
  sub_sync();
  bf16_t* As = (bf16_t*)smem; bf16_t* Bs = As + 2 * 9216;
  const int tid = otid(), lane = tid & 63, wave = tid >> 6, wr = wave >> 1, wc = wave & 1, r = lane & 31, h = lane >> 5;
  const int m0 = mt * 128, n0 = nt * 128;
  f32x16 tot[2][2]; zero_acc(tot);
  const bf16_t* SIG = (const bf16_t*)(p.ws + O_SIG);
  for (int n = 0; n < 5; ++n) {
    f32x16 acc[2][2]; zero_acc(acc);
    PlainA al{(const bf16_t*)(p.ws + O_SZ) + n * 384, 1920};
    gemm_kloop_t<32>(al, (const bf16_t*)(p.ws + O_WTBR) + (size_t)(layer * 5 + n) * 1024 * 384, 384, 12, m0, n0, acc, As, Bs);
#pragma unroll
    for (int mi = 0; mi < 2; ++mi) {
      const int tok = m0 + wr * 64 + mi * 32 + r;
#pragma unroll
      for (int ni = 0; ni < 2; ++ni)
#pragma unroll
        for (int g = 0; g < 4; ++g) {
          const int col = n0 + wc * 64 + ni * 32 + 8 * g + 4 * h;
          const u32x2 sg = *(const u32x2*)(SIG + (size_t)tok * 5120 + n * 1024 + col);
          tot[mi][ni][4 * g] += bflo(sg.x) * acc[mi][ni][4 * g];
          tot[mi][ni][4 * g + 1] += bfhi(sg.x) * acc[mi][ni][4 * g + 1];
          tot[mi][ni][4 * g + 2] += bflo(sg.y) * acc[mi][ni][4 * g + 2];
          tot[mi][ni][4 * g + 3] += bfhi(sg.y) * acc[mi][ni][4 * g + 3];
          asm volatile("" ::: "memory");
        }
    }
  }
  bf16_t* YM = (bf16_t*)(p.ws + O_YM);
  {
    bf16_t* stg = (bf16_t*)smem + wave * (64 * 72);
#pragma unroll
    for (int ni = 0; ni < 2; ++ni)
#pragma unroll
      for (int mi = 0; mi < 2; ++mi)
#pragma unroll
        for (int g = 0; g < 4; ++g)
          *(u32x2*)(stg + (mi * 32 + r) * 72 + ni * 32 + 8 * g + 4 * h) = pk4(tot[mi][ni][4 * g], tot[mi][ni][4 * g + 1], tot[mi][ni][4 * g + 2], tot[mi][ni][4 * g + 3]);
    asm volatile("s_waitcnt lgkmcnt(0)" ::: "memory");
    __builtin_amdgcn_wave_barrier();
    const int tok0 = m0 + wr * 64, col0 = n0 + wc * 64;
#pragma unroll
    for (int it = 0; it < 8; ++it) {
      const int row = it * 8 + (lane >> 3), ch = (lane & 7) * 8;
      const bf16x8 val = *(const bf16x8*)(stg + row * 72 + ch);
      *(bf16x8*)(YM + (size_t)(tok0 + row) * 1024 + col0 + ch) = val;
    }
  }
}

DI void p4b_tile(const Params& p, int layer, int half, int mt, int nt, unsigned char* smem) {
  bf16_t* As = (bf16_t*)smem; bf16_t* Bs = As + 2 * 9216;
  const int tid = otid(), lane = tid & 63, wave = tid >> 6, wr = wave >> 1, wc = wave & 1, r = lane & 31, h = lane >> 5;
  const int m0 = mt * 128, n0 = nt * 128;
  f32x16 acc[2][2]; zero_acc(acc);
  PlainA al{(const bf16_t*)(p.ws + O_YM), 1024};
  gemm_kloop(al, (const bf16_t*)(p.ws + O_WTOUT + layer * SZ_WTOUT1), 1024, 16, m0, n0, acc, As, Bs);
  const float* xin = layer == 0 ? p.x : p.out;
  const float alpha = 1.4142135623730951f;
#pragma unroll
  for (int mi = 0; mi < 2; ++mi) {
    const size_t gt = (size_t)half * TH + m0 + wr * 64 + mi * 32 + r;
#pragma unroll
    for (int ni = 0; ni < 2; ++ni)
#pragma unroll
      for (int g = 0; g < 4; ++g) {
        const int col = n0 + wc * 64 + ni * 32 + 8 * g + 4 * h;
        const f32x4 xv = *(const f32x4*)(xin + gt * 1024 + col);
        f32x4 o;
#pragma unroll
        for (int e = 0; e < 4; ++e) o[e] = alpha * xv[e] + acc[mi][ni][4 * g + e];
        *(f32x4*)(p.out + gt * 1024 + col) = o;
      }
  }
}

DI void gemm8_kloop(const bf16_t* __restrict__ Ab, int lda, const bf16_t* __restrict__ Bb, int ldb, int nkt, f32x4 (&acc)[4][4], unsigned char* lds) {
  const int tid = rtid(), wid = tid >> 6, lane = tid & 63, wr = wid >> 1, wc = wid & 1, fr = lane & 15, fq = lane >> 4;
  int aOff[4], bOff[2];
#pragma unroll
  for (int i = 0; i < 4; ++i) { int R, C; g_stage_rc(wid * 1024 + i * 8192 + lane * 16, R, C); aOff[i] = R * lda + C; }
#pragma unroll
  for (int i = 0; i < 2; ++i) { int R, C; g_stage_rc(wid * 1024 + i * 8192 + lane * 16, R, C); bOff[i] = R * ldb + C; }
  auto stage = [&](int buf, int kt) {
#pragma unroll
    for (int i = 0; i < 4; ++i)
      __builtin_amdgcn_global_load_lds((const unsigned*)(Ab + aOff[i] + kt * 64), (unsigned*)(lds + buf * 49152 + wid * 1024 + i * 8192), 16, 0, 0);
#pragma unroll
    for (int i = 0; i < 2; ++i)
      __builtin_amdgcn_global_load_lds((const unsigned*)(Bb + bOff[i] + kt * 64), (unsigned*)(lds + buf * 49152 + 32768 + wid * 1024 + i * 8192), 16, 0, 0);
  };
  const int lane_off = (fr * 64 + fq * 16) ^ ((fr >> 3) << 5);
  __syncthreads();
  stage(0, 0);
  asm volatile("s_waitcnt vmcnt(0)" ::: "memory");
  __syncthreads();
#pragma unroll 1
  for (int t = 0; t < nkt; ++t) {
    const int cur = t & 1;
    if (t + 1 < nkt) stage(cur ^ 1, t + 1);
    const unsigned char* SA = lds + cur * 49152 + wr * 8192 + lane_off;
    const unsigned char* SB = lds + cur * 49152 + 32768 + wc * 8192 + lane_off;
#pragma unroll
    for (int ks = 0; ks < 2; ++ks) {
      bf16x8 At[4], Bf[4];
#pragma unroll
      for (int n = 0; n < 4; ++n) Bf[n] = *(const bf16x8*)(SB + n * 2048 + ks * 1024);
#pragma unroll
      for (int m = 0; m < 4; ++m) At[m] = *(const bf16x8*)(SA + m * 2048 + ks * 1024);
#pragma unroll
      for (int m = 0; m < 4; ++m)
#pragma unroll
        for (int n = 0; n < 4; ++n) acc[m][n] = MFMA16(Bf[n], At[m], acc[m][n]);
    }
    asm volatile("s_waitcnt vmcnt(0)" ::: "memory");
    __syncthreads();
  }
}

DI void p4a_unit(const Params& p, int layer, int pm, int pn, unsigned char* lds) {
  const int tid = rtid(), wid = tid >> 6, lane = tid & 63, wr = wid >> 1, wc = wid & 1, fr = lane & 15, fq = lane >> 4;
  const int tok0 = pm * 256 + wr * 64, col0 = pn * 128 + wc * 64;
  const bf16_t* SIG = (const bf16_t*)(p.ws + O_SIG);
  const bf16_t* Ab = (const bf16_t*)(p.ws + O_SZ) + (size_t)pm * 256 * 1920;
  const bf16_t* Bb = (const bf16_t*)(p.ws + O_WTBR) + (size_t)layer * 5 * 1024 * 384 + (size_t)pn * 128 * 384;
  int aOff[4], bOff[2];
#pragma unroll
  for (int i = 0; i < 4; ++i) { int R, C; g_stage_rc(wid * 1024 + i * 8192 + lane * 16, R, C); aOff[i] = R * 1920 + C; }
#pragma unroll
  for (int i = 0; i < 2; ++i) { int R, C; g_stage_rc(wid * 1024 + i * 8192 + lane * 16, R, C); bOff[i] = R * 384 + C; }
  auto stage = [&](int buf, int T) {
    const int nb = T / 6, kk = T - nb * 6;
    const long bo = (long)nb * (1024 * 384) + kk * 64;
#pragma unroll
    for (int i = 0; i < 4; ++i)
      __builtin_amdgcn_global_load_lds((const unsigned*)(Ab + aOff[i] + T * 64), (unsigned*)(lds + buf * 49152 + wid * 1024 + i * 8192), 16, 0, 0);
#pragma unroll
    for (int i = 0; i < 2; ++i)
      __builtin_amdgcn_global_load_lds((const unsigned*)(Bb + bOff[i] + bo), (unsigned*)(lds + buf * 49152 + 32768 + wid * 1024 + i * 8192), 16, 0, 0);
  };
  f32x4 tot[4][4], acc[4][4];
#pragma unroll
  for (int m = 0; m < 4; ++m)
#pragma unroll
    for (int n = 0; n < 4; ++n) { tot[m][n] = (f32x4){0.f, 0.f, 0.f, 0.f}; acc[m][n] = (f32x4){0.f, 0.f, 0.f, 0.f}; }
  const int lane_off = (fr * 64 + fq * 16) ^ ((fr >> 3) << 5);
  __syncthreads();
  stage(0, 0);
  asm volatile("s_waitcnt vmcnt(0)" ::: "memory");
  __syncthreads();
#pragma unroll 1
  for (int t = 0; t < 30; ++t) {
    const int cur = t & 1;
    if (t + 1 < 30) stage(cur ^ 1, t + 1);
    const unsigned char* SA = lds + cur * 49152 + wr * 8192 + lane_off;
    const unsigned char* SB = lds + cur * 49152 + 32768 + wc * 8192 + lane_off;
#pragma unroll
    for (int ks = 0; ks < 2; ++ks) {
      bf16x8 At[4], Bf[4];
#pragma unroll
      for (int n = 0; n < 4; ++n) Bf[n] = *(const bf16x8*)(SB + n * 2048 + ks * 1024);
#pragma unroll
      for (int m = 0; m < 4; ++m) At[m] = *(const bf16x8*)(SA + m * 2048 + ks * 1024);
#pragma unroll
      for (int m = 0; m < 4; ++m)
#pragma unroll
        for (int n = 0; n < 4; ++n) acc[m][n] = MFMA16(Bf[n], At[m], acc[m][n]);
    }
    const int nb = t / 6;
    if (t - nb * 6 == 5) {
#pragma unroll
      for (int m = 0; m < 4; ++m) {
        const int tok = tok0 + m * 16 + fr;
#pragma unroll
        for (int n = 0; n < 4; ++n) {
          const u32x2 sg = *(const u32x2*)(SIG + (size_t)tok * 5120 + nb * 1024 + col0 + n * 16 + fq * 4);
          tot[m][n][0] += bflo(sg.x) * acc[m][n][0]; tot[m][n][1] += bfhi(sg.x) * acc[m][n][1];
          tot[m][n][2] += bflo(sg.y) * acc[m][n][2]; tot[m][n][3] += bfhi(sg.y) * acc[m][n][3];
          acc[m][n] = (f32x4){0.f, 0.f, 0.f, 0.f};
        }
      }
    }
    asm volatile("s_waitcnt vmcnt(0)" ::: "memory");
    __syncthreads();
  }
  bf16_t* YM = (bf16_t*)(p.ws + O_YM);
  bf16_t* stg = (bf16_t*)(lds + wid * 9216);
#pragma unroll
  for (int m = 0; m < 4; ++m)
#pragma unroll
    for (int n = 0; n < 4; ++n) *(u32x2*)(stg + (m * 16 + fr) * 72 + n * 16 + fq * 4) = pk4(tot[m][n][0], tot[m][n][1], tot[m][n][2], tot[m][n][3]);
  asm volatile("s_waitcnt lgkmcnt(0)" ::: "memory");
  __builtin_amdgcn_wave_barrier();
#pragma unroll
  for (int it = 0; it < 8; ++it) {
    const int row = it * 8 + (lane >> 3), ch = (lane & 7) * 8;
    const bf16x8 val = *(const bf16x8*)(stg + row * 72 + ch);
    *(bf16x8*)(YM + (size_t)(tok0 + row) * 1024 + col0 + ch) = val;
  }
}

DI void p4b_unit(const Params& p, int layer, int half, int pm, int pn, unsigned char* lds) {
  const int tid = rtid(), wid = tid >> 6, lane = tid & 63, wr = wid >> 1, wc = wid & 1, fr = lane & 15, fq = lane >> 4;
  f32x4 acc[4][4];
#pragma unroll
  for (int m = 0; m < 4; ++m)
#pragma unroll
    for (int n = 0; n < 4; ++n) acc[m][n] = (f32x4){0.f, 0.f, 0.f, 0.f};
  gemm8_kloop((const bf16_t*)(p.ws + O_YM) + (size_t)pm * 256 * 1024, 1024,
              (const bf16_t*)(p.ws + O_WTOUT + layer * SZ_WTOUT1) + (size_t)pn * 128 * 1024, 1024, 16, acc, lds);
  const float* xin = layer == 0 ? p.x : p.out;
  const float alpha = 1.4142135623730951f;
#pragma unroll
  for (int m = 0; m < 4; ++m) {
    const size_t gt = (size_t)half * TH + pm * 256 + wr * 64 + m * 16 + fr;
#pragma unroll
    for (int n = 0; n < 4; ++n) {
      const int col = pn * 128 + wc * 64 + n * 16 + fq * 4;
      const f32x4 xv = *(const f32x4*)(xin + gt * 1024 + col);
      f32x4 o;
#pragma unroll
      for (int e = 0; e < 4; ++e) o[e] = alpha * xv[e] + acc[m][n][e];
      *(f32x4*)(p.out + gt * 1024 + col) = o;
    }
  }
}

DI void p4c_row(const Params& p, int layer, size_t gt, bool wxb = true) {
  const int lane = otid() & 63;
  float* row = p.out + gt * 1024;
  f32x4 v[4]; float s = 0.f;
#pragma unroll
  for (int j = 0; j < 4; ++j) { v[j] = *(const f32x4*)(row + 4 * lane + 256 * j); s += v[j][0] + v[j][1] + v[j][2] + v[j][3]; }
#pragma unroll
  for (int o = 32; o >= 1; o >>= 1) s += __shfl_xor(s, o);
  const float mu = s * (1.f / 1024.f); float q = 0.f;
#pragma unroll
  for (int j = 0; j < 4; ++j) { v[j] -= mu; q += v[j][0] * v[j][0] + v[j][1] * v[j][1] + v[j][2] * v[j][2] + v[j][3] * v[j][3]; }
#pragma unroll
  for (int o = 32; o >= 1; o >>= 1) q += __shfl_xor(q, o);
  const float rs = rsqrtf(q * (1.f / 1024.f) + 1e-5f);
  bf16_t* xb = (bf16_t*)(p.ws + O_XB) + gt * 1024;
#pragma unroll
  for (int j = 0; j < 4; ++j) {
    const int c = 4 * lane + 256 * j;
    const f32x4 g = *(const f32x4*)(p.ln_g + layer * 1024 + c), b = *(const f32x4*)(p.ln_b + layer * 1024 + c);
    f32x4 y;
#pragma unroll
    for (int e = 0; e < 4; ++e) y[e] = v[j][e] * rs * g[e] + b[e];
    *(f32x4*)(row + c) = y;
    if (wxb) *(u32x2*)(xb + c) = pk4(y[0], y[1], y[2], y[3]);
  }
}


#define XB_TMO      128
#define XB_XCNT(j)  (256  + 64 * (j))
#define XB_XSUB(j)  (1280 + 64 * (j))
#define XB_XGEN(j)  (2304 + 64 * (j))
#define XB_TOP      3328
#define XB_TOPGEN   3392
#define XB_SPIN_CAP (1u << 22)
#define LAS __attribute__((address_space(3)))
DI unsigned xb_ld(unsigned* p) { return __hip_atomic_load(p, __ATOMIC_RELAXED, __HIP_MEMORY_SCOPE_AGENT); }
DI unsigned xb_add(unsigned* p, unsigned v) { return __hip_atomic_fetch_add(p, v, __ATOMIC_RELAXED, __HIP_MEMORY_SCOPE_AGENT); }
DI unsigned xb_xcc_id() { return (unsigned)__builtin_amdgcn_s_getreg((3 << 11) | 20) & 0xFu; }
#define XB_SPIN(cond, bar) do { unsigned _sp = 0; while (cond) { __builtin_amdgcn_s_sleep(1); \
    if ((++_sp & 255u) == 0u) { if (xb_ld(&(bar)[XB_TMO])) break; if (_sp > XB_SPIN_CAP) { atomicAdd(&(bar)[XB_TMO], 1u); break; } } } } while (0)
struct XcdBarrier { unsigned* bar; unsigned x; volatile LAS unsigned* st; };
DI XcdBarrier xcd_barrier_post(unsigned* bar, volatile LAS unsigned* st) {
  XcdBarrier b; b.bar = bar; b.x = xb_xcc_id(); b.st = st;
  if (threadIdx.x == 0) (void)xb_add(&bar[XB_XCNT(b.x)], 1u);
  return b;
}
DI void xcd_barrier_complete(unsigned* bar, unsigned x, unsigned& nloc, unsigned& nx) {
  const unsigned G = gridDim.x;
  unsigned sum, cnt, mine, sp = 0u;
  for (;;) {
    sum = 0u; cnt = 0u; mine = 0u;
#pragma unroll
    for (unsigned j = 0; j < 16; ++j) { const unsigned c = xb_ld(&bar[XB_XCNT(j)]); sum += c; cnt += (c > 0u) ? 1u : 0u; mine = (j == x) ? c : mine; }
    if (sum == G) break;
    __builtin_amdgcn_s_sleep(1);
    if ((++sp & 255u) == 0u) { if (xb_ld(&bar[XB_TMO])) break; if (sp > XB_SPIN_CAP) { atomicAdd(&bar[XB_TMO], 1u); break; } }
  }
  nloc = mine > 0u ? mine : 1u; nx = cnt > 0u ? cnt : 1u;
}
DI void xcd_barrier(const XcdBarrier& b) {
  asm volatile("s_waitcnt vmcnt(0)" ::: "memory");
  __syncthreads();
  if (threadIdx.x == 0) {
    unsigned* bar = b.bar;
    __builtin_amdgcn_s_waitcnt(0);
    unsigned nloc = b.st[0], nx = b.st[1];
    if (nloc == 0u) { xcd_barrier_complete(bar, b.x, nloc, nx); b.st[0] = nloc; b.st[1] = nx; }
    const unsigned old = xb_add(&bar[XB_XSUB(b.x)], 1u);
    const unsigned gen = old / nloc;
    if (old + 1u == (gen + 1u) * nloc) {
      __builtin_amdgcn_fence(__ATOMIC_RELEASE, "agent");
      asm volatile("s_waitcnt vmcnt(0)" ::: "memory");
      const unsigned og = xb_add(&bar[XB_TOP], 1u);
      const unsigned tg = og / nx;
      if (og + 1u == (tg + 1u) * nx) xb_add(&bar[XB_TOPGEN], 1u);
      else XB_SPIN(xb_ld(&bar[XB_TOPGEN]) == tg, bar);
      __builtin_amdgcn_fence(__ATOMIC_ACQUIRE, "agent");
      xb_add(&bar[XB_XGEN(b.x)], 1u);
      asm volatile("s_waitcnt vmcnt(0)" ::: "memory");
    } else {
      XB_SPIN(xb_ld(&bar[XB_XGEN(b.x)]) == gen, bar);
      __builtin_amdgcn_fence(__ATOMIC_ACQUIRE, "agent");
      asm volatile("s_waitcnt vmcnt(0)" ::: "memory");
    }
  }
  __syncthreads();
}

#ifdef PROBE_A
#define STAMP(k) do { if (blockIdx.x == 0 && otid() == 0) { unsigned long long now_ = __builtin_amdgcn_s_memrealtime(); tsacc[k] += (float)(now_ - tlast) * 0.01f; tlast = now_; } } while (0)
#else
#define STAMP(k) do {} while (0)
#endif
__global__ void __launch_bounds__(512, 2) mega(Params p) {
  extern __shared__ __attribute__((aligned(16))) unsigned char smem_all[];
  cg::grid_group grid = cg::this_grid();
  if (p.ws == nullptr) grid.sync();
  volatile LAS unsigned* xbst = (volatile LAS unsigned*)(smem_all + 2 * SUB_LDS);
  if (threadIdx.x < 4) xbst[threadIdx.x] = 0u;
  __syncthreads();
  const XcdBarrier xb = xcd_barrier_post((unsigned*)(p.ws + O_BAR), xbst);
#define GSYNC() xcd_barrier(xb)
  const int sub = __builtin_amdgcn_readfirstlane(__builtin_amdgcn_workitem_id_x() >> 8);
  unsigned char* smem = smem_all + sub * SUB_LDS;
  const int vb = (int)blockIdx.x * 2 + sub, vgrid = (int)gridDim.x * 2;
  const int wave = otid() >> 6;
  const int gw = vb * 4 + wave, ngw = vgrid * 4;
  phase0(p, smem, vb, vgrid);
  GSYNC();
  int pend_layer = -1, pend_half = 0;
  for (int itn = 0; itn < 4; ++itn) {
    const int layer = itn >> 1, half = itn & 1;
    if (pend_layer >= 0) { for (int rw = gw; rw < TH; rw += ngw) p4c_row(p, pend_layer, (size_t)pend_half * TH + rw, true); pend_layer = -1; }
    for (int t = (int)blockIdx.x; t < 32 * 54; t += (int)gridDim.x) {
      const int tn = t + (int)gridDim.x;
      p1_unit(p, layer, half, t & 31, t >> 5, tn < 32 * 54 ? (tn & 31) : 0, tn < 32 * 54 ? (tn >> 5) : -1, t == (int)blockIdx.x, smem_all);
    }
    GSYNC();
    {
      constexpr int N_FOX = 6, N_GDN = 768, N_MKV = 12, N_KM = 48, TOT = N_FOX + N_GDN + N_MKV + N_KM;
      for (int t = vb; t < TOT; t += vgrid) {
        int i = t;
        if (i < N_FOX) { fox_prep(p, i, smem); continue; }
        i -= N_FOX;
        if (i < N_GDN) { gdn_prep(p, layer, half, i / 128, i % 128, smem); continue; }
        i -= N_GDN;
        if (i < N_MKV) { memkv_tile(p, layer, half, i / 6, i % 6, smem); continue; }
        i -= N_MKV;
        kmean_prep(p, i * 4 + wave, (unsigned*)(p.ws + O_CTL) + 64 + (layer * 2 + half) * 8);
      }
    }
    if (vb >= 256) { for (int a = (vb - 256) * 4 + wave; a < 1536; a += (vgrid - 256) * 4) moba_select(p, a); }
    GSYNC();
    phase3(p, half, (unsigned*)(p.ws + O_CTL) + layer * 2 + half, (const unsigned*)(p.ws + O_CTL) + 64 + (layer * 2 + half) * 8, smem, sub);
    GSYNC();
    for (int ci = vb * 256 + otid(); ci < TH * 240; ci += vgrid * 256) gbuild_chunk(p, layer, ci / 240, ci % 240);
    GSYNC();
    for (int t = (int)blockIdx.x; t < 256; t += (int)gridDim.x) p4a_unit(p, layer, t & 31, t >> 5, smem_all);
    GSYNC();
    for (int t = (int)blockIdx.x; t < 256; t += (int)gridDim.x) p4b_unit(p, layer, half, t & 31, t >> 5, smem_all);
    GSYNC();
    pend_layer = layer; pend_half = half;
  }
  if (pend_layer >= 0) { for (int rw = gw; rw < TH; rw += ngw) p4c_row(p, pend_layer, (size_t)pend_half * TH + rw, true); }
}

extern "C" void kernel_launch(void* const* d_in, const int* in_sizes, int n_in, void* d_out, int out_size, void* d_ws, size_t ws_size,
                              hipStream_t stream) {
  static int grid_blocks = 0;
  if (grid_blocks == 0) {
    if (ws_size < WS_END) { fprintf(stderr, "workspace too small: %zu < %zu\n", ws_size, (size_t)WS_END); grid_blocks = -1; return; }
    int dev = 0, cus = 0, per_cu = 0;
    (void)hipGetDevice(&dev);
    (void)hipDeviceGetAttribute(&cus, hipDeviceAttributeMultiprocessorCount, dev);
    (void)hipFuncSetAttribute((const void*)mega, hipFuncAttributeMaxDynamicSharedMemorySize, LDS_BYTES);
    (void)hipOccupancyMaxActiveBlocksPerMultiprocessor(&per_cu, (const void*)mega, 512, LDS_BYTES);
    if (per_cu < 1) per_cu = 1;
    if (per_cu > 1) per_cu = 1;
    grid_blocks = cus * per_cu;
  }
  if (grid_blocks < 0) return;
  (void)hipMemsetAsync((char*)d_ws + O_CTL, 0, 32768, stream);
  Params p{};
  p.x = (const float*)d_in[0]; p.mem = (const float*)d_in[1]; p.mem_g = (const float*)d_in[2]; p.mem_b = (const float*)d_in[3];
  p.w_in = (const float*)d_in[4]; p.b_in = (const float*)d_in[5]; p.conv_w = (const float*)d_in[6]; p.a_log = (const float*)d_in[7];
  p.dt_bias = (const float*)d_in[8]; p.gdn_w = (const float*)d_in[9]; p.w_kv = (const float*)d_in[10]; p.w_br = (const float*)d_in[11];
  p.w_out = (const float*)d_in[12]; p.ln_g = (const float*)d_in[13]; p.ln_b = (const float*)d_in[14];
  p.out = (float*)d_out; p.ws = (unsigned char*)d_ws;
  void* args[] = {&p};
  hipError_t e = hipLaunchCooperativeKernel((const void*)mega, dim3(grid_blocks), dim3(512), args, LDS_BYTES, stream);
  if (e != hipSuccess) fprintf(stderr, "cooperative launch failed: %s (grid %d)\n", hipGetErrorString(e), grid_blocks);
}
```

```cpp
#include <hip/hip_runtime.h>
#include <hip/hip_cooperative_groups.h>
#include <cstdio>
#include <cstdint>
namespace cg = cooperative_groups;

#define DI __device__ __forceinline__
typedef unsigned short bf16_t;
typedef short bf16x8 __attribute__((ext_vector_type(8)));
typedef short s16x4 __attribute__((ext_vector_type(4)));
typedef float f32x4 __attribute__((ext_vector_type(4)));
typedef float f32x2 __attribute__((ext_vector_type(2)));
typedef float f32x16 __attribute__((ext_vector_type(16)));
typedef unsigned u32x2 __attribute__((ext_vector_type(2)));
typedef unsigned u32x4 __attribute__((ext_vector_type(4)));
typedef __bf16 bfv2 __attribute__((ext_vector_type(2)));

#define MFMA32(a, b, c) __builtin_amdgcn_mfma_f32_32x32x16_bf16((a), (b), (c), 0, 0, 0)
#define MFMA16(a, b, c) __builtin_amdgcn_mfma_f32_16x16x32_bf16((a), (b), (c), 0, 0, 0)

DI unsigned pk2(float a, float b) { f32x2 v = {a, b}; return __builtin_bit_cast(unsigned, __builtin_convertvector(v, bfv2)); }
DI bf16_t f2bf(float a) { return (bf16_t)(pk2(a, 0.f) & 0xffffu); }
DI float bf2f(bf16_t v) { return __uint_as_float(((unsigned)v) << 16); }
DI float bflo(unsigned u) { return __uint_as_float(u << 16); }
DI float bfhi(unsigned u) { return __uint_as_float(u & 0xffff0000u); }
DI int rtid() { int t = __builtin_amdgcn_workitem_id_x(); asm volatile("" : "+v"(t)); return t; }
DI int otid() { return rtid() & 255; }
extern __shared__ __attribute__((aligned(16))) unsigned char g_lds_all[];
#define LAS3 __attribute__((address_space(3)))
DI void sub_sync() {
  asm volatile("s_waitcnt lgkmcnt(0)" ::: "memory");
  const int t = __builtin_amdgcn_workitem_id_x();
  LAS3 unsigned* c = (LAS3 unsigned*)(g_lds_all + 2 * 75776 + 8) + (t >> 8);
  if ((t & 63) == 0) {
    const unsigned old = __hip_atomic_fetch_add(c, 1u, __ATOMIC_RELAXED, __HIP_MEMORY_SCOPE_WORKGROUP);
    const unsigned target = (old / 4u + 1u) * 4u;
    while (__hip_atomic_load(c, __ATOMIC_RELAXED, __HIP_MEMORY_SCOPE_WORKGROUP) < target) __builtin_amdgcn_s_sleep(1);
  }
  asm volatile("s_waitcnt lgkmcnt(0)" ::: "memory");
}
DI int crow(int i, int h) { return (i & 3) + 8 * (i >> 2) + 4 * h; }
DI float fsigmoid(float v) { return __builtin_amdgcn_rcpf(1.f + __expf(-v)); }
DI float fsilu(float v) { return v * fsigmoid(v); }
DI u32x2 pk4(float a, float b, float c, float d) { u32x2 r; r.x = pk2(a, b); r.y = pk2(c, d); return r; }
DI bf16x8 pk8(const float* v) { u32x4 r; r.x = pk2(v[0], v[1]); r.y = pk2(v[2], v[3]); r.z = pk2(v[4], v[5]); r.w = pk2(v[6], v[7]); return __builtin_bit_cast(bf16x8, r); }
DI void unpk8(bf16x8 x, float* v) { u32x4 u = __builtin_bit_cast(u32x4, x); v[0] = bflo(u.x); v[1] = bfhi(u.x); v[2] = bflo(u.y); v[3] = bfhi(u.y); v[4] = bflo(u.z); v[5] = bfhi(u.z); v[6] = bflo(u.w); v[7] = bfhi(u.w); }

constexpr int NB = 2, SQ = 8192, NT = NB * SQ, DM = 1024, NH = 6, BW = 384;
constexpr int TH = 8192;
constexpr int NP = 13824;
constexpr int DIN = 13586;
constexpr float LOG2E = 1.4426950408889634f;
#define NEG_INF (-__builtin_inff())

constexpr int C_AQK = 0, C_AV = 768, C_BQK = 1152, C_BV = 3456, C_CQK = 3840, C_CV = 4608, C_D = 4992, C_E = 6144, C_SM = 6528, C_SMEND = 6546, C_Z = 6656, C_MG = 8576;

__host__ __device__ constexpr int inmap(int n) {
  return n < 4992 ? n : n < 6144 ? n + 6 : n < 6528 ? n + 18 : n < 6534 ? n - 1536 : n < 6546 ? n - 384 : n < 6656 ? -1 : n < 13696 ? n - 110 : -1;
}

constexpr size_t O_CTL = 0;
constexpr size_t O_BAR = 4096;
constexpr size_t O_WTIN = 32768;
constexpr size_t SZ_WTIN1 = (size_t)NP * 1024 * 2;
constexpr size_t O_WTBR = O_WTIN + 2 * SZ_WTIN1;
constexpr size_t SZ_WTBR1 = (size_t)5 * 1024 * 384 * 2;
constexpr size_t O_WTOUT = O_WTBR + 2 * SZ_WTBR1;
constexpr size_t SZ_WTOUT1 = (size_t)1024 * 1024 * 2;
constexpr size_t O_WTKV = O_WTOUT + 2 * SZ_WTOUT1;
constexpr size_t SZ_WTKV1 = (size_t)768 * 1024 * 2;
constexpr size_t O_BIASP = O_WTKV + 2 * SZ_WTKV1;
constexpr size_t O_XB = O_BIASP + (size_t)2 * NP * 4;
constexpr size_t O_MEMN = O_XB + (size_t)NT * 1024 * 2;
constexpr size_t O_MEMK = O_MEMN + (size_t)512 * 1024 * 2;
constexpr size_t O_MEMVT = O_MEMK + (size_t)512 * 384 * 2;
constexpr size_t O_QKA = O_MEMVT + (size_t)512 * 384 * 2;
constexpr size_t SZ_VT = (size_t)384 * TH * 2;
constexpr size_t O_KFA = O_QKA + SZ_VT;
constexpr size_t O_VTA = O_KFA + SZ_VT;
constexpr size_t O_QKB = O_VTA + SZ_VT;
constexpr size_t O_KFB = O_QKB + 3 * SZ_VT;
constexpr size_t O_VTB = O_KFB + 3 * SZ_VT;
constexpr size_t O_QKC = O_VTB + 3 * SZ_VT;
constexpr size_t O_KFC = O_QKC + SZ_VT;
constexpr size_t O_VTC = O_KFC + SZ_VT;
constexpr size_t O_QKVD = O_VTC + SZ_VT;
constexpr size_t O_QE = O_QKVD + (size_t)TH * 1152 * 2;
constexpr size_t O_SM = O_QE + (size_t)TH * 384 * 2;
constexpr size_t O_FF = O_SM + (size_t)TH * 32 * 4;
constexpr size_t O_KM = O_FF + (size_t)6 * TH * 4;
constexpr size_t O_KMAX = O_KM + (size_t)2 * 6 * 32 * 64 * 2;
constexpr size_t O_GL = O_KMAX + 256;
constexpr size_t O_MASK = O_GL + 6 * 128 * 4;
constexpr size_t O_KSUM = O_MASK + (size_t)TH * 8 * 4;
constexpr size_t O_DPREP = O_KSUM + (size_t)32 * 2 * 384 * 4;
constexpr size_t O_SZ = O_DPREP + (size_t)768 * 32768;
constexpr size_t O_SIG = O_SZ + (size_t)TH * 1920 * 2;
constexpr size_t O_OA = O_SIG + (size_t)TH * 5120 * 2;
constexpr size_t SZ_O = (size_t)TH * 384 * 2;
constexpr size_t O_STA = O_OA + 4 * SZ_O;
constexpr size_t O_OB = O_STA + (size_t)4 * TH * 6 * 2 * 4;
constexpr size_t O_STB = O_OB + 3 * SZ_O;
constexpr size_t O_OC = O_STB + (size_t)3 * TH * 6 * 2 * 4;
constexpr size_t O_OD = O_OC + SZ_O;
constexpr size_t O_SSQ = O_OD + SZ_O;
constexpr size_t O_OE = O_SSQ + (size_t)TH * 6 * 4 * 4;
constexpr size_t WS_END = O_OE + SZ_O;
constexpr size_t O_YM = O_QKB;
static_assert(WS_END < (size_t)443 * 1000 * 1000, "workspace too large");

struct Params {
  const float *x, *mem, *mem_g, *mem_b, *w_in, *b_in, *conv_w, *a_log, *dt_bias, *gdn_w, *w_kv, *w_br, *w_out, *ln_g, *ln_b;
  float* out;
  unsigned char* ws;
};

constexpr int SUB_LDS = 75776;
constexpr int LDS_BYTES = 2 * SUB_LDS + 16;
#ifndef PH_MASK
#define PH_MASK 0xFFFF
#endif
#define PH(x) ((PH_MASK >> (x)) & 1)
#ifndef REP_MASK
#define REP_MASK 0
#endif
#define REP(x) (1 + ((REP_MASK >> (x)) & 1))

DI void transpose_tile(const float* __restrict__ src, int ld, int k0, int n0, bool usemap, bf16_t* __restrict__ dst, int dstld, float* tile) {
  const int tid = otid();
#pragma unroll
  for (int it = 0; it < 16; ++it) {
    const int kk = (tid >> 6) + 4 * it, n2 = (tid & 63) * 2;
    const int sc = usemap ? inmap(n0 + n2) : (n0 + n2);
    f32x2 v = {0.f, 0.f};
    if (sc >= 0) v = *(const f32x2*)(src + (size_t)(k0 + kk) * ld + sc);
    *(f32x2*)(tile + kk * 130 + n2) = v;
  }
  sub_sync();
#pragma unroll
  for (int it = 0; it < 4; ++it) {
    const int nn = (tid >> 3) + 32 * it, kc = (tid & 7) * 8;
    float v[8];
#pragma unroll
    for (int e = 0; e < 8; ++e) v[e] = tile[(kc + e) * 130 + nn];
    *(bf16x8*)(dst + (size_t)(n0 + nn) * dstld + k0 + kc) = pk8(v);
  }
  sub_sync();
}

DI void transpose_in_pair(const Params& p, int iA, int iB, float* tile) {
  const int tid = otid();
  const float* srcA; const float* srcB; bf16_t* dstA; bf16_t* dstB; int k0A, n0A, k0B, n0B;
  { const int l = iA / (108 * 16), rr = iA % (108 * 16); srcA = p.w_in + (size_t)l * 1024 * DIN; dstA = (bf16_t*)(p.ws + O_WTIN + l * SZ_WTIN1); n0A = (rr / 16) * 128; k0A = (rr % 16) * 64; }
  const bool hasB = iB >= 0;
  { const int i = hasB ? iB : iA; const int l = i / (108 * 16), rr = i % (108 * 16); srcB = p.w_in + (size_t)l * 1024 * DIN; dstB = (bf16_t*)(p.ws + O_WTIN + l * SZ_WTIN1); n0B = (rr / 16) * 128; k0B = (rr % 16) * 64; }
  float* tileB = tile + 64 * 130;
  f32x2 va[16], vb2[16];
#pragma unroll
  for (int it = 0; it < 16; ++it) {
    const int kk = (tid >> 6) + 4 * it, n2 = (tid & 63) * 2;
    const int scA = inmap(n0A + n2), scB = inmap(n0B + n2);
    va[it] = (f32x2){0.f, 0.f}; vb2[it] = (f32x2){0.f, 0.f};
    if (scA >= 0) va[it] = *(const f32x2*)(srcA + (size_t)(k0A + kk) * DIN + scA);
    if (scB >= 0) vb2[it] = *(const f32x2*)(srcB + (size_t)(k0B + kk) * DIN + scB);
  }
#pragma unroll
  for (int it = 0; it < 16; ++it) {
    const int kk = (tid >> 6) + 4 * it, n2 = (tid & 63) * 2;
    *(f32x2*)(tile + kk * 130 + n2) = va[it];
    *(f32x2*)(tileB + kk * 130 + n2) = vb2[it];
  }
  sub_sync();
#pragma unroll
  for (int it = 0; it < 4; ++it) {
    const int nn = (tid >> 3) + 32 * it, kc = (tid & 7) * 8;
    float v[8], w[8];
#pragma unroll
    for (int e = 0; e < 8; ++e) { v[e] = tile[(kc + e) * 130 + nn]; w[e] = tileB[(kc + e) * 130 + nn]; }
    *(bf16x8*)(dstA + (size_t)(n0A + nn) * 1024 + k0A + kc) = pk8(v);
    if (hasB) *(bf16x8*)(dstB + (size_t)(n0B + nn) * 1024 + k0B + kc) = pk8(w);
  }
  sub_sync();
}

DI void phase0(const Params& p, unsigned char* smem, int vb, int vgrid) {
  float* tile = (float*)smem;
  const int tid = otid(), lane = tid & 63, wave = tid >> 6;
  constexpr int N_TIN = 2 * 108 * 16, N_TBR = 2 * 5 * 8 * 6, N_TOUT = 2 * 8 * 16, N_TKV = 2 * 6 * 16, N_XB = 1024, N_MEMN = 128, N_BIAS = 108;
  constexpr int TOT = N_TIN + N_TBR + N_TOUT + N_TKV + N_XB + N_MEMN + N_BIAS;
  for (int it = vb; it < N_TIN; it += 2 * vgrid) transpose_in_pair(p, it, it + vgrid < N_TIN ? it + vgrid : -1, tile);
  for (int it = vb; it < TOT - N_TIN; it += vgrid) {
    int i = it;
    if (i < N_TBR) {
      const int ln = i / 48, rr = i % 48, nt = rr / 6, kt = rr % 6;
      transpose_tile(p.w_br + (size_t)ln * 384 * 1024, 1024, kt * 64, nt * 128, false, (bf16_t*)(p.ws + O_WTBR) + (size_t)ln * 1024 * 384, 384, tile);
      continue;
    }
    i -= N_TBR;
    if (i < N_TOUT) {
      const int l = i / 128, rr = i % 128, nt = rr / 16, kt = rr % 16;
      transpose_tile(p.w_out + (size_t)l * 1024 * 1024, 1024, kt * 64, nt * 128, false, (bf16_t*)(p.ws + O_WTOUT + l * SZ_WTOUT1), 1024, tile);
      continue;
    }
    i -= N_TOUT;
    if (i < N_TKV) {
      const int l = i / 96, rr = i % 96, nt = rr / 16, kt = rr % 16;
      transpose_tile(p.w_kv + (size_t)l * 1024 * 768, 768, kt * 64, nt * 128, false, (bf16_t*)(p.ws + O_WTKV + l * SZ_WTKV1), 1024, tile);
      continue;
    }
    i -= N_TKV;
    if (i < N_XB) {
      const float* src = p.x + (size_t)i * 16 * 1024;
      bf16_t* dst = (bf16_t*)(p.ws + O_XB) + (size_t)i * 16 * 1024;
#pragma unroll
      for (int j = 0; j < 16; ++j) {
        const int e = (j * 256 + tid) * 4;
        const f32x4 v = *(const f32x4*)(src + e);
        *(u32x2*)(dst + e) = pk4(v[0], v[1], v[2], v[3]);
      }
      continue;
    }
    i -= N_XB;
    if (i < N_MEMN) {
      const int row = i * 4 + wave;
      const float* src = p.mem + (size_t)row * 1024;
      f32x4 v[4]; float s = 0.f;
#pragma unroll
      for (int j = 0; j < 4; ++j) { v[j] = *(const f32x4*)(src + 4 * lane + 256 * j); s += v[j][0] + v[j][1] + v[j][2] + v[j][3]; }
#pragma unroll
      for (int o = 32; o >= 1; o >>= 1) s += __shfl_xor(s, o);
      const float mu = s * (1.f / 1024.f); float q = 0.f;
#pragma unroll
      for (int j = 0; j < 4; ++j) { v[j] -= mu; q += v[j][0] * v[j][0] + v[j][1] * v[j][1] + v[j][2] * v[j][2] + v[j][3] * v[j][3]; }
#pragma unroll
      for (int o = 32; o >= 1; o >>= 1) q += __shfl_xor(q, o);
      const float rs = rsqrtf(q * (1.f / 1024.f) + 1e-5f);
      bf16_t* dst = (bf16_t*)(p.ws + O_MEMN) + (size_t)row * 1024;
#pragma unroll
      for (int j = 0; j < 4; ++j) {
        const int c = 4 * lane + 256 * j;
        const f32x4 g = *(const f32x4*)(p.mem_g + c), b = *(const f32x4*)(p.mem_b + c);
        *(u32x2*)(dst + c) = pk4(v[j][0] * rs * g[0] + b[0], v[j][1] * rs * g[1] + b[1], v[j][2] * rs * g[2] + b[2], v[j][3] * rs * g[3] + b[3]);
      }
      continue;
    }
    i -= N_MEMN;
    {
      float* bp = (float*)(p.ws + O_BIASP);
      if (tid < 128) {
        const int n = i * 128 + tid;
        const int sc = inmap(n);
        for (int l = 0; l < 2; ++l) bp[l * NP + n] = sc >= 0 ? p.b_in[l * DIN + sc] : 0.f;
      }
    }
  }
}

template <int BK, class AL>
DI void gemm_kloop_t(const AL& al, const bf16_t* __restrict__ Bt, int ldb, int nkt, int m0, int n0, f32x16 (&acc)[2][2], bf16_t* As, bf16_t* Bs) {
  constexpr int CPR = BK / 8, NCH = BK / 16, PITCH = BK + 8, BUF = 128 * PITCH;
  const int tid = otid(), lane = tid & 63, wave = tid >> 6, wr = wave >> 1, wc = wave & 1, r = lane & 31, h = lane >> 5;
  bf16x8 ra[NCH], rb[NCH];
  auto gload = [&](int kt) {
#pragma unroll
    for (int i = 0; i < NCH; ++i) {
      const int cid = tid + 256 * i, row = cid / CPR, kc = (cid % CPR) * 8;
      ra[i] = al(m0 + row, kt * BK + kc);
      rb[i] = *(const bf16x8*)(Bt + (size_t)(n0 + row) * ldb + kt * BK + kc);
    }
  };
  auto lstore = [&](int buf) {
#pragma unroll
    for (int i = 0; i < NCH; ++i) {
      const int cid = tid + 256 * i, row = cid / CPR, kc = (cid % CPR) * 8;
      *(bf16x8*)(As + buf * BUF + row * PITCH + kc) = ra[i];
      *(bf16x8*)(Bs + buf * BUF + row * PITCH + kc) = rb[i];
    }
  };
  gload(0); lstore(0); sub_sync();
  for (int kt = 0; kt < nkt; ++kt) {
    const int buf = kt & 1;
    if (kt + 1 < nkt) gload(kt + 1);
    asm volatile("" ::: "memory");
    const bf16_t* a_ = As + buf * BUF + (wr * 64 + r) * PITCH + 8 * h;
    const bf16_t* b_ = Bs + buf * BUF + (wc * 64 + r) * PITCH + 8 * h;
#pragma unroll
    for (int s = 0; s < BK / 16; ++s) {
      bf16x8 af[2], bfr[2];
      af[0] = *(const bf16x8*)(a_ + 16 * s); af[1] = *(const bf16x8*)(a_ + 32 * PITCH + 16 * s);
      bfr[0] = *(const bf16x8*)(b_ + 16 * s); bfr[1] = *(const bf16x8*)(b_ + 32 * PITCH + 16 * s);
#pragma unroll
      for (int mi = 0; mi < 2; ++mi)
#pragma unroll
        for (int ni = 0; ni < 2; ++ni) acc[mi][ni] = MFMA32(bfr[ni], af[mi], acc[mi][ni]);
    }
    if (kt + 1 < nkt) lstore(buf ^ 1);
    sub_sync();
  }
}
template <class AL>
DI void gemm_kloop(const AL& al, const bf16_t* __restrict__ Bt, int ldb, int nkt, int m0, int n0, f32x16 (&acc)[2][2], bf16_t* As, bf16_t* Bs) {
  gemm_kloop_t<64>(al, Bt, ldb, nkt, m0, n0, acc, As, Bs);
}

DI void zero_acc(f32x16 (&acc)[2][2]) {
#pragma unroll
  for (int a = 0; a < 2; ++a)
#pragma unroll
    for (int b = 0; b < 2; ++b)
#pragma unroll
      for (int i = 0; i < 16; ++i) acc[a][b][i] = 0.f;
}

DI int vfrag_key(int key) { const int kk = key & 31; return (key >> 5) * 2048 + (kk >> 4) * 512 + ((kk >> 2) & 1) * 256 + ((kk >> 3) & 1) * 4 + (kk & 3); }
DI int vfrag_col(int cw) { const int d = cw & 63; return (cw >> 6) * 524288 + (d >> 5) * 1024 + (d & 31) * 8; }

DI int kfrag_key(int key) { return (key >> 5) * 2048 + (key & 31) * 8; }
DI int kfrag_col(int cw) { const int d = cw & 63; return (cw >> 6) * 524288 + (d >> 4) * 512 + ((d >> 3) & 1) * 256 + (d & 7); }

struct PlainA {
  const bf16_t* A; int lda;
  DI bf16x8 operator()(int row, int k) const { return *(const bf16x8*)(A + (size_t)row * lda + k); }
};

DI void p1_tile(const Params& p, int layer, int half, int mt, int nt, unsigned char* smem) {
  sub_sync();
  bf16_t* As = (bf16_t*)smem; bf16_t* Bs = As + 2 * 9216;
  f32x16 acc[2][2]; zero_acc(acc);
  PlainA al{(const bf16_t*)(p.ws + O_XB) + (size_t)half * TH * 1024, 1024};
  const int m0 = mt * 128, n0 = nt * 128;
  gemm_kloop(al, (const bf16_t*)(p.ws + O_WTIN + layer * SZ_WTIN1), 1024, 16, m0, n0, acc, As, Bs);
  const int tid = otid(), lane = tid & 63, wave = tid >> 6, wr = wave >> 1, wc = wave & 1, r = lane & 31, h = lane >> 5;
  const float* bias = (const float*)(p.ws + O_BIASP) + layer * NP;
  unsigned char* ws = p.ws;
  {
    const int nb0 = n0 + wc * 64;
    bf16_t* dst0 = nullptr; int pitch0 = 0, coff0 = 0, xf0 = 0;
    if (nb0 < 384) { dst0 = (bf16_t*)(ws + O_QKA); pitch0 = 384; coff0 = nb0; }
    else if (nb0 >= C_BQK && nb0 < 2304) { dst0 = (bf16_t*)(ws + O_QKB); pitch0 = 1152; coff0 = nb0 - C_BQK; }
    else if (nb0 >= C_CQK && nb0 < 4224) { dst0 = (bf16_t*)(ws + O_QKC); pitch0 = 384; coff0 = nb0 - C_CQK; }
    else if (nb0 >= C_D && nb0 < C_E) { dst0 = (bf16_t*)(ws + O_QKVD); pitch0 = 1152; coff0 = nb0 - C_D; }
    else if (nb0 >= C_E && nb0 < C_SM) { dst0 = (bf16_t*)(ws + O_QE); pitch0 = 384; coff0 = nb0 - C_E; }
    else if (nb0 >= C_Z && nb0 < C_MG) { dst0 = (bf16_t*)(ws + O_SZ); pitch0 = 1920; coff0 = nb0 - C_Z; xf0 = 1; }
    else if (nb0 >= C_MG) { dst0 = (bf16_t*)(ws + O_SIG); pitch0 = 5120; coff0 = nb0 - C_MG; xf0 = 2; }
    if (dst0 != nullptr) {
      bf16_t* stg = (bf16_t*)smem + wave * (64 * 72);
#pragma unroll
      for (int ni = 0; ni < 2; ++ni)
#pragma unroll
        for (int mi = 0; mi < 2; ++mi)
#pragma unroll
          for (int g = 0; g < 4; ++g) {
            const int cq = ni * 32 + 8 * g + 4 * h;
            const f32x4 bv = *(const f32x4*)(bias + nb0 + cq);
            float v[4];
#pragma unroll
            for (int e = 0; e < 4; ++e) v[e] = acc[mi][ni][4 * g + e] + bv[e];
            if (xf0 == 1) {
#pragma unroll
              for (int e = 0; e < 4; ++e) v[e] = fsilu(v[e]);
            } else if (xf0 == 2) {
#pragma unroll
              for (int e = 0; e < 4; ++e) v[e] = fsigmoid(v[e]);
            }
            *(u32x2*)(stg + (mi * 32 + r) * 72 + cq) = pk4(v[0], v[1], v[2], v[3]);
          }
      asm volatile("s_waitcnt lgkmcnt(0)" ::: "memory");
      __builtin_amdgcn_wave_barrier();
      const int tok0 = m0 + wr * 64;
#pragma unroll
      for (int it = 0; it < 8; ++it) {
        const int row = it * 8 + (lane >> 3), ch = (lane & 7) * 8;
        const bf16x8 val = *(const bf16x8*)(stg + row * 72 + ch);
        *(bf16x8*)(dst0 + (size_t)(tok0 + row) * pitch0 + coff0 + ch) = val;
      }
      return;
    }
  }
#pragma unroll
  for (int ni = 0; ni < 2; ++ni) {
    const int nb = n0 + wc * 64 + ni * 32;
    int kind;
    int xf = 0;
    bf16_t* dst = nullptr; int pitch = 0, coff = 0;
    int kgrp = 0;
    if (nb < 384) { kind = 0; dst = (bf16_t*)(ws + O_QKA); pitch = 384; coff = nb; }
    else if (nb < C_AV) { kind = 5; dst = (bf16_t*)(ws + O_KFA); coff = nb - 384; }
    else if (nb < C_BQK) { kind = 1; dst = (bf16_t*)(ws + O_VTA); coff = nb - C_AV; }
    else if (nb < 2304) { kind = 0; dst = (bf16_t*)(ws + O_QKB); pitch = 1152; coff = nb - C_BQK; }
    else if (nb < C_BV) { kind = 5; kgrp = (nb - 2304) / 384; dst = (bf16_t*)(ws + O_KFB + kgrp * SZ_VT); coff = (nb - 2304) - kgrp * 384; }
    else if (nb < C_CQK) { kind = 2; dst = (bf16_t*)(ws + O_VTB); coff = nb - C_BV; }
    else if (nb < 4224) { kind = 0; dst = (bf16_t*)(ws + O_QKC); pitch = 384; coff = nb - C_CQK; }
    else if (nb < C_CV) { kind = 5; dst = (bf16_t*)(ws + O_KFC); coff = nb - 4224; }
    else if (nb < C_D) { kind = 1; dst = (bf16_t*)(ws + O_VTC); coff = nb - C_CV; }
    else if (nb < C_E) { kind = 0; dst = (bf16_t*)(ws + O_QKVD); pitch = 1152; coff = nb - C_D; }
    else if (nb < C_SM) { kind = 0; dst = (bf16_t*)(ws + O_QE); pitch = 384; coff = nb - C_E; }
    else if (nb < C_Z) { kind = (nb == C_SM) ? 3 : 4; }
    else if (nb < C_MG) { kind = 0; xf = 1; dst = (bf16_t*)(ws + O_SZ); pitch = 1920; coff = nb - C_Z; }
    else { kind = 0; xf = 2; dst = (bf16_t*)(ws + O_SIG); pitch = 5120; coff = nb - C_MG; }
    if (kind == 4) continue;
#pragma unroll
    for (int mi = 0; mi < 2; ++mi) {
      const int tok = m0 + wr * 64 + mi * 32 + r;
#pragma unroll
      for (int g = 0; g < 4; ++g) {
        const int cq = 8 * g + 4 * h;
        const f32x4 bv = *(const f32x4*)(bias + nb + cq);
        float v[4];
#pragma unroll
        for (int e = 0; e < 4; ++e) v[e] = acc[mi][ni][4 * g + e] + bv[e];
        if (kind == 0) {
          if (xf == 1) {
#pragma unroll
            for (int e = 0; e < 4; ++e) v[e] = fsilu(v[e]);
          } else if (xf == 2) {
#pragma unroll
            for (int e = 0; e < 4; ++e) v[e] = fsigmoid(v[e]);
          }
          *(u32x2*)(dst + (size_t)tok * pitch + coff + cq) = pk4(v[0], v[1], v[2], v[3]);
        } else if (kind == 5) {
          const int key = kgrp == 0 ? tok : kgrp == 1 ? (tok & 3) * 2048 + (tok >> 2) : (tok & 15) * 512 + (tok >> 4);
          *(u32x2*)(dst + kfrag_col(coff + cq) + kfrag_key(key)) = pk4(v[0], v[1], v[2], v[3]);
        } else if (kind == 1) {
          const int ko = vfrag_key(tok);
#pragma unroll
          for (int e = 0; e < 4; ++e) dst[vfrag_col(coff + cq + e) + ko] = f2bf(v[e]);
        } else if (kind == 2) {
          const int k1 = vfrag_key(tok), k4 = vfrag_key((tok & 3) * 2048 + (tok >> 2)), k16 = vfrag_key((tok & 15) * 512 + (tok >> 4));
#pragma unroll
          for (int e = 0; e < 4; ++e) {
            const bf16_t b = f2bf(v[e]); const int co = vfrag_col(coff + cq + e);
            dst[co + k1] = b; dst[SZ_VT / 2 + co + k4] = b; dst[SZ_VT + co + k16] = b;
          }
        } else {
          float* sm = (float*)(ws + O_SM);
#pragma unroll
          for (int e = 0; e < 4; ++e) if (cq + e < 18) sm[tok * 32 + cq + e] = v[e];
        }
      }
    }
  }
}


DI int g_lds_byte(int r, int c) { const int st = (r >> 4) * 2 + (c >> 5), ob = (r & 15) * 64 + (c & 31) * 2; return st * 1024 + (ob ^ (((ob >> 9) & 1) << 5)); }
DI void g_stage_rc(int b, int& R, int& C) { const int st = b >> 10, sb = b & 1023, swz = sb ^ (((sb >> 9) & 1) << 5); R = (st >> 1) * 16 + (swz >> 6); C = (st & 1) * 32 + ((swz & 63) >> 1); }

DI float row16_sum(float v);
DI void p1_unit(const Params& p, int layer, int half, int pm, int pn, int pm_next, int pn_next  , bool first, unsigned char* lds) {
  const int tid = rtid(), wid = tid >> 6, lane = tid & 63, wr = wid >> 2, wc = wid & 3, fr = lane & 15, fq = lane >> 4;
  const bf16_t* Ab = (const bf16_t*)(p.ws + O_XB) + ((size_t)half * TH + (size_t)pm * 256) * 1024;
  const bf16_t* Bb = (const bf16_t*)(p.ws + O_WTIN + layer * SZ_WTIN1) + (size_t)pn * 256 * 1024;
  int sOff[4];
#pragma unroll
  for (int i = 0; i < 4; ++i) { int R, C; g_stage_rc(wid * 1024 + i * 8192 + lane * 16, R, C); sOff[i] = R * 1024 + C; }
  auto stage2 = [&](const bf16_t* A_, const bf16_t* B_, int buf, int kt) {
#pragma unroll
    for (int i = 0; i < 4; ++i) {
      __builtin_amdgcn_global_load_lds((const unsigned*)(A_ + sOff[i] + kt * 64), (unsigned*)(lds + buf * 65536 + wid * 1024 + i * 8192), 16, 0, 0);
      __builtin_amdgcn_global_load_lds((const unsigned*)(B_ + sOff[i] + kt * 64), (unsigned*)(lds + buf * 65536 + 32768 + wid * 1024 + i * 8192), 16, 0, 0);
    }
  };
  auto stage = [&](int buf, int kt) { stage2(Ab, Bb, buf, kt); };
  f32x4 acc[8][4];
#pragma unroll
  for (int m = 0; m < 8; ++m)
#pragma unroll
    for (int n = 0; n < 4; ++n) acc[m][n] = (f32x4){0.f, 0.f, 0.f, 0.f};
  const int lane_off = (fr * 64 + fq * 16) ^ ((fr >> 3) << 5);
  if (first) { __syncthreads(); stage(0, 0); }
  asm volatile("s_waitcnt vmcnt(0)" ::: "memory");
  __syncthreads();
#pragma unroll 1
  for (int t = 0; t < 16; ++t) {
    const int cur = t & 1;
    {
      const bool last = (t + 1 == 16);
      if (!last || pn_next >= 0) {
        const long dA = last ? (long)(pm_next - pm) * 256 * 1024 - 0 : (long)(t + 1) * 64;
        const long dB = last ? (long)(pn_next - pn) * 256 * 1024 - 0 : (long)(t + 1) * 64;
#pragma unroll
        for (int i = 0; i < 4; ++i) {
          __builtin_amdgcn_global_load_lds((const unsigned*)(Ab + sOff[i] + dA), (unsigned*)(lds + (cur ^ 1) * 65536 + wid * 1024 + i * 8192), 16, 0, 0);
          __builtin_amdgcn_global_load_lds((const unsigned*)(Bb + sOff[i] + dB), (unsigned*)(lds + (cur ^ 1) * 65536 + 32768 + wid * 1024 + i * 8192), 16, 0, 0);
        }
      }
    }
    const unsigned char* SA = lds + cur * 65536 + wr * 16384 + lane_off;
    const unsigned char* SB = lds + cur * 65536 + 32768 + wc * 8192 + lane_off;
    bf16x8 Bf[2][4], At[2][2];
#pragma unroll
    for (int n = 0; n < 4; ++n) Bf[0][n] = *(const bf16x8*)(SB + n * 2048);
#pragma unroll
    for (int m = 0; m < 2; ++m) At[0][m] = *(const bf16x8*)(SA + m * 2048);
#pragma unroll
    for (int g = 0; g < 8; ++g) {
      const int ks = g >> 2, pr = g & 3;
      if (g == 1) {
#pragma unroll
        for (int n = 0; n < 4; ++n) Bf[1][n] = *(const bf16x8*)(SB + n * 2048 + 1024);
      }
      if (g < 7) {
        const int g1 = g + 1;
#pragma unroll
        for (int m = 0; m < 2; ++m) At[g1 & 1][m] = *(const bf16x8*)(SA + ((g1 & 3) * 2 + m) * 2048 + (g1 >> 2) * 1024);
      }
      asm volatile("" : "+v"(acc[pr * 2][0][0]) :: "memory");
#pragma unroll
      for (int m = 0; m < 2; ++m)
#pragma unroll
        for (int n = 0; n < 4; ++n) acc[pr * 2 + m][n] = MFMA16(Bf[ks][n], At[g & 1][m], acc[pr * 2 + m][n]);
    }
    asm volatile("s_waitcnt vmcnt(0)" ::: "memory");
    __syncthreads();
  }
  const int nb0 = pn * 256 + wc * 64, tok0 = pm * 256 + wr * 128;
  const float* bias = (const float*)(p.ws + O_BIASP) + layer * NP;
  unsigned char* ws = p.ws;
  int kind, xf = 0, kgrp = 0, pitch = 0, coff = 0; bf16_t* dst = nullptr;
  if (nb0 < 384) { kind = 0; dst = (bf16_t*)(ws + O_QKA); pitch = 384; coff = nb0; }
  else if (nb0 < C_AV) { kind = 5; dst = (bf16_t*)(ws + O_KFA); coff = nb0 - 384; }
  else if (nb0 < C_BQK) { kind = 1; dst = (bf16_t*)(ws + O_VTA); coff = nb0 - C_AV; }
  else if (nb0 < 2304) { kind = 0; dst = (bf16_t*)(ws + O_QKB); pitch = 1152; coff = nb0 - C_BQK; }
  else if (nb0 < C_BV) { kind = 5; kgrp = (nb0 - 2304) / 384; dst = (bf16_t*)(ws + O_KFB + kgrp * SZ_VT); coff = (nb0 - 2304) - kgrp * 384; }
  else if (nb0 < C_CQK) { kind = 2; dst = (bf16_t*)(ws + O_VTB); coff = nb0 - C_BV; }
  else if (nb0 < 4224) { kind = 0; dst = (bf16_t*)(ws + O_QKC); pitch = 384; coff = nb0 - C_CQK; }
  else if (nb0 < C_CV) { kind = 5; dst = (bf16_t*)(ws + O_KFC); coff = nb0 - 4224; }
  else if (nb0 < C_D) { kind = 1; dst = (bf16_t*)(ws + O_VTC); coff = nb0 - C_CV; }
  else if (nb0 < C_E) { kind = 0; dst = (bf16_t*)(ws + O_QKVD); pitch = 1152; coff = nb0 - C_D; }
  else if (nb0 < C_SM) { kind = 0; dst = (bf16_t*)(ws + O_QE); pitch = 384; coff = nb0 - C_E; }
  else if (nb0 < C_Z) { kind = (nb0 == C_SM) ? 3 : 4; }
  else if (nb0 < C_MG) { kind = 0; xf = 1; dst = (bf16_t*)(ws + O_SZ); pitch = 1920; coff = nb0 - C_Z; }
  else if (nb0 < 13696) { kind = 0; xf = 2; dst = (bf16_t*)(ws + O_SIG); pitch = 5120; coff = nb0 - C_MG; }
  else { kind = 4; }
  if (kind == 4) return;
  if (kind == 0) {
    bf16_t* stg = (bf16_t*)(lds + 65536 + wid * 9216);
#pragma unroll
    for (int mh = 0; mh < 2; ++mh) {
#pragma unroll
      for (int m = 0; m < 4; ++m)
#pragma unroll
        for (int n = 0; n < 4; ++n) {
          const int c4 = n * 16 + fq * 4;
          const f32x4 bv = *(const f32x4*)(bias + nb0 + c4);
          float v[4];
#pragma unroll
          for (int e = 0; e < 4; ++e) v[e] = acc[mh * 4 + m][n][e] + bv[e];
          if (xf == 1) {
#pragma unroll
            for (int e = 0; e < 4; ++e) v[e] = fsilu(v[e]);
          } else if (xf == 2) {
#pragma unroll
            for (int e = 0; e < 4; ++e) v[e] = fsigmoid(v[e]);
          }
          *(u32x2*)(stg + (m * 16 + fr) * 72 + c4) = pk4(v[0], v[1], v[2], v[3]);
        }
      asm volatile("s_waitcnt lgkmcnt(0)" ::: "memory");
      __builtin_amdgcn_wave_barrier();
#pragma unroll
      for (int it = 0; it < 8; ++it) {
        const int row = it * 8 + (lane >> 3), ch = (lane & 7) * 8;
        const bf16x8 val = *(const bf16x8*)(stg + row * 72 + ch);
        *(bf16x8*)(dst + (size_t)(tok0 + mh * 64 + row) * pitch + coff + ch) = val;
      }
      asm volatile("s_waitcnt lgkmcnt(0)" ::: "memory");
      __builtin_amdgcn_wave_barrier();
    }
    return;
  }
  if (nb0 >= 384 && nb0 < C_AV) {
    float* ksum = (float*)(ws + O_KSUM) + (size_t)(pm * 2 + wr) * 384 + (nb0 - 384);
#pragma unroll
    for (int n = 0; n < 4; ++n) {
      const f32x4 bv = *(const f32x4*)(bias + nb0 + n * 16 + fq * 4);
#pragma unroll
      for (int e = 0; e < 4; ++e) {
        float t = 8.f * bv[e];
#pragma unroll
        for (int m = 0; m < 8; ++m) t += acc[m][n][e];
        t = row16_sum(t);
        if (fr == 0) ksum[n * 16 + fq * 4 + e] = t;
      }
    }
  }
#pragma unroll
  for (int m = 0; m < 8; ++m) {
    const int tok = tok0 + m * 16 + fr;
#pragma unroll
    for (int n = 0; n < 4; ++n) {
      const int c4 = n * 16 + fq * 4;
      const f32x4 bv = *(const f32x4*)(bias + nb0 + c4);
      float v[4];
#pragma unroll
      for (int e = 0; e < 4; ++e) v[e] = acc[m][n][e] + bv[e];
      if (kind == 5) {
        const int key = kgrp == 0 ? tok : kgrp == 1 ? (tok & 3) * 2048 + (tok >> 2) : (tok & 15) * 512 + (tok >> 4);
        *(u32x2*)(dst + kfrag_col(coff + c4) + kfrag_key(key)) = pk4(v[0], v[1], v[2], v[3]);
      } else if (kind == 1) {
        const int ko = vfrag_key(tok);
#pragma unroll
        for (int e = 0; e < 4; ++e) dst[vfrag_col(coff + c4 + e) + ko] = f2bf(v[e]);
      } else if (kind == 2) {
        const int k1 = vfrag_key(tok), k4 = vfrag_key((tok & 3) * 2048 + (tok >> 2)), k16 = vfrag_key((tok & 15) * 512 + (tok >> 4));
#pragma unroll
        for (int e = 0; e < 4; ++e) {
          const bf16_t b = f2bf(v[e]); const int co = vfrag_col(coff + c4 + e);
          dst[co + k1] = b; dst[SZ_VT / 2 + co + k4] = b; dst[SZ_VT + co + k16] = b;
        }
      } else {
        float* sm = (float*)(ws + O_SM);
#pragma unroll
        for (int e = 0; e < 4; ++e) if (c4 + e < 18) sm[tok * 32 + c4 + e] = v[e];
      }
    }
  }
}

DI void fox_prep(const Params& p, int hh, unsigned char* smem) {
  float* red = (float*)smem;
  const int tid = otid(), lane = tid & 63, wave = tid >> 6;
  const float* sm = (const float*)(p.ws + O_SM);
  float* FF = (float*)(p.ws + O_FF) + hh * TH;
  float loc[32];
#pragma unroll
  for (int j = 0; j < 32; ++j) loc[j] = sm[(tid * 32 + j) * 32 + hh];
  float s = 0.f;
#pragma unroll
  for (int j = 0; j < 32; ++j) { const float xv = loc[j]; s += fminf(xv, 0.f) - log1pf(expf(-fabsf(xv))); loc[j] = s; }
  float inc = s;
#pragma unroll
  for (int o = 1; o < 64; o <<= 1) { const float t = __shfl_up(inc, o); if (lane >= o) inc += t; }
  if (lane == 63) red[wave] = inc;
  sub_sync();
  float off = inc - s;
  for (int w = 0; w < wave; ++w) off += red[w];
#pragma unroll
  for (int j4 = 0; j4 < 8; ++j4) {
    f32x4 o4 = {off + loc[4 * j4], off + loc[4 * j4 + 1], off + loc[4 * j4 + 2], off + loc[4 * j4 + 3]};
    *(f32x4*)(FF + tid * 32 + 4 * j4) = o4;
  }
  sub_sync();
}

DI void kmean_prep(const Params& p, int idx, unsigned* kmaxu) {
  const int lane = otid() & 63;
  const int hh = idx / 32, blk = idx % 32;
  const bf16_t* kc = (const bf16_t*)(p.ws + O_KFC) + (size_t)hh * 524288;
  float mx = 0.f;
#pragma unroll
  for (int t = 0; t < 4; ++t) {
    const int key = blk * 256 + lane * 4 + t;
    float kk = 0.f;
#pragma unroll
    for (int c = 0; c < 8; ++c) { float v[8]; unpk8(*(const bf16x8*)(kc + kfrag_key(key) + c * 256), v);
#pragma unroll
      for (int e = 0; e < 8; ++e) kk += v[e] * v[e]; }
    mx = fmaxf(mx, kk);
  }
#pragma unroll
  for (int o = 32; o >= 1; o >>= 1) mx = fmaxf(mx, __shfl_xor(mx, o));
  if (lane == 0) atomicMax(kmaxu + hh, __float_as_uint(mx));
}

DI void memkv_tile(const Params& p, int layer, int half, int mt, int nt, unsigned char* smem) {
  bf16_t* As = (bf16_t*)smem; bf16_t* Bs = As + 2 * 9216;
  f32x16 acc[2][2]; zero_acc(acc);
  PlainA al{(const bf16_t*)(p.ws + O_MEMN) + (size_t)half * 256 * 1024, 1024};
  const int m0 = mt * 128, n0 = nt * 128;
  gemm_kloop(al, (const bf16_t*)(p.ws + O_WTKV + layer * SZ_WTKV1), 1024, 16, m0, n0, acc, As, Bs);
  const int tid = otid(), lane = tid & 63, wave = tid >> 6, wr = wave >> 1, wc = wave & 1, r = lane & 31, h = lane >> 5;
  bf16_t* mk = (bf16_t*)(p.ws + O_MEMK); bf16_t* mv = (bf16_t*)(p.ws + O_MEMVT);
#pragma unroll
  for (int ni = 0; ni < 2; ++ni)
#pragma unroll
    for (int mi = 0; mi < 2; ++mi) {
      const int m = m0 + wr * 64 + mi * 32 + r;
#pragma unroll
      for (int i = 0; i < 16; ++i) {
        const int col = n0 + wc * 64 + ni * 32 + crow(i, h);
        const bf16_t b = f2bf(acc[mi][ni][i]);
        if (col < 384) { const int hd = col / 96, d = col % 96; mk[(size_t)((half * 4 + hd) * 8 + (m >> 5)) * 3072 + (d >> 4) * 512 + ((d >> 3) & 1) * 256 + (m & 31) * 8 + (d & 7)] = b; }
        else { const int cc = col - 384, hd = cc / 96, d = cc % 96, kk = m & 31;
          mv[(size_t)((half * 4 + hd) * 8 + (m >> 5)) * 3072 + (d >> 5) * 1024 + (kk >> 4) * 512 + ((kk >> 2) & 1) * 256 + (d & 31) * 8 + ((kk >> 3) & 1) * 4 + (kk & 3)] = b; }
      }
    }
}

DI f32x16 mm_quad(const bf16_t* A, const bf16_t* B, int wr, int wc, int r, int h) {
  f32x16 acc;
#pragma unroll
  for (int i = 0; i < 16; ++i) acc[i] = 0.f;
  const bf16_t* a_ = A + (wr * 32 + r) * 72 + 8 * h;
  const bf16_t* b_ = B + (wc * 32 + r) * 72 + 8 * h;
#pragma unroll
  for (int s = 0; s < 4; ++s) acc = MFMA32(*(const bf16x8*)(a_ + 16 * s), *(const bf16x8*)(b_ + 16 * s), acc);
  return acc;
}

DI void gdn_prep(const Params& p, int layer, int half, int hh, int c, unsigned char* smem) {
  bf16_t* QN = (bf16_t*)smem; bf16_t* KN = QN + 4608; bf16_t* KB = KN + 4608; bf16_t* KDT = KB + 4608; bf16_t* VBT = KDT + 4608;
  bf16_t* KBET = VBT + 4608; bf16_t* QKm = KBET + 4608; bf16_t* Tm = QKm + 4608;
  float* gcv = (float*)(smem + 73728); float* betav = gcv + 64; float* egc = gcv + 128;
  float* Mf = (float*)(smem + 9216);
  bf16_t* UT = KN; bf16_t* WT = KB;
  int tid = otid();
  int lane = tid & 63, wave = tid >> 6, wr = wave >> 1, wc = wave & 1, r = lane & 31, h = lane >> 5;
#define REOPAQUE() do { asm volatile("" : "+v"(tid)); lane = tid & 63; wave = tid >> 6; wr = wave >> 1; wc = wave & 1; r = lane & 31; h = lane >> 5; } while (0)
  const float* sm = (const float*)(p.ws + O_SM);
  if (wave == 0) {
    const int tok = c * 64 + lane;
    const float bt = fsigmoid(sm[tok * 32 + 6 + hh]);
    const float xv = sm[tok * 32 + 12 + hh] + p.dt_bias[layer * 6 + hh];
    const float sp = fmaxf(xv, 0.f) + log1pf(expf(-fabsf(xv)));
    float g = -expf(p.a_log[layer * 6 + hh]) * sp;
#pragma unroll
    for (int o = 1; o < 64; o <<= 1) { const float t = __shfl_up(g, o); if (lane >= o) g += t; }
    gcv[lane] = g; betav[lane] = bt; egc[lane] = expf(g);
    if (lane == 63) ((float*)(p.ws + O_GL))[hh * 128 + c] = expf(g);
  }
  sub_sync();
  REOPAQUE();
  {
    const int t = tid >> 2, cg4 = tid & 3, ch0 = cg4 * 16;
    const bf16_t* src = (const bf16_t*)(p.ws + O_QKVD);
    const float* cw = p.conv_w + (size_t)layer * 4 * 1152;
    const float bt = betav[t], gct = gcv[t], eg = egc[t], ed = expf(gcv[63] - gct);
    auto convpart = [&](int pt, float (&val)[16]) {
      const int col = pt * 384 + hh * 64 + ch0;
#pragma unroll
      for (int e = 0; e < 16; ++e) val[e] = 0.f;
#pragma unroll
      for (int j = 0; j < 4; ++j) {
        const int row = c * 64 + t - 3 + j;
        if (row >= 0) {
          float xv[16];
          unpk8(*(const bf16x8*)(src + (size_t)row * 1152 + col), xv);
          unpk8(*(const bf16x8*)(src + (size_t)row * 1152 + col + 8), xv + 8);
#pragma unroll
          for (int e4 = 0; e4 < 4; ++e4) {
            const f32x4 w4 = *(const f32x4*)(cw + j * 1152 + col + 4 * e4);
#pragma unroll
            for (int e = 0; e < 4; ++e) val[4 * e4 + e] += w4[e] * xv[4 * e4 + e];
          }
        }
      }
#pragma unroll
      for (int e = 0; e < 16; ++e) val[e] = fsilu(val[e]);
    };
    {
      float val[16]; convpart(0, val);
      float sq = 0.f;
#pragma unroll
      for (int e = 0; e < 16; ++e) sq += val[e] * val[e];
      sq += __shfl_xor(sq, 1); sq += __shfl_xor(sq, 2);
      const float rq = rsqrtf(sq + 1e-6f) * 0.125f;
#pragma unroll
      for (int e = 0; e < 16; ++e) val[e] *= rq;
      *(bf16x8*)(QN + t * 72 + ch0) = pk8(val); *(bf16x8*)(QN + t * 72 + ch0 + 8) = pk8(val + 8);
    }
    asm volatile("" ::: "memory");
    {
      float val[16]; convpart(1, val);
      float sk = 0.f;
#pragma unroll
      for (int e = 0; e < 16; ++e) sk += val[e] * val[e];
      sk += __shfl_xor(sk, 1); sk += __shfl_xor(sk, 2);
      const float rk = rsqrtf(sk + 1e-6f);
      float kb[16];
#pragma unroll
      for (int e = 0; e < 16; ++e) { val[e] *= rk; kb[e] = val[e] * bt; }
      *(bf16x8*)(KN + t * 72 + ch0) = pk8(val); *(bf16x8*)(KN + t * 72 + ch0 + 8) = pk8(val + 8);
      *(bf16x8*)(KB + t * 72 + ch0) = pk8(kb); *(bf16x8*)(KB + t * 72 + ch0 + 8) = pk8(kb + 8);
#pragma unroll
      for (int e = 0; e < 16; ++e) {
        KDT[(ch0 + e) * 72 + t] = f2bf(val[e] * ed);
        KBET[(ch0 + e) * 72 + t] = f2bf(kb[e] * eg);
      }
    }
    asm volatile("" ::: "memory");
    {
      float val[16]; convpart(2, val);
#pragma unroll
      for (int e = 0; e < 16; ++e) VBT[(ch0 + e) * 72 + t] = f2bf(val[e] * bt);
    }
  }
  sub_sync();
  REOPAQUE();
  {
    const f32x16 kk = mm_quad(KB, KN, wr, wc, r, h);
    const f32x16 qk = mm_quad(QN, KN, wr, wc, r, h);
    sub_sync();
    const int j = wc * 32 + r; const float gj = gcv[j];
#pragma unroll
    for (int i = 0; i < 16; ++i) {
      const int row = wr * 32 + crow(i, h);
      const float dec = (row >= j) ? expf(gcv[row] - gj) : 0.f;
      Mf[row * 68 + j] = (row > j) ? kk[i] * dec : 0.f;
      QKm[row * 72 + j] = f2bf(qk[i] * dec);
    }
  }
  sub_sync();
  REOPAQUE();
  if (wave == 0) {
    float t[64];
#pragma unroll
    for (int i = 0; i < 64; ++i) {
      float a4[4] = {(i == lane) ? 1.f : 0.f, 0.f, 0.f, 0.f};
#pragma unroll
      for (int j4 = 0; j4 < (i + 3) / 4; ++j4) {
        const f32x4 mrow = *(const f32x4*)(Mf + i * 68 + 4 * j4);
#pragma unroll
        for (int e = 0; e < 4; ++e) if (4 * j4 + e < i) a4[e] -= mrow[e] * t[4 * j4 + e];
      }
      const float a = (a4[0] + a4[1]) + (a4[2] + a4[3]);
      t[i] = a;
      Tm[i * 72 + lane] = f2bf(a);
      asm volatile("" ::: "memory");
    }
  }
  sub_sync();
  REOPAQUE();
  {
    const f32x16 u = mm_quad(Tm, VBT, wr, wc, r, h);
    const f32x16 w = mm_quad(Tm, KBET, wr, wc, r, h);
    const int col = wc * 32 + r;
#pragma unroll
    for (int g = 0; g < 4; ++g) {
      const int i0 = wr * 32 + 8 * g + 4 * h;
      *(u32x2*)(UT + col * 72 + i0) = pk4(u[4 * g], u[4 * g + 1], u[4 * g + 2], u[4 * g + 3]);
      *(u32x2*)(WT + col * 72 + i0) = pk4(w[4 * g], w[4 * g + 1], w[4 * g + 2], w[4 * g + 3]);
    }
  }
  sub_sync();
  REOPAQUE();
  {
    bf16_t* base = (bf16_t*)(p.ws + O_DPREP + (size_t)(hh * 128 + c) * 32768);
    const int n = wc * 32 + r;
    {
      const int ks = n >> 5, jh = (n >> 4) & 1, q = (n >> 2) & 3, jl = n & 3, jj = 4 * jh + jl;
      const int cbase = (ks * 64 + 16 * q) * 8 + jj;
      {
        const f32x16 P = mm_quad(KDT, WT, wr, wc, r, h);
#pragma unroll
        for (int i = 0; i < 16; ++i) {
          const int m = wr * 32 + crow(i, h);
          base[((m >> 4) * 128 + (m & 15)) * 8 + cbase] = f2bf(P[i]);
        }
      }
      asm volatile("" ::: "memory");
      {
        const f32x16 QW = mm_quad(QKm, WT, wr, wc, r, h);
#pragma unroll
        for (int i = 0; i < 16; ++i) {
          const int m = wr * 32 + crow(i, h);
          const float qd = bf2f(QN[m * 72 + n]) * egc[m];
          base[4096 + ((m >> 4) * 128 + (m & 15)) * 8 + cbase] = f2bf(qd - QW[i]);
        }
      }
      asm volatile("" ::: "memory");
    }
    const int jsl = n >> 4;
    {
      const f32x16 Bc = mm_quad(KDT, UT, wr, wc, r, h);
#pragma unroll
      for (int g = 0; g < 4; ++g) {
        const int row0 = wr * 32 + 8 * g + 4 * h;
        const int rt = row0 >> 4, lp = 16 * ((row0 >> 2) & 3) + (n & 15);
        *(u32x2*)(base + 8192 + ((jsl * 4 + rt) * 64 + lp) * 4) = pk4(Bc[4 * g], Bc[4 * g + 1], Bc[4 * g + 2], Bc[4 * g + 3]);
      }
    }
    asm volatile("" ::: "memory");
    {
      const f32x16 O0 = mm_quad(QKm, UT, wr, wc, r, h);
#pragma unroll
      for (int g = 0; g < 4; ++g) {
        const int row0 = wr * 32 + 8 * g + 4 * h;
        const int rt = row0 >> 4, lp = 16 * ((row0 >> 2) & 3) + (n & 15);
        *(u32x2*)(base + 12288 + ((jsl * 4 + rt) * 64 + lp) * 4) = pk4(O0[4 * g], O0[4 * g + 1], O0[4 * g + 2], O0[4 * g + 3]);
      }
    }
  }
  sub_sync();
#undef REOPAQUE
}

struct TileDesc { const bf16_t* k; const bf16_t* v; const float* aux; int tag; };

template <int DHT, bool AUX>
struct TileRegs { bf16x8 k[DHT / 16]; bf16x8 v[DHT / 32][2]; f32x4 a[4]; };

template <int DHT, bool AUX>
DI void load_tile(const bf16_t* kp, const bf16_t* vp, const float* ap, long ldv, TileRegs<DHT, AUX>& t) {
#pragma unroll
  for (int s = 0; s < DHT / 16; ++s) t.k[s] = *(const bf16x8*)(kp + 512 * s);
#pragma unroll
  for (int dt = 0; dt < DHT / 32; ++dt)
#pragma unroll
    for (int s = 0; s < 2; ++s) t.v[dt][s] = *(const bf16x8*)(vp + (dt * 2 + s) * 512);
  if (AUX) {
#pragma unroll
    for (int g = 0; g < 4; ++g) t.a[g] = *(const f32x4*)(ap + 8 * g);
  }
}

template <int DHT, bool AUX, class TF, class MF, class SF>
DI void attn_loop(int maxtiles, TF&& tf, MF&& mf, SF&& stopf, const bf16x8 (&qf)[DHT / 16], long ldv, float scale2,
                  f32x16 (&o)[DHT / 32], float& m, float& l) {
  TileRegs<DHT, AUX> cur, nxt;
  int tagc, tagn;
  bf16x8 qf0 = qf[0];
  { const bf16_t* kp; const bf16_t* vp; const float* ap = nullptr; tagc = tf(0, kp, vp, ap); load_tile<DHT, AUX>(kp, vp, ap, ldv, cur); }
#pragma unroll 1
  for (int t = 0; t < maxtiles; ++t) {
    { const bf16_t* kp; const bf16_t* vp; const float* ap = nullptr; tagn = tf(t + 1, kp, vp, ap); load_tile<DHT, AUX>(kp, vp, ap, ldv, nxt); }
    { bf16x8 q0 = qf[0]; asm volatile("" : "+v"(q0) :: "memory"); qf0 = q0; }
    f32x16 sacc;
#pragma unroll
    for (int i = 0; i < 16; ++i) sacc[i] = 0.f;
#pragma unroll
    for (int s = 0; s < DHT / 16; ++s) sacc = MFMA32(cur.k[s], s == 0 ? qf0 : qf[s], sacc);
    float sv[16]; float mx = NEG_INF;
#pragma unroll
    for (int i = 0; i < 16; ++i) { sv[i] = sacc[i] * scale2 + mf(tagc, i, AUX ? cur.a[i >> 2][i & 3] : 0.f); mx = fmaxf(mx, sv[i]); }
    mx = fmaxf(mx, __shfl_xor(mx, 32));
    const float mnew = fmaxf(m, mx);
    const float alpha = __builtin_amdgcn_exp2f(m - mnew);
    m = mnew;
    float pv[16]; float ps = 0.f;
#pragma unroll
    for (int i = 0; i < 16; ++i) { pv[i] = __builtin_amdgcn_exp2f(sv[i] - mnew); ps += pv[i]; }
    l = l * alpha + ps;
#pragma unroll
    for (int dt = 0; dt < DHT / 32; ++dt)
#pragma unroll
      for (int i = 0; i < 16; ++i) o[dt][i] *= alpha;
    bf16x8 pf[2]; pf[0] = pk8(pv); pf[1] = pk8(pv + 8);
#pragma unroll
    for (int dt = 0; dt < DHT / 32; ++dt)
#pragma unroll
      for (int s = 0; s < 2; ++s) {
        o[dt] = MFMA32(cur.v[dt][s], pf[s], o[dt]);
      }
    if (stopf(t, m, AUX ? cur.a[0][0] : 0.f)) break;
    cur = nxt; tagc = tagn;
  }
}

template <int DHT>
DI void attn_store(const f32x16 (&o)[DHT / 32], float l, bf16_t* dstrow, int h, float& ltot_out, bool valid = true) {
  const float ltot = l + __shfl_xor(l, 32);
  ltot_out = ltot;
  const float inv = ltot > 0.f ? 1.f / ltot : 0.f;
  if (valid)
#pragma unroll
  for (int dt = 0; dt < DHT / 32; ++dt)
#pragma unroll
    for (int g = 0; g < 4; ++g)
      *(u32x2*)(dstrow + dt * 32 + 8 * g + 4 * h) = pk4(o[dt][4 * g] * inv, o[dt][4 * g + 1] * inv, o[dt][4 * g + 2] * inv, o[dt][4 * g + 3] * inv);
}

template <int DHT>
DI void attn_store_gated(const f32x16 (&o)[DHT / 32], float l, bf16_t* szrow, int h) {
  const float ltot = l + __shfl_xor(l, 32);
  const float inv = ltot > 0.f ? 1.f / ltot : 0.f;
#pragma unroll
  for (int dt = 0; dt < DHT / 32; ++dt)
#pragma unroll
    for (int g = 0; g < 4; ++g) {
      bf16_t* q = szrow + dt * 32 + 8 * g + 4 * h;
      const u32x2 z = *(const u32x2*)q;
      *(u32x2*)q = pk4(o[dt][4 * g] * inv * bflo(z.x), o[dt][4 * g + 1] * inv * bfhi(z.x), o[dt][4 * g + 2] * inv * bflo(z.y), o[dt][4 * g + 3] * inv * bfhi(z.y));
    }
}

template <int N>
DI void zero_o(f32x16 (&o)[N]) {
#pragma unroll
  for (int a = 0; a < N; ++a)
#pragma unroll
    for (int i = 0; i < 16; ++i) o[a][i] = 0.f;
}

DI void top3_insert(float v, int n, float& v0, float& v1, float& v2, int& i0, int& i1, int& i2) {
  const bool g0 = v > v0, g1 = v > v1, g2 = v > v2;
  v2 = g1 ? v1 : (g2 ? v : v2); i2 = g1 ? i1 : (g2 ? n : i2);
  v1 = g0 ? v0 : (g1 ? v : v1); i1 = g0 ? i0 : (g1 ? n : i1);
  v0 = g0 ? v : v0;             i0 = g0 ? n : i0;
}

DI void moba_select(const Params& p, int a) {
  const int lane = otid() & 63, r = lane & 31, h = lane >> 5;
  const int qtile = a / 6, hh = a % 6, qb = qtile >> 3;
  unsigned mask = 0;
  if (qb > 0) {
    const bf16_t* qrow = (const bf16_t*)(p.ws + O_QKA) + (size_t)(qtile * 32 + r) * 384 + hh * 64 + 8 * h;
    bf16x8 qf[4];
#pragma unroll
    for (int s = 0; s < 4; ++s) qf[s] = *(const bf16x8*)(qrow + 16 * s);
    const float* ks0 = (const float*)(p.ws + O_KSUM) + (size_t)(r * 2) * 384 + hh * 64 + 8 * h;
    f32x16 g;
#pragma unroll
    for (int i = 0; i < 16; ++i) g[i] = 0.f;
#pragma unroll
    for (int s = 0; s < 4; ++s) {
      const f32x4 a0 = *(const f32x4*)(ks0 + 16 * s), a1 = *(const f32x4*)(ks0 + 16 * s + 4);
      const f32x4 b0 = *(const f32x4*)(ks0 + 384 + 16 * s), b1 = *(const f32x4*)(ks0 + 384 + 16 * s + 4);
      float hi[8], lo[8];
#pragma unroll
      for (int e = 0; e < 4; ++e) {
        const float m0 = (a0[e] + b0[e]) * (1.f / 256.f), m1 = (a1[e] + b1[e]) * (1.f / 256.f);
        hi[e] = bf2f(f2bf(m0)); lo[e] = m0 - hi[e];
        hi[4 + e] = bf2f(f2bf(m1)); lo[4 + e] = m1 - hi[4 + e];
      }
      g = MFMA32(pk8(hi), qf[s], g); g = MFMA32(pk8(lo), qf[s], g);
    }
    float v0 = NEG_INF, v1 = NEG_INF, v2 = NEG_INF; int i0 = -1, i1 = -1, i2 = -1;
#pragma unroll
    for (int i = 0; i < 16; ++i) { const int n = crow(i, h); if (n < qb) top3_insert(g[i], n, v0, v1, v2, i0, i1, i2); }
    const float pv0 = __shfl_xor(v0, 32), pv1 = __shfl_xor(v1, 32), pv2 = __shfl_xor(v2, 32);
    const int pi0 = __shfl_xor(i0, 32), pi1 = __shfl_xor(i1, 32), pi2 = __shfl_xor(i2, 32);
    if (pi0 >= 0) top3_insert(pv0, pi0, v0, v1, v2, i0, i1, i2);
    if (pi1 >= 0) top3_insert(pv1, pi1, v0, v1, v2, i0, i1, i2);
    if (pi2 >= 0) top3_insert(pv2, pi2, v0, v1, v2, i0, i1, i2);
    if (i0 >= 0) mask |= 1u << i0;
    if (i1 >= 0) mask |= 1u << i1;
    if (i2 >= 0) mask |= 1u << i2;
  }
  if (h == 0) ((unsigned*)(p.ws + O_MASK))[(qtile * 32 + r) * 8 + hh] = mask;
}

DI void moba_gather(const Params& p, int a, unsigned char* smem) {
  const int tid = otid(), lane = tid & 63, wave = tid >> 6, r = lane & 31, h = lane >> 5;
  const int part = a & 1, a2 = a >> 1;
  const int hh = a2 % 6, idx = a2 / 6;
  int qb = 1;
  while ((qb + 1) * qb / 2 <= idx) ++qb;
  const int n = idx - qb * (qb - 1) / 2;
  const unsigned* MASK = (const unsigned*)(p.ws + O_MASK);
  unsigned* list = (unsigned*)(smem + wave * 1024);
  int cnt = 0;
#pragma unroll
  for (int j = 0; j < 4; ++j) {
    const int qi = j * 64 + lane;
    const unsigned mk = MASK[(qb * 256 + qi) * 8 + hh];
    const bool pred = (mk >> n) & 1u;
    const unsigned long long ball = __ballot(pred);
    const int pos = cnt + __builtin_popcountll(ball & ((1ull << lane) - 1ull));
    if (pred) list[pos] = (unsigned)qi | ((unsigned)__builtin_popcount(mk & ((1u << n) - 1u)) << 8);
    cnt += __builtin_popcountll(ball);
  }
  cnt = __builtin_amdgcn_readfirstlane(cnt);
  if (cnt == 0) return;
  asm volatile("s_waitcnt lgkmcnt(0)" ::: "memory");
  __builtin_amdgcn_wave_barrier();
  const bf16_t* QK = (const bf16_t*)(p.ws + O_QKA);
  const bf16_t* KF = (const bf16_t*)(p.ws + O_KFA) + (size_t)hh * 524288 + (size_t)n * 8 * 2048 + lane * 8;
  const bf16_t* VT = (const bf16_t*)(p.ws + O_VTA) + (size_t)hh * 524288 + (size_t)n * 8 * 2048 + lane * 8;
  const int nch = (cnt + 31) >> 5;
#pragma unroll 1
  for (int c = part; c < nch; c += 2) {
    const int e = c * 32 + r;
    const bool valid = e < cnt;
    const unsigned ent = list[valid ? e : 0];
    const int tok = qb * 256 + (int)(ent & 255u), slot = (int)(ent >> 8);
    bf16x8 qf[4];
    { const bf16_t* qrow = QK + (size_t)tok * 384 + hh * 64 + 8 * h;
#pragma unroll
      for (int s = 0; s < 4; ++s) qf[s] = *(const bf16x8*)(qrow + 16 * s); }
    auto tf = [&](int t, const bf16_t*& kp, const bf16_t*& vp, const float*&) -> int {
      const int tt = t < 7 ? t : 7;
      kp = KF + tt * 2048; vp = VT + tt * 2048;
      return 0;
    };
    auto mf = [&](int, int, float) -> float { return 0.f; };
    auto sf = [&](int, float, float) { return false; };
    f32x16 o[2]; zero_o(o); float m = -1e30f, l = 0.f;
    int nt8 = 8; asm volatile("" : "+s"(nt8));
    attn_loop<64, false>(nt8, tf, mf, sf, qf, (long)TH, 0.125f * LOG2E, o, m, l);
    float lt;
    attn_store<64>(o, l, (bf16_t*)(p.ws + O_OA + slot * SZ_O) + (size_t)tok * 384 + hh * 64, h, lt, valid);
    if (valid && h == 0) { float* st = (float*)(p.ws + O_STA) + ((size_t)(slot * TH + tok) * 6 + hh) * 2; st[0] = m; st[1] = lt; }
  }
}

DI void moba_own(const Params& p, int a) {
  const int lane = otid() & 63, r = lane & 31, h = lane >> 5;
  const int qtile = 255 - a / 6, hh = a % 6, qb = qtile >> 3, own = qtile & 7;
  const bf16_t* QK = (const bf16_t*)(p.ws + O_QKA);
  const bf16_t* KF = (const bf16_t*)(p.ws + O_KFA) + (size_t)hh * 524288 + (size_t)qb * 8 * 2048 + lane * 8;
  const bf16_t* VT = (const bf16_t*)(p.ws + O_VTA) + (size_t)hh * 524288 + (size_t)qb * 8 * 2048 + lane * 8;
  const int tok = qtile * 32 + r;
  bf16x8 qf[4];
  { const bf16_t* qrow = QK + (size_t)tok * 384 + hh * 64 + 8 * h;
#pragma unroll
    for (int s = 0; s < 4; ++s) qf[s] = *(const bf16x8*)(qrow + 16 * s); }
  auto tf = [&](int t, const bf16_t*& kp, const bf16_t*& vp, const float*&) -> int {
    const int kk = t < own ? t : own;
    kp = KF + kk * 2048; vp = VT + kk * 2048;
    return (kk == own) ? 101 : 100;
  };
  auto mf = [&](int tag, int i, float) -> float {
    if (tag == 100) return 0.f;
    return (crow(i, h) <= r) ? 0.f : NEG_INF;
  };
  auto sf = [&](int, float, float) { return false; };
  f32x16 o[2]; zero_o(o); float m = -1e30f, l = 0.f;
  attn_loop<64, false>(own + 1, tf, mf, sf, qf, (long)TH, 0.125f * LOG2E, o, m, l);
  float lt;
  attn_store<64>(o, l, (bf16_t*)(p.ws + O_OA + 3 * SZ_O) + (size_t)tok * 384 + hh * 64, h, lt);
  if (h == 0) {
    float* st = (float*)(p.ws + O_STA);
    st[((size_t)(3 * TH + tok) * 6 + hh) * 2] = m; st[((size_t)(3 * TH + tok) * 6 + hh) * 2 + 1] = lt;
    const int np = __builtin_popcount(((const unsigned*)(p.ws + O_MASK))[tok * 8 + hh]);
    for (int sl = np; sl < 3; ++sl) { st[((size_t)(sl * TH + tok) * 6 + hh) * 2] = -1e30f; st[((size_t)(sl * TH + tok) * 6 + hh) * 2 + 1] = 0.f; }
  }
}

DI void fox_item(const Params& p, int c, const unsigned* kmaxu) {
  const int lane = otid() & 63, r = lane & 31, h = lane >> 5;
  const int qtile = 255 - c / 6, hh = c % 6;
  const bf16_t* QK = (const bf16_t*)(p.ws + O_QKC);
  const bf16_t* KF = (const bf16_t*)(p.ws + O_KFC);
  const bf16_t* VT = (const bf16_t*)(p.ws + O_VTC);
  const float* FF = (const float*)(p.ws + O_FF) + hh * TH;
  bf16x8 qf[4]; float qn2 = 0.f;
  { const bf16_t* qrow = QK + (size_t)(qtile * 32 + r) * 384 + hh * 64 + 8 * h;
#pragma unroll
    for (int s = 0; s < 4; ++s) { qf[s] = *(const bf16x8*)(qrow + 16 * s); float v[8]; unpk8(qf[s], v);
#pragma unroll
      for (int e = 0; e < 8; ++e) qn2 += v[e] * v[e]; } }
  qn2 += __shfl_xor(qn2, 32);
#pragma unroll
  for (int o = 16; o >= 1; o >>= 1) qn2 = fmaxf(qn2, __shfl_xor(qn2, o));
  const float Fq = FF[qtile * 32 + r];
  const float Ffirst = FF[qtile * 32];
  const float kmaxn = sqrtf(__uint_as_float(kmaxu[hh]));
  const float bound = sqrtf(qn2) * kmaxn * 0.125f + Ffirst;
  auto tf = [&](int t, const bf16_t*& kp, const bf16_t*& vp, const float*& ap) -> int {
    const int keybase = (qtile - t > 0 ? qtile - t : 0) * 32;
    kp = KF + (size_t)hh * 524288 + (keybase >> 5) * 2048 + lane * 8;
    vp = VT + (size_t)hh * 524288 + (keybase >> 5) * 2048 + lane * 8;
    ap = FF + keybase + 4 * h;
    return (t == 0) ? 1 : 0;
  };
  auto mf = [&](int tag, int i, float fk) -> float {
    const float b = (Fq - fk) * LOG2E;
    return (tag == 1 && crow(i, h) > r) ? NEG_INF : b;
  };
  auto sf = [&](int, float m, float a0) {
    const float fkb = __builtin_bit_cast(float, __builtin_amdgcn_readfirstlane(__builtin_bit_cast(int, a0)));
    float mm = m;
#pragma unroll
    for (int o = 16; o >= 1; o >>= 1) mm = fminf(mm, __shfl_xor(mm, o));
    return (bound - fkb) * LOG2E < mm - 45.f;
  };
  f32x16 o[2]; zero_o(o); float m = -1e30f, l = 0.f;
  attn_loop<64, true>(qtile + 1, tf, mf, sf, qf, (long)TH, 0.125f * LOG2E, o, m, l);
  float lt;
  attn_store_gated<64>(o, l, (bf16_t*)(p.ws + O_SZ) + (size_t)(qtile * 32 + r) * 1920 + 2 * 384 + hh * 64, h);
}

DI void dil_item(const Params& p, int idx) {
  const int lane = otid() & 63, r = lane & 31, h = lane >> 5;
  const int g = idx / 1536, rem = idx % 1536, hh = rem / 256, w = rem % 256;
  const int dsh = 2 * g;
  const int dil = 1 << dsh, L = TH >> dsh, tps = L / 32;
  const int rs = w / tps, lt_ = w % tps, l0 = lt_ * 32;
  const bf16_t* QK = (const bf16_t*)(p.ws + O_QKB);
  const bf16_t* KF = (const bf16_t*)(p.ws + O_KFB + g * SZ_VT);
  const bf16_t* VT = (const bf16_t*)(p.ws + O_VTB + g * SZ_VT);
  const int tq = (l0 + r) * dil + rs;
  bf16x8 qf[4];
  { const bf16_t* qrow = QK + (size_t)tq * 1152 + g * 384 + hh * 64 + 8 * h;
#pragma unroll
    for (int s = 0; s < 4; ++s) qf[s] = *(const bf16x8*)(qrow + 16 * s); }
  const int t0 = (l0 >= 128) ? 0 : (128 - l0) / 32;
  auto tf = [&](int tt, const bf16_t*& kp, const bf16_t*& vp, const float*&) -> int {
    const int t = (t0 + tt < 4) ? t0 + tt : 4; const int keybase = l0 - 128 + 32 * t;
    kp = KF + (size_t)hh * 524288 + ((rs * L + keybase) >> 5) * 2048 + lane * 8;
    vp = VT + (size_t)hh * 524288 + ((rs * L + keybase) >> 5) * 2048 + lane * 8;
    return t;
  };
  auto mf = [&](int tag, int i, float) -> float {
    const int kj = crow(i, h);
    if (tag == 0) return (kj >= r) ? 0.f : NEG_INF;
    if (tag == 4) return (kj <= r) ? 0.f : NEG_INF;
    return 0.f;
  };
  auto sf = [&](int, float, float) { return false; };
  f32x16 o[2]; zero_o(o); float m = -1e30f, l = 0.f;
  attn_loop<64, false>(5 - t0, tf, mf, sf, qf, (long)TH, 0.125f * LOG2E, o, m, l);
  float lt;
  attn_store<64>(o, l, (bf16_t*)(p.ws + O_OB + g * SZ_O) + (size_t)tq * 384 + hh * 64, h, lt);
  if (h == 0) { float* st = (float*)(p.ws + O_STB) + ((size_t)(g * TH + tq) * 6 + hh) * 2; st[0] = m; st[1] = lt; }
}

DI void mem_item(const Params& p, int half, int e) {
  const int lane = otid() & 63, r = lane & 31, h = lane >> 5;
  const int hd = e & 3, qtile = e >> 2;
  const bf16_t* QE = (const bf16_t*)(p.ws + O_QE);
  const bf16_t* MK = (const bf16_t*)(p.ws + O_MEMK);
  const bf16_t* MV = (const bf16_t*)(p.ws + O_MEMVT);
  bf16x8 qf[6];
  { const bf16_t* qrow = QE + (size_t)(qtile * 32 + r) * 384 + hd * 96 + 8 * h;
#pragma unroll
    for (int s = 0; s < 6; ++s) qf[s] = *(const bf16x8*)(qrow + 16 * s); }
  auto tf = [&](int t, const bf16_t*& kp, const bf16_t*& vp, const float*&) -> int {
    const int keybase = 32 * (t < 7 ? t : 7);
    kp = MK + (size_t)((half * 4 + hd) * 8 + (keybase >> 5)) * 3072 + lane * 8;
    vp = MV + (size_t)((half * 4 + hd) * 8 + (keybase >> 5)) * 3072 + lane * 8;
    return 0;
  };
  auto mf = [&](int, int, float) -> float { return 0.f; };
  auto sf = [&](int, float, float) { return false; };
  f32x16 o[3]; zero_o(o); float m = -1e30f, l = 0.f;
  attn_loop<96, false>(8, tf, mf, sf, qf, 256L, 0.10206207261596577f * LOG2E, o, m, l);
  float lt;
  attn_store_gated<96>(o, l, (bf16_t*)(p.ws + O_SZ) + (size_t)(qtile * 32 + r) * 1920 + 4 * 384 + hd * 96, h);
}

DI float dpp_ror(float v, int ctrl);
DI float row16_sum(float v) {
  v += __builtin_bit_cast(float, __builtin_amdgcn_update_dpp(0, __builtin_bit_cast(int, v), 0x128, 0xf, 0xf, false));
  v += __builtin_bit_cast(float, __builtin_amdgcn_update_dpp(0, __builtin_bit_cast(int, v), 0x124, 0xf, 0xf, false));
  v += __builtin_bit_cast(float, __builtin_amdgcn_update_dpp(0, __builtin_bit_cast(int, v), 0x122, 0xf, 0xf, false));
  v += __builtin_bit_cast(float, __builtin_amdgcn_update_dpp(0, __builtin_bit_cast(int, v), 0x121, 0xf, 0xf, false));
  return v;
}

struct ScanRegs { bf16x8 pf[4][2]; bf16x8 qe[4][2]; s16x4 bc[4]; s16x4 o0[4]; float gl; };
DI void scan_load(const Params& p, int hh, int j, int c, int lane, ScanRegs& s) {
  const unsigned char* base = p.ws + O_DPREP + (size_t)(hh * 128 + c) * 32768;
#pragma unroll
  for (int mt = 0; mt < 4; ++mt)
#pragma unroll
    for (int ks = 0; ks < 2; ++ks) {
      s.pf[mt][ks] = *(const bf16x8*)(base + ((mt * 2 + ks) * 64 + lane) * 16);
      s.qe[mt][ks] = *(const bf16x8*)(base + 8192 + ((mt * 2 + ks) * 64 + lane) * 16);
    }
#pragma unroll
  for (int rt = 0; rt < 4; ++rt) {
    s.bc[rt] = *(const s16x4*)(base + 16384 + ((j * 4 + rt) * 64 + lane) * 8);
    s.o0[rt] = *(const s16x4*)(base + 24576 + ((j * 4 + rt) * 64 + lane) * 8);
  }
  s.gl = ((const float*)(p.ws + O_GL))[hh * 128 + c];
}
DI f32x4 s4f(s16x4 v) { u32x2 u = __builtin_bit_cast(u32x2, v); f32x4 r; r[0] = bflo(u.x); r[1] = bfhi(u.x); r[2] = bflo(u.y); r[3] = bfhi(u.y); return r; }

DI void scan_item(const Params& p, int it) {
  const int lane = otid() & 63, q = lane >> 4, cl = lane & 15;
  const int hh = it >> 2, j = it & 3;
  f32x4 S[4];
#pragma unroll
  for (int rt = 0; rt < 4; ++rt) S[rt] = (f32x4){0.f, 0.f, 0.f, 0.f};
  bf16_t* OD = (bf16_t*)(p.ws + O_OD);
  float* SSQ = (float*)(p.ws + O_SSQ);
#ifndef SCAN_PREFETCH
#define SCAN_PREFETCH 1
#endif
  ScanRegs cur, nxt;
  if (SCAN_PREFETCH) scan_load(p, hh, j, 0, lane, cur);
  for (int c = 0; c < 128; ++c) {
    if (SCAN_PREFETCH) {
      scan_load(p, hh, j, (c + 1 < 128) ? c + 1 : c, lane, nxt);
      asm volatile("" : "+v"(S[0][0]) :: "memory");
    } else {
      scan_load(p, hh, j, c, lane, cur);
    }
    bf16x8 bfr[2];
#pragma unroll
    for (int ks = 0; ks < 2; ++ks) {
      u32x4 u; u.x = pk2(S[2 * ks][0], S[2 * ks][1]); u.y = pk2(S[2 * ks][2], S[2 * ks][3]); u.z = pk2(S[2 * ks + 1][0], S[2 * ks + 1][1]); u.w = pk2(S[2 * ks + 1][2], S[2 * ks + 1][3]);
      bfr[ks] = __builtin_bit_cast(bf16x8, u);
    }
    f32x4 aP[4], aO[4];
#pragma unroll
    for (int rt = 0; rt < 4; ++rt) {
      aP[rt] = (f32x4){0.f, 0.f, 0.f, 0.f};
      aO[rt] = s4f(cur.o0[rt]);
#pragma unroll
      for (int ks = 0; ks < 2; ++ks) { aP[rt] = MFMA16(cur.pf[rt][ks], bfr[ks], aP[rt]); aO[rt] = MFMA16(cur.qe[rt][ks], bfr[ks], aO[rt]); }
    }
#pragma unroll
    for (int rt = 0; rt < 4; ++rt) S[rt] = S[rt] * cur.gl - aP[rt] + s4f(cur.bc[rt]);
#pragma unroll
    for (int rt = 0; rt < 4; ++rt)
#pragma unroll
      for (int e = 0; e < 4; ++e) {
        const int tok = c * 64 + 16 * rt + 4 * q + e;
        const float v = aO[rt][e];
        OD[(size_t)tok * 384 + hh * 64 + 16 * j + cl] = f2bf(v);
        const float ss = row16_sum(v * v);
        if (cl == 0) SSQ[(tok * 6 + hh) * 4 + j] = ss;
      }
    if (SCAN_PREFETCH) cur = nxt;
  }
}

DI void scan_block(const Params& p, int hh, unsigned char* smem) {
  const int tid = otid(), lane = tid & 63, j = tid >> 6, q = lane >> 4, cl = lane & 15;
  const unsigned char* src = p.ws + O_DPREP + (size_t)hh * 128 * 32768;
  bf16_t* ostg = (bf16_t*)(smem + 65536);
  bf16x8 R0[8], R1[8];
  auto gld = [&](int c, bf16x8 (&R)[8]) {
    c = c < 128 ? c : 127;
    const unsigned char* b = src + (size_t)c * 32768 + tid * 16;
#pragma unroll
    for (int i = 0; i < 8; ++i) R[i] = *(const bf16x8*)(b + i * 4096);
  };
  auto lst = [&](int buf, const bf16x8 (&R)[8]) {
    unsigned char* d = smem + buf * 32768 + tid * 16;
#pragma unroll
    for (int i = 0; i < 8; ++i) *(bf16x8*)(d + i * 4096) = R[i];
  };
  const float* GL = (const float*)(p.ws + O_GL) + hh * 128;
  const float gl_lo = GL[lane], gl_hi = GL[64 + lane];
  f32x4 S[4];
#pragma unroll
  for (int rt = 0; rt < 4; ++rt) S[rt] = (f32x4){0.f, 0.f, 0.f, 0.f};
  bf16_t* OD = (bf16_t*)(p.ws + O_OD);
  float* SSQ = (float*)(p.ws + O_SSQ);
  f32x4 aO[4];
  auto flush = [&](int cp) {
    const int row = tid >> 2, part = tid & 3;
    const bf16x8 v0 = *(const bf16x8*)(ostg + row * 72 + 16 * part), v1 = *(const bf16x8*)(ostg + row * 72 + 16 * part + 8);
    float f[16]; unpk8(v0, f); unpk8(v1, f + 8);
    float ss = 0.f;
#pragma unroll
    for (int e = 0; e < 16; ++e) ss += f[e] * f[e];
    const int tok = cp * 64 + row;
    bf16_t* dst = OD + (size_t)tok * 384 + hh * 64 + 16 * part;
    *(bf16x8*)dst = v0; *(bf16x8*)(dst + 8) = v1;
    SSQ[(tok * 6 + hh) * 4 + part] = ss;
  };
  auto compute = [&](int buf, int c) {
    const unsigned char* base = smem + buf * 32768;
    const float gl = __builtin_bit_cast(float, __builtin_amdgcn_readlane(__builtin_bit_cast(int, c < 64 ? gl_lo : gl_hi), c & 63));
    bf16x8 bfr[2];
#pragma unroll
    for (int ks = 0; ks < 2; ++ks) {
      u32x4 u; u.x = pk2(S[2 * ks][0], S[2 * ks][1]); u.y = pk2(S[2 * ks][2], S[2 * ks][3]); u.z = pk2(S[2 * ks + 1][0], S[2 * ks + 1][1]); u.w = pk2(S[2 * ks + 1][2], S[2 * ks + 1][3]);
      bfr[ks] = __builtin_bit_cast(bf16x8, u);
    }
    f32x4 aP[4];
#pragma unroll
    for (int rt = 0; rt < 4; ++rt) {
      aP[rt] = (f32x4){0.f, 0.f, 0.f, 0.f};
      aO[rt] = s4f(*(const s16x4*)(base + 24576 + ((j * 4 + rt) * 64 + lane) * 8));
#pragma unroll
      for (int ks = 0; ks < 2; ++ks) {
        aP[rt] = MFMA16(*(const bf16x8*)(base + ((rt * 2 + ks) * 64 + lane) * 16), bfr[ks], aP[rt]);
        aO[rt] = MFMA16(*(const bf16x8*)(base + 8192 + ((rt * 2 + ks) * 64 + lane) * 16), bfr[ks], aO[rt]);
      }
    }
#pragma unroll
    for (int rt = 0; rt < 4; ++rt) S[rt] = S[rt] * gl - aP[rt] + s4f(*(const s16x4*)(base + 16384 + ((j * 4 + rt) * 64 + lane) * 8));
  };
  auto stage_out = [&]() {
#pragma unroll
    for (int rt = 0; rt < 4; ++rt)
#pragma unroll
      for (int e = 0; e < 4; ++e) ostg[(16 * rt + 4 * q + e) * 72 + 16 * j + cl] = f2bf(aO[rt][e]);
  };
  __builtin_amdgcn_s_setprio(3);
  gld(0, R0); gld(1, R1);
  lst(0, R0); gld(2, R0);
  sub_sync();
#pragma unroll 1
  for (int c = 0; c < 128; c += 2) {
    lst(1, R1);
    gld(c + 3, R1);
    if (c > 0) flush(c - 1);
    compute(0, c);
    sub_sync();
    stage_out();
    sub_sync();
    lst(0, R0);
    gld(c + 4, R0);
    flush(c);
    compute(1, c + 1);
    sub_sync();
    stage_out();
    sub_sync();
  }
  flush(127);
  sub_sync();
  __builtin_amdgcn_s_setprio(0);
}

DI void phase3(const Params& p, int half, unsigned* ctr, const unsigned* kmaxu, unsigned char* smem, int sub, int limit = 1 << 30) {
  const int tid = otid(), wave = tid >> 6;
  const int hb = (int)blockIdx.x, x = hb & 7, bi = hb >> 3;
  if (hb < 3 && limit >= 0) { if (PH(5)) scan_block(p, hb * 2 + sub, smem); }
  if (bi >= 1 && limit != 0) {
    const int nlw = ((int)(gridDim.x >> 3) - 1) * 8, lw = ((bi - 1) * 2 + sub) * 4 + wave;
    if (x < 6) {
      const int hh = x;
      constexpr int NG = 992, NOWN = 256, NB_ = 640, NTOT = NG + NOWN + NB_;
      for (int pos0 = lw; pos0 < NTOT; pos0 += nlw) {
        int pos = __builtin_amdgcn_readfirstlane(pos0);
        if (pos < NG) { if (PH(6)) moba_gather(p, (((pos >> 1) * 6 + hh) << 1) | (pos & 1), smem); continue; }
        pos -= NG;
        if (pos < NOWN) { if (PH(6)) moba_own(p, pos * 6 + hh); continue; }
        pos -= NOWN;
        const int g = pos < 512 ? (pos >> 8) : 2, w = pos < 512 ? (pos & 255) : 2 * (pos - 512);
        if (PH(8)) dil_item(p, g * 1536 + hh * 256 + w);
      }
    } else {
      const int h0 = (x - 6) * 3;
      constexpr int NE = 512, NC = 768, NB2 = 384, NTOT = NE + NC + NB2;
      for (int pos0 = lw; pos0 < NTOT; pos0 += nlw) {
        int pos = __builtin_amdgcn_readfirstlane(pos0);
        if (pos < NE) { if (PH(7)) mem_item(p, half, (x - 6) * 512 + pos); continue; }
        pos -= NE;
        if (pos < NC) { if (PH(9)) fox_item(p, (pos & 255) * 6 + h0 + (pos >> 8), kmaxu); continue; }
        pos -= NC;
        if (PH(8)) dil_item(p, 2 * 1536 + (h0 + (pos >> 7)) * 256 + 2 * (pos & 127) + 1);
      }
    }
  }
}

DI void gbuild_chunk(const Params& p, int layer, int tok, int c8) {
  const unsigned char* ws = p.ws;
  const int n = c8 / 48, c = (c8 % 48) * 8;
  if (n == 2 || n == 4) return;
  bf16_t* szp = (bf16_t*)(p.ws + O_SZ) + (size_t)tok * 1920 + n * 384 + c;
  float o[8], z[8];
  unpk8(*(const bf16x8*)szp, z);
  if (n == 1) {
    const int hh = c >> 6;
    const float* st = (const float*)(ws + O_STB);
    float mg[3], lg[3];
#pragma unroll
    for (int g = 0; g < 3; ++g) { const f32x2 s2 = *(const f32x2*)(st + ((size_t)(g * TH + tok) * 6 + hh) * 2); mg[g] = s2[0]; lg[g] = s2[1]; }
    const float mm = fmaxf(mg[0], fmaxf(mg[1], mg[2]));
    float wg[3], ws_ = 0.f;
#pragma unroll
    for (int g = 0; g < 3; ++g) { wg[g] = exp2f(mg[g] - mm) * lg[g]; ws_ += wg[g]; }
    const float inv = 1.f / ws_;
#pragma unroll
    for (int e = 0; e < 8; ++e) o[e] = 0.f;
#pragma unroll
    for (int g = 0; g < 3; ++g) {
      float t[8]; unpk8(*(const bf16x8*)((const bf16_t*)(ws + O_OB + g * SZ_O) + (size_t)tok * 384 + c), t);
      const float wgi = wg[g] * inv;
#pragma unroll
      for (int e = 0; e < 8; ++e) o[e] += wgi * t[e];
    }
  } else if (n == 3) {
    const int hh = c >> 6;
    const f32x4 sq = *(const f32x4*)((const float*)(ws + O_SSQ) + ((size_t)tok * 6 + hh) * 4);
    const float rs = rsqrtf((sq[0] + sq[1] + sq[2] + sq[3]) * (1.f / 64.f) + 1e-6f);
    unpk8(*(const bf16x8*)((const bf16_t*)(ws + O_OD) + (size_t)tok * 384 + c), o);
    const float* gw = p.gdn_w + layer * 64 + (c & 63);
#pragma unroll
    for (int e = 0; e < 8; ++e) o[e] *= rs * gw[e];
  } else if (n == 0) {
    const int hh = c >> 6;
    const float* st = (const float*)(ws + O_STA);
    float mg[4], lg[4], mm = -1e30f;
#pragma unroll
    for (int g = 0; g < 4; ++g) { const f32x2 s2 = *(const f32x2*)(st + ((size_t)(g * TH + tok) * 6 + hh) * 2); mg[g] = s2[0]; lg[g] = s2[1]; mm = fmaxf(mm, mg[g]); }
    float wg[4], ws_ = 0.f;
#pragma unroll
    for (int g = 0; g < 4; ++g) { wg[g] = exp2f(mg[g] - mm) * lg[g]; ws_ += wg[g]; }
    const float inv = 1.f / ws_;
#pragma unroll
    for (int e = 0; e < 8; ++e) o[e] = 0.f;
#pragma unroll
    for (int g = 0; g < 4; ++g) {
      if (lg[g] > 0.f) {
        float t[8]; unpk8(*(const bf16x8*)((const bf16_t*)(ws + O_OA + g * SZ_O) + (size_t)tok * 384 + c), t);
        const float wgi = wg[g] * inv;
#pragma unroll
        for (int e = 0; e < 8; ++e) o[e] += wgi * t[e];
      }
    }
  } else {
    const size_t off = (n == 2) ? O_OC : O_OE;
    unpk8(*(const bf16x8*)((const bf16_t*)(ws + off) + (size_t)tok * 384 + c), o);
  }
#pragma unroll
  for (int e = 0; e < 8; ++e) o[e] *= z[e];
  *(bf16x8*)szp = pk8(o);
}

DI void p4a_tile(const Params& p, int layer, int mt, int nt, unsigned char* smem) {
  sub_sync();
  bf16_t* As = (bf16_t*)smem; bf16_t* Bs = As + 2 * 9216;
  const int tid = otid(), lane = tid & 63, wave = tid >> 6, wr = wave >> 1, wc = wave & 1, r = lane & 31, h = lane >> 5;
  const int m0 = mt * 128, n0 = nt * 128;
  f32x16 tot[2][2]; zero_acc(tot);
  const bf16_t* SIG = (const bf16_t*)(p.ws + O_SIG);
  for (int n = 0; n < 5; ++n) {
    f32x16 acc[2][2]; zero_acc(acc);
    PlainA al{(const bf16_t*)(p.ws + O_SZ) + n * 384, 1920};
    gemm_kloop_t<32>(al, (const bf16_t*)(p.ws + O_WTBR) + (size_t)(layer * 5 + n) * 1024 * 384, 384, 12, m0, n0, acc, As, Bs);
#pragma unroll
    for (int mi = 0; mi < 2; ++mi) {
      const int tok = m0 + wr * 64 + mi * 32 + r;
#pragma unroll
      for (int ni = 0; ni < 2; ++ni)
#pragma unroll
        for (int g = 0; g < 4; ++g) {
          const int col = n0 + wc * 64 + ni * 32 + 8 * g + 4 * h;
          const u32x2 sg = *(const u32x2*)(SIG + (size_t)tok * 5120 + n * 1024 + col);
          tot[mi][ni][4 * g] += bflo(sg.x) * acc[mi][ni][4 * g];
          tot[mi][ni][4 * g + 1] += bfhi(sg.x) * acc[mi][ni][4 * g + 1];
          tot[mi][ni][4 * g + 2] += bflo(sg.y) * acc[mi][ni][4 * g + 2];
          tot[mi][ni][4 * g + 3] += bfhi(sg.y) * acc[mi][ni][4 * g + 3];
          asm volatile("" ::: "memory");
        }
    }
  }
  bf16_t* YM = (bf16_t*)(p.ws + O_YM);
  {
    bf16_t* stg = (bf16_t*)smem + wave * (64 * 72);
#pragma unroll
    for (int ni = 0; ni < 2; ++ni)
#pragma unroll
      for (int mi = 0; mi < 2; ++mi)
#pragma unroll
        for (int g = 0; g < 4; ++g)
          *(u32x2*)(stg + (mi * 32 + r) * 72 + ni * 32 + 8 * g + 4 * h) = pk4(tot[mi][ni][4 * g], tot[mi][ni][4 * g + 1], tot[mi][ni][4 * g + 2], tot[mi][ni][4 * g + 3]);
    asm volatile("s_waitcnt lgkmcnt(0)" ::: "memory");
    __builtin_amdgcn_wave_barrier();
    const int tok0 = m0 + wr * 64, col0 = n0 + wc * 64;
#pragma unroll
    for (int it = 0; it < 8; ++it) {
      const int row = it * 8 + (lane >> 3), ch = (lane & 7) * 8;
      const bf16x8 val = *(const bf16x8*)(stg + row * 72 + ch);
      *(bf16x8*)(YM + (size_t)(tok0 + row) * 1024 + col0 + ch) = val;
    }
  }
}

DI void p4b_tile(const Params& p, int layer, int half, int mt, int nt, unsigned char* smem) {
  bf16_t* As = (bf16_t*)smem; bf16_t* Bs = As + 2 * 9216;
  const int tid = otid(), lane = tid & 63, wave = tid >> 6, wr = wave >> 1, wc = wave & 1, r = lane & 31, h = lane >> 5;
  const int m0 = mt * 128, n0 = nt * 128;
  f32x16 acc[2][2]; zero_acc(acc);
  PlainA al{(const bf16_t*)(p.ws + O_YM), 1024};
  gemm_kloop(al, (const bf16_t*)(p.ws + O_WTOUT + layer * SZ_WTOUT1), 1024, 16, m0, n0, acc, As, Bs);
  const float* xin = layer == 0 ? p.x : p.out;
  const float alpha = 1.4142135623730951f;
#pragma unroll
  for (int mi = 0; mi < 2; ++mi) {
    const size_t gt = (size_t)half * TH + m0 + wr * 64 + mi * 32 + r;
#pragma unroll
    for (int ni = 0; ni < 2; ++ni)
#pragma unroll
      for (int g = 0; g < 4; ++g) {
        const int col = n0 + wc * 64 + ni * 32 + 8 * g + 4 * h;
        const f32x4 xv = *(const f32x4*)(xin + gt * 1024 + col);
        f32x4 o;
#pragma unroll
        for (int e = 0; e < 4; ++e) o[e] = alpha * xv[e] + acc[mi][ni][4 * g + e];
        *(f32x4*)(p.out + gt * 1024 + col) = o;
      }
  }
}

DI void gemm8_kloop(const bf16_t* __restrict__ Ab, int lda, const bf16_t* __restrict__ Bb, int ldb, int nkt, f32x4 (&acc)[4][4], unsigned char* lds) {
  const int tid = rtid(), wid = tid >> 6, lane = tid & 63, wr = wid >> 1, wc = wid & 1, fr = lane & 15, fq = lane >> 4;
  int aOff[4], bOff[2];
#pragma unroll
  for (int i = 0; i < 4; ++i) { int R, C; g_stage_rc(wid * 1024 + i * 8192 + lane * 16, R, C); aOff[i] = R * lda + C; }
#pragma unroll
  for (int i = 0; i < 2; ++i) { int R, C; g_stage_rc(wid * 1024 + i * 8192 + lane * 16, R, C); bOff[i] = R * ldb + C; }
  auto stage = [&](int buf, int kt) {
#pragma unroll
    for (int i = 0; i < 4; ++i)
      __builtin_amdgcn_global_load_lds((const unsigned*)(Ab + aOff[i] + kt * 64), (unsigned*)(lds + buf * 49152 + wid * 1024 + i * 8192), 16, 0, 0);
#pragma unroll
    for (int i = 0; i < 2; ++i)
      __builtin_amdgcn_global_load_lds((const unsigned*)(Bb + bOff[i] + kt * 64), (unsigned*)(lds + buf * 49152 + 32768 + wid * 1024 + i * 8192), 16, 0, 0);
  };
  const int lane_off = (fr * 64 + fq * 16) ^ ((fr >> 3) << 5);
  __syncthreads();
  stage(0, 0);
  asm volatile("s_waitcnt vmcnt(0)" ::: "memory");
  __syncthreads();
#pragma unroll 1
  for (int t = 0; t < nkt; ++t) {
    const int cur = t & 1;
    if (t + 1 < nkt) stage(cur ^ 1, t + 1);
    const unsigned char* SA = lds + cur * 49152 + wr * 8192 + lane_off;
    const unsigned char* SB = lds + cur * 49152 + 32768 + wc * 8192 + lane_off;
#pragma unroll
    for (int ks = 0; ks < 2; ++ks) {
      bf16x8 At[4], Bf[4];
#pragma unroll
      for (int n = 0; n < 4; ++n) Bf[n] = *(const bf16x8*)(SB + n * 2048 + ks * 1024);
#pragma unroll
      for (int m = 0; m < 4; ++m) At[m] = *(const bf16x8*)(SA + m * 2048 + ks * 1024);
#pragma unroll
      for (int m = 0; m < 4; ++m)
#pragma unroll
        for (int n = 0; n < 4; ++n) acc[m][n] = MFMA16(Bf[n], At[m], acc[m][n]);
    }
    asm volatile("s_waitcnt vmcnt(0)" ::: "memory");
    __syncthreads();
  }
}

DI void p4a_unit(const Params& p, int layer, int pm, int pn, unsigned char* lds) {
  const int tid = rtid(), wid = tid >> 6, lane = tid & 63, wr = wid >> 1, wc = wid & 1, fr = lane & 15, fq = lane >> 4;
  const int tok0 = pm * 256 + wr * 64, col0 = pn * 128 + wc * 64;
  const bf16_t* SIG = (const bf16_t*)(p.ws + O_SIG);
  const bf16_t* Ab = (const bf16_t*)(p.ws + O_SZ) + (size_t)pm * 256 * 1920;
  const bf16_t* Bb = (const bf16_t*)(p.ws + O_WTBR) + (size_t)layer * 5 * 1024 * 384 + (size_t)pn * 128 * 384;
  int aOff[4], bOff[2];
#pragma unroll
  for (int i = 0; i < 4; ++i) { int R, C; g_stage_rc(wid * 1024 + i * 8192 + lane * 16, R, C); aOff[i] = R * 1920 + C; }
#pragma unroll
  for (int i = 0; i < 2; ++i) { int R, C; g_stage_rc(wid * 1024 + i * 8192 + lane * 16, R, C); bOff[i] = R * 384 + C; }
  auto stage = [&](int buf, int T) {
    const int nb = T / 6, kk = T - nb * 6;
    const long bo = (long)nb * (1024 * 384) + kk * 64;
#pragma unroll
    for (int i = 0; i < 4; ++i)
      __builtin_amdgcn_global_load_lds((const unsigned*)(Ab + aOff[i] + T * 64), (unsigned*)(lds + buf * 49152 + wid * 1024 + i * 8192), 16, 0, 0);
#pragma unroll
    for (int i = 0; i < 2; ++i)
      __builtin_amdgcn_global_load_lds((const unsigned*)(Bb + bOff[i] + bo), (unsigned*)(lds + buf * 49152 + 32768 + wid * 1024 + i * 8192), 16, 0, 0);
  };
  f32x4 tot[4][4], acc[4][4];
#pragma unroll
  for (int m = 0; m < 4; ++m)
#pragma unroll
    for (int n = 0; n < 4; ++n) { tot[m][n] = (f32x4){0.f, 0.f, 0.f, 0.f}; acc[m][n] = (f32x4){0.f, 0.f, 0.f, 0.f}; }
  const int lane_off = (fr * 64 + fq * 16) ^ ((fr >> 3) << 5);
  __syncthreads();
  stage(0, 0);
  asm volatile("s_waitcnt vmcnt(0)" ::: "memory");
  __syncthreads();
#pragma unroll 1
  for (int t = 0; t < 30; ++t) {
    const int cur = t & 1;
    if (t + 1 < 30) stage(cur ^ 1, t + 1);
    const unsigned char* SA = lds + cur * 49152 + wr * 8192 + lane_off;
    const unsigned char* SB = lds + cur * 49152 + 32768 + wc * 8192 + lane_off;
#pragma unroll
    for (int ks = 0; ks < 2; ++ks) {
      bf16x8 At[4], Bf[4];
#pragma unroll
      for (int n = 0; n < 4; ++n) Bf[n] = *(const bf16x8*)(SB + n * 2048 + ks * 1024);
#pragma unroll
      for (int m = 0; m < 4; ++m) At[m] = *(const bf16x8*)(SA + m * 2048 + ks * 1024);
#pragma unroll
      for (int m = 0; m < 4; ++m)
#pragma unroll
        for (int n = 0; n < 4; ++n) acc[m][n] = MFMA16(Bf[n], At[m], acc[m][n]);
    }
    const int nb = t / 6;
    if (t - nb * 6 == 5) {
#pragma unroll
      for (int m = 0; m < 4; ++m) {
        const int tok = tok0 + m * 16 + fr;
#pragma unroll
        for (int n = 0; n < 4; ++n) {
          const u32x2 sg = *(const u32x2*)(SIG + (size_t)tok * 5120 + nb * 1024 + col0 + n * 16 + fq * 4);
          tot[m][n][0] += bflo(sg.x) * acc[m][n][0]; tot[m][n][1] += bfhi(sg.x) * acc[m][n][1];
          tot[m][n][2] += bflo(sg.y) * acc[m][n][2]; tot[m][n][3] += bfhi(sg.y) * acc[m][n][3];
          acc[m][n] = (f32x4){0.f, 0.f, 0.f, 0.f};
        }
      }
    }
    asm volatile("s_waitcnt vmcnt(0)" ::: "memory");
    __syncthreads();
  }
  bf16_t* YM = (bf16_t*)(p.ws + O_YM);
  bf16_t* stg = (bf16_t*)(lds + wid * 9216);
#pragma unroll
  for (int m = 0; m < 4; ++m)
#pragma unroll
    for (int n = 0; n < 4; ++n) *(u32x2*)(stg + (m * 16 + fr) * 72 + n * 16 + fq * 4) = pk4(tot[m][n][0], tot[m][n][1], tot[m][n][2], tot[m][n][3]);
  asm volatile("s_waitcnt lgkmcnt(0)" ::: "memory");
  __builtin_amdgcn_wave_barrier();
#pragma unroll
  for (int it = 0; it < 8; ++it) {
    const int row = it * 8 + (lane >> 3), ch = (lane & 7) * 8;
    const bf16x8 val = *(const bf16x8*)(stg + row * 72 + ch);
    *(bf16x8*)(YM + (size_t)(tok0 + row) * 1024 + col0 + ch) = val;
  }
}

DI void p4b_unit(const Params& p, int layer, int half, int pm, int pn, unsigned char* lds) {
  const int tid = rtid(), wid = tid >> 6, lane = tid & 63, wr = wid >> 1, wc = wid & 1, fr = lane & 15, fq = lane >> 4;
  f32x4 acc[4][4];
#pragma unroll
  for (int m = 0; m < 4; ++m)
#pragma unroll
    for (int n = 0; n < 4; ++n) acc[m][n] = (f32x4){0.f, 0.f, 0.f, 0.f};
  gemm8_kloop((const bf16_t*)(p.ws + O_YM) + (size_t)pm * 256 * 1024, 1024,
              (const bf16_t*)(p.ws + O_WTOUT + layer * SZ_WTOUT1) + (size_t)pn * 128 * 1024, 1024, 16, acc, lds);
  const float* xin = layer == 0 ? p.x : p.out;
  const float alpha = 1.4142135623730951f;
#pragma unroll
  for (int m = 0; m < 4; ++m) {
    const size_t gt = (size_t)half * TH + pm * 256 + wr * 64 + m * 16 + fr;
#pragma unroll
    for (int n = 0; n < 4; ++n) {
      const int col = pn * 128 + wc * 64 + n * 16 + fq * 4;
      const f32x4 xv = *(const f32x4*)(xin + gt * 1024 + col);
      f32x4 o;
#pragma unroll
      for (int e = 0; e < 4; ++e) o[e] = alpha * xv[e] + acc[m][n][e];
      *(f32x4*)(p.out + gt * 1024 + col) = o;
    }
  }
}

DI void p4c_row(const Params& p, int layer, size_t gt, bool wxb = true) {
  const int lane = otid() & 63;
  float* row = p.out + gt * 1024;
  f32x4 v[4]; float s = 0.f;
#pragma unroll
  for (int j = 0; j < 4; ++j) { v[j] = *(const f32x4*)(row + 4 * lane + 256 * j); s += v[j][0] + v[j][1] + v[j][2] + v[j][3]; }
#pragma unroll
  for (int o = 32; o >= 1; o >>= 1) s += __shfl_xor(s, o);
  const float mu = s * (1.f / 1024.f); float q = 0.f;
#pragma unroll
  for (int j = 0; j < 4; ++j) { v[j] -= mu; q += v[j][0] * v[j][0] + v[j][1] * v[j][1] + v[j][2] * v[j][2] + v[j][3] * v[j][3]; }
#pragma unroll
  for (int o = 32; o >= 1; o >>= 1) q += __shfl_xor(q, o);
  const float rs = rsqrtf(q * (1.f / 1024.f) + 1e-5f);
  bf16_t* xb = (bf16_t*)(p.ws + O_XB) + gt * 1024;
#pragma unroll
  for (int j = 0; j < 4; ++j) {
    const int c = 4 * lane + 256 * j;
    const f32x4 g = *(const f32x4*)(p.ln_g + layer * 1024 + c), b = *(const f32x4*)(p.ln_b + layer * 1024 + c);
    f32x4 y;
#pragma unroll
    for (int e = 0; e < 4; ++e) y[e] = v[j][e] * rs * g[e] + b[e];
    *(f32x4*)(row + c) = y;
    if (wxb) *(u32x2*)(xb + c) = pk4(y[0], y[1], y[2], y[3]);
  }
}


#define XB_TMO      128
#define XB_XCNT(j)  (256  + 64 * (j))
#define XB_XSUB(j)  (1280 + 64 * (j))
#define XB_XGEN(j)  (2304 + 64 * (j))
#define XB_TOP      3328
#define XB_TOPGEN   3392
#define XB_SPIN_CAP (1u << 22)
#define LAS __attribute__((address_space(3)))
DI unsigned xb_ld(unsigned* p) { return __hip_atomic_load(p, __ATOMIC_RELAXED, __HIP_MEMORY_SCOPE_AGENT); }
DI unsigned xb_add(unsigned* p, unsigned v) { return __hip_atomic_fetch_add(p, v, __ATOMIC_RELAXED, __HIP_MEMORY_SCOPE_AGENT); }
DI unsigned xb_xcc_id() { return (unsigned)__builtin_amdgcn_s_getreg((3 << 11) | 20) & 0xFu; }
#define XB_SPIN(cond, bar) do { unsigned _sp = 0; while (cond) { __builtin_amdgcn_s_sleep(1); \
    if ((++_sp & 255u) == 0u) { if (xb_ld(&(bar)[XB_TMO])) break; if (_sp > XB_SPIN_CAP) { atomicAdd(&(bar)[XB_TMO], 1u); break; } } } } while (0)
struct XcdBarrier { unsigned* bar; unsigned x; volatile LAS unsigned* st; };
DI XcdBarrier xcd_barrier_post(unsigned* bar, volatile LAS unsigned* st) {
  XcdBarrier b; b.bar = bar; b.x = xb_xcc_id(); b.st = st;
  if (threadIdx.x == 0) (void)xb_add(&bar[XB_XCNT(b.x)], 1u);
  return b;
}
DI void xcd_barrier_complete(unsigned* bar, unsigned x, unsigned& nloc, unsigned& nx) {
  const unsigned G = gridDim.x;
  unsigned sum, cnt, mine, sp = 0u;
  for (;;) {
    sum = 0u; cnt = 0u; mine = 0u;
#pragma unroll
    for (unsigned j = 0; j < 16; ++j) { const unsigned c = xb_ld(&bar[XB_XCNT(j)]); sum += c; cnt += (c > 0u) ? 1u : 0u; mine = (j == x) ? c : mine; }
    if (sum == G) break;
    __builtin_amdgcn_s_sleep(1);
    if ((++sp & 255u) == 0u) { if (xb_ld(&bar[XB_TMO])) break; if (sp > XB_SPIN_CAP) { atomicAdd(&bar[XB_TMO], 1u); break; } }
  }
  nloc = mine > 0u ? mine : 1u; nx = cnt > 0u ? cnt : 1u;
}
DI void xcd_barrier(const XcdBarrier& b) {
  asm volatile("s_waitcnt vmcnt(0)" ::: "memory");
  __syncthreads();
  if (threadIdx.x == 0) {
    unsigned* bar = b.bar;
    __builtin_amdgcn_s_waitcnt(0);
    unsigned nloc = b.st[0], nx = b.st[1];
    if (nloc == 0u) { xcd_barrier_complete(bar, b.x, nloc, nx); b.st[0] = nloc; b.st[1] = nx; }
    const unsigned old = xb_add(&bar[XB_XSUB(b.x)], 1u);
    const unsigned gen = old / nloc;
    if (old + 1u == (gen + 1u) * nloc) {
      __builtin_amdgcn_fence(__ATOMIC_RELEASE, "agent");
      asm volatile("s_waitcnt vmcnt(0)" ::: "memory");
      const unsigned og = xb_add(&bar[XB_TOP], 1u);
      const unsigned tg = og / nx;
      if (og + 1u == (tg + 1u) * nx) xb_add(&bar[XB_TOPGEN], 1u);
      else XB_SPIN(xb_ld(&bar[XB_TOPGEN]) == tg, bar);
      __builtin_amdgcn_fence(__ATOMIC_ACQUIRE, "agent");
      xb_add(&bar[XB_XGEN(b.x)], 1u);
      asm volatile("s_waitcnt vmcnt(0)" ::: "memory");
    } else {
      XB_SPIN(xb_ld(&bar[XB_XGEN(b.x)]) == gen, bar);
      __builtin_amdgcn_fence(__ATOMIC_ACQUIRE, "agent");
      asm volatile("s_waitcnt vmcnt(0)" ::: "memory");
    }
  }
  __syncthreads();
}

#ifdef PROBE_A
#define STAMP(k) do { if (blockIdx.x == 0 && otid() == 0) { unsigned long long now_ = __builtin_amdgcn_s_memrealtime(); tsacc[k] += (float)(now_ - tlast) * 0.01f; tlast = now_; } } while (0)
#else
#define STAMP(k) do {} while (0)
#endif
__global__ void __launch_bounds__(512, 2) mega(Params p) {
  extern __shared__ __attribute__((aligned(16))) unsigned char smem_all[];
  cg::grid_group grid = cg::this_grid();
  if (p.ws == nullptr) grid.sync();
  volatile LAS unsigned* xbst = (volatile LAS unsigned*)(smem_all + 2 * SUB_LDS);
  if (threadIdx.x < 4) xbst[threadIdx.x] = 0u;
  __syncthreads();
  const XcdBarrier xb = xcd_barrier_post((unsigned*)(p.ws + O_BAR), xbst);
#define GSYNC() xcd_barrier(xb)
  const int sub = __builtin_amdgcn_readfirstlane(__builtin_amdgcn_workitem_id_x() >> 8);
  unsigned char* smem = smem_all + sub * SUB_LDS;
  const int vb = (int)blockIdx.x * 2 + sub, vgrid = (int)gridDim.x * 2;
  const int wave = otid() >> 6;
  const int gw = vb * 4 + wave, ngw = vgrid * 4;
  phase0(p, smem, vb, vgrid);
  GSYNC();
  int pend_layer = -1, pend_half = 0;
  for (int itn = 0; itn < 4; ++itn) {
    const int layer = itn >> 1, half = itn & 1;
    if (pend_layer >= 0) { for (int rw = gw; rw < TH; rw += ngw) p4c_row(p, pend_layer, (size_t)pend_half * TH + rw, true); pend_layer = -1; }
    for (int t = (int)blockIdx.x; t < 32 * 54; t += (int)gridDim.x) {
      const int tn = t + (int)gridDim.x;
      p1_unit(p, layer, half, t & 31, t >> 5, tn < 32 * 54 ? (tn & 31) : 0, tn < 32 * 54 ? (tn >> 5) : -1, t == (int)blockIdx.x, smem_all);
    }
    GSYNC();
    const int vb2 = sub * (int)gridDim.x + (int)blockIdx.x;
    {
      constexpr int N_FOX = 6, N_GDN = 768, N_MKV = 12, N_KM = 48, TOT = N_FOX + N_GDN + N_MKV + N_KM;
      for (int t = vb2; t < TOT; t += vgrid) {
        int i = t;
        if (i < N_FOX) { fox_prep(p, i, smem); continue; }
        i -= N_FOX;
        if (i < N_GDN) { gdn_prep(p, layer, half, i / 128, i % 128, smem); continue; }
        i -= N_GDN;
        if (i < N_MKV) { memkv_tile(p, layer, half, i / 6, i % 6, smem); continue; }
        i -= N_MKV;
        kmean_prep(p, i * 4 + wave, (unsigned*)(p.ws + O_CTL) + 64 + (layer * 2 + half) * 8);
      }
    }
    if (vb2 >= 256) { for (int a = (vb2 - 256) * 4 + wave; a < 1536; a += (vgrid - 256) * 4) moba_select(p, a); }
    GSYNC();
    phase3(p, half, (unsigned*)(p.ws + O_CTL) + layer * 2 + half, (const unsigned*)(p.ws + O_CTL) + 64 + (layer * 2 + half) * 8, smem, sub);
    GSYNC();
    for (int ci = vb * 256 + otid(); ci < TH * 240; ci += vgrid * 256) gbuild_chunk(p, layer, ci / 240, ci % 240);
    GSYNC();
    for (int t = (int)blockIdx.x; t < 256; t += (int)gridDim.x) p4a_unit(p, layer, t & 31, t >> 5, smem_all);
    GSYNC();
    for (int t = (int)blockIdx.x; t < 256; t += (int)gridDim.x) p4b_unit(p, layer, half, t & 31, t >> 5, smem_all);
    GSYNC();
    pend_layer = layer; pend_half = half;
  }
  if (pend_layer >= 0) { for (int rw = gw; rw < TH; rw += ngw) p4c_row(p, pend_layer, (size_t)pend_half * TH + rw, true); }
}

extern "C" void kernel_launch(void* const* d_in, const int* in_sizes, int n_in, void* d_out, int out_size, void* d_ws, size_t ws_size,
                              hipStream_t stream) {
  static int grid_blocks = 0;
  if (grid_blocks == 0) {
    if (ws_size < WS_END) { fprintf(stderr, "workspace too small: %zu < %zu\n", ws_size, (size_t)WS_END); grid_blocks = -1; return; }
    int dev = 0, cus = 0, per_cu = 0;
    (void)hipGetDevice(&dev);
    (void)hipDeviceGetAttribute(&cus, hipDeviceAttributeMultiprocessorCount, dev);
    (void)hipFuncSetAttribute((const void*)mega, hipFuncAttributeMaxDynamicSharedMemorySize, LDS_BYTES);
    (void)hipOccupancyMaxActiveBlocksPerMultiprocessor(&per_cu, (const void*)mega, 512, LDS_BYTES);
    if (per_cu < 1) per_cu = 1;
    if (per_cu > 1) per_cu = 1;
    grid_blocks = cus * per_cu;
  }
  if (grid_blocks < 0) return;
  (void)hipMemsetAsync((char*)d_ws + O_CTL, 0, 32768, stream);
  Params p{};
  p.x = (const float*)d_in[0]; p.mem = (const float*)d_in[1]; p.mem_g = (const float*)d_in[2]; p.mem_b = (const float*)d_in[3];
  p.w_in = (const float*)d_in[4]; p.b_in = (const float*)d_in[5]; p.conv_w = (const float*)d_in[6]; p.a_log = (const float*)d_in[7];
  p.dt_bias = (const float*)d_in[8]; p.gdn_w = (const float*)d_in[9]; p.w_kv = (const float*)d_in[10]; p.w_br = (const float*)d_in[11];
  p.w_out = (const float*)d_in[12]; p.ln_g = (const float*)d_in[13]; p.ln_b = (const float*)d_in[14];
  p.out = (float*)d_out; p.ws = (unsigned char*)d_ws;
  void* args[] = {&p};
  hipError_t e = hipLaunchCooperativeKernel((const void*)mega, dim3(grid_blocks), dim3(512), args, LDS_BYTES, stream);
  if (e != hipSuccess) fprintf(stderr, "cooperative launch failed: %s (grid %d)\n", hipGetErrorString(e), grid_blocks);
}
```

```cpp
#include <hip/hip_runtime.h>
#include <hip/hip_cooperative_groups.h>
#include <cstdio>
#include <cstdint>
namespace cg = cooperative_groups;

#define DI __device__ __forceinline__
typedef unsigned short bf16_t;
typedef short bf16x8 __attribute__((ext_vector_type(8)));
typedef short s16x4 __attribute__((ext_vector_type(4)));
typedef float f32x4 __attribute__((ext_vector_type(4)));
typedef float f32x2 __attribute__((ext_vector_type(2)));
typedef float f32x16 __attribute__((ext_vector_type(16)));
typedef unsigned u32x2 __attribute__((ext_vector_type(2)));
typedef unsigned u32x4 __attribute__((ext_vector_type(4)));
typedef __bf16 bfv2 __attribute__((ext_vector_type(2)));

#define MFMA32(a, b, c) __builtin_amdgcn_mfma_f32_32x32x16_bf16((a), (b), (c), 0, 0, 0)
#define MFMA16(a, b, c) __builtin_amdgcn_mfma_f32_16x16x32_bf16((a), (b), (c), 0, 0, 0)

DI unsigned pk2(float a, float b) { f32x2 v = {a, b}; return __builtin_bit_cast(unsigned, __builtin_convertvector(v, bfv2)); }
DI bf16_t f2bf(float a) { return (bf16_t)(pk2(a, 0.f) & 0xffffu); }
DI float bf2f(bf16_t v) { return __uint_as_float(((unsigned)v) << 16); }
DI float bflo(unsigned u) { return __uint_as_float(u << 16); }
DI float bfhi(unsigned u) { return __uint_as_float(u & 0xffff0000u); }
DI int rtid() { int t = __builtin_amdgcn_workitem_id_x(); asm volatile("" : "+v"(t)); return t; }
DI int otid() { return rtid() & 255; }
extern __shared__ __attribute__((aligned(16))) unsigned char g_lds_all[];
#define LAS3 __attribute__((address_space(3)))
DI void sub_sync() {
  asm volatile("s_waitcnt lgkmcnt(0)" ::: "memory");
  const int t = __builtin_amdgcn_workitem_id_x();
  LAS3 unsigned* c = (LAS3 unsigned*)(g_lds_all + 2 * 75776 + 8) + (t >> 8);
  if ((t & 63) == 0) {
    const unsigned old = __hip_atomic_fetch_add(c, 1u, __ATOMIC_RELAXED, __HIP_MEMORY_SCOPE_WORKGROUP);
    const unsigned target = (old / 4u + 1u) * 4u;
    while (__hip_atomic_load(c, __ATOMIC_RELAXED, __HIP_MEMORY_SCOPE_WORKGROUP) < target) __builtin_amdgcn_s_sleep(1);
  }
  asm volatile("s_waitcnt lgkmcnt(0)" ::: "memory");
}
DI int crow(int i, int h) { return (i & 3) + 8 * (i >> 2) + 4 * h; }
DI float fsigmoid(float v) { return __builtin_amdgcn_rcpf(1.f + __expf(-v)); }
DI float fsilu(float v) { return v * fsigmoid(v); }
DI u32x2 pk4(float a, float b, float c, float d) { u32x2 r; r.x = pk2(a, b); r.y = pk2(c, d); return r; }
DI bf16x8 pk8(const float* v) { u32x4 r; r.x = pk2(v[0], v[1]); r.y = pk2(v[2], v[3]); r.z = pk2(v[4], v[5]); r.w = pk2(v[6], v[7]); return __builtin_bit_cast(bf16x8, r); }
DI void unpk8(bf16x8 x, float* v) { u32x4 u = __builtin_bit_cast(u32x4, x); v[0] = bflo(u.x); v[1] = bfhi(u.x); v[2] = bflo(u.y); v[3] = bfhi(u.y); v[4] = bflo(u.z); v[5] = bfhi(u.z); v[6] = bflo(u.w); v[7] = bfhi(u.w); }

constexpr int NB = 2, SQ = 8192, NT = NB * SQ, DM = 1024, NH = 6, BW = 384;
constexpr int TH = 8192;
constexpr int NP = 13824;
constexpr int DIN = 13586;
constexpr float LOG2E = 1.4426950408889634f;
#define NEG_INF (-__builtin_inff())

constexpr int C_AQK = 0, C_AV = 768, C_BQK = 1152, C_BV = 3456, C_CQK = 3840, C_CV = 4608, C_D = 4992, C_E = 6144, C_SM = 6528, C_SMEND = 6546, C_Z = 6656, C_MG = 8576;

__host__ __device__ constexpr int inmap(int n) {
  return n < 4992 ? n : n < 6144 ? n + 6 : n < 6528 ? n + 18 : n < 6534 ? n - 1536 : n < 6546 ? n - 384 : n < 6656 ? -1 : n < 13696 ? n - 110 : -1;
}

constexpr size_t O_CTL = 0;
constexpr size_t O_BAR = 4096;
constexpr size_t O_WTIN = 32768;
constexpr size_t SZ_WTIN1 = (size_t)NP * 1024 * 2;
constexpr size_t O_WTBR = O_WTIN + 2 * SZ_WTIN1;
constexpr size_t SZ_WTBR1 = (size_t)5 * 1024 * 384 * 2;
constexpr size_t O_WTOUT = O_WTBR + 2 * SZ_WTBR1;
constexpr size_t SZ_WTOUT1 = (size_t)1024 * 1024 * 2;
constexpr size_t O_WTKV = O_WTOUT + 2 * SZ_WTOUT1;
constexpr size_t SZ_WTKV1 = (size_t)768 * 1024 * 2;
constexpr size_t O_BIASP = O_WTKV + 2 * SZ_WTKV1;
constexpr size_t O_XB = O_BIASP + (size_t)2 * NP * 4;
constexpr size_t O_MEMN = O_XB + (size_t)NT * 1024 * 2;
constexpr size_t O_MEMK = O_MEMN + (size_t)512 * 1024 * 2;
constexpr size_t O_MEMVT = O_MEMK + (size_t)512 * 384 * 2;
constexpr size_t O_QKA = O_MEMVT + (size_t)512 * 384 * 2;
constexpr size_t SZ_VT = (size_t)384 * TH * 2;
constexpr size_t O_KFA = O_QKA + SZ_VT;
constexpr size_t O_VTA = O_KFA + SZ_VT;
constexpr size_t O_QKB = O_VTA + SZ_VT;
constexpr size_t O_KFB = O_QKB + 3 * SZ_VT;
constexpr size_t O_VTB = O_KFB + 3 * SZ_VT;
constexpr size_t O_QKC = O_VTB + 3 * SZ_VT;
constexpr size_t O_KFC = O_QKC + SZ_VT;
constexpr size_t O_VTC = O_KFC + SZ_VT;
constexpr size_t O_QKVD = O_VTC + SZ_VT;
constexpr size_t O_QE = O_QKVD + (size_t)TH * 1152 * 2;
constexpr size_t O_SM = O_QE + (size_t)TH * 384 * 2;
constexpr size_t O_FF = O_SM + (size_t)TH * 32 * 4;
constexpr size_t O_KM = O_FF + (size_t)6 * TH * 4;
constexpr size_t O_KMAX = O_KM + (size_t)2 * 6 * 32 * 64 * 2;
constexpr size_t O_GL = O_KMAX + 256;
constexpr size_t O_MASK = O_GL + 6 * 128 * 4;
constexpr size_t O_KSUM = O_MASK + (size_t)TH * 8 * 4;
constexpr size_t O_DPREP = O_KSUM + (size_t)32 * 2 * 384 * 4;
constexpr size_t O_SZ = O_DPREP + (size_t)768 * 32768;
constexpr size_t O_SIG = O_SZ + (size_t)TH * 1920 * 2;
constexpr size_t O_OA = O_SIG + (size_t)TH * 5120 * 2;
constexpr size_t SZ_O = (size_t)TH * 384 * 2;
constexpr size_t O_STA = O_OA + 4 * SZ_O;
constexpr size_t O_OB = O_STA + (size_t)4 * TH * 6 * 2 * 4;
constexpr size_t O_STB = O_OB + 3 * SZ_O;
constexpr size_t O_OC = O_STB + (size_t)3 * TH * 6 * 2 * 4;
constexpr size_t O_OD = O_OC + SZ_O;
constexpr size_t O_SSQ = O_OD + SZ_O;
constexpr size_t O_OE = O_SSQ + (size_t)TH * 6 * 4 * 4;
constexpr size_t WS_END = O_OE + SZ_O;
constexpr size_t O_YM = O_QKB;
static_assert(WS_END < (size_t)443 * 1000 * 1000, "workspace too large");

struct Params {
  const float *x, *mem, *mem_g, *mem_b, *w_in, *b_in, *conv_w, *a_log, *dt_bias, *gdn_w, *w_kv, *w_br, *w_out, *ln_g, *ln_b;
  float* out;
  unsigned char* ws;
};

constexpr int SUB_LDS = 75776;
constexpr int LDS_BYTES = 2 * SUB_LDS + 16;
#ifndef PH_MASK
#define PH_MASK 0xFFFF
#endif
#define PH(x) ((PH_MASK >> (x)) & 1)
#ifndef REP_MASK
#define REP_MASK 0
#endif
#define REP(x) (1 + ((REP_MASK >> (x)) & 1))

DI void transpose_tile(const float* __restrict__ src, int ld, int k0, int n0, bool usemap, bf16_t* __restrict__ dst, int dstld, float* tile) {
  const int tid = otid();
#pragma unroll
  for (int it = 0; it < 16; ++it) {
    const int kk = (tid >> 6) + 4 * it, n2 = (tid & 63) * 2;
    const int sc = usemap ? inmap(n0 + n2) : (n0 + n2);
    f32x2 v = {0.f, 0.f};
    if (sc >= 0) v = *(const f32x2*)(src + (size_t)(k0 + kk) * ld + sc);
    *(f32x2*)(tile + kk * 130 + n2) = v;
  }
  sub_sync();
#pragma unroll
  for (int it = 0; it < 4; ++it) {
    const int nn = (tid >> 3) + 32 * it, kc = (tid & 7) * 8;
    float v[8];
#pragma unroll
    for (int e = 0; e < 8; ++e) v[e] = tile[(kc + e) * 130 + nn];
    *(bf16x8*)(dst + (size_t)(n0 + nn) * dstld + k0 + kc) = pk8(v);
  }
  sub_sync();
}

DI void transpose_in_pair(const Params& p, int iA, int iB, float* tile) {
  const int tid = otid();
  const float* srcA; const float* srcB; bf16_t* dstA; bf16_t* dstB; int k0A, n0A, k0B, n0B;
  { const int l = iA / (108 * 16), rr = iA % (108 * 16); srcA = p.w_in + (size_t)l * 1024 * DIN; dstA = (bf16_t*)(p.ws + O_WTIN + l * SZ_WTIN1); n0A = (rr / 16) * 128; k0A = (rr % 16) * 64; }
  const bool hasB = iB >= 0;
  { const int i = hasB ? iB : iA; const int l = i / (108 * 16), rr = i % (108 * 16); srcB = p.w_in + (size_t)l * 1024 * DIN; dstB = (bf16_t*)(p.ws + O_WTIN + l * SZ_WTIN1); n0B = (rr / 16) * 128; k0B = (rr % 16) * 64; }
  float* tileB = tile + 64 * 130;
  f32x2 va[16], vb2[16];
#pragma unroll
  for (int it = 0; it < 16; ++it) {
    const int kk = (tid >> 6) + 4 * it, n2 = (tid & 63) * 2;
    const int scA = inmap(n0A + n2), scB = inmap(n0B + n2);
    va[it] = (f32x2){0.f, 0.f}; vb2[it] = (f32x2){0.f, 0.f};
    if (scA >= 0) va[it] = *(const f32x2*)(srcA + (size_t)(k0A + kk) * DIN + scA);
    if (scB >= 0) vb2[it] = *(const f32x2*)(srcB + (size_t)(k0B + kk) * DIN + scB);
  }
#pragma unroll
  for (int it = 0; it < 16; ++it) {
    const int kk = (tid >> 6) + 4 * it, n2 = (tid & 63) * 2;
    *(f32x2*)(tile + kk * 130 + n2) = va[it];
    *(f32x2*)(tileB + kk * 130 + n2) = vb2[it];
  }
  sub_sync();
#pragma unroll
  for (int it = 0; it < 4; ++it) {
    const int nn = (tid >> 3) + 32 * it, kc = (tid & 7) * 8;
    float v[8], w[8];
#pragma unroll
    for (int e = 0; e < 8; ++e) { v[e] = tile[(kc + e) * 130 + nn]; w[e] = tileB[(kc + e) * 130 + nn]; }
    *(bf16x8*)(dstA + (size_t)(n0A + nn) * 1024 + k0A + kc) = pk8(v);
    if (hasB) *(bf16x8*)(dstB + (size_t)(n0B + nn) * 1024 + k0B + kc) = pk8(w);
  }
  sub_sync();
}

DI void phase0(const Params& p, unsigned char* smem, int vb, int vgrid) {
  float* tile = (float*)smem;
  const int tid = otid(), lane = tid & 63, wave = tid >> 6;
  constexpr int N_TIN = 2 * 108 * 16, N_TBR = 2 * 5 * 8 * 6, N_TOUT = 2 * 8 * 16, N_TKV = 2 * 6 * 16, N_XB = 1024, N_MEMN = 128, N_BIAS = 108;
  constexpr int TOT = N_TIN + N_TBR + N_TOUT + N_TKV + N_XB + N_MEMN + N_BIAS;
  for (int it = vb; it < N_TIN; it += 2 * vgrid) transpose_in_pair(p, it, it + vgrid < N_TIN ? it + vgrid : -1, tile);
  for (int it = vb; it < TOT - N_TIN; it += vgrid) {
    int i = it;
    if (i < N_TBR) {
      const int ln = i / 48, rr = i % 48, nt = rr / 6, kt = rr % 6;
      transpose_tile(p.w_br + (size_t)ln * 384 * 1024, 1024, kt * 64, nt * 128, false, (bf16_t*)(p.ws + O_WTBR) + (size_t)ln * 1024 * 384, 384, tile);
      continue;
    }
    i -= N_TBR;
    if (i < N_TOUT) {
      const int l = i / 128, rr = i % 128, nt = rr / 16, kt = rr % 16;
      transpose_tile(p.w_out + (size_t)l * 1024 * 1024, 1024, kt * 64, nt * 128, false, (bf16_t*)(p.ws + O_WTOUT + l * SZ_WTOUT1), 1024, tile);
      continue;
    }
    i -= N_TOUT;
    if (i < N_TKV) {
      const int l = i / 96, rr = i % 96, nt = rr / 16, kt = rr % 16;
      transpose_tile(p.w_kv + (size_t)l * 1024 * 768, 768, kt * 64, nt * 128, false, (bf16_t*)(p.ws + O_WTKV + l * SZ_WTKV1), 1024, tile);
      continue;
    }
    i -= N_TKV;
    if (i < N_XB) {
      const float* src = p.x + (size_t)i * 16 * 1024;
      bf16_t* dst = (bf16_t*)(p.ws + O_XB) + (size_t)i * 16 * 1024;
#pragma unroll
      for (int j = 0; j < 16; ++j) {
        const int e = (j * 256 + tid) * 4;
        const f32x4 v = *(const f32x4*)(src + e);
        *(u32x2*)(dst + e) = pk4(v[0], v[1], v[2], v[3]);
      }
      continue;
    }
    i -= N_XB;
    if (i < N_MEMN) {
      const int row = i * 4 + wave;
      const float* src = p.mem + (size_t)row * 1024;
      f32x4 v[4]; float s = 0.f;
#pragma unroll
      for (int j = 0; j < 4; ++j) { v[j] = *(const f32x4*)(src + 4 * lane + 256 * j); s += v[j][0] + v[j][1] + v[j][2] + v[j][3]; }
#pragma unroll
      for (int o = 32; o >= 1; o >>= 1) s += __shfl_xor(s, o);
      const float mu = s * (1.f / 1024.f); float q = 0.f;
#pragma unroll
      for (int j = 0; j < 4; ++j) { v[j] -= mu; q += v[j][0] * v[j][0] + v[j][1] * v[j][1] + v[j][2] * v[j][2] + v[j][3] * v[j][3]; }
#pragma unroll
      for (int o = 32; o >= 1; o >>= 1) q += __shfl_xor(q, o);
      const float rs = rsqrtf(q * (1.f / 1024.f) + 1e-5f);
      bf16_t* dst = (bf16_t*)(p.ws + O_MEMN) + (size_t)row * 1024;
#pragma unroll
      for (int j = 0; j < 4; ++j) {
        const int c = 4 * lane + 256 * j;
        const f32x4 g = *(const f32x4*)(p.mem_g + c), b = *(const f32x4*)(p.mem_b + c);
        *(u32x2*)(dst + c) = pk4(v[j][0] * rs * g[0] + b[0], v[j][1] * rs * g[1] + b[1], v[j][2] * rs * g[2] + b[2], v[j][3] * rs * g[3] + b[3]);
      }
      continue;
    }
    i -= N_MEMN;
    {
      float* bp = (float*)(p.ws + O_BIASP);
      if (tid < 128) {
        const int n = i * 128 + tid;
        const int sc = inmap(n);
        for (int l = 0; l < 2; ++l) bp[l * NP + n] = sc >= 0 ? p.b_in[l * DIN + sc] : 0.f;
      }
    }
  }
}

template <int BK, class AL>
DI void gemm_kloop_t(const AL& al, const bf16_t* __restrict__ Bt, int ldb, int nkt, int m0, int n0, f32x16 (&acc)[2][2], bf16_t* As, bf16_t* Bs) {
  constexpr int CPR = BK / 8, NCH = BK / 16, PITCH = BK + 8, BUF = 128 * PITCH;
  const int tid = otid(), lane = tid & 63, wave = tid >> 6, wr = wave >> 1, wc = wave & 1, r = lane & 31, h = lane >> 5;
  bf16x8 ra[NCH], rb[NCH];
  auto gload = [&](int kt) {
#pragma unroll
    for (int i = 0; i < NCH; ++i) {
      const int cid = tid + 256 * i, row = cid / CPR, kc = (cid % CPR) * 8;
      ra[i] = al(m0 + row, kt * BK + kc);
      rb[i] = *(const bf16x8*)(Bt + (size_t)(n0 + row) * ldb + kt * BK + kc);
    }
  };
  auto lstore = [&](int buf) {
#pragma unroll
    for (int i = 0; i < NCH; ++i) {
      const int cid = tid + 256 * i, row = cid / CPR, kc = (cid % CPR) * 8;
      *(bf16x8*)(As + buf * BUF + row * PITCH + kc) = ra[i];
      *(bf16x8*)(Bs + buf * BUF + row * PITCH + kc) = rb[i];
    }
  };
  gload(0); lstore(0); sub_sync();
  for (int kt = 0; kt < nkt; ++kt) {
    const int buf = kt & 1;
    if (kt + 1 < nkt) gload(kt + 1);
    asm volatile("" ::: "memory");
    const bf16_t* a_ = As + buf * BUF + (wr * 64 + r) * PITCH + 8 * h;
    const bf16_t* b_ = Bs + buf * BUF + (wc * 64 + r) * PITCH + 8 * h;
#pragma unroll
    for (int s = 0; s < BK / 16; ++s) {
      bf16x8 af[2], bfr[2];
      af[0] = *(const bf16x8*)(a_ + 16 * s); af[1] = *(const bf16x8*)(a_ + 32 * PITCH + 16 * s);
      bfr[0] = *(const bf16x8*)(b_ + 16 * s); bfr[1] = *(const bf16x8*)(b_ + 32 * PITCH + 16 * s);
#pragma unroll
      for (int mi = 0; mi < 2; ++mi)
#pragma unroll
        for (int ni = 0; ni < 2; ++ni) acc[mi][ni] = MFMA32(bfr[ni], af[mi], acc[mi][ni]);
    }
    if (kt + 1 < nkt) lstore(buf ^ 1);
    sub_sync();
  }
}
template <class AL>
DI void gemm_kloop(const AL& al, const bf16_t* __restrict__ Bt, int ldb, int nkt, int m0, int n0, f32x16 (&acc)[2][2], bf16_t* As, bf16_t* Bs) {
  gemm_kloop_t<64>(al, Bt, ldb, nkt, m0, n0, acc, As, Bs);
}

DI void zero_acc(f32x16 (&acc)[2][2]) {
#pragma unroll
  for (int a = 0; a < 2; ++a)
#pragma unroll
    for (int b = 0; b < 2; ++b)
#pragma unroll
      for (int i = 0; i < 16; ++i) acc[a][b][i] = 0.f;
}

DI int vfrag_key(int key) { const int kk = key & 31; return (key >> 5) * 2048 + (kk >> 4) * 512 + ((kk >> 2) & 1) * 256 + ((kk >> 3) & 1) * 4 + (kk & 3); }
DI int vfrag_col(int cw) { const int d = cw & 63; return (cw >> 6) * 524288 + (d >> 5) * 1024 + (d & 31) * 8; }

DI int kfrag_key(int key) { return (key >> 5) * 2048 + (key & 31) * 8; }
DI int kfrag_col(int cw) { const int d = cw & 63; return (cw >> 6) * 524288 + (d >> 4) * 512 + ((d >> 3) & 1) * 256 + (d & 7); }

struct PlainA {
  const bf16_t* A; int lda;
  DI bf16x8 operator()(int row, int k) const { return *(const bf16x8*)(A + (size_t)row * lda + k); }
};

DI void p1_tile(const Params& p, int layer, int half, int mt, int nt, unsigned char* smem) {
  sub_sync();
  bf16_t* As = (bf16_t*)smem; bf16_t* Bs = As + 2 * 9216;
  f32x16 acc[2][2]; zero_acc(acc);
  PlainA al{(const bf16_t*)(p.ws + O_XB) + (size_t)half * TH * 1024, 1024};
  const int m0 = mt * 128, n0 = nt * 128;
  gemm_kloop(al, (const bf16_t*)(p.ws + O_WTIN + layer * SZ_WTIN1), 1024, 16, m0, n0, acc, As, Bs);
  const int tid = otid(), lane = tid & 63, wave = tid >> 6, wr = wave >> 1, wc = wave & 1, r = lane & 31, h = lane >> 5;
  const float* bias = (const float*)(p.ws + O_BIASP) + layer * NP;
  unsigned char* ws = p.ws;
  {
    const int nb0 = n0 + wc * 64;
    bf16_t* dst0 = nullptr; int pitch0 = 0, coff0 = 0, xf0 = 0;
    if (nb0 < 384) { dst0 = (bf16_t*)(ws + O_QKA); pitch0 = 384; coff0 = nb0; }
    else if (nb0 >= C_BQK && nb0 < 2304) { dst0 = (bf16_t*)(ws + O_QKB); pitch0 = 1152; coff0 = nb0 - C_BQK; }
    else if (nb0 >= C_CQK && nb0 < 4224) { dst0 = (bf16_t*)(ws + O_QKC); pitch0 = 384; coff0 = nb0 - C_CQK; }
    else if (nb0 >= C_D && nb0 < C_E) { dst0 = (bf16_t*)(ws + O_QKVD); pitch0 = 1152; coff0 = nb0 - C_D; }
    else if (nb0 >= C_E && nb0 < C_SM) { dst0 = (bf16_t*)(ws + O_QE); pitch0 = 384; coff0 = nb0 - C_E; }
    else if (nb0 >= C_Z && nb0 < C_MG) { dst0 = (bf16_t*)(ws + O_SZ); pitch0 = 1920; coff0 = nb0 - C_Z; xf0 = 1; }
    else if (nb0 >= C_MG) { dst0 = (bf16_t*)(ws + O_SIG); pitch0 = 5120; coff0 = nb0 - C_MG; xf0 = 2; }
    if (dst0 != nullptr) {
      bf16_t* stg = (bf16_t*)smem + wave * (64 * 72);
#pragma unroll
      for (int ni = 0; ni < 2; ++ni)
#pragma unroll
        for (int mi = 0; mi < 2; ++mi)
#pragma unroll
          for (int g = 0; g < 4; ++g) {
            const int cq = ni * 32 + 8 * g + 4 * h;
            const f32x4 bv = *(const f32x4*)(bias + nb0 + cq);
            float v[4];
#pragma unroll
            for (int e = 0; e < 4; ++e) v[e] = acc[mi][ni][4 * g + e] + bv[e];
            if (xf0 == 1) {
#pragma unroll
              for (int e = 0; e < 4; ++e) v[e] = fsilu(v[e]);
            } else if (xf0 == 2) {
#pragma unroll
              for (int e = 0; e < 4; ++e) v[e] = fsigmoid(v[e]);
            }
            *(u32x2*)(stg + (mi * 32 + r) * 72 + cq) = pk4(v[0], v[1], v[2], v[3]);
          }
      asm volatile("s_waitcnt lgkmcnt(0)" ::: "memory");
      __builtin_amdgcn_wave_barrier();
      const int tok0 = m0 + wr * 64;
#pragma unroll
      for (int it = 0; it < 8; ++it) {
        const int row = it * 8 + (lane >> 3), ch = (lane & 7) * 8;
        const bf16x8 val = *(const bf16x8*)(stg + row * 72 + ch);
        *(bf16x8*)(dst0 + (size_t)(tok0 + row) * pitch0 + coff0 + ch) = val;
      }
      return;
    }
  }
#pragma unroll
  for (int ni = 0; ni < 2; ++ni) {
    const int nb = n0 + wc * 64 + ni * 32;
    int kind;
    int xf = 0;
    bf16_t* dst = nullptr; int pitch = 0, coff = 0;
    int kgrp = 0;
    if (nb < 384) { kind = 0; dst = (bf16_t*)(ws + O_QKA); pitch = 384; coff = nb; }
    else if (nb < C_AV) { kind = 5; dst = (bf16_t*)(ws + O_KFA); coff = nb - 384; }
    else if (nb < C_BQK) { kind = 1; dst = (bf16_t*)(ws + O_VTA); coff = nb - C_AV; }
    else if (nb < 2304) { kind = 0; dst = (bf16_t*)(ws + O_QKB); pitch = 1152; coff = nb - C_BQK; }
    else if (nb < C_BV) { kind = 5; kgrp = (nb - 2304) / 384; dst = (bf16_t*)(ws + O_KFB + kgrp * SZ_VT); coff = (nb - 2304) - kgrp * 384; }
    else if (nb < C_CQK) { kind = 2; dst = (bf16_t*)(ws + O_VTB); coff = nb - C_BV; }
    else if (nb < 4224) { kind = 0; dst = (bf16_t*)(ws + O_QKC); pitch = 384; coff = nb - C_CQK; }
    else if (nb < C_CV) { kind = 5; dst = (bf16_t*)(ws + O_KFC); coff = nb - 4224; }
    else if (nb < C_D) { kind = 1; dst = (bf16_t*)(ws + O_VTC); coff = nb - C_CV; }
    else if (nb < C_E) { kind = 0; dst = (bf16_t*)(ws + O_QKVD); pitch = 1152; coff = nb - C_D; }
    else if (nb < C_SM) { kind = 0; dst = (bf16_t*)(ws + O_QE); pitch = 384; coff = nb - C_E; }
    else if (nb < C_Z) { kind = (nb == C_SM) ? 3 : 4; }
    else if (nb < C_MG) { kind = 0; xf = 1; dst = (bf16_t*)(ws + O_SZ); pitch = 1920; coff = nb - C_Z; }
    else { kind = 0; xf = 2; dst = (bf16_t*)(ws + O_SIG); pitch = 5120; coff = nb - C_MG; }
    if (kind == 4) continue;
#pragma unroll
    for (int mi = 0; mi < 2; ++mi) {
      const int tok = m0 + wr * 64 + mi * 32 + r;
#pragma unroll
      for (int g = 0; g < 4; ++g) {
        const int cq = 8 * g + 4 * h;
        const f32x4 bv = *(const f32x4*)(bias + nb + cq);
        float v[4];
#pragma unroll
        for (int e = 0; e < 4; ++e) v[e] = acc[mi][ni][4 * g + e] + bv[e];
        if (kind == 0) {
          if (xf == 1) {
#pragma unroll
            for (int e = 0; e < 4; ++e) v[e] = fsilu(v[e]);
          } else if (xf == 2) {
#pragma unroll
            for (int e = 0; e < 4; ++e) v[e] = fsigmoid(v[e]);
          }
          *(u32x2*)(dst + (size_t)tok * pitch + coff + cq) = pk4(v[0], v[1], v[2], v[3]);
        } else if (kind == 5) {
          const int key = kgrp == 0 ? tok : kgrp == 1 ? (tok & 3) * 2048 + (tok >> 2) : (tok & 15) * 512 + (tok >> 4);
          *(u32x2*)(dst + kfrag_col(coff + cq) + kfrag_key(key)) = pk4(v[0], v[1], v[2], v[3]);
        } else if (kind == 1) {
          const int ko = vfrag_key(tok);
#pragma unroll
          for (int e = 0; e < 4; ++e) dst[vfrag_col(coff + cq + e) + ko] = f2bf(v[e]);
        } else if (kind == 2) {
          const int k1 = vfrag_key(tok), k4 = vfrag_key((tok & 3) * 2048 + (tok >> 2)), k16 = vfrag_key((tok & 15) * 512 + (tok >> 4));
#pragma unroll
          for (int e = 0; e < 4; ++e) {
            const bf16_t b = f2bf(v[e]); const int co = vfrag_col(coff + cq + e);
            dst[co + k1] = b; dst[SZ_VT / 2 + co + k4] = b; dst[SZ_VT + co + k16] = b;
          }
        } else {
          float* sm = (float*)(ws + O_SM);
#pragma unroll
          for (int e = 0; e < 4; ++e) if (cq + e < 18) sm[tok * 32 + cq + e] = v[e];
        }
      }
    }
  }
}


DI int g_lds_byte(int r, int c) { const int st = (r >> 4) * 2 + (c >> 5), ob = (r & 15) * 64 + (c & 31) * 2; return st * 1024 + (ob ^ (((ob >> 9) & 1) << 5)); }
DI void g_stage_rc(int b, int& R, int& C) { const int st = b >> 10, sb = b & 1023, swz = sb ^ (((sb >> 9) & 1) << 5); R = (st >> 1) * 16 + (swz >> 6); C = (st & 1) * 32 + ((swz & 63) >> 1); }

DI float row16_sum(float v);
DI void p1_unit(const Params& p, int layer, int half, int pm, int pn, int pm_next, int pn_next  , bool first, unsigned char* lds) {
  const int tid = rtid(), wid = tid >> 6, lane = tid & 63, wr = wid >> 2, wc = wid & 3, fr = lane & 15, fq = lane >> 4;
  const bf16_t* Ab = (const bf16_t*)(p.ws + O_XB) + ((size_t)half * TH + (size_t)pm * 256) * 1024;
  const bf16_t* Bb = (const bf16_t*)(p.ws + O_WTIN + layer * SZ_WTIN1) + (size_t)pn * 256 * 1024;
  int sOff[4];
#pragma unroll
  for (int i = 0; i < 4; ++i) { int R, C; g_stage_rc(wid * 1024 + i * 8192 + lane * 16, R, C); sOff[i] = R * 1024 + C; }
  auto stage2 = [&](const bf16_t* A_, const bf16_t* B_, int buf, int kt) {
#pragma unroll
    for (int i = 0; i < 4; ++i) {
      __builtin_amdgcn_global_load_lds((const unsigned*)(A_ + sOff[i] + kt * 64), (unsigned*)(lds + buf * 65536 + wid * 1024 + i * 8192), 16, 0, 0);
      __builtin_amdgcn_global_load_lds((const unsigned*)(B_ + sOff[i] + kt * 64), (unsigned*)(lds + buf * 65536 + 32768 + wid * 1024 + i * 8192), 16, 0, 0);
    }
  };
  auto stage = [&](int buf, int kt) { stage2(Ab, Bb, buf, kt); };
  f32x4 acc[8][4];
#pragma unroll
  for (int m = 0; m < 8; ++m)
#pragma unroll
    for (int n = 0; n < 4; ++n) acc[m][n] = (f32x4){0.f, 0.f, 0.f, 0.f};
  const int lane_off = (fr * 64 + fq * 16) ^ ((fr >> 3) << 5);
  if (first) { __syncthreads(); stage(0, 0); }
  asm volatile("s_waitcnt vmcnt(0)" ::: "memory");
  __syncthreads();
#pragma unroll 1
  for (int t = 0; t < 16; ++t) {
    const int cur = t & 1;
    {
      const bool last = (t + 1 == 16);
      if (!last || pn_next >= 0) {
        const long dA = last ? (long)(pm_next - pm) * 256 * 1024 - 0 : (long)(t + 1) * 64;
        const long dB = last ? (long)(pn_next - pn) * 256 * 1024 - 0 : (long)(t + 1) * 64;
#pragma unroll
        for (int i = 0; i < 4; ++i) {
          __builtin_amdgcn_global_load_lds((const unsigned*)(Ab + sOff[i] + dA), (unsigned*)(lds + (cur ^ 1) * 65536 + wid * 1024 + i * 8192), 16, 0, 0);
          __builtin_amdgcn_global_load_lds((const unsigned*)(Bb + sOff[i] + dB), (unsigned*)(lds + (cur ^ 1) * 65536 + 32768 + wid * 1024 + i * 8192), 16, 0, 0);
        }
      }
    }
    const unsigned char* SA = lds + cur * 65536 + wr * 16384 + lane_off;
    const unsigned char* SB = lds + cur * 65536 + 32768 + wc * 8192 + lane_off;
    bf16x8 Bf[2][4], At[2][2];
#pragma unroll
    for (int n = 0; n < 4; ++n) Bf[0][n] = *(const bf16x8*)(SB + n * 2048);
#pragma unroll
    for (int m = 0; m < 2; ++m) At[0][m] = *(const bf16x8*)(SA + m * 2048);
#pragma unroll
    for (int g = 0; g < 8; ++g) {
      const int ks = g >> 2, pr = g & 3;
      if (g == 1) {
#pragma unroll
        for (int n = 0; n < 4; ++n) Bf[1][n] = *(const bf16x8*)(SB + n * 2048 + 1024);
      }
      if (g < 7) {
        const int g1 = g + 1;
#pragma unroll
        for (int m = 0; m < 2; ++m) At[g1 & 1][m] = *(const bf16x8*)(SA + ((g1 & 3) * 2 + m) * 2048 + (g1 >> 2) * 1024);
      }
      asm volatile("" : "+v"(acc[pr * 2][0][0]) :: "memory");
#pragma unroll
      for (int m = 0; m < 2; ++m)
#pragma unroll
        for (int n = 0; n < 4; ++n) acc[pr * 2 + m][n] = MFMA16(Bf[ks][n], At[g & 1][m], acc[pr * 2 + m][n]);
    }
    asm volatile("s_waitcnt vmcnt(0)" ::: "memory");
    __syncthreads();
  }
  const int nb0 = pn * 256 + wc * 64, tok0 = pm * 256 + wr * 128;
  const float* bias = (const float*)(p.ws + O_BIASP) + layer * NP;
  unsigned char* ws = p.ws;
  int kind, xf = 0, kgrp = 0, pitch = 0, coff = 0; bf16_t* dst = nullptr;
  if (nb0 < 384) { kind = 0; dst = (bf16_t*)(ws + O_QKA); pitch = 384; coff = nb0; }
  else if (nb0 < C_AV) { kind = 5; dst = (bf16_t*)(ws + O_KFA); coff = nb0 - 384; }
  else if (nb0 < C_BQK) { kind = 1; dst = (bf16_t*)(ws + O_VTA); coff = nb0 - C_AV; }
  else if (nb0 < 2304) { kind = 0; dst = (bf16_t*)(ws + O_QKB); pitch = 1152; coff = nb0 - C_BQK; }
  else if (nb0 < C_BV) { kind = 5; kgrp = (nb0 - 2304) / 384; dst = (bf16_t*)(ws + O_KFB + kgrp * SZ_VT); coff = (nb0 - 2304) - kgrp * 384; }
  else if (nb0 < C_CQK) { kind = 2; dst = (bf16_t*)(ws + O_VTB); coff = nb0 - C_BV; }
  else if (nb0 < 4224) { kind = 0; dst = (bf16_t*)(ws + O_QKC); pitch = 384; coff = nb0 - C_CQK; }
  else if (nb0 < C_CV) { kind = 5; dst = (bf16_t*)(ws + O_KFC); coff = nb0 - 4224; }
  else if (nb0 < C_D) { kind = 1; dst = (bf16_t*)(ws + O_VTC); coff = nb0 - C_CV; }
  else if (nb0 < C_E) { kind = 0; dst = (bf16_t*)(ws + O_QKVD); pitch = 1152; coff = nb0 - C_D; }
  else if (nb0 < C_SM) { kind = 0; dst = (bf16_t*)(ws + O_QE); pitch = 384; coff = nb0 - C_E; }
  else if (nb0 < C_Z) { kind = (nb0 == C_SM) ? 3 : 4; }
  else if (nb0 < C_MG) { kind = 0; xf = 1; dst = (bf16_t*)(ws + O_SZ); pitch = 1920; coff = nb0 - C_Z; }
  else if (nb0 < 13696) { kind = 0; xf = 2; dst = (bf16_t*)(ws + O_SIG); pitch = 5120; coff = nb0 - C_MG; }
  else { kind = 4; }
  if (kind == 4) return;
  if (kind == 0) {
    bf16_t* stg = (bf16_t*)(lds + 65536 + wid * 9216);
#pragma unroll
    for (int mh = 0; mh < 2; ++mh) {
#pragma unroll
      for (int m = 0; m < 4; ++m)
#pragma unroll
        for (int n = 0; n < 4; ++n) {
          const int c4 = n * 16 + fq * 4;
          const f32x4 bv = *(const f32x4*)(bias + nb0 + c4);
          float v[4];
#pragma unroll
          for (int e = 0; e < 4; ++e) v[e] = acc[mh * 4 + m][n][e] + bv[e];
          if (xf == 1) {
#pragma unroll
            for (int e = 0; e < 4; ++e) v[e] = fsilu(v[e]);
          } else if (xf == 2) {
#pragma unroll
            for (int e = 0; e < 4; ++e) v[e] = fsigmoid(v[e]);
          }
          *(u32x2*)(stg + (m * 16 + fr) * 72 + c4) = pk4(v[0], v[1], v[2], v[3]);
        }
      asm volatile("s_waitcnt lgkmcnt(0)" ::: "memory");
      __builtin_amdgcn_wave_barrier();
#pragma unroll
      for (int it = 0; it < 8; ++it) {
        const int row = it * 8 + (lane >> 3), ch = (lane & 7) * 8;
        const bf16x8 val = *(const bf16x8*)(stg + row * 72 + ch);
        *(bf16x8*)(dst + (size_t)(tok0 + mh * 64 + row) * pitch + coff + ch) = val;
      }
      asm volatile("s_waitcnt lgkmcnt(0)" ::: "memory");
      __builtin_amdgcn_wave_barrier();
    }
    return;
  }
  if (nb0 >= 384 && nb0 < C_AV) {
    float* ksum = (float*)(ws + O_KSUM) + (size_t)(pm * 2 + wr) * 384 + (nb0 - 384);
#pragma unroll
    for (int n = 0; n < 4; ++n) {
      const f32x4 bv = *(const f32x4*)(bias + nb0 + n * 16 + fq * 4);
#pragma unroll
      for (int e = 0; e < 4; ++e) {
        float t = 8.f * bv[e];
#pragma unroll
        for (int m = 0; m < 8; ++m) t += acc[m][n][e];
        t = row16_sum(t);
        if (fr == 0) ksum[n * 16 + fq * 4 + e] = t;
      }
    }
  }
#pragma unroll
  for (int m = 0; m < 8; ++m) {
    const int tok = tok0 + m * 16 + fr;
#pragma unroll
    for (int n = 0; n < 4; ++n) {
      const int c4 = n * 16 + fq * 4;
      const f32x4 bv = *(const f32x4*)(bias + nb0 + c4);
      float v[4];
#pragma unroll
      for (int e = 0; e < 4; ++e) v[e] = acc[m][n][e] + bv[e];
      if (kind == 5) {
        const int key = kgrp == 0 ? tok : kgrp == 1 ? (tok & 3) * 2048 + (tok >> 2) : (tok & 15) * 512 + (tok >> 4);
        *(u32x2*)(dst + kfrag_col(coff + c4) + kfrag_key(key)) = pk4(v[0], v[1], v[2], v[3]);
      } else if (kind == 1) {
        const int ko = vfrag_key(tok);
#pragma unroll
        for (int e = 0; e < 4; ++e) dst[vfrag_col(coff + c4 + e) + ko] = f2bf(v[e]);
      } else if (kind == 2) {
        const int k1 = vfrag_key(tok), k4 = vfrag_key((tok & 3) * 2048 + (tok >> 2)), k16 = vfrag_key((tok & 15) * 512 + (tok >> 4));
#pragma unroll
        for (int e = 0; e < 4; ++e) {
          const bf16_t b = f2bf(v[e]); const int co = vfrag_col(coff + c4 + e);
          dst[co + k1] = b; dst[SZ_VT / 2 + co + k4] = b; dst[SZ_VT + co + k16] = b;
        }
      } else {
        float* sm = (float*)(ws + O_SM);
#pragma unroll
        for (int e = 0; e < 4; ++e) if (c4 + e < 18) sm[tok * 32 + c4 + e] = v[e];
      }
    }
  }
}

DI void fox_prep(const Params& p, int hh, unsigned char* smem) {
  float* red = (float*)smem;
  const int tid = otid(), lane = tid & 63, wave = tid >> 6;
  const float* sm = (const float*)(p.ws + O_SM);
  float* FF = (float*)(p.ws + O_FF) + hh * TH;
  float loc[32];
#pragma unroll
  for (int j = 0; j < 32; ++j) loc[j] = sm[(tid * 32 + j) * 32 + hh];
  float s = 0.f;
#pragma unroll
  for (int j = 0; j < 32; ++j) { const float xv = loc[j]; s += fminf(xv, 0.f) - log1pf(expf(-fabsf(xv))); loc[j] = s; }
  float inc = s;
#pragma unroll
  for (int o = 1; o < 64; o <<= 1) { const float t = __shfl_up(inc, o); if (lane >= o) inc += t; }
  if (lane == 63) red[wave] = inc;
  sub_sync();
  float off = inc - s;
  for (int w = 0; w < wave; ++w) off += red[w];
#pragma unroll
  for (int j4 = 0; j4 < 8; ++j4) {
    f32x4 o4 = {off + loc[4 * j4], off + loc[4 * j4 + 1], off + loc[4 * j4 + 2], off + loc[4 * j4 + 3]};
    *(f32x4*)(FF + tid * 32 + 4 * j4) = o4;
  }
  sub_sync();
}

DI void kmean_prep(const Params& p, int idx, unsigned* kmaxu) {
  const int lane = otid() & 63;
  const int hh = idx / 32, blk = idx % 32;
  const bf16_t* kc = (const bf16_t*)(p.ws + O_KFC) + (size_t)hh * 524288;
  float mx = 0.f;
#pragma unroll
  for (int t = 0; t < 4; ++t) {
    const int key = blk * 256 + lane * 4 + t;
    float kk = 0.f;
#pragma unroll
    for (int c = 0; c < 8; ++c) { float v[8]; unpk8(*(const bf16x8*)(kc + kfrag_key(key) + c * 256), v);
#pragma unroll
      for (int e = 0; e < 8; ++e) kk += v[e] * v[e]; }
    mx = fmaxf(mx, kk);
  }
#pragma unroll
  for (int o = 32; o >= 1; o >>= 1) mx = fmaxf(mx, __shfl_xor(mx, o));
  if (lane == 0) atomicMax(kmaxu + hh, __float_as_uint(mx));
}

DI void memkv_tile(const Params& p, int layer, int half, int mt, int nt, unsigned char* smem) {
  bf16_t* As = (bf16_t*)smem; bf16_t* Bs = As + 2 * 9216;
  f32x16 acc[2][2]; zero_acc(acc);
  PlainA al{(const bf16_t*)(p.ws + O_MEMN) + (size_t)half * 256 * 1024, 1024};
  const int m0 = mt * 128, n0 = nt * 128;
  gemm_kloop(al, (const bf16_t*)(p.ws + O_WTKV + layer * SZ_WTKV1), 1024, 16, m0, n0, acc, As, Bs);
  const int tid = otid(), lane = tid & 63, wave = tid >> 6, wr = wave >> 1, wc = wave & 1, r = lane & 31, h = lane >> 5;
  bf16_t* mk = (bf16_t*)(p.ws + O_MEMK); bf16_t* mv = (bf16_t*)(p.ws + O_MEMVT);
#pragma unroll
  for (int ni = 0; ni < 2; ++ni)
#pragma unroll
    for (int mi = 0; mi < 2; ++mi) {
      const int m = m0 + wr * 64 + mi * 32 + r;
#pragma unroll
      for (int i = 0; i < 16; ++i) {
        const int col = n0 + wc * 64 + ni * 32 + crow(i, h);
        const bf16_t b = f2bf(acc[mi][ni][i]);
        if (col < 384) { const int hd = col / 96, d = col % 96; mk[(size_t)((half * 4 + hd) * 8 + (m >> 5)) * 3072 + (d >> 4) * 512 + ((d >> 3) & 1) * 256 + (m & 31) * 8 + (d & 7)] = b; }
        else { const int cc = col - 384, hd = cc / 96, d = cc % 96, kk = m & 31;
          mv[(size_t)((half * 4 + hd) * 8 + (m >> 5)) * 3072 + (d >> 5) * 1024 + (kk >> 4) * 512 + ((kk >> 2) & 1) * 256 + (d & 31) * 8 + ((kk >> 3) & 1) * 4 + (kk & 3)] = b; }
      }
    }
}

DI f32x16 mm_quad(const bf16_t* A, const bf16_t* B, int wr, int wc, int r, int h) {
  f32x16 acc;
#pragma unroll
  for (int i = 0; i < 16; ++i) acc[i] = 0.f;
  const bf16_t* a_ = A + (wr * 32 + r) * 72 + 8 * h;
  const bf16_t* b_ = B + (wc * 32 + r) * 72 + 8 * h;
#pragma unroll
  for (int s = 0; s < 4; ++s) acc = MFMA32(*(const bf16x8*)(a_ + 16 * s), *(const bf16x8*)(b_ + 16 * s), acc);
  return acc;
}

DI void gdn_prep(const Params& p, int layer, int half, int hh, int c, unsigned char* smem) {
  bf16_t* QN = (bf16_t*)smem; bf16_t* KN = QN + 4608; bf16_t* KB = KN + 4608; bf16_t* KDT = KB + 4608; bf16_t* VBT = KDT + 4608;
  bf16_t* KBET = VBT + 4608; bf16_t* QKm = KBET + 4608; bf16_t* Tm = QKm + 4608;
  float* gcv = (float*)(smem + 73728); float* betav = gcv + 64; float* egc = gcv + 128;
  float* Mf = (float*)(smem + 9216);
  bf16_t* UT = KN; bf16_t* WT = KB;
  int tid = otid();
  int lane = tid & 63, wave = tid >> 6, wr = wave >> 1, wc = wave & 1, r = lane & 31, h = lane >> 5;
#define REOPAQUE() do { asm volatile("" : "+v"(tid)); lane = tid & 63; wave = tid >> 6; wr = wave >> 1; wc = wave & 1; r = lane & 31; h = lane >> 5; } while (0)
  const float* sm = (const float*)(p.ws + O_SM);
  if (wave == 0) {
    const int tok = c * 64 + lane;
    const float bt = fsigmoid(sm[tok * 32 + 6 + hh]);
    const float xv = sm[tok * 32 + 12 + hh] + p.dt_bias[layer * 6 + hh];
    const float sp = fmaxf(xv, 0.f) + log1pf(expf(-fabsf(xv)));
    float g = -expf(p.a_log[layer * 6 + hh]) * sp;
#pragma unroll
    for (int o = 1; o < 64; o <<= 1) { const float t = __shfl_up(g, o); if (lane >= o) g += t; }
    gcv[lane] = g; betav[lane] = bt; egc[lane] = expf(g);
    if (lane == 63) ((float*)(p.ws + O_GL))[hh * 128 + c] = expf(g);
  }
  sub_sync();
  REOPAQUE();
  {
    const int t = tid >> 2, cg4 = tid & 3, ch0 = cg4 * 16;
    const bf16_t* src = (const bf16_t*)(p.ws + O_QKVD);
    const float* cw = p.conv_w + (size_t)layer * 4 * 1152;
    const float bt = betav[t], gct = gcv[t], eg = egc[t], ed = expf(gcv[63] - gct);
    auto convpart = [&](int pt, float (&val)[16]) {
      const int col = pt * 384 + hh * 64 + ch0;
#pragma unroll
      for (int e = 0; e < 16; ++e) val[e] = 0.f;
#pragma unroll
      for (int j = 0; j < 4; ++j) {
        const int row = c * 64 + t - 3 + j;
        if (row >= 0) {
          float xv[16];
          unpk8(*(const bf16x8*)(src + (size_t)row * 1152 + col), xv);
          unpk8(*(const bf16x8*)(src + (size_t)row * 1152 + col + 8), xv + 8);
#pragma unroll
          for (int e4 = 0; e4 < 4; ++e4) {
            const f32x4 w4 = *(const f32x4*)(cw + j * 1152 + col + 4 * e4);
#pragma unroll
            for (int e = 0; e < 4; ++e) val[4 * e4 + e] += w4[e] * xv[4 * e4 + e];
          }
        }
      }
#pragma unroll
      for (int e = 0; e < 16; ++e) val[e] = fsilu(val[e]);
    };
    {
      float val[16]; convpart(0, val);
      float sq = 0.f;
#pragma unroll
      for (int e = 0; e < 16; ++e) sq += val[e] * val[e];
      sq += __shfl_xor(sq, 1); sq += __shfl_xor(sq, 2);
      const float rq = rsqrtf(sq + 1e-6f) * 0.125f;
#pragma unroll
      for (int e = 0; e < 16; ++e) val[e] *= rq;
      *(bf16x8*)(QN + t * 72 + ch0) = pk8(val); *(bf16x8*)(QN + t * 72 + ch0 + 8) = pk8(val + 8);
    }
    asm volatile("" ::: "memory");
    {
      float val[16]; convpart(1, val);
      float sk = 0.f;
#pragma unroll
      for (int e = 0; e < 16; ++e) sk += val[e] * val[e];
      sk += __shfl_xor(sk, 1); sk += __shfl_xor(sk, 2);
      const float rk = rsqrtf(sk + 1e-6f);
      float kb[16];
#pragma unroll
      for (int e = 0; e < 16; ++e) { val[e] *= rk; kb[e] = val[e] * bt; }
      *(bf16x8*)(KN + t * 72 + ch0) = pk8(val); *(bf16x8*)(KN + t * 72 + ch0 + 8) = pk8(val + 8);
      *(bf16x8*)(KB + t * 72 + ch0) = pk8(kb); *(bf16x8*)(KB + t * 72 + ch0 + 8) = pk8(kb + 8);
#pragma unroll
      for (int e = 0; e < 16; ++e) {
        KDT[(ch0 + e) * 72 + t] = f2bf(val[e] * ed);
        KBET[(ch0 + e) * 72 + t] = f2bf(kb[e] * eg);
      }
    }
    asm volatile("" ::: "memory");
    {
      float val[16]; convpart(2, val);
#pragma unroll
      for (int e = 0; e < 16; ++e) VBT[(ch0 + e) * 72 + t] = f2bf(val[e] * bt);
    }
  }
  sub_sync();
  REOPAQUE();
  {
    const f32x16 kk = mm_quad(KB, KN, wr, wc, r, h);
    const f32x16 qk = mm_quad(QN, KN, wr, wc, r, h);
    sub_sync();
    const int j = wc * 32 + r; const float gj = gcv[j];
#pragma unroll
    for (int i = 0; i < 16; ++i) {
      const int row = wr * 32 + crow(i, h);
      const float dec = (row >= j) ? expf(gcv[row] - gj) : 0.f;
      Mf[row * 68 + j] = (row > j) ? kk[i] * dec : 0.f;
      QKm[row * 72 + j] = f2bf(qk[i] * dec);
    }
  }
  sub_sync();
  REOPAQUE();
  if (wave == 0) {
    float t[64];
#pragma unroll
    for (int i = 0; i < 64; ++i) {
      float a4[4] = {(i == lane) ? 1.f : 0.f, 0.f, 0.f, 0.f};
#pragma unroll
      for (int j4 = 0; j4 < (i + 3) / 4; ++j4) {
        const f32x4 mrow = *(const f32x4*)(Mf + i * 68 + 4 * j4);
#pragma unroll
        for (int e = 0; e < 4; ++e) if (4 * j4 + e < i) a4[e] -= mrow[e] * t[4 * j4 + e];
      }
      const float a = (a4[0] + a4[1]) + (a4[2] + a4[3]);
      t[i] = a;
      Tm[i * 72 + lane] = f2bf(a);
      asm volatile("" ::: "memory");
    }
  }
  sub_sync();
  REOPAQUE();
  {
    const f32x16 u = mm_quad(Tm, VBT, wr, wc, r, h);
    const f32x16 w = mm_quad(Tm, KBET, wr, wc, r, h);
    const int col = wc * 32 + r;
#pragma unroll
    for (int g = 0; g < 4; ++g) {
      const int i0 = wr * 32 + 8 * g + 4 * h;
      *(u32x2*)(UT + col * 72 + i0) = pk4(u[4 * g], u[4 * g + 1], u[4 * g + 2], u[4 * g + 3]);
      *(u32x2*)(WT + col * 72 + i0) = pk4(w[4 * g], w[4 * g + 1], w[4 * g + 2], w[4 * g + 3]);
    }
  }
  sub_sync();
  REOPAQUE();
  {
    bf16_t* base = (bf16_t*)(p.ws + O_DPREP + (size_t)(hh * 128 + c) * 32768);
    const int n = wc * 32 + r;
    {
      const int ks = n >> 5, jh = (n >> 4) & 1, q = (n >> 2) & 3, jl = n & 3, jj = 4 * jh + jl;
      const int cbase = (ks * 64 + 16 * q) * 8 + jj;
      {
        const f32x16 P = mm_quad(KDT, WT, wr, wc, r, h);
#pragma unroll
        for (int i = 0; i < 16; ++i) {
          const int m = wr * 32 + crow(i, h);
          base[((m >> 4) * 128 + (m & 15)) * 8 + cbase] = f2bf(P[i]);
        }
      }
      asm volatile("" ::: "memory");
      {
        const f32x16 QW = mm_quad(QKm, WT, wr, wc, r, h);
#pragma unroll
        for (int i = 0; i < 16; ++i) {
          const int m = wr * 32 + crow(i, h);
          const float qd = bf2f(QN[m * 72 + n]) * egc[m];
          base[4096 + ((m >> 4) * 128 + (m & 15)) * 8 + cbase] = f2bf(qd - QW[i]);
        }
      }
      asm volatile("" ::: "memory");
    }
    const int jsl = n >> 4;
    {
      const f32x16 Bc = mm_quad(KDT, UT, wr, wc, r, h);
#pragma unroll
      for (int g = 0; g < 4; ++g) {
        const int row0 = wr * 32 + 8 * g + 4 * h;
        const int rt = row0 >> 4, lp = 16 * ((row0 >> 2) & 3) + (n & 15);
        *(u32x2*)(base + 8192 + ((jsl * 4 + rt) * 64 + lp) * 4) = pk4(Bc[4 * g], Bc[4 * g + 1], Bc[4 * g + 2], Bc[4 * g + 3]);
      }
    }
    asm volatile("" ::: "memory");
    {
      const f32x16 O0 = mm_quad(QKm, UT, wr, wc, r, h);
#pragma unroll
      for (int g = 0; g < 4; ++g) {
        const int row0 = wr * 32 + 8 * g + 4 * h;
        const int rt = row0 >> 4, lp = 16 * ((row0 >> 2) & 3) + (n & 15);
        *(u32x2*)(base + 12288 + ((jsl * 4 + rt) * 64 + lp) * 4) = pk4(O0[4 * g], O0[4 * g + 1], O0[4 * g + 2], O0[4 * g + 3]);
      }
    }
  }
  sub_sync();
#undef REOPAQUE
}

struct TileDesc { const bf16_t* k; const bf16_t* v; const float* aux; int tag; };

template <int DHT, bool AUX>
struct TileRegs { bf16x8 k[DHT / 16]; bf16x8 v[DHT / 32][2]; f32x4 a[4]; };

template <int DHT, bool AUX>
DI void load_tile(const bf16_t* kp, const bf16_t* vp, const float* ap, long ldv, TileRegs<DHT, AUX>& t) {
#pragma unroll
  for (int s = 0; s < DHT / 16; ++s) t.k[s] = *(const bf16x8*)(kp + 512 * s);
#pragma unroll
  for (int dt = 0; dt < DHT / 32; ++dt)
#pragma unroll
    for (int s = 0; s < 2; ++s) t.v[dt][s] = *(const bf16x8*)(vp + (dt * 2 + s) * 512);
  if (AUX) {
#pragma unroll
    for (int g = 0; g < 4; ++g) t.a[g] = *(const f32x4*)(ap + 8 * g);
  }
}

template <int DHT, bool AUX, class TF, class MF, class SF>
DI void attn_loop(int maxtiles, TF&& tf, MF&& mf, SF&& stopf, const bf16x8 (&qf)[DHT / 16], long ldv, float scale2,
                  f32x16 (&o)[DHT / 32], float& m, float& l) {
  TileRegs<DHT, AUX> cur, nxt;
  int tagc, tagn;
  bf16x8 qf0 = qf[0];
  { const bf16_t* kp; const bf16_t* vp; const float* ap = nullptr; tagc = tf(0, kp, vp, ap); load_tile<DHT, AUX>(kp, vp, ap, ldv, cur); }
#pragma unroll 1
  for (int t = 0; t < maxtiles; ++t) {
    { const bf16_t* kp; const bf16_t* vp; const float* ap = nullptr; tagn = tf(t + 1, kp, vp, ap); load_tile<DHT, AUX>(kp, vp, ap, ldv, nxt); }
    { bf16x8 q0 = qf[0]; asm volatile("" : "+v"(q0) :: "memory"); qf0 = q0; }
    f32x16 sacc;
#pragma unroll
    for (int i = 0; i < 16; ++i) sacc[i] = 0.f;
#pragma unroll
    for (int s = 0; s < DHT / 16; ++s) sacc = MFMA32(cur.k[s], s == 0 ? qf0 : qf[s], sacc);
    float sv[16]; float mx = NEG_INF;
#pragma unroll
    for (int i = 0; i < 16; ++i) { sv[i] = sacc[i] * scale2 + mf(tagc, i, AUX ? cur.a[i >> 2][i & 3] : 0.f); mx = fmaxf(mx, sv[i]); }
    mx = fmaxf(mx, __shfl_xor(mx, 32));
    const float mnew = fmaxf(m, mx);
    const float alpha = __builtin_amdgcn_exp2f(m - mnew);
    m = mnew;
    float pv[16]; float ps = 0.f;
#pragma unroll
    for (int i = 0; i < 16; ++i) { pv[i] = __builtin_amdgcn_exp2f(sv[i] - mnew); ps += pv[i]; }
    l = l * alpha + ps;
#pragma unroll
    for (int dt = 0; dt < DHT / 32; ++dt)
#pragma unroll
      for (int i = 0; i < 16; ++i) o[dt][i] *= alpha;
    bf16x8 pf[2]; pf[0] = pk8(pv); pf[1] = pk8(pv + 8);
#pragma unroll
    for (int dt = 0; dt < DHT / 32; ++dt)
#pragma unroll
      for (int s = 0; s < 2; ++s) {
        o[dt] = MFMA32(cur.v[dt][s], pf[s], o[dt]);
      }
    if (stopf(t, m, AUX ? cur.a[0][0] : 0.f)) break;
    cur = nxt; tagc = tagn;
  }
}

template <int DHT>
DI void attn_store(const f32x16 (&o)[DHT / 32], float l, bf16_t* dstrow, int h, float& ltot_out, bool valid = true) {
  const float ltot = l + __shfl_xor(l, 32);
  ltot_out = ltot;
  const float inv = ltot > 0.f ? 1.f / ltot : 0.f;
  if (valid)
#pragma unroll
  for (int dt = 0; dt < DHT / 32; ++dt)
#pragma unroll
    for (int g = 0; g < 4; ++g)
      *(u32x2*)(dstrow + dt * 32 + 8 * g + 4 * h) = pk4(o[dt][4 * g] * inv, o[dt][4 * g + 1] * inv, o[dt][4 * g + 2] * inv, o[dt][4 * g + 3] * inv);
}

template <int DHT>
DI void attn_store_gated(const f32x16 (&o)[DHT / 32], float l, bf16_t* szrow, int h) {
  const float ltot = l + __shfl_xor(l, 32);
  const float inv = ltot > 0.f ? 1.f / ltot : 0.f;
#pragma unroll
  for (int dt = 0; dt < DHT / 32; ++dt)
#pragma unroll
    for (int g = 0; g < 4; ++g) {
      bf16_t* q = szrow + dt * 32 + 8 * g + 4 * h;
      const u32x2 z = *(const u32x2*)q;
      *(u32x2*)q = pk4(o[dt][4 * g] * inv * bflo(z.x), o[dt][4 * g + 1] * inv * bfhi(z.x), o[dt][4 * g + 2] * inv * bflo(z.y), o[dt][4 * g + 3] * inv * bfhi(z.y));
    }
}

template <int N>
DI void zero_o(f32x16 (&o)[N]) {
#pragma unroll
  for (int a = 0; a < N; ++a)
#pragma unroll
    for (int i = 0; i < 16; ++i) o[a][i] = 0.f;
}

DI void top3_insert(float v, int n, float& v0, float& v1, float& v2, int& i0, int& i1, int& i2) {
  const bool g0 = v > v0, g1 = v > v1, g2 = v > v2;
  v2 = g1 ? v1 : (g2 ? v : v2); i2 = g1 ? i1 : (g2 ? n : i2);
  v1 = g0 ? v0 : (g1 ? v : v1); i1 = g0 ? i0 : (g1 ? n : i1);
  v0 = g0 ? v : v0;             i0 = g0 ? n : i0;
}

DI void moba_select(const Params& p, int a) {
  const int lane = otid() & 63, r = lane & 31, h = lane >> 5;
  const int qtile = a / 6, hh = a % 6, qb = qtile >> 3;
  unsigned mask = 0;
  if (qb > 0) {
    const bf16_t* qrow = (const bf16_t*)(p.ws + O_QKA) + (size_t)(qtile * 32 + r) * 384 + hh * 64 + 8 * h;
    bf16x8 qf[4];
#pragma unroll
    for (int s = 0; s < 4; ++s) qf[s] = *(const bf16x8*)(qrow + 16 * s);
    const float* ks0 = (const float*)(p.ws + O_KSUM) + (size_t)(r * 2) * 384 + hh * 64 + 8 * h;
    f32x16 g;
#pragma unroll
    for (int i = 0; i < 16; ++i) g[i] = 0.f;
#pragma unroll
    for (int s = 0; s < 4; ++s) {
      const f32x4 a0 = *(const f32x4*)(ks0 + 16 * s), a1 = *(const f32x4*)(ks0 + 16 * s + 4);
      const f32x4 b0 = *(const f32x4*)(ks0 + 384 + 16 * s), b1 = *(const f32x4*)(ks0 + 384 + 16 * s + 4);
      float hi[8], lo[8];
#pragma unroll
      for (int e = 0; e < 4; ++e) {
        const float m0 = (a0[e] + b0[e]) * (1.f / 256.f), m1 = (a1[e] + b1[e]) * (1.f / 256.f);
        hi[e] = bf2f(f2bf(m0)); lo[e] = m0 - hi[e];
        hi[4 + e] = bf2f(f2bf(m1)); lo[4 + e] = m1 - hi[4 + e];
      }
      g = MFMA32(pk8(hi), qf[s], g); g = MFMA32(pk8(lo), qf[s], g);
    }
    float v0 = NEG_INF, v1 = NEG_INF, v2 = NEG_INF; int i0 = -1, i1 = -1, i2 = -1;
#pragma unroll
    for (int i = 0; i < 16; ++i) { const int n = crow(i, h); if (n < qb) top3_insert(g[i], n, v0, v1, v2, i0, i1, i2); }
    const float pv0 = __shfl_xor(v0, 32), pv1 = __shfl_xor(v1, 32), pv2 = __shfl_xor(v2, 32);
    const int pi0 = __shfl_xor(i0, 32), pi1 = __shfl_xor(i1, 32), pi2 = __shfl_xor(i2, 32);
    if (pi0 >= 0) top3_insert(pv0, pi0, v0, v1, v2, i0, i1, i2);
    if (pi1 >= 0) top3_insert(pv1, pi1, v0, v1, v2, i0, i1, i2);
    if (pi2 >= 0) top3_insert(pv2, pi2, v0, v1, v2, i0, i1, i2);
    if (i0 >= 0) mask |= 1u << i0;
    if (i1 >= 0) mask |= 1u << i1;
    if (i2 >= 0) mask |= 1u << i2;
  }
  if (h == 0) ((unsigned*)(p.ws + O_MASK))[(qtile * 32 + r) * 8 + hh] = mask;
}

DI void moba_gather(const Params& p, int a, unsigned char* smem) {
  const int tid = otid(), lane = tid & 63, wave = tid >> 6, r = lane & 31, h = lane >> 5;
  const int part = a & 1, a2 = a >> 1;
  const int hh = a2 % 6, idx = a2 / 6;
  int qb = 1;
  while ((qb + 1) * qb / 2 <= idx) ++qb;
  const int n = idx - qb * (qb - 1) / 2;
  const unsigned* MASK = (const unsigned*)(p.ws + O_MASK);
  unsigned* list = (unsigned*)(smem + wave * 1024);
  int cnt = 0;
#pragma unroll
  for (int j = 0; j < 4; ++j) {
    const int qi = j * 64 + lane;
    const unsigned mk = MASK[(qb * 256 + qi) * 8 + hh];
    const bool pred = (mk >> n) & 1u;
    const unsigned long long ball = __ballot(pred);
    const int pos = cnt + __builtin_popcountll(ball & ((1ull << lane) - 1ull));
    if (pred) list[pos] = (unsigned)qi | ((unsigned)__builtin_popcount(mk & ((1u << n) - 1u)) << 8);
    cnt += __builtin_popcountll(ball);
  }
  cnt = __builtin_amdgcn_readfirstlane(cnt);
  if (cnt == 0) return;
  asm volatile("s_waitcnt lgkmcnt(0)" ::: "memory");
  __builtin_amdgcn_wave_barrier();
  const bf16_t* QK = (const bf16_t*)(p.ws + O_QKA);
  const bf16_t* KF = (const bf16_t*)(p.ws + O_KFA) + (size_t)hh * 524288 + (size_t)n * 8 * 2048 + lane * 8;
  const bf16_t* VT = (const bf16_t*)(p.ws + O_VTA) + (size_t)hh * 524288 + (size_t)n * 8 * 2048 + lane * 8;
  const int nch = (cnt + 31) >> 5;
#pragma unroll 1
  for (int c = part; c < nch; c += 2) {
    const int e = c * 32 + r;
    const bool valid = e < cnt;
    const unsigned ent = list[valid ? e : 0];
    const int tok = qb * 256 + (int)(ent & 255u), slot = (int)(ent >> 8);
    bf16x8 qf[4];
    { const bf16_t* qrow = QK + (size_t)tok * 384 + hh * 64 + 8 * h;
#pragma unroll
      for (int s = 0; s < 4; ++s) qf[s] = *(const bf16x8*)(qrow + 16 * s); }
    auto tf = [&](int t, const bf16_t*& kp, const bf16_t*& vp, const float*&) -> int {
      const int tt = t < 7 ? t : 7;
      kp = KF + tt * 2048; vp = VT + tt * 2048;
      return 0;
    };
    auto mf = [&](int, int, float) -> float { return 0.f; };
    auto sf = [&](int, float, float) { return false; };
    f32x16 o[2]; zero_o(o); float m = -1e30f, l = 0.f;
    int nt8 = 8; asm volatile("" : "+s"(nt8));
    attn_loop<64, false>(nt8, tf, mf, sf, qf, (long)TH, 0.125f * LOG2E, o, m, l);
    float lt;
    attn_store<64>(o, l, (bf16_t*)(p.ws + O_OA + slot * SZ_O) + (size_t)tok * 384 + hh * 64, h, lt, valid);
    if (valid && h == 0) { float* st = (float*)(p.ws + O_STA) + ((size_t)(slot * TH + tok) * 6 + hh) * 2; st[0] = m; st[1] = lt; }
  }
}

DI void moba_own(const Params& p, int a) {
  const int lane = otid() & 63, r = lane & 31, h = lane >> 5;
  const int qtile = 255 - a / 6, hh = a % 6, qb = qtile >> 3, own = qtile & 7;
  const bf16_t* QK = (const bf16_t*)(p.ws + O_QKA);
  const bf16_t* KF = (const bf16_t*)(p.ws + O_KFA) + (size_t)hh * 524288 + (size_t)qb * 8 * 2048 + lane * 8;
  const bf16_t* VT = (const bf16_t*)(p.ws + O_VTA) + (size_t)hh * 524288 + (size_t)qb * 8 * 2048 + lane * 8;
  const int tok = qtile * 32 + r;
  bf16x8 qf[4];
  { const bf16_t* qrow = QK + (size_t)tok * 384 + hh * 64 + 8 * h;
#pragma unroll
    for (int s = 0; s < 4; ++s) qf[s] = *(const bf16x8*)(qrow + 16 * s); }
  auto tf = [&](int t, const bf16_t*& kp, const bf16_t*& vp, const float*&) -> int {
    const int kk = t < own ? t : own;
    kp = KF + kk * 2048; vp = VT + kk * 2048;
    return (kk == own) ? 101 : 100;
  };
  auto mf = [&](int tag, int i, float) -> float {
    if (tag == 100) return 0.f;
    return (crow(i, h) <= r) ? 0.f : NEG_INF;
  };
  auto sf = [&](int, float, float) { return false; };
  f32x16 o[2]; zero_o(o); float m = -1e30f, l = 0.f;
  attn_loop<64, false>(own + 1, tf, mf, sf, qf, (long)TH, 0.125f * LOG2E, o, m, l);
  float lt;
  attn_store<64>(o, l, (bf16_t*)(p.ws + O_OA + 3 * SZ_O) + (size_t)tok * 384 + hh * 64, h, lt);
  if (h == 0) {
    float* st = (float*)(p.ws + O_STA);
    st[((size_t)(3 * TH + tok) * 6 + hh) * 2] = m; st[((size_t)(3 * TH + tok) * 6 + hh) * 2 + 1] = lt;
    const int np = __builtin_popcount(((const unsigned*)(p.ws + O_MASK))[tok * 8 + hh]);
    for (int sl = np; sl < 3; ++sl) { st[((size_t)(sl * TH + tok) * 6 + hh) * 2] = -1e30f; st[((size_t)(sl * TH + tok) * 6 + hh) * 2 + 1] = 0.f; }
  }
}

DI void fox_item(const Params& p, int c, const unsigned* kmaxu) {
  const int lane = otid() & 63, r = lane & 31, h = lane >> 5;
  const int qtile = 255 - c / 6, hh = c % 6;
  const bf16_t* QK = (const bf16_t*)(p.ws + O_QKC);
  const bf16_t* KF = (const bf16_t*)(p.ws + O_KFC);
  const bf16_t* VT = (const bf16_t*)(p.ws + O_VTC);
  const float* FF = (const float*)(p.ws + O_FF) + hh * TH;
  bf16x8 qf[4]; float qn2 = 0.f;
  { const bf16_t* qrow = QK + (size_t)(qtile * 32 + r) * 384 + hh * 64 + 8 * h;
#pragma unroll
    for (int s = 0; s < 4; ++s) { qf[s] = *(const bf16x8*)(qrow + 16 * s); float v[8]; unpk8(qf[s], v);
#pragma unroll
      for (int e = 0; e < 8; ++e) qn2 += v[e] * v[e]; } }
  qn2 += __shfl_xor(qn2, 32);
#pragma unroll
  for (int o = 16; o >= 1; o >>= 1) qn2 = fmaxf(qn2, __shfl_xor(qn2, o));
  const float Fq = FF[qtile * 32 + r];
  const float Ffirst = FF[qtile * 32];
  const float kmaxn = sqrtf(__uint_as_float(kmaxu[hh]));
  const float bound = sqrtf(qn2) * kmaxn * 0.125f + Ffirst;
  auto tf = [&](int t, const bf16_t*& kp, const bf16_t*& vp, const float*& ap) -> int {
    const int keybase = (qtile - t > 0 ? qtile - t : 0) * 32;
    kp = KF + (size_t)hh * 524288 + (keybase >> 5) * 2048 + lane * 8;
    vp = VT + (size_t)hh * 524288 + (keybase >> 5) * 2048 + lane * 8;
    ap = FF + keybase + 4 * h;
    return (t == 0) ? 1 : 0;
  };
  auto mf = [&](int tag, int i, float fk) -> float {
    const float b = (Fq - fk) * LOG2E;
    return (tag == 1 && crow(i, h) > r) ? NEG_INF : b;
  };
  auto sf = [&](int, float m, float a0) {
    const float fkb = __builtin_bit_cast(float, __builtin_amdgcn_readfirstlane(__builtin_bit_cast(int, a0)));
    float mm = m;
#pragma unroll
    for (int o = 16; o >= 1; o >>= 1) mm = fminf(mm, __shfl_xor(mm, o));
    return (bound - fkb) * LOG2E < mm - 45.f;
  };
  f32x16 o[2]; zero_o(o); float m = -1e30f, l = 0.f;
  attn_loop<64, true>(qtile + 1, tf, mf, sf, qf, (long)TH, 0.125f * LOG2E, o, m, l);
  float lt;
  attn_store_gated<64>(o, l, (bf16_t*)(p.ws + O_SZ) + (size_t)(qtile * 32 + r) * 1920 + 2 * 384 + hh * 64, h);
}

DI void dil_item(const Params& p, int idx) {
  const int lane = otid() & 63, r = lane & 31, h = lane >> 5;
  const int g = idx / 1536, rem = idx % 1536, hh = rem / 256, w = rem % 256;
  const int dsh = 2 * g;
  const int dil = 1 << dsh, L = TH >> dsh, tps = L / 32;
  const int rs = w / tps, lt_ = w % tps, l0 = lt_ * 32;
  const bf16_t* QK = (const bf16_t*)(p.ws + O_QKB);
  const bf16_t* KF = (const bf16_t*)(p.ws + O_KFB + g * SZ_VT);
  const bf16_t* VT = (const bf16_t*)(p.ws + O_VTB + g * SZ_VT);
  const int tq = (l0 + r) * dil + rs;
  bf16x8 qf[4];
  { const bf16_t* qrow = QK + (size_t)tq * 1152 + g * 384 + hh * 64 + 8 * h;
#pragma unroll
    for (int s = 0; s < 4; ++s) qf[s] = *(const bf16x8*)(qrow + 16 * s); }
  const int t0 = (l0 >= 128) ? 0 : (128 - l0) / 32;
  auto tf = [&](int tt, const bf16_t*& kp, const bf16_t*& vp, const float*&) -> int {
    const int t = (t0 + tt < 4) ? t0 + tt : 4; const int keybase = l0 - 128 + 32 * t;
    kp = KF + (size_t)hh * 524288 + ((rs * L + keybase) >> 5) * 2048 + lane * 8;
    vp = VT + (size_t)hh * 524288 + ((rs * L + keybase) >> 5) * 2048 + lane * 8;
    return t;
  };
  auto mf = [&](int tag, int i, float) -> float {
    const int kj = crow(i, h);
    if (tag == 0) return (kj >= r) ? 0.f : NEG_INF;
    if (tag == 4) return (kj <= r) ? 0.f : NEG_INF;
    return 0.f;
  };
  auto sf = [&](int, float, float) { return false; };
  f32x16 o[2]; zero_o(o); float m = -1e30f, l = 0.f;
  attn_loop<64, false>(5 - t0, tf, mf, sf, qf, (long)TH, 0.125f * LOG2E, o, m, l);
  float lt;
  attn_store<64>(o, l, (bf16_t*)(p.ws + O_OB + g * SZ_O) + (size_t)tq * 384 + hh * 64, h, lt);
  if (h == 0) { float* st = (float*)(p.ws + O_STB) + ((size_t)(g * TH + tq) * 6 + hh) * 2; st[0] = m; st[1] = lt; }
}

DI void mem_item(const Params& p, int half, int e) {
  const int lane = otid() & 63, r = lane & 31, h = lane >> 5;
  const int hd = e & 3, qtile = e >> 2;
  const bf16_t* QE = (const bf16_t*)(p.ws + O_QE);
  const bf16_t* MK = (const bf16_t*)(p.ws + O_MEMK);
  const bf16_t* MV = (const bf16_t*)(p.ws + O_MEMVT);
  bf16x8 qf[6];
  { const bf16_t* qrow = QE + (size_t)(qtile * 32 + r) * 384 + hd * 96 + 8 * h;
#pragma unroll
    for (int s = 0; s < 6; ++s) qf[s] = *(const bf16x8*)(qrow + 16 * s); }
  auto tf = [&](int t, const bf16_t*& kp, const bf16_t*& vp, const float*&) -> int {
    const int keybase = 32 * (t < 7 ? t : 7);
    kp = MK + (size_t)((half * 4 + hd) * 8 + (keybase >> 5)) * 3072 + lane * 8;
    vp = MV + (size_t)((half * 4 + hd) * 8 + (keybase >> 5)) * 3072 + lane * 8;
    return 0;
  };
  auto mf = [&](int, int, float) -> float { return 0.f; };
  auto sf = [&](int, float, float) { return false; };
  f32x16 o[3]; zero_o(o); float m = -1e30f, l = 0.f;
  attn_loop<96, false>(8, tf, mf, sf, qf, 256L, 0.10206207261596577f * LOG2E, o, m, l);
  float lt;
  attn_store_gated<96>(o, l, (bf16_t*)(p.ws + O_SZ) + (size_t)(qtile * 32 + r) * 1920 + 4 * 384 + hd * 96, h);
}

DI float dpp_ror(float v, int ctrl);
DI float row16_sum(float v) {
  v += __builtin_bit_cast(float, __builtin_amdgcn_update_dpp(0, __builtin_bit_cast(int, v), 0x128, 0xf, 0xf, false));
  v += __builtin_bit_cast(float, __builtin_amdgcn_update_dpp(0, __builtin_bit_cast(int, v), 0x124, 0xf, 0xf, false));
  v += __builtin_bit_cast(float, __builtin_amdgcn_update_dpp(0, __builtin_bit_cast(int, v), 0x122, 0xf, 0xf, false));
  v += __builtin_bit_cast(float, __builtin_amdgcn_update_dpp(0, __builtin_bit_cast(int, v), 0x121, 0xf, 0xf, false));
  return v;
}

struct ScanRegs { bf16x8 pf[4][2]; bf16x8 qe[4][2]; s16x4 bc[4]; s16x4 o0[4]; float gl; };
DI void scan_load(const Params& p, int hh, int j, int c, int lane, ScanRegs& s) {
  const unsigned char* base = p.ws + O_DPREP + (size_t)(hh * 128 + c) * 32768;
#pragma unroll
  for (int mt = 0; mt < 4; ++mt)
#pragma unroll
    for (int ks = 0; ks < 2; ++ks) {
      s.pf[mt][ks] = *(const bf16x8*)(base + ((mt * 2 + ks) * 64 + lane) * 16);
      s.qe[mt][ks] = *(const bf16x8*)(base + 8192 + ((mt * 2 + ks) * 64 + lane) * 16);
    }
#pragma unroll
  for (int rt = 0; rt < 4; ++rt) {
    s.bc[rt] = *(const s16x4*)(base + 16384 + ((j * 4 + rt) * 64 + lane) * 8);
    s.o0[rt] = *(const s16x4*)(base + 24576 + ((j * 4 + rt) * 64 + lane) * 8);
  }
  s.gl = ((const float*)(p.ws + O_GL))[hh * 128 + c];
}
DI f32x4 s4f(s16x4 v) { u32x2 u = __builtin_bit_cast(u32x2, v); f32x4 r; r[0] = bflo(u.x); r[1] = bfhi(u.x); r[2] = bflo(u.y); r[3] = bfhi(u.y); return r; }

DI void scan_item(const Params& p, int it) {
  const int lane = otid() & 63, q = lane >> 4, cl = lane & 15;
  const int hh = it >> 2, j = it & 3;
  f32x4 S[4];
#pragma unroll
  for (int rt = 0; rt < 4; ++rt) S[rt] = (f32x4){0.f, 0.f, 0.f, 0.f};
  bf16_t* OD = (bf16_t*)(p.ws + O_OD);
  float* SSQ = (float*)(p.ws + O_SSQ);
#ifndef SCAN_PREFETCH
#define SCAN_PREFETCH 1
#endif
  ScanRegs cur, nxt;
  if (SCAN_PREFETCH) scan_load(p, hh, j, 0, lane, cur);
  for (int c = 0; c < 128; ++c) {
    if (SCAN_PREFETCH) {
      scan_load(p, hh, j, (c + 1 < 128) ? c + 1 : c, lane, nxt);
      asm volatile("" : "+v"(S[0][0]) :: "memory");
    } else {
      scan_load(p, hh, j, c, lane, cur);
    }
    bf16x8 bfr[2];
#pragma unroll
    for (int ks = 0; ks < 2; ++ks) {
      u32x4 u; u.x = pk2(S[2 * ks][0], S[2 * ks][1]); u.y = pk2(S[2 * ks][2], S[2 * ks][3]); u.z = pk2(S[2 * ks + 1][0], S[2 * ks + 1][1]); u.w = pk2(S[2 * ks + 1][2], S[2 * ks + 1][3]);
      bfr[ks] = __builtin_bit_cast(bf16x8, u);
    }
    f32x4 aP[4], aO[4];
#pragma unroll
    for (int rt = 0; rt < 4; ++rt) {
      aP[rt] = (f32x4){0.f, 0.f, 0.f, 0.f};
      aO[rt] = s4f(cur.o0[rt]);
#pragma unroll
      for (int ks = 0; ks < 2; ++ks) { aP[rt] = MFMA16(cur.pf[rt][ks], bfr[ks], aP[rt]); aO[rt] = MFMA16(cur.qe[rt][ks], bfr[ks], aO[rt]); }
    }
#pragma unroll
    for (int rt = 0; rt < 4; ++rt) S[rt] = S[rt] * cur.gl - aP[rt] + s4f(cur.bc[rt]);
#pragma unroll
    for (int rt = 0; rt < 4; ++rt)
#pragma unroll
      for (int e = 0; e < 4; ++e) {
        const int tok = c * 64 + 16 * rt + 4 * q + e;
        const float v = aO[rt][e];
        OD[(size_t)tok * 384 + hh * 64 + 16 * j + cl] = f2bf(v);
        const float ss = row16_sum(v * v);
        if (cl == 0) SSQ[(tok * 6 + hh) * 4 + j] = ss;
      }
    if (SCAN_PREFETCH) cur = nxt;
  }
}

DI void scan_block(const Params& p, int hh, unsigned char* smem) {
  const int tid = otid(), lane = tid & 63, j = tid >> 6, q = lane >> 4, cl = lane & 15;
  const unsigned char* src = p.ws + O_DPREP + (size_t)hh * 128 * 32768;
  bf16_t* ostg = (bf16_t*)(smem + 65536);
  bf16x8 R0[8], R1[8];
  auto gld = [&](int c, bf16x8 (&R)[8]) {
    c = c < 128 ? c : 127;
    const unsigned char* b = src + (size_t)c * 32768 + tid * 16;
#pragma unroll
    for (int i = 0; i < 8; ++i) R[i] = *(const bf16x8*)(b + i * 4096);
  };
  auto lst = [&](int buf, const bf16x8 (&R)[8]) {
    unsigned char* d = smem + buf * 32768 + tid * 16;
#pragma unroll
    for (int i = 0; i < 8; ++i) *(bf16x8*)(d + i * 4096) = R[i];
  };
  const float* GL = (const float*)(p.ws + O_GL) + hh * 128;
  const float gl_lo = GL[lane], gl_hi = GL[64 + lane];
  f32x4 S[4];
#pragma unroll
  for (int rt = 0; rt < 4; ++rt) S[rt] = (f32x4){0.f, 0.f, 0.f, 0.f};
  bf16_t* OD = (bf16_t*)(p.ws + O_OD);
  float* SSQ = (float*)(p.ws + O_SSQ);
  f32x4 aO[4];
  auto flush = [&](int cp) {
    const int row = tid >> 2, part = tid & 3;
    const bf16x8 v0 = *(const bf16x8*)(ostg + row * 72 + 16 * part), v1 = *(const bf16x8*)(ostg + row * 72 + 16 * part + 8);
    float f[16]; unpk8(v0, f); unpk8(v1, f + 8);
    float ss = 0.f;
#pragma unroll
    for (int e = 0; e < 16; ++e) ss += f[e] * f[e];
    const int tok = cp * 64 + row;
    bf16_t* dst = OD + (size_t)tok * 384 + hh * 64 + 16 * part;
    *(bf16x8*)dst = v0; *(bf16x8*)(dst + 8) = v1;
    SSQ[(tok * 6 + hh) * 4 + part] = ss;
  };
  auto compute = [&](int buf, int c) {
    const unsigned char* base = smem + buf * 32768;
    const float gl = __builtin_bit_cast(float, __builtin_amdgcn_readlane(__builtin_bit_cast(int, c < 64 ? gl_lo : gl_hi), c & 63));
    bf16x8 bfr[2];
#pragma unroll
    for (int ks = 0; ks < 2; ++ks) {
      u32x4 u; u.x = pk2(S[2 * ks][0], S[2 * ks][1]); u.y = pk2(S[2 * ks][2], S[2 * ks][3]); u.z = pk2(S[2 * ks + 1][0], S[2 * ks + 1][1]); u.w = pk2(S[2 * ks + 1][2], S[2 * ks + 1][3]);
      bfr[ks] = __builtin_bit_cast(bf16x8, u);
    }
    f32x4 aP[4];
#pragma unroll
    for (int rt = 0; rt < 4; ++rt) {
      aP[rt] = (f32x4){0.f, 0.f, 0.f, 0.f};
      aO[rt] = s4f(*(const s16x4*)(base + 24576 + ((j * 4 + rt) * 64 + lane) * 8));
#pragma unroll
      for (int ks = 0; ks < 2; ++ks) {
        aP[rt] = MFMA16(*(const bf16x8*)(base + ((rt * 2 + ks) * 64 + lane) * 16), bfr[ks], aP[rt]);
        aO[rt] = MFMA16(*(const bf16x8*)(base + 8192 + ((rt * 2 + ks) * 64 + lane) * 16), bfr[ks], aO[rt]);
      }
    }
#pragma unroll
    for (int rt = 0; rt < 4; ++rt) S[rt] = S[rt] * gl - aP[rt] + s4f(*(const s16x4*)(base + 16384 + ((j * 4 + rt) * 64 + lane) * 8));
  };
  auto stage_out = [&]() {
#pragma unroll
    for (int rt = 0; rt < 4; ++rt)
#pragma unroll
      for (int e = 0; e < 4; ++e) ostg[(16 * rt + 4 * q + e) * 72 + 16 * j + cl] = f2bf(aO[rt][e]);
  };
  __builtin_amdgcn_s_setprio(3);
  gld(0, R0); gld(1, R1);
  lst(0, R0); gld(2, R0);
  sub_sync();
#pragma unroll 1
  for (int c = 0; c < 128; c += 2) {
    lst(1, R1);
    gld(c + 3, R1);
    if (c > 0) flush(c - 1);
    compute(0, c);
    sub_sync();
    stage_out();
    sub_sync();
    lst(0, R0);
    gld(c + 4, R0);
    flush(c);
    compute(1, c + 1);
    sub_sync();
    stage_out();
    sub_sync();
  }
  flush(127);
  sub_sync();
  __builtin_amdgcn_s_setprio(0);
}

DI void phase3(const Params& p, int half, unsigned* ctr, const unsigned* kmaxu, unsigned char* smem, int sub, int limit = 1 << 30) {
  const int tid = otid(), wave = tid >> 6;
  const int hb = (int)blockIdx.x, x = hb & 7, bi = hb >> 3;
  if (hb < 6 && sub == 0 && limit >= 0) { if (PH(5)) scan_block(p, hb, smem); }
  if (bi >= 1 && limit != 0) {
    const int nlw = ((int)(gridDim.x >> 3) - 1) * 8, lw = ((bi - 1) * 2 + sub) * 4 + wave;
    if (x < 6) {
      const int hh = x;
      constexpr int NG = 992, NOWN = 256, NB_ = 640, NTOT = NG + NOWN + NB_;
      for (int pos0 = lw; pos0 < NTOT; pos0 += nlw) {
        int pos = __builtin_amdgcn_readfirstlane(pos0);
        if (pos < NG) { if (PH(6)) moba_gather(p, (((pos >> 1) * 6 + hh) << 1) | (pos & 1), smem); continue; }
        pos -= NG;
        if (pos < NOWN) { if (PH(6)) moba_own(p, pos * 6 + hh); continue; }
        pos -= NOWN;
        const int g = pos < 512 ? (pos >> 8) : 2, w = pos < 512 ? (pos & 255) : 2 * (pos - 512);
        if (PH(8)) dil_item(p, g * 1536 + hh * 256 + w);
      }
    } else {
      const int h0 = (x - 6) * 3;
      constexpr int NE = 512, NC = 768, NB2 = 384, NTOT = NE + NC + NB2;
      for (int pos0 = lw; pos0 < NTOT; pos0 += nlw) {
        int pos = __builtin_amdgcn_readfirstlane(pos0);
        if (pos < NE) { if (PH(7)) mem_item(p, half, (x - 6) * 512 + pos); continue; }
        pos -= NE;
        if (pos < NC) { if (PH(9)) fox_item(p, (pos & 255) * 6 + h0 + (pos >> 8), kmaxu); continue; }
        pos -= NC;
        if (PH(8)) dil_item(p, 2 * 1536 + (h0 + (pos >> 7)) * 256 + 2 * (pos & 127) + 1);
      }
    }
  }
}

DI void gbuild_chunk(const Params& p, int layer, int tok, int c8) {
  const unsigned char* ws = p.ws;
  const int n = c8 / 48, c = (c8 % 48) * 8;
  if (n == 2 || n == 4) return;
  bf16_t* szp = (bf16_t*)(p.ws + O_SZ) + (size_t)tok * 1920 + n * 384 + c;
  float o[8], z[8];
  unpk8(*(const bf16x8*)szp, z);
  if (n == 1) {
    const int hh = c >> 6;
    const float* st = (const float*)(ws + O_STB);
    float mg[3], lg[3];
#pragma unroll
    for (int g = 0; g < 3; ++g) { const f32x2 s2 = *(const f32x2*)(st + ((size_t)(g * TH + tok) * 6 + hh) * 2); mg[g] = s2[0]; lg[g] = s2[1]; }
    const float mm = fmaxf(mg[0], fmaxf(mg[1], mg[2]));
    float wg[3], ws_ = 0.f;
#pragma unroll
    for (int g = 0; g < 3; ++g) { wg[g] = exp2f(mg[g] - mm) * lg[g]; ws_ += wg[g]; }
    const float inv = 1.f / ws_;
#pragma unroll
    for (int e = 0; e < 8; ++e) o[e] = 0.f;
#pragma unroll
    for (int g = 0; g < 3; ++g) {
      float t[8]; unpk8(*(const bf16x8*)((const bf16_t*)(ws + O_OB + g * SZ_O) + (size_t)tok * 384 + c), t);
      const float wgi = wg[g] * inv;
#pragma unroll
      for (int e = 0; e < 8; ++e) o[e] += wgi * t[e];
    }
  } else if (n == 3) {
    const int hh = c >> 6;
    const f32x4 sq = *(const f32x4*)((const float*)(ws + O_SSQ) + ((size_t)tok * 6 + hh) * 4);
    const float rs = rsqrtf((sq[0] + sq[1] + sq[2] + sq[3]) * (1.f / 64.f) + 1e-6f);
    unpk8(*(const bf16x8*)((const bf16_t*)(ws + O_OD) + (size_t)tok * 384 + c), o);
    const float* gw = p.gdn_w + layer * 64 + (c & 63);
#pragma unroll
    for (int e = 0; e < 8; ++e) o[e] *= rs * gw[e];
  } else if (n == 0) {
    const int hh = c >> 6;
    const float* st = (const float*)(ws + O_STA);
    float mg[4], lg[4], mm = -1e30f;
#pragma unroll
    for (int g = 0; g < 4; ++g) { const f32x2 s2 = *(const f32x2*)(st + ((size_t)(g * TH + tok) * 6 + hh) * 2); mg[g] = s2[0]; lg[g] = s2[1]; mm = fmaxf(mm, mg[g]); }
    float wg[4], ws_ = 0.f;
#pragma unroll
    for (int g = 0; g < 4; ++g) { wg[g] = exp2f(mg[g] - mm) * lg[g]; ws_ += wg[g]; }
    const float inv = 1.f / ws_;
#pragma unroll
    for (int e = 0; e < 8; ++e) o[e] = 0.f;
#pragma unroll
    for (int g = 0; g < 4; ++g) {
      if (lg[g] > 0.f) {
        float t[8]; unpk8(*(const bf16x8*)((const bf16_t*)(ws + O_OA + g * SZ_O) + (size_t)tok * 384 + c), t);
        const float wgi = wg[g] * inv;
#pragma unroll
        for (int e = 0; e < 8; ++e) o[e] += wgi * t[e];
      }
    }
  } else {
    const size_t off = (n == 2) ? O_OC : O_OE;
    unpk8(*(const bf16x8*)((const bf16_t*)(ws + off) + (size_t)tok * 384 + c), o);
  }
#pragma unroll
  for (int e = 0; e < 8; ++e) o[e] *= z[e];
  *(bf16x8*)szp = pk8(o);
}

DI void p4a_tile(const Params& p, int layer, int mt, int nt, unsigned char* smem) {
  sub_sync();
  bf16_t* As = (bf16_t*)smem; bf16_t* Bs = As + 2 * 9216;
  const int tid = otid(), lane = tid & 63, wave = tid >> 6, wr = wave >> 1, wc = wave & 1, r = lane & 31, h = lane >> 5;
  const int m0 = mt * 128, n0 = nt * 128;
  f32x16 tot[2][2]; zero_acc(tot);
  const bf16_t* SIG = (const bf16_t*)(p.ws + O_SIG);
  for (int n = 0; n < 5; ++n) {
    f32x16 acc[2][2]; zero_acc(acc);
    PlainA al{(const bf16_t*)(p.ws + O_SZ) + n * 384, 1920};
    gemm_kloop_t<32>(al, (const bf16_t*)(p.ws + O_WTBR) + (size_t)(layer * 5 + n) * 1024 * 384, 384, 12, m0, n0, acc, As, Bs);
#pragma unroll
    for (int mi = 0; mi < 2; ++mi) {
      const int tok = m0 + wr * 64 + mi * 32 + r;
#pragma unroll
      for (int ni = 0; ni < 2; ++ni)
#pragma unroll
        for (int g = 0; g < 4; ++g) {
          const int col = n0 + wc * 64 + ni * 32 + 8 * g + 4 * h;
          const u32x2 sg = *(const u32x2*)(SIG + (size_t)tok * 5120 + n * 1024 + col);
          tot[mi][ni][4 * g] += bflo(sg.x) * acc[mi][ni][4 * g];
          tot[mi][ni][4 * g + 1] += bfhi(sg.x) * acc[mi][ni][4 * g + 1];
          tot[mi][ni][4 * g + 2] += bflo(sg.y) * acc[mi][ni][4 * g + 2];
          tot[mi][ni][4 * g + 3] += bfhi(sg.y) * acc[mi][ni][4 * g + 3];
          asm volatile("" ::: "memory");
        }
    }
  }
  bf16_t* YM = (bf16_t*)(p.ws + O_YM);
  {
    bf16_t* stg = (bf16_t*)smem + wave * (64 * 72);
#pragma unroll
    for (int ni = 0; ni < 2; ++ni)
#pragma unroll
      for (int mi = 0; mi < 2; ++mi)
#pragma unroll
        for (int g = 0; g < 4; ++g)
          *(u32x2*)(stg + (mi * 32 + r) * 72 + ni * 32 + 8 * g + 4 * h) = pk4(tot[mi][ni][4 * g], tot[mi][ni][4 * g + 1], tot[mi][ni][4 * g + 2], tot[mi][ni][4 * g + 3]);
    asm volatile("s_waitcnt lgkmcnt(0)" ::: "memory");
    __builtin_amdgcn_wave_barrier();
    const int tok0 = m0 + wr * 64, col0 = n0 + wc * 64;
#pragma unroll
    for (int it = 0; it < 8; ++it) {
      const int row = it * 8 + (lane >> 3), ch = (lane & 7) * 8;
      const bf16x8 val = *(const bf16x8*)(stg + row * 72 + ch);
      *(bf16x8*)(YM + (size_t)(tok0 + row) * 1024 + col0 + ch) = val;
    }
  }
}

DI void p4b_tile(const Params& p, int layer, int half, int mt, int nt, unsigned char* smem) {
  bf16_t* As = (bf16_t*)smem; bf16_t* Bs = As + 2 * 9216;
  const int tid = otid(), lane = tid & 63, wave = tid >> 6, wr = wave >> 1, wc = wave & 1, r = lane & 31, h = lane >> 5;
  const int m0 = mt * 128, n0 = nt * 128;
  f32x16 acc[2][2]; zero_acc(acc);
  PlainA al{(const bf16_t*)(p.ws + O_YM), 1024};
  gemm_kloop(al, (const bf16_t*)(p.ws + O_WTOUT + layer * SZ_WTOUT1), 1024, 16, m0, n0, acc, As, Bs);
  const float* xin = layer == 0 ? p.x : p.out;
  const float alpha = 1.4142135623730951f;
#pragma unroll
  for (int mi = 0; mi < 2; ++mi) {
    const size_t gt = (size_t)half * TH + m0 + wr * 64 + mi * 32 + r;
#pragma unroll
    for (int ni = 0; ni < 2; ++ni)
#pragma unroll
      for (int g = 0; g < 4; ++g) {
        const int col = n0 + wc * 64 + ni * 32 + 8 * g + 4 * h;
        const f32x4 xv = *(const f32x4*)(xin + gt * 1024 + col);
        f32x4 o;
#pragma unroll
        for (int e = 0; e < 4; ++e) o[e] = alpha * xv[e] + acc[mi][ni][4 * g + e];
        *(f32x4*)(p.out + gt * 1024 + col) = o;
      }
  }
}

DI void gemm8_kloop(const bf16_t* __restrict__ Ab, int lda, const bf16_t* __restrict__ Bb, int ldb, int nkt, f32x4 (&acc)[4][4], unsigned char* lds) {
  const int tid = rtid(), wid = tid >> 6, lane = tid & 63, wr = wid >> 1, wc = wid & 1, fr = lane & 15, fq = lane >> 4;
  int aOff[4], bOff[2];
#pragma unroll
  for (int i = 0; i < 4; ++i) { int R, C; g_stage_rc(wid * 1024 + i * 8192 + lane * 16, R, C); aOff[i] = R * lda + C; }
#pragma unroll
  for (int i = 0; i < 2; ++i) { int R, C; g_stage_rc(wid * 1024 + i * 8192 + lane * 16, R, C); bOff[i] = R * ldb + C; }
  auto stage = [&](int buf, int kt) {
#pragma unroll
    for (int i = 0; i < 4; ++i)
      __builtin_amdgcn_global_load_lds((const unsigned*)(Ab + aOff[i] + kt * 64), (unsigned*)(lds + buf * 49152 + wid * 1024 + i * 8192), 16, 0, 0);
#pragma unroll
    for (int i = 0; i < 2; ++i)
      __builtin_amdgcn_global_load_lds((const unsigned*)(Bb + bOff[i] + kt * 64), (unsigned*)(lds + buf * 49152 + 32768 + wid * 1024 + i * 8192), 16, 0, 0);
  };
  const int lane_off = (fr * 64 + fq * 16) ^ ((fr >> 3) << 5);
  __syncthreads();
  stage(0, 0);
  asm volatile("s_waitcnt vmcnt(0)" ::: "memory");
  __syncthreads();
#pragma unroll 1
  for (int t = 0; t < nkt; ++t) {
    const int cur = t & 1;
    if (t + 1 < nkt) stage(cur ^ 1, t + 1);
    const unsigned char* SA = lds + cur * 49152 + wr * 8192 + lane_off;
    const unsigned char* SB = lds + cur * 49152 + 32768 + wc * 8192 + lane_off;
#pragma unroll
    for (int ks = 0; ks < 2; ++ks) {
      bf16x8 At[4], Bf[4];
#pragma unroll
      for (int n = 0; n < 4; ++n) Bf[n] = *(const bf16x8*)(SB + n * 2048 + ks * 1024);
#pragma unroll
      for (int m = 0; m < 4; ++m) At[m] = *(const bf16x8*)(SA + m * 2048 + ks * 1024);
#pragma unroll
      for (int m = 0; m < 4; ++m)
#pragma unroll
        for (int n = 0; n < 4; ++n) acc[m][n] = MFMA16(Bf[n], At[m], acc[m][n]);
    }
    asm volatile("s_waitcnt vmcnt(0)" ::: "memory");
    __syncthreads();
  }
}

DI void p4a_unit(const Params& p, int layer, int pm, int pn, unsigned char* lds) {
  const int tid = rtid(), wid = tid >> 6, lane = tid & 63, wr = wid >> 1, wc = wid & 1, fr = lane & 15, fq = lane >> 4;
  const int tok0 = pm * 256 + wr * 64, col0 = pn * 128 + wc * 64;
  const bf16_t* SIG = (const bf16_t*)(p.ws + O_SIG);
  const bf16_t* Ab = (const bf16_t*)(p.ws + O_SZ) + (size_t)pm * 256 * 1920;
  const bf16_t* Bb = (const bf16_t*)(p.ws + O_WTBR) + (size_t)layer * 5 * 1024 * 384 + (size_t)pn * 128 * 384;
  int aOff[4], bOff[2];
#pragma unroll
  for (int i = 0; i < 4; ++i) { int R, C; g_stage_rc(wid * 1024 + i * 8192 + lane * 16, R, C); aOff[i] = R * 1920 + C; }
#pragma unroll
  for (int i = 0; i < 2; ++i) { int R, C; g_stage_rc(wid * 1024 + i * 8192 + lane * 16, R, C); bOff[i] = R * 384 + C; }
  auto stage = [&](int buf, int T) {
    const int nb = T / 6, kk = T - nb * 6;
    const long bo = (long)nb * (1024 * 384) + kk * 64;
#pragma unroll
    for (int i = 0; i < 4; ++i)
      __builtin_amdgcn_global_load_lds((const unsigned*)(Ab + aOff[i] + T * 64), (unsigned*)(lds + buf * 49152 + wid * 1024 + i * 8192), 16, 0, 0);
#pragma unroll
    for (int i = 0; i < 2; ++i)
      __builtin_amdgcn_global_load_lds((const unsigned*)(Bb + bOff[i] + bo), (unsigned*)(lds + buf * 49152 + 32768 + wid * 1024 + i * 8192), 16, 0, 0);
  };
  f32x4 tot[4][4], acc[4][4];
#pragma unroll
  for (int m = 0; m < 4; ++m)
#pragma unroll
    for (int n = 0; n < 4; ++n) { tot[m][n] = (f32x4){0.f, 0.f, 0.f, 0.f}; acc[m][n] = (f32x4){0.f, 0.f, 0.f, 0.f}; }
  const int lane_off = (fr * 64 + fq * 16) ^ ((fr >> 3) << 5);
  __syncthreads();
  stage(0, 0);
  asm volatile("s_waitcnt vmcnt(0)" ::: "memory");
  __syncthreads();
#pragma unroll 1
  for (int t = 0; t < 30; ++t) {
    const int cur = t & 1;
    if (t + 1 < 30) stage(cur ^ 1, t + 1);
    const unsigned char* SA = lds + cur * 49152 + wr * 8192 + lane_off;
    const unsigned char* SB = lds + cur * 49152 + 32768 + wc * 8192 + lane_off;
#pragma unroll
    for (int ks = 0; ks < 2; ++ks) {
      bf16x8 At[4], Bf[4];
#pragma unroll
      for (int n = 0; n < 4; ++n) Bf[n] = *(const bf16x8*)(SB + n * 2048 + ks * 1024);
#pragma unroll
      for (int m = 0; m < 4; ++m) At[m] = *(const bf16x8*)(SA + m * 2048 + ks * 1024);
#pragma unroll
      for (int m = 0; m < 4; ++m)
#pragma unroll
        for (int n = 0; n < 4; ++n) acc[m][n] = MFMA16(Bf[n], At[m], acc[m][n]);
    }
    const int nb = t / 6;
    if (t - nb * 6 == 5) {
#pragma unroll
      for (int m = 0; m < 4; ++m) {
        const int tok = tok0 + m * 16 + fr;
#pragma unroll
        for (int n = 0; n < 4; ++n) {
          const u32x2 sg = *(const u32x2*)(SIG + (size_t)tok * 5120 + nb * 1024 + col0 + n * 16 + fq * 4);
          tot[m][n][0] += bflo(sg.x) * acc[m][n][0]; tot[m][n][1] += bfhi(sg.x) * acc[m][n][1];
          tot[m][n][2] += bflo(sg.y) * acc[m][n][2]; tot[m][n][3] += bfhi(sg.y) * acc[m][n][3];
          acc[m][n] = (f32x4){0.f, 0.f, 0.f, 0.f};
        }
      }
    }
    asm volatile("s_waitcnt vmcnt(0)" ::: "memory");
    __syncthreads();
  }
  bf16_t* YM = (bf16_t*)(p.ws + O_YM);
  bf16_t* stg = (bf16_t*)(lds + wid * 9216);
#pragma unroll
  for (int m = 0; m < 4; ++m)
#pragma unroll
    for (int n = 0; n < 4; ++n) *(u32x2*)(stg + (m * 16 + fr) * 72 + n * 16 + fq * 4) = pk4(tot[m][n][0], tot[m][n][1], tot[m][n][2], tot[m][n][3]);
  asm volatile("s_waitcnt lgkmcnt(0)" ::: "memory");
  __builtin_amdgcn_wave_barrier();
#pragma unroll
  for (int it = 0; it < 8; ++it) {
    const int row = it * 8 + (lane >> 3), ch = (lane & 7) * 8;
    const bf16x8 val = *(const bf16x8*)(stg + row * 72 + ch);
    *(bf16x8*)(YM + (size_t)(tok0 + row) * 1024 + col0 + ch) = val;
  }
}

DI void p4b_unit(const Params& p, int layer, int half, int pm, int pn, unsigned char* lds) {
  const int tid = rtid(), wid = tid >> 6, lane = tid & 63, wr = wid >> 1, wc = wid & 1, fr = lane & 15, fq = lane >> 4;
  f32x4 acc[4][4];
#pragma unroll
  for (int m = 0; m < 4; ++m)
#pragma unroll
    for (int n = 0; n < 4; ++n) acc[m][n] = (f32x4){0.f, 0.f, 0.f, 0.f};
  gemm8_kloop((const bf16_t*)(p.ws + O_YM) + (size_t)pm * 256 * 1024, 1024,
              (const bf16_t*)(p.ws + O_WTOUT + layer * SZ_WTOUT1) + (size_t)pn * 128 * 1024, 1024, 16, acc, lds);
  const float* xin = layer == 0 ? p.x : p.out;
  const float alpha = 1.4142135623730951f;
#pragma unroll
  for (int m = 0; m < 4; ++m) {
    const size_t gt = (size_t)half * TH + pm * 256 + wr * 64 + m * 16 + fr;
#pragma unroll
    for (int n = 0; n < 4; ++n) {
      const int col = pn * 128 + wc * 64 + n * 16 + fq * 4;
      const f32x4 xv = *(const f32x4*)(xin + gt * 1024 + col);
      f32x4 o;
#pragma unroll
      for (int e = 0; e < 4; ++e) o[e] = alpha * xv[e] + acc[m][n][e];
      *(f32x4*)(p.out + gt * 1024 + col) = o;
    }
  }
}

DI void p4c_row(const Params& p, int layer, size_t gt, bool wxb = true) {
  const int lane = otid() & 63;
  float* row = p.out + gt * 1024;
  f32x4 v[4]; float s = 0.f;
#pragma unroll
  for (int j = 0; j < 4; ++j) { v[j] = *(const f32x4*)(row + 4 * lane + 256 * j); s += v[j][0] + v[j][1] + v[j][2] + v[j][3]; }
#pragma unroll
  for (int o = 32; o >= 1; o >>= 1) s += __shfl_xor(s, o);
  const float mu = s * (1.f / 1024.f); float q = 0.f;
#pragma unroll
  for (int j = 0; j < 4; ++j) { v[j] -= mu; q += v[j][0] * v[j][0] + v[j][1] * v[j][1] + v[j][2] * v[j][2] + v[j][3] * v[j][3]; }
#pragma unroll
  for (int o = 32; o >= 1; o >>= 1) q += __shfl_xor(q, o);
  const float rs = rsqrtf(q * (1.f / 1024.f) + 1e-5f);
  bf16_t* xb = (bf16_t*)(p.ws + O_XB) + gt * 1024;
#pragma unroll
  for (int j = 0; j < 4; ++j) {
    const int c = 4 * lane + 256 * j;
    const f32x4 g = *(const f32x4*)(p.ln_g + layer * 1024 + c), b = *(const f32x4*)(p.ln_b + layer * 1024 + c);
    f32x4 y;
#pragma unroll
    for (int e = 0; e < 4; ++e) y[e] = v[j][e] * rs * g[e] + b[e];
    *(f32x4*)(row + c) = y;
    if (wxb) *(u32x2*)(xb + c) = pk4(y[0], y[1], y[2], y[3]);
  }
}


#define XB_TMO      128
#define XB_XCNT(j)  (256  + 64 * (j))
#define XB_XSUB(j)  (1280 + 64 * (j))
#define XB_XGEN(j)  (2304 + 64 * (j))
#define XB_TOP      3328
#define XB_TOPGEN   3392
#define XB_SPIN_CAP (1u << 22)
#define LAS __attribute__((address_space(3)))
DI unsigned xb_ld(unsigned* p) { return __hip_atomic_load(p, __ATOMIC_RELAXED, __HIP_MEMORY_SCOPE_AGENT); }
DI unsigned xb_add(unsigned* p, unsigned v) { return __hip_atomic_fetch_add(p, v, __ATOMIC_RELAXED, __HIP_MEMORY_SCOPE_AGENT); }
DI unsigned xb_xcc_id() { return (unsigned)__builtin_amdgcn_s_getreg((3 << 11) | 20) & 0xFu; }
#define XB_SPIN(cond, bar) do { unsigned _sp = 0; while (cond) { __builtin_amdgcn_s_sleep(1); \
    if ((++_sp & 255u) == 0u) { if (xb_ld(&(bar)[XB_TMO])) break; if (_sp > XB_SPIN_CAP) { atomicAdd(&(bar)[XB_TMO], 1u); break; } } } } while (0)
struct XcdBarrier { unsigned* bar; unsigned x; volatile LAS unsigned* st; };
DI XcdBarrier xcd_barrier_post(unsigned* bar, volatile LAS unsigned* st) {
  XcdBarrier b; b.bar = bar; b.x = xb_xcc_id(); b.st = st;
  if (threadIdx.x == 0) (void)xb_add(&bar[XB_XCNT(b.x)], 1u);
  return b;
}
DI void xcd_barrier_complete(unsigned* bar, unsigned x, unsigned& nloc, unsigned& nx) {
  const unsigned G = gridDim.x;
  unsigned sum, cnt, mine, sp = 0u;
  for (;;) {
    sum = 0u; cnt = 0u; mine = 0u;
#pragma unroll
    for (unsigned j = 0; j < 16; ++j) { const unsigned c = xb_ld(&bar[XB_XCNT(j)]); sum += c; cnt += (c > 0u) ? 1u : 0u; mine = (j == x) ? c : mine; }
    if (sum == G) break;
    __builtin_amdgcn_s_sleep(1);
    if ((++sp & 255u) == 0u) { if (xb_ld(&bar[XB_TMO])) break; if (sp > XB_SPIN_CAP) { atomicAdd(&bar[XB_TMO], 1u); break; } }
  }
  nloc = mine > 0u ? mine : 1u; nx = cnt > 0u ? cnt : 1u;
}
DI void xcd_barrier(const XcdBarrier& b) {
  asm volatile("s_waitcnt vmcnt(0)" ::: "memory");
  __syncthreads();
  if (threadIdx.x == 0) {
    unsigned* bar = b.bar;
    __builtin_amdgcn_s_waitcnt(0);
    unsigned nloc = b.st[0], nx = b.st[1];
    if (nloc == 0u) { xcd_barrier_complete(bar, b.x, nloc, nx); b.st[0] = nloc; b.st[1] = nx; }
    const unsigned old = xb_add(&bar[XB_XSUB(b.x)], 1u);
    const unsigned gen = old / nloc;
    if (old + 1u == (gen + 1u) * nloc) {
      __builtin_amdgcn_fence(__ATOMIC_RELEASE, "agent");
      asm volatile("s_waitcnt vmcnt(0)" ::: "memory");
      const unsigned og = xb_add(&bar[XB_TOP], 1u);
      const unsigned tg = og / nx;
      if (og + 1u == (tg + 1u) * nx) xb_add(&bar[XB_TOPGEN], 1u);
      else XB_SPIN(xb_ld(&bar[XB_TOPGEN]) == tg, bar);
      __builtin_amdgcn_fence(__ATOMIC_ACQUIRE, "agent");
      xb_add(&bar[XB_XGEN(b.x)], 1u);
      asm volatile("s_waitcnt vmcnt(0)" ::: "memory");
    } else {
      XB_SPIN(xb_ld(&bar[XB_XGEN(b.x)]) == gen, bar);
      __builtin_amdgcn_fence(__ATOMIC_ACQUIRE, "agent");
      asm volatile("s_waitcnt vmcnt(0)" ::: "memory");
    }
  }
  __syncthreads();
}

#ifdef PROBE_A
#define STAMP(k) do { if (blockIdx.x == 0 && otid() == 0) { unsigned long long now_ = __builtin_amdgcn_s_memrealtime(); tsacc[k] += (float)(now_ - tlast) * 0.01f; tlast = now_; } } while (0)
#else
#define STAMP(k) do {} while (0)
#endif
__global__ void __launch_bounds__(512, 2) mega(Params p) {
  extern __shared__ __attribute__((aligned(16))) unsigned char smem_all[];
  cg::grid_group grid = cg::this_grid();
  if (p.ws == nullptr) grid.sync();
  volatile LAS unsigned* xbst = (volatile LAS unsigned*)(smem_all + 2 * SUB_LDS);
  if (threadIdx.x < 4) xbst[threadIdx.x] = 0u;
  __syncthreads();
  const XcdBarrier xb = xcd_barrier_post((unsigned*)(p.ws + O_BAR), xbst);
#define GSYNC() xcd_barrier(xb)
  const int sub = __builtin_amdgcn_readfirstlane(__builtin_amdgcn_workitem_id_x() >> 8);
  unsigned char* smem = smem_all + sub * SUB_LDS;
  const int vb = (int)blockIdx.x * 2 + sub, vgrid = (int)gridDim.x * 2;
  const int wave = otid() >> 6;
  const int gw = vb * 4 + wave, ngw = vgrid * 4;
  phase0(p, smem, vb, vgrid);
  GSYNC();
  int pend_layer = -1, pend_half = 0;
  for (int itn = 0; itn < 4; ++itn) {
    const int layer = itn >> 1, half = itn & 1;
    if (pend_layer >= 0) { for (int rw = gw; rw < TH; rw += ngw) p4c_row(p, pend_layer, (size_t)pend_half * TH + rw, true); pend_layer = -1; }
    for (int t = (int)blockIdx.x; t < 32 * 54; t += (int)gridDim.x) {
      const int tn = t + (int)gridDim.x;
      p1_unit(p, layer, half, t & 31, t >> 5, tn < 32 * 54 ? (tn & 31) : 0, tn < 32 * 54 ? (tn >> 5) : -1, t == (int)blockIdx.x, smem_all);
    }
    GSYNC();
    const int vb2 = sub * (int)gridDim.x + (int)blockIdx.x;
    {
      constexpr int N_FOX = 6, N_GDN = 768, N_MKV = 12, N_KM = 48, TOT = N_FOX + N_GDN + N_MKV + N_KM;
      for (int t = vb2; t < TOT; t += vgrid) {
        int i = t;
        if (i < N_FOX) { fox_prep(p, i, smem); continue; }
        i -= N_FOX;
        if (i < N_GDN) { gdn_prep(p, layer, half, i / 128, i % 128, smem); continue; }
        i -= N_GDN;
        if (i < N_MKV) { memkv_tile(p, layer, half, i / 6, i % 6, smem); continue; }
        i -= N_MKV;
        kmean_prep(p, i * 4 + wave, (unsigned*)(p.ws + O_CTL) + 64 + (layer * 2 + half) * 8);
      }
    }
    if (vb2 >= 256) { for (int a = (vb2 - 256) * 4 + wave; a < 1536; a += (vgrid - 256) * 4) moba_select(p, a); }
    GSYNC();
    phase3(p, half, (unsigned*)(p.ws + O_CTL) + layer * 2 + half, (const unsigned*)(p.ws + O_CTL) + 64 + (layer * 2 + half) * 8, smem, sub);
    GSYNC();
    for (int ci = vb * 256 + otid(); ci < TH * 240; ci += vgrid * 256) gbuild_chunk(p, layer, ci / 240, ci % 240);
    GSYNC();
    for (int t = (int)blockIdx.x; t < 256; t += (int)gridDim.x) p4a_unit(p, layer, t & 31, t >> 5, smem_all);
    GSYNC();
    for (int t = (int)blockIdx.x; t < 256; t += (int)gridDim.x) p4b_unit(p, layer, half, t & 31, t >> 5, smem_all);
    GSYNC();
    pend_layer = layer; pend_half = half;
  }
  if (pend_layer >= 0) { for (int rw = gw; rw < TH; rw += ngw) p4c_row(p, pend_layer, (size_t)pend_half * TH + rw, true); }
}

extern "C" void kernel_launch(void* const* d_in, const int* in_sizes, int n_in, void* d_out, int out_size, void* d_ws, size_t ws_size,
                              hipStream_t stream) {
  static int grid_blocks = 0;
  if (grid_blocks == 0) {
    if (ws_size < WS_END) { fprintf(stderr, "workspace too small: %zu < %zu\n", ws_size, (size_t)WS_END); grid_blocks = -1; return; }
    int dev = 0, cus = 0, per_cu = 0;
    (void)hipGetDevice(&dev);
    (void)hipDeviceGetAttribute(&cus, hipDeviceAttributeMultiprocessorCount, dev);
    (void)hipFuncSetAttribute((const void*)mega, hipFuncAttributeMaxDynamicSharedMemorySize, LDS_BYTES);
    (void)hipOccupancyMaxActiveBlocksPerMultiprocessor(&per_cu, (const void*)mega, 512, LDS_BYTES);
    if (per_cu < 1) per_cu = 1;
    if (per_cu > 1) per_cu = 1;
    grid_blocks = cus * per_cu;
  }
  if (grid_blocks < 0) return;
  (void)hipMemsetAsync((char*)d_ws + O_CTL, 0, 32768, stream);
  Params p{};
  p.x = (const float*)d_in[0]; p.mem = (const float*)d_in[1]; p.mem_g = (const float*)d_in[2]; p.mem_b = (const float*)d_in[3];
  p.w_in = (const float*)d_in[4]; p.b_in = (const float*)d_in[5]; p.conv_w = (const float*)d_in[6]; p.a_log = (const float*)d_in[7];
  p.dt_bias = (const float*)d_in[8]; p.gdn_w = (const float*)d_in[9]; p.w_kv = (const float*)d_in[10]; p.w_br = (const float*)d_in[11];
  p.w_out = (const float*)d_in[12]; p.ln_g = (const float*)d_in[13]; p.ln_b = (const float*)d_in[14];
  p.out = (float*)d_out; p.ws = (unsigned char*)d_ws;
  void* args[] = {&p};
  hipError_t e = hipLaunchCooperativeKernel((const void*)mega, dim3(grid_blocks), dim3(512), args, LDS_BYTES, stream);
  if (e != hipSuccess) fprintf(stderr, "cooperative launch failed: %s (grid %d)\n", hipGetErrorString(e), grid_blocks);
}
```
